# Optimizing an MI355X kernel written in HIP

```python
import math
import jax, jax.numpy as jnp
from jax import lax
import numpy as np

D_MODEL = 1024
BATCH = 1
SEQ = 16384
DEPTH = 2
DEC_BATCH = 16
DEC_SEQ = 16
PAST_LEN = 2048

CHUNK = 64
MIX_WIDTH = D_MODEL
GROUP_WIDTH = MIX_WIDTH // 4
A_HEADS = 4
A_HEAD_DIM = GROUP_WIDTH // A_HEADS
A_PREV_CHUNKS = 8
A_BAND_PREV = A_PREV_CHUNKS * CHUNK
REL_CLIP = 128
B_HEADS = 4
B_HEAD_DIM = GROUP_WIDTH // B_HEADS
B_GROUPS = 2
B_STATE = 128
B_CONV = 4
B_CONV_DIM = GROUP_WIDTH + 2 * B_GROUPS * B_STATE
C_HEADS = 4
C_KEY_DIM = GROUP_WIDTH // C_HEADS
C_VAL_DIM = GROUP_WIDTH // C_HEADS
D_WINDOWS = (2, 4, 8, 16)
D_GROUP = GROUP_WIDTH // 4
D_BUF = 15
D_FF = -(-8 * D_MODEL // (3 * 256)) * 256
SPLIT_SIZES = (GROUP_WIDTH, GROUP_WIDTH, GROUP_WIDTH,
               GROUP_WIDTH, B_CONV_DIM, B_HEADS,
               GROUP_WIDTH, GROUP_WIDTH, GROUP_WIDTH, GROUP_WIDTH,
               GROUP_WIDTH)
IN_WIDTH = 3 * GROUP_WIDTH + GROUP_WIDTH + B_CONV_DIM + B_HEADS + 4 * GROUP_WIDTH + GROUP_WIDTH
EPS = 1e-6

kernel_name = 'hybrid_chunk_streaming_encoder_step'


def _rmsnorm(x, w):
    xf = x.astype(jnp.float32)
    y = xf * lax.rsqrt(jnp.mean(xf * xf, axis=-1, keepdims=True) + EPS)
    return (y * w.astype(jnp.float32)).astype(x.dtype)


def _to_chunks(a, lp):
    b, l = a.shape[:2]
    a = jnp.pad(a, [(0, 0), (0, lp - l)] + [(0, 0)] * (a.ndim - 2))
    return jnp.moveaxis(a.reshape((b, lp // CHUNK, CHUNK) + a.shape[2:]), 1, 0)


def _from_chunks(a, l):
    a = jnp.moveaxis(a, 0, 1)
    return a.reshape((a.shape[0], -1) + a.shape[3:])[:, :l]


def _band_attention(q, k, v, k_prev, v_prev, rel_bias):
    b, l, h, dh = q.shape
    p = k_prev.shape[1]
    lp = -(-l // CHUNK) * CHUNK
    nc = lp // CHUNK
    pad_new = ((0, 0), (0, lp - l), (0, 0), (0, 0))
    pad_old = ((0, 0), (A_BAND_PREV - p, 0), (0, 0), (0, 0))
    kf = jnp.concatenate([jnp.pad(k_prev, pad_old), jnp.pad(k, pad_new)], axis=1)
    vf = jnp.concatenate([jnp.pad(v_prev, pad_old), jnp.pad(v, pad_new)], axis=1)
    pos = jnp.arange(A_BAND_PREV + lp)
    valid = ((pos >= A_BAND_PREV - p) & (pos < A_BAND_PREV + l)).reshape(nc + A_PREV_CHUNKS, CHUNK)
    kc = kf.reshape(b, nc + A_PREV_CHUNKS, CHUNK, h, dh)
    vc = vf.reshape(b, nc + A_PREV_CHUNKS, CHUNK, h, dh)
    n_band = A_PREV_CHUNKS + 1
    kb = jnp.concatenate([kc[:, i:i + nc] for i in range(n_band)], axis=2)
    vb = jnp.concatenate([vc[:, i:i + nc] for i in range(n_band)], axis=2)
    mb = jnp.concatenate([valid[i:i + nc] for i in range(n_band)], axis=1)
    qc = jnp.pad(q, pad_new).reshape(b, nc, CHUNK, h, dh)
    rel = A_BAND_PREV + jnp.arange(CHUNK)[:, None] - jnp.arange(n_band * CHUNK)[None, :]
    bias = rel_bias[jnp.clip(rel, -REL_CLIP, REL_CLIP) + REL_CLIP]
    s = jnp.einsum('bcihd,bcjhd->bchij', qc, kb).astype(jnp.float32) * (dh ** -0.5)
    s = s + jnp.transpose(bias, (2, 0, 1)).astype(jnp.float32)
    s = jnp.where(mb[None, :, None, None, :], s, -1e30)
    pr = jax.nn.softmax(s, axis=-1).astype(vb.dtype)
    o = jnp.einsum('bchij,bcjhd->bcihd', pr, vb).reshape(b, lp, h, dh)[:, :l]
    return o


def _causal_dwconv(x, buf, w, bias):
    l = x.shape[1]
    xp = jnp.concatenate([buf, x], axis=1)
    y = bias
    for i in range(B_CONV):
        y = y + xp[:, i:i + l] * w[i]
    return jax.nn.silu(y), xp[:, -(B_CONV - 1):]


def _ssd_scan(u, loga, bm, cm, s0):
    l = u.shape[1]
    lp = -(-l // CHUNK) * CHUNK
    xs = tuple(_to_chunks(t.astype(jnp.float32), lp) for t in (u, loga, bm, cm))
    causal = jnp.tril(jnp.ones((CHUNK, CHUNK), dtype=bool))[None, :, :, None]

    def step(state, inp):
        uc, ac, bc, cc = inp
        acs = jnp.cumsum(ac, axis=1)
        decay = jnp.exp(jnp.where(causal, acs[:, :, None] - acs[:, None, :], -jnp.inf))
        y = jnp.einsum('bijh,bjhp->bihp', jnp.einsum('bihn,bjhn->bijh', cc, bc) * decay, uc)
        y = y + jnp.einsum('bihn,bhpn->bihp', cc * jnp.exp(acs)[..., None], state)
        last = acs[:, -1:]
        state = (jnp.exp(last[:, 0])[:, :, None, None] * state
                 + jnp.einsum('bjhn,bjhp->bhpn', bc * jnp.exp(last - acs)[..., None], uc))
        return state, y

    s_fin, ys = lax.scan(step, s0.astype(jnp.float32), xs)
    return _from_chunks(ys, l), s_fin.astype(s0.dtype)


def _hgrn2_scan(q, k, v, logf, s0):
    l = q.shape[1]
    lp = -(-l // CHUNK) * CHUNK
    xs = tuple(_to_chunks(t.astype(jnp.float32), lp) for t in (q, k, v, logf))
    causal = jnp.tril(jnp.ones((CHUNK, CHUNK), dtype=bool))[None, :, :, None, None]

    def step(state, inp):
        qc, kc, vc, gc = inp
        bcs = jnp.cumsum(gc, axis=1)
        decay = jnp.exp(jnp.where(causal, bcs[:, :, None] - bcs[:, None, :], -jnp.inf))
        att = jnp.einsum('bihk,bjhk,bijhk->bijh', qc, kc, decay)
        o = jnp.einsum('bijh,bjhv->bihv', att, vc) + jnp.einsum('bihk,bhkv->bihv', qc * jnp.exp(bcs), state)
        last = bcs[:, -1:]
        state = (jnp.exp(last[:, 0])[..., None] * state
                 + jnp.einsum('bjhk,bjhv->bhkv', kc * jnp.exp(last - bcs), vc))
        return state, o

    s_fin, os_ = lax.scan(step, s0.astype(jnp.float32), xs)
    return _from_chunks(os_, l), s_fin.astype(s0.dtype)


def _multiscale_pool(xd, buf, w_pool, scale):
    b, l, _ = xd.shape
    xp = jnp.concatenate([buf, xd], axis=1)
    xf = xp.astype(jnp.float32)
    cs = jnp.concatenate([jnp.zeros_like(xf[:, :1]), jnp.cumsum(xf, axis=1)], axis=1)
    groups = []
    for g, win in enumerate(D_WINDOWS):
        c0, c1 = g * D_GROUP, (g + 1) * D_GROUP
        total = cs[:, D_BUF + 1:D_BUF + 1 + l, c0:c1] - cs[:, D_BUF + 1 - win:D_BUF + 1 - win + l, c0:c1]
        groups.append(total / win - xf[:, D_BUF:, c0:c1])
    pooled = jnp.stack(groups, axis=2)
    y = jnp.einsum('blgc,gcd->blgd', pooled, w_pool.astype(jnp.float32)).reshape(b, l, GROUP_WIDTH)
    y = y * scale.astype(jnp.float32)
    return y.astype(xd.dtype), xp[:, -D_BUF:]


def _layer(x, w, st, lb):
    (n1, w_in, a_rel, b_cw, b_cb, b_dtb, b_alog, b_d, b_nrm, c_nrm,
     d_pw, d_ps, w_out, n2, w_gu, w_dn) = w
    (k_prev, v_prev, conv_buf, ssm0, hgrn0, pool_buf) = st
    b, l, _ = x.shape
    h = _rmsnorm(x, n1)
    proj = h @ w_in
    split_points = [int(s) for s in np.cumsum(np.array(SPLIT_SIZES))[:-1]]
    (aq, ak, av, bz, bxbc, bdt, cq, cf, ci, cg, dx) = jnp.split(proj, split_points, axis=-1)

    def heads(t, n):
        return t.reshape(b, l, n, -1)

    qa, ka, va = heads(aq, A_HEADS), heads(ak, A_HEADS), heads(av, A_HEADS)
    oa = _band_attention(qa, ka, va, k_prev, v_prev, a_rel).reshape(b, l, GROUP_WIDTH)
    keep = min(A_BAND_PREV, k_prev.shape[1] + l)
    new_k = jnp.concatenate([k_prev, ka], axis=1)[:, -keep:]
    new_v = jnp.concatenate([v_prev, va], axis=1)[:, -keep:]

    xbc, new_conv = _causal_dwconv(bxbc, conv_buf, b_cw, b_cb)
    xs, bb, bc = jnp.split(xbc, [GROUP_WIDTH, GROUP_WIDTH + B_GROUPS * B_STATE], axis=-1)
    xs = heads(xs, B_HEADS).astype(jnp.float32)
    rep = B_HEADS // B_GROUPS
    bb = jnp.repeat(heads(bb, B_GROUPS), rep, axis=2)
    bc = jnp.repeat(heads(bc, B_GROUPS), rep, axis=2)
    dt = jax.nn.softplus(bdt.astype(jnp.float32) + b_dtb.astype(jnp.float32))
    a_neg = -jnp.exp(b_alog.astype(jnp.float32))
    ys, new_ssm = _ssd_scan(xs * dt[..., None], dt * a_neg, bb, bc, ssm0)
    ys = ys + b_d.astype(jnp.float32)[:, None] * xs
    ob = _rmsnorm(ys.reshape(b, l, GROUP_WIDTH) * jax.nn.silu(bz.astype(jnp.float32)), b_nrm).astype(x.dtype)

    f = lb + (1.0 - lb) * jax.nn.sigmoid(cf.astype(jnp.float32))
    oc, new_hgrn = _hgrn2_scan(heads(cq, C_HEADS), heads(1.0 - f, C_HEADS), heads(ci, C_HEADS),
                               heads(jnp.log(f), C_HEADS), hgrn0)
    oc = _rmsnorm(oc, c_nrm).reshape(b, l, GROUP_WIDTH) * jax.nn.silu(cg.astype(jnp.float32))
    oc = oc.astype(x.dtype)

    od, new_pool = _multiscale_pool(dx, pool_buf, d_pw, d_ps)

    x = x + jnp.concatenate([oa, ob, oc, od], axis=-1) @ w_out
    gate, up = jnp.split(_rmsnorm(x, n2) @ w_gu, 2, axis=-1)
    x = x + (jax.nn.silu(gate) * up) @ w_dn
    return x, (new_k, new_v, new_conv, new_ssm, new_hgrn, new_pool)


def _trunk(x, states, weights, lbs, norm_f):
    new = [[] for _ in range(6)]
    for layer in range(DEPTH):
        st_l = tuple(s[layer] for s in states)
        w_l = tuple(wt[layer] for wt in weights)
        x, ns = _layer(x, w_l, st_l, lbs[layer])
        for i in range(6):
            new[i].append(ns[i])
    return _rmsnorm(x, norm_f), tuple(jnp.stack(n, axis=0) for n in new)


def setup_inputs(seed: int = 0) -> dict:
    key = jax.random.key(seed)
    ks = jax.random.split(key, 32)
    f32 = jnp.float32
    lc = min(A_BAND_PREV, PAST_LEN)
    nrm = lambda k, shape, s: jax.random.normal(k, shape, f32) * s
    dt0 = jnp.exp(jax.random.uniform(ks[12], (DEPTH, B_HEADS), f32) * (math.log(0.1) - math.log(1e-3)) + math.log(1e-3))
    return {
        'x_prompt': nrm(ks[0], (BATCH, SEQ, D_MODEL), 1.0),
        'x_sample': nrm(ks[1], (DEC_BATCH, DEC_SEQ, D_MODEL), 1.0),
        'cache_a_k': nrm(ks[2], (DEPTH, DEC_BATCH, lc, A_HEADS, A_HEAD_DIM), 1.0),
        'cache_a_v': nrm(ks[3], (DEPTH, DEC_BATCH, lc, A_HEADS, A_HEAD_DIM), 1.0),
        'state_b_conv': nrm(ks[4], (DEPTH, DEC_BATCH, B_CONV - 1, B_CONV_DIM), 1.0),
        'state_b_ssm': nrm(ks[5], (DEPTH, DEC_BATCH, B_HEADS, B_HEAD_DIM, B_STATE), 0.5),
        'state_c_hgrn': nrm(ks[6], (DEPTH, DEC_BATCH, C_HEADS, C_KEY_DIM, C_VAL_DIM), 0.5),
        'state_d_pool': nrm(ks[7], (DEPTH, DEC_BATCH, D_BUF, GROUP_WIDTH), 1.0),
        'norm1': 1.0 + nrm(ks[8], (DEPTH, D_MODEL), 0.01),
        'w_in': nrm(ks[9], (DEPTH, D_MODEL, IN_WIDTH), D_MODEL ** -0.5),
        'a_rel_bias': nrm(ks[10], (DEPTH, 2 * REL_CLIP + 1, A_HEADS), 0.1),
        'b_conv_w': nrm(ks[11], (DEPTH, B_CONV, B_CONV_DIM), B_CONV ** -0.5),
        'b_conv_b': nrm(ks[13], (DEPTH, B_CONV_DIM), 0.01),
        'b_dt_bias': dt0 + jnp.log(-jnp.expm1(-dt0)),
        'b_a_log': jnp.log(jax.random.uniform(ks[14], (DEPTH, B_HEADS), f32, 1.0, 16.0)),
        'b_d': 1.0 + nrm(ks[15], (DEPTH, B_HEADS), 0.01),
        'b_norm': 1.0 + nrm(ks[16], (DEPTH, GROUP_WIDTH), 0.01),
        'c_lb_logits': nrm(ks[17], (DEPTH, GROUP_WIDTH), 1.0),
        'c_norm': 1.0 + nrm(ks[18], (DEPTH, C_HEADS, C_VAL_DIM), 0.01),
        'd_pool_w': nrm(ks[19], (DEPTH, 4, D_GROUP, D_GROUP), D_GROUP ** -0.5),
        'd_pool_scale': 0.5 + nrm(ks[20], (DEPTH, GROUP_WIDTH), 0.1),
        'w_out': nrm(ks[21], (DEPTH, MIX_WIDTH, D_MODEL), MIX_WIDTH ** -0.5),
        'norm2': 1.0 + nrm(ks[22], (DEPTH, D_MODEL), 0.01),
        'w_gate_up': nrm(ks[23], (DEPTH, D_MODEL, 2 * D_FF), D_MODEL ** -0.5),
        'w_down': nrm(ks[24], (DEPTH, D_FF, D_MODEL), D_FF ** -0.5),
        'norm_f': 1.0 + nrm(ks[25], (D_MODEL,), 0.01),
    }


def reference(x_prompt, x_sample, cache_a_k, cache_a_v, state_b_conv, state_b_ssm, state_c_hgrn, state_d_pool,
              norm1, w_in, a_rel_bias, b_conv_w, b_conv_b, b_dt_bias, b_a_log, b_d, b_norm, c_lb_logits, c_norm,
              d_pool_w, d_pool_scale, w_out, norm2, w_gate_up, w_down, norm_f):
    weights = (norm1, w_in, a_rel_bias, b_conv_w, b_conv_b, b_dt_bias, b_a_log, b_d, b_norm, c_norm,
               d_pool_w, d_pool_scale, w_out, norm2, w_gate_up, w_down)
    lbs = jnp.cumsum(jax.nn.softmax(c_lb_logits.astype(jnp.float32), axis=0), axis=0)
    lbs = lbs - lbs[:1]
    bp = x_prompt.shape[0]
    dtp = x_prompt.dtype
    prompt_states = (
        jnp.zeros((DEPTH, bp, 0, A_HEADS, A_HEAD_DIM), dtp),
        jnp.zeros((DEPTH, bp, 0, A_HEADS, A_HEAD_DIM), dtp),
        jnp.zeros((DEPTH, bp, B_CONV - 1, B_CONV_DIM), dtp),
        jnp.zeros((DEPTH, bp, B_HEADS, B_HEAD_DIM, B_STATE), dtp),
        jnp.zeros((DEPTH, bp, C_HEADS, C_KEY_DIM, C_VAL_DIM), dtp),
        jnp.zeros((DEPTH, bp, D_BUF, GROUP_WIDTH), dtp),
    )
    y_prompt, (pk, pv, pconv, pssm, phgrn, ppool) = _trunk(x_prompt, prompt_states, weights, lbs, norm_f)
    sample_states = (cache_a_k, cache_a_v, state_b_conv, state_b_ssm, state_c_hgrn, state_d_pool)
    y_sample, (sk, sv, sconv, sssm, shgrn, spool) = _trunk(x_sample, sample_states, weights, lbs, norm_f)
    return (y_prompt, y_sample, pk, pv, pconv, pssm, phgrn, ppool, sk, sv, sconv, sssm, shgrn, spool)
```

```cpp
#include <hip/hip_runtime.h>
#include <cstdio>
#include <cstdint>
namespace pg8 {
#define PG8_LAS __attribute__((address_space(3)))
typedef unsigned short bf16_t;
typedef short bf16x8 __attribute__((ext_vector_type(8)));
typedef float f32x4 __attribute__((ext_vector_type(4)));
typedef unsigned u32x4 __attribute__((ext_vector_type(4)));
constexpr int BM = 256, BK = 64, HALF = 128, HTB = HALF * BK * 2  , STAGE_BYTES = 8 * HTB, NXCD = 8, WGM = 8;

__host__ __device__ __forceinline__ int lds_byte(int r, int c) { const int st = (r >> 4) * 2 + (c >> 5), rr = r & 15, cc = c & 31, ob = rr * 64 + cc * 2; return st * 1024 + (ob ^ (((ob >> 9) & 1) << 5)); }
__host__ __device__ __forceinline__ void stage_rc(int b, int& R, int& C) { const int st = b / 1024, sb = b % 1024, swz = sb ^ (((sb >> 9) & 1) << 5); R = (st >> 1) * 16 + swz / 64; C = (st & 1) * 32 + (swz % 64) / 2; }
__host__ __device__ __forceinline__ int perm32(int rho) { const int n = rho >> 4, i = rho & 15; return 8 * (i >> 2) + 4 * n + (i & 3); }

struct Unit { int pm, pn; };
struct Gemm { const bf16_t* A; const bf16_t* Bt; int M, N, K; };

struct StaticOrder {
    int nM, nN, nwg, G, c;
    __host__ __device__ void init(int M, int N, int G_, int c_) { nM = M / BM; nN = N / BM; nwg = nM * nN; G = G_; c = c_; }
    __host__ __device__ bool next(int i, Unit& u) const {
        const long L = (long)i * G + c; if (L >= nwg) return false;
        int wgid = (int)L; { const int q = nwg / NXCD, r = nwg % NXCD, xcd = wgid % NXCD, off = wgid / NXCD; wgid = (xcd < r ? xcd * (q + 1) : r * (q + 1) + (xcd - r) * q) + off; }
        const int nig = WGM * nN, gid = wgid / nig, fm = gid * WGM, gsz = (nM - fm) < WGM ? (nM - fm) : WGM;
        u.pm = fm + ((wgid % nig) % gsz); u.pn = (wgid % nig) / gsz; return true;
    }
    __device__ __forceinline__ void a_ready(const Unit&) const {}
    __device__ __forceinline__ void done(const Unit&) const {}
};

__device__ __forceinline__ unsigned cvt_pk_bf16(float lo, float hi) { unsigned r; asm volatile("v_cvt_pk_bf16_f32 %0, %1, %2" : "=v"(r) : "v"(lo), "v"(hi)); return r; }
__device__ __forceinline__ float silu_f(float x) { return x * __builtin_amdgcn_rcpf(1.0f + __expf(-x)); }
struct EpiBf16 {
    static constexpr bool PERM = true, AFTER_DRAIN = false;
    bf16_t* O; int ldc;
    __device__ __forceinline__ void operator()(const f32x4 (&acc)[2][2][4][2], const Unit& u, int wr, int wc, int fr, int fq) const {
        const int row0 = u.pm * BM + wr * 64 + fr, col0 = u.pn * BM + wc * 32 + 8 * fq;
#pragma unroll
        for (int ai = 0; ai < 2; ++ai)
#pragma unroll
            for (int m = 0; m < 4; ++m) { bf16_t* rowp = O + (size_t)(row0 + ai * HALF + m * 16) * ldc + col0;
#pragma unroll
                for (int bj = 0; bj < 2; ++bj) { const f32x4 v0 = acc[ai][bj][m][0], v1 = acc[ai][bj][m][1];
                    u32x4 w; w.x = cvt_pk_bf16(v0[0], v0[1]); w.y = cvt_pk_bf16(v0[2], v0[3]); w.z = cvt_pk_bf16(v1[0], v1[1]); w.w = cvt_pk_bf16(v1[2], v1[3]);
                    *(u32x4*)(rowp + bj * HALF) = w; } }
    }
};
struct EpiRes {
    static constexpr bool PERM = false, AFTER_DRAIN = false;
    const float* rlo; const float* rhi; float* C;
    __device__ __forceinline__ void operator()(const f32x4 (&acc)[2][2][4][2], const Unit& u, int wr, int wc, int fr, int fq) const {
        const int row0 = u.pm * BM + wr * 64 + fr, col0 = u.pn * BM + wc * 32 + 4 * fq;
        const float* rb = (u.pm < 64) ? rlo : rhi;
#pragma unroll
        for (int ai = 0; ai < 2; ++ai)
#pragma unroll
            for (int m = 0; m < 4; ++m) { const size_t off = (size_t)(row0 + ai * HALF + m * 16) * 1024 + col0;
#pragma unroll
                for (int bj = 0; bj < 2; ++bj)
#pragma unroll
                    for (int n = 0; n < 2; ++n) { const f32x4 r = *(const f32x4*)(rb + off + bj * HALF + n * 16); *(f32x4*)(C + off + bj * HALF + n * 16) = r + acc[ai][bj][m][n]; }
                asm volatile("" ::: "memory"); }
    }
};
struct EpiSwiGLU {
    static constexpr bool PERM = true, AFTER_DRAIN = false;
    bf16_t* O; int ldc;
    __device__ __forceinline__ void operator()(const f32x4 (&acc)[2][2][4][2], const Unit& u, int wr, int wc, int fr, int fq) const {
        const int row0 = u.pm * BM + wr * 64 + fr, col0 = u.pn * HALF + wc * 32 + 8 * fq;
#pragma unroll
        for (int ai = 0; ai < 2; ++ai)
#pragma unroll
            for (int m = 0; m < 4; ++m) { bf16_t* rowp = O + (size_t)(row0 + ai * HALF + m * 16) * ldc + col0;
                const f32x4 g0 = acc[ai][0][m][0], g1 = acc[ai][0][m][1], u0 = acc[ai][1][m][0], u1 = acc[ai][1][m][1];
                u32x4 w; w.x = cvt_pk_bf16(silu_f(g0[0]) * u0[0], silu_f(g0[1]) * u0[1]); w.y = cvt_pk_bf16(silu_f(g0[2]) * u0[2], silu_f(g0[3]) * u0[3]);
                w.z = cvt_pk_bf16(silu_f(g1[0]) * u1[0], silu_f(g1[1]) * u1[1]); w.w = cvt_pk_bf16(silu_f(g1[2]) * u1[2], silu_f(g1[3]) * u1[3]);
                *(u32x4*)rowp = w; }
    }
};
template <class Epi, class Sched, bool ALIGN_EPI = false, bool SP2 = false>
__device__ __forceinline__ void gemm_phase(PG8_LAS unsigned char* lds, const Gemm g, const Sched& S, const Epi& E) {
    int tid0 = threadIdx.x; asm volatile("" : "+v"(tid0));
    const int tid = tid0, wid = __builtin_amdgcn_readfirstlane(tid >> 6), lane = tid & 63, wr = wid >> 2, wc = wid & 3, fr = lane & 15, fq = lane >> 4;
    const int K = g.K, nt = K / BK;
    unsigned voffA[2], voffB[2];
#pragma unroll
    for (int i = 0; i < 2; ++i) { int R, C; stage_rc(tid * 16 + i * 8192, R, C); const int Rb = Epi::PERM ? ((R & ~31) + perm32(R & 31)) : R;
        voffA[i] = (unsigned)(R * K + C) * 2u; voffB[i] = (unsigned)(Rb * K + C) * 2u; }
    const size_t kstep = (size_t)(BK * 2);
    const size_t hstep = (size_t)HALF * K * 2;
    const size_t tstep = 2 * hstep;
    const unsigned ldsw = (unsigned)wid * 1024u;
    const int aoff = lds_byte(wr * 64 + fr, fq * 8), boff = lds_byte(wc * 32 + fr, fq * 8);
#define PG8_SA(b, h) (((b) * 2 + (h)) * HTB)
#define PG8_SB(b, h) ((4 + (b) * 2 + (h)) * HTB)
#define PG8_STAGE(bufoff, gbase, voff) do { _Pragma("unroll") for (int _i = 0; _i < 2; ++_i) \
        __builtin_amdgcn_global_load_lds((const unsigned*)((const char*)(gbase) + (voff)[_i]), (PG8_LAS unsigned*)(lds + (bufoff) + ldsw + _i * 8192), 16, 0, 0); } while (0)
#define PG8_LDA(dst, b, h) do { _Pragma("unroll") for (int m = 0; m < 4; ++m) _Pragma("unroll") for (int k = 0; k < 2; ++k) dst[m][k] = *(const PG8_LAS bf16x8*)(lds + PG8_SA(b, h) + aoff + m * 2048 + k * 1024); } while (0)
#define PG8_LDB(dst, b, h) do { _Pragma("unroll") for (int n = 0; n < 2; ++n) _Pragma("unroll") for (int k = 0; k < 2; ++k) dst[n][k] = *(const PG8_LAS bf16x8*)(lds + PG8_SB(b, h) + boff + n * 2048 + k * 1024); } while (0)
#define PG8_MMA(ai, bj, At, Bt) do { __builtin_amdgcn_s_setprio(1); _Pragma("unroll") for (int m = 0; m < 4; ++m) _Pragma("unroll") for (int n = 0; n < 2; ++n) _Pragma("unroll") for (int k = 0; k < 2; ++k) \
        acc[ai][bj][m][n] = __builtin_amdgcn_mfma_f32_16x16x32_bf16(Bt[n][k], At[m][k], acc[ai][bj][m][n], 0, 0, 0); __builtin_amdgcn_s_setprio(0); } while (0)
#define PG8_WAIT_V(n) asm volatile("s_waitcnt vmcnt(" #n ")" ::: "memory")
#define PG8_WAIT_L(n) asm volatile("s_waitcnt lgkmcnt(" #n ")" ::: "memory")
#define PG8_BAR __builtin_amdgcn_s_barrier()
#define PG8_SCHED __builtin_amdgcn_sched_barrier(0)
    Unit cur, nxt; int ui = 0;
    if (!S.next(0, cur)) return;
    f32x4 acc[2][2][4][2];
#pragma unroll
    for (int a = 0; a < 2; ++a)
#pragma unroll
        for (int b = 0; b < 2; ++b)
#pragma unroll
            for (int m = 0; m < 4; ++m)
#pragma unroll
                for (int n = 0; n < 2; ++n) acc[a][b][m][n] = (f32x4){0.f, 0.f, 0.f, 0.f};
    bf16x8 At[4][2], B0[2][2], B1[2][2];
    const char* cA = (const char*)g.A + (size_t)cur.pm * tstep; const char* cB = (const char*)g.Bt + (size_t)cur.pn * tstep;
    S.a_ready(cur);
    if constexpr (SP2) {
        PG8_STAGE(PG8_SB(0, 0), cB, voffB); PG8_STAGE(PG8_SB(0, 1), cB + hstep, voffB); PG8_STAGE(PG8_SA(0, 0), cA, voffA); PG8_STAGE(PG8_SA(0, 1), cA + hstep, voffA);
        if (wr == 1) PG8_BAR;
        PG8_WAIT_V(2); PG8_BAR;
        PG8_STAGE(PG8_SB(1, 0), cB + kstep, voffB); PG8_STAGE(PG8_SA(1, 0), cA + kstep, voffA); PG8_STAGE(PG8_SB(1, 1), cB + hstep + kstep, voffB);
        PG8_WAIT_V(6); PG8_BAR;
    } else {
        PG8_STAGE(PG8_SB(0, 0), cB, voffB); PG8_STAGE(PG8_SA(0, 0), cA, voffA); PG8_STAGE(PG8_SB(0, 1), cB + hstep, voffB); PG8_STAGE(PG8_SA(0, 1), cA + hstep, voffA);
        if (wr == 1) PG8_BAR;
        PG8_WAIT_V(4); PG8_BAR;
        PG8_STAGE(PG8_SB(1, 0), cB + kstep, voffB); PG8_STAGE(PG8_SA(1, 0), cA + kstep, voffA); PG8_STAGE(PG8_SB(1, 1), cB + hstep + kstep, voffB);
        PG8_WAIT_V(6); PG8_BAR;
    }
    for (;;) {
        const bool has_next = S.next(ui + 1, nxt);
        const char* nA = has_next ? (const char*)g.A + (size_t)nxt.pm * tstep : cA; const char* nB = has_next ? (const char*)g.Bt + (size_t)nxt.pn * tstep : cB;
        for (int t = 0; t < nt; t += 2) {
            const bool last = (t == nt - 2);
            const char* a1 = cA + (size_t)(t + 1) * kstep;
            const char* a2 = last ? nA : cA + (size_t)(t + 2) * kstep; const char* b2 = last ? nB : cB + (size_t)(t + 2) * kstep;
            const char* a3 = a2 + kstep; const char* b3 = b2 + kstep;
            if (last && has_next) S.a_ready(nxt);
            if constexpr (SP2) {
            PG8_LDB(B0, 0, 0); PG8_LDB(B1, 0, 1); PG8_SCHED; PG8_LDA(At, 0, 0); PG8_STAGE(PG8_SA(1, 1), a1 + hstep, voffA);
            PG8_WAIT_V(8); PG8_WAIT_L(0); PG8_BAR; PG8_MMA(0, 0, At, B0); PG8_MMA(0, 1, At, B1); PG8_BAR; PG8_SCHED;
            PG8_LDA(At, 0, 1); PG8_STAGE(PG8_SB(0, 0), b2, voffB); PG8_STAGE(PG8_SB(0, 1), b2 + hstep, voffB); PG8_STAGE(PG8_SA(0, 0), a2, voffA);
            PG8_WAIT_V(8); PG8_WAIT_L(0); PG8_BAR; PG8_MMA(1, 0, At, B0); PG8_MMA(1, 1, At, B1); PG8_BAR; PG8_SCHED;
            PG8_LDB(B0, 1, 0); PG8_LDB(B1, 1, 1); PG8_SCHED; PG8_LDA(At, 1, 0); PG8_STAGE(PG8_SA(0, 1), a2 + hstep, voffA);
            PG8_WAIT_V(8); PG8_WAIT_L(0); PG8_BAR; PG8_MMA(0, 0, At, B0); PG8_MMA(0, 1, At, B1); PG8_BAR; PG8_SCHED;
            PG8_LDA(At, 1, 1); PG8_STAGE(PG8_SB(1, 0), b3, voffB); PG8_STAGE(PG8_SB(1, 1), b3 + hstep, voffB); PG8_STAGE(PG8_SA(1, 0), a3, voffA);
            PG8_WAIT_V(8); PG8_WAIT_L(0); PG8_BAR; PG8_MMA(1, 0, At, B0); PG8_MMA(1, 1, At, B1); PG8_BAR; PG8_SCHED;
            } else {
            PG8_LDB(B0, 0, 0); PG8_SCHED; PG8_LDA(At, 0, 0); PG8_STAGE(PG8_SA(1, 1), a1 + hstep, voffA);
            PG8_WAIT_L(8); PG8_BAR; PG8_WAIT_L(0); PG8_MMA(0, 0, At, B0); PG8_BAR; PG8_SCHED;
            PG8_LDB(B1, 0, 1); PG8_STAGE(PG8_SB(0, 0), b2, voffB);
            PG8_BAR; PG8_WAIT_L(0); PG8_MMA(0, 1, At, B1); PG8_BAR;
            PG8_LDA(At, 0, 1); PG8_STAGE(PG8_SA(0, 0), a2, voffA);
            PG8_BAR; PG8_WAIT_L(0); PG8_MMA(1, 0, At, B0); PG8_BAR; PG8_SCHED;
            PG8_STAGE(PG8_SB(0, 1), b2 + hstep, voffB);
            PG8_WAIT_V(6); PG8_BAR; PG8_MMA(1, 1, At, B1); PG8_BAR;
            PG8_LDB(B0, 1, 0); PG8_SCHED; PG8_LDA(At, 1, 0); PG8_STAGE(PG8_SA(0, 1), a2 + hstep, voffA);
            PG8_WAIT_L(8); PG8_BAR; PG8_WAIT_L(0); PG8_MMA(0, 0, At, B0); PG8_BAR; PG8_SCHED;
            PG8_LDB(B1, 1, 1); PG8_STAGE(PG8_SB(1, 0), b3, voffB);
            PG8_BAR; PG8_WAIT_L(0); PG8_MMA(0, 1, At, B1); PG8_BAR;
            PG8_LDA(At, 1, 1); PG8_STAGE(PG8_SA(1, 0), a3, voffA);
            PG8_BAR; PG8_WAIT_L(0); PG8_MMA(1, 0, At, B0); PG8_BAR; PG8_SCHED;
            PG8_STAGE(PG8_SB(1, 1), b3 + hstep, voffB);
            PG8_WAIT_V(6); PG8_BAR; PG8_MMA(1, 1, At, B1); PG8_BAR;
            }
        }
        if constexpr (ALIGN_EPI) { if (wr == 0) PG8_BAR; }
        if constexpr (!Epi::AFTER_DRAIN) { E(acc, cur, wr, wc, fr, fq); S.done(cur); }
        if (!has_next) break;
#pragma unroll
        for (int a = 0; a < 2; ++a)
#pragma unroll
            for (int b = 0; b < 2; ++b)
#pragma unroll
                for (int m = 0; m < 4; ++m)
#pragma unroll
                    for (int n = 0; n < 2; ++n) acc[a][b][m][n] = (f32x4){0.f, 0.f, 0.f, 0.f};
        cur = nxt; cA = nA; cB = nB; ++ui;
        if constexpr (ALIGN_EPI) { if (wr == 1) PG8_BAR; }
    }
    PG8_WAIT_V(0);
    if constexpr (!ALIGN_EPI) { if (wr == 0) PG8_BAR; }
    PG8_BAR;
    if constexpr (Epi::AFTER_DRAIN) { E.fused(acc, cur, wr, wc, fr, fq, lds, wid, lane); S.done(cur); }
#undef PG8_SA
#undef PG8_SB
#undef PG8_STAGE
#undef PG8_LDA
#undef PG8_LDB
#undef PG8_MMA
#undef PG8_WAIT_V
#undef PG8_WAIT_L
#undef PG8_BAR
#undef PG8_SCHED
}
}
#define GAS __attribute__((address_space(1)))
#define LAS __attribute__((address_space(3)))
typedef unsigned short bf16;
typedef unsigned v4u __attribute__((ext_vector_type(4)));
typedef float f32x4 __attribute__((ext_vector_type(4)));
typedef short bf16x8 __attribute__((ext_vector_type(8)));
typedef GAS unsigned gu32;
typedef GAS unsigned long long gu64;
#define RLX_AGENT __ATOMIC_RELAXED, __HIP_MEMORY_SCOPE_AGENT
#define LDS_WAIT() asm volatile("s_waitcnt lgkmcnt(0)" ::: "memory")
#define VM_WAIT() asm volatile("s_waitcnt vmcnt(0)" ::: "memory")
__device__ __forceinline__ unsigned long long rt() { return __builtin_amdgcn_s_memrealtime(); }
__device__ __forceinline__ unsigned f2bf(float f) { unsigned u = __builtin_bit_cast(unsigned, f); return (u + 0x7fffu + ((u >> 16) & 1u)) >> 16; }
__device__ __forceinline__ unsigned pk2(float lo, float hi) { return f2bf(lo) | (f2bf(hi) << 16); }
#define XB_TMO      128
#define XB_XCNT(j)  (256  + 64 * (j))
#define XB_XSUB(j)  (1280 + 64 * (j))
#define XB_XGEN(j)  (2304 + 64 * (j))
#define XB_TOP      3328
#define XB_TOPGEN   3392
#define XCD_BAR_WORDS 3456
#define XB_SPIN_CAP (1u << 18)

__device__ __forceinline__ unsigned xb_ld(unsigned* p)              { return __hip_atomic_load(p, __ATOMIC_RELAXED, __HIP_MEMORY_SCOPE_AGENT); }
__device__ __forceinline__ unsigned xb_add(unsigned* p, unsigned v) { return __hip_atomic_fetch_add(p, v, __ATOMIC_RELAXED, __HIP_MEMORY_SCOPE_AGENT); }
__device__ __forceinline__ unsigned xb_xcc_id() { return (unsigned)__builtin_amdgcn_s_getreg((3 << 11) | 20) & 0xFu; }
#define XB_SPIN(cond, bar) do { unsigned _sp = 0; while (cond) { __builtin_amdgcn_s_sleep(1); \
    if ((++_sp & 255u) == 0u) { if (xb_ld(&(bar)[XB_TMO])) break; if (_sp > XB_SPIN_CAP) { atomicAdd(&(bar)[XB_TMO], 1u); break; } } } } while (0)

struct XcdBarrier {
    unsigned* bar; unsigned x;
    volatile LAS unsigned* st;
};

__device__ __forceinline__ XcdBarrier xcd_barrier_post(unsigned* bar, volatile LAS unsigned* st) {
    XcdBarrier b; b.bar = bar; b.x = xb_xcc_id(); b.st = st;
    if (threadIdx.x == 0) (void)xb_add(&bar[XB_XCNT(b.x)], 1u);
    return b;
}
__device__ __forceinline__ void xcd_barrier_complete(unsigned* bar, unsigned x, unsigned& nloc, unsigned& nx) {
    const unsigned G = gridDim.x * gridDim.y * gridDim.z;
    unsigned sum, cnt, mine, sp = 0u;
    for (;;) {
        sum = 0u; cnt = 0u; mine = 0u;
#pragma unroll
        for (unsigned j = 0; j < 16; ++j) { const unsigned c = xb_ld(&bar[XB_XCNT(j)]); sum += c; cnt += (c > 0u) ? 1u : 0u; mine = (j == x) ? c : mine; }
        if (sum == G) break;
        __builtin_amdgcn_s_sleep(1);
        if ((++sp & 255u) == 0u) { if (xb_ld(&bar[XB_TMO])) break; if (sp > XB_SPIN_CAP) { atomicAdd(&bar[XB_TMO], 1u); break; } }
    }
    nloc = mine > 0u ? mine : 1u; nx = cnt > 0u ? cnt : 1u;
}

__device__ __forceinline__ void xcd_barrier(const XcdBarrier& b) {
    asm volatile("s_waitcnt vmcnt(0)" ::: "memory");
    __syncthreads();
    if (threadIdx.x == 0) {
        unsigned* bar = b.bar;
        __builtin_amdgcn_s_waitcnt(0);
        unsigned nloc = b.st[0], nx = b.st[1];
        if (nloc == 0u) { xcd_barrier_complete(bar, b.x, nloc, nx); b.st[0] = nloc; b.st[1] = nx; }
        const unsigned old = xb_add(&bar[XB_XSUB(b.x)], 1u);
        const unsigned gen = old / nloc;
        if (old + 1u == (gen + 1u) * nloc) {
            __builtin_amdgcn_fence(__ATOMIC_RELEASE, "agent");
            asm volatile("s_waitcnt vmcnt(0)" ::: "memory");
            const unsigned og = xb_add(&bar[XB_TOP], 1u);
            const unsigned tg = og / nx;
            if (og + 1u == (tg + 1u) * nx) xb_add(&bar[XB_TOPGEN], 1u);
            else XB_SPIN(xb_ld(&bar[XB_TOPGEN]) == tg, bar);
            __builtin_amdgcn_fence(__ATOMIC_ACQUIRE, "agent");
            xb_add(&bar[XB_XGEN(b.x)], 1u);
            asm volatile("s_waitcnt vmcnt(0)" ::: "memory");
        } else {
            XB_SPIN(xb_ld(&bar[XB_XGEN(b.x)]) == gen, bar);
            __builtin_amdgcn_fence(__ATOMIC_ACQUIRE, "agent");
            asm volatile("s_waitcnt vmcnt(0)" ::: "memory");
        }
    }
    __syncthreads();
}
constexpr int NWAVES = 8, NTHR = 512;
constexpr int D = 1024, MP = 16384, NSB = 16, SSEQ = 16, MS = NSB * SSEQ, M = MP + MS;
constexpr int NIN = 3076, NPROJ = 3072, DFF = 2816, NGU = 2 * DFF;
constexpr int NCHP = 256, NCH = NCHP + NSB;
constexpr int PC_Q = 0, PC_K = 256, PC_V = 512, PC_Z = 768, PC_X = 1024, PC_B = 1280, PC_C = 1536, PC_CQ = 1792, PC_CF = 2048, PC_CI = 2304, PC_CG = 2560, PC_DX = 2816;
constexpr float EPS = 1e-6f;
enum { I_XP = 0, I_XS, I_CK, I_CV, I_SCONV, I_SSSM, I_SHGRN, I_SPOOL, I_N1, I_WIN, I_AREL, I_CW, I_CB, I_DTB, I_ALOG, I_BD, I_BNRM, I_LB, I_CNRM, I_PW, I_PS, I_WOUT, I_N2, I_WGU, I_WDN, I_NF, N_IN };
constexpr size_t O_YP = 0, O_YS = O_YP + (size_t)MP * D, O_PK = O_YS + (size_t)MS * D, O_PV = O_PK + 2 * 512 * 256, O_PCONV = O_PV + 2 * 512 * 256, O_PSSM = O_PCONV + 2 * 3 * 768,
                 O_PHGRN = O_PSSM + 2 * 4 * 64 * 128, O_PPOOL = O_PHGRN + 2 * 4 * 64 * 64, O_SK = O_PPOOL + 2 * 15 * 256, O_SV = O_SK + (size_t)2 * 16 * 512 * 256,
                 O_SCONV = O_SV + (size_t)2 * 16 * 512 * 256, O_SSSM = O_SCONV + 2 * 16 * 3 * 768, O_SHGRN = O_SSSM + 2 * 16 * 4 * 64 * 128, O_SPOOL = O_SHGRN + 2 * 16 * 4 * 64 * 64,
                 O_END = O_SPOOL + 2 * 16 * 15 * 256;
constexpr size_t MiB = 1u << 20;
constexpr size_t WS_CTL = 0, CTL_ZERO_BYTES = 64 * 1024;
constexpr size_t WL_IN = 0, WL_OUT = 6 * MiB, WL_GU = 8 * MiB, WL_DN = 19 * MiB, WL_STRIDE = 24 * MiB + MiB / 2;
constexpr size_t WS_W = 1 * MiB;
constexpr size_t WS_XN = 50 * MiB;
constexpr size_t WS_PROJ = 83 * MiB;
constexpr size_t WS_STB = 181 * MiB;
constexpr size_t WS_STC = 215 * MiB;
constexpr size_t WS_DT = 232 * MiB;
constexpr size_t WS_DECB = 233 * MiB;
constexpr size_t WS_DECC = 233 * MiB + 64 * 1024;
constexpr size_t WS_END = 234 * MiB;
static_assert(WS_XN + (size_t)M * D * 2 <= WS_PROJ && WS_PROJ + (size_t)M * NPROJ * 2 <= WS_STB && WS_STB + (size_t)NCH * 4 * 64 * 128 * 4 <= WS_STC && WS_STC + (size_t)NCH * 4 * 64 * 64 * 4 <= WS_DT, "ws map");
static_assert(WL_DN + (size_t)D * DFF * 2 <= WL_STRIDE && WS_W + 2 * WL_STRIDE <= WS_XN, "weight map");
constexpr int CW_BAR = 1024;
constexpr int LDS_BYTES = 163840;
constexpr int MISC_OFF = LDS_BYTES - 256;
constexpr int RING_OFF = 0;
typedef LAS float lf32;
typedef float f32x2 __attribute__((ext_vector_type(2)));
struct Args { const float* in[N_IN]; float* out; unsigned char* ws; };
struct Frame {
    LAS unsigned char* lds;
    int tid, lane, wave, G, bid;
    float* out; unsigned char* ws;
};
__device__ __forceinline__ const float* inp(int i) { asm volatile("" : "+s"(i)); return ((const float* const __attribute__((address_space(4)))*)__builtin_amdgcn_kernarg_segment_ptr())[i]; }
#define ITEM_IDS() int tid_ = F.tid; asm volatile("" : "+v"(tid_)); int wave_ = F.wave; asm volatile("" : "+s"(wave_)); const int lane_ = tid_ & 63; (void)lane_; (void)wave_
#define F_XN   ((bf16*)(F.ws + WS_XN))
#define F_PROJ ((bf16*)(F.ws + WS_PROJ))
#define F_ACT  ((bf16*)(F.ws + WS_PROJ))
#define F_STB  ((float*)(F.ws + WS_STB))
#define F_STC  ((float*)(F.ws + WS_STC))
#define F_DT   ((float*)(F.ws + WS_DT))
#define F_DECB ((float*)(F.ws + WS_DECB))
#define F_DECC ((float*)(F.ws + WS_DECC))
#define F_X    (F.out)
__device__ __forceinline__ float bf_lo(unsigned w) { return __builtin_bit_cast(float, w << 16); }
__device__ __forceinline__ float bf_hi(unsigned w) { return __builtin_bit_cast(float, w & 0xffff0000u); }
__device__ __forceinline__ float bf1(bf16 b) { return __builtin_bit_cast(float, (unsigned)b << 16); }
__device__ __forceinline__ void unpack8(const v4u w, float (&v)[8]) { v[0] = bf_lo(w.x); v[1] = bf_hi(w.x); v[2] = bf_lo(w.y); v[3] = bf_hi(w.y); v[4] = bf_lo(w.z); v[5] = bf_hi(w.z); v[6] = bf_lo(w.w); v[7] = bf_hi(w.w); }
__device__ __forceinline__ float wave_sum(float v) {
#pragma unroll
    for (int o = 1; o < 64; o <<= 1) v += __shfl_xor(v, o);
    return v;
}
__device__ __forceinline__ float sum16(float v) {
#pragma unroll
    for (int o = 1; o < 16; o <<= 1) v += __shfl_xor(v, o);
    return v;
}
__device__ __forceinline__ float max16(float v) {
#pragma unroll
    for (int o = 1; o < 16; o <<= 1) v = fmaxf(v, __shfl_xor(v, o));
    return v;
}
__device__ __forceinline__ float sigmoid_f(float x) { return 1.0f / (1.0f + __expf(-x)); }
__device__ __forceinline__ float silu_g(float x) { return x / (1.0f + __expf(-x)); }
__device__ __forceinline__ float softplus_f(float x) { return x > 20.f ? x : log1pf(__expf(x)); }
__device__ __forceinline__ f32x4 mfma4(float a, float b, f32x4 c) { return __builtin_amdgcn_mfma_f32_16x16x4f32(a, b, c, 0, 0, 0); }

struct Chunk { int ci, row0, nrows, b; };
__device__ __forceinline__ Chunk chunk_of(int ci) { Chunk c; c.ci = ci; if (ci < NCHP) { c.row0 = 64 * ci; c.nrows = 64; c.b = -1; } else { c.b = ci - NCHP; c.row0 = MP + SSEQ * c.b; c.nrows = SSEQ; } return c; }

__device__ __forceinline__ void tr_item(const float* W, int ldw, int K, bf16* WT, int k0, int nd0, int ns0, float scale, lf32* scr, int lane) {
#pragma unroll 8
    for (int i = 0; i < 32; ++i) { const int kk = 2 * i + (lane >> 5); scr[kk * 33 + (lane & 31)] = W[(size_t)(k0 + kk) * ldw + ns0 + (lane & 31)]; }
    LDS_WAIT(); asm volatile("" ::: "memory");
    const int c = lane & 7;
#pragma unroll
    for (int j = 0; j < 4; ++j) { const int n = (lane >> 3) + 8 * j; const lf32* s = scr + (8 * c) * 33 + n;
        v4u o; o.x = pk2(s[0 * 33] * scale, s[1 * 33] * scale); o.y = pk2(s[2 * 33] * scale, s[3 * 33] * scale); o.z = pk2(s[4 * 33] * scale, s[5 * 33] * scale); o.w = pk2(s[6 * 33] * scale, s[7 * 33] * scale);
        *(GAS v4u*)(WT + (size_t)(nd0 + n) * K + k0 + 8 * c) = o; }
    LDS_WAIT(); asm volatile("" ::: "memory");
}
__device__ __forceinline__ void p0_weights(Frame& F) {
    ITEM_IDS();
    lf32* scr = (lf32*)(F.lds + wave_ * 16384);
    const int gw = F.bid * NWAVES + wave_, NGW = F.G * NWAVES;
    constexpr int I_IN = 16 * 96, I_OUT = 16 * 32, I_GU = 16 * 176, I_DN = 44 * 32, I_L = I_IN + I_OUT + I_GU + I_DN;
    for (int it = gw; it < 2 * I_L; it += NGW) {
        const int l = it / I_L; int r = it % I_L;
        unsigned char* wl = F.ws + WS_W + (size_t)l * WL_STRIDE;
        if (r < I_IN) { const int kb = r / 96, nb = r % 96, nd0 = 32 * nb; tr_item(inp(I_WIN) + (size_t)l * D * NIN, NIN, D, (bf16*)(wl + WL_IN), 64 * kb, nd0, nd0 < 1792 ? nd0 : nd0 + 4, nd0 < 256 ? 0.125f : 1.0f, scr, lane_); continue; } r -= I_IN;
        if (r < I_OUT) { const int kb = r / 32, nb = r % 32; tr_item(inp(I_WOUT) + (size_t)l * D * D, D, D, (bf16*)(wl + WL_OUT), 64 * kb, 32 * nb, 32 * nb, 1.0f, scr, lane_); continue; } r -= I_OUT;
        if (r < I_GU) { const int kb = r / 176, nb = r % 176, nd0 = 32 * nb, pn = nd0 >> 8, bj = (nd0 >> 7) & 1, c = nd0 & 127; tr_item(inp(I_WGU) + (size_t)l * D * NGU, NGU, D, (bf16*)(wl + WL_GU), 64 * kb, nd0, bj * DFF + 128 * pn + c, 1.0f, scr, lane_); continue; } r -= I_GU;
        { const int kb = r / 32, nb = r % 32; tr_item(inp(I_WDN) + (size_t)l * DFF * D, D, DFF, (bf16*)(wl + WL_DN), 64 * kb, 32 * nb, 32 * nb, 1.0f, scr, lane_); }
    }
}
template <bool WITH_DT, bool FINAL>
__device__ __forceinline__ void norm_rows(Frame& F, const float* xlo, const float* xhi, const float* w, const float* wdt  ) {
    ITEM_IDS();
    lf32* wl = (lf32*)F.lds;
    if (WITH_DT) { for (int k = tid_; k < D; k += NTHR) { const f32x4 v = *(const f32x4*)(wdt + (size_t)k * NIN + 1792); *(LAS f32x4*)(wl + 4 * k) = v; } __syncthreads(); }
    const int gw = F.bid * NWAVES + wave_, NGW = F.G * NWAVES;
    f32x4 wv[4];
#pragma unroll
    for (int j = 0; j < 4; ++j) wv[j] = *(const f32x4*)(w + 256 * j + 4 * lane_);
    for (int m = gw; m < M; m += NGW) {
        const float* xr = (m < MP ? xlo : xhi) + (size_t)m * D;
        f32x4 v[4]; float s = 0.f;
#pragma unroll
        for (int j = 0; j < 4; ++j) { v[j] = *(const f32x4*)(xr + 256 * j + 4 * lane_); s += (v[j].x * v[j].x + v[j].y * v[j].y) + (v[j].z * v[j].z + v[j].w * v[j].w); }
        const float rstd = 1.0f / sqrtf(wave_sum(s) * (1.0f / D) + EPS);
#pragma unroll
        for (int j = 0; j < 4; ++j) v[j] = v[j] * rstd * wv[j];
        if (FINAL) {
#pragma unroll
            for (int j = 0; j < 4; ++j) *(f32x4*)(F.out + (size_t)m * D + 256 * j + 4 * lane_) = v[j];
        } else {
            GAS unsigned long long* o8 = (GAS unsigned long long*)(F_XN + (size_t)m * D) + lane_;
#pragma unroll
            for (int j = 0; j < 4; ++j) o8[64 * j] = (unsigned long long)pk2(v[j].x, v[j].y) | ((unsigned long long)pk2(v[j].z, v[j].w) << 32);
        }
        if (WITH_DT) {
            f32x4 a = {0.f, 0.f, 0.f, 0.f};
#pragma unroll
            for (int j = 0; j < 4; ++j) { const LAS f32x4* wp = (const LAS f32x4*)(wl + 4 * (256 * j + 4 * lane_));
                a += wp[0] * v[j].x; a += wp[1] * v[j].y; a += wp[2] * v[j].z; a += wp[3] * v[j].w; }
            a.x = wave_sum(a.x); a.y = wave_sum(a.y); a.z = wave_sum(a.z); a.w = wave_sum(a.w);
            if (lane_ == 0) *(f32x4*)(F_DT + (size_t)m * 4) = a;
        }
    }
    if (WITH_DT) __syncthreads();
}
__device__ __forceinline__ void load_xbc8(const Frame& F, const Chunk& c, const float* sconv, int r, int col, float (&v)[8]) {
    if (r >= 0 || (c.b < 0 && c.row0 + r >= 0)) { const v4u w = *(const v4u*)(F_PROJ + (size_t)(c.row0 + r) * NPROJ + PC_X + col); unpack8(w, v); }
    else if (c.b < 0) {
#pragma unroll
        for (int i = 0; i < 8; ++i) v[i] = 0.f; }
    else { const float* s = sconv + (size_t)(3 + r) * 768 + col; const f32x4 a = *(const f32x4*)s, b2 = *(const f32x4*)(s + 4);
        v[0] = a.x; v[1] = a.y; v[2] = a.z; v[3] = a.w; v[4] = b2.x; v[5] = b2.y; v[6] = b2.z; v[7] = b2.w; }
}
__device__ __forceinline__ void conv_stage(const Frame& F, int tid_, const Chunk& c, int layer, int col0, int nch, lf32* dst, int ld) {
    const float* cw = inp(I_CW) + (size_t)layer * 4 * 768; const float* cb = inp(I_CB) + (size_t)layer * 768;
    const float* sconv = inp(I_SCONV) + (size_t)(layer * NSB + (c.b < 0 ? 0 : c.b)) * 3 * 768;
    const int ng = nch >> 3;
    for (int it = tid_; it < 64 * ng; it += NTHR) {
        const int r = it / ng, cg = it % ng, col = col0 + 8 * cg;
        float y[8];
        if (r < c.nrows) {
            float w0[8], w1[8], w2[8], w3[8], x0[8], x1[8], x2[8], x3[8];
#pragma unroll
            for (int i = 0; i < 8; ++i) { y[i] = cb[col + i]; w0[i] = cw[col + i]; w1[i] = cw[768 + col + i]; w2[i] = cw[2 * 768 + col + i]; w3[i] = cw[3 * 768 + col + i]; }
            load_xbc8(F, c, sconv, r - 3, col, x0); load_xbc8(F, c, sconv, r - 2, col, x1); load_xbc8(F, c, sconv, r - 1, col, x2); load_xbc8(F, c, sconv, r, col, x3);
#pragma unroll
            for (int i = 0; i < 8; ++i) { y[i] += w0[i] * x0[i] + w1[i] * x1[i] + w2[i] * x2[i] + w3[i] * x3[i]; y[i] = silu_g(y[i]); }
        } else {
#pragma unroll
            for (int i = 0; i < 8; ++i) y[i] = 0.f; }
#pragma unroll
        for (int i = 0; i < 8; ++i) dst[r * ld + 8 * cg + i] = y[i];
    }
}
__device__ __forceinline__ void dt_stage(const Frame& F, int tid_, const Chunk& c, int layer, lf32* acs, lf32* dtv) {
    if (tid_ < 4) { const int h = tid_; const float bias = inp(I_DTB)[layer * 4 + h], an = -__expf(inp(I_ALOG)[layer * 4 + h]); float run = 0.f;
        for (int r = 0; r < 64; ++r) { float dt = 0.f; if (r < c.nrows) { dt = softplus_f(F_DT[(size_t)(c.row0 + r) * 4 + h] + bias); run += dt * an; } acs[r * 4 + h] = run; dtv[r * 4 + h] = dt; } }
}

__device__ __forceinline__ void ssd_local_item(Frame& F, int layer, int ci, int g) {
    ITEM_IDS();
    const Chunk c = chunk_of(ci);
    lf32* U = (lf32*)F.lds; lf32* Bm = U + 64 * 144; lf32* acs = Bm + 64 * 144; lf32* dtv = acs + 256;
    conv_stage(F, tid_, c, layer, 128 * g, 128, U, 144);
    conv_stage(F, tid_, c, layer, 256 + 128 * g, 128, Bm, 144);
    dt_stage(F, tid_, c, layer, acs, dtv);
    __syncthreads();
    for (int it = tid_; it < 64 * 128; it += NTHR) { const int r = it >> 7, cc = it & 127, h = 2 * g + (cc >> 6); U[r * 144 + cc] *= dtv[r * 4 + h] * __expf(acs[63 * 4 + h] - acs[r * 4 + h]); }
    if (tid_ < 2) F_DECB[ci * 4 + 2 * g + tid_] = __expf(acs[63 * 4 + 2 * g + tid_]);
    __syncthreads();
    const int hh = wave_ >> 2, pb = wave_ & 3, kq = lane_ >> 4, fr = lane_ & 15;
    f32x4 acc[8];
#pragma unroll
    for (int t = 0; t < 8; ++t) acc[t] = (f32x4){0.f, 0.f, 0.f, 0.f};
    for (int k0 = 0; k0 < 64; k0 += 4) {
        const float a = U[(k0 + kq) * 144 + hh * 64 + pb * 16 + fr];
#pragma unroll
        for (int t = 0; t < 8; ++t) acc[t] = mfma4(a, Bm[(k0 + kq) * 144 + t * 16 + fr], acc[t]);
    }
    float* dst = F_STB + ((size_t)(ci * 4 + 2 * g + hh) * 64 + pb * 16 + 4 * kq) * 128 + fr;
#pragma unroll
    for (int t = 0; t < 8; ++t)
#pragma unroll
        for (int r = 0; r < 4; ++r) dst[r * 128 + t * 16] = acc[t][r];
    __syncthreads();
}

__device__ __forceinline__ float hgrn_lb(const float* lbp, int layer, int ch) { if (layer == 0) return 0.f; const float l0 = lbp[ch], l1 = lbp[256 + ch]; return 1.0f / (1.0f + __expf(l0 - l1)); }

__device__ __forceinline__ void hgrn_local_item(Frame& F, int layer, int ci, int hp) {
    ITEM_IDS();
    const Chunk c = chunk_of(ci);
    lf32* Gl = (lf32*)F.lds; lf32* Kk = Gl + 64 * 144; lf32* Vv = Kk + 64 * 144;
    const float* lbp = inp(I_LB);
    for (int it = tid_; it < 64 * 16; it += NTHR) {
        const int r = it >> 4, cg = it & 15, ch = 128 * hp + 8 * cg;
        float gq[8], kk[8], vv[8];
        if (r < c.nrows) {
            float cf[8]; unpack8(*(const v4u*)(F_PROJ + (size_t)(c.row0 + r) * NPROJ + PC_CF + ch), cf); unpack8(*(const v4u*)(F_PROJ + (size_t)(c.row0 + r) * NPROJ + PC_CI + ch), vv);
#pragma unroll
            for (int i = 0; i < 8; ++i) { const float lb = hgrn_lb(lbp, layer, ch + i); kk[i] = (1.0f - lb) * sigmoid_f(-cf[i]); gq[i] = log1pf(-kk[i]); }
        } else {
#pragma unroll
            for (int i = 0; i < 8; ++i) { gq[i] = 0.f; kk[i] = 0.f; vv[i] = 0.f; } }
#pragma unroll
        for (int i = 0; i < 8; ++i) { Gl[r * 144 + 8 * cg + i] = gq[i]; Kk[r * 144 + 8 * cg + i] = kk[i]; Vv[r * 144 + 8 * cg + i] = vv[i]; }
    }
    __syncthreads();
    if (tid_ < 128) { float run = 0.f; for (int r = 0; r < 64; ++r) { run += Gl[r * 144 + tid_]; Gl[r * 144 + tid_] = run; } F_DECC[(size_t)ci * 256 + 128 * hp + tid_] = __expf(run); }
    __syncthreads();
    for (int it = tid_; it < 64 * 128; it += NTHR) { const int r = it >> 7, cc = it & 127; Kk[r * 144 + cc] *= __expf(Gl[63 * 144 + cc] - Gl[r * 144 + cc]); }
    __syncthreads();
    const int hh = wave_ >> 2, kb = wave_ & 3, kq = lane_ >> 4, fr = lane_ & 15;
    f32x4 acc[4];
#pragma unroll
    for (int t = 0; t < 4; ++t) acc[t] = (f32x4){0.f, 0.f, 0.f, 0.f};
    for (int k0 = 0; k0 < 64; k0 += 4) {
        const float a = Kk[(k0 + kq) * 144 + hh * 64 + kb * 16 + fr];
#pragma unroll
        for (int t = 0; t < 4; ++t) acc[t] = mfma4(a, Vv[(k0 + kq) * 144 + hh * 64 + t * 16 + fr], acc[t]);
    }
    float* dst = F_STC + ((size_t)(ci * 4 + 2 * hp + hh) * 64 + kb * 16 + 4 * kq) * 64 + fr;
#pragma unroll
    for (int t = 0; t < 4; ++t)
#pragma unroll
        for (int r = 0; r < 4; ++r) dst[r * 64 + t * 16] = acc[t][r];
    __syncthreads();
}

__device__ __forceinline__ void pool_item(Frame& F, int layer, int ci) {
    ITEM_IDS();
    const Chunk c = chunk_of(ci);
    lf32* raw = (lf32*)F.lds;
    lf32* Pl = raw + 79 * 256;
    const float* spool = inp(I_SPOOL) + (size_t)(layer * NSB + (c.b < 0 ? 0 : c.b)) * 15 * 256;
    for (int it = tid_; it < 79 * 32; it += NTHR) {
        const int rr = it >> 5, cg = it & 31, r = rr - 15; float v[8];
        if (r >= c.nrows) {
#pragma unroll
            for (int i = 0; i < 8; ++i) v[i] = 0.f; }
        else if (r >= 0 || (c.b < 0 && c.row0 + r >= 0)) unpack8(*(const v4u*)(F_PROJ + (size_t)(c.row0 + r) * NPROJ + PC_DX + 8 * cg), v);
        else if (c.b < 0) {
#pragma unroll
            for (int i = 0; i < 8; ++i) v[i] = 0.f; }
        else { const float* s = spool + (size_t)(15 + r) * 256 + 8 * cg; const f32x4 a = *(const f32x4*)s, b2 = *(const f32x4*)(s + 4);
            v[0] = a.x; v[1] = a.y; v[2] = a.z; v[3] = a.w; v[4] = b2.x; v[5] = b2.y; v[6] = b2.z; v[7] = b2.w; }
#pragma unroll
        for (int i = 0; i < 8; ++i) raw[rr * 256 + 8 * cg + i] = v[i];
    }
    __syncthreads();
    { const int ch = tid_ & 255, half = tid_ >> 8, win = 2 << (ch >> 6); const float inv = 1.0f / (float)win;
      for (int r = 32 * half; r < 32 * half + 32; ++r) { float s = 0.f; for (int q = 0; q < win; ++q) s += raw[(r + 15 - q) * 256 + ch]; Pl[r * 258 + ch] = s * inv - raw[(r + 15) * 256 + ch]; } }
    __syncthreads();
    const int tb = wave_ >> 1, g0 = 2 * (wave_ & 1), kq = lane_ >> 4, fr = lane_ & 15;
    const float* Wp = inp(I_PW) + (size_t)layer * 4 * 64 * 64; const float* sc = inp(I_PS) + (size_t)layer * 256;
#pragma unroll
    for (int gg = 0; gg < 2; ++gg) {
        const int g = g0 + gg;
        f32x4 acc[4];
#pragma unroll
        for (int t = 0; t < 4; ++t) acc[t] = (f32x4){0.f, 0.f, 0.f, 0.f};
        for (int k0 = 0; k0 < 64; k0 += 4) {
            const float a = Pl[(tb * 16 + fr) * 258 + g * 64 + k0 + kq];
#pragma unroll
            for (int t = 0; t < 4; ++t) acc[t] = mfma4(a, Wp[(size_t)(g * 64 + k0 + kq) * 64 + t * 16 + fr], acc[t]);
        }
#pragma unroll
        for (int t = 0; t < 4; ++t) { const float s = sc[g * 64 + t * 16 + fr];
#pragma unroll
            for (int r = 0; r < 4; ++r) { const int row = tb * 16 + 4 * kq + r; if (row < c.nrows) F_XN[(size_t)(c.row0 + row) * D + 768 + g * 64 + t * 16 + fr] = (bf16)f2bf(acc[t][r] * s); } }
    }
    __syncthreads();
}

__device__ __forceinline__ void copy_states(Frame& F, int layer) {
    ITEM_IDS();
    const size_t gt = (size_t)F.bid * NTHR + tid_, GT = (size_t)F.G * NTHR;
    float* out = F.out; const float* ckp = inp(I_CK); const float* cvp = inp(I_CV);
    for (size_t i = gt; i < 2 * 512 * 256; i += GT) { const int which = (int)(i >> 17), j = (int)((i >> 8) & 511), cc = (int)(i & 255);
        out[(which ? O_PV : O_PK) + (size_t)layer * 512 * 256 + j * 256 + cc] = bf1(F_PROJ[(size_t)(MP - 512 + j) * NPROJ + (which ? PC_V : PC_K) + cc]); }
    for (size_t i = gt; i < (size_t)2 * 16 * 512 * 256; i += GT) { const int which = (int)(i >> 21), b = (int)((i >> 17) & 15), j = (int)((i >> 8) & 511), cc = (int)(i & 255);
        float v; if (j < 496) v = (which ? cvp : ckp)[((size_t)(layer * NSB + b) * 512 + j + 16) * 256 + cc]; else v = bf1(F_PROJ[(size_t)(MP + 16 * b + j - 496) * NPROJ + (which ? PC_V : PC_K) + cc]);
        out[(which ? O_SV : O_SK) + ((size_t)(layer * NSB + b) * 512 + j) * 256 + cc] = v; }
    for (size_t i = gt; i < 17 * 3 * 768; i += GT) { const int b = (int)(i / 2304), rr = (int)((i / 768) % 3), cc = (int)(i % 768);
        if (b == 0) out[O_PCONV + (size_t)layer * 2304 + rr * 768 + cc] = bf1(F_PROJ[(size_t)(MP - 3 + rr) * NPROJ + PC_X + cc]);
        else out[O_SCONV + ((size_t)(layer * NSB + b - 1) * 3 + rr) * 768 + cc] = bf1(F_PROJ[(size_t)(MP + 16 * (b - 1) + 13 + rr) * NPROJ + PC_X + cc]); }
    for (size_t i = gt; i < 17 * 15 * 256; i += GT) { const int b = (int)(i / 3840), rr = (int)((i / 256) % 15), cc = (int)(i % 256);
        if (b == 0) out[O_PPOOL + (size_t)layer * 3840 + rr * 256 + cc] = bf1(F_PROJ[(size_t)(MP - 15 + rr) * NPROJ + PC_DX + cc]);
        else out[O_SPOOL + ((size_t)(layer * NSB + b - 1) * 15 + rr) * 256 + cc] = bf1(F_PROJ[(size_t)(MP + 16 * (b - 1) + 1 + rr) * NPROJ + PC_DX + cc]); }
}
constexpr int KS_LD = 72, PS_LD = 584;
constexpr int AT_KS = 0, AT_VT = 576 * KS_LD * 2, AT_ST = AT_VT + 64 * PS_LD * 2, AT_BIAS = AT_ST + 2048;
static_assert(AT_BIAS + 260 * 4 <= MISC_OFF, "attention LDS map");
__device__ __forceinline__ void attn_item(Frame& F, int layer, int ci, int h) {
    ITEM_IDS();
    const Chunk c = chunk_of(ci);
    LAS bf16* Ks = (LAS bf16*)(F.lds + AT_KS); LAS bf16* Ps = Ks; LAS bf16* Vt = (LAS bf16*)(F.lds + AT_VT);
    lf32* mx = (lf32*)(F.lds + AT_ST); lf32* sm = mx + 128; lf32* bias = (lf32*)(F.lds + AT_BIAS);
    const int jlo = (c.b < 0) ? (ci < 8 ? 64 * (8 - ci) : 0) : 0;
    const int jval = (c.b < 0) ? 576 : 528;
    const float* ckp = inp(I_CK); const float* cvp = inp(I_CV); const float* arel = inp(I_AREL) + (size_t)layer * 257 * 4 + h;
    for (int it = tid_; it < (576 - jlo) * 8; it += NTHR) {
        const int j = jlo + (it >> 3), dg = it & 7;
        v4u kw, vw;
        if (c.b < 0) { const size_t row = (size_t)(c.row0 - 512 + j); kw = *(const v4u*)(F_PROJ + row * NPROJ + PC_K + 64 * h + 8 * dg); vw = *(const v4u*)(F_PROJ + row * NPROJ + PC_V + 64 * h + 8 * dg); }
        else if (j < 512) { const size_t o = (((size_t)(layer * NSB + c.b) * 512 + j) * 4 + h) * 64 + 8 * dg; const float* kp = ckp + o; const float* vp = cvp + o;
            const f32x4 k0 = *(const f32x4*)kp, k1 = *(const f32x4*)(kp + 4), v0 = *(const f32x4*)vp, v1 = *(const f32x4*)(vp + 4);
            kw.x = pk2(k0.x, k0.y); kw.y = pk2(k0.z, k0.w); kw.z = pk2(k1.x, k1.y); kw.w = pk2(k1.z, k1.w); vw.x = pk2(v0.x, v0.y); vw.y = pk2(v0.z, v0.w); vw.z = pk2(v1.x, v1.y); vw.w = pk2(v1.z, v1.w); }
        else if (j < 528) { const size_t row = (size_t)(c.row0 + j - 512); kw = *(const v4u*)(F_PROJ + row * NPROJ + PC_K + 64 * h + 8 * dg); vw = *(const v4u*)(F_PROJ + row * NPROJ + PC_V + 64 * h + 8 * dg); }
        else { kw = (v4u){0u, 0u, 0u, 0u}; vw = kw; }
        *(LAS v4u*)(Ks + j * KS_LD + 8 * dg) = kw;
        LAS bf16* vt = Vt + (8 * dg) * PS_LD + j;
        vt[0 * PS_LD] = (bf16)(vw.x & 0xffffu); vt[1 * PS_LD] = (bf16)(vw.x >> 16); vt[2 * PS_LD] = (bf16)(vw.y & 0xffffu); vt[3 * PS_LD] = (bf16)(vw.y >> 16);
        vt[4 * PS_LD] = (bf16)(vw.z & 0xffffu); vt[5 * PS_LD] = (bf16)(vw.z >> 16); vt[6 * PS_LD] = (bf16)(vw.w & 0xffffu); vt[7 * PS_LD] = (bf16)(vw.w >> 16);
    }
    for (int i = tid_; i < 257; i += NTHR) bias[i] = arel[i * 4];
    __syncthreads();
    const int qb = wave_ >> 1, kh = wave_ & 1, kq = lane_ >> 4, fr = lane_ & 15;
    const bool active = (c.b < 0) || (qb == 0);
    const int ntw = (576 - jlo) / 32;
    const int kbase = jlo + kh * ntw * 16;
    f32x4 s[18];
    float mloc[4] = {-3.0e38f, -3.0e38f, -3.0e38f, -3.0e38f};
    if (active) {
        const bf16* qp = F_PROJ + (size_t)(c.row0 + qb * 16 + fr) * NPROJ + PC_Q + 64 * h + 8 * kq;
        const bf16x8 qa0 = *(const bf16x8*)qp, qa1 = *(const bf16x8*)(qp + 32);
#pragma unroll
        for (int t = 0; t < 18; ++t) {
            s[t] = (f32x4){0.f, 0.f, 0.f, 0.f};
            if (t < ntw) {
                const LAS bf16* kp = Ks + (kbase + t * 16 + fr) * KS_LD + 8 * kq;
                const bf16x8 kb0 = *(const LAS bf16x8*)kp, kb1 = *(const LAS bf16x8*)(kp + 32);
                s[t] = __builtin_amdgcn_mfma_f32_16x16x32_bf16(qa0, kb0, s[t], 0, 0, 0);
                s[t] = __builtin_amdgcn_mfma_f32_16x16x32_bf16(qa1, kb1, s[t], 0, 0, 0);
                const int j = kbase + t * 16 + fr;
#pragma unroll
                for (int r = 0; r < 4; ++r) { const int i = qb * 16 + 4 * kq + r; int rel = 512 + i - j; rel = rel > 128 ? 128 : rel; float v = s[t][r] + bias[rel + 128]; if (j >= jval) v = -1.0e30f; s[t][r] = v; mloc[r] = fmaxf(mloc[r], v); }
            }
        }
#pragma unroll
        for (int r = 0; r < 4; ++r) { mloc[r] = max16(mloc[r]); if (fr == 0) mx[(qb * 16 + 4 * kq + r) * 2 + kh] = mloc[r]; }
    }
    __syncthreads();
    if (active) {
        float lsum[4];
#pragma unroll
        for (int r = 0; r < 4; ++r) { const int row = qb * 16 + 4 * kq + r; mloc[r] = fmaxf(mx[row * 2], mx[row * 2 + 1]); lsum[r] = 0.f; }
#pragma unroll
        for (int t = 0; t < 18; ++t) if (t < ntw) {
#pragma unroll
            for (int r = 0; r < 4; ++r) { const float p = __expf(s[t][r] - mloc[r]); lsum[r] += p; Ps[(qb * 16 + 4 * kq + r) * PS_LD + kbase + t * 16 + fr] = (bf16)f2bf(p); }
        }
#pragma unroll
        for (int r = 0; r < 4; ++r) { lsum[r] = sum16(lsum[r]); if (fr == 0) sm[(qb * 16 + 4 * kq + r) * 2 + kh] = lsum[r]; }
    }
    __syncthreads();
    if (active) {
        f32x4 o[2] = {(f32x4){0.f, 0.f, 0.f, 0.f}, (f32x4){0.f, 0.f, 0.f, 0.f}};
        const int nks = (576 - jlo) / 32;
        for (int ks = 0; ks < nks; ++ks) {
            const int j0 = jlo + 32 * ks + 8 * kq;
            const bf16x8 pa = *(const LAS bf16x8*)(Ps + (qb * 16 + fr) * PS_LD + j0);
#pragma unroll
            for (int t = 0; t < 2; ++t) { const bf16x8 vb = *(const LAS bf16x8*)(Vt + (kh * 32 + t * 16 + fr) * PS_LD + j0); o[t] = __builtin_amdgcn_mfma_f32_16x16x32_bf16(pa, vb, o[t], 0, 0, 0); }
        }
#pragma unroll
        for (int r = 0; r < 4; ++r) { const int row = qb * 16 + 4 * kq + r; const float inv = 1.0f / (sm[row * 2] + sm[row * 2 + 1]);
#pragma unroll
            for (int t = 0; t < 2; ++t) F_XN[(size_t)(c.row0 + row) * D + 64 * h + kh * 32 + t * 16 + fr] = (bf16)f2bf(o[t][r] * inv); }
    }
    __syncthreads();
}
__device__ __forceinline__ void scan_phase(Frame& F, int layer) {
    ITEM_IDS();
    constexpr int EPB = 192;
    if (tid_ < EPB) {
        for (int e = F.bid * EPB + tid_; e < 49152; e += F.G * EPB) {
            const bool isb = e < 32768; const int e2 = isb ? e : e - 32768;
            float* st = isb ? F_STB + e2 : F_STC + e2; const size_t cs = isb ? 32768 : 16384;
            const float* dec = isb ? F_DECB + (e2 >> 13) : F_DECC + (e2 >> 6); const int ds = isb ? 4 : 256;
            float run = 0.f;
            for (int c0 = 0; c0 < NCHP; c0 += 16) {
                float sl[16], dc[16];
#pragma unroll
                for (int i = 0; i < 16; ++i) { sl[i] = st[(size_t)(c0 + i) * cs]; dc[i] = dec[(size_t)(c0 + i) * ds]; }
#pragma unroll
                for (int i = 0; i < 16; ++i) { st[(size_t)(c0 + i) * cs] = run; run = dc[i] * run + sl[i]; }
            }
            F.out[(isb ? O_PSSM + (size_t)layer * 32768 : O_PHGRN + (size_t)layer * 16384) + e2] = run;
        }
    }
    const size_t gt = (size_t)F.bid * NTHR + tid_, GT = (size_t)F.G * NTHR; const float* sssm = inp(I_SSSM); const float* shgrn = inp(I_SHGRN);
    for (size_t i = gt; i < (size_t)NSB * 49152; i += GT) {
        const int b = (int)(i / 49152), e = (int)(i % 49152); const int ci = NCHP + b;
        if (e < 32768) { const float s0 = sssm[(size_t)(layer * NSB + b) * 32768 + e];
            F.out[O_SSSM + (size_t)(layer * NSB + b) * 32768 + e] = F_DECB[ci * 4 + (e >> 13)] * s0 + F_STB[(size_t)ci * 32768 + e]; }
        else { const int e2 = e - 32768; const float s0 = shgrn[(size_t)(layer * NSB + b) * 16384 + e2];
            F.out[O_SHGRN + (size_t)(layer * NSB + b) * 16384 + e2] = F_DECC[(size_t)ci * 256 + (e2 >> 6)] * s0 + F_STC[(size_t)ci * 16384 + e2]; }
    }
}

constexpr int P4_CM = 0, P4_BM = P4_CM + 64 * 130 * 4, P4_XS = P4_BM + 64 * 130 * 4, P4_GM = P4_XS + 64 * 144 * 4, P4_ACS = P4_GM + 64 * 66 * 4, P4_DTV = P4_ACS + 1024, P4_SS = P4_DTV + 1024, P4_END = P4_SS + 256;
static_assert(P4_END <= MISC_OFF, "P4 SSD LDS map");
__device__ __forceinline__ void ssd_out_item(Frame& F, int layer, int ci) {
    ITEM_IDS();
    const Chunk c = chunk_of(ci);
    lf32* Cm = (lf32*)(F.lds + P4_CM); lf32* Bm = (lf32*)(F.lds + P4_BM); lf32* Xs = (lf32*)(F.lds + P4_XS); lf32* Gm = (lf32*)(F.lds + P4_GM);
    lf32* acs = (lf32*)(F.lds + P4_ACS); lf32* dtv = (lf32*)(F.lds + P4_DTV); lf32* ss = (lf32*)(F.lds + P4_SS);
    const int kq = lane_ >> 4, fr = lane_ & 15, ib = wave_ >> 1, tp = 2 * (wave_ & 1);
    dt_stage(F, tid_, c, layer, acs, dtv);
    if (tid_ < 64) ss[tid_] = 0.f;
    f32x4 yg[2][2][2];
#pragma unroll
    for (int g = 0; g < 2; ++g) {
        conv_stage(F, tid_, c, layer, 512 + 128 * g, 128, Cm, 130);
        conv_stage(F, tid_, c, layer, 256 + 128 * g, 128, Bm, 130);
        conv_stage(F, tid_, c, layer, 128 * g, 128, Xs, 144);
        __syncthreads();
        f32x4 G[2] = {(f32x4){0.f, 0.f, 0.f, 0.f}, (f32x4){0.f, 0.f, 0.f, 0.f}};
        for (int k0 = 0; k0 < 128; k0 += 4) {
            const float a = Cm[(ib * 16 + fr) * 130 + k0 + kq];
#pragma unroll
            for (int t = 0; t < 2; ++t) if (tp + t <= ib) G[t] = mfma4(a, Bm[((tp + t) * 16 + fr) * 130 + k0 + kq], G[t]);
        }
        __syncthreads();
#pragma unroll
        for (int hh = 0; hh < 2; ++hh) {
            const int h = 2 * g + hh;
#pragma unroll
            for (int t = 0; t < 2; ++t) { const int j = (tp + t) * 16 + fr; const float aj = acs[j * 4 + h], dj = dtv[j * 4 + h];
#pragma unroll
                for (int r = 0; r < 4; ++r) { const int i = ib * 16 + 4 * kq + r; Gm[i * 66 + j] = (j <= i) ? G[t][r] * __expf(acs[i * 4 + h] - aj) * dj : 0.f; } }
            { const float* sp = (c.b < 0) ? F_STB + (size_t)(ci * 4 + h) * 8192 : inp(I_SSSM) + (size_t)((layer * NSB + c.b) * 4 + h) * 8192;
              for (int it = tid_; it < 2048; it += NTHR) { const int p = it >> 5, n4 = it & 31; const f32x4 v = *(const f32x4*)(sp + p * 128 + 4 * n4); lf32* d = Bm + p * 130 + 4 * n4; d[0] = v.x; d[1] = v.y; d[2] = v.z; d[3] = v.w; } }
            __syncthreads();
            f32x4 a1[2] = {(f32x4){0.f, 0.f, 0.f, 0.f}, (f32x4){0.f, 0.f, 0.f, 0.f}}, a2[2] = {(f32x4){0.f, 0.f, 0.f, 0.f}, (f32x4){0.f, 0.f, 0.f, 0.f}};
            for (int j0 = 0; j0 < 16 * (ib + 1); j0 += 4) {
                const float a = Gm[(ib * 16 + fr) * 66 + j0 + kq];
#pragma unroll
                for (int t = 0; t < 2; ++t) a1[t] = mfma4(a, Xs[(j0 + kq) * 144 + hh * 64 + (tp + t) * 16 + fr], a1[t]);
            }
            for (int k0 = 0; k0 < 128; k0 += 4) {
                const float a = Cm[(ib * 16 + fr) * 130 + k0 + kq];
#pragma unroll
                for (int t = 0; t < 2; ++t) a2[t] = mfma4(a, Bm[((tp + t) * 16 + fr) * 130 + k0 + kq], a2[t]);
            }
            const float dh = inp(I_BD)[layer * 4 + h];
            float sq[4] = {0.f, 0.f, 0.f, 0.f};
#pragma unroll
            for (int t = 0; t < 2; ++t) { const int p = (tp + t) * 16 + fr;
#pragma unroll
                for (int r = 0; r < 4; ++r) { const int i = ib * 16 + 4 * kq + r;
                    float y = a1[t][r] + __expf(acs[i * 4 + h]) * a2[t][r] + dh * Xs[i * 144 + hh * 64 + p];
                    float z = 0.f; if (i < c.nrows) z = bf1(F_PROJ[(size_t)(c.row0 + i) * NPROJ + PC_Z + h * 64 + p]);
                    y *= silu_g(z); yg[g][hh][t][r] = y; sq[r] += y * y; } }
#pragma unroll
            for (int r = 0; r < 4; ++r) { const float q = sum16(sq[r]); if (fr == 0) atomicAdd((float*)(ss + ib * 16 + 4 * kq + r), q); }
            __syncthreads();
        }
    }
    __syncthreads();
    const float* nw = inp(I_BNRM) + (size_t)layer * 256;
#pragma unroll
    for (int r = 0; r < 4; ++r) { const int i = ib * 16 + 4 * kq + r; const float rstd = 1.0f / sqrtf(ss[i] * (1.0f / 256.0f) + EPS);
        if (i < c.nrows) {
#pragma unroll
            for (int g = 0; g < 2; ++g)
#pragma unroll
                for (int hh = 0; hh < 2; ++hh)
#pragma unroll
                    for (int t = 0; t < 2; ++t) { const int ch = (2 * g + hh) * 64 + (tp + t) * 16 + fr; F_XN[(size_t)(c.row0 + i) * D + 256 + ch] = (bf16)f2bf(yg[g][hh][t][r] * rstd * nw[ch]); } } }
    __syncthreads();
}

constexpr int P4C_QT = 0, P4C_KK = P4C_QT + 64 * 66 * 4, P4C_BC = P4C_KK + 64 * 66 * 4, P4C_AT = P4C_BC + 64 * 66 * 4, P4C_VV = P4C_AT + 64 * 66 * 4, P4C_SL = P4C_VV + 64 * 80 * 4,
              P4C_RI = P4C_SL + 64 * 80 * 4, P4C_ERI = P4C_RI + 1024, P4C_GT = P4C_ERI + 1024, P4C_SS = P4C_GT + 8 * 64 * 4, P4C_END = P4C_SS + 256;
static_assert(P4C_END <= MISC_OFF, "P4 HGRN LDS map");
__device__ __forceinline__ void hgrn_out_item(Frame& F, int layer, int ci) {
    ITEM_IDS();
    const Chunk c = chunk_of(ci);
    lf32* Qt = (lf32*)(F.lds + P4C_QT); lf32* Kk = (lf32*)(F.lds + P4C_KK); lf32* Bc = (lf32*)(F.lds + P4C_BC); lf32* At = (lf32*)(F.lds + P4C_AT); lf32* Vv = (lf32*)(F.lds + P4C_VV); lf32* Sl = (lf32*)(F.lds + P4C_SL);
    lf32* rI = (lf32*)(F.lds + P4C_RI); lf32* erI = (lf32*)(F.lds + P4C_ERI); lf32* gt = (lf32*)(F.lds + P4C_GT); lf32* ss = (lf32*)(F.lds + P4C_SS);
    const int kq = lane_ >> 4, fr = lane_ & 15, ib = wave_ >> 1, tv = 2 * (wave_ & 1);
    for (int h = 0; h < 4; ++h) {
        { const int k = tid_ & 63, rg = tid_ >> 6; const float lb = hgrn_lb(inp(I_LB), layer, h * 64 + k); float cum[8], qv[8]; float run = 0.f;
#pragma unroll
          for (int i = 0; i < 8; ++i) { const int r = 8 * rg + i; float kk = 0.f, q = 0.f, v = 0.f, g = 0.f;
              if (r < c.nrows) { const bf16* pr = F_PROJ + (size_t)(c.row0 + r) * NPROJ + h * 64 + k; const float cf = bf1(pr[PC_CF]); q = bf1(pr[PC_CQ]); v = bf1(pr[PC_CI]); kk = (1.0f - lb) * sigmoid_f(-cf); g = log1pf(-kk); }
              run += g; cum[i] = run; qv[i] = q; Kk[r * 66 + k] = kk; Vv[r * 80 + k] = v; }
          gt[rg * 64 + k] = run;
          __syncthreads();
          float pre = 0.f;
#pragma unroll
          for (int q2 = 0; q2 < 8; ++q2) if (q2 < rg) pre += gt[q2 * 64 + k];
          if ((rg & 1) == 0) { rI[(rg >> 1) * 64 + k] = pre; erI[(rg >> 1) * 64 + k] = __expf(pre); }
#pragma unroll
          for (int i = 0; i < 8; ++i) { const int r = 8 * rg + i; Bc[r * 66 + k] = pre + cum[i]; }
          __syncthreads();
          const float rref = rI[(rg >> 1) * 64 + k];
#pragma unroll
          for (int i = 0; i < 8; ++i) { const int r = 8 * rg + i; Qt[r * 66 + k] = qv[i] * __expf(pre + cum[i] - rref); }
        }
        { const float* sp = (c.b < 0) ? F_STC + (size_t)(ci * 4 + h) * 4096 : inp(I_SHGRN) + (size_t)((layer * NSB + c.b) * 4 + h) * 4096;
          for (int it = tid_; it < 1024; it += NTHR) { const int k = it >> 4, v4 = it & 15; const f32x4 v = *(const f32x4*)(sp + k * 64 + 4 * v4); *(LAS f32x4*)(Sl + k * 80 + 4 * v4) = v; } }
        if (tid_ < 64) ss[tid_] = 0.f;
        __syncthreads();
        for (int pr = wave_; pr < 10; pr += 8) {
            const int I = pr < 1 ? 0 : pr < 3 ? 1 : pr < 6 ? 2 : 3, J = pr - (I * (I + 1)) / 2;
            f32x4 acc = {0.f, 0.f, 0.f, 0.f};
            for (int k0 = 0; k0 < 64; k0 += 4) { const int kk = k0 + kq;
                const float a = Qt[(16 * I + fr) * 66 + kk];
                const float b = Kk[(16 * J + fr) * 66 + kk] * __expf(fminf(rI[I * 64 + kk] - Bc[(16 * J + fr) * 66 + kk], 80.f));
                acc = mfma4(a, b, acc); }
#pragma unroll
            for (int r = 0; r < 4; ++r) { const int i = 16 * I + 4 * kq + r, j = 16 * J + fr; At[i * 66 + j] = (j <= i) ? acc[r] : 0.f; }
        }
        __syncthreads();
        f32x4 o[2] = {(f32x4){0.f, 0.f, 0.f, 0.f}, (f32x4){0.f, 0.f, 0.f, 0.f}};
        for (int j0 = 0; j0 < 16 * (ib + 1); j0 += 4) {
            const float a = At[(16 * ib + fr) * 66 + j0 + kq];
#pragma unroll
            for (int t = 0; t < 2; ++t) o[t] = mfma4(a, Vv[(j0 + kq) * 80 + (tv + t) * 16 + fr], o[t]);
        }
        for (int k0 = 0; k0 < 64; k0 += 4) { const int kk = k0 + kq;
            const float a = Qt[(16 * ib + fr) * 66 + kk] * erI[ib * 64 + kk];
#pragma unroll
            for (int t = 0; t < 2; ++t) o[t] = mfma4(a, Sl[kk * 80 + (tv + t) * 16 + fr], o[t]);
        }
        float sq[4] = {0.f, 0.f, 0.f, 0.f};
#pragma unroll
        for (int t = 0; t < 2; ++t)
#pragma unroll
            for (int r = 0; r < 4; ++r) sq[r] += o[t][r] * o[t][r];
#pragma unroll
        for (int r = 0; r < 4; ++r) { const float q = sum16(sq[r]); if (fr == 0) atomicAdd((float*)(ss + ib * 16 + 4 * kq + r), q); }
        __syncthreads();
        const float* nw = inp(I_CNRM) + (size_t)layer * 256 + h * 64;
#pragma unroll
        for (int r = 0; r < 4; ++r) { const int i = ib * 16 + 4 * kq + r; const float rstd = 1.0f / sqrtf(ss[i] * (1.0f / 64.0f) + EPS);
            if (i < c.nrows) {
#pragma unroll
                for (int t = 0; t < 2; ++t) { const int v = (tv + t) * 16 + fr; const float cg = bf1(F_PROJ[(size_t)(c.row0 + i) * NPROJ + PC_CG + h * 64 + v]);
                    F_XN[(size_t)(c.row0 + i) * D + 512 + h * 64 + v] = (bf16)f2bf(o[t][r] * rstd * nw[v] * silu_g(cg)); } } }
        __syncthreads();
    }
}
__device__ __forceinline__ void p2_phase(Frame& F, int layer) {
    constexpr int NA = NCH * 4, NB = NCH * 2, NC = NCH * 2, ND = NCH, NTOT = NA + NB + NC + ND;
    for (int it = F.bid; it < NTOT; it += F.G) {
        if (it < NA) attn_item(F, layer, it >> 2, it & 3);
        else if (it < NA + NB) { const int r = it - NA; ssd_local_item(F, layer, r >> 1, r & 1); }
        else if (it < NA + NB + NC) { const int r = it - NA - NB; hgrn_local_item(F, layer, r >> 1, r & 1); }
        else pool_item(F, layer, it - NA - NB - NC);
    }
    copy_states(F, layer);
}
__device__ __forceinline__ void p4_phase(Frame& F, int layer) {
    for (int ci = F.bid; ci < NCH; ci += F.G) { ssd_out_item(F, layer, ci); hgrn_out_item(F, layer, ci); }
}

__global__ void __launch_bounds__(NTHR, 2) fwd_kernel(Args args) {
    extern __shared__ __attribute__((aligned(16))) unsigned char lds[];
    Frame F;
    F.lds = (LAS unsigned char*)lds;
    F.tid = threadIdx.x; F.lane = F.tid & 63; F.wave = __builtin_amdgcn_readfirstlane(F.tid >> 6);
    F.G = gridDim.x; F.bid = blockIdx.x;
    F.out = args.out; F.ws = args.ws;
    volatile LAS unsigned* MISC = (volatile LAS unsigned*)(F.lds + MISC_OFF);
    if (F.tid < 64) MISC[F.tid] = 0u;
    __syncthreads();
    XcdBarrier bar = xcd_barrier_post((unsigned*)(args.ws + WS_CTL) + CW_BAR, MISC + 8);
#define GRID_BAR() xcd_barrier(bar)

    p0_weights(F);
    __syncthreads();
    norm_rows<true, false>(F, inp(I_XP), inp(I_XS) - (size_t)MP * D, inp(I_N1), inp(I_WIN));
    GRID_BAR();
#pragma unroll 1
    for (int layer = 0; layer < 2; ++layer) {
        unsigned char* wl = args.ws + WS_W + (size_t)layer * WL_STRIDE;
        { pg8::Gemm g{F_XN, (const bf16*)(wl + WL_IN), M, NPROJ, D}; pg8::StaticOrder S; S.init(M, NPROJ, F.G, F.bid);
          pg8::EpiBf16 E{F_PROJ, NPROJ};
          pg8::gemm_phase<pg8::EpiBf16, pg8::StaticOrder, true, true>(F.lds + RING_OFF, g, S, E); }
        GRID_BAR();
        p2_phase(F, layer);
        GRID_BAR();
        scan_phase(F, layer);
        GRID_BAR();
        p4_phase(F, layer);
        GRID_BAR();
        { pg8::Gemm g{F_XN, (const bf16*)(wl + WL_OUT), M, D, D}; pg8::StaticOrder S; S.init(M, D, F.G, F.bid);
          pg8::EpiRes E{layer == 0 ? inp(I_XP) : F_X, layer == 0 ? inp(I_XS) - (size_t)MP * D : F_X, F_X};
          pg8::gemm_phase<pg8::EpiRes, pg8::StaticOrder, true, true>(F.lds + RING_OFF, g, S, E); }
        GRID_BAR();
        norm_rows<false, false>(F, F_X, F_X, inp(I_N2) + (size_t)layer * D, nullptr);
        GRID_BAR();
        { pg8::Gemm g{F_XN, (const bf16*)(wl + WL_GU), M, NGU, D}; pg8::StaticOrder S; S.init(M, NGU, F.G, F.bid);
          pg8::EpiSwiGLU E{F_ACT, DFF};
          pg8::gemm_phase<pg8::EpiSwiGLU, pg8::StaticOrder, true, true>(F.lds + RING_OFF, g, S, E); }
        GRID_BAR();
        { pg8::Gemm g{F_ACT, (const bf16*)(wl + WL_DN), M, D, DFF}; pg8::StaticOrder S; S.init(M, D, F.G, F.bid);
          pg8::EpiRes E{F_X, F_X, F_X};
          pg8::gemm_phase<pg8::EpiRes, pg8::StaticOrder, true, true>(F.lds + RING_OFF, g, S, E); }
        GRID_BAR();
        if (layer == 0) { norm_rows<true, false>(F, F_X, F_X, inp(I_N1) + D, inp(I_WIN) + (size_t)D * NIN); GRID_BAR(); }
        else norm_rows<false, true>(F, F_X, F_X, inp(I_NF), nullptr);
    }
}

extern "C" void kernel_launch(void* const* d_in, const int* in_sizes, int n_in, void* d_out, int out_size, void* d_ws, size_t ws_size, hipStream_t stream) {
    static int grid = 0;
    if (grid == 0) {
        if (n_in != N_IN || (size_t)out_size != O_END || ws_size < WS_END) { fprintf(stderr, "kernel_launch: unexpected shapes (n_in %d, out %d, ws %zu)\n", n_in, out_size, ws_size); grid = -1; return; }
        int dev = 0, cus = 0, per_cu = 0;
        if (hipGetDevice(&dev) != hipSuccess || hipDeviceGetAttribute(&cus, hipDeviceAttributeMultiprocessorCount, dev) != hipSuccess) { grid = -1; return; }
        if (hipFuncSetAttribute((const void*)fwd_kernel, hipFuncAttributeMaxDynamicSharedMemorySize, LDS_BYTES) != hipSuccess) { fprintf(stderr, "kernel_launch: hipFuncSetAttribute failed\n"); grid = -1; return; }
        if (hipOccupancyMaxActiveBlocksPerMultiprocessor(&per_cu, (const void*)fwd_kernel, NTHR, LDS_BYTES) != hipSuccess || per_cu < 1) { fprintf(stderr, "kernel_launch: occupancy query says %d blocks per CU\n", per_cu); (void)hipGetLastError(); grid = -1; return; }
        grid = cus;
    }
    if (grid < 0) return;
    if (hipMemsetAsync((char*)d_ws + WS_CTL, 0, CTL_ZERO_BYTES, stream) != hipSuccess) { fprintf(stderr, "kernel_launch: hipMemsetAsync failed\n"); return; }
    Args a{};
    for (int i = 0; i < N_IN; ++i) a.in[i] = (const float*)d_in[i];
    a.out = (float*)d_out; a.ws = (unsigned char*)d_ws;
    void* kargs[] = {&a};
    hipError_t e = hipLaunchCooperativeKernel((const void*)fwd_kernel, dim3(grid), dim3(NTHR), kargs, LDS_BYTES, stream);
    if (e != hipSuccess) { fprintf(stderr, "kernel_launch: cooperative launch failed: %s (grid %d)\n", hipGetErrorString(e), grid); }
}
```

```cpp
#include <hip/hip_runtime.h>
#include <cstdio>
#include <cstdint>
namespace pg8 {
#define PG8_LAS __attribute__((address_space(3)))
typedef unsigned short bf16_t;
typedef short bf16x8 __attribute__((ext_vector_type(8)));
typedef float f32x4 __attribute__((ext_vector_type(4)));
typedef unsigned u32x4 __attribute__((ext_vector_type(4)));
constexpr int BM = 256, BK = 64, HALF = 128, HTB = HALF * BK * 2  , STAGE_BYTES = 8 * HTB, NXCD = 8, WGM = 8;

__host__ __device__ __forceinline__ int lds_byte(int r, int c) { const int st = (r >> 4) * 2 + (c >> 5), rr = r & 15, cc = c & 31, ob = rr * 64 + cc * 2; return st * 1024 + (ob ^ (((ob >> 9) & 1) << 5)); }
__host__ __device__ __forceinline__ void stage_rc(int b, int& R, int& C) { const int st = b / 1024, sb = b % 1024, swz = sb ^ (((sb >> 9) & 1) << 5); R = (st >> 1) * 16 + swz / 64; C = (st & 1) * 32 + (swz % 64) / 2; }
__host__ __device__ __forceinline__ int perm32(int rho) { const int n = rho >> 4, i = rho & 15; return 8 * (i >> 2) + 4 * n + (i & 3); }

struct Unit { int pm, pn; };
struct Gemm { const bf16_t* A; const bf16_t* Bt; int M, N, K; };

struct StaticOrder {
    int nM, nN, nwg, G, c;
    __host__ __device__ void init(int M, int N, int G_, int c_) { nM = M / BM; nN = N / BM; nwg = nM * nN; G = G_; c = c_; }
    __host__ __device__ bool next(int i, Unit& u) const {
        const long L = (long)i * G + c; if (L >= nwg) return false;
        int wgid = (int)L; { const int q = nwg / NXCD, r = nwg % NXCD, xcd = wgid % NXCD, off = wgid / NXCD; wgid = (xcd < r ? xcd * (q + 1) : r * (q + 1) + (xcd - r) * q) + off; }
        const int nig = WGM * nN, gid = wgid / nig, fm = gid * WGM, gsz = (nM - fm) < WGM ? (nM - fm) : WGM;
        u.pm = fm + ((wgid % nig) % gsz); u.pn = (wgid % nig) / gsz; return true;
    }
    __device__ __forceinline__ void a_ready(const Unit&) const {}
    __device__ __forceinline__ void done(const Unit&) const {}
};

__device__ __forceinline__ unsigned cvt_pk_bf16(float lo, float hi) { unsigned r; asm volatile("v_cvt_pk_bf16_f32 %0, %1, %2" : "=v"(r) : "v"(lo), "v"(hi)); return r; }
__device__ __forceinline__ float silu_f(float x) { return x * __builtin_amdgcn_rcpf(1.0f + __expf(-x)); }
struct EpiBf16 {
    static constexpr bool PERM = true, AFTER_DRAIN = false;
    bf16_t* O; int ldc; bf16_t* halo; bf16_t* vta; int vld;
    __device__ __forceinline__ void operator()(const f32x4 (&acc)[2][2][4][2], const Unit& u, int wr, int wc, int fr, int fq) const {
        const int row0 = u.pm * BM + wr * 64 + fr, col0 = u.pn * BM + wc * 32 + 8 * fq;
        const bool hz = halo != nullptr && u.pn >= 4 && u.pn <= 6;
#pragma unroll
        for (int ai = 0; ai < 2; ++ai)
#pragma unroll
            for (int m = 0; m < 4; ++m) { const int row = row0 + ai * HALF + m * 16; bf16_t* rowp = O + (size_t)row * ldc + col0;
#pragma unroll
                for (int bj = 0; bj < 2; ++bj) { const f32x4 v0 = acc[ai][bj][m][0], v1 = acc[ai][bj][m][1];
                    u32x4 w; w.x = cvt_pk_bf16(v0[0], v0[1]); w.y = cvt_pk_bf16(v0[2], v0[3]); w.z = cvt_pk_bf16(v1[0], v1[1]); w.w = cvt_pk_bf16(v1[2], v1[3]);
                    *(u32x4*)(rowp + bj * HALF) = w;
                    if (hz && (row & 63) >= 61) *(u32x4*)(halo + ((size_t)(row >> 6) * 3 + (row & 63) - 61) * 768 + (col0 - 1024) + bj * HALF) = w;
                    if (vta != nullptr && u.pn == 2) { bf16_t* vp = vta + (size_t)(col0 - 512 + bj * HALF) * vld + row;
                        vp[0] = (bf16_t)(w.x & 0xffffu); vp[(size_t)vld] = (bf16_t)(w.x >> 16); vp[(size_t)2 * vld] = (bf16_t)(w.y & 0xffffu); vp[(size_t)3 * vld] = (bf16_t)(w.y >> 16);
                        vp[(size_t)4 * vld] = (bf16_t)(w.z & 0xffffu); vp[(size_t)5 * vld] = (bf16_t)(w.z >> 16); vp[(size_t)6 * vld] = (bf16_t)(w.w & 0xffffu); vp[(size_t)7 * vld] = (bf16_t)(w.w >> 16); } } }
    }
};
struct EpiRes {
    static constexpr bool PERM = false, AFTER_DRAIN = false;
    const float* rlo; const float* rhi; float* C;
    __device__ __forceinline__ void operator()(const f32x4 (&acc)[2][2][4][2], const Unit& u, int wr, int wc, int fr, int fq) const {
        const int row0 = u.pm * BM + wr * 64 + fr, col0 = u.pn * BM + wc * 32 + 4 * fq;
        const float* rb = (u.pm < 64) ? rlo : rhi;
#pragma unroll
        for (int ai = 0; ai < 2; ++ai)
#pragma unroll
            for (int m = 0; m < 4; ++m) { const size_t off = (size_t)(row0 + ai * HALF + m * 16) * 1024 + col0;
#pragma unroll
                for (int bj = 0; bj < 2; ++bj)
#pragma unroll
                    for (int n = 0; n < 2; ++n) { const f32x4 r = *(const f32x4*)(rb + off + bj * HALF + n * 16); *(f32x4*)(C + off + bj * HALF + n * 16) = r + acc[ai][bj][m][n]; }
                if (m & 1) asm volatile("" ::: "memory"); }
    }
};
struct EpiSwiGLU {
    static constexpr bool PERM = true, AFTER_DRAIN = false;
    bf16_t* O; int ldc;
    __device__ __forceinline__ void operator()(const f32x4 (&acc)[2][2][4][2], const Unit& u, int wr, int wc, int fr, int fq) const {
        const int row0 = u.pm * BM + wr * 64 + fr, col0 = u.pn * HALF + wc * 32 + 8 * fq;
#pragma unroll
        for (int ai = 0; ai < 2; ++ai)
#pragma unroll
            for (int m = 0; m < 4; ++m) { bf16_t* rowp = O + (size_t)(row0 + ai * HALF + m * 16) * ldc + col0;
                const f32x4 g0 = acc[ai][0][m][0], g1 = acc[ai][0][m][1], u0 = acc[ai][1][m][0], u1 = acc[ai][1][m][1];
                u32x4 w; w.x = cvt_pk_bf16(silu_f(g0[0]) * u0[0], silu_f(g0[1]) * u0[1]); w.y = cvt_pk_bf16(silu_f(g0[2]) * u0[2], silu_f(g0[3]) * u0[3]);
                w.z = cvt_pk_bf16(silu_f(g1[0]) * u1[0], silu_f(g1[1]) * u1[1]); w.w = cvt_pk_bf16(silu_f(g1[2]) * u1[2], silu_f(g1[3]) * u1[3]);
                *(u32x4*)rowp = w; }
    }
};
template <class Epi, class Sched, bool ALIGN_EPI = false, bool SP2 = false>
__device__ __forceinline__ void gemm_phase(PG8_LAS unsigned char* lds, const Gemm g, const Sched& S, const Epi& E) {
    int tid0 = threadIdx.x; asm volatile("" : "+v"(tid0));
    const int tid = tid0, wid = __builtin_amdgcn_readfirstlane(tid >> 6), lane = tid & 63, wr = wid >> 2, wc = wid & 3, fr = lane & 15, fq = lane >> 4;
    const int K = g.K, nt = K / BK;
    unsigned voffA[2], voffB[2];
#pragma unroll
    for (int i = 0; i < 2; ++i) { int R, C; stage_rc(tid * 16 + i * 8192, R, C); const int Rb = Epi::PERM ? ((R & ~31) + perm32(R & 31)) : R;
        voffA[i] = (unsigned)(R * K + C) * 2u; voffB[i] = (unsigned)(Rb * K + C) * 2u; }
    const size_t kstep = (size_t)(BK * 2);
    const size_t hstep = (size_t)HALF * K * 2;
    const size_t tstep = 2 * hstep;
    const unsigned ldsw = (unsigned)wid * 1024u;
    const int aoff = lds_byte(wr * 64 + fr, fq * 8), boff = lds_byte(wc * 32 + fr, fq * 8);
#define PG8_SA(b, h) (((b) * 2 + (h)) * HTB)
#define PG8_SB(b, h) ((4 + (b) * 2 + (h)) * HTB)
#define PG8_STAGE(bufoff, gbase, voff) do { _Pragma("unroll") for (int _i = 0; _i < 2; ++_i) \
        __builtin_amdgcn_global_load_lds((const unsigned*)((const char*)(gbase) + (voff)[_i]), (PG8_LAS unsigned*)(lds + (bufoff) + ldsw + _i * 8192), 16, 0, 0); } while (0)
#define PG8_LDA(dst, b, h) do { _Pragma("unroll") for (int m = 0; m < 4; ++m) _Pragma("unroll") for (int k = 0; k < 2; ++k) dst[m][k] = *(const PG8_LAS bf16x8*)(lds + PG8_SA(b, h) + aoff + m * 2048 + k * 1024); } while (0)
#define PG8_LDB(dst, b, h) do { _Pragma("unroll") for (int n = 0; n < 2; ++n) _Pragma("unroll") for (int k = 0; k < 2; ++k) dst[n][k] = *(const PG8_LAS bf16x8*)(lds + PG8_SB(b, h) + boff + n * 2048 + k * 1024); } while (0)
#define PG8_MMA(ai, bj, At, Bt) do { __builtin_amdgcn_s_setprio(1); _Pragma("unroll") for (int m = 0; m < 4; ++m) _Pragma("unroll") for (int n = 0; n < 2; ++n) _Pragma("unroll") for (int k = 0; k < 2; ++k) \
        acc[ai][bj][m][n] = __builtin_amdgcn_mfma_f32_16x16x32_bf16(Bt[n][k], At[m][k], acc[ai][bj][m][n], 0, 0, 0); __builtin_amdgcn_s_setprio(0); } while (0)
#define PG8_WAIT_V(n) asm volatile("s_waitcnt vmcnt(" #n ")" ::: "memory")
#define PG8_WAIT_L(n) asm volatile("s_waitcnt lgkmcnt(" #n ")" ::: "memory")
#define PG8_BAR __builtin_amdgcn_s_barrier()
#define PG8_SCHED __builtin_amdgcn_sched_barrier(0)
    Unit cur, nxt; int ui = 0;
    if (!S.next(0, cur)) return;
    f32x4 acc[2][2][4][2];
#pragma unroll
    for (int a = 0; a < 2; ++a)
#pragma unroll
        for (int b = 0; b < 2; ++b)
#pragma unroll
            for (int m = 0; m < 4; ++m)
#pragma unroll
                for (int n = 0; n < 2; ++n) acc[a][b][m][n] = (f32x4){0.f, 0.f, 0.f, 0.f};
    bf16x8 At[4][2], B0[2][2], B1[2][2];
    const char* cA = (const char*)g.A + (size_t)cur.pm * tstep; const char* cB = (const char*)g.Bt + (size_t)cur.pn * tstep;
    S.a_ready(cur);
    if constexpr (SP2) {
        PG8_STAGE(PG8_SB(0, 0), cB, voffB); PG8_STAGE(PG8_SB(0, 1), cB + hstep, voffB); PG8_STAGE(PG8_SA(0, 0), cA, voffA); PG8_STAGE(PG8_SA(0, 1), cA + hstep, voffA);
        if (wr == 1) PG8_BAR;
        PG8_WAIT_V(2); PG8_BAR;
        PG8_STAGE(PG8_SB(1, 0), cB + kstep, voffB); PG8_STAGE(PG8_SA(1, 0), cA + kstep, voffA); PG8_STAGE(PG8_SB(1, 1), cB + hstep + kstep, voffB);
        PG8_WAIT_V(6); PG8_BAR;
    } else {
        PG8_STAGE(PG8_SB(0, 0), cB, voffB); PG8_STAGE(PG8_SA(0, 0), cA, voffA); PG8_STAGE(PG8_SB(0, 1), cB + hstep, voffB); PG8_STAGE(PG8_SA(0, 1), cA + hstep, voffA);
        if (wr == 1) PG8_BAR;
        PG8_WAIT_V(4); PG8_BAR;
        PG8_STAGE(PG8_SB(1, 0), cB + kstep, voffB); PG8_STAGE(PG8_SA(1, 0), cA + kstep, voffA); PG8_STAGE(PG8_SB(1, 1), cB + hstep + kstep, voffB);
        PG8_WAIT_V(6); PG8_BAR;
    }
    for (;;) {
        const bool has_next = S.next(ui + 1, nxt);
        const char* nA = has_next ? (const char*)g.A + (size_t)nxt.pm * tstep : cA; const char* nB = has_next ? (const char*)g.Bt + (size_t)nxt.pn * tstep : cB;
        for (int t = 0; t < nt; t += 2) {
            const bool last = (t == nt - 2);
            const char* a1 = cA + (size_t)(t + 1) * kstep;
            const char* a2 = last ? nA : cA + (size_t)(t + 2) * kstep; const char* b2 = last ? nB : cB + (size_t)(t + 2) * kstep;
            const char* a3 = a2 + kstep; const char* b3 = b2 + kstep;
            if (last && has_next) S.a_ready(nxt);
            if constexpr (SP2) {
            PG8_LDB(B0, 0, 0); PG8_LDB(B1, 0, 1); PG8_SCHED; PG8_LDA(At, 0, 0); PG8_STAGE(PG8_SA(1, 1), a1 + hstep, voffA);
            PG8_WAIT_V(8); PG8_WAIT_L(0); PG8_BAR; PG8_MMA(0, 0, At, B0); PG8_MMA(0, 1, At, B1); PG8_BAR; PG8_SCHED;
            PG8_LDA(At, 0, 1); PG8_STAGE(PG8_SB(0, 0), b2, voffB); PG8_STAGE(PG8_SB(0, 1), b2 + hstep, voffB); PG8_STAGE(PG8_SA(0, 0), a2, voffA);
            PG8_WAIT_V(8); PG8_WAIT_L(0); PG8_BAR; PG8_MMA(1, 0, At, B0); PG8_MMA(1, 1, At, B1); PG8_BAR; PG8_SCHED;
            PG8_LDB(B0, 1, 0); PG8_LDB(B1, 1, 1); PG8_SCHED; PG8_LDA(At, 1, 0); PG8_STAGE(PG8_SA(0, 1), a2 + hstep, voffA);
            PG8_WAIT_V(8); PG8_WAIT_L(0); PG8_BAR; PG8_MMA(0, 0, At, B0); PG8_MMA(0, 1, At, B1); PG8_BAR; PG8_SCHED;
            PG8_LDA(At, 1, 1); PG8_STAGE(PG8_SB(1, 0), b3, voffB); PG8_STAGE(PG8_SB(1, 1), b3 + hstep, voffB); PG8_STAGE(PG8_SA(1, 0), a3, voffA);
            PG8_WAIT_V(8); PG8_WAIT_L(0); PG8_BAR; PG8_MMA(1, 0, At, B0); PG8_MMA(1, 1, At, B1); PG8_BAR; PG8_SCHED;
            } else {
            PG8_LDB(B0, 0, 0); PG8_SCHED; PG8_LDA(At, 0, 0); PG8_STAGE(PG8_SA(1, 1), a1 + hstep, voffA);
            PG8_WAIT_L(8); PG8_BAR; PG8_WAIT_L(0); PG8_MMA(0, 0, At, B0); PG8_BAR; PG8_SCHED;
            PG8_LDB(B1, 0, 1); PG8_STAGE(PG8_SB(0, 0), b2, voffB);
            PG8_BAR; PG8_WAIT_L(0); PG8_MMA(0, 1, At, B1); PG8_BAR;
            PG8_LDA(At, 0, 1); PG8_STAGE(PG8_SA(0, 0), a2, voffA);
            PG8_BAR; PG8_WAIT_L(0); PG8_MMA(1, 0, At, B0); PG8_BAR; PG8_SCHED;
            PG8_STAGE(PG8_SB(0, 1), b2 + hstep, voffB);
            PG8_WAIT_V(6); PG8_BAR; PG8_MMA(1, 1, At, B1); PG8_BAR;
            PG8_LDB(B0, 1, 0); PG8_SCHED; PG8_LDA(At, 1, 0); PG8_STAGE(PG8_SA(0, 1), a2 + hstep, voffA);
            PG8_WAIT_L(8); PG8_BAR; PG8_WAIT_L(0); PG8_MMA(0, 0, At, B0); PG8_BAR; PG8_SCHED;
            PG8_LDB(B1, 1, 1); PG8_STAGE(PG8_SB(1, 0), b3, voffB);
            PG8_BAR; PG8_WAIT_L(0); PG8_MMA(0, 1, At, B1); PG8_BAR;
            PG8_LDA(At, 1, 1); PG8_STAGE(PG8_SA(1, 0), a3, voffA);
            PG8_BAR; PG8_WAIT_L(0); PG8_MMA(1, 0, At, B0); PG8_BAR; PG8_SCHED;
            PG8_STAGE(PG8_SB(1, 1), b3 + hstep, voffB);
            PG8_WAIT_V(6); PG8_BAR; PG8_MMA(1, 1, At, B1); PG8_BAR;
            }
        }
        if constexpr (ALIGN_EPI) { if (wr == 0) PG8_BAR; }
        if constexpr (!Epi::AFTER_DRAIN) { E(acc, cur, wr, wc, fr, fq); S.done(cur); }
        if (!has_next) break;
#pragma unroll
        for (int a = 0; a < 2; ++a)
#pragma unroll
            for (int b = 0; b < 2; ++b)
#pragma unroll
                for (int m = 0; m < 4; ++m)
#pragma unroll
                    for (int n = 0; n < 2; ++n) acc[a][b][m][n] = (f32x4){0.f, 0.f, 0.f, 0.f};
        cur = nxt; cA = nA; cB = nB; ++ui;
        if constexpr (ALIGN_EPI) { if (wr == 1) PG8_BAR; }
    }
    PG8_WAIT_V(0);
    if constexpr (!ALIGN_EPI) { if (wr == 0) PG8_BAR; }
    PG8_BAR;
    if constexpr (Epi::AFTER_DRAIN) { E.fused(acc, cur, wr, wc, fr, fq, lds, wid, lane); S.done(cur); }
#undef PG8_SA
#undef PG8_SB
#undef PG8_STAGE
#undef PG8_LDA
#undef PG8_LDB
#undef PG8_MMA
#undef PG8_WAIT_V
#undef PG8_WAIT_L
#undef PG8_BAR
#undef PG8_SCHED
}
}
#define GAS __attribute__((address_space(1)))
#define LAS __attribute__((address_space(3)))
typedef unsigned short bf16;
typedef unsigned v4u __attribute__((ext_vector_type(4)));
typedef float f32x4 __attribute__((ext_vector_type(4)));
typedef short bf16x8 __attribute__((ext_vector_type(8)));
typedef GAS unsigned gu32;
typedef GAS unsigned long long gu64;
#define RLX_AGENT __ATOMIC_RELAXED, __HIP_MEMORY_SCOPE_AGENT
#define LDS_WAIT() asm volatile("s_waitcnt lgkmcnt(0)" ::: "memory")
#define VM_WAIT() asm volatile("s_waitcnt vmcnt(0)" ::: "memory")
__device__ __forceinline__ unsigned long long rt() { return __builtin_amdgcn_s_memrealtime(); }
__device__ __forceinline__ unsigned f2bf(float f) { unsigned u = __builtin_bit_cast(unsigned, f); return (u + 0x7fffu + ((u >> 16) & 1u)) >> 16; }
__device__ __forceinline__ unsigned pk2(float lo, float hi) { return f2bf(lo) | (f2bf(hi) << 16); }
#define XB_TMO      128
#define XB_XCNT(j)  (256  + 64 * (j))
#define XB_XSUB(j)  (1280 + 64 * (j))
#define XB_XGEN(j)  (2304 + 64 * (j))
#define XB_TOP      3328
#define XB_TOPGEN   3392
#define XCD_BAR_WORDS 3456
#define XB_SPIN_CAP (1u << 18)

__device__ __forceinline__ unsigned xb_ld(unsigned* p)              { return __hip_atomic_load(p, __ATOMIC_RELAXED, __HIP_MEMORY_SCOPE_AGENT); }
__device__ __forceinline__ unsigned xb_add(unsigned* p, unsigned v) { return __hip_atomic_fetch_add(p, v, __ATOMIC_RELAXED, __HIP_MEMORY_SCOPE_AGENT); }
__device__ __forceinline__ unsigned xb_xcc_id() { return (unsigned)__builtin_amdgcn_s_getreg((3 << 11) | 20) & 0xFu; }
#define XB_SPIN(cond, bar) do { unsigned _sp = 0; while (cond) { __builtin_amdgcn_s_sleep(1); \
    if ((++_sp & 255u) == 0u) { if (xb_ld(&(bar)[XB_TMO])) break; if (_sp > XB_SPIN_CAP) { atomicAdd(&(bar)[XB_TMO], 1u); break; } } } } while (0)

struct XcdBarrier {
    unsigned* bar; unsigned x;
    volatile LAS unsigned* st;
};

__device__ __forceinline__ XcdBarrier xcd_barrier_post(unsigned* bar, volatile LAS unsigned* st) {
    XcdBarrier b; b.bar = bar; b.x = xb_xcc_id(); b.st = st;
    if (threadIdx.x == 0) (void)xb_add(&bar[XB_XCNT(b.x)], 1u);
    return b;
}
__device__ __forceinline__ void xcd_barrier_complete(unsigned* bar, unsigned x, unsigned& nloc, unsigned& nx) {
    const unsigned G = gridDim.x * gridDim.y * gridDim.z;
    unsigned sum, cnt, mine, sp = 0u;
    for (;;) {
        sum = 0u; cnt = 0u; mine = 0u;
#pragma unroll
        for (unsigned j = 0; j < 16; ++j) { const unsigned c = xb_ld(&bar[XB_XCNT(j)]); sum += c; cnt += (c > 0u) ? 1u : 0u; mine = (j == x) ? c : mine; }
        if (sum == G) break;
        __builtin_amdgcn_s_sleep(1);
        if ((++sp & 255u) == 0u) { if (xb_ld(&bar[XB_TMO])) break; if (sp > XB_SPIN_CAP) { atomicAdd(&bar[XB_TMO], 1u); break; } }
    }
    nloc = mine > 0u ? mine : 1u; nx = cnt > 0u ? cnt : 1u;
}

__device__ __forceinline__ void xcd_barrier(const XcdBarrier& b) {
    asm volatile("s_waitcnt vmcnt(0)" ::: "memory");
    __syncthreads();
    if (threadIdx.x == 0) {
        unsigned* bar = b.bar;
        __builtin_amdgcn_s_waitcnt(0);
        unsigned nloc = b.st[0], nx = b.st[1];
        if (nloc == 0u) { xcd_barrier_complete(bar, b.x, nloc, nx); b.st[0] = nloc; b.st[1] = nx; }
        const unsigned old = xb_add(&bar[XB_XSUB(b.x)], 1u);
        const unsigned gen = old / nloc;
        if (old + 1u == (gen + 1u) * nloc) {
            __builtin_amdgcn_fence(__ATOMIC_RELEASE, "agent");
            asm volatile("s_waitcnt vmcnt(0)" ::: "memory");
            const unsigned og = xb_add(&bar[XB_TOP], 1u);
            const unsigned tg = og / nx;
            if (og + 1u == (tg + 1u) * nx) xb_add(&bar[XB_TOPGEN], 1u);
            else XB_SPIN(xb_ld(&bar[XB_TOPGEN]) == tg, bar);
            __builtin_amdgcn_fence(__ATOMIC_ACQUIRE, "agent");
            xb_add(&bar[XB_XGEN(b.x)], 1u);
            asm volatile("s_waitcnt vmcnt(0)" ::: "memory");
        } else {
            XB_SPIN(xb_ld(&bar[XB_XGEN(b.x)]) == gen, bar);
            __builtin_amdgcn_fence(__ATOMIC_ACQUIRE, "agent");
            asm volatile("s_waitcnt vmcnt(0)" ::: "memory");
        }
    }
    __syncthreads();
}
constexpr int NWAVES = 8, NTHR = 512;
constexpr int D = 1024, MP = 16384, NSB = 16, SSEQ = 16, MS = NSB * SSEQ, M = MP + MS;
constexpr int NIN = 3076, NPROJ = 3072, DFF = 2816, NGU = 2 * DFF;
constexpr int NCHP = 256, NCH = NCHP + NSB;
constexpr int PC_Q = 0, PC_K = 256, PC_V = 512, PC_Z = 768, PC_X = 1024, PC_B = 1280, PC_C = 1536, PC_CQ = 1792, PC_CF = 2048, PC_CI = 2304, PC_CG = 2560, PC_DX = 2816;
constexpr float EPS = 1e-6f;
enum { I_XP = 0, I_XS, I_CK, I_CV, I_SCONV, I_SSSM, I_SHGRN, I_SPOOL, I_N1, I_WIN, I_AREL, I_CW, I_CB, I_DTB, I_ALOG, I_BD, I_BNRM, I_LB, I_CNRM, I_PW, I_PS, I_WOUT, I_N2, I_WGU, I_WDN, I_NF, N_IN };
constexpr size_t O_YP = 0, O_YS = O_YP + (size_t)MP * D, O_PK = O_YS + (size_t)MS * D, O_PV = O_PK + 2 * 512 * 256, O_PCONV = O_PV + 2 * 512 * 256, O_PSSM = O_PCONV + 2 * 3 * 768,
                 O_PHGRN = O_PSSM + 2 * 4 * 64 * 128, O_PPOOL = O_PHGRN + 2 * 4 * 64 * 64, O_SK = O_PPOOL + 2 * 15 * 256, O_SV = O_SK + (size_t)2 * 16 * 512 * 256,
                 O_SCONV = O_SV + (size_t)2 * 16 * 512 * 256, O_SSSM = O_SCONV + 2 * 16 * 3 * 768, O_SHGRN = O_SSSM + 2 * 16 * 4 * 64 * 128, O_SPOOL = O_SHGRN + 2 * 16 * 4 * 64 * 64,
                 O_END = O_SPOOL + 2 * 16 * 15 * 256;
constexpr size_t MiB = 1u << 20;
constexpr size_t WS_CTL = 0, CTL_ZERO_BYTES = 64 * 1024;
constexpr size_t WL_IN = 0, WL_OUT = 6 * MiB, WL_GU = 8 * MiB, WL_DN = 19 * MiB, WL_STRIDE = 24 * MiB + MiB / 2;
constexpr size_t WS_W = 1 * MiB;
constexpr size_t WS_XN = 50 * MiB;
constexpr size_t WS_PROJ = 83 * MiB;
constexpr size_t WS_STB = 181 * MiB;
constexpr size_t WS_XT = 198 * MiB;
constexpr size_t WS_HALO = 207 * MiB;
constexpr size_t WS_RH = 208 * MiB + MiB / 2;
constexpr size_t WS_STC = 215 * MiB;
constexpr size_t WS_VT = 223 * MiB + MiB / 2;
constexpr size_t WS_DT = 232 * MiB;
constexpr size_t WS_DECB = 233 * MiB;
constexpr size_t WS_DECC = 233 * MiB + 64 * 1024;
constexpr size_t WS_ACS = 233 * MiB + 384 * 1024, WS_DTV = 233 * MiB + 704 * 1024;
constexpr size_t WS_VTA = 234 * MiB;
constexpr size_t WS_END = 243 * MiB;
static_assert(WS_VTA + (size_t)256 * M * 2 <= WS_END, "ws map 2");
constexpr int CW_QUEUE = 512;
static_assert(WS_XN + (size_t)M * D * 2 <= WS_PROJ && WS_PROJ + (size_t)M * NPROJ * 2 <= WS_STB && WS_STB + (size_t)NCH * 4 * 64 * 128 * 2 <= WS_XT && WS_XT + (size_t)NCH * 256 * 64 * 2 <= WS_HALO && WS_HALO + (size_t)256 * 3 * 768 * 2 <= WS_STC && WS_RH + (size_t)NCH * 1280 * 4 <= WS_STC && WS_STC + (size_t)NCH * 4 * 64 * 64 * 2 <= WS_VT && WS_VT + (size_t)NCH * 256 * 64 * 2 <= WS_DT, "ws map");
static_assert(WL_DN + (size_t)D * DFF * 2 <= WL_STRIDE && WS_W + 2 * WL_STRIDE <= WS_XN, "weight map");
constexpr size_t WS_WPT = 128 * 1024;
constexpr int CW_BAR = 1024;
constexpr int LDS_BYTES = 163840;
constexpr int MISC_OFF = LDS_BYTES - 256;
constexpr int RING_OFF = 0;
typedef LAS float lf32;
typedef float f32x2 __attribute__((ext_vector_type(2)));
struct Args { const float* in[N_IN]; float* out; unsigned char* ws; };
struct Frame {
    LAS unsigned char* lds;
    float* out; unsigned char* ws;
};
__device__ __forceinline__ float* inp(int i) { asm volatile("" : "+s"(i)); return ((float* const __attribute__((address_space(4)))*)__builtin_amdgcn_kernarg_segment_ptr())[i]; }
__device__ __forceinline__ unsigned char* opq(unsigned char* p) { asm volatile("" : "+s"(p)); return p; }
#define ITEM_IDS() int tid_ = threadIdx.x; asm volatile("" : "+v"(tid_)); const int wave_ = __builtin_amdgcn_readfirstlane(tid_ >> 6); const int lane_ = tid_ & 63; (void)lane_; (void)wave_
#define F_XN ((bf16*)opq(F.ws + WS_XN))
#define F_PROJ ((bf16*)opq(F.ws + WS_PROJ))
#define F_ACT ((bf16*)opq(F.ws + WS_PROJ))
#define F_STB ((bf16*)opq(F.ws + WS_STB))
#define F_XT ((bf16*)opq(F.ws + WS_XT))
#define F_HALO ((bf16*)opq(F.ws + WS_HALO))
#define F_ACS ((float*)opq(F.ws + WS_ACS))
#define F_DTV ((float*)opq(F.ws + WS_DTV))
#define F_STC ((bf16*)opq(F.ws + WS_STC))
#define F_VT ((bf16*)opq(F.ws + WS_VT))
#define F_RH ((float*)opq(F.ws + WS_RH))
#define F_VTA ((bf16*)opq(F.ws + WS_VTA))
#define F_WPT ((bf16*)opq(F.ws + WS_WPT))
#define F_DT ((float*)opq(F.ws + WS_DT))
#define F_DECB ((float*)opq(F.ws + WS_DECB))
#define F_DECC ((float*)opq(F.ws + WS_DECC))
#define F_X    (F.out)
__device__ __forceinline__ float bf_lo(unsigned w) { return __builtin_bit_cast(float, w << 16); }
__device__ __forceinline__ float bf_hi(unsigned w) { return __builtin_bit_cast(float, w & 0xffff0000u); }
__device__ __forceinline__ float bf1(bf16 b) { return __builtin_bit_cast(float, (unsigned)b << 16); }
__device__ __forceinline__ void unpack8(const v4u w, float (&v)[8]) { v[0] = bf_lo(w.x); v[1] = bf_hi(w.x); v[2] = bf_lo(w.y); v[3] = bf_hi(w.y); v[4] = bf_lo(w.z); v[5] = bf_hi(w.z); v[6] = bf_lo(w.w); v[7] = bf_hi(w.w); }
__device__ __forceinline__ v4u pack8(const float (&v)[8]) { v4u o; o.x = pk2(v[0], v[1]); o.y = pk2(v[2], v[3]); o.z = pk2(v[4], v[5]); o.w = pk2(v[6], v[7]); return o; }
__device__ __forceinline__ float shx(int lane, float v, int o) { return __builtin_bit_cast(float, __builtin_amdgcn_ds_bpermute((lane ^ o) << 2, __builtin_bit_cast(int, v))); }
__device__ __forceinline__ float shu(int lane, float v, int o) { return __builtin_bit_cast(float, __builtin_amdgcn_ds_bpermute((lane - o) << 2, __builtin_bit_cast(int, v))); }
__device__ __forceinline__ float shi(float v, int idx) { return __builtin_bit_cast(float, __builtin_amdgcn_ds_bpermute(idx << 2, __builtin_bit_cast(int, v))); }
__device__ __forceinline__ float wave_sum_l(int lane, float v) {
#pragma unroll
    for (int o = 1; o < 64; o <<= 1) v += shx(lane, v, o);
    return v;
}
__device__ __forceinline__ float sum16_l(int lane, float v) {
#pragma unroll
    for (int o = 1; o < 16; o <<= 1) v += shx(lane, v, o);
    return v;
}
__device__ __forceinline__ float max16_l(int lane, float v) {
#pragma unroll
    for (int o = 1; o < 16; o <<= 1) v = fmaxf(v, shx(lane, v, o));
    return v;
}
__device__ __forceinline__ float rcp_f(float x) { return __builtin_amdgcn_rcpf(x); }
__device__ __forceinline__ float rsq_f(float x) { return __builtin_amdgcn_rsqf(x); }
__device__ __forceinline__ float sigmoid_f(float x) { return rcp_f(1.0f + __expf(-x)); }
__device__ __forceinline__ float silu_g(float x) { return x * rcp_f(1.0f + __expf(-x)); }
__device__ __forceinline__ float softplus_f(float x) { const float e = __expf(x); return x > 20.f ? x : (e < 0.01f ? e * (1.0f - e * (0.5f - e * (1.0f / 3.0f))) : __logf(1.0f + e)); }
__device__ __forceinline__ f32x4 mfma4(float a, float b, f32x4 c) { return __builtin_amdgcn_mfma_f32_16x16x4f32(a, b, c, 0, 0, 0); }

struct Chunk { int ci, row0, nrows, b; };
__device__ __forceinline__ Chunk chunk_of(int ci) { Chunk c; c.ci = ci; if (ci < NCHP) { c.row0 = 64 * ci; c.nrows = 64; c.b = -1; } else { c.b = ci - NCHP; c.row0 = MP + SSEQ * c.b; c.nrows = SSEQ; } return c; }

__device__ __forceinline__ void tr_item(const float* W, int ldw, int K, bf16* WT, int k0, int nd0, int ns0, float scale, lf32* scr, int lane) {
    float wv_[32];
#pragma unroll
    for (int i = 0; i < 32; ++i) wv_[i] = W[(size_t)(k0 + 2 * i + (lane >> 5)) * ldw + ns0 + (lane & 31)];
#pragma unroll
    for (int i = 0; i < 32; ++i) scr[(2 * i + (lane >> 5)) * 33 + (lane & 31)] = wv_[i];
    LDS_WAIT(); asm volatile("" ::: "memory");
    const int c = lane & 7;
#pragma unroll
    for (int j = 0; j < 4; ++j) { const int n = (lane >> 3) + 8 * j; const lf32* s = scr + (8 * c) * 33 + n;
        v4u o; o.x = pk2(s[0 * 33] * scale, s[1 * 33] * scale); o.y = pk2(s[2 * 33] * scale, s[3 * 33] * scale); o.z = pk2(s[4 * 33] * scale, s[5 * 33] * scale); o.w = pk2(s[6 * 33] * scale, s[7 * 33] * scale);
        *(GAS v4u*)(WT + (size_t)(nd0 + n) * K + k0 + 8 * c) = o; }
    LDS_WAIT(); asm volatile("" ::: "memory");
}
__device__ __forceinline__ void p0_weights(Frame& F, int l, int gw, int NGW, bool pool) {
    ITEM_IDS();
    lf32* scr = (lf32*)(F.lds + wave_ * 16384);
    constexpr int I_IN = 16 * 96, I_OUT = 16 * 32, I_GU = 16 * 176, I_DN = 44 * 32, I_L = I_IN + I_OUT + I_GU + I_DN;
    for (int it = gw; it < I_L; it += NGW) {
        int r = it;
        unsigned char* wl = F.ws + WS_W + (size_t)l * WL_STRIDE;
        if (r < I_IN) { const int kb = r / 96, nb = r % 96, nd0 = 32 * nb; tr_item(inp(I_WIN) + (size_t)l * D * NIN, NIN, D, (bf16*)(wl + WL_IN), 64 * kb, nd0, nd0 < 1792 ? nd0 : nd0 + 4, nd0 < 256 ? 0.125f : 1.0f, scr, lane_); continue; } r -= I_IN;
        if (r < I_OUT) { const int kb = r / 32, nb = r % 32; tr_item(inp(I_WOUT) + (size_t)l * D * D, D, D, (bf16*)(wl + WL_OUT), 64 * kb, 32 * nb, 32 * nb, 1.0f, scr, lane_); continue; } r -= I_OUT;
        if (r < I_GU) { const int kb = r / 176, nb = r % 176, nd0 = 32 * nb, pn = nd0 >> 8, bj = (nd0 >> 7) & 1, c = nd0 & 127; tr_item(inp(I_WGU) + (size_t)l * D * NGU, NGU, D, (bf16*)(wl + WL_GU), 64 * kb, nd0, bj * DFF + 128 * pn + c, 1.0f, scr, lane_); continue; } r -= I_GU;
        { const int kb = r / 32, nb = r % 32; tr_item(inp(I_WDN) + (size_t)l * DFF * D, D, DFF, (bf16*)(wl + WL_DN), 64 * kb, 32 * nb, 32 * nb, 1.0f, scr, lane_); }
    }
    if (pool) { const float* pw = inp(I_PW); for (int i = ((int)blockIdx.x) * NTHR + tid_; i < 2 * 4 * 64 * 64; i += ((int)gridDim.x) * NTHR) { const int c = i & 63, d = (i >> 6) & 63, lg = i >> 12; F_WPT[i] = (bf16)f2bf(pw[(size_t)(lg * 64 + c) * 64 + d]); } }
}
template <bool WITH_DT, bool FINAL>
__device__ __forceinline__ void norm_rows(Frame& F, const float* xlo, const float* xhi, const float* w, const float* wdt  ) {
    ITEM_IDS();
    lf32* wl = (lf32*)F.lds;
    if (WITH_DT) { for (int k = tid_; k < D; k += NTHR) { const f32x4 v = *(const f32x4*)(wdt + (size_t)k * NIN + 1792); *(LAS f32x4*)(wl + 4 * k) = v; } __syncthreads(); }
    const int gw = ((int)blockIdx.x) * NWAVES + wave_, NGW = ((int)gridDim.x) * NWAVES;
    f32x4 wv[4];
#pragma unroll
    for (int j = 0; j < 4; ++j) wv[j] = *(const f32x4*)(w + 256 * j + 4 * lane_);
    for (int m0 = gw; m0 < M; m0 += 4 * NGW) {
        f32x4 v[4][4];
#pragma unroll
        for (int q = 0; q < 4; ++q) { const int m = m0 + q * NGW; if (m < M) { const float* xr = (m < MP ? xlo : xhi) + (size_t)m * D;
#pragma unroll
            for (int j = 0; j < 4; ++j) v[q][j] = *(const f32x4*)(xr + 256 * j + 4 * lane_); } }
#pragma unroll
        for (int q = 0; q < 4; ++q) { const int m = m0 + q * NGW; if (m < M) {
            float s = 0.f;
#pragma unroll
            for (int j = 0; j < 4; ++j) s += (v[q][j].x * v[q][j].x + v[q][j].y * v[q][j].y) + (v[q][j].z * v[q][j].z + v[q][j].w * v[q][j].w);
            const float rstd = rsq_f(wave_sum_l(lane_, s) * (1.0f / D) + EPS);
#pragma unroll
            for (int j = 0; j < 4; ++j) v[q][j] = v[q][j] * rstd * wv[j];
            if (FINAL) {
#pragma unroll
                for (int j = 0; j < 4; ++j) *(f32x4*)(F.out + (size_t)m * D + 256 * j + 4 * lane_) = v[q][j];
            } else {
                GAS unsigned long long* o8 = (GAS unsigned long long*)(F_XN + (size_t)m * D) + lane_;
#pragma unroll
                for (int j = 0; j < 4; ++j) o8[64 * j] = (unsigned long long)pk2(v[q][j].x, v[q][j].y) | ((unsigned long long)pk2(v[q][j].z, v[q][j].w) << 32);
            }
            if (WITH_DT) {
                f32x4 a = {0.f, 0.f, 0.f, 0.f};
#pragma unroll
                for (int j = 0; j < 4; ++j) { const LAS f32x4* wp = (const LAS f32x4*)(wl + 4 * (256 * j + 4 * lane_));
                    a += wp[0] * v[q][j].x; a += wp[1] * v[q][j].y; a += wp[2] * v[q][j].z; a += wp[3] * v[q][j].w; }
                a.x = wave_sum_l(lane_, a.x); a.y = wave_sum_l(lane_, a.y); a.z = wave_sum_l(lane_, a.z); a.w = wave_sum_l(lane_, a.w);
                if (lane_ == 0) *(f32x4*)(F_DT + (size_t)m * 4) = a;
            } } }
    }
    if (WITH_DT) __syncthreads();
}
constexpr int PL_RAW = 0, PL_PL = 79 * 256 * 4, PL_END = PL_PL + 64 * 264 * 2;
static_assert(PL_END <= MISC_OFF, "pool LDS map");
__device__ __forceinline__ void pool_item(Frame& F, int layer, int ci) {
    ITEM_IDS();
    const Chunk c = chunk_of(ci);
    lf32* raw = (lf32*)(F.lds + PL_RAW);
    LAS bf16* Pl = (LAS bf16*)(F.lds + PL_PL);
    const float* spool = inp(I_SPOOL) + (size_t)(layer * NSB + (c.b < 0 ? 0 : c.b)) * 15 * 256;
    v4u pw[5]; f32x4 pf[5][2];
#pragma unroll
    for (int q = 0; q < 5; ++q) { const int it = tid_ + q * NTHR; pw[q] = (v4u){0u, 0u, 0u, 0u}; pf[q][0] = (f32x4){0.f, 0.f, 0.f, 0.f}; pf[q][1] = pf[q][0];
        if (it < 79 * 32) { const int rr = it >> 5, cg = it & 31, r = rr - 15;
            if (r < c.nrows) { if (r >= 0 || (c.b < 0 && c.row0 + r >= 0)) pw[q] = *(const v4u*)(F_PROJ + (size_t)(c.row0 + r) * NPROJ + PC_DX + 8 * cg);
                               else if (c.b >= 0) { const float* s = spool + (size_t)(15 + r) * 256 + 8 * cg; pf[q][0] = *(const f32x4*)s; pf[q][1] = *(const f32x4*)(s + 4); } } } }
#pragma unroll
    for (int q = 0; q < 5; ++q) { const int it = tid_ + q * NTHR;
        if (it < 79 * 32) { const int rr = it >> 5, cg = it & 31, r = rr - 15; float v[8];
            if (c.b >= 0 && r < 0) { v[0] = pf[q][0].x; v[1] = pf[q][0].y; v[2] = pf[q][0].z; v[3] = pf[q][0].w; v[4] = pf[q][1].x; v[5] = pf[q][1].y; v[6] = pf[q][1].z; v[7] = pf[q][1].w; } else unpack8(pw[q], v);
            *(LAS f32x4*)(raw + rr * 256 + 8 * cg) = (f32x4){v[0], v[1], v[2], v[3]}; *(LAS f32x4*)(raw + rr * 256 + 8 * cg + 4) = (f32x4){v[4], v[5], v[6], v[7]}; } }
    __syncthreads();
    { const int ch = tid_ & 255, half = tid_ >> 8, win = 2 << (ch >> 6); const float inv = 1.0f / (float)win;
      for (int r = 32 * half; r < 32 * half + 32; ++r) { float s = 0.f; for (int q = 0; q < win; ++q) s += raw[(r + 15 - q) * 256 + ch]; Pl[r * 264 + ch] = (bf16)f2bf(s * inv - raw[(r + 15) * 256 + ch]); } }
    __syncthreads();
    const int tb = wave_ >> 1, g0 = 2 * (wave_ & 1), kq = lane_ >> 4, fr = lane_ & 15;
    const bf16* wt = F_WPT + (size_t)layer * 4 * 64 * 64; const float* sc = inp(I_PS) + (size_t)layer * 256;
#pragma unroll
    for (int gg = 0; gg < 2; ++gg) {
        const int g = g0 + gg;
        bf16x8 bw[4][2];
#pragma unroll
        for (int t = 0; t < 4; ++t)
#pragma unroll
            for (int ks = 0; ks < 2; ++ks) bw[t][ks] = *(const bf16x8*)(wt + (size_t)(g * 64 + t * 16 + fr) * 64 + 32 * ks + 8 * kq);
        bf16x8 a[2];
#pragma unroll
        for (int ks = 0; ks < 2; ++ks) a[ks] = *(const LAS bf16x8*)(Pl + (tb * 16 + fr) * 264 + g * 64 + 32 * ks + 8 * kq);
#pragma unroll
        for (int t = 0; t < 4; ++t) { f32x4 acc = {0.f, 0.f, 0.f, 0.f};
#pragma unroll
            for (int ks = 0; ks < 2; ++ks) acc = __builtin_amdgcn_mfma_f32_16x16x32_bf16(a[ks], bw[t][ks], acc, 0, 0, 0);
            const float s = sc[g * 64 + t * 16 + fr];
#pragma unroll
            for (int r = 0; r < 4; ++r) { const int row = tb * 16 + 4 * kq + r; if (row < c.nrows) F_XN[(size_t)(c.row0 + row) * D + 768 + g * 64 + t * 16 + fr] = (bf16)f2bf(acc[r] * s); } }
    }
    __syncthreads();
}

__device__ __forceinline__ void copy_cache(Frame& F, int layer, int b0, int nb) {
    ITEM_IDS();
    const int gt = b0 * NTHR + tid_, GT = nb * NTHR;
    float* out = F.out; const float* ckp = inp(I_CK); const float* cvp = inp(I_CV);
    for (int base = gt; base < 32 * 31744; base += 8 * GT) {
        f32x4 v[8];
#pragma unroll
        for (int q = 0; q < 8; ++q) { const int i = base + q * GT; if (i < 32 * 31744) { const int wb = i / 31744, e = i - wb * 31744; const int which = wb >> 4, b = wb & 15;
            v[q] = *(const f32x4*)((which ? cvp : ckp) + ((size_t)(layer * NSB + b) * 512 + 16) * 256 + 4 * (size_t)e); } }
#pragma unroll
        for (int q = 0; q < 8; ++q) { const int i = base + q * GT; if (i < 32 * 31744) { const int wb = i / 31744, e = i - wb * 31744; const int which = wb >> 4, b = wb & 15;
            *(f32x4*)(out + (which ? O_SV : O_SK) + (size_t)(layer * NSB + b) * 512 * 256 + 4 * (size_t)e) = v[q]; } }
    }
}
__device__ __forceinline__ void copy_small(Frame& F, int layer, int b0, int nb) {
    ITEM_IDS();
    const int gt = b0 * NTHR + tid_, GT = nb * NTHR;
    float* out = F.out;
    constexpr int T_P = 2 * 512 * 32, T_S = 2 * 16 * 16 * 32, T_D = 17 * 15 * 32, T_ALL = T_P + T_S + T_D;
    for (int base = gt; base < T_ALL; base += 4 * GT) {
        v4u w[4];
#pragma unroll
        for (int q = 0; q < 4; ++q) { int t = base + q * GT; if (t < T_ALL) { size_t src;
            if (t < T_P) { const int which = t >> 14, j = (t >> 5) & 511, cg = t & 31; src = (size_t)(MP - 512 + j) * NPROJ + (which ? PC_V : PC_K) + 8 * cg; }
            else if (t < T_P + T_S) { t -= T_P; const int which = t >> 13, b = (t >> 9) & 15, j = (t >> 5) & 15, cg = t & 31; src = (size_t)(MP + 16 * b + j) * NPROJ + (which ? PC_V : PC_K) + 8 * cg; }
            else { t -= T_P + T_S; const int b = t / 480, rr = (t / 32) % 15, cg = t & 31; src = (size_t)(b == 0 ? MP - 15 + rr : MP + 16 * (b - 1) + 1 + rr) * NPROJ + PC_DX + 8 * cg; }
            w[q] = *(const v4u*)(F_PROJ + src); } }
#pragma unroll
        for (int q = 0; q < 4; ++q) { int t = base + q * GT; if (t < T_ALL) { size_t dst;
            if (t < T_P) { const int which = t >> 14, j = (t >> 5) & 511, cg = t & 31; dst = (which ? O_PV : O_PK) + (size_t)layer * 512 * 256 + j * 256 + 8 * cg; }
            else if (t < T_P + T_S) { t -= T_P; const int which = t >> 13, b = (t >> 9) & 15, j = (t >> 5) & 15, cg = t & 31; dst = (which ? O_SV : O_SK) + ((size_t)(layer * NSB + b) * 512 + 496 + j) * 256 + 8 * cg; }
            else { t -= T_P + T_S; const int b = t / 480, rr = (t / 32) % 15, cg = t & 31; dst = (b == 0 ? O_PPOOL + (size_t)layer * 3840 : O_SPOOL + (size_t)(layer * NSB + b - 1) * 3840) + rr * 256 + 8 * cg; }
            float v[8]; unpack8(w[q], v); *(f32x4*)(out + dst) = (f32x4){v[0], v[1], v[2], v[3]}; *(f32x4*)(out + dst + 4) = (f32x4){v[4], v[5], v[6], v[7]}; } }
    }
}
constexpr int KS_LD = 72, PS_LD = 584;
constexpr int AT_KS = 0, AT_VT = 576 * KS_LD * 2, AT_ST = AT_VT + 64 * PS_LD * 2, AT_BIAS = AT_ST + 1024;
static_assert(AT_BIAS + 4 * 260 * 4 <= MISC_OFF, "attention LDS map");
__device__ __forceinline__ void attn_bias_load(Frame& F, int layer) { const float* arel = inp(I_AREL) + (size_t)layer * 257 * 4; lf32* b = (lf32*)(F.lds + AT_BIAS); ITEM_IDS(); for (int i = tid_; i < 257 * 4; i += NTHR) b[260 * (i & 3) + (i >> 2)] = arel[i]; }
__device__ __forceinline__ void attn_item(Frame& F, int layer, int ci, int h) {
    ITEM_IDS();
    const Chunk c = chunk_of(ci);
    LAS bf16* Ks = (LAS bf16*)(F.lds + AT_KS); LAS bf16* Ps = Ks; LAS bf16* Vt = (LAS bf16*)(F.lds + AT_VT);
    lf32* mx = (lf32*)(F.lds + AT_ST); lf32* sm = mx + 128; lf32* bias = (lf32*)(F.lds + AT_BIAS) + 260 * h;
    const int jlo = (c.b < 0) ? (ci < 8 ? 64 * (8 - ci) : 0) : 0;
    const int jval = (c.b < 0) ? 576 : 528;
    const float* ckp = inp(I_CK); const float* cvp = inp(I_CV);
    bf16x8 qa0 = {0, 0, 0, 0, 0, 0, 0, 0}, qa1 = qa0;
    if (c.b < 0 || (wave_ >> 1) == 0) { const bf16* qp = F_PROJ + (size_t)(c.row0 + (wave_ >> 1) * 16 + (lane_ & 15)) * NPROJ + PC_Q + 64 * h + 8 * (lane_ >> 4); qa0 = *(const bf16x8*)qp; qa1 = *(const bf16x8*)(qp + 32); }
    if (c.b < 0) {
        const bf16* kg = F_PROJ + (long)(c.row0 - 512) * NPROJ + PC_K + 64 * h;
        const bf16* vg = F_VTA + (long)(64 * h) * M + (long)(c.row0 - 512);
        const int npc = (576 - jlo) >> 3, nk = (576 - jlo) * 8, nv = 64 * npc;
        v4u kr[9], vr[9];
#pragma unroll
        for (int q = 0; q < 9; ++q) { const int it = tid_ + q * NTHR;
            if (it < nk) kr[q] = *(const v4u*)(kg + (long)(jlo + (it >> 3)) * NPROJ + 8 * (it & 7));
            if (it < nv) { const int d = it / npc, pc = it - d * npc; vr[q] = *(const v4u*)(vg + (long)d * M + jlo + 8 * pc); } }
#pragma unroll
        for (int q = 0; q < 9; ++q) { const int it = tid_ + q * NTHR;
            if (it < nk) *(LAS v4u*)(Ks + (jlo + (it >> 3)) * KS_LD + 8 * (it & 7)) = kr[q];
            if (it < nv) { const int d = it / npc, pc = it - d * npc; *(LAS v4u*)(Vt + d * PS_LD + jlo + 8 * pc) = vr[q]; } }
    } else {
    for (int it = tid_; it < (576 - jlo) * 8; it += NTHR) {
        const int j = jlo + (it >> 3), dg = it & 7;
        v4u kw, vw;
        if (j < 512) { const size_t o = (((size_t)(layer * NSB + c.b) * 512 + j) * 4 + h) * 64 + 8 * dg; const float* kp = ckp + o; const float* vp = cvp + o;
            const f32x4 k0 = *(const f32x4*)kp, k1 = *(const f32x4*)(kp + 4), v0 = *(const f32x4*)vp, v1 = *(const f32x4*)(vp + 4);
            kw.x = pk2(k0.x, k0.y); kw.y = pk2(k0.z, k0.w); kw.z = pk2(k1.x, k1.y); kw.w = pk2(k1.z, k1.w); vw.x = pk2(v0.x, v0.y); vw.y = pk2(v0.z, v0.w); vw.z = pk2(v1.x, v1.y); vw.w = pk2(v1.z, v1.w); }
        else if (j < 528) { const size_t row = (size_t)(c.row0 + j - 512); kw = *(const v4u*)(F_PROJ + row * NPROJ + PC_K + 64 * h + 8 * dg); vw = *(const v4u*)(F_PROJ + row * NPROJ + PC_V + 64 * h + 8 * dg); }
        else { kw = (v4u){0u, 0u, 0u, 0u}; vw = kw; }
        *(LAS v4u*)(Ks + j * KS_LD + 8 * dg) = kw;
        LAS bf16* vt = Vt + (8 * dg) * PS_LD + j;
        vt[0 * PS_LD] = (bf16)(vw.x & 0xffffu); vt[1 * PS_LD] = (bf16)(vw.x >> 16); vt[2 * PS_LD] = (bf16)(vw.y & 0xffffu); vt[3 * PS_LD] = (bf16)(vw.y >> 16);
        vt[4 * PS_LD] = (bf16)(vw.z & 0xffffu); vt[5 * PS_LD] = (bf16)(vw.z >> 16); vt[6 * PS_LD] = (bf16)(vw.w & 0xffffu); vt[7 * PS_LD] = (bf16)(vw.w >> 16);
    }
    }
    __syncthreads();
    const int qb = wave_ >> 1, kh = wave_ & 1, kq = lane_ >> 4, fr = lane_ & 15;
    const bool active = (c.b < 0) || (qb == 0);
    const int ntw = (576 - jlo) / 32;
    const int kbase = jlo + kh * ntw * 16;
    f32x4 s[18];
    float mloc = -3.0e38f;
    const int iq = qb * 16 + fr;
    if (active) {
#pragma unroll
        for (int t = 0; t < 18; ++t) {
            s[t] = (f32x4){0.f, 0.f, 0.f, 0.f};
            if (t < ntw) {
                const LAS bf16* kp = Ks + (kbase + t * 16 + fr) * KS_LD + 8 * kq;
                const bf16x8 kb0 = *(const LAS bf16x8*)kp, kb1 = *(const LAS bf16x8*)(kp + 32);
                s[t] = __builtin_amdgcn_mfma_f32_16x16x32_bf16(kb0, qa0, s[t], 0, 0, 0);
                s[t] = __builtin_amdgcn_mfma_f32_16x16x32_bf16(kb1, qa1, s[t], 0, 0, 0);
#pragma unroll
                for (int r = 0; r < 4; ++r) { const int j = kbase + t * 16 + 4 * kq + r; int rel = 512 + iq - j; rel = rel > 128 ? 128 : rel; float v = s[t][r] + bias[rel + 128]; if (j >= jval) v = -1.0e30f; s[t][r] = v; mloc = fmaxf(mloc, v); }
            }
        }
        mloc = fmaxf(mloc, shx(lane_, mloc, 16)); mloc = fmaxf(mloc, shx(lane_, mloc, 32));
        if (kq == 0) mx[iq * 2 + kh] = mloc;
    }
    __syncthreads();
    if (active) {
        mloc = fmaxf(mx[iq * 2], mx[iq * 2 + 1]);
        float lsum = 0.f;
#pragma unroll
        for (int t = 0; t < 18; ++t) if (t < ntw) {
            const float p0 = __expf(s[t][0] - mloc), p1 = __expf(s[t][1] - mloc), p2 = __expf(s[t][2] - mloc), p3 = __expf(s[t][3] - mloc);
            lsum += (p0 + p1) + (p2 + p3);
            *(LAS f32x2*)(Ps + iq * PS_LD + kbase + t * 16 + 4 * kq) = __builtin_bit_cast(f32x2, (unsigned long long)pk2(p0, p1) | ((unsigned long long)pk2(p2, p3) << 32));
        }
        lsum += shx(lane_, lsum, 16); lsum += shx(lane_, lsum, 32);
        if (kq == 0) sm[iq * 2 + kh] = lsum;
    }
    __syncthreads();
    if (active) {
        f32x4 o[2] = {(f32x4){0.f, 0.f, 0.f, 0.f}, (f32x4){0.f, 0.f, 0.f, 0.f}};
        const int nks = (576 - jlo) / 32;
        for (int ks = 0; ks < nks; ++ks) {
            const int j0 = jlo + 32 * ks + 8 * kq;
            const bf16x8 pa = *(const LAS bf16x8*)(Ps + iq * PS_LD + j0);
#pragma unroll
            for (int t = 0; t < 2; ++t) { const bf16x8 vb = *(const LAS bf16x8*)(Vt + (kh * 32 + t * 16 + fr) * PS_LD + j0); o[t] = __builtin_amdgcn_mfma_f32_16x16x32_bf16(vb, pa, o[t], 0, 0, 0); }
        }
        const float inv = rcp_f(sm[iq * 2] + sm[iq * 2 + 1]);
#pragma unroll
        for (int t = 0; t < 2; ++t) *(f32x2*)(F_XN + (size_t)(c.row0 + iq) * D + 64 * h + kh * 32 + t * 16 + 4 * kq) =
            __builtin_bit_cast(f32x2, (unsigned long long)pk2(o[t][0] * inv, o[t][1] * inv) | ((unsigned long long)pk2(o[t][2] * inv, o[t][3] * inv) << 32));
    }
    __syncthreads();
}
__device__ __forceinline__ void scan_phase(Frame& F, int layer) {
    ITEM_IDS();
    lf32* db = (lf32*)F.lds; lf32* dcl = db + NCHP * 4;
    for (int i = tid_; i < NCHP * 4; i += NTHR) db[i] = F_DECB[i];
    __syncthreads();
    constexpr int NSCAN = 48;
    if (((int)blockIdx.x) < NSCAN) {
        for (int u = ((int)blockIdx.x) * NTHR + tid_; u < 24576; u += NSCAN * NTHR) {
            const bool isb = u < 16384; const int u2 = isb ? u : u - 16384;
            unsigned* st = isb ? (unsigned*)F_STB + u2 : (unsigned*)F_STC + u2; const size_t cs = isb ? 16384 : 8192;
            const int hk = (u2 >> 11) * 64 + 2 * (u2 & 31); const float* dg = F_DECC + hk; const int hb = u2 >> 12;
            float r0 = 0.f, r1 = 0.f;
            for (int c0 = 0; c0 < NCHP; c0 += 32) {
                unsigned sl[32]; f32x2 dd[32];
#pragma unroll
                for (int i = 0; i < 32; ++i) { sl[i] = st[(size_t)(c0 + i) * cs]; if (!isb) dd[i] = *(const f32x2*)(dg + (size_t)(c0 + i) * 256); }
#pragma unroll
                for (int i = 0; i < 32; ++i) { float d0, d1; if (isb) { d0 = db[(c0 + i) * 4 + hb]; d1 = d0; } else { d0 = dd[i].x; d1 = dd[i].y; }
                    st[(size_t)(c0 + i) * cs] = pk2(r0, r1); r0 = d0 * r0 + bf_lo(sl[i]); r1 = d1 * r1 + bf_hi(sl[i]); }
            }
            if (isb) *(f32x2*)(F.out + O_PSSM + (size_t)layer * 32768 + 2 * u2) = (f32x2){r0, r1};
            else { const int v = (u2 >> 5) & 63; float* o = F.out + O_PHGRN + (size_t)layer * 16384 + (size_t)hk * 64 + v; o[0] = r0; o[64] = r1; }
        }
    }
    else {
        const int nb = ((int)gridDim.x) - NSCAN, b0 = ((int)blockIdx.x) - NSCAN;
        for (int ci = b0; ci < NCH; ci += nb) pool_item(F, layer, ci);
        if (layer == 0) p0_weights(F, 1, b0 * NWAVES + wave_, nb * NWAVES, false);
        copy_cache(F, layer, b0, nb);
        copy_small(F, layer, b0, nb);
        const float* sssm = inp(I_SSSM) + (size_t)layer * NSB * 32768; const float* shgrn = inp(I_SHGRN) + (size_t)layer * NSB * 16384;
        float* osb = F.out + O_SSSM + (size_t)layer * NSB * 32768; float* osc = F.out + O_SHGRN + (size_t)layer * NSB * 16384;
        for (int t = b0 * NTHR + tid_; t < NSB * 8192; t += nb * NTHR) {
            const int b = t >> 13, e = (t & 8191) * 4; const f32x4 s0 = *(const f32x4*)(sssm + (size_t)b * 32768 + e); const unsigned long long w = *(const unsigned long long*)(F_STB + (size_t)(NCHP + b) * 32768 + e);
            const float d = F_DECB[(NCHP + b) * 4 + (e >> 13)];
            *(f32x4*)(osb + (size_t)b * 32768 + e) = (f32x4){d * s0.x + bf_lo((unsigned)w), d * s0.y + bf_hi((unsigned)w), d * s0.z + bf_lo((unsigned)(w >> 32)), d * s0.w + bf_hi((unsigned)(w >> 32))}; }
        for (int t = b0 * NTHR + tid_; t < NSB * 4096; t += nb * NTHR) {
            const int b = t >> 12, e2 = (t & 4095) * 4, hk = e2 >> 6, v = e2 & 63; const f32x4 s0 = *(const f32x4*)(shgrn + (size_t)b * 16384 + e2);
            const bf16* sp = F_STC + (size_t)(NCHP + b) * 16384 + (size_t)((hk >> 6) * 64 + v) * 64 + (hk & 63); const float d = F_DECC[(size_t)(NCHP + b) * 256 + hk];
            *(f32x4*)(osc + (size_t)b * 16384 + e2) = (f32x4){d * s0.x + bf1(sp[0]), d * s0.y + bf1(sp[64]), d * s0.z + bf1(sp[128]), d * s0.w + bf1(sp[192])}; }
    }
}
constexpr int SP_XT = 0, SP_BT = 256 * 72 * 2, SP_ACS = 2 * 256 * 72 * 2, SP_DTV = SP_ACS + 1024, SP_SJ = SP_DTV + 1024, SP_END = SP_SJ + 1024;
static_assert(SP_END <= MISC_OFF, "ssd_prep LDS map");
__device__ __forceinline__ void ssd_prep_item(Frame& F, int layer, int ci) {
    ITEM_IDS();
    const Chunk c = chunk_of(ci);
    LAS bf16* XTl = (LAS bf16*)(F.lds + SP_XT); LAS bf16* BTl = (LAS bf16*)(F.lds + SP_BT);
    lf32* acs = (lf32*)(F.lds + SP_ACS); lf32* dtv = (lf32*)(F.lds + SP_DTV); lf32* sj = (lf32*)(F.lds + SP_SJ);
    const int cg = tid_ % 96, seg = tid_ / 96, col = 8 * cg;
    const bool act = seg < 4 && 16 * seg < c.nrows;
    bf16* prow = F_PROJ + (size_t)c.row0 * NPROJ + PC_X + col;
    v4u raw[19];
    if (act) {
#pragma unroll
        for (int q = 0; q < 19; ++q) { const int r = 16 * seg - 3 + q;
            if (r >= 0) raw[q] = *(const v4u*)(prow + (size_t)r * NPROJ);
            else if (c.b < 0) { if (ci > 0) raw[q] = *(const v4u*)(F_HALO + ((size_t)(ci - 1) * 3 + (3 + r)) * 768 + col); else raw[q] = (v4u){0u, 0u, 0u, 0u}; }
            else { const float* s = inp(I_SCONV) + ((size_t)(layer * NSB + c.b) * 3 + (3 + r)) * 768 + col; const f32x4 a = *(const f32x4*)s, b2 = *(const f32x4*)(s + 4);
                raw[q].x = pk2(a.x, a.y); raw[q].y = pk2(a.z, a.w); raw[q].z = pk2(b2.x, b2.y); raw[q].w = pk2(b2.z, b2.w); } }
    }
    if (wave_ == 6) { const int r = lane_; const float* dtb = inp(I_DTB) + layer * 4; const float* alg = inp(I_ALOG) + layer * 4;
        f32x4 raw4 = {0.f, 0.f, 0.f, 0.f}; if (r < c.nrows) raw4 = *(const f32x4*)(F_DT + (size_t)(c.row0 + r) * 4);
        f32x4 dt4, ac4;
#pragma unroll
        for (int h = 0; h < 4; ++h) { float dt = 0.f; if (r < c.nrows) dt = softplus_f(raw4[h] + dtb[h]); float v = -__expf(alg[h]) * dt;
#pragma unroll
            for (int o = 1; o < 64; o <<= 1) { const float t = shu(lane_, v, o); if (lane_ >= o) v += t; }
            const float last = shi(v, 63);
            dt4[h] = dt; ac4[h] = v; acs[r * 4 + h] = v; dtv[r * 4 + h] = dt; sj[h * 64 + r] = dt * __expf(last - v);
            if (r == 63) F_DECB[ci * 4 + h] = __expf(last); }
        if (r < c.nrows) { *(f32x4*)(F_DTV + (size_t)(c.row0 + r) * 4) = dt4; *(f32x4*)(F_ACS + (size_t)(c.row0 + r) * 4) = ac4; } }
    if (c.nrows < 64) { for (int i = tid_; i < 2 * 256 * 72 / 2; i += NTHR) ((LAS unsigned*)XTl)[i] = 0u; }
    asm volatile("s_waitcnt vmcnt(0)" ::: "memory");
    __syncthreads();
    if (act) {
        if (ci == NCHP - 1 && seg == 3) {
#pragma unroll
            for (int q = 0; q < 3; ++q) { float v[8]; unpack8(raw[16 + q], v); float* o = F.out + O_PCONV + (size_t)layer * 2304 + q * 768 + col;
                *(f32x4*)o = (f32x4){v[0], v[1], v[2], v[3]}; *(f32x4*)(o + 4) = (f32x4){v[4], v[5], v[6], v[7]}; } }
        if (c.b >= 0) {
#pragma unroll
            for (int q = 0; q < 3; ++q) { float v[8]; unpack8(raw[16 + q], v); float* o = F.out + O_SCONV + ((size_t)(layer * NSB + c.b) * 3 + q) * 768 + col;
                *(f32x4*)o = (f32x4){v[0], v[1], v[2], v[3]}; *(f32x4*)(o + 4) = (f32x4){v[4], v[5], v[6], v[7]}; } }
        const float* cw = inp(I_CW) + (size_t)layer * 4 * 768 + col; const float* cb = inp(I_CB) + (size_t)layer * 768 + col;
        LAS bf16* tl = (cg < 32) ? XTl + col * 72 : BTl + (col - 256) * 72;
#pragma unroll
        for (int hc = 0; hc < 2; ++hc) {
            float w0[4], w1[4], w2[4], w3[4], bb[4];
#pragma unroll
            for (int e = 0; e < 4; ++e) { bb[e] = cb[4 * hc + e]; w0[e] = cw[4 * hc + e]; w1[e] = cw[768 + 4 * hc + e]; w2[e] = cw[2 * 768 + 4 * hc + e]; w3[e] = cw[3 * 768 + 4 * hc + e]; }
#pragma unroll
            for (int i = 0; i < 16; i += 2) {
                float x[5][4];
#pragma unroll
                for (int q = 0; q < 5; ++q) { const unsigned ua = hc ? raw[i + q].z : raw[i + q].x, ub = hc ? raw[i + q].w : raw[i + q].y; x[q][0] = bf_lo(ua); x[q][1] = bf_hi(ua); x[q][2] = bf_lo(ub); x[q][3] = bf_hi(ub); }
                float ya[4], yb[4];
#pragma unroll
                for (int e = 0; e < 4; ++e) { ya[e] = silu_g(bb[e] + w0[e] * x[0][e] + w1[e] * x[1][e] + w2[e] * x[2][e] + w3[e] * x[3][e]); yb[e] = silu_g(bb[e] + w0[e] * x[1][e] + w1[e] * x[2][e] + w2[e] * x[3][e] + w3[e] * x[4][e]); }
                const int r = 16 * seg + i;
                *(unsigned long long*)(prow + (size_t)r * NPROJ + 4 * hc) = (unsigned long long)pk2(ya[0], ya[1]) | ((unsigned long long)pk2(ya[2], ya[3]) << 32);
                *(unsigned long long*)(prow + (size_t)(r + 1) * NPROJ + 4 * hc) = (unsigned long long)pk2(yb[0], yb[1]) | ((unsigned long long)pk2(yb[2], yb[3]) << 32);
                if (cg < 64) {
#pragma unroll
                    for (int e = 0; e < 4; ++e) *(LAS unsigned*)(tl + (4 * hc + e) * 72 + r) = pk2(ya[e], yb[e]); }
            }
        }
    }
    __syncthreads();
    { const int ch = tid_ >> 1, hf = tid_ & 1; bf16* dst = F_XT + ((size_t)ci * 256 + ch) * 64 + 32 * hf; const LAS bf16* src = XTl + ch * 72 + 32 * hf;
#pragma unroll
      for (int q = 0; q < 4; ++q) *(v4u*)(dst + 8 * q) = *(const LAS v4u*)(src + 8 * q); }
    const int kq = lane_ >> 4, fr = lane_ & 15, h = wave_ >> 1, g = h >> 1;
#pragma unroll
    for (int pi = 0; pi < 2; ++pi) {
        const int pb = 2 * (wave_ & 1) + pi;
        bf16x8 af[2];
#pragma unroll
        for (int ks = 0; ks < 2; ++ks) { float v[8]; unpack8(*(const LAS v4u*)(XTl + (h * 64 + pb * 16 + fr) * 72 + 32 * ks + 8 * kq), v);
#pragma unroll
            for (int e = 0; e < 8; ++e) v[e] *= sj[h * 64 + 32 * ks + 8 * kq + e];
            af[ks] = __builtin_bit_cast(bf16x8, pack8(v)); }
        bf16* dst = F_STB + ((size_t)(ci * 4 + h) * 64 + pb * 16 + 4 * kq) * 128 + fr;
#pragma unroll
        for (int nt = 0; nt < 8; ++nt) {
            f32x4 acc = {0.f, 0.f, 0.f, 0.f};
#pragma unroll
            for (int ks = 0; ks < 2; ++ks) { const bf16x8 bfr = *(const LAS bf16x8*)(BTl + (g * 128 + nt * 16 + fr) * 72 + 32 * ks + 8 * kq); acc = __builtin_amdgcn_mfma_f32_16x16x32_bf16(af[ks], bfr, acc, 0, 0, 0); }
#pragma unroll
            for (int r = 0; r < 4; ++r) dst[r * 128 + nt * 16] = (bf16)f2bf(acc[r]);
        }
    }
    __syncthreads();
}

__device__ __forceinline__ void ssd_out_witem(Frame& F, int layer, int ci, int ib, int wave_, int lane_) {
    const Chunk c = chunk_of(ci);
    const int kq = lane_ >> 4, fr = lane_ & 15;
    constexpr int WSTRIDE = 2560 + 16384; static_assert(8 * WSTRIDE <= MISC_OFF, "per-wave LDS");
    LAS bf16* scr = (LAS bf16*)(F.lds + wave_ * WSTRIDE);
    lf32* ysc = (lf32*)(F.lds + wave_ * WSTRIDE + 2560) + lane_;
    const bf16* P = F_PROJ + (size_t)c.row0 * NPROJ;
    const float* acsg = F_ACS + (size_t)c.row0 * 4; const float* dtg = F_DTV + (size_t)c.row0 * 4;
    const int nks = (ib + 2) >> 1;
    float sq[4] = {0.f, 0.f, 0.f, 0.f};
    const float* bdp = inp(I_BD) + layer * 4;
#pragma unroll
    for (int g = 0; g < 2; ++g) {
        bf16x8 cf[4];
#pragma unroll
        for (int ks = 0; ks < 4; ++ks) cf[ks] = *(const bf16x8*)(P + (size_t)(16 * ib + fr) * NPROJ + PC_C + 128 * g + 32 * ks + 8 * kq);
        f32x4 G[4];
#pragma unroll
        for (int jb = 0; jb < 4; ++jb) { G[jb] = (f32x4){0.f, 0.f, 0.f, 0.f};
            if (jb <= ib) {
#pragma unroll
                for (int ks = 0; ks < 4; ++ks) { const bf16x8 bfr = *(const bf16x8*)(P + (size_t)(16 * jb + fr) * NPROJ + PC_B + 128 * g + 32 * ks + 8 * kq); G[jb] = __builtin_amdgcn_mfma_f32_16x16x32_bf16(cf[ks], bfr, G[jb], 0, 0, 0); } } }
#pragma unroll
        for (int hh = 0; hh < 2; ++hh) {
            const int h = 2 * g + hh;
            float ai[4], ea[4];
#pragma unroll
            for (int r = 0; r < 4; ++r) { ai[r] = acsg[(16 * ib + 4 * kq + r) * 4 + h]; ea[r] = __expf(ai[r]); }
#pragma unroll
            for (int jb = 0; jb < 4; ++jb) { const int j = 16 * jb + fr; float aj = 0.f, dj = 0.f; if (jb <= ib) { aj = acsg[j * 4 + h]; dj = dtg[j * 4 + h]; }
#pragma unroll
                for (int r = 0; r < 4; ++r) { const int i = 16 * ib + 4 * kq + r; const float v = (jb <= ib && j <= i) ? G[jb][r] * __expf(ai[r] - aj) * dj : 0.f; scr[(4 * kq + r) * 72 + j] = (bf16)f2bf(v); } }
            asm volatile("s_waitcnt lgkmcnt(0)" ::: "memory");
            bf16x8 gm[2];
#pragma unroll
            for (int ks = 0; ks < 2; ++ks) gm[ks] = *(const LAS bf16x8*)(scr + fr * 72 + 32 * ks + 8 * kq);
            asm volatile("s_waitcnt lgkmcnt(0)" ::: "memory");
            const bf16* xt = F_XT + ((size_t)ci * 256 + h * 64) * 64;
            const bf16* sin_b = F_STB + (size_t)(ci * 4 + h) * 8192; const float* sin_f = inp(I_SSSM) + (size_t)((layer * NSB + (c.b < 0 ? 0 : c.b)) * 4 + h) * 8192;
#pragma unroll 2
            for (int pt = 0; pt < 4; ++pt) {
                f32x4 a1 = {0.f, 0.f, 0.f, 0.f}, a2 = {0.f, 0.f, 0.f, 0.f};
#pragma unroll
                for (int ks = 0; ks < 2; ++ks) if (ks < nks) { const bf16x8 bfr = *(const bf16x8*)(xt + (size_t)(pt * 16 + fr) * 64 + 32 * ks + 8 * kq); a1 = __builtin_amdgcn_mfma_f32_16x16x32_bf16(gm[ks], bfr, a1, 0, 0, 0); }
#pragma unroll
                for (int ks = 0; ks < 4; ++ks) { bf16x8 bfr;
                    if (c.b < 0) bfr = *(const bf16x8*)(sin_b + (size_t)(pt * 16 + fr) * 128 + 32 * ks + 8 * kq);
                    else { const float* s = sin_f + (size_t)(pt * 16 + fr) * 128 + 32 * ks + 8 * kq; const f32x4 u0 = *(const f32x4*)s, u1 = *(const f32x4*)(s + 4); v4u w; w.x = pk2(u0.x, u0.y); w.y = pk2(u0.z, u0.w); w.z = pk2(u1.x, u1.y); w.w = pk2(u1.z, u1.w); bfr = __builtin_bit_cast(bf16x8, w); }
                    a2 = __builtin_amdgcn_mfma_f32_16x16x32_bf16(cf[ks], bfr, a2, 0, 0, 0); }
                const float dh = bdp[h];
#pragma unroll
                for (int r = 0; r < 4; ++r) { const size_t ro = (size_t)(16 * ib + 4 * kq + r) * NPROJ; const int p = h * 64 + pt * 16 + fr;
                    float y = a1[r] + ea[r] * a2[r] + dh * bf1(P[ro + PC_X + p]);
                    y *= silu_g(bf1(P[ro + PC_Z + p])); ysc[((h * 4 + pt) * 4 + r) * 64] = y; sq[r] += y * y; }
            }
        }
    }
    const float* nw = inp(I_BNRM) + (size_t)layer * 256;
#pragma unroll
    for (int r = 0; r < 4; ++r) { const float rstd = rsq_f(sum16_l(lane_, sq[r]) * (1.0f / 256.0f) + EPS); bf16* o = F_XN + (size_t)(c.row0 + 16 * ib + 4 * kq + r) * D + 256 + fr;
#pragma unroll 4
        for (int q = 0; q < 16; ++q) o[q * 16] = (bf16)f2bf(ysc[(q * 4 + r) * 64] * rstd * nw[q * 16 + fr]); }
}

constexpr int SO_SIN = 0, SO_XT = 4 * 64 * 136 * 2, SO_ACS = SO_XT + 256 * 72 * 2, SO_DTV = SO_ACS + 1024, SO_SS = SO_DTV + 1024, SO_SCR = SO_SS + 512, SO_END = SO_SCR + 8 * 2560;
static_assert(SO_END <= MISC_OFF, "ssd_out_block LDS map");
__device__ __forceinline__ void ssd_out_block(Frame& F, int layer, int ci) {
    ITEM_IDS();
    const int row0 = 64 * ci;
    LAS bf16* SIN = (LAS bf16*)(F.lds + SO_SIN); LAS bf16* XTl = (LAS bf16*)(F.lds + SO_XT);
    lf32* acs = (lf32*)(F.lds + SO_ACS); lf32* dtv = (lf32*)(F.lds + SO_DTV); lf32* ss = (lf32*)(F.lds + SO_SS);
    LAS bf16* scr = (LAS bf16*)(F.lds + SO_SCR + wave_ * 2560);
    const int kq = lane_ >> 4, fr = lane_ & 15, ib = wave_ >> 1, g = wave_ & 1;
    const bf16* P = F_PROJ + (size_t)row0 * NPROJ;
    v4u st[12];
    { const bf16* sg = F_STB + (size_t)ci * 32768; const bf16* xg = F_XT + (size_t)ci * 16384;
#pragma unroll
      for (int q = 0; q < 8; ++q) st[q] = *(const v4u*)(sg + (size_t)(tid_ + q * NTHR) * 8);
#pragma unroll
      for (int q = 0; q < 4; ++q) st[8 + q] = *(const v4u*)(xg + (size_t)(tid_ + q * NTHR) * 8); }
    float a4 = 0.f, d4 = 0.f; if (tid_ < 256) { a4 = F_ACS[(size_t)row0 * 4 + tid_]; d4 = F_DTV[(size_t)row0 * 4 + tid_]; }
    bf16x8 cf[4], bfr[4][4];
#pragma unroll
    for (int ks = 0; ks < 4; ++ks) cf[ks] = *(const bf16x8*)(P + (size_t)(16 * ib + fr) * NPROJ + PC_C + 128 * g + 32 * ks + 8 * kq);
#pragma unroll
    for (int jb = 0; jb < 4; ++jb)
#pragma unroll
        for (int ks = 0; ks < 4; ++ks) { bfr[jb][ks] = (bf16x8){0, 0, 0, 0, 0, 0, 0, 0}; if (jb <= ib) bfr[jb][ks] = *(const bf16x8*)(P + (size_t)(16 * jb + fr) * NPROJ + PC_B + 128 * g + 32 * ks + 8 * kq); }
#pragma unroll
    for (int q = 0; q < 8; ++q) { const int it = tid_ + q * NTHR; *(LAS v4u*)(SIN + (it >> 4) * 136 + 8 * (it & 15)) = st[q]; }
#pragma unroll
    for (int q = 0; q < 4; ++q) { const int it = tid_ + q * NTHR; *(LAS v4u*)(XTl + (it >> 3) * 72 + 8 * (it & 7)) = st[8 + q]; }
    if (tid_ < 256) { acs[tid_] = a4; dtv[tid_] = d4; }
    bf16 zv[2][4][4];
#pragma unroll
    for (int hh = 0; hh < 2; ++hh)
#pragma unroll
        for (int pt = 0; pt < 4; ++pt)
#pragma unroll
            for (int r = 0; r < 4; ++r) zv[hh][pt][r] = P[(size_t)(16 * ib + 4 * kq + r) * NPROJ + PC_Z + (2 * g + hh) * 64 + pt * 16 + fr];
    __syncthreads();
    f32x4 G[4];
#pragma unroll
    for (int jb = 0; jb < 4; ++jb) { G[jb] = (f32x4){0.f, 0.f, 0.f, 0.f};
        if (jb <= ib) {
#pragma unroll
            for (int ks = 0; ks < 4; ++ks) G[jb] = __builtin_amdgcn_mfma_f32_16x16x32_bf16(cf[ks], bfr[jb][ks], G[jb], 0, 0, 0); } }
    const int nks = (ib + 2) >> 1;
    const float* bdp = inp(I_BD) + layer * 4;
    f32x4 yv[2][4]; float sq[4] = {0.f, 0.f, 0.f, 0.f};
#pragma unroll
    for (int hh = 0; hh < 2; ++hh) {
        const int h = 2 * g + hh;
        float ai[4], ea[4];
#pragma unroll
        for (int r = 0; r < 4; ++r) { ai[r] = acs[(16 * ib + 4 * kq + r) * 4 + h]; ea[r] = __expf(ai[r]); }
#pragma unroll
        for (int jb = 0; jb < 4; ++jb) { const int j = 16 * jb + fr; const float aj = acs[j * 4 + h], dj = dtv[j * 4 + h];
#pragma unroll
            for (int r = 0; r < 4; ++r) { const int i = 16 * ib + 4 * kq + r; const float v = (jb <= ib && j <= i) ? G[jb][r] * __expf(ai[r] - aj) * dj : 0.f; scr[(4 * kq + r) * 72 + j] = (bf16)f2bf(v); } }
        asm volatile("s_waitcnt lgkmcnt(0)" ::: "memory");
        bf16x8 gm[2];
#pragma unroll
        for (int ks = 0; ks < 2; ++ks) gm[ks] = *(const LAS bf16x8*)(scr + fr * 72 + 32 * ks + 8 * kq);
        asm volatile("s_waitcnt lgkmcnt(0)" ::: "memory");
        const float dh = bdp[h];
#pragma unroll
        for (int pt = 0; pt < 4; ++pt) {
            f32x4 a1 = {0.f, 0.f, 0.f, 0.f}, a2 = {0.f, 0.f, 0.f, 0.f};
            const LAS bf16* xr = XTl + (h * 64 + pt * 16 + fr) * 72; const LAS bf16* sr = SIN + (h * 64 + pt * 16 + fr) * 136;
#pragma unroll
            for (int ks = 0; ks < 2; ++ks) if (ks < nks) a1 = __builtin_amdgcn_mfma_f32_16x16x32_bf16(gm[ks], *(const LAS bf16x8*)(xr + 32 * ks + 8 * kq), a1, 0, 0, 0);
#pragma unroll
            for (int ks = 0; ks < 4; ++ks) a2 = __builtin_amdgcn_mfma_f32_16x16x32_bf16(cf[ks], *(const LAS bf16x8*)(sr + 32 * ks + 8 * kq), a2, 0, 0, 0);
            const unsigned long long xw = *(const LAS unsigned long long*)(xr + 16 * ib + 4 * kq);
            const float xx[4] = {bf_lo((unsigned)xw), bf_hi((unsigned)xw), bf_lo((unsigned)(xw >> 32)), bf_hi((unsigned)(xw >> 32))};
#pragma unroll
            for (int r = 0; r < 4; ++r) { float y = a1[r] + ea[r] * a2[r] + dh * xx[r]; y *= silu_g(bf1(zv[hh][pt][r])); yv[hh][pt][r] = y; sq[r] += y * y; }
        }
    }
#pragma unroll
    for (int r = 0; r < 4; ++r) { const float q = sum16_l(lane_, sq[r]); if (fr == 0) ss[(16 * ib + 4 * kq + r) * 2 + g] = q; }
    __syncthreads();
    const float* nw = inp(I_BNRM) + (size_t)layer * 256 + 128 * g;
#pragma unroll
    for (int r = 0; r < 4; ++r) { const int i = 16 * ib + 4 * kq + r; const float rstd = rsq_f((ss[i * 2] + ss[i * 2 + 1]) * (1.0f / 256.0f) + EPS); bf16* o = F_XN + (size_t)(row0 + i) * D + 256 + 128 * g + fr;
#pragma unroll
        for (int hh = 0; hh < 2; ++hh)
#pragma unroll
            for (int pt = 0; pt < 4; ++pt) o[hh * 64 + pt * 16] = (bf16)f2bf(yv[hh][pt][r] * rstd * nw[hh * 64 + pt * 16 + fr]); }
    __syncthreads();
}
constexpr int HP_KT = 0, HP_VT = 256 * 72 * 2, HP_HT = 2 * 256 * 72 * 2, HP_END = HP_HT + 4 * 256 * 4;
static_assert(HP_END <= MISC_OFF, "hgrn_prep LDS map");
__device__ __forceinline__ void hgrn_prep_item(Frame& F, int layer, int ci) {
    ITEM_IDS();
    const Chunk c = chunk_of(ci);
    LAS bf16* KTl = (LAS bf16*)(F.lds + HP_KT); LAS bf16* VTl = (LAS bf16*)(F.lds + HP_VT);
    lf32* ht = (lf32*)(F.lds + HP_HT);
    const int cp = tid_ & 127, qt = tid_ >> 7;
    float lb0 = 0.f, lb1 = 0.f; if (layer != 0) { const float* lbp = inp(I_LB) + 2 * cp; lb0 = rcp_f(1.0f + __expf(lbp[0] - lbp[256])); lb1 = rcp_f(1.0f + __expf(lbp[1] - lbp[257])); }
    bf16* pq = F_PROJ + (size_t)(c.row0 + 16 * qt) * NPROJ + PC_CQ + 2 * cp;
    const bool act = 16 * qt < c.nrows;
    unsigned rq[16], rf[16], rv[16];
#pragma unroll
    for (int i = 0; i < 16; ++i) { rq[i] = 0u; rf[i] = 0u; rv[i] = 0u; if (act) { const unsigned* p = (const unsigned*)(pq + (size_t)i * NPROJ); rq[i] = p[0]; rf[i] = p[128]; rv[i] = p[256]; } }
    float b0[16], b1[16], k0[16], k1[16];
    float run0 = 0.f, run1 = 0.f;
#pragma unroll
    for (int i = 0; i < 16; ++i) { float g0 = 0.f, g1 = 0.f; k0[i] = 0.f; k1[i] = 0.f;
        if (act) { const float e0 = __expf(-bf_lo(rf[i])), e1 = __expf(-bf_hi(rf[i])); const float d0 = rcp_f(1.0f + e0), d1 = rcp_f(1.0f + e1);
            g0 = __logf(lb0 + (1.0f - lb0) * d0); g1 = __logf(lb1 + (1.0f - lb1) * d1); k0[i] = (1.0f - lb0) * e0 * d0; k1[i] = (1.0f - lb1) * e1 * d1; }
        run0 += g0; run1 += g1; b0[i] = run0; b1[i] = run1; }
    *(LAS f32x2*)(ht + qt * 256 + 2 * cp) = (f32x2){run0, run1};
    __syncthreads();
    float pre0 = 0.f, pre1 = 0.f, last0 = 0.f, last1 = 0.f;
#pragma unroll
    for (int q = 0; q < 4; ++q) { const f32x2 t = *(const LAS f32x2*)(ht + q * 256 + 2 * cp); if (q < qt) { pre0 += t.x; pre1 += t.y; } last0 += t.x; last1 += t.y; }
    { float* Rg = F_RH + (size_t)ci * 1280 + 2 * cp; *(f32x2*)(Rg + qt * 256) = (f32x2){pre0, pre1};
      if (qt == 3) { *(f32x2*)(Rg + 1024) = (f32x2){last0, last1}; *(f32x2*)(F_DECC + (size_t)ci * 256 + 2 * cp) = (f32x2){__expf(last0), __expf(last1)}; } }
    const float e0 = run0, e1 = run1;
#pragma unroll
    for (int i = 0; i < 16; i += 2) {
        unsigned kt0, kt1;
#pragma unroll
        for (int q = 0; q < 2; ++q) { const int ii = i + q;
            const float qe0 = bf_lo(rq[ii]) * __expf(b0[ii]), qe1 = bf_hi(rq[ii]) * __expf(b1[ii]);
            const float ke0 = k0[ii] * __expf(e0 - b0[ii]), ke1 = k1[ii] * __expf(e1 - b1[ii]);
            const float kd0 = k0[ii] * __expf(fminf(-b0[ii], 80.f)), kd1 = k1[ii] * __expf(fminf(-b1[ii], 80.f));
            if (act && 16 * qt + ii < c.nrows) { unsigned* p = (unsigned*)(pq + (size_t)ii * NPROJ); p[0] = pk2(qe0, qe1); p[128] = pk2(ke0, ke1); p[256] = pk2(kd0, kd1); }
            const float t0 = k0[ii] * __expf(last0 - pre0 - b0[ii]), t1 = k1[ii] * __expf(last1 - pre1 - b1[ii]);
            if (q == 0) { kt0 = f2bf(t0); kt1 = f2bf(t1); } else { kt0 |= f2bf(t0) << 16; kt1 |= f2bf(t1) << 16; } }
        const int j = 16 * qt + i;
        *(LAS unsigned*)(KTl + (2 * cp) * 72 + j) = kt0; *(LAS unsigned*)(KTl + (2 * cp + 1) * 72 + j) = kt1;
        *(LAS unsigned*)(VTl + (2 * cp) * 72 + j) = (rv[i] & 0xffffu) | (rv[i + 1] << 16); *(LAS unsigned*)(VTl + (2 * cp + 1) * 72 + j) = (rv[i] >> 16) | (rv[i + 1] & 0xffff0000u);
    }
    __syncthreads();
    { const int c2 = tid_ >> 1, hf = tid_ & 1; bf16* dst = F_VT + ((size_t)ci * 256 + c2) * 64 + 32 * hf; const LAS bf16* src = VTl + c2 * 72 + 32 * hf;
#pragma unroll
      for (int q = 0; q < 4; ++q) *(v4u*)(dst + 8 * q) = *(const LAS v4u*)(src + 8 * q); }
    const int kq = lane_ >> 4, fr = lane_ & 15, h = wave_ >> 1;
#pragma unroll
    for (int vi = 0; vi < 2; ++vi) {
        const int vb = 2 * (wave_ & 1) + vi;
        bf16x8 af[2];
#pragma unroll
        for (int ks = 0; ks < 2; ++ks) af[ks] = *(const LAS bf16x8*)(VTl + (h * 64 + vb * 16 + fr) * 72 + 32 * ks + 8 * kq);
        bf16* dst = F_STC + ((size_t)(ci * 4 + h) * 64 + vb * 16 + 4 * kq) * 64 + fr;
#pragma unroll
        for (int kb = 0; kb < 4; ++kb) {
            f32x4 acc = {0.f, 0.f, 0.f, 0.f};
#pragma unroll
            for (int ks = 0; ks < 2; ++ks) { const bf16x8 bfr = *(const LAS bf16x8*)(KTl + (h * 64 + kb * 16 + fr) * 72 + 32 * ks + 8 * kq); acc = __builtin_amdgcn_mfma_f32_16x16x32_bf16(af[ks], bfr, acc, 0, 0, 0); }
#pragma unroll
            for (int r = 0; r < 4; ++r) dst[r * 64 + kb * 16] = (bf16)f2bf(acc[r]);
        }
    }
    __syncthreads();
}

__device__ __forceinline__ void hgrn_out_witem(Frame& F, int layer, int ci, int h, int ib, int wave_, int lane_) {
    const Chunk c = chunk_of(ci);
    const int kq = lane_ >> 4, fr = lane_ & 15;
    LAS bf16* scr = (LAS bf16*)(F.lds + wave_ * (2560 + 16384));
    const bf16* P = F_PROJ + (size_t)c.row0 * NPROJ + h * 64;
    const float* Rg = F_RH + (size_t)ci * 1280 + h * 64;
    bf16x8 qf[2]; float qv[2][8], rI[2][8];
#pragma unroll
    for (int ks = 0; ks < 2; ++ks) { qf[ks] = *(const bf16x8*)(P + (size_t)(16 * ib + fr) * NPROJ + PC_CQ + 32 * ks + 8 * kq); unpack8(__builtin_bit_cast(v4u, qf[ks]), qv[ks]);
        const float* rp = Rg + ib * 256 + 32 * ks + 8 * kq; const f32x4 a = *(const f32x4*)rp, b2 = *(const f32x4*)(rp + 4);
        rI[ks][0] = a.x; rI[ks][1] = a.y; rI[ks][2] = a.z; rI[ks][3] = a.w; rI[ks][4] = b2.x; rI[ks][5] = b2.y; rI[ks][6] = b2.z; rI[ks][7] = b2.w; }
#pragma unroll
    for (int J = 0; J < 4; ++J) {
        f32x4 acc = {0.f, 0.f, 0.f, 0.f};
        if (J <= ib) {
#pragma unroll
            for (int ks = 0; ks < 2; ++ks) {
                bf16x8 a = qf[ks];
                if (J < ib) { const float* rp = Rg + (J + 1) * 256 + 32 * ks + 8 * kq; const f32x4 u0 = *(const f32x4*)rp, u1 = *(const f32x4*)(rp + 4); const float rj[8] = {u0.x, u0.y, u0.z, u0.w, u1.x, u1.y, u1.z, u1.w};
                    float v[8];
#pragma unroll
                    for (int e = 0; e < 8; ++e) v[e] = qv[ks][e] * __expf(rI[ks][e] - rj[e]);
                    a = __builtin_bit_cast(bf16x8, pack8(v)); }
                const bf16x8 bfr = *(const bf16x8*)(P + (size_t)(16 * J + fr) * NPROJ + (J < ib ? PC_CF : PC_CI) + 32 * ks + 8 * kq);
                acc = __builtin_amdgcn_mfma_f32_16x16x32_bf16(a, bfr, acc, 0, 0, 0);
            }
        }
#pragma unroll
        for (int r = 0; r < 4; ++r) { const int i = 4 * kq + r, j = fr; const float v = (J < ib || (J == ib && j <= i)) ? acc[r] : 0.f; scr[(4 * kq + r) * 72 + 16 * J + fr] = (bf16)f2bf(v); }
    }
    asm volatile("s_waitcnt lgkmcnt(0)" ::: "memory");
    bf16x8 ga[2];
#pragma unroll
    for (int ks = 0; ks < 2; ++ks) ga[ks] = *(const LAS bf16x8*)(scr + fr * 72 + 32 * ks + 8 * kq);
    asm volatile("s_waitcnt lgkmcnt(0)" ::: "memory");
    bf16x8 qs[2];
#pragma unroll
    for (int ks = 0; ks < 2; ++ks) { float v[8];
#pragma unroll
        for (int e = 0; e < 8; ++e) v[e] = qv[ks][e] * __expf(rI[ks][e]);
        qs[ks] = __builtin_bit_cast(bf16x8, pack8(v)); }
    const int nks = (ib + 2) >> 1;
    const bf16* vt = F_VT + ((size_t)ci * 256 + h * 64) * 64;
    const bf16* sin_b = F_STC + (size_t)(ci * 4 + h) * 4096; const float* sin_f = inp(I_SHGRN) + (size_t)((layer * NSB + (c.b < 0 ? 0 : c.b)) * 4 + h) * 4096;
    f32x4 o[4]; float sq[4] = {0.f, 0.f, 0.f, 0.f};
#pragma unroll
    for (int t = 0; t < 4; ++t) {
        o[t] = (f32x4){0.f, 0.f, 0.f, 0.f};
#pragma unroll
        for (int ks = 0; ks < 2; ++ks) if (ks < nks) { const bf16x8 bfr = *(const bf16x8*)(vt + (size_t)(t * 16 + fr) * 64 + 32 * ks + 8 * kq); o[t] = __builtin_amdgcn_mfma_f32_16x16x32_bf16(ga[ks], bfr, o[t], 0, 0, 0); }
#pragma unroll
        for (int ks = 0; ks < 2; ++ks) { bf16x8 bfr;
            if (c.b < 0) bfr = *(const bf16x8*)(sin_b + (size_t)(t * 16 + fr) * 64 + 32 * ks + 8 * kq);
            else { float v[8];
#pragma unroll
                for (int e = 0; e < 8; ++e) v[e] = sin_f[(size_t)(32 * ks + 8 * kq + e) * 64 + t * 16 + fr];
                bfr = __builtin_bit_cast(bf16x8, pack8(v)); }
            o[t] = __builtin_amdgcn_mfma_f32_16x16x32_bf16(qs[ks], bfr, o[t], 0, 0, 0); }
#pragma unroll
        for (int r = 0; r < 4; ++r) sq[r] += o[t][r] * o[t][r];
    }
    const float* nw = inp(I_CNRM) + (size_t)layer * 256 + h * 64;
#pragma unroll
    for (int r = 0; r < 4; ++r) { const float rstd = rsq_f(sum16_l(lane_, sq[r]) * (1.0f / 64.0f) + EPS); const size_t row = (size_t)(16 * ib + 4 * kq + r);
#pragma unroll
        for (int t = 0; t < 4; ++t) { const int v = t * 16 + fr; const float cg = bf1(P[row * NPROJ + PC_CG + v]);
            F_XN[(size_t)(c.row0 + row) * D + 512 + h * 64 + v] = (bf16)f2bf(o[t][r] * rstd * nw[v] * silu_g(cg)); } }
}

constexpr int HO_KE = 0, HO_VT = 64 * 264 * 2, HO_SIN = HO_VT + 256 * 72 * 2, HO_R = HO_SIN + 256 * 72 * 2, HO_SCR = HO_R + 1280 * 4, HO_END = HO_SCR + 8 * 2304;
static_assert(HO_END <= MISC_OFF, "hgrn_out_block LDS map");
__device__ __forceinline__ void hgrn_out_block(Frame& F, int layer, int ci) {
    ITEM_IDS();
    const int row0 = 64 * ci;
    LAS bf16* KEl = (LAS bf16*)(F.lds + HO_KE); LAS bf16* VTl = (LAS bf16*)(F.lds + HO_VT); LAS bf16* SIN = (LAS bf16*)(F.lds + HO_SIN); lf32* Rl = (lf32*)(F.lds + HO_R);
    LAS bf16* scr = (LAS bf16*)(F.lds + HO_SCR + wave_ * 2304);
    const int kq = lane_ >> 4, fr = lane_ & 15, h = wave_ >> 1, ib0 = 2 * (wave_ & 1);
    const bf16* P = F_PROJ + (size_t)row0 * NPROJ;
    v4u st[13];
    { const bf16* kg = P + PC_CF; const bf16* vg = F_VT + (size_t)ci * 16384; const bf16* sg = F_STC + (size_t)ci * 16384; const float* rg = F_RH + (size_t)ci * 1280;
#pragma unroll
      for (int q = 0; q < 4; ++q) { const int it = tid_ + q * NTHR; st[q] = *(const v4u*)(kg + (size_t)(it >> 5) * NPROJ + 8 * (it & 31)); }
#pragma unroll
      for (int q = 0; q < 4; ++q) st[4 + q] = *(const v4u*)(vg + (size_t)(tid_ + q * NTHR) * 8);
#pragma unroll
      for (int q = 0; q < 4; ++q) st[8 + q] = *(const v4u*)(sg + (size_t)(tid_ + q * NTHR) * 8);
      st[12] = (v4u){0u, 0u, 0u, 0u}; if (tid_ < 320) st[12] = *(const v4u*)(rg + 4 * tid_); }
    bf16x8 qf[2][2], kd[2][2];
#pragma unroll
    for (int bi = 0; bi < 2; ++bi)
#pragma unroll
        for (int ks = 0; ks < 2; ++ks) { const bf16* p = P + (size_t)(16 * (ib0 + bi) + fr) * NPROJ + h * 64 + 32 * ks + 8 * kq; qf[bi][ks] = *(const bf16x8*)(p + PC_CQ); kd[bi][ks] = *(const bf16x8*)(p + PC_CI); }
#pragma unroll
    for (int q = 0; q < 4; ++q) { const int it = tid_ + q * NTHR; *(LAS v4u*)(KEl + (it >> 5) * 264 + 8 * (it & 31)) = st[q]; }
#pragma unroll
    for (int q = 0; q < 4; ++q) { const int it = tid_ + q * NTHR; *(LAS v4u*)(VTl + (it >> 3) * 72 + 8 * (it & 7)) = st[4 + q]; *(LAS v4u*)(SIN + (it >> 3) * 72 + 8 * (it & 7)) = st[8 + q]; }
    if (tid_ < 320) *(LAS v4u*)(Rl + 4 * tid_) = st[12];
    bf16 cgv[2][4][4];
#pragma unroll
    for (int bi = 0; bi < 2; ++bi)
#pragma unroll
        for (int t = 0; t < 4; ++t)
#pragma unroll
            for (int r = 0; r < 4; ++r) cgv[bi][t][r] = P[(size_t)(16 * (ib0 + bi) + 4 * kq + r) * NPROJ + PC_CG + h * 64 + t * 16 + fr];
    __syncthreads();
    const float* nw = inp(I_CNRM) + (size_t)layer * 256 + h * 64;
#pragma unroll
    for (int bi = 0; bi < 2; ++bi) {
        const int ib = ib0 + bi;
        float qv[2][8], rI[2][8];
#pragma unroll
        for (int ks = 0; ks < 2; ++ks) { unpack8(__builtin_bit_cast(v4u, qf[bi][ks]), qv[ks]); const lf32* rp = Rl + ib * 256 + h * 64 + 32 * ks + 8 * kq;
#pragma unroll
            for (int e = 0; e < 8; ++e) rI[ks][e] = rp[e]; }
#pragma unroll
        for (int J = 0; J < 4; ++J) {
            f32x4 acc = {0.f, 0.f, 0.f, 0.f};
            if (J <= ib) {
#pragma unroll
                for (int ks = 0; ks < 2; ++ks) {
                    bf16x8 a = qf[bi][ks], bfr = kd[bi][ks];
                    if (J < ib) { const lf32* rp = Rl + (J + 1) * 256 + h * 64 + 32 * ks + 8 * kq; float v[8];
#pragma unroll
                        for (int e = 0; e < 8; ++e) v[e] = qv[ks][e] * __expf(rI[ks][e] - rp[e]);
                        a = __builtin_bit_cast(bf16x8, pack8(v)); bfr = *(const LAS bf16x8*)(KEl + (16 * J + fr) * 264 + h * 64 + 32 * ks + 8 * kq); }
                    acc = __builtin_amdgcn_mfma_f32_16x16x32_bf16(a, bfr, acc, 0, 0, 0);
                }
            }
#pragma unroll
            for (int r = 0; r < 4; ++r) { const int i = 4 * kq + r, j = fr; const float v = (J < ib || (J == ib && j <= i)) ? acc[r] : 0.f; scr[(4 * kq + r) * 72 + 16 * J + fr] = (bf16)f2bf(v); }
        }
        asm volatile("s_waitcnt lgkmcnt(0)" ::: "memory");
        bf16x8 ga[2];
#pragma unroll
        for (int ks = 0; ks < 2; ++ks) ga[ks] = *(const LAS bf16x8*)(scr + fr * 72 + 32 * ks + 8 * kq);
        asm volatile("s_waitcnt lgkmcnt(0)" ::: "memory");
        bf16x8 qs[2];
#pragma unroll
        for (int ks = 0; ks < 2; ++ks) { float v[8];
#pragma unroll
            for (int e = 0; e < 8; ++e) v[e] = qv[ks][e] * __expf(rI[ks][e]);
            qs[ks] = __builtin_bit_cast(bf16x8, pack8(v)); }
        const int nks = (ib + 2) >> 1;
        f32x4 o[4]; float sq[4] = {0.f, 0.f, 0.f, 0.f};
#pragma unroll
        for (int t = 0; t < 4; ++t) {
            o[t] = (f32x4){0.f, 0.f, 0.f, 0.f};
#pragma unroll
            for (int ks = 0; ks < 2; ++ks) if (ks < nks) o[t] = __builtin_amdgcn_mfma_f32_16x16x32_bf16(ga[ks], *(const LAS bf16x8*)(VTl + (h * 64 + t * 16 + fr) * 72 + 32 * ks + 8 * kq), o[t], 0, 0, 0);
#pragma unroll
            for (int ks = 0; ks < 2; ++ks) o[t] = __builtin_amdgcn_mfma_f32_16x16x32_bf16(qs[ks], *(const LAS bf16x8*)(SIN + (h * 64 + t * 16 + fr) * 72 + 32 * ks + 8 * kq), o[t], 0, 0, 0);
#pragma unroll
            for (int r = 0; r < 4; ++r) sq[r] += o[t][r] * o[t][r];
        }
#pragma unroll
        for (int r = 0; r < 4; ++r) { const float rstd = rsq_f(sum16_l(lane_, sq[r]) * (1.0f / 64.0f) + EPS); bf16* op = F_XN + (size_t)(row0 + 16 * ib + 4 * kq + r) * D + 512 + h * 64 + fr;
#pragma unroll
            for (int t = 0; t < 4; ++t) op[t * 16] = (bf16)f2bf(o[t][r] * rstd * nw[t * 16 + fr] * silu_g(bf1(cgv[bi][t][r]))); }
    }
    __syncthreads();
}
template <int MODE>
__device__ __forceinline__ void mini_gemm(Frame& F, const bf16* A, const bf16* Bt, int K, int ncb, bf16* O, int ldo, const float* res, float* C) {
    ITEM_IDS();
    const int kq = lane_ >> 4, fr = lane_ & 15;
    for (int wi = ((int)blockIdx.x) * NWAVES + wave_; wi < 16 * ncb; wi += ((int)gridDim.x) * NWAVES) {
        const int rb = wi & 15, cb = wi >> 4;
        const bf16* ap = A + (size_t)(MP + 16 * rb + fr) * K + 8 * kq;
        const int c = 16 * cb + fr;
        const bf16* bp = Bt + (size_t)(MODE == 2 ? ((c >> 7) * 256 + (c & 127)) : c) * K + 8 * kq;
        f32x4 acc0 = {0.f, 0.f, 0.f, 0.f}, acc1 = {0.f, 0.f, 0.f, 0.f};
#pragma unroll 16
        for (int k0 = 0; k0 < K; k0 += 32) {
            const bf16x8 a = *(const bf16x8*)(ap + k0), b0 = *(const bf16x8*)(bp + k0);
            acc0 = __builtin_amdgcn_mfma_f32_16x16x32_bf16(a, b0, acc0, 0, 0, 0);
            if (MODE == 2) { const bf16x8 b1 = *(const bf16x8*)(bp + (size_t)128 * K + k0); acc1 = __builtin_amdgcn_mfma_f32_16x16x32_bf16(a, b1, acc1, 0, 0, 0); }
        }
#pragma unroll
        for (int r = 0; r < 4; ++r) { const size_t row = (size_t)(MP + 16 * rb + 4 * kq + r);
            if (MODE == 0) { const bf16 ob = (bf16)f2bf(acc0[r]); O[row * ldo + c] = ob; if (c >= PC_V && c < PC_V + 256) F_VTA[(size_t)(c - PC_V) * M + row] = ob; }
            if (MODE == 1) C[row * 1024 + c] = res[row * 1024 + c] + acc0[r];
            if (MODE == 2) O[row * ldo + c] = (bf16)f2bf(silu_g(acc0[r]) * acc1[r]); }
    }
}
__device__ __forceinline__ void sample_mix_item(Frame& F, int layer, int b) {
    ssd_prep_item(F, layer, NCHP + b);
    hgrn_prep_item(F, layer, NCHP + b);
    asm volatile("s_waitcnt vmcnt(0)" ::: "memory");
    __syncthreads();
    __builtin_amdgcn_fence(__ATOMIC_ACQUIRE, "agent");
    asm volatile("s_waitcnt vmcnt(0)" ::: "memory");
    { ITEM_IDS();
      if (wave_ == 0) ssd_out_witem(F, layer, NCHP + b, 0, wave_, lane_);
      else if (wave_ <= 4) hgrn_out_witem(F, layer, NCHP + b, wave_ - 1, 0, wave_, lane_); }
    __syncthreads();
}
__device__ __forceinline__ void p2_phase(Frame& F, int layer, volatile LAS unsigned* MISC) {
    constexpr int NS = NSB, NA = NCH * 4, NB = NCHP, NC = NCHP, NTOT = NS + NA + NB + NC;
    unsigned* head = (unsigned*)(F.ws + WS_CTL) + CW_QUEUE + 64 * layer;
    attn_bias_load(F, layer);
    for (;;) {
        __syncthreads();
        if (threadIdx.x == 0) MISC[12] = __hip_atomic_fetch_add(head, 1u, __ATOMIC_RELAXED, __HIP_MEMORY_SCOPE_AGENT);
        __syncthreads();
        int it = (int)MISC[12];
        if (it >= NTOT) break;
        if (it < NS) { sample_mix_item(F, layer, it); continue; } it -= NS;
        if (it < NA) { const int i2 = it - NSB * 4; const int ci = it < NSB * 4 ? NCHP + (it >> 2) : NCHP - 1 - (i2 >> 2); attn_item(F, layer, ci, it & 3); }
        else if (it < NA + NB) ssd_prep_item(F, layer, it - NA);
        else hgrn_prep_item(F, layer, it - NA - NB);
    }
}
__device__ __forceinline__ void p4_phase(Frame& F, int layer) {
    for (int ci = ((int)blockIdx.x); ci < NCHP; ci += ((int)gridDim.x)) { ssd_out_block(F, layer, ci); hgrn_out_block(F, layer, ci); }
}

__global__ void __launch_bounds__(NTHR, 2) fwd_kernel(Args args) {
    extern __shared__ __attribute__((aligned(16))) unsigned char lds[];
    Frame F;
    F.lds = (LAS unsigned char*)lds;
    F.out = args.out; F.ws = args.ws;
    volatile LAS unsigned* MISC = (volatile LAS unsigned*)(F.lds + MISC_OFF);
    if (threadIdx.x < 64) MISC[threadIdx.x] = 0u;
    __syncthreads();
    (void)xcd_barrier_post((unsigned*)(args.ws + WS_CTL) + CW_BAR, MISC + 8);
#define GRID_BAR() do { XcdBarrier bar_; bar_.bar = (unsigned*)((unsigned char*)inp(N_IN + 1) + WS_CTL) + CW_BAR; bar_.x = xb_xcc_id(); bar_.st = MISC + 8; xcd_barrier(bar_); \
        F.out = (float*)inp(N_IN); F.ws = (unsigned char*)inp(N_IN + 1); } while (0)
#ifdef TPROBE
    const bool stamper = (blockIdx.x == 0 && threadIdx.x == 0); int n_stamp = 0;
#define STAMP() do { if (stamper) MISC[16 + n_stamp] = (unsigned)__builtin_amdgcn_s_memrealtime(); ++n_stamp; } while (0)
#else
#define STAMP() do { } while (0)
#endif
    STAMP();

    p0_weights(F, 0, ((int)blockIdx.x) * NWAVES + __builtin_amdgcn_readfirstlane((int)(threadIdx.x >> 6)), ((int)gridDim.x) * NWAVES, true);
    __syncthreads();
    norm_rows<true, false>(F, inp(I_XP), inp(I_XS) - (size_t)MP * D, inp(I_N1), inp(I_WIN));
    GRID_BAR(); STAMP();
#pragma unroll 1
    for (int layer = 0; layer < 2; ++layer) {
        unsigned char* wl = F.ws + WS_W + (size_t)layer * WL_STRIDE;
        mini_gemm<0>(F, F_XN, (const bf16*)(wl + WL_IN), D, NPROJ / 16, F_PROJ, NPROJ, nullptr, nullptr);
        { pg8::Gemm g{F_XN, (const bf16*)(wl + WL_IN), MP, NPROJ, D}; pg8::StaticOrder S; S.init(MP, NPROJ, ((int)gridDim.x), ((int)blockIdx.x));
          pg8::EpiBf16 E{F_PROJ, NPROJ, F_HALO, F_VTA, M};
          pg8::gemm_phase<pg8::EpiBf16, pg8::StaticOrder, true, true>(F.lds + RING_OFF, g, S, E); }
        GRID_BAR(); STAMP();
        p2_phase(F, layer, MISC);
        GRID_BAR(); STAMP();
        scan_phase(F, layer);
        GRID_BAR(); STAMP();
        p4_phase(F, layer);
        GRID_BAR(); STAMP();
        mini_gemm<1>(F, F_XN, (const bf16*)(wl + WL_OUT), D, D / 16, nullptr, 0, layer == 0 ? inp(I_XS) - (size_t)MP * D : F_X, F_X);
        { pg8::Gemm g{F_XN, (const bf16*)(wl + WL_OUT), MP, D, D}; pg8::StaticOrder S; S.init(MP, D, ((int)gridDim.x), ((int)blockIdx.x));
          pg8::EpiRes E{layer == 0 ? inp(I_XP) : F_X, layer == 0 ? inp(I_XS) - (size_t)MP * D : F_X, F_X};
          pg8::gemm_phase<pg8::EpiRes, pg8::StaticOrder, true, true>(F.lds + RING_OFF, g, S, E); }
        GRID_BAR(); STAMP();
        norm_rows<false, false>(F, F_X, F_X, inp(I_N2) + (size_t)layer * D, nullptr);
        GRID_BAR(); STAMP();
        { pg8::Gemm g{F_XN, (const bf16*)(wl + WL_GU), M, NGU, D}; pg8::StaticOrder S; S.init(M, NGU, ((int)gridDim.x), ((int)blockIdx.x));
          pg8::EpiSwiGLU E{F_ACT, DFF};
          pg8::gemm_phase<pg8::EpiSwiGLU, pg8::StaticOrder, true, true>(F.lds + RING_OFF, g, S, E); }
        GRID_BAR(); STAMP();
        mini_gemm<1>(F, F_ACT, (const bf16*)(wl + WL_DN), DFF, D / 16, nullptr, 0, F_X, F_X);
        { pg8::Gemm g{F_ACT, (const bf16*)(wl + WL_DN), MP, D, DFF}; pg8::StaticOrder S; S.init(MP, D, ((int)gridDim.x), ((int)blockIdx.x));
          pg8::EpiRes E{F_X, F_X, F_X};
          pg8::gemm_phase<pg8::EpiRes, pg8::StaticOrder, true, true>(F.lds + RING_OFF, g, S, E); }
        GRID_BAR(); STAMP();
        if (layer == 0) { norm_rows<true, false>(F, F_X, F_X, inp(I_N1) + D, inp(I_WIN) + (size_t)D * NIN); GRID_BAR(); STAMP(); }
        else { norm_rows<false, true>(F, F_X, F_X, inp(I_NF), nullptr); STAMP(); }
    }
#ifdef TPROBE
    if (stamper) {
        unsigned v[11]; v[0] = MISC[17] - MISC[16];
        for (int j = 1; j < 10; ++j) v[j] = (MISC[17 + j] - MISC[16 + j]) + (MISC[26 + j] - MISC[25 + j]);
        v[10] = (MISC[35] - MISC[16]) / 4;
        const unsigned dl = 800000u + 16u * v[TPROBE];
        const unsigned t0 = MISC[16];
        while ((unsigned)((unsigned)__builtin_amdgcn_s_memrealtime() - t0) < dl) __builtin_amdgcn_s_sleep(32);
    }
#endif
}

extern "C" void kernel_launch(void* const* d_in, const int* in_sizes, int n_in, void* d_out, int out_size, void* d_ws, size_t ws_size, hipStream_t stream) {
    static int grid = 0;
    if (grid == 0) {
        if (n_in != N_IN || (size_t)out_size != O_END || ws_size < WS_END) { fprintf(stderr, "kernel_launch: unexpected shapes (n_in %d, out %d, ws %zu)\n", n_in, out_size, ws_size); grid = -1; return; }
        int dev = 0, cus = 0, per_cu = 0;
        if (hipGetDevice(&dev) != hipSuccess || hipDeviceGetAttribute(&cus, hipDeviceAttributeMultiprocessorCount, dev) != hipSuccess) { grid = -1; return; }
        if (hipFuncSetAttribute((const void*)fwd_kernel, hipFuncAttributeMaxDynamicSharedMemorySize, LDS_BYTES) != hipSuccess) { fprintf(stderr, "kernel_launch: hipFuncSetAttribute failed\n"); grid = -1; return; }
        if (hipOccupancyMaxActiveBlocksPerMultiprocessor(&per_cu, (const void*)fwd_kernel, NTHR, LDS_BYTES) != hipSuccess || per_cu < 1) { fprintf(stderr, "kernel_launch: occupancy query says %d blocks per CU\n", per_cu); (void)hipGetLastError(); grid = -1; return; }
        grid = cus;
        if (grid < 64) { fprintf(stderr, "kernel_launch: needs at least 64 CUs (got %d)\n", cus); grid = -1; return; }
    }
    if (grid < 0) return;
    if (hipMemsetAsync((char*)d_ws + WS_CTL, 0, CTL_ZERO_BYTES, stream) != hipSuccess) { fprintf(stderr, "kernel_launch: hipMemsetAsync failed\n"); return; }
    Args a{};
    for (int i = 0; i < N_IN; ++i) a.in[i] = (const float*)d_in[i];
    a.out = (float*)d_out; a.ws = (unsigned char*)d_ws;
    void* kargs[] = {&a};
    hipError_t e = hipLaunchCooperativeKernel((const void*)fwd_kernel, dim3(grid), dim3(NTHR), kargs, LDS_BYTES, stream);
    if (e != hipSuccess) { fprintf(stderr, "kernel_launch: cooperative launch failed: %s (grid %d)\n", hipGetErrorString(e), grid); }
}
```

```cpp
#include <hip/hip_runtime.h>
#include <cstdio>
#include <cstdint>
namespace pg8 {
#define PG8_LAS __attribute__((address_space(3)))
typedef unsigned short bf16_t;
typedef short bf16x8 __attribute__((ext_vector_type(8)));
typedef float f32x4 __attribute__((ext_vector_type(4)));
typedef unsigned u32x4 __attribute__((ext_vector_type(4)));
constexpr int BM = 256, BK = 64, HALF = 128, HTB = HALF * BK * 2  , STAGE_BYTES = 8 * HTB, NXCD = 8, WGM = 8;

__host__ __device__ __forceinline__ int lds_byte(int r, int c) { const int st = (r >> 4) * 2 + (c >> 5), rr = r & 15, cc = c & 31, ob = rr * 64 + cc * 2; return st * 1024 + (ob ^ (((ob >> 9) & 1) << 5)); }
__host__ __device__ __forceinline__ void stage_rc(int b, int& R, int& C) { const int st = b / 1024, sb = b % 1024, swz = sb ^ (((sb >> 9) & 1) << 5); R = (st >> 1) * 16 + swz / 64; C = (st & 1) * 32 + (swz % 64) / 2; }
__host__ __device__ __forceinline__ int perm32(int rho) { const int n = rho >> 4, i = rho & 15; return 8 * (i >> 2) + 4 * n + (i & 3); }

struct Unit { int pm, pn; };
struct Gemm { const bf16_t* A; const bf16_t* Bt; int M, N, K; };

struct StaticOrder {
    int nM, nN, nwg, G, c;
    __host__ __device__ void init(int M, int N, int G_, int c_) { nM = M / BM; nN = N / BM; nwg = nM * nN; G = G_; c = c_; }
    __host__ __device__ bool next(int i, Unit& u) const {
        const long L = (long)i * G + c; if (L >= nwg) return false;
        int wgid = (int)L; { const int q = nwg / NXCD, r = nwg % NXCD, xcd = wgid % NXCD, off = wgid / NXCD; wgid = (xcd < r ? xcd * (q + 1) : r * (q + 1) + (xcd - r) * q) + off; }
        const int nig = WGM * nN, gid = wgid / nig, fm = gid * WGM, gsz = (nM - fm) < WGM ? (nM - fm) : WGM;
        u.pm = fm + ((wgid % nig) % gsz); u.pn = (wgid % nig) / gsz; return true;
    }
    __device__ __forceinline__ void a_ready(const Unit&) const {}
    __device__ __forceinline__ void done(const Unit&) const {}
};

__device__ __forceinline__ unsigned cvt_pk_bf16(float lo, float hi) { unsigned r; asm volatile("v_cvt_pk_bf16_f32 %0, %1, %2" : "=v"(r) : "v"(lo), "v"(hi)); return r; }
__device__ __forceinline__ float silu_f(float x) { return x * __builtin_amdgcn_rcpf(1.0f + __expf(-x)); }
struct EpiBf16 {
    static constexpr bool PERM = true, AFTER_DRAIN = false;
    bf16_t* O; int ldc; bf16_t* halo; bf16_t* vta; int vld;
    __device__ __forceinline__ void operator()(const f32x4 (&acc)[2][2][4][2], const Unit& u, int wr, int wc, int fr, int fq) const {
        const int row0 = u.pm * BM + wr * 64 + fr, col0 = u.pn * BM + wc * 32 + 8 * fq;
        const bool hz = halo != nullptr && u.pn >= 4 && u.pn <= 6;
#pragma unroll
        for (int ai = 0; ai < 2; ++ai)
#pragma unroll
            for (int m = 0; m < 4; ++m) { const int row = row0 + ai * HALF + m * 16; bf16_t* rowp = O + (size_t)row * ldc + col0;
#pragma unroll
                for (int bj = 0; bj < 2; ++bj) { const f32x4 v0 = acc[ai][bj][m][0], v1 = acc[ai][bj][m][1];
                    u32x4 w; w.x = cvt_pk_bf16(v0[0], v0[1]); w.y = cvt_pk_bf16(v0[2], v0[3]); w.z = cvt_pk_bf16(v1[0], v1[1]); w.w = cvt_pk_bf16(v1[2], v1[3]);
                    *(u32x4*)(rowp + bj * HALF) = w;
                    if (hz && (row & 63) >= 61) *(u32x4*)(halo + ((size_t)(row >> 6) * 3 + (row & 63) - 61) * 768 + (col0 - 1024) + bj * HALF) = w;
                    if (vta != nullptr && u.pn == 2) { bf16_t* vp = vta + (size_t)(col0 - 512 + bj * HALF) * vld + row;
                        vp[0] = (bf16_t)(w.x & 0xffffu); vp[(size_t)vld] = (bf16_t)(w.x >> 16); vp[(size_t)2 * vld] = (bf16_t)(w.y & 0xffffu); vp[(size_t)3 * vld] = (bf16_t)(w.y >> 16);
                        vp[(size_t)4 * vld] = (bf16_t)(w.z & 0xffffu); vp[(size_t)5 * vld] = (bf16_t)(w.z >> 16); vp[(size_t)6 * vld] = (bf16_t)(w.w & 0xffffu); vp[(size_t)7 * vld] = (bf16_t)(w.w >> 16); } } }
    }
};
struct EpiRes {
    static constexpr bool PERM = false, AFTER_DRAIN = false;
    const float* rlo; const float* rhi; float* C; const float* nw; bf16_t* xo; float* rs;
    __device__ __forceinline__ void operator()(const f32x4 (&acc)[2][2][4][2], const Unit& u, int wr, int wc, int fr, int fq) const {
        const int row0 = u.pm * BM + wr * 64 + fr, col0 = u.pn * BM + wc * 32 + 4 * fq;
        const float* rb = (u.pm < 64) ? rlo : rhi;
        f32x4 wv[2][2];
        if (nw) {
#pragma unroll
            for (int bj = 0; bj < 2; ++bj)
#pragma unroll
                for (int n = 0; n < 2; ++n) wv[bj][n] = *(const f32x4*)(nw + col0 + bj * HALF + n * 16); }
#pragma unroll
        for (int ai = 0; ai < 2; ++ai)
#pragma unroll
            for (int m = 0; m < 4; ++m) { const int row = row0 + ai * HALF + m * 16; const size_t off = (size_t)row * 1024 + col0; float ss = 0.f;
#pragma unroll
                for (int bj = 0; bj < 2; ++bj)
#pragma unroll
                    for (int n = 0; n < 2; ++n) { const f32x4 r = *(const f32x4*)(rb + off + bj * HALF + n * 16); const f32x4 x = r + acc[ai][bj][m][n]; *(f32x4*)(C + off + bj * HALF + n * 16) = x;
                        if (nw) { ss += (x[0] * x[0] + x[1] * x[1]) + (x[2] * x[2] + x[3] * x[3]); const f32x4 y = x * wv[bj][n];
                            *(unsigned long long*)(xo + off + bj * HALF + n * 16) = (unsigned long long)cvt_pk_bf16(y[0], y[1]) | ((unsigned long long)cvt_pk_bf16(y[2], y[3]) << 32); } }
                if (nw) { const int lane = fq * 16 + fr;
                    ss += __builtin_bit_cast(float, __builtin_amdgcn_ds_bpermute((lane ^ 16) << 2, __builtin_bit_cast(int, ss)));
                    ss += __builtin_bit_cast(float, __builtin_amdgcn_ds_bpermute((lane ^ 32) << 2, __builtin_bit_cast(int, ss)));
                    if (fq == 0) atomicAdd(rs + row, ss); }
                asm volatile("" ::: "memory"); }
    }
};
struct EpiSwiGLU {
    static constexpr bool PERM = true, AFTER_DRAIN = false;
    bf16_t* O; int ldc; const float* rs;
    __device__ __forceinline__ void operator()(const f32x4 (&acc)[2][2][4][2], const Unit& u, int wr, int wc, int fr, int fq) const {
        const int row0 = u.pm * BM + wr * 64 + fr, col0 = u.pn * HALF + wc * 32 + 8 * fq;
#pragma unroll
        for (int ai = 0; ai < 2; ++ai)
#pragma unroll
            for (int m = 0; m < 4; ++m) { const int row = row0 + ai * HALF + m * 16; bf16_t* rowp = O + (size_t)row * ldc + col0;
                const float rstd = __builtin_amdgcn_rsqf(rs[row] * (1.0f / 1024.0f) + 1e-6f);
                const f32x4 g0 = acc[ai][0][m][0] * rstd, g1 = acc[ai][0][m][1] * rstd, u0 = acc[ai][1][m][0] * rstd, u1 = acc[ai][1][m][1] * rstd;
                u32x4 w; w.x = cvt_pk_bf16(silu_f(g0[0]) * u0[0], silu_f(g0[1]) * u0[1]); w.y = cvt_pk_bf16(silu_f(g0[2]) * u0[2], silu_f(g0[3]) * u0[3]);
                w.z = cvt_pk_bf16(silu_f(g1[0]) * u1[0], silu_f(g1[1]) * u1[1]); w.w = cvt_pk_bf16(silu_f(g1[2]) * u1[2], silu_f(g1[3]) * u1[3]);
                *(u32x4*)rowp = w; }
    }
};
template <class Epi, class Sched, bool ALIGN_EPI = false, bool SP2 = false>
__device__ __forceinline__ void gemm_phase(PG8_LAS unsigned char* lds, const Gemm g, const Sched& S, const Epi& E) {
    int tid0 = threadIdx.x; asm volatile("" : "+v"(tid0));
    const int tid = tid0, wid = __builtin_amdgcn_readfirstlane(tid >> 6), lane = tid & 63, wr = wid >> 2, wc = wid & 3, fr = lane & 15, fq = lane >> 4;
    const int K = g.K, nt = K / BK;
    unsigned voffA[2], voffB[2];
#pragma unroll
    for (int i = 0; i < 2; ++i) { int R, C; stage_rc(tid * 16 + i * 8192, R, C); const int Rb = Epi::PERM ? ((R & ~31) + perm32(R & 31)) : R;
        voffA[i] = (unsigned)(R * K + C) * 2u; voffB[i] = (unsigned)(Rb * K + C) * 2u; }
    const size_t kstep = (size_t)(BK * 2);
    const size_t hstep = (size_t)HALF * K * 2;
    const size_t tstep = 2 * hstep;
    const unsigned ldsw = (unsigned)wid * 1024u;
    const int aoff = lds_byte(wr * 64 + fr, fq * 8), boff = lds_byte(wc * 32 + fr, fq * 8);
#define PG8_SA(b, h) (((b) * 2 + (h)) * HTB)
#define PG8_SB(b, h) ((4 + (b) * 2 + (h)) * HTB)
#define PG8_STAGE(bufoff, gbase, voff) do { _Pragma("unroll") for (int _i = 0; _i < 2; ++_i) \
        __builtin_amdgcn_global_load_lds((const unsigned*)((const char*)(gbase) + (voff)[_i]), (PG8_LAS unsigned*)(lds + (bufoff) + ldsw + _i * 8192), 16, 0, 0); } while (0)
#define PG8_LDA(dst, b, h) do { _Pragma("unroll") for (int m = 0; m < 4; ++m) _Pragma("unroll") for (int k = 0; k < 2; ++k) dst[m][k] = *(const PG8_LAS bf16x8*)(lds + PG8_SA(b, h) + aoff + m * 2048 + k * 1024); } while (0)
#define PG8_LDB(dst, b, h) do { _Pragma("unroll") for (int n = 0; n < 2; ++n) _Pragma("unroll") for (int k = 0; k < 2; ++k) dst[n][k] = *(const PG8_LAS bf16x8*)(lds + PG8_SB(b, h) + boff + n * 2048 + k * 1024); } while (0)
#define PG8_MMA(ai, bj, At, Bt) do { __builtin_amdgcn_s_setprio(1); _Pragma("unroll") for (int m = 0; m < 4; ++m) _Pragma("unroll") for (int n = 0; n < 2; ++n) _Pragma("unroll") for (int k = 0; k < 2; ++k) \
        acc[ai][bj][m][n] = __builtin_amdgcn_mfma_f32_16x16x32_bf16(Bt[n][k], At[m][k], acc[ai][bj][m][n], 0, 0, 0); __builtin_amdgcn_s_setprio(0); } while (0)
#define PG8_WAIT_V(n) asm volatile("s_waitcnt vmcnt(" #n ")" ::: "memory")
#define PG8_WAIT_L(n) asm volatile("s_waitcnt lgkmcnt(" #n ")" ::: "memory")
#define PG8_BAR __builtin_amdgcn_s_barrier()
#define PG8_SCHED __builtin_amdgcn_sched_barrier(0)
    Unit cur, nxt; int ui = 0;
    if (!S.next(0, cur)) return;
    f32x4 acc[2][2][4][2];
#pragma unroll
    for (int a = 0; a < 2; ++a)
#pragma unroll
        for (int b = 0; b < 2; ++b)
#pragma unroll
            for (int m = 0; m < 4; ++m)
#pragma unroll
                for (int n = 0; n < 2; ++n) acc[a][b][m][n] = (f32x4){0.f, 0.f, 0.f, 0.f};
    bf16x8 At[4][2], B0[2][2], B1[2][2];
    const char* cA = (const char*)g.A + (size_t)cur.pm * tstep; const char* cB = (const char*)g.Bt + (size_t)cur.pn * tstep;
    S.a_ready(cur);
    if constexpr (SP2) {
        PG8_STAGE(PG8_SB(0, 0), cB, voffB); PG8_STAGE(PG8_SB(0, 1), cB + hstep, voffB); PG8_STAGE(PG8_SA(0, 0), cA, voffA); PG8_STAGE(PG8_SA(0, 1), cA + hstep, voffA);
        if (wr == 1) PG8_BAR;
        PG8_WAIT_V(2); PG8_BAR;
        PG8_STAGE(PG8_SB(1, 0), cB + kstep, voffB); PG8_STAGE(PG8_SA(1, 0), cA + kstep, voffA); PG8_STAGE(PG8_SB(1, 1), cB + hstep + kstep, voffB);
        PG8_WAIT_V(6); PG8_BAR;
    } else {
        PG8_STAGE(PG8_SB(0, 0), cB, voffB); PG8_STAGE(PG8_SA(0, 0), cA, voffA); PG8_STAGE(PG8_SB(0, 1), cB + hstep, voffB); PG8_STAGE(PG8_SA(0, 1), cA + hstep, voffA);
        if (wr == 1) PG8_BAR;
        PG8_WAIT_V(4); PG8_BAR;
        PG8_STAGE(PG8_SB(1, 0), cB + kstep, voffB); PG8_STAGE(PG8_SA(1, 0), cA + kstep, voffA); PG8_STAGE(PG8_SB(1, 1), cB + hstep + kstep, voffB);
        PG8_WAIT_V(6); PG8_BAR;
    }
    for (;;) {
        const bool has_next = S.next(ui + 1, nxt);
        const char* nA = has_next ? (const char*)g.A + (size_t)nxt.pm * tstep : cA; const char* nB = has_next ? (const char*)g.Bt + (size_t)nxt.pn * tstep : cB;
        for (int t = 0; t < nt; t += 2) {
            const bool last = (t == nt - 2);
            const char* a1 = cA + (size_t)(t + 1) * kstep;
            const char* a2 = last ? nA : cA + (size_t)(t + 2) * kstep; const char* b2 = last ? nB : cB + (size_t)(t + 2) * kstep;
            const char* a3 = a2 + kstep; const char* b3 = b2 + kstep;
            if (last && has_next) S.a_ready(nxt);
            if constexpr (SP2) {
            PG8_LDB(B0, 0, 0); PG8_LDB(B1, 0, 1); PG8_SCHED; PG8_LDA(At, 0, 0); PG8_STAGE(PG8_SA(1, 1), a1 + hstep, voffA);
            PG8_WAIT_V(8); PG8_WAIT_L(0); PG8_BAR; PG8_MMA(0, 0, At, B0); PG8_MMA(0, 1, At, B1); PG8_BAR; PG8_SCHED;
            PG8_LDA(At, 0, 1); PG8_STAGE(PG8_SB(0, 0), b2, voffB); PG8_STAGE(PG8_SB(0, 1), b2 + hstep, voffB); PG8_STAGE(PG8_SA(0, 0), a2, voffA);
            PG8_WAIT_V(8); PG8_WAIT_L(0); PG8_BAR; PG8_MMA(1, 0, At, B0); PG8_MMA(1, 1, At, B1); PG8_BAR; PG8_SCHED;
            PG8_LDB(B0, 1, 0); PG8_LDB(B1, 1, 1); PG8_SCHED; PG8_LDA(At, 1, 0); PG8_STAGE(PG8_SA(0, 1), a2 + hstep, voffA);
            PG8_WAIT_V(8); PG8_WAIT_L(0); PG8_BAR; PG8_MMA(0, 0, At, B0); PG8_MMA(0, 1, At, B1); PG8_BAR; PG8_SCHED;
            PG8_LDA(At, 1, 1); PG8_STAGE(PG8_SB(1, 0), b3, voffB); PG8_STAGE(PG8_SB(1, 1), b3 + hstep, voffB); PG8_STAGE(PG8_SA(1, 0), a3, voffA);
            PG8_WAIT_V(8); PG8_WAIT_L(0); PG8_BAR; PG8_MMA(1, 0, At, B0); PG8_MMA(1, 1, At, B1); PG8_BAR; PG8_SCHED;
            } else {
            PG8_LDB(B0, 0, 0); PG8_SCHED; PG8_LDA(At, 0, 0); PG8_STAGE(PG8_SA(1, 1), a1 + hstep, voffA);
            PG8_WAIT_L(8); PG8_BAR; PG8_WAIT_L(0); PG8_MMA(0, 0, At, B0); PG8_BAR; PG8_SCHED;
            PG8_LDB(B1, 0, 1); PG8_STAGE(PG8_SB(0, 0), b2, voffB);
            PG8_BAR; PG8_WAIT_L(0); PG8_MMA(0, 1, At, B1); PG8_BAR;
            PG8_LDA(At, 0, 1); PG8_STAGE(PG8_SA(0, 0), a2, voffA);
            PG8_BAR; PG8_WAIT_L(0); PG8_MMA(1, 0, At, B0); PG8_BAR; PG8_SCHED;
            PG8_STAGE(PG8_SB(0, 1), b2 + hstep, voffB);
            PG8_WAIT_V(6); PG8_BAR; PG8_MMA(1, 1, At, B1); PG8_BAR;
            PG8_LDB(B0, 1, 0); PG8_SCHED; PG8_LDA(At, 1, 0); PG8_STAGE(PG8_SA(0, 1), a2 + hstep, voffA);
            PG8_WAIT_L(8); PG8_BAR; PG8_WAIT_L(0); PG8_MMA(0, 0, At, B0); PG8_BAR; PG8_SCHED;
            PG8_LDB(B1, 1, 1); PG8_STAGE(PG8_SB(1, 0), b3, voffB);
            PG8_BAR; PG8_WAIT_L(0); PG8_MMA(0, 1, At, B1); PG8_BAR;
            PG8_LDA(At, 1, 1); PG8_STAGE(PG8_SA(1, 0), a3, voffA);
            PG8_BAR; PG8_WAIT_L(0); PG8_MMA(1, 0, At, B0); PG8_BAR; PG8_SCHED;
            PG8_STAGE(PG8_SB(1, 1), b3 + hstep, voffB);
            PG8_WAIT_V(6); PG8_BAR; PG8_MMA(1, 1, At, B1); PG8_BAR;
            }
        }
        if constexpr (ALIGN_EPI) { if (wr == 0) PG8_BAR; }
        if constexpr (!Epi::AFTER_DRAIN) { E(acc, cur, wr, wc, fr, fq); S.done(cur); }
        if (!has_next) break;
#pragma unroll
        for (int a = 0; a < 2; ++a)
#pragma unroll
            for (int b = 0; b < 2; ++b)
#pragma unroll
                for (int m = 0; m < 4; ++m)
#pragma unroll
                    for (int n = 0; n < 2; ++n) acc[a][b][m][n] = (f32x4){0.f, 0.f, 0.f, 0.f};
        cur = nxt; cA = nA; cB = nB; ++ui;
        if constexpr (ALIGN_EPI) { if (wr == 1) PG8_BAR; }
    }
    PG8_WAIT_V(0);
    if constexpr (!ALIGN_EPI) { if (wr == 0) PG8_BAR; }
    PG8_BAR;
    if constexpr (Epi::AFTER_DRAIN) { E.fused(acc, cur, wr, wc, fr, fq, lds, wid, lane); S.done(cur); }
#undef PG8_SA
#undef PG8_SB
#undef PG8_STAGE
#undef PG8_LDA
#undef PG8_LDB
#undef PG8_MMA
#undef PG8_WAIT_V
#undef PG8_WAIT_L
#undef PG8_BAR
#undef PG8_SCHED
}
}
#define GAS __attribute__((address_space(1)))
#define LAS __attribute__((address_space(3)))
typedef unsigned short bf16;
typedef unsigned v4u __attribute__((ext_vector_type(4)));
typedef float f32x4 __attribute__((ext_vector_type(4)));
typedef short bf16x8 __attribute__((ext_vector_type(8)));
typedef GAS unsigned gu32;
typedef GAS unsigned long long gu64;
#define RLX_AGENT __ATOMIC_RELAXED, __HIP_MEMORY_SCOPE_AGENT
#define LDS_WAIT() asm volatile("s_waitcnt lgkmcnt(0)" ::: "memory")
#define VM_WAIT() asm volatile("s_waitcnt vmcnt(0)" ::: "memory")
__device__ __forceinline__ unsigned long long rt() { return __builtin_amdgcn_s_memrealtime(); }
__device__ __forceinline__ unsigned f2bf(float f) { unsigned u = __builtin_bit_cast(unsigned, f); return (u + 0x7fffu + ((u >> 16) & 1u)) >> 16; }
__device__ __forceinline__ unsigned pk2(float lo, float hi) { return f2bf(lo) | (f2bf(hi) << 16); }
#define XB_TMO      128
#define XB_XCNT(j)  (256  + 64 * (j))
#define XB_XSUB(j)  (1280 + 64 * (j))
#define XB_XGEN(j)  (2304 + 64 * (j))
#define XB_TOP      3328
#define XB_TOPGEN   3392
#define XCD_BAR_WORDS 3456
#define XB_SPIN_CAP (1u << 18)

__device__ __forceinline__ unsigned xb_ld(unsigned* p)              { return __hip_atomic_load(p, __ATOMIC_RELAXED, __HIP_MEMORY_SCOPE_AGENT); }
__device__ __forceinline__ unsigned xb_add(unsigned* p, unsigned v) { return __hip_atomic_fetch_add(p, v, __ATOMIC_RELAXED, __HIP_MEMORY_SCOPE_AGENT); }
__device__ __forceinline__ unsigned xb_xcc_id() { return (unsigned)__builtin_amdgcn_s_getreg((3 << 11) | 20) & 0xFu; }
#define XB_SPIN(cond, bar) do { unsigned _sp = 0; while (cond) { __builtin_amdgcn_s_sleep(1); \
    if ((++_sp & 255u) == 0u) { if (xb_ld(&(bar)[XB_TMO])) break; if (_sp > XB_SPIN_CAP) { atomicAdd(&(bar)[XB_TMO], 1u); break; } } } } while (0)

struct XcdBarrier {
    unsigned* bar; unsigned x;
    volatile LAS unsigned* st;
};

__device__ __forceinline__ XcdBarrier xcd_barrier_post(unsigned* bar, volatile LAS unsigned* st) {
    XcdBarrier b; b.bar = bar; b.x = xb_xcc_id(); b.st = st;
    if (threadIdx.x == 0) (void)xb_add(&bar[XB_XCNT(b.x)], 1u);
    return b;
}
__device__ __forceinline__ void xcd_barrier_complete(unsigned* bar, unsigned x, unsigned& nloc, unsigned& nx) {
    const unsigned G = gridDim.x * gridDim.y * gridDim.z;
    unsigned sum, cnt, mine, sp = 0u;
    for (;;) {
        sum = 0u; cnt = 0u; mine = 0u;
#pragma unroll
        for (unsigned j = 0; j < 16; ++j) { const unsigned c = xb_ld(&bar[XB_XCNT(j)]); sum += c; cnt += (c > 0u) ? 1u : 0u; mine = (j == x) ? c : mine; }
        if (sum == G) break;
        __builtin_amdgcn_s_sleep(1);
        if ((++sp & 255u) == 0u) { if (xb_ld(&bar[XB_TMO])) break; if (sp > XB_SPIN_CAP) { atomicAdd(&bar[XB_TMO], 1u); break; } }
    }
    nloc = mine > 0u ? mine : 1u; nx = cnt > 0u ? cnt : 1u;
}

__device__ __forceinline__ void xcd_barrier(const XcdBarrier& b) {
    asm volatile("s_waitcnt vmcnt(0)" ::: "memory");
    __syncthreads();
    if (threadIdx.x == 0) {
        unsigned* bar = b.bar;
        __builtin_amdgcn_s_waitcnt(0);
        unsigned nloc = b.st[0], nx = b.st[1];
        if (nloc == 0u) { xcd_barrier_complete(bar, b.x, nloc, nx); b.st[0] = nloc; b.st[1] = nx; }
        const unsigned old = xb_add(&bar[XB_XSUB(b.x)], 1u);
        const unsigned gen = old / nloc;
        if (old + 1u == (gen + 1u) * nloc) {
            __builtin_amdgcn_fence(__ATOMIC_RELEASE, "agent");
            asm volatile("s_waitcnt vmcnt(0)" ::: "memory");
            const unsigned og = xb_add(&bar[XB_TOP], 1u);
            const unsigned tg = og / nx;
            if (og + 1u == (tg + 1u) * nx) xb_add(&bar[XB_TOPGEN], 1u);
            else XB_SPIN(xb_ld(&bar[XB_TOPGEN]) == tg, bar);
            __builtin_amdgcn_fence(__ATOMIC_ACQUIRE, "agent");
            xb_add(&bar[XB_XGEN(b.x)], 1u);
            asm volatile("s_waitcnt vmcnt(0)" ::: "memory");
        } else {
            XB_SPIN(xb_ld(&bar[XB_XGEN(b.x)]) == gen, bar);
            __builtin_amdgcn_fence(__ATOMIC_ACQUIRE, "agent");
            asm volatile("s_waitcnt vmcnt(0)" ::: "memory");
        }
    }
    __syncthreads();
}
constexpr int NWAVES = 8, NTHR = 512;
constexpr int D = 1024, MP = 16384, NSB = 16, SSEQ = 16, MS = NSB * SSEQ, M = MP + MS;
constexpr int NIN = 3076, NPROJ = 3072, DFF = 2816, NGU = 2 * DFF;
constexpr int NCHP = 256, NCH = NCHP + NSB;
constexpr int PC_Q = 0, PC_K = 256, PC_V = 512, PC_Z = 768, PC_X = 1024, PC_B = 1280, PC_C = 1536, PC_CQ = 1792, PC_CF = 2048, PC_CI = 2304, PC_CG = 2560, PC_DX = 2816;
constexpr float EPS = 1e-6f;
enum { I_XP = 0, I_XS, I_CK, I_CV, I_SCONV, I_SSSM, I_SHGRN, I_SPOOL, I_N1, I_WIN, I_AREL, I_CW, I_CB, I_DTB, I_ALOG, I_BD, I_BNRM, I_LB, I_CNRM, I_PW, I_PS, I_WOUT, I_N2, I_WGU, I_WDN, I_NF, N_IN };
constexpr size_t O_YP = 0, O_YS = O_YP + (size_t)MP * D, O_PK = O_YS + (size_t)MS * D, O_PV = O_PK + 2 * 512 * 256, O_PCONV = O_PV + 2 * 512 * 256, O_PSSM = O_PCONV + 2 * 3 * 768,
                 O_PHGRN = O_PSSM + 2 * 4 * 64 * 128, O_PPOOL = O_PHGRN + 2 * 4 * 64 * 64, O_SK = O_PPOOL + 2 * 15 * 256, O_SV = O_SK + (size_t)2 * 16 * 512 * 256,
                 O_SCONV = O_SV + (size_t)2 * 16 * 512 * 256, O_SSSM = O_SCONV + 2 * 16 * 3 * 768, O_SHGRN = O_SSSM + 2 * 16 * 4 * 64 * 128, O_SPOOL = O_SHGRN + 2 * 16 * 4 * 64 * 64,
                 O_END = O_SPOOL + 2 * 16 * 15 * 256;
constexpr size_t MiB = 1u << 20;
constexpr size_t WS_CTL = 0, CTL_ZERO_BYTES = 64 * 1024;
constexpr size_t WL_IN = 0, WL_OUT = 6 * MiB, WL_GU = 8 * MiB, WL_DN = 19 * MiB, WL_STRIDE = 24 * MiB + MiB / 2;
constexpr size_t WS_W = 1 * MiB;
constexpr size_t WS_XN = 50 * MiB;
constexpr size_t WS_PROJ = 83 * MiB;
constexpr size_t WS_STB = 181 * MiB;
constexpr size_t WS_XT = 198 * MiB;
constexpr size_t WS_HALO = 207 * MiB;
constexpr size_t WS_RH = 208 * MiB + MiB / 2;
constexpr size_t WS_STC = 215 * MiB;
constexpr size_t WS_VT = 223 * MiB + MiB / 2;
constexpr size_t WS_DT = 232 * MiB;
constexpr size_t WS_DECB = 233 * MiB;
constexpr size_t WS_DECC = 233 * MiB + 64 * 1024;
constexpr size_t WS_ACS = 233 * MiB + 384 * 1024, WS_DTV = 233 * MiB + 704 * 1024;
constexpr size_t WS_VTA = 234 * MiB;
constexpr size_t WS_END = 243 * MiB;
static_assert(WS_VTA + (size_t)256 * M * 2 <= WS_END, "ws map 2");
constexpr int CW_QUEUE = 512;
static_assert(WS_XN + (size_t)M * D * 2 <= WS_PROJ && WS_PROJ + (size_t)M * NPROJ * 2 <= WS_STB && WS_STB + (size_t)NCH * 4 * 64 * 128 * 2 <= WS_XT && WS_XT + (size_t)NCH * 256 * 64 * 2 <= WS_HALO && WS_HALO + (size_t)256 * 3 * 768 * 2 <= WS_STC && WS_RH + (size_t)NCH * 1280 * 4 <= WS_STC && WS_STC + (size_t)NCH * 4 * 64 * 64 * 2 <= WS_VT && WS_VT + (size_t)NCH * 256 * 64 * 2 <= WS_DT, "ws map");
static_assert(WL_DN + (size_t)D * DFF * 2 <= WL_STRIDE && WS_W + 2 * WL_STRIDE <= WS_XN, "weight map");
constexpr size_t WS_WPT = 128 * 1024;
constexpr size_t WS_RS = 256 * 1024;
constexpr size_t WS_XN2 = 181 * MiB;
static_assert(WS_XN2 + (size_t)M * D * 2 <= 232 * MiB && WS_RS + 2 * (size_t)M * 4 <= MiB, "ws map 3");
constexpr int CW_BAR = 1024;
constexpr int LDS_BYTES = 163840;
constexpr int MISC_OFF = LDS_BYTES - 256;
constexpr int RING_OFF = 0;
typedef LAS float lf32;
typedef float f32x2 __attribute__((ext_vector_type(2)));
struct Args { const float* in[N_IN]; float* out; unsigned char* ws; };
struct Frame {
    LAS unsigned char* lds;
    float* out; unsigned char* ws;
};
__device__ __forceinline__ float* inp(int i) { asm volatile("" : "+s"(i)); return ((float* const __attribute__((address_space(4)))*)__builtin_amdgcn_kernarg_segment_ptr())[i]; }
__device__ __forceinline__ unsigned char* opq(unsigned char* p) { asm volatile("" : "+s"(p)); return p; }
#define ITEM_IDS() int tid_ = threadIdx.x; asm volatile("" : "+v"(tid_)); const int wave_ = __builtin_amdgcn_readfirstlane(tid_ >> 6); const int lane_ = tid_ & 63; (void)lane_; (void)wave_
#define F_XN ((bf16*)opq(F.ws + WS_XN))
#define F_PROJ ((bf16*)opq(F.ws + WS_PROJ))
#define F_ACT ((bf16*)opq(F.ws + WS_PROJ))
#define F_STB ((bf16*)opq(F.ws + WS_STB))
#define F_XT ((bf16*)opq(F.ws + WS_XT))
#define F_HALO ((bf16*)opq(F.ws + WS_HALO))
#define F_ACS ((float*)opq(F.ws + WS_ACS))
#define F_DTV ((float*)opq(F.ws + WS_DTV))
#define F_STC ((bf16*)opq(F.ws + WS_STC))
#define F_VT ((bf16*)opq(F.ws + WS_VT))
#define F_RH ((float*)opq(F.ws + WS_RH))
#define F_VTA ((bf16*)opq(F.ws + WS_VTA))
#define F_WPT ((bf16*)opq(F.ws + WS_WPT))
#define F_RS ((float*)opq(F.ws + WS_RS))
#define F_XN2 ((bf16*)opq(F.ws + WS_XN2))
#define F_DT ((float*)opq(F.ws + WS_DT))
#define F_DECB ((float*)opq(F.ws + WS_DECB))
#define F_DECC ((float*)opq(F.ws + WS_DECC))
#define F_X    (F.out)
__device__ __forceinline__ float bf_lo(unsigned w) { return __builtin_bit_cast(float, w << 16); }
__device__ __forceinline__ float bf_hi(unsigned w) { return __builtin_bit_cast(float, w & 0xffff0000u); }
__device__ __forceinline__ float bf1(bf16 b) { return __builtin_bit_cast(float, (unsigned)b << 16); }
__device__ __forceinline__ void unpack8(const v4u w, float (&v)[8]) { v[0] = bf_lo(w.x); v[1] = bf_hi(w.x); v[2] = bf_lo(w.y); v[3] = bf_hi(w.y); v[4] = bf_lo(w.z); v[5] = bf_hi(w.z); v[6] = bf_lo(w.w); v[7] = bf_hi(w.w); }
__device__ __forceinline__ v4u pack8(const float (&v)[8]) { v4u o; o.x = pk2(v[0], v[1]); o.y = pk2(v[2], v[3]); o.z = pk2(v[4], v[5]); o.w = pk2(v[6], v[7]); return o; }
__device__ __forceinline__ float shx(int lane, float v, int o) { return __builtin_bit_cast(float, __builtin_amdgcn_ds_bpermute((lane ^ o) << 2, __builtin_bit_cast(int, v))); }
__device__ __forceinline__ float shu(int lane, float v, int o) { return __builtin_bit_cast(float, __builtin_amdgcn_ds_bpermute((lane - o) << 2, __builtin_bit_cast(int, v))); }
__device__ __forceinline__ float shi(float v, int idx) { return __builtin_bit_cast(float, __builtin_amdgcn_ds_bpermute(idx << 2, __builtin_bit_cast(int, v))); }
__device__ __forceinline__ float wave_sum_l(int lane, float v) {
#pragma unroll
    for (int o = 1; o < 64; o <<= 1) v += shx(lane, v, o);
    return v;
}
__device__ __forceinline__ float sum16_l(int lane, float v) {
#pragma unroll
    for (int o = 1; o < 16; o <<= 1) v += shx(lane, v, o);
    return v;
}
__device__ __forceinline__ float max16_l(int lane, float v) {
#pragma unroll
    for (int o = 1; o < 16; o <<= 1) v = fmaxf(v, shx(lane, v, o));
    return v;
}
__device__ __forceinline__ float rcp_f(float x) { return __builtin_amdgcn_rcpf(x); }
__device__ __forceinline__ float rsq_f(float x) { return __builtin_amdgcn_rsqf(x); }
__device__ __forceinline__ float sigmoid_f(float x) { return rcp_f(1.0f + __expf(-x)); }
__device__ __forceinline__ float silu_g(float x) { return x * rcp_f(1.0f + __expf(-x)); }
__device__ __forceinline__ float softplus_f(float x) { const float e = __expf(x); return x > 20.f ? x : (e < 0.01f ? e * (1.0f - e * (0.5f - e * (1.0f / 3.0f))) : __logf(1.0f + e)); }
__device__ __forceinline__ f32x4 mfma4(float a, float b, f32x4 c) { return __builtin_amdgcn_mfma_f32_16x16x4f32(a, b, c, 0, 0, 0); }

struct Chunk { int ci, row0, nrows, b; };
__device__ __forceinline__ Chunk chunk_of(int ci) { Chunk c; c.ci = ci; if (ci < NCHP) { c.row0 = 64 * ci; c.nrows = 64; c.b = -1; } else { c.b = ci - NCHP; c.row0 = MP + SSEQ * c.b; c.nrows = SSEQ; } return c; }

__device__ __forceinline__ void tr_item(const float* W, int ldw, int K, bf16* WT, int k0, int nd0, int ns0, float scale, lf32* scr, int lane) {
    float wv_[32];
#pragma unroll
    for (int i = 0; i < 32; ++i) wv_[i] = W[(size_t)(k0 + 2 * i + (lane >> 5)) * ldw + ns0 + (lane & 31)];
#pragma unroll
    for (int i = 0; i < 32; ++i) scr[(2 * i + (lane >> 5)) * 33 + (lane & 31)] = wv_[i];
    LDS_WAIT(); asm volatile("" ::: "memory");
    const int c = lane & 7;
#pragma unroll
    for (int j = 0; j < 4; ++j) { const int n = (lane >> 3) + 8 * j; const lf32* s = scr + (8 * c) * 33 + n;
        v4u o; o.x = pk2(s[0 * 33] * scale, s[1 * 33] * scale); o.y = pk2(s[2 * 33] * scale, s[3 * 33] * scale); o.z = pk2(s[4 * 33] * scale, s[5 * 33] * scale); o.w = pk2(s[6 * 33] * scale, s[7 * 33] * scale);
        *(GAS v4u*)(WT + (size_t)(nd0 + n) * K + k0 + 8 * c) = o; }
    LDS_WAIT(); asm volatile("" ::: "memory");
}
__device__ __forceinline__ void p0_weights(Frame& F, int l, int gw, int NGW, bool pool) {
    ITEM_IDS();
    lf32* scr = (lf32*)(F.lds + wave_ * 16384);
    constexpr int I_IN = 16 * 96, I_OUT = 16 * 32, I_GU = 16 * 176, I_DN = 44 * 32, I_L = I_IN + I_OUT + I_GU + I_DN;
    for (int it = gw; it < I_L; it += NGW) {
        int r = it;
        unsigned char* wl = F.ws + WS_W + (size_t)l * WL_STRIDE;
        if (r < I_IN) { const int kb = r / 96, nb = r % 96, nd0 = 32 * nb; tr_item(inp(I_WIN) + (size_t)l * D * NIN, NIN, D, (bf16*)(wl + WL_IN), 64 * kb, nd0, nd0 < 1792 ? nd0 : nd0 + 4, nd0 < 256 ? 0.125f : 1.0f, scr, lane_); continue; } r -= I_IN;
        if (r < I_OUT) { const int kb = r / 32, nb = r % 32; tr_item(inp(I_WOUT) + (size_t)l * D * D, D, D, (bf16*)(wl + WL_OUT), 64 * kb, 32 * nb, 32 * nb, 1.0f, scr, lane_); continue; } r -= I_OUT;
        if (r < I_GU) { const int kb = r / 176, nb = r % 176, nd0 = 32 * nb, pn = nd0 >> 8, bj = (nd0 >> 7) & 1, c = nd0 & 127; tr_item(inp(I_WGU) + (size_t)l * D * NGU, NGU, D, (bf16*)(wl + WL_GU), 64 * kb, nd0, bj * DFF + 128 * pn + c, 1.0f, scr, lane_); continue; } r -= I_GU;
        { const int kb = r / 32, nb = r % 32; tr_item(inp(I_WDN) + (size_t)l * DFF * D, D, DFF, (bf16*)(wl + WL_DN), 64 * kb, 32 * nb, 32 * nb, 1.0f, scr, lane_); }
    }
    if (pool) { const float* pw = inp(I_PW); for (int i = ((int)blockIdx.x) * NTHR + tid_; i < 2 * 4 * 64 * 64; i += ((int)gridDim.x) * NTHR) { const int c = i & 63, d = (i >> 6) & 63, lg = i >> 12; F_WPT[i] = (bf16)f2bf(pw[(size_t)(lg * 64 + c) * 64 + d]); } }
}
template <bool WITH_DT, bool FINAL>
__device__ __forceinline__ void norm_rows(Frame& F, const float* xlo, const float* xhi, const float* w, const float* wdt  ) {
    ITEM_IDS();
    lf32* wl = (lf32*)F.lds;
    if (WITH_DT) { for (int k = tid_; k < D; k += NTHR) { const f32x4 v = *(const f32x4*)(wdt + (size_t)k * NIN + 1792); *(LAS f32x4*)(wl + 4 * k) = v; } __syncthreads(); }
    const int gw = ((int)blockIdx.x) * NWAVES + wave_, NGW = ((int)gridDim.x) * NWAVES;
    f32x4 wv[4];
#pragma unroll
    for (int j = 0; j < 4; ++j) wv[j] = *(const f32x4*)(w + 256 * j + 4 * lane_);
    for (int m0 = gw; m0 < M; m0 += 4 * NGW) {
        f32x4 v[4][4];
#pragma unroll
        for (int q = 0; q < 4; ++q) { const int m = m0 + q * NGW; if (m < M) { const float* xr = (m < MP ? xlo : xhi) + (size_t)m * D;
#pragma unroll
            for (int j = 0; j < 4; ++j) v[q][j] = *(const f32x4*)(xr + 256 * j + 4 * lane_); } }
#pragma unroll
        for (int q = 0; q < 4; ++q) { const int m = m0 + q * NGW; if (m < M) {
            float s = 0.f;
#pragma unroll
            for (int j = 0; j < 4; ++j) s += (v[q][j].x * v[q][j].x + v[q][j].y * v[q][j].y) + (v[q][j].z * v[q][j].z + v[q][j].w * v[q][j].w);
            const float rstd = rsq_f(wave_sum_l(lane_, s) * (1.0f / D) + EPS);
#pragma unroll
            for (int j = 0; j < 4; ++j) v[q][j] = v[q][j] * rstd * wv[j];
            if (FINAL) {
#pragma unroll
                for (int j = 0; j < 4; ++j) *(f32x4*)(F.out + (size_t)m * D + 256 * j + 4 * lane_) = v[q][j];
            } else {
                GAS unsigned long long* o8 = (GAS unsigned long long*)(F_XN + (size_t)m * D) + lane_;
#pragma unroll
                for (int j = 0; j < 4; ++j) o8[64 * j] = (unsigned long long)pk2(v[q][j].x, v[q][j].y) | ((unsigned long long)pk2(v[q][j].z, v[q][j].w) << 32);
            }
            if (WITH_DT) {
                f32x4 a = {0.f, 0.f, 0.f, 0.f};
#pragma unroll
                for (int j = 0; j < 4; ++j) { const LAS f32x4* wp = (const LAS f32x4*)(wl + 4 * (256 * j + 4 * lane_));
                    a += wp[0] * v[q][j].x; a += wp[1] * v[q][j].y; a += wp[2] * v[q][j].z; a += wp[3] * v[q][j].w; }
                a.x = wave_sum_l(lane_, a.x); a.y = wave_sum_l(lane_, a.y); a.z = wave_sum_l(lane_, a.z); a.w = wave_sum_l(lane_, a.w);
                if (lane_ == 0) *(f32x4*)(F_DT + (size_t)m * 4) = a;
            } } }
    }
    if (WITH_DT) __syncthreads();
}
constexpr int PL_RAW = 0, PL_PL = 79 * 256 * 4, PL_END = PL_PL + 64 * 264 * 2;
static_assert(PL_END <= MISC_OFF, "pool LDS map");
__device__ __forceinline__ void pool_item(Frame& F, int layer, int ci) {
    ITEM_IDS();
    const Chunk c = chunk_of(ci);
    lf32* raw = (lf32*)(F.lds + PL_RAW);
    LAS bf16* Pl = (LAS bf16*)(F.lds + PL_PL);
    const float* spool = inp(I_SPOOL) + (size_t)(layer * NSB + (c.b < 0 ? 0 : c.b)) * 15 * 256;
    v4u pw[5]; f32x4 pf[5][2];
#pragma unroll
    for (int q = 0; q < 5; ++q) { const int it = tid_ + q * NTHR; pw[q] = (v4u){0u, 0u, 0u, 0u}; pf[q][0] = (f32x4){0.f, 0.f, 0.f, 0.f}; pf[q][1] = pf[q][0];
        if (it < 79 * 32) { const int rr = it >> 5, cg = it & 31, r = rr - 15;
            if (r < c.nrows) { if (r >= 0 || (c.b < 0 && c.row0 + r >= 0)) pw[q] = *(const v4u*)(F_PROJ + (size_t)(c.row0 + r) * NPROJ + PC_DX + 8 * cg);
                               else if (c.b >= 0) { const float* s = spool + (size_t)(15 + r) * 256 + 8 * cg; pf[q][0] = *(const f32x4*)s; pf[q][1] = *(const f32x4*)(s + 4); } } } }
#pragma unroll
    for (int q = 0; q < 5; ++q) { const int it = tid_ + q * NTHR;
        if (it < 79 * 32) { const int rr = it >> 5, cg = it & 31, r = rr - 15; float v[8];
            if (c.b >= 0 && r < 0) { v[0] = pf[q][0].x; v[1] = pf[q][0].y; v[2] = pf[q][0].z; v[3] = pf[q][0].w; v[4] = pf[q][1].x; v[5] = pf[q][1].y; v[6] = pf[q][1].z; v[7] = pf[q][1].w; } else unpack8(pw[q], v);
            *(LAS f32x4*)(raw + rr * 256 + 8 * cg) = (f32x4){v[0], v[1], v[2], v[3]}; *(LAS f32x4*)(raw + rr * 256 + 8 * cg + 4) = (f32x4){v[4], v[5], v[6], v[7]}; } }
    __syncthreads();
    { const int ch = tid_ & 255, half = tid_ >> 8, win = 2 << (ch >> 6); const float inv = 1.0f / (float)win;
      for (int r = 32 * half; r < 32 * half + 32; ++r) { float s = 0.f; for (int q = 0; q < win; ++q) s += raw[(r + 15 - q) * 256 + ch]; Pl[r * 264 + ch] = (bf16)f2bf(s * inv - raw[(r + 15) * 256 + ch]); } }
    __syncthreads();
    const int tb = wave_ >> 1, g0 = 2 * (wave_ & 1), kq = lane_ >> 4, fr = lane_ & 15;
    const bf16* wt = F_WPT + (size_t)layer * 4 * 64 * 64; const float* sc = inp(I_PS) + (size_t)layer * 256;
#pragma unroll
    for (int gg = 0; gg < 2; ++gg) {
        const int g = g0 + gg;
        bf16x8 bw[4][2];
#pragma unroll
        for (int t = 0; t < 4; ++t)
#pragma unroll
            for (int ks = 0; ks < 2; ++ks) bw[t][ks] = *(const bf16x8*)(wt + (size_t)(g * 64 + t * 16 + fr) * 64 + 32 * ks + 8 * kq);
        bf16x8 a[2];
#pragma unroll
        for (int ks = 0; ks < 2; ++ks) a[ks] = *(const LAS bf16x8*)(Pl + (tb * 16 + fr) * 264 + g * 64 + 32 * ks + 8 * kq);
#pragma unroll
        for (int t = 0; t < 4; ++t) { f32x4 acc = {0.f, 0.f, 0.f, 0.f};
#pragma unroll
            for (int ks = 0; ks < 2; ++ks) acc = __builtin_amdgcn_mfma_f32_16x16x32_bf16(a[ks], bw[t][ks], acc, 0, 0, 0);
            const float s = sc[g * 64 + t * 16 + fr];
#pragma unroll
            for (int r = 0; r < 4; ++r) { const int row = tb * 16 + 4 * kq + r; if (row < c.nrows) F_XN[(size_t)(c.row0 + row) * D + 768 + g * 64 + t * 16 + fr] = (bf16)f2bf(acc[r] * s); } }
    }
    __syncthreads();
}

__device__ __forceinline__ void copy_cache(Frame& F, int layer, int b0, int nb) {
    ITEM_IDS();
    const int gt = b0 * NTHR + tid_, GT = nb * NTHR;
    float* out = F.out; const float* ckp = inp(I_CK); const float* cvp = inp(I_CV);
    for (int base = gt; base < 32 * 31744; base += 8 * GT) {
        f32x4 v[8];
#pragma unroll
        for (int q = 0; q < 8; ++q) { const int i = base + q * GT; if (i < 32 * 31744) { const int wb = i / 31744, e = i - wb * 31744; const int which = wb >> 4, b = wb & 15;
            v[q] = *(const f32x4*)((which ? cvp : ckp) + ((size_t)(layer * NSB + b) * 512 + 16) * 256 + 4 * (size_t)e); } }
#pragma unroll
        for (int q = 0; q < 8; ++q) { const int i = base + q * GT; if (i < 32 * 31744) { const int wb = i / 31744, e = i - wb * 31744; const int which = wb >> 4, b = wb & 15;
            *(f32x4*)(out + (which ? O_SV : O_SK) + (size_t)(layer * NSB + b) * 512 * 256 + 4 * (size_t)e) = v[q]; } }
    }
}
__device__ __forceinline__ void copy_small(Frame& F, int layer, int b0, int nb) {
    ITEM_IDS();
    const int gt = b0 * NTHR + tid_, GT = nb * NTHR;
    float* out = F.out;
    constexpr int T_P = 2 * 512 * 32, T_S = 2 * 16 * 16 * 32, T_D = 17 * 15 * 32, T_ALL = T_P + T_S + T_D;
    for (int base = gt; base < T_ALL; base += 4 * GT) {
        v4u w[4];
#pragma unroll
        for (int q = 0; q < 4; ++q) { int t = base + q * GT; if (t < T_ALL) { size_t src;
            if (t < T_P) { const int which = t >> 14, j = (t >> 5) & 511, cg = t & 31; src = (size_t)(MP - 512 + j) * NPROJ + (which ? PC_V : PC_K) + 8 * cg; }
            else if (t < T_P + T_S) { t -= T_P; const int which = t >> 13, b = (t >> 9) & 15, j = (t >> 5) & 15, cg = t & 31; src = (size_t)(MP + 16 * b + j) * NPROJ + (which ? PC_V : PC_K) + 8 * cg; }
            else { t -= T_P + T_S; const int b = t / 480, rr = (t / 32) % 15, cg = t & 31; src = (size_t)(b == 0 ? MP - 15 + rr : MP + 16 * (b - 1) + 1 + rr) * NPROJ + PC_DX + 8 * cg; }
            w[q] = *(const v4u*)(F_PROJ + src); } }
#pragma unroll
        for (int q = 0; q < 4; ++q) { int t = base + q * GT; if (t < T_ALL) { size_t dst;
            if (t < T_P) { const int which = t >> 14, j = (t >> 5) & 511, cg = t & 31; dst = (which ? O_PV : O_PK) + (size_t)layer * 512 * 256 + j * 256 + 8 * cg; }
            else if (t < T_P + T_S) { t -= T_P; const int which = t >> 13, b = (t >> 9) & 15, j = (t >> 5) & 15, cg = t & 31; dst = (which ? O_SV : O_SK) + ((size_t)(layer * NSB + b) * 512 + 496 + j) * 256 + 8 * cg; }
            else { t -= T_P + T_S; const int b = t / 480, rr = (t / 32) % 15, cg = t & 31; dst = (b == 0 ? O_PPOOL + (size_t)layer * 3840 : O_SPOOL + (size_t)(layer * NSB + b - 1) * 3840) + rr * 256 + 8 * cg; }
            float v[8]; unpack8(w[q], v); *(f32x4*)(out + dst) = (f32x4){v[0], v[1], v[2], v[3]}; *(f32x4*)(out + dst + 4) = (f32x4){v[4], v[5], v[6], v[7]}; } }
    }
}
constexpr int KS_LD = 72, PS_LD = 584;
constexpr int AT_KS = 0, AT_VT = 576 * KS_LD * 2, AT_ST = AT_VT + 64 * PS_LD * 2, AT_BIAS = AT_ST + 1024;
static_assert(AT_BIAS + 4 * 260 * 4 <= MISC_OFF, "attention LDS map");
__device__ __forceinline__ void attn_bias_load(Frame& F, int layer) { const float* arel = inp(I_AREL) + (size_t)layer * 257 * 4; lf32* b = (lf32*)(F.lds + AT_BIAS); ITEM_IDS(); for (int i = tid_; i < 257 * 4; i += NTHR) b[260 * (i & 3) + (i >> 2)] = arel[i]; }
__device__ __forceinline__ void attn_item(Frame& F, int layer, int ci, int h) {
    ITEM_IDS();
    const Chunk c = chunk_of(ci);
    LAS bf16* Ks = (LAS bf16*)(F.lds + AT_KS); LAS bf16* Ps = Ks; LAS bf16* Vt = (LAS bf16*)(F.lds + AT_VT);
    lf32* mx = (lf32*)(F.lds + AT_ST); lf32* sm = mx + 128; lf32* bias = (lf32*)(F.lds + AT_BIAS) + 260 * h;
    const int jlo = (c.b < 0) ? (ci < 8 ? 64 * (8 - ci) : 0) : 0;
    const int jval = (c.b < 0) ? 576 : 528;
    const float* ckp = inp(I_CK); const float* cvp = inp(I_CV);
    bf16x8 qa0 = {0, 0, 0, 0, 0, 0, 0, 0}, qa1 = qa0;
    if (c.b < 0 || (wave_ >> 1) == 0) { const bf16* qp = F_PROJ + (size_t)(c.row0 + (wave_ >> 1) * 16 + (lane_ & 15)) * NPROJ + PC_Q + 64 * h + 8 * (lane_ >> 4); qa0 = *(const bf16x8*)qp; qa1 = *(const bf16x8*)(qp + 32); }
    if (c.b < 0) {
        const bf16* kg = F_PROJ + (long)(c.row0 - 512) * NPROJ + PC_K + 64 * h;
        const bf16* vg = F_VTA + (long)(64 * h) * M + (long)(c.row0 - 512);
        const int npc = (576 - jlo) >> 3, nk = (576 - jlo) * 8, nv = 64 * npc;
        v4u kr[9], vr[9];
#pragma unroll
        for (int q = 0; q < 9; ++q) { const int it = tid_ + q * NTHR;
            if (it < nk) kr[q] = *(const v4u*)(kg + (long)(jlo + (it >> 3)) * NPROJ + 8 * (it & 7));
            if (it < nv) { const int d = it / npc, pc = it - d * npc; vr[q] = *(const v4u*)(vg + (long)d * M + jlo + 8 * pc); } }
#pragma unroll
        for (int q = 0; q < 9; ++q) { const int it = tid_ + q * NTHR;
            if (it < nk) *(LAS v4u*)(Ks + (jlo + (it >> 3)) * KS_LD + 8 * (it & 7)) = kr[q];
            if (it < nv) { const int d = it / npc, pc = it - d * npc; *(LAS v4u*)(Vt + d * PS_LD + jlo + 8 * pc) = vr[q]; } }
    } else {
    for (int it = tid_; it < (576 - jlo) * 8; it += NTHR) {
        const int j = jlo + (it >> 3), dg = it & 7;
        v4u kw, vw;
        if (j < 512) { const size_t o = (((size_t)(layer * NSB + c.b) * 512 + j) * 4 + h) * 64 + 8 * dg; const float* kp = ckp + o; const float* vp = cvp + o;
            const f32x4 k0 = *(const f32x4*)kp, k1 = *(const f32x4*)(kp + 4), v0 = *(const f32x4*)vp, v1 = *(const f32x4*)(vp + 4);
            kw.x = pk2(k0.x, k0.y); kw.y = pk2(k0.z, k0.w); kw.z = pk2(k1.x, k1.y); kw.w = pk2(k1.z, k1.w); vw.x = pk2(v0.x, v0.y); vw.y = pk2(v0.z, v0.w); vw.z = pk2(v1.x, v1.y); vw.w = pk2(v1.z, v1.w); }
        else if (j < 528) { const size_t row = (size_t)(c.row0 + j - 512); kw = *(const v4u*)(F_PROJ + row * NPROJ + PC_K + 64 * h + 8 * dg); vw = *(const v4u*)(F_PROJ + row * NPROJ + PC_V + 64 * h + 8 * dg); }
        else { kw = (v4u){0u, 0u, 0u, 0u}; vw = kw; }
        *(LAS v4u*)(Ks + j * KS_LD + 8 * dg) = kw;
        LAS bf16* vt = Vt + (8 * dg) * PS_LD + j;
        vt[0 * PS_LD] = (bf16)(vw.x & 0xffffu); vt[1 * PS_LD] = (bf16)(vw.x >> 16); vt[2 * PS_LD] = (bf16)(vw.y & 0xffffu); vt[3 * PS_LD] = (bf16)(vw.y >> 16);
        vt[4 * PS_LD] = (bf16)(vw.z & 0xffffu); vt[5 * PS_LD] = (bf16)(vw.z >> 16); vt[6 * PS_LD] = (bf16)(vw.w & 0xffffu); vt[7 * PS_LD] = (bf16)(vw.w >> 16);
    }
    }
    __syncthreads();
    const int qb = wave_ >> 1, kh = wave_ & 1, kq = lane_ >> 4, fr = lane_ & 15;
    const bool active = (c.b < 0) || (qb == 0);
    const int ntw = (576 - jlo) / 32;
    const int kbase = jlo + kh * ntw * 16;
    f32x4 s[18];
    float mloc = -3.0e38f;
    const int iq = qb * 16 + fr;
    if (active) {
#pragma unroll
        for (int t = 0; t < 18; ++t) {
            s[t] = (f32x4){0.f, 0.f, 0.f, 0.f};
            if (t < ntw) {
                const LAS bf16* kp = Ks + (kbase + t * 16 + fr) * KS_LD + 8 * kq;
                const bf16x8 kb0 = *(const LAS bf16x8*)kp, kb1 = *(const LAS bf16x8*)(kp + 32);
                s[t] = __builtin_amdgcn_mfma_f32_16x16x32_bf16(kb0, qa0, s[t], 0, 0, 0);
                s[t] = __builtin_amdgcn_mfma_f32_16x16x32_bf16(kb1, qa1, s[t], 0, 0, 0);
#pragma unroll
                for (int r = 0; r < 4; ++r) { const int j = kbase + t * 16 + 4 * kq + r; int rel = 512 + iq - j; rel = rel > 128 ? 128 : rel; float v = s[t][r] + bias[rel + 128]; if (j >= jval) v = -1.0e30f; s[t][r] = v; mloc = fmaxf(mloc, v); }
            }
        }
        mloc = fmaxf(mloc, shx(lane_, mloc, 16)); mloc = fmaxf(mloc, shx(lane_, mloc, 32));
        if (kq == 0) mx[iq * 2 + kh] = mloc;
    }
    __syncthreads();
    if (active) {
        mloc = fmaxf(mx[iq * 2], mx[iq * 2 + 1]);
        float lsum = 0.f;
#pragma unroll
        for (int t = 0; t < 18; ++t) if (t < ntw) {
            const float p0 = __expf(s[t][0] - mloc), p1 = __expf(s[t][1] - mloc), p2 = __expf(s[t][2] - mloc), p3 = __expf(s[t][3] - mloc);
            lsum += (p0 + p1) + (p2 + p3);
            *(LAS f32x2*)(Ps + iq * PS_LD + kbase + t * 16 + 4 * kq) = __builtin_bit_cast(f32x2, (unsigned long long)pk2(p0, p1) | ((unsigned long long)pk2(p2, p3) << 32));
        }
        lsum += shx(lane_, lsum, 16); lsum += shx(lane_, lsum, 32);
        if (kq == 0) sm[iq * 2 + kh] = lsum;
    }
    __syncthreads();
    if (active) {
        f32x4 o[2] = {(f32x4){0.f, 0.f, 0.f, 0.f}, (f32x4){0.f, 0.f, 0.f, 0.f}};
        const int nks = (576 - jlo) / 32;
        for (int ks = 0; ks < nks; ++ks) {
            const int j0 = jlo + 32 * ks + 8 * kq;
            const bf16x8 pa = *(const LAS bf16x8*)(Ps + iq * PS_LD + j0);
#pragma unroll
            for (int t = 0; t < 2; ++t) { const bf16x8 vb = *(const LAS bf16x8*)(Vt + (kh * 32 + t * 16 + fr) * PS_LD + j0); o[t] = __builtin_amdgcn_mfma_f32_16x16x32_bf16(vb, pa, o[t], 0, 0, 0); }
        }
        const float inv = rcp_f(sm[iq * 2] + sm[iq * 2 + 1]);
#pragma unroll
        for (int t = 0; t < 2; ++t) *(f32x2*)(F_XN + (size_t)(c.row0 + iq) * D + 64 * h + kh * 32 + t * 16 + 4 * kq) =
            __builtin_bit_cast(f32x2, (unsigned long long)pk2(o[t][0] * inv, o[t][1] * inv) | ((unsigned long long)pk2(o[t][2] * inv, o[t][3] * inv) << 32));
    }
    __syncthreads();
}
__device__ __forceinline__ void scan_phase(Frame& F, int layer) {
    ITEM_IDS();
    lf32* db = (lf32*)F.lds; lf32* dcl = db + NCHP * 4;
    for (int i = tid_; i < NCHP * 4; i += NTHR) db[i] = F_DECB[i];
    __syncthreads();
    constexpr int NSCAN = 48;
    if (((int)blockIdx.x) < NSCAN) {
        for (int u = ((int)blockIdx.x) * NTHR + tid_; u < 24576; u += NSCAN * NTHR) {
            const bool isb = u < 16384; const int u2 = isb ? u : u - 16384;
            unsigned* st = isb ? (unsigned*)F_STB + u2 : (unsigned*)F_STC + u2; const size_t cs = isb ? 16384 : 8192;
            const int hk = (u2 >> 11) * 64 + 2 * (u2 & 31); const float* dg = F_DECC + hk; const int hb = u2 >> 12;
            float r0 = 0.f, r1 = 0.f;
            for (int c0 = 0; c0 < NCHP; c0 += 32) {
                unsigned sl[32]; f32x2 dd[32];
#pragma unroll
                for (int i = 0; i < 32; ++i) { sl[i] = st[(size_t)(c0 + i) * cs]; if (!isb) dd[i] = *(const f32x2*)(dg + (size_t)(c0 + i) * 256); }
#pragma unroll
                for (int i = 0; i < 32; ++i) { float d0, d1; if (isb) { d0 = db[(c0 + i) * 4 + hb]; d1 = d0; } else { d0 = dd[i].x; d1 = dd[i].y; }
                    st[(size_t)(c0 + i) * cs] = pk2(r0, r1); r0 = d0 * r0 + bf_lo(sl[i]); r1 = d1 * r1 + bf_hi(sl[i]); }
            }
            if (isb) *(f32x2*)(F.out + O_PSSM + (size_t)layer * 32768 + 2 * u2) = (f32x2){r0, r1};
            else { const int v = (u2 >> 5) & 63; float* o = F.out + O_PHGRN + (size_t)layer * 16384 + (size_t)hk * 64 + v; o[0] = r0; o[64] = r1; }
        }
    }
    else {
        const int nb = ((int)gridDim.x) - NSCAN, b0 = ((int)blockIdx.x) - NSCAN;
        copy_small(F, layer, b0, nb);
        const float* sssm = inp(I_SSSM) + (size_t)layer * NSB * 32768; const float* shgrn = inp(I_SHGRN) + (size_t)layer * NSB * 16384;
        float* osb = F.out + O_SSSM + (size_t)layer * NSB * 32768; float* osc = F.out + O_SHGRN + (size_t)layer * NSB * 16384;
        for (int t = b0 * NTHR + tid_; t < NSB * 8192; t += nb * NTHR) {
            const int b = t >> 13, e = (t & 8191) * 4; const f32x4 s0 = *(const f32x4*)(sssm + (size_t)b * 32768 + e); const unsigned long long w = *(const unsigned long long*)(F_STB + (size_t)(NCHP + b) * 32768 + e);
            const float d = F_DECB[(NCHP + b) * 4 + (e >> 13)];
            *(f32x4*)(osb + (size_t)b * 32768 + e) = (f32x4){d * s0.x + bf_lo((unsigned)w), d * s0.y + bf_hi((unsigned)w), d * s0.z + bf_lo((unsigned)(w >> 32)), d * s0.w + bf_hi((unsigned)(w >> 32))}; }
        for (int t = b0 * NTHR + tid_; t < NSB * 4096; t += nb * NTHR) {
            const int b = t >> 12, e2 = (t & 4095) * 4, hk = e2 >> 6, v = e2 & 63; const f32x4 s0 = *(const f32x4*)(shgrn + (size_t)b * 16384 + e2);
            const bf16* sp = F_STC + (size_t)(NCHP + b) * 16384 + (size_t)((hk >> 6) * 64 + v) * 64 + (hk & 63); const float d = F_DECC[(size_t)(NCHP + b) * 256 + hk];
            *(f32x4*)(osc + (size_t)b * 16384 + e2) = (f32x4){d * s0.x + bf1(sp[0]), d * s0.y + bf1(sp[64]), d * s0.z + bf1(sp[128]), d * s0.w + bf1(sp[192])}; }
    }
}
constexpr int SP_XT = 0, SP_BT = 256 * 72 * 2, SP_ACS = 2 * 256 * 72 * 2, SP_DTV = SP_ACS + 1024, SP_SJ = SP_DTV + 1024, SP_END = SP_SJ + 1024;
static_assert(SP_END <= MISC_OFF, "ssd_prep LDS map");
__device__ __forceinline__ void ssd_prep_item(Frame& F, int layer, int ci) {
    ITEM_IDS();
    const Chunk c = chunk_of(ci);
    LAS bf16* XTl = (LAS bf16*)(F.lds + SP_XT); LAS bf16* BTl = (LAS bf16*)(F.lds + SP_BT);
    lf32* acs = (lf32*)(F.lds + SP_ACS); lf32* dtv = (lf32*)(F.lds + SP_DTV); lf32* sj = (lf32*)(F.lds + SP_SJ);
    const int cg = tid_ % 96, seg = tid_ / 96, col = 8 * cg;
    const bool act = seg < 4 && 16 * seg < c.nrows;
    bf16* prow = F_PROJ + (size_t)c.row0 * NPROJ + PC_X + col;
    v4u raw[19];
    if (act) {
#pragma unroll
        for (int q = 0; q < 19; ++q) { const int r = 16 * seg - 3 + q;
            if (r >= 0) raw[q] = *(const v4u*)(prow + (size_t)r * NPROJ);
            else if (c.b < 0) { if (ci > 0) raw[q] = *(const v4u*)(F_HALO + ((size_t)(ci - 1) * 3 + (3 + r)) * 768 + col); else raw[q] = (v4u){0u, 0u, 0u, 0u}; }
            else { const float* s = inp(I_SCONV) + ((size_t)(layer * NSB + c.b) * 3 + (3 + r)) * 768 + col; const f32x4 a = *(const f32x4*)s, b2 = *(const f32x4*)(s + 4);
                raw[q].x = pk2(a.x, a.y); raw[q].y = pk2(a.z, a.w); raw[q].z = pk2(b2.x, b2.y); raw[q].w = pk2(b2.z, b2.w); } }
    }
    if (wave_ == 6) { const int r = lane_; const float* dtb = inp(I_DTB) + layer * 4; const float* alg = inp(I_ALOG) + layer * 4;
        f32x4 raw4 = {0.f, 0.f, 0.f, 0.f}; if (r < c.nrows) raw4 = *(const f32x4*)(F_DT + (size_t)(c.row0 + r) * 4);
        f32x4 dt4, ac4;
#pragma unroll
        for (int h = 0; h < 4; ++h) { float dt = 0.f; if (r < c.nrows) dt = softplus_f(raw4[h] + dtb[h]); float v = -__expf(alg[h]) * dt;
#pragma unroll
            for (int o = 1; o < 64; o <<= 1) { const float t = shu(lane_, v, o); if (lane_ >= o) v += t; }
            const float last = shi(v, 63);
            dt4[h] = dt; ac4[h] = v; acs[r * 4 + h] = v; dtv[r * 4 + h] = dt; sj[h * 64 + r] = dt * __expf(last - v);
            if (r == 63) F_DECB[ci * 4 + h] = __expf(last); }
        if (r < c.nrows) { *(f32x4*)(F_DTV + (size_t)(c.row0 + r) * 4) = dt4; *(f32x4*)(F_ACS + (size_t)(c.row0 + r) * 4) = ac4; } }
    if (c.nrows < 64) { for (int i = tid_; i < 2 * 256 * 72 / 2; i += NTHR) ((LAS unsigned*)XTl)[i] = 0u; }
    asm volatile("s_waitcnt vmcnt(0)" ::: "memory");
    __syncthreads();
    if (act) {
        if (ci == NCHP - 1 && seg == 3) {
#pragma unroll
            for (int q = 0; q < 3; ++q) { float v[8]; unpack8(raw[16 + q], v); float* o = F.out + O_PCONV + (size_t)layer * 2304 + q * 768 + col;
                *(f32x4*)o = (f32x4){v[0], v[1], v[2], v[3]}; *(f32x4*)(o + 4) = (f32x4){v[4], v[5], v[6], v[7]}; } }
        if (c.b >= 0) {
#pragma unroll
            for (int q = 0; q < 3; ++q) { float v[8]; unpack8(raw[16 + q], v); float* o = F.out + O_SCONV + ((size_t)(layer * NSB + c.b) * 3 + q) * 768 + col;
                *(f32x4*)o = (f32x4){v[0], v[1], v[2], v[3]}; *(f32x4*)(o + 4) = (f32x4){v[4], v[5], v[6], v[7]}; } }
        const float* cw = inp(I_CW) + (size_t)layer * 4 * 768 + col; const float* cb = inp(I_CB) + (size_t)layer * 768 + col;
        LAS bf16* tl = (cg < 32) ? XTl + col * 72 : BTl + (col - 256) * 72;
#pragma unroll
        for (int hc = 0; hc < 2; ++hc) {
            float w0[4], w1[4], w2[4], w3[4], bb[4];
#pragma unroll
            for (int e = 0; e < 4; ++e) { bb[e] = cb[4 * hc + e]; w0[e] = cw[4 * hc + e]; w1[e] = cw[768 + 4 * hc + e]; w2[e] = cw[2 * 768 + 4 * hc + e]; w3[e] = cw[3 * 768 + 4 * hc + e]; }
#pragma unroll
            for (int i = 0; i < 16; i += 2) {
                float x[5][4];
#pragma unroll
                for (int q = 0; q < 5; ++q) { const unsigned ua = hc ? raw[i + q].z : raw[i + q].x, ub = hc ? raw[i + q].w : raw[i + q].y; x[q][0] = bf_lo(ua); x[q][1] = bf_hi(ua); x[q][2] = bf_lo(ub); x[q][3] = bf_hi(ub); }
                float ya[4], yb[4];
#pragma unroll
                for (int e = 0; e < 4; ++e) { ya[e] = silu_g(bb[e] + w0[e] * x[0][e] + w1[e] * x[1][e] + w2[e] * x[2][e] + w3[e] * x[3][e]); yb[e] = silu_g(bb[e] + w0[e] * x[1][e] + w1[e] * x[2][e] + w2[e] * x[3][e] + w3[e] * x[4][e]); }
                const int r = 16 * seg + i;
                *(unsigned long long*)(prow + (size_t)r * NPROJ + 4 * hc) = (unsigned long long)pk2(ya[0], ya[1]) | ((unsigned long long)pk2(ya[2], ya[3]) << 32);
                *(unsigned long long*)(prow + (size_t)(r + 1) * NPROJ + 4 * hc) = (unsigned long long)pk2(yb[0], yb[1]) | ((unsigned long long)pk2(yb[2], yb[3]) << 32);
                if (cg < 64) {
#pragma unroll
                    for (int e = 0; e < 4; ++e) *(LAS unsigned*)(tl + (4 * hc + e) * 72 + r) = pk2(ya[e], yb[e]); }
            }
        }
    }
    __syncthreads();
    { const int ch = tid_ >> 1, hf = tid_ & 1; bf16* dst = F_XT + ((size_t)ci * 256 + ch) * 64 + 32 * hf; const LAS bf16* src = XTl + ch * 72 + 32 * hf;
#pragma unroll
      for (int q = 0; q < 4; ++q) *(v4u*)(dst + 8 * q) = *(const LAS v4u*)(src + 8 * q); }
    const int kq = lane_ >> 4, fr = lane_ & 15, h = wave_ >> 1, g = h >> 1;
#pragma unroll
    for (int pi = 0; pi < 2; ++pi) {
        const int pb = 2 * (wave_ & 1) + pi;
        bf16x8 af[2];
#pragma unroll
        for (int ks = 0; ks < 2; ++ks) { float v[8]; unpack8(*(const LAS v4u*)(XTl + (h * 64 + pb * 16 + fr) * 72 + 32 * ks + 8 * kq), v);
#pragma unroll
            for (int e = 0; e < 8; ++e) v[e] *= sj[h * 64 + 32 * ks + 8 * kq + e];
            af[ks] = __builtin_bit_cast(bf16x8, pack8(v)); }
        bf16* dst = F_STB + ((size_t)(ci * 4 + h) * 64 + pb * 16 + 4 * kq) * 128 + fr;
#pragma unroll
        for (int nt = 0; nt < 8; ++nt) {
            f32x4 acc = {0.f, 0.f, 0.f, 0.f};
#pragma unroll
            for (int ks = 0; ks < 2; ++ks) { const bf16x8 bfr = *(const LAS bf16x8*)(BTl + (g * 128 + nt * 16 + fr) * 72 + 32 * ks + 8 * kq); acc = __builtin_amdgcn_mfma_f32_16x16x32_bf16(af[ks], bfr, acc, 0, 0, 0); }
#pragma unroll
            for (int r = 0; r < 4; ++r) dst[r * 128 + nt * 16] = (bf16)f2bf(acc[r]);
        }
    }
    __syncthreads();
}

__device__ __forceinline__ void ssd_out_witem(Frame& F, int layer, int ci, int ib, int wave_, int lane_) {
    const Chunk c = chunk_of(ci);
    const int kq = lane_ >> 4, fr = lane_ & 15;
    constexpr int WSTRIDE = 2560 + 16384; static_assert(8 * WSTRIDE <= MISC_OFF, "per-wave LDS");
    LAS bf16* scr = (LAS bf16*)(F.lds + wave_ * WSTRIDE);
    lf32* ysc = (lf32*)(F.lds + wave_ * WSTRIDE + 2560) + lane_;
    const bf16* P = F_PROJ + (size_t)c.row0 * NPROJ;
    const float* acsg = F_ACS + (size_t)c.row0 * 4; const float* dtg = F_DTV + (size_t)c.row0 * 4;
    const int nks = (ib + 2) >> 1;
    float sq[4] = {0.f, 0.f, 0.f, 0.f};
    const float* bdp = inp(I_BD) + layer * 4;
#pragma unroll
    for (int g = 0; g < 2; ++g) {
        bf16x8 cf[4];
#pragma unroll
        for (int ks = 0; ks < 4; ++ks) cf[ks] = *(const bf16x8*)(P + (size_t)(16 * ib + fr) * NPROJ + PC_C + 128 * g + 32 * ks + 8 * kq);
        f32x4 G[4];
#pragma unroll
        for (int jb = 0; jb < 4; ++jb) { G[jb] = (f32x4){0.f, 0.f, 0.f, 0.f};
            if (jb <= ib) {
#pragma unroll
                for (int ks = 0; ks < 4; ++ks) { const bf16x8 bfr = *(const bf16x8*)(P + (size_t)(16 * jb + fr) * NPROJ + PC_B + 128 * g + 32 * ks + 8 * kq); G[jb] = __builtin_amdgcn_mfma_f32_16x16x32_bf16(cf[ks], bfr, G[jb], 0, 0, 0); } } }
#pragma unroll
        for (int hh = 0; hh < 2; ++hh) {
            const int h = 2 * g + hh;
            float ai[4], ea[4];
#pragma unroll
            for (int r = 0; r < 4; ++r) { ai[r] = acsg[(16 * ib + 4 * kq + r) * 4 + h]; ea[r] = __expf(ai[r]); }
#pragma unroll
            for (int jb = 0; jb < 4; ++jb) { const int j = 16 * jb + fr; float aj = 0.f, dj = 0.f; if (jb <= ib) { aj = acsg[j * 4 + h]; dj = dtg[j * 4 + h]; }
#pragma unroll
                for (int r = 0; r < 4; ++r) { const int i = 16 * ib + 4 * kq + r; const float v = (jb <= ib && j <= i) ? G[jb][r] * __expf(ai[r] - aj) * dj : 0.f; scr[(4 * kq + r) * 72 + j] = (bf16)f2bf(v); } }
            asm volatile("s_waitcnt lgkmcnt(0)" ::: "memory");
            bf16x8 gm[2];
#pragma unroll
            for (int ks = 0; ks < 2; ++ks) gm[ks] = *(const LAS bf16x8*)(scr + fr * 72 + 32 * ks + 8 * kq);
            asm volatile("s_waitcnt lgkmcnt(0)" ::: "memory");
            const bf16* xt = F_XT + ((size_t)ci * 256 + h * 64) * 64;
            const bf16* sin_b = F_STB + (size_t)(ci * 4 + h) * 8192; const float* sin_f = inp(I_SSSM) + (size_t)((layer * NSB + (c.b < 0 ? 0 : c.b)) * 4 + h) * 8192;
#pragma unroll 2
            for (int pt = 0; pt < 4; ++pt) {
                f32x4 a1 = {0.f, 0.f, 0.f, 0.f}, a2 = {0.f, 0.f, 0.f, 0.f};
#pragma unroll
                for (int ks = 0; ks < 2; ++ks) if (ks < nks) { const bf16x8 bfr = *(const bf16x8*)(xt + (size_t)(pt * 16 + fr) * 64 + 32 * ks + 8 * kq); a1 = __builtin_amdgcn_mfma_f32_16x16x32_bf16(gm[ks], bfr, a1, 0, 0, 0); }
#pragma unroll
                for (int ks = 0; ks < 4; ++ks) { bf16x8 bfr;
                    if (c.b < 0) bfr = *(const bf16x8*)(sin_b + (size_t)(pt * 16 + fr) * 128 + 32 * ks + 8 * kq);
                    else { const float* s = sin_f + (size_t)(pt * 16 + fr) * 128 + 32 * ks + 8 * kq; const f32x4 u0 = *(const f32x4*)s, u1 = *(const f32x4*)(s + 4); v4u w; w.x = pk2(u0.x, u0.y); w.y = pk2(u0.z, u0.w); w.z = pk2(u1.x, u1.y); w.w = pk2(u1.z, u1.w); bfr = __builtin_bit_cast(bf16x8, w); }
                    a2 = __builtin_amdgcn_mfma_f32_16x16x32_bf16(cf[ks], bfr, a2, 0, 0, 0); }
                const float dh = bdp[h];
#pragma unroll
                for (int r = 0; r < 4; ++r) { const size_t ro = (size_t)(16 * ib + 4 * kq + r) * NPROJ; const int p = h * 64 + pt * 16 + fr;
                    float y = a1[r] + ea[r] * a2[r] + dh * bf1(P[ro + PC_X + p]);
                    y *= silu_g(bf1(P[ro + PC_Z + p])); ysc[((h * 4 + pt) * 4 + r) * 64] = y; sq[r] += y * y; }
            }
        }
    }
    const float* nw = inp(I_BNRM) + (size_t)layer * 256;
#pragma unroll
    for (int r = 0; r < 4; ++r) { const float rstd = rsq_f(sum16_l(lane_, sq[r]) * (1.0f / 256.0f) + EPS); bf16* o = F_XN + (size_t)(c.row0 + 16 * ib + 4 * kq + r) * D + 256 + fr;
#pragma unroll 4
        for (int q = 0; q < 16; ++q) o[q * 16] = (bf16)f2bf(ysc[(q * 4 + r) * 64] * rstd * nw[q * 16 + fr]); }
}

constexpr int SO_SIN = 0, SO_XT = 4 * 64 * 136 * 2, SO_ACS = SO_XT + 256 * 72 * 2, SO_DTV = SO_ACS + 1024, SO_SS = SO_DTV + 1024, SO_SCR = SO_SS + 512, SO_END = SO_SCR + 8 * 2560;
static_assert(SO_END <= MISC_OFF, "ssd_out_block LDS map");
__device__ __forceinline__ void ssd_out_block(Frame& F, int layer, int ci) {
    ITEM_IDS();
    const int row0 = 64 * ci;
    LAS bf16* SIN = (LAS bf16*)(F.lds + SO_SIN); LAS bf16* XTl = (LAS bf16*)(F.lds + SO_XT);
    lf32* acs = (lf32*)(F.lds + SO_ACS); lf32* dtv = (lf32*)(F.lds + SO_DTV); lf32* ss = (lf32*)(F.lds + SO_SS);
    LAS bf16* scr = (LAS bf16*)(F.lds + SO_SCR + wave_ * 2560);
    const int kq = lane_ >> 4, fr = lane_ & 15, ib = wave_ >> 1, g = wave_ & 1;
    const bf16* P = F_PROJ + (size_t)row0 * NPROJ;
    v4u st[12];
    { const bf16* sg = F_STB + (size_t)ci * 32768; const bf16* xg = F_XT + (size_t)ci * 16384;
#pragma unroll
      for (int q = 0; q < 8; ++q) st[q] = *(const v4u*)(sg + (size_t)(tid_ + q * NTHR) * 8);
#pragma unroll
      for (int q = 0; q < 4; ++q) st[8 + q] = *(const v4u*)(xg + (size_t)(tid_ + q * NTHR) * 8); }
    float a4 = 0.f, d4 = 0.f; if (tid_ < 256) { a4 = F_ACS[(size_t)row0 * 4 + tid_]; d4 = F_DTV[(size_t)row0 * 4 + tid_]; }
    bf16x8 cf[4], bfr[4][4];
#pragma unroll
    for (int ks = 0; ks < 4; ++ks) cf[ks] = *(const bf16x8*)(P + (size_t)(16 * ib + fr) * NPROJ + PC_C + 128 * g + 32 * ks + 8 * kq);
#pragma unroll
    for (int jb = 0; jb < 4; ++jb)
#pragma unroll
        for (int ks = 0; ks < 4; ++ks) { bfr[jb][ks] = (bf16x8){0, 0, 0, 0, 0, 0, 0, 0}; if (jb <= ib) bfr[jb][ks] = *(const bf16x8*)(P + (size_t)(16 * jb + fr) * NPROJ + PC_B + 128 * g + 32 * ks + 8 * kq); }
#pragma unroll
    for (int q = 0; q < 8; ++q) { const int it = tid_ + q * NTHR; *(LAS v4u*)(SIN + (it >> 4) * 136 + 8 * (it & 15)) = st[q]; }
#pragma unroll
    for (int q = 0; q < 4; ++q) { const int it = tid_ + q * NTHR; *(LAS v4u*)(XTl + (it >> 3) * 72 + 8 * (it & 7)) = st[8 + q]; }
    if (tid_ < 256) { acs[tid_] = a4; dtv[tid_] = d4; }
    bf16 zv[2][4][4];
#pragma unroll
    for (int hh = 0; hh < 2; ++hh)
#pragma unroll
        for (int pt = 0; pt < 4; ++pt)
#pragma unroll
            for (int r = 0; r < 4; ++r) zv[hh][pt][r] = P[(size_t)(16 * ib + 4 * kq + r) * NPROJ + PC_Z + (2 * g + hh) * 64 + pt * 16 + fr];
    __syncthreads();
    f32x4 G[4];
#pragma unroll
    for (int jb = 0; jb < 4; ++jb) { G[jb] = (f32x4){0.f, 0.f, 0.f, 0.f};
        if (jb <= ib) {
#pragma unroll
            for (int ks = 0; ks < 4; ++ks) G[jb] = __builtin_amdgcn_mfma_f32_16x16x32_bf16(cf[ks], bfr[jb][ks], G[jb], 0, 0, 0); } }
    const int nks = (ib + 2) >> 1;
    const float* bdp = inp(I_BD) + layer * 4;
    f32x4 yv[2][4]; float sq[4] = {0.f, 0.f, 0.f, 0.f};
#pragma unroll
    for (int hh = 0; hh < 2; ++hh) {
        const int h = 2 * g + hh;
        float ai[4], ea[4];
#pragma unroll
        for (int r = 0; r < 4; ++r) { ai[r] = acs[(16 * ib + 4 * kq + r) * 4 + h]; ea[r] = __expf(ai[r]); }
#pragma unroll
        for (int jb = 0; jb < 4; ++jb) { const int j = 16 * jb + fr; const float aj = acs[j * 4 + h], dj = dtv[j * 4 + h];
#pragma unroll
            for (int r = 0; r < 4; ++r) { const int i = 16 * ib + 4 * kq + r; const float v = (jb <= ib && j <= i) ? G[jb][r] * __expf(ai[r] - aj) * dj : 0.f; scr[(4 * kq + r) * 72 + j] = (bf16)f2bf(v); } }
        asm volatile("s_waitcnt lgkmcnt(0)" ::: "memory");
        bf16x8 gm[2];
#pragma unroll
        for (int ks = 0; ks < 2; ++ks) gm[ks] = *(const LAS bf16x8*)(scr + fr * 72 + 32 * ks + 8 * kq);
        asm volatile("s_waitcnt lgkmcnt(0)" ::: "memory");
        const float dh = bdp[h];
#pragma unroll
        for (int pt = 0; pt < 4; ++pt) {
            f32x4 a1 = {0.f, 0.f, 0.f, 0.f}, a2 = {0.f, 0.f, 0.f, 0.f};
            const LAS bf16* xr = XTl + (h * 64 + pt * 16 + fr) * 72; const LAS bf16* sr = SIN + (h * 64 + pt * 16 + fr) * 136;
#pragma unroll
            for (int ks = 0; ks < 2; ++ks) if (ks < nks) a1 = __builtin_amdgcn_mfma_f32_16x16x32_bf16(gm[ks], *(const LAS bf16x8*)(xr + 32 * ks + 8 * kq), a1, 0, 0, 0);
#pragma unroll
            for (int ks = 0; ks < 4; ++ks) a2 = __builtin_amdgcn_mfma_f32_16x16x32_bf16(cf[ks], *(const LAS bf16x8*)(sr + 32 * ks + 8 * kq), a2, 0, 0, 0);
            const unsigned long long xw = *(const LAS unsigned long long*)(xr + 16 * ib + 4 * kq);
            const float xx[4] = {bf_lo((unsigned)xw), bf_hi((unsigned)xw), bf_lo((unsigned)(xw >> 32)), bf_hi((unsigned)(xw >> 32))};
#pragma unroll
            for (int r = 0; r < 4; ++r) { float y = a1[r] + ea[r] * a2[r] + dh * xx[r]; y *= silu_g(bf1(zv[hh][pt][r])); yv[hh][pt][r] = y; sq[r] += y * y; }
        }
    }
#pragma unroll
    for (int r = 0; r < 4; ++r) { const float q = sum16_l(lane_, sq[r]); if (fr == 0) ss[(16 * ib + 4 * kq + r) * 2 + g] = q; }
    __syncthreads();
    const float* nw = inp(I_BNRM) + (size_t)layer * 256 + 128 * g;
#pragma unroll
    for (int r = 0; r < 4; ++r) { const int i = 16 * ib + 4 * kq + r; const float rstd = rsq_f((ss[i * 2] + ss[i * 2 + 1]) * (1.0f / 256.0f) + EPS); bf16* o = F_XN + (size_t)(row0 + i) * D + 256 + 128 * g + fr;
#pragma unroll
        for (int hh = 0; hh < 2; ++hh)
#pragma unroll
            for (int pt = 0; pt < 4; ++pt) o[hh * 64 + pt * 16] = (bf16)f2bf(yv[hh][pt][r] * rstd * nw[hh * 64 + pt * 16 + fr]); }
    __syncthreads();
}
constexpr int HP_KT = 0, HP_VT = 256 * 72 * 2, HP_HT = 2 * 256 * 72 * 2, HP_END = HP_HT + 4 * 256 * 4;
static_assert(HP_END <= MISC_OFF, "hgrn_prep LDS map");
__device__ __forceinline__ void hgrn_prep_item(Frame& F, int layer, int ci) {
    ITEM_IDS();
    const Chunk c = chunk_of(ci);
    LAS bf16* KTl = (LAS bf16*)(F.lds + HP_KT); LAS bf16* VTl = (LAS bf16*)(F.lds + HP_VT);
    lf32* ht = (lf32*)(F.lds + HP_HT);
    const int cp = tid_ & 127, qt = tid_ >> 7;
    float lb0 = 0.f, lb1 = 0.f; if (layer != 0) { const float* lbp = inp(I_LB) + 2 * cp; lb0 = rcp_f(1.0f + __expf(lbp[0] - lbp[256])); lb1 = rcp_f(1.0f + __expf(lbp[1] - lbp[257])); }
    bf16* pq = F_PROJ + (size_t)(c.row0 + 16 * qt) * NPROJ + PC_CQ + 2 * cp;
    const bool act = 16 * qt < c.nrows;
    unsigned rq[16], rf[16], rv[16];
#pragma unroll
    for (int i = 0; i < 16; ++i) { rq[i] = 0u; rf[i] = 0u; rv[i] = 0u; if (act) { const unsigned* p = (const unsigned*)(pq + (size_t)i * NPROJ); rq[i] = p[0]; rf[i] = p[128]; rv[i] = p[256]; } }
    float b0[16], b1[16], k0[16], k1[16];
    float run0 = 0.f, run1 = 0.f;
#pragma unroll
    for (int i = 0; i < 16; ++i) { float g0 = 0.f, g1 = 0.f; k0[i] = 0.f; k1[i] = 0.f;
        if (act) { const float e0 = __expf(-bf_lo(rf[i])), e1 = __expf(-bf_hi(rf[i])); const float d0 = rcp_f(1.0f + e0), d1 = rcp_f(1.0f + e1);
            g0 = __logf(lb0 + (1.0f - lb0) * d0); g1 = __logf(lb1 + (1.0f - lb1) * d1); k0[i] = (1.0f - lb0) * e0 * d0; k1[i] = (1.0f - lb1) * e1 * d1; }
        run0 += g0; run1 += g1; b0[i] = run0; b1[i] = run1; }
    *(LAS f32x2*)(ht + qt * 256 + 2 * cp) = (f32x2){run0, run1};
    __syncthreads();
    float pre0 = 0.f, pre1 = 0.f, last0 = 0.f, last1 = 0.f;
#pragma unroll
    for (int q = 0; q < 4; ++q) { const f32x2 t = *(const LAS f32x2*)(ht + q * 256 + 2 * cp); if (q < qt) { pre0 += t.x; pre1 += t.y; } last0 += t.x; last1 += t.y; }
    { float* Rg = F_RH + (size_t)ci * 1280 + 2 * cp; *(f32x2*)(Rg + qt * 256) = (f32x2){pre0, pre1};
      if (qt == 3) { *(f32x2*)(Rg + 1024) = (f32x2){last0, last1}; *(f32x2*)(F_DECC + (size_t)ci * 256 + 2 * cp) = (f32x2){__expf(last0), __expf(last1)}; } }
    const float e0 = run0, e1 = run1;
#pragma unroll
    for (int i = 0; i < 16; i += 2) {
        unsigned kt0, kt1;
#pragma unroll
        for (int q = 0; q < 2; ++q) { const int ii = i + q;
            const float qe0 = bf_lo(rq[ii]) * __expf(b0[ii]), qe1 = bf_hi(rq[ii]) * __expf(b1[ii]);
            const float ke0 = k0[ii] * __expf(e0 - b0[ii]), ke1 = k1[ii] * __expf(e1 - b1[ii]);
            const float kd0 = k0[ii] * __expf(fminf(-b0[ii], 80.f)), kd1 = k1[ii] * __expf(fminf(-b1[ii], 80.f));
            if (act && 16 * qt + ii < c.nrows) { unsigned* p = (unsigned*)(pq + (size_t)ii * NPROJ); p[0] = pk2(qe0, qe1); p[128] = pk2(ke0, ke1); p[256] = pk2(kd0, kd1); }
            const float t0 = k0[ii] * __expf(last0 - pre0 - b0[ii]), t1 = k1[ii] * __expf(last1 - pre1 - b1[ii]);
            if (q == 0) { kt0 = f2bf(t0); kt1 = f2bf(t1); } else { kt0 |= f2bf(t0) << 16; kt1 |= f2bf(t1) << 16; } }
        const int j = 16 * qt + i;
        *(LAS unsigned*)(KTl + (2 * cp) * 72 + j) = kt0; *(LAS unsigned*)(KTl + (2 * cp + 1) * 72 + j) = kt1;
        *(LAS unsigned*)(VTl + (2 * cp) * 72 + j) = (rv[i] & 0xffffu) | (rv[i + 1] << 16); *(LAS unsigned*)(VTl + (2 * cp + 1) * 72 + j) = (rv[i] >> 16) | (rv[i + 1] & 0xffff0000u);
    }
    __syncthreads();
    { const int c2 = tid_ >> 1, hf = tid_ & 1; bf16* dst = F_VT + ((size_t)ci * 256 + c2) * 64 + 32 * hf; const LAS bf16* src = VTl + c2 * 72 + 32 * hf;
#pragma unroll
      for (int q = 0; q < 4; ++q) *(v4u*)(dst + 8 * q) = *(const LAS v4u*)(src + 8 * q); }
    const int kq = lane_ >> 4, fr = lane_ & 15, h = wave_ >> 1;
#pragma unroll
    for (int vi = 0; vi < 2; ++vi) {
        const int vb = 2 * (wave_ & 1) + vi;
        bf16x8 af[2];
#pragma unroll
        for (int ks = 0; ks < 2; ++ks) af[ks] = *(const LAS bf16x8*)(VTl + (h * 64 + vb * 16 + fr) * 72 + 32 * ks + 8 * kq);
        bf16* dst = F_STC + ((size_t)(ci * 4 + h) * 64 + vb * 16 + 4 * kq) * 64 + fr;
#pragma unroll
        for (int kb = 0; kb < 4; ++kb) {
            f32x4 acc = {0.f, 0.f, 0.f, 0.f};
#pragma unroll
            for (int ks = 0; ks < 2; ++ks) { const bf16x8 bfr = *(const LAS bf16x8*)(KTl + (h * 64 + kb * 16 + fr) * 72 + 32 * ks + 8 * kq); acc = __builtin_amdgcn_mfma_f32_16x16x32_bf16(af[ks], bfr, acc, 0, 0, 0); }
#pragma unroll
            for (int r = 0; r < 4; ++r) dst[r * 64 + kb * 16] = (bf16)f2bf(acc[r]);
        }
    }
    __syncthreads();
}

__device__ __forceinline__ void hgrn_out_witem(Frame& F, int layer, int ci, int h, int ib, int wave_, int lane_) {
    const Chunk c = chunk_of(ci);
    const int kq = lane_ >> 4, fr = lane_ & 15;
    LAS bf16* scr = (LAS bf16*)(F.lds + wave_ * (2560 + 16384));
    const bf16* P = F_PROJ + (size_t)c.row0 * NPROJ + h * 64;
    const float* Rg = F_RH + (size_t)ci * 1280 + h * 64;
    bf16x8 qf[2]; float qv[2][8], rI[2][8];
#pragma unroll
    for (int ks = 0; ks < 2; ++ks) { qf[ks] = *(const bf16x8*)(P + (size_t)(16 * ib + fr) * NPROJ + PC_CQ + 32 * ks + 8 * kq); unpack8(__builtin_bit_cast(v4u, qf[ks]), qv[ks]);
        const float* rp = Rg + ib * 256 + 32 * ks + 8 * kq; const f32x4 a = *(const f32x4*)rp, b2 = *(const f32x4*)(rp + 4);
        rI[ks][0] = a.x; rI[ks][1] = a.y; rI[ks][2] = a.z; rI[ks][3] = a.w; rI[ks][4] = b2.x; rI[ks][5] = b2.y; rI[ks][6] = b2.z; rI[ks][7] = b2.w; }
#pragma unroll
    for (int J = 0; J < 4; ++J) {
        f32x4 acc = {0.f, 0.f, 0.f, 0.f};
        if (J <= ib) {
#pragma unroll
            for (int ks = 0; ks < 2; ++ks) {
                bf16x8 a = qf[ks];
                if (J < ib) { const float* rp = Rg + (J + 1) * 256 + 32 * ks + 8 * kq; const f32x4 u0 = *(const f32x4*)rp, u1 = *(const f32x4*)(rp + 4); const float rj[8] = {u0.x, u0.y, u0.z, u0.w, u1.x, u1.y, u1.z, u1.w};
                    float v[8];
#pragma unroll
                    for (int e = 0; e < 8; ++e) v[e] = qv[ks][e] * __expf(rI[ks][e] - rj[e]);
                    a = __builtin_bit_cast(bf16x8, pack8(v)); }
                const bf16x8 bfr = *(const bf16x8*)(P + (size_t)(16 * J + fr) * NPROJ + (J < ib ? PC_CF : PC_CI) + 32 * ks + 8 * kq);
                acc = __builtin_amdgcn_mfma_f32_16x16x32_bf16(a, bfr, acc, 0, 0, 0);
            }
        }
#pragma unroll
        for (int r = 0; r < 4; ++r) { const int i = 4 * kq + r, j = fr; const float v = (J < ib || (J == ib && j <= i)) ? acc[r] : 0.f; scr[(4 * kq + r) * 72 + 16 * J + fr] = (bf16)f2bf(v); }
    }
    asm volatile("s_waitcnt lgkmcnt(0)" ::: "memory");
    bf16x8 ga[2];
#pragma unroll
    for (int ks = 0; ks < 2; ++ks) ga[ks] = *(const LAS bf16x8*)(scr + fr * 72 + 32 * ks + 8 * kq);
    asm volatile("s_waitcnt lgkmcnt(0)" ::: "memory");
    bf16x8 qs[2];
#pragma unroll
    for (int ks = 0; ks < 2; ++ks) { float v[8];
#pragma unroll
        for (int e = 0; e < 8; ++e) v[e] = qv[ks][e] * __expf(rI[ks][e]);
        qs[ks] = __builtin_bit_cast(bf16x8, pack8(v)); }
    const int nks = (ib + 2) >> 1;
    const bf16* vt = F_VT + ((size_t)ci * 256 + h * 64) * 64;
    const bf16* sin_b = F_STC + (size_t)(ci * 4 + h) * 4096; const float* sin_f = inp(I_SHGRN) + (size_t)((layer * NSB + (c.b < 0 ? 0 : c.b)) * 4 + h) * 4096;
    f32x4 o[4]; float sq[4] = {0.f, 0.f, 0.f, 0.f};
#pragma unroll
    for (int t = 0; t < 4; ++t) {
        o[t] = (f32x4){0.f, 0.f, 0.f, 0.f};
#pragma unroll
        for (int ks = 0; ks < 2; ++ks) if (ks < nks) { const bf16x8 bfr = *(const bf16x8*)(vt + (size_t)(t * 16 + fr) * 64 + 32 * ks + 8 * kq); o[t] = __builtin_amdgcn_mfma_f32_16x16x32_bf16(ga[ks], bfr, o[t], 0, 0, 0); }
#pragma unroll
        for (int ks = 0; ks < 2; ++ks) { bf16x8 bfr;
            if (c.b < 0) bfr = *(const bf16x8*)(sin_b + (size_t)(t * 16 + fr) * 64 + 32 * ks + 8 * kq);
            else { float v[8];
#pragma unroll
                for (int e = 0; e < 8; ++e) v[e] = sin_f[(size_t)(32 * ks + 8 * kq + e) * 64 + t * 16 + fr];
                bfr = __builtin_bit_cast(bf16x8, pack8(v)); }
            o[t] = __builtin_amdgcn_mfma_f32_16x16x32_bf16(qs[ks], bfr, o[t], 0, 0, 0); }
#pragma unroll
        for (int r = 0; r < 4; ++r) sq[r] += o[t][r] * o[t][r];
    }
    const float* nw = inp(I_CNRM) + (size_t)layer * 256 + h * 64;
#pragma unroll
    for (int r = 0; r < 4; ++r) { const float rstd = rsq_f(sum16_l(lane_, sq[r]) * (1.0f / 64.0f) + EPS); const size_t row = (size_t)(16 * ib + 4 * kq + r);
#pragma unroll
        for (int t = 0; t < 4; ++t) { const int v = t * 16 + fr; const float cg = bf1(P[row * NPROJ + PC_CG + v]);
            F_XN[(size_t)(c.row0 + row) * D + 512 + h * 64 + v] = (bf16)f2bf(o[t][r] * rstd * nw[v] * silu_g(cg)); } }
}

constexpr int HO_KE = 0, HO_VT = 64 * 264 * 2, HO_SIN = HO_VT + 256 * 72 * 2, HO_R = HO_SIN + 256 * 72 * 2, HO_SCR = HO_R + 1280 * 4, HO_END = HO_SCR + 8 * 2304;
static_assert(HO_END <= MISC_OFF, "hgrn_out_block LDS map");
__device__ __forceinline__ void hgrn_out_block(Frame& F, int layer, int ci) {
    ITEM_IDS();
    const int row0 = 64 * ci;
    LAS bf16* KEl = (LAS bf16*)(F.lds + HO_KE); LAS bf16* VTl = (LAS bf16*)(F.lds + HO_VT); LAS bf16* SIN = (LAS bf16*)(F.lds + HO_SIN); lf32* Rl = (lf32*)(F.lds + HO_R);
    LAS bf16* scr = (LAS bf16*)(F.lds + HO_SCR + wave_ * 2304);
    const int kq = lane_ >> 4, fr = lane_ & 15, h = wave_ >> 1, ib0 = 2 * (wave_ & 1);
    const bf16* P = F_PROJ + (size_t)row0 * NPROJ;
    v4u st[13];
    { const bf16* kg = P + PC_CF; const bf16* vg = F_VT + (size_t)ci * 16384; const bf16* sg = F_STC + (size_t)ci * 16384; const float* rg = F_RH + (size_t)ci * 1280;
#pragma unroll
      for (int q = 0; q < 4; ++q) { const int it = tid_ + q * NTHR; st[q] = *(const v4u*)(kg + (size_t)(it >> 5) * NPROJ + 8 * (it & 31)); }
#pragma unroll
      for (int q = 0; q < 4; ++q) st[4 + q] = *(const v4u*)(vg + (size_t)(tid_ + q * NTHR) * 8);
#pragma unroll
      for (int q = 0; q < 4; ++q) st[8 + q] = *(const v4u*)(sg + (size_t)(tid_ + q * NTHR) * 8);
      st[12] = (v4u){0u, 0u, 0u, 0u}; if (tid_ < 320) st[12] = *(const v4u*)(rg + 4 * tid_); }
    bf16x8 qf[2][2], kd[2][2];
#pragma unroll
    for (int bi = 0; bi < 2; ++bi)
#pragma unroll
        for (int ks = 0; ks < 2; ++ks) { const bf16* p = P + (size_t)(16 * (ib0 + bi) + fr) * NPROJ + h * 64 + 32 * ks + 8 * kq; qf[bi][ks] = *(const bf16x8*)(p + PC_CQ); kd[bi][ks] = *(const bf16x8*)(p + PC_CI); }
#pragma unroll
    for (int q = 0; q < 4; ++q) { const int it = tid_ + q * NTHR; *(LAS v4u*)(KEl + (it >> 5) * 264 + 8 * (it & 31)) = st[q]; }
#pragma unroll
    for (int q = 0; q < 4; ++q) { const int it = tid_ + q * NTHR; *(LAS v4u*)(VTl + (it >> 3) * 72 + 8 * (it & 7)) = st[4 + q]; *(LAS v4u*)(SIN + (it >> 3) * 72 + 8 * (it & 7)) = st[8 + q]; }
    if (tid_ < 320) *(LAS v4u*)(Rl + 4 * tid_) = st[12];
    bf16 cgv[2][4][4];
#pragma unroll
    for (int bi = 0; bi < 2; ++bi)
#pragma unroll
        for (int t = 0; t < 4; ++t)
#pragma unroll
            for (int r = 0; r < 4; ++r) cgv[bi][t][r] = P[(size_t)(16 * (ib0 + bi) + 4 * kq + r) * NPROJ + PC_CG + h * 64 + t * 16 + fr];
    __syncthreads();
    const float* nw = inp(I_CNRM) + (size_t)layer * 256 + h * 64;
#pragma unroll
    for (int bi = 0; bi < 2; ++bi) {
        const int ib = ib0 + bi;
        float qv[2][8], rI[2][8];
#pragma unroll
        for (int ks = 0; ks < 2; ++ks) { unpack8(__builtin_bit_cast(v4u, qf[bi][ks]), qv[ks]); const lf32* rp = Rl + ib * 256 + h * 64 + 32 * ks + 8 * kq;
#pragma unroll
            for (int e = 0; e < 8; ++e) rI[ks][e] = rp[e]; }
#pragma unroll
        for (int J = 0; J < 4; ++J) {
            f32x4 acc = {0.f, 0.f, 0.f, 0.f};
            if (J <= ib) {
#pragma unroll
                for (int ks = 0; ks < 2; ++ks) {
                    bf16x8 a = qf[bi][ks], bfr = kd[bi][ks];
                    if (J < ib) { const lf32* rp = Rl + (J + 1) * 256 + h * 64 + 32 * ks + 8 * kq; float v[8];
#pragma unroll
                        for (int e = 0; e < 8; ++e) v[e] = qv[ks][e] * __expf(rI[ks][e] - rp[e]);
                        a = __builtin_bit_cast(bf16x8, pack8(v)); bfr = *(const LAS bf16x8*)(KEl + (16 * J + fr) * 264 + h * 64 + 32 * ks + 8 * kq); }
                    acc = __builtin_amdgcn_mfma_f32_16x16x32_bf16(a, bfr, acc, 0, 0, 0);
                }
            }
#pragma unroll
            for (int r = 0; r < 4; ++r) { const int i = 4 * kq + r, j = fr; const float v = (J < ib || (J == ib && j <= i)) ? acc[r] : 0.f; scr[(4 * kq + r) * 72 + 16 * J + fr] = (bf16)f2bf(v); }
        }
        asm volatile("s_waitcnt lgkmcnt(0)" ::: "memory");
        bf16x8 ga[2];
#pragma unroll
        for (int ks = 0; ks < 2; ++ks) ga[ks] = *(const LAS bf16x8*)(scr + fr * 72 + 32 * ks + 8 * kq);
        asm volatile("s_waitcnt lgkmcnt(0)" ::: "memory");
        bf16x8 qs[2];
#pragma unroll
        for (int ks = 0; ks < 2; ++ks) { float v[8];
#pragma unroll
            for (int e = 0; e < 8; ++e) v[e] = qv[ks][e] * __expf(rI[ks][e]);
            qs[ks] = __builtin_bit_cast(bf16x8, pack8(v)); }
        const int nks = (ib + 2) >> 1;
        f32x4 o[4]; float sq[4] = {0.f, 0.f, 0.f, 0.f};
#pragma unroll
        for (int t = 0; t < 4; ++t) {
            o[t] = (f32x4){0.f, 0.f, 0.f, 0.f};
#pragma unroll
            for (int ks = 0; ks < 2; ++ks) if (ks < nks) o[t] = __builtin_amdgcn_mfma_f32_16x16x32_bf16(ga[ks], *(const LAS bf16x8*)(VTl + (h * 64 + t * 16 + fr) * 72 + 32 * ks + 8 * kq), o[t], 0, 0, 0);
#pragma unroll
            for (int ks = 0; ks < 2; ++ks) o[t] = __builtin_amdgcn_mfma_f32_16x16x32_bf16(qs[ks], *(const LAS bf16x8*)(SIN + (h * 64 + t * 16 + fr) * 72 + 32 * ks + 8 * kq), o[t], 0, 0, 0);
#pragma unroll
            for (int r = 0; r < 4; ++r) sq[r] += o[t][r] * o[t][r];
        }
#pragma unroll
        for (int r = 0; r < 4; ++r) { const float rstd = rsq_f(sum16_l(lane_, sq[r]) * (1.0f / 64.0f) + EPS); bf16* op = F_XN + (size_t)(row0 + 16 * ib + 4 * kq + r) * D + 512 + h * 64 + fr;
#pragma unroll
            for (int t = 0; t < 4; ++t) op[t * 16] = (bf16)f2bf(o[t][r] * rstd * nw[t * 16 + fr] * silu_g(bf1(cgv[bi][t][r]))); }
    }
    __syncthreads();
}
template <int MODE>
__device__ __forceinline__ void mini_gemm(Frame& F, const bf16* A, const bf16* Bt, int K, int ncb, bf16* O, int ldo, const float* res, float* C, const float* nw = nullptr, bf16* xo = nullptr, float* rs = nullptr) {
    ITEM_IDS();
    const int kq = lane_ >> 4, fr = lane_ & 15;
    for (int wi = ((int)blockIdx.x) * NWAVES + wave_; wi < 16 * ncb; wi += ((int)gridDim.x) * NWAVES) {
        const int rb = wi & 15, cb = wi >> 4;
        const bf16* ap = A + (size_t)(MP + 16 * rb + fr) * K + 8 * kq;
        const int c = 16 * cb + fr;
        const bf16* bp = Bt + (size_t)(MODE == 2 ? ((c >> 7) * 256 + (c & 127)) : c) * K + 8 * kq;
        f32x4 acc0 = {0.f, 0.f, 0.f, 0.f}, acc1 = {0.f, 0.f, 0.f, 0.f};
#pragma unroll 8
        for (int k0 = 0; k0 < K; k0 += 32) {
            const bf16x8 a = *(const bf16x8*)(ap + k0), b0 = *(const bf16x8*)(bp + k0);
            acc0 = __builtin_amdgcn_mfma_f32_16x16x32_bf16(a, b0, acc0, 0, 0, 0);
            if (MODE == 2) { const bf16x8 b1 = *(const bf16x8*)(bp + (size_t)128 * K + k0); acc1 = __builtin_amdgcn_mfma_f32_16x16x32_bf16(a, b1, acc1, 0, 0, 0); }
        }
#pragma unroll
        for (int r = 0; r < 4; ++r) { const size_t row = (size_t)(MP + 16 * rb + 4 * kq + r);
            if (MODE == 0) { const bf16 ob = (bf16)f2bf(acc0[r]); O[row * ldo + c] = ob; if (c >= PC_V && c < PC_V + 256) F_VTA[(size_t)(c - PC_V) * M + row] = ob; }
            if (MODE == 1) { const float x = res[row * 1024 + c] + acc0[r]; C[row * 1024 + c] = x;
                if (nw) { xo[row * 1024 + c] = (bf16)f2bf(x * nw[c]); const float q = sum16_l(lane_, x * x); if (fr == 0) atomicAdd(rs + row, q); } }
            if (MODE == 2) O[row * ldo + c] = (bf16)f2bf(silu_g(acc0[r]) * acc1[r]); }
    }
}
__device__ __forceinline__ void sample_mix_item(Frame& F, int layer, int b) {
    ssd_prep_item(F, layer, NCHP + b);
    hgrn_prep_item(F, layer, NCHP + b);
    asm volatile("s_waitcnt vmcnt(0)" ::: "memory");
    __syncthreads();
    __builtin_amdgcn_fence(__ATOMIC_ACQUIRE, "agent");
    asm volatile("s_waitcnt vmcnt(0)" ::: "memory");
    { ITEM_IDS();
      if (wave_ == 0) ssd_out_witem(F, layer, NCHP + b, 0, wave_, lane_);
      else if (wave_ <= 4) hgrn_out_witem(F, layer, NCHP + b, wave_ - 1, 0, wave_, lane_); }
    __syncthreads();
}
__device__ __forceinline__ void p2_phase(Frame& F, int layer, volatile LAS unsigned* MISC) {
    constexpr int NS = NSB, NA = NCH * 4, NB = NCHP, NC = NCHP, ND = NCH, NE = 64, NW = 784;
    const int NTOT = NS + NA + NB + NC + ND + NE + (layer == 0 ? NW : 0);
    unsigned* head = (unsigned*)(F.ws + WS_CTL) + CW_QUEUE + 64 * layer;
    attn_bias_load(F, layer);
    unsigned nxt = 0u; if (threadIdx.x == 0) nxt = __hip_atomic_fetch_add(head, 1u, __ATOMIC_RELAXED, __HIP_MEMORY_SCOPE_AGENT);
    for (;;) {
        __syncthreads();
        if (threadIdx.x == 0) MISC[12] = nxt;
        __syncthreads();
        int it = (int)MISC[12];
        if (it >= NTOT) break;
        if (threadIdx.x == 0) nxt = __hip_atomic_fetch_add(head, 1u, __ATOMIC_RELAXED, __HIP_MEMORY_SCOPE_AGENT);
        if (it < NS) { sample_mix_item(F, layer, it); continue; } it -= NS;
        if (it < NA) { const int i2 = it - NSB * 4; const int ci = it < NSB * 4 ? NCHP + (it >> 2) : NCHP - 1 - (i2 >> 2); attn_item(F, layer, ci, it & 3); }
        else if (it < NA + NB) ssd_prep_item(F, layer, it - NA);
        else if (it < NA + NB + NC) hgrn_prep_item(F, layer, it - NA - NB);
        else if (it < NA + NB + NC + ND) pool_item(F, layer, it - NA - NB - NC);
        else if (it < NA + NB + NC + ND + NE) copy_cache(F, layer, it - NA - NB - NC - ND, NE);
        else { ITEM_IDS(); p0_weights(F, 1, (it - NA - NB - NC - ND - NE) * NWAVES + wave_, NW * NWAVES, false); }
    }
}
__device__ __forceinline__ void p4_phase(Frame& F, int layer) {
    for (int ci = ((int)blockIdx.x); ci < NCHP; ci += ((int)gridDim.x)) { ssd_out_block(F, layer, ci); hgrn_out_block(F, layer, ci); }
}

__global__ void __launch_bounds__(NTHR, 2) fwd_kernel(Args args) {
    extern __shared__ __attribute__((aligned(16))) unsigned char lds[];
    Frame F;
    F.lds = (LAS unsigned char*)lds;
    F.out = args.out; F.ws = args.ws;
    volatile LAS unsigned* MISC = (volatile LAS unsigned*)(F.lds + MISC_OFF);
    if (threadIdx.x < 64) MISC[threadIdx.x] = 0u;
    __syncthreads();
    (void)xcd_barrier_post((unsigned*)(args.ws + WS_CTL) + CW_BAR, MISC + 8);
#define GRID_BAR() do { XcdBarrier bar_; bar_.bar = (unsigned*)((unsigned char*)inp(N_IN + 1) + WS_CTL) + CW_BAR; bar_.x = xb_xcc_id(); bar_.st = MISC + 8; xcd_barrier(bar_); \
        F.out = (float*)inp(N_IN); F.ws = (unsigned char*)inp(N_IN + 1); } while (0)
#ifdef TPROBE
    const bool stamper = (blockIdx.x == 0 && threadIdx.x == 0); int n_stamp = 0;
#define STAMP() do { if (stamper) MISC[16 + n_stamp] = (unsigned)__builtin_amdgcn_s_memrealtime(); ++n_stamp; } while (0)
#else
#define STAMP() do { } while (0)
#endif
    STAMP();

    { float* rsz = F_RS; for (int i = (int)blockIdx.x * NTHR + (int)threadIdx.x; i < 2 * M; i += (int)gridDim.x * NTHR) rsz[i] = 0.f; }
    p0_weights(F, 0, ((int)blockIdx.x) * NWAVES + __builtin_amdgcn_readfirstlane((int)(threadIdx.x >> 6)), ((int)gridDim.x) * NWAVES, true);
    __syncthreads();
    norm_rows<true, false>(F, inp(I_XP), inp(I_XS) - (size_t)MP * D, inp(I_N1), inp(I_WIN));
    GRID_BAR(); STAMP();
#pragma unroll 1
    for (int layer = 0; layer < 2; ++layer) {
        unsigned char* wl = F.ws + WS_W + (size_t)layer * WL_STRIDE;
        mini_gemm<0>(F, F_XN, (const bf16*)(wl + WL_IN), D, NPROJ / 16, F_PROJ, NPROJ, nullptr, nullptr);
        { pg8::Gemm g{F_XN, (const bf16*)(wl + WL_IN), MP, NPROJ, D}; pg8::StaticOrder S; S.init(MP, NPROJ, ((int)gridDim.x), ((int)blockIdx.x));
          pg8::EpiBf16 E{F_PROJ, NPROJ, F_HALO, F_VTA, M};
          pg8::gemm_phase<pg8::EpiBf16, pg8::StaticOrder, true, true>(F.lds + RING_OFF, g, S, E); }
        GRID_BAR(); STAMP();
        p2_phase(F, layer, MISC);
        GRID_BAR(); STAMP();
        scan_phase(F, layer);
        GRID_BAR(); STAMP();
        p4_phase(F, layer);
        GRID_BAR(); STAMP();
        mini_gemm<1>(F, F_XN, (const bf16*)(wl + WL_OUT), D, D / 16, nullptr, 0, layer == 0 ? inp(I_XS) - (size_t)MP * D : F_X, F_X, inp(I_N2) + (size_t)layer * D, F_XN2, F_RS + (size_t)layer * M);
        { pg8::Gemm g{F_XN, (const bf16*)(wl + WL_OUT), MP, D, D}; pg8::StaticOrder S; S.init(MP, D, ((int)gridDim.x), ((int)blockIdx.x));
          pg8::EpiRes E{layer == 0 ? inp(I_XP) : F_X, layer == 0 ? inp(I_XS) - (size_t)MP * D : F_X, F_X, inp(I_N2) + (size_t)layer * D, F_XN2, F_RS + (size_t)layer * M};
          pg8::gemm_phase<pg8::EpiRes, pg8::StaticOrder, true, true>(F.lds + RING_OFF, g, S, E); }
        GRID_BAR(); STAMP();
        { pg8::Gemm g{F_XN2, (const bf16*)(wl + WL_GU), M, NGU, D}; pg8::StaticOrder S; S.init(M, NGU, ((int)gridDim.x), ((int)blockIdx.x));
          pg8::EpiSwiGLU E{F_ACT, DFF, F_RS + (size_t)layer * M};
          pg8::gemm_phase<pg8::EpiSwiGLU, pg8::StaticOrder, true, true>(F.lds + RING_OFF, g, S, E); }
        GRID_BAR(); STAMP();
        mini_gemm<1>(F, F_ACT, (const bf16*)(wl + WL_DN), DFF, D / 16, nullptr, 0, F_X, F_X);
        { pg8::Gemm g{F_ACT, (const bf16*)(wl + WL_DN), MP, D, DFF}; pg8::StaticOrder S; S.init(MP, D, ((int)gridDim.x), ((int)blockIdx.x));
          pg8::EpiRes E{F_X, F_X, F_X, nullptr, nullptr, nullptr};
          pg8::gemm_phase<pg8::EpiRes, pg8::StaticOrder, true, true>(F.lds + RING_OFF, g, S, E); }
        GRID_BAR(); STAMP();
        if (layer == 0) { norm_rows<true, false>(F, F_X, F_X, inp(I_N1) + D, inp(I_WIN) + (size_t)D * NIN); GRID_BAR(); STAMP(); }
        else { norm_rows<false, true>(F, F_X, F_X, inp(I_NF), nullptr); STAMP(); }
    }
#ifdef TPROBE
    if (stamper) {
        unsigned v[11]; v[0] = MISC[17] - MISC[16];
        for (int j = 1; j < 10; ++j) v[j] = (MISC[17 + j] - MISC[16 + j]) + (MISC[26 + j] - MISC[25 + j]);
        v[10] = (MISC[35] - MISC[16]) / 4;
        const unsigned dl = 800000u + 16u * v[TPROBE];
        const unsigned t0 = MISC[16];
        while ((unsigned)((unsigned)__builtin_amdgcn_s_memrealtime() - t0) < dl) __builtin_amdgcn_s_sleep(32);
    }
#endif
}

extern "C" void kernel_launch(void* const* d_in, const int* in_sizes, int n_in, void* d_out, int out_size, void* d_ws, size_t ws_size, hipStream_t stream) {
    static int grid = 0;
    if (grid == 0) {
        if (n_in != N_IN || (size_t)out_size != O_END || ws_size < WS_END) { fprintf(stderr, "kernel_launch: unexpected shapes (n_in %d, out %d, ws %zu)\n", n_in, out_size, ws_size); grid = -1; return; }
        int dev = 0, cus = 0, per_cu = 0;
        if (hipGetDevice(&dev) != hipSuccess || hipDeviceGetAttribute(&cus, hipDeviceAttributeMultiprocessorCount, dev) != hipSuccess) { grid = -1; return; }
        if (hipFuncSetAttribute((const void*)fwd_kernel, hipFuncAttributeMaxDynamicSharedMemorySize, LDS_BYTES) != hipSuccess) { fprintf(stderr, "kernel_launch: hipFuncSetAttribute failed\n"); grid = -1; return; }
        if (hipOccupancyMaxActiveBlocksPerMultiprocessor(&per_cu, (const void*)fwd_kernel, NTHR, LDS_BYTES) != hipSuccess || per_cu < 1) { fprintf(stderr, "kernel_launch: occupancy query says %d blocks per CU\n", per_cu); (void)hipGetLastError(); grid = -1; return; }
        grid = cus;
        if (grid < 64) { fprintf(stderr, "kernel_launch: needs at least 64 CUs (got %d)\n", cus); grid = -1; return; }
    }
    if (grid < 0) return;
    if (hipMemsetAsync((char*)d_ws + WS_CTL, 0, CTL_ZERO_BYTES, stream) != hipSuccess) { fprintf(stderr, "kernel_launch: hipMemsetAsync failed\n"); return; }
    Args a{};
    for (int i = 0; i < N_IN; ++i) a.in[i] = (const float*)d_in[i];
    a.out = (float*)d_out; a.ws = (unsigned char*)d_ws;
    void* kargs[] = {&a};
    hipError_t e = hipLaunchCooperativeKernel((const void*)fwd_kernel, dim3(grid), dim3(NTHR), kargs, LDS_BYTES, stream);
    if (e != hipSuccess) { fprintf(stderr, "kernel_launch: cooperative launch failed: %s (grid %d)\n", hipGetErrorString(e), grid); }
}
```

```cpp
#include <hip/hip_runtime.h>
#include <cstdio>
#include <cstdint>
namespace pg8 {
#define PG8_LAS __attribute__((address_space(3)))
typedef unsigned short bf16_t;
typedef short bf16x8 __attribute__((ext_vector_type(8)));
typedef float f32x4 __attribute__((ext_vector_type(4)));
typedef unsigned u32x4 __attribute__((ext_vector_type(4)));
constexpr int BM = 256, BK = 64, HALF = 128, HTB = HALF * BK * 2  , STAGE_BYTES = 8 * HTB, NXCD = 8, WGM = 8;

__host__ __device__ __forceinline__ int lds_byte(int r, int c) { const int st = (r >> 4) * 2 + (c >> 5), rr = r & 15, cc = c & 31, ob = rr * 64 + cc * 2; return st * 1024 + (ob ^ (((ob >> 9) & 1) << 5)); }
__host__ __device__ __forceinline__ void stage_rc(int b, int& R, int& C) { const int st = b / 1024, sb = b % 1024, swz = sb ^ (((sb >> 9) & 1) << 5); R = (st >> 1) * 16 + swz / 64; C = (st & 1) * 32 + (swz % 64) / 2; }
__host__ __device__ __forceinline__ int perm32(int rho) { const int n = rho >> 4, i = rho & 15; return 8 * (i >> 2) + 4 * n + (i & 3); }

struct Unit { int pm, pn; };
struct Gemm { const bf16_t* A; const bf16_t* Bt; int M, N, K; };

struct StaticOrder {
    int nM, nN, nwg, G, c;
    __host__ __device__ void init(int M, int N, int G_, int c_) { nM = M / BM; nN = N / BM; nwg = nM * nN; G = G_; c = c_; }
    __host__ __device__ bool next(int i, Unit& u) const {
        const long L = (long)i * G + c; if (L >= nwg) return false;
        int wgid = (int)L; { const int q = nwg / NXCD, r = nwg % NXCD, xcd = wgid % NXCD, off = wgid / NXCD; wgid = (xcd < r ? xcd * (q + 1) : r * (q + 1) + (xcd - r) * q) + off; }
        const int nig = WGM * nN, gid = wgid / nig, fm = gid * WGM, gsz = (nM - fm) < WGM ? (nM - fm) : WGM;
        u.pm = fm + ((wgid % nig) % gsz); u.pn = (wgid % nig) / gsz; return true;
    }
    __device__ __forceinline__ void a_ready(const Unit&) const {}
    __device__ __forceinline__ void done(const Unit&) const {}
};

__device__ __forceinline__ unsigned cvt_pk_bf16(float lo, float hi) { unsigned r; asm volatile("v_cvt_pk_bf16_f32 %0, %1, %2" : "=v"(r) : "v"(lo), "v"(hi)); return r; }
__device__ __forceinline__ float silu_f(float x) { return x * __builtin_amdgcn_rcpf(1.0f + __expf(-x)); }
struct EpiBf16 {
    static constexpr bool PERM = true, AFTER_DRAIN = false;
    bf16_t* O; int ldc; bf16_t* halo; bf16_t* vta; int vld;
    __device__ __forceinline__ void operator()(const f32x4 (&acc)[2][2][4][2], const Unit& u, int wr, int wc, int fr, int fq) const {
        const int row0 = u.pm * BM + wr * 64 + fr, col0 = u.pn * BM + wc * 32 + 8 * fq;
        const bool hz = halo != nullptr && u.pn >= 4 && u.pn <= 6;
#pragma unroll
        for (int ai = 0; ai < 2; ++ai)
#pragma unroll
            for (int m = 0; m < 4; ++m) { const int row = row0 + ai * HALF + m * 16; bf16_t* rowp = O + (size_t)row * ldc + col0;
#pragma unroll
                for (int bj = 0; bj < 2; ++bj) { const f32x4 v0 = acc[ai][bj][m][0], v1 = acc[ai][bj][m][1];
                    u32x4 w; w.x = cvt_pk_bf16(v0[0], v0[1]); w.y = cvt_pk_bf16(v0[2], v0[3]); w.z = cvt_pk_bf16(v1[0], v1[1]); w.w = cvt_pk_bf16(v1[2], v1[3]);
                    *(u32x4*)(rowp + bj * HALF) = w;
                    if (hz && (row & 63) >= 61) *(u32x4*)(halo + ((size_t)(row >> 6) * 3 + (row & 63) - 61) * 768 + (col0 - 1024) + bj * HALF) = w;
                    if (vta != nullptr && u.pn == 2) { bf16_t* vp = vta + (size_t)(col0 - 512 + bj * HALF) * vld + row;
                        vp[0] = (bf16_t)(w.x & 0xffffu); vp[(size_t)vld] = (bf16_t)(w.x >> 16); vp[(size_t)2 * vld] = (bf16_t)(w.y & 0xffffu); vp[(size_t)3 * vld] = (bf16_t)(w.y >> 16);
                        vp[(size_t)4 * vld] = (bf16_t)(w.z & 0xffffu); vp[(size_t)5 * vld] = (bf16_t)(w.z >> 16); vp[(size_t)6 * vld] = (bf16_t)(w.w & 0xffffu); vp[(size_t)7 * vld] = (bf16_t)(w.w >> 16); } } }
    }
};
struct EpiRes {
    static constexpr bool PERM = false, AFTER_DRAIN = false;
    const float* rlo; const float* rhi; float* C; const float* nw; bf16_t* xo; float* rs;
    __device__ __forceinline__ void operator()(const f32x4 (&acc)[2][2][4][2], const Unit& u, int wr, int wc, int fr, int fq) const {
        const int row0 = u.pm * BM + wr * 64 + fr, col0 = u.pn * BM + wc * 32 + 4 * fq;
        const float* rb = (u.pm < 64) ? rlo : rhi;
        f32x4 wv[2][2];
        if (nw) {
#pragma unroll
            for (int bj = 0; bj < 2; ++bj)
#pragma unroll
                for (int n = 0; n < 2; ++n) wv[bj][n] = *(const f32x4*)(nw + col0 + bj * HALF + n * 16); }
#pragma unroll
        for (int ai = 0; ai < 2; ++ai)
#pragma unroll
            for (int m = 0; m < 4; ++m) { const int row = row0 + ai * HALF + m * 16; const size_t off = (size_t)row * 1024 + col0; float ss = 0.f;
#pragma unroll
                for (int bj = 0; bj < 2; ++bj)
#pragma unroll
                    for (int n = 0; n < 2; ++n) { const f32x4 r = *(const f32x4*)(rb + off + bj * HALF + n * 16); const f32x4 x = r + acc[ai][bj][m][n]; *(f32x4*)(C + off + bj * HALF + n * 16) = x;
                        if (nw) { ss += (x[0] * x[0] + x[1] * x[1]) + (x[2] * x[2] + x[3] * x[3]); const f32x4 y = x * wv[bj][n];
                            *(unsigned long long*)(xo + off + bj * HALF + n * 16) = (unsigned long long)cvt_pk_bf16(y[0], y[1]) | ((unsigned long long)cvt_pk_bf16(y[2], y[3]) << 32); } }
                if (nw) { const int lane = fq * 16 + fr;
                    ss += __builtin_bit_cast(float, __builtin_amdgcn_ds_bpermute((lane ^ 16) << 2, __builtin_bit_cast(int, ss)));
                    ss += __builtin_bit_cast(float, __builtin_amdgcn_ds_bpermute((lane ^ 32) << 2, __builtin_bit_cast(int, ss)));
                    if (fq == 0) atomicAdd(rs + row, ss); }
                asm volatile("" ::: "memory"); }
    }
};
struct EpiSwiGLU {
    static constexpr bool PERM = true, AFTER_DRAIN = false;
    bf16_t* O; int ldc; const float* rs;
    __device__ __forceinline__ void operator()(const f32x4 (&acc)[2][2][4][2], const Unit& u, int wr, int wc, int fr, int fq) const {
        const int row0 = u.pm * BM + wr * 64 + fr, col0 = u.pn * HALF + wc * 32 + 8 * fq;
#pragma unroll
        for (int ai = 0; ai < 2; ++ai)
#pragma unroll
            for (int m = 0; m < 4; ++m) { const int row = row0 + ai * HALF + m * 16; bf16_t* rowp = O + (size_t)row * ldc + col0;
                const float rstd = __builtin_amdgcn_rsqf(rs[row] * (1.0f / 1024.0f) + 1e-6f);
                const f32x4 g0 = acc[ai][0][m][0] * rstd, g1 = acc[ai][0][m][1] * rstd, u0 = acc[ai][1][m][0] * rstd, u1 = acc[ai][1][m][1] * rstd;
                u32x4 w; w.x = cvt_pk_bf16(silu_f(g0[0]) * u0[0], silu_f(g0[1]) * u0[1]); w.y = cvt_pk_bf16(silu_f(g0[2]) * u0[2], silu_f(g0[3]) * u0[3]);
                w.z = cvt_pk_bf16(silu_f(g1[0]) * u1[0], silu_f(g1[1]) * u1[1]); w.w = cvt_pk_bf16(silu_f(g1[2]) * u1[2], silu_f(g1[3]) * u1[3]);
                *(u32x4*)rowp = w; }
    }
};
template <class Epi, class Sched, bool ALIGN_EPI = false, bool SP2 = false>
__device__ __forceinline__ void gemm_phase(PG8_LAS unsigned char* lds, const Gemm g, const Sched& S, const Epi& E) {
    int tid0 = threadIdx.x; asm volatile("" : "+v"(tid0));
    const int tid = tid0, wid = __builtin_amdgcn_readfirstlane(tid >> 6), lane = tid & 63, wr = wid >> 2, wc = wid & 3, fr = lane & 15, fq = lane >> 4;
    const int K = g.K, nt = K / BK;
    unsigned voffA[2], voffB[2];
#pragma unroll
    for (int i = 0; i < 2; ++i) { int R, C; stage_rc(tid * 16 + i * 8192, R, C); const int Rb = Epi::PERM ? ((R & ~31) + perm32(R & 31)) : R;
        voffA[i] = (unsigned)(R * K + C) * 2u; voffB[i] = (unsigned)(Rb * K + C) * 2u; }
    const size_t kstep = (size_t)(BK * 2);
    const size_t hstep = (size_t)HALF * K * 2;
    const size_t tstep = 2 * hstep;
    const unsigned ldsw = (unsigned)wid * 1024u;
    const int aoff = lds_byte(wr * 64 + fr, fq * 8), boff = lds_byte(wc * 32 + fr, fq * 8);
#define PG8_SA(b, h) (((b) * 2 + (h)) * HTB)
#define PG8_SB(b, h) ((4 + (b) * 2 + (h)) * HTB)
#define PG8_STAGE(bufoff, gbase, voff) do { _Pragma("unroll") for (int _i = 0; _i < 2; ++_i) \
        __builtin_amdgcn_global_load_lds((const unsigned*)((const char*)(gbase) + (voff)[_i]), (PG8_LAS unsigned*)(lds + (bufoff) + ldsw + _i * 8192), 16, 0, 0); } while (0)
#define PG8_LDA(dst, b, h) do { _Pragma("unroll") for (int m = 0; m < 4; ++m) _Pragma("unroll") for (int k = 0; k < 2; ++k) dst[m][k] = *(const PG8_LAS bf16x8*)(lds + PG8_SA(b, h) + aoff + m * 2048 + k * 1024); } while (0)
#define PG8_LDB(dst, b, h) do { _Pragma("unroll") for (int n = 0; n < 2; ++n) _Pragma("unroll") for (int k = 0; k < 2; ++k) dst[n][k] = *(const PG8_LAS bf16x8*)(lds + PG8_SB(b, h) + boff + n * 2048 + k * 1024); } while (0)
#define PG8_MMA(ai, bj, At, Bt) do { __builtin_amdgcn_s_setprio(1); _Pragma("unroll") for (int m = 0; m < 4; ++m) _Pragma("unroll") for (int n = 0; n < 2; ++n) _Pragma("unroll") for (int k = 0; k < 2; ++k) \
        acc[ai][bj][m][n] = __builtin_amdgcn_mfma_f32_16x16x32_bf16(Bt[n][k], At[m][k], acc[ai][bj][m][n], 0, 0, 0); __builtin_amdgcn_s_setprio(0); } while (0)
#define PG8_WAIT_V(n) asm volatile("s_waitcnt vmcnt(" #n ")" ::: "memory")
#define PG8_WAIT_L(n) asm volatile("s_waitcnt lgkmcnt(" #n ")" ::: "memory")
#define PG8_BAR __builtin_amdgcn_s_barrier()
#define PG8_SCHED __builtin_amdgcn_sched_barrier(0)
    Unit cur, nxt; int ui = 0;
    if (!S.next(0, cur)) return;
    f32x4 acc[2][2][4][2];
#pragma unroll
    for (int a = 0; a < 2; ++a)
#pragma unroll
        for (int b = 0; b < 2; ++b)
#pragma unroll
            for (int m = 0; m < 4; ++m)
#pragma unroll
                for (int n = 0; n < 2; ++n) acc[a][b][m][n] = (f32x4){0.f, 0.f, 0.f, 0.f};
    bf16x8 At[4][2], B0[2][2], B1[2][2];
    const char* cA = (const char*)g.A + (size_t)cur.pm * tstep; const char* cB = (const char*)g.Bt + (size_t)cur.pn * tstep;
    S.a_ready(cur);
    if constexpr (SP2) {
        PG8_STAGE(PG8_SB(0, 0), cB, voffB); PG8_STAGE(PG8_SB(0, 1), cB + hstep, voffB); PG8_STAGE(PG8_SA(0, 0), cA, voffA); PG8_STAGE(PG8_SA(0, 1), cA + hstep, voffA);
        if (wr == 1) PG8_BAR;
        PG8_WAIT_V(2); PG8_BAR;
        PG8_STAGE(PG8_SB(1, 0), cB + kstep, voffB); PG8_STAGE(PG8_SA(1, 0), cA + kstep, voffA); PG8_STAGE(PG8_SB(1, 1), cB + hstep + kstep, voffB);
        PG8_WAIT_V(6); PG8_BAR;
    } else {
        PG8_STAGE(PG8_SB(0, 0), cB, voffB); PG8_STAGE(PG8_SA(0, 0), cA, voffA); PG8_STAGE(PG8_SB(0, 1), cB + hstep, voffB); PG8_STAGE(PG8_SA(0, 1), cA + hstep, voffA);
        if (wr == 1) PG8_BAR;
        PG8_WAIT_V(4); PG8_BAR;
        PG8_STAGE(PG8_SB(1, 0), cB + kstep, voffB); PG8_STAGE(PG8_SA(1, 0), cA + kstep, voffA); PG8_STAGE(PG8_SB(1, 1), cB + hstep + kstep, voffB);
        PG8_WAIT_V(6); PG8_BAR;
    }
    for (;;) {
        const bool has_next = S.next(ui + 1, nxt);
        const char* nA = has_next ? (const char*)g.A + (size_t)nxt.pm * tstep : cA; const char* nB = has_next ? (const char*)g.Bt + (size_t)nxt.pn * tstep : cB;
        for (int t = 0; t < nt; t += 2) {
            const bool last = (t == nt - 2);
            const char* a1 = cA + (size_t)(t + 1) * kstep;
            const char* a2 = last ? nA : cA + (size_t)(t + 2) * kstep; const char* b2 = last ? nB : cB + (size_t)(t + 2) * kstep;
            const char* a3 = a2 + kstep; const char* b3 = b2 + kstep;
            if (last && has_next) S.a_ready(nxt);
            if constexpr (SP2) {
            PG8_LDB(B0, 0, 0); PG8_LDB(B1, 0, 1); PG8_SCHED; PG8_LDA(At, 0, 0); PG8_STAGE(PG8_SA(1, 1), a1 + hstep, voffA);
            PG8_WAIT_V(8); PG8_WAIT_L(0); PG8_BAR; PG8_MMA(0, 0, At, B0); PG8_MMA(0, 1, At, B1); PG8_BAR; PG8_SCHED;
            PG8_LDA(At, 0, 1); PG8_STAGE(PG8_SB(0, 0), b2, voffB); PG8_STAGE(PG8_SB(0, 1), b2 + hstep, voffB); PG8_STAGE(PG8_SA(0, 0), a2, voffA);
            PG8_WAIT_V(8); PG8_WAIT_L(0); PG8_BAR; PG8_MMA(1, 0, At, B0); PG8_MMA(1, 1, At, B1); PG8_BAR; PG8_SCHED;
            PG8_LDB(B0, 1, 0); PG8_LDB(B1, 1, 1); PG8_SCHED; PG8_LDA(At, 1, 0); PG8_STAGE(PG8_SA(0, 1), a2 + hstep, voffA);
            PG8_WAIT_V(8); PG8_WAIT_L(0); PG8_BAR; PG8_MMA(0, 0, At, B0); PG8_MMA(0, 1, At, B1); PG8_BAR; PG8_SCHED;
            PG8_LDA(At, 1, 1); PG8_STAGE(PG8_SB(1, 0), b3, voffB); PG8_STAGE(PG8_SB(1, 1), b3 + hstep, voffB); PG8_STAGE(PG8_SA(1, 0), a3, voffA);
            PG8_WAIT_V(8); PG8_WAIT_L(0); PG8_BAR; PG8_MMA(1, 0, At, B0); PG8_MMA(1, 1, At, B1); PG8_BAR; PG8_SCHED;
            } else {
            PG8_LDB(B0, 0, 0); PG8_SCHED; PG8_LDA(At, 0, 0); PG8_STAGE(PG8_SA(1, 1), a1 + hstep, voffA);
            PG8_WAIT_L(8); PG8_BAR; PG8_WAIT_L(0); PG8_MMA(0, 0, At, B0); PG8_BAR; PG8_SCHED;
            PG8_LDB(B1, 0, 1); PG8_STAGE(PG8_SB(0, 0), b2, voffB);
            PG8_BAR; PG8_WAIT_L(0); PG8_MMA(0, 1, At, B1); PG8_BAR;
            PG8_LDA(At, 0, 1); PG8_STAGE(PG8_SA(0, 0), a2, voffA);
            PG8_BAR; PG8_WAIT_L(0); PG8_MMA(1, 0, At, B0); PG8_BAR; PG8_SCHED;
            PG8_STAGE(PG8_SB(0, 1), b2 + hstep, voffB);
            PG8_WAIT_V(6); PG8_BAR; PG8_MMA(1, 1, At, B1); PG8_BAR;
            PG8_LDB(B0, 1, 0); PG8_SCHED; PG8_LDA(At, 1, 0); PG8_STAGE(PG8_SA(0, 1), a2 + hstep, voffA);
            PG8_WAIT_L(8); PG8_BAR; PG8_WAIT_L(0); PG8_MMA(0, 0, At, B0); PG8_BAR; PG8_SCHED;
            PG8_LDB(B1, 1, 1); PG8_STAGE(PG8_SB(1, 0), b3, voffB);
            PG8_BAR; PG8_WAIT_L(0); PG8_MMA(0, 1, At, B1); PG8_BAR;
            PG8_LDA(At, 1, 1); PG8_STAGE(PG8_SA(1, 0), a3, voffA);
            PG8_BAR; PG8_WAIT_L(0); PG8_MMA(1, 0, At, B0); PG8_BAR; PG8_SCHED;
            PG8_STAGE(PG8_SB(1, 1), b3 + hstep, voffB);
            PG8_WAIT_V(6); PG8_BAR; PG8_MMA(1, 1, At, B1); PG8_BAR;
            }
        }
        if constexpr (ALIGN_EPI) { if (wr == 0) PG8_BAR; }
        if constexpr (!Epi::AFTER_DRAIN) { E(acc, cur, wr, wc, fr, fq); S.done(cur); }
        if (!has_next) break;
#pragma unroll
        for (int a = 0; a < 2; ++a)
#pragma unroll
            for (int b = 0; b < 2; ++b)
#pragma unroll
                for (int m = 0; m < 4; ++m)
#pragma unroll
                    for (int n = 0; n < 2; ++n) acc[a][b][m][n] = (f32x4){0.f, 0.f, 0.f, 0.f};
        cur = nxt; cA = nA; cB = nB; ++ui;
        if constexpr (ALIGN_EPI) { if (wr == 1) PG8_BAR; }
    }
    PG8_WAIT_V(0);
    if constexpr (!ALIGN_EPI) { if (wr == 0) PG8_BAR; }
    PG8_BAR;
    if constexpr (Epi::AFTER_DRAIN) { E.fused(acc, cur, wr, wc, fr, fq, lds, wid, lane); S.done(cur); }
#undef PG8_SA
#undef PG8_SB
#undef PG8_STAGE
#undef PG8_LDA
#undef PG8_LDB
#undef PG8_MMA
#undef PG8_WAIT_V
#undef PG8_WAIT_L
#undef PG8_BAR
#undef PG8_SCHED
}
}
#define GAS __attribute__((address_space(1)))
#define LAS __attribute__((address_space(3)))
typedef unsigned short bf16;
typedef unsigned v4u __attribute__((ext_vector_type(4)));
typedef float f32x4 __attribute__((ext_vector_type(4)));
typedef short bf16x8 __attribute__((ext_vector_type(8)));
typedef GAS unsigned gu32;
typedef GAS unsigned long long gu64;
#define RLX_AGENT __ATOMIC_RELAXED, __HIP_MEMORY_SCOPE_AGENT
#define LDS_WAIT() asm volatile("s_waitcnt lgkmcnt(0)" ::: "memory")
#define VM_WAIT() asm volatile("s_waitcnt vmcnt(0)" ::: "memory")
__device__ __forceinline__ unsigned long long rt() { return __builtin_amdgcn_s_memrealtime(); }
__device__ __forceinline__ unsigned f2bf(float f) { unsigned u = __builtin_bit_cast(unsigned, f); return (u + 0x7fffu + ((u >> 16) & 1u)) >> 16; }
__device__ __forceinline__ unsigned pk2(float lo, float hi) { return f2bf(lo) | (f2bf(hi) << 16); }
#define XB_TMO      128
#define XB_XCNT(j)  (256  + 64 * (j))
#define XB_XSUB(j)  (1280 + 64 * (j))
#define XB_XGEN(j)  (2304 + 64 * (j))
#define XB_TOP      3328
#define XB_TOPGEN   3392
#define XCD_BAR_WORDS 3456
#define XB_SPIN_CAP (1u << 18)

__device__ __forceinline__ unsigned xb_ld(unsigned* p)              { return __hip_atomic_load(p, __ATOMIC_RELAXED, __HIP_MEMORY_SCOPE_AGENT); }
__device__ __forceinline__ unsigned xb_add(unsigned* p, unsigned v) { return __hip_atomic_fetch_add(p, v, __ATOMIC_RELAXED, __HIP_MEMORY_SCOPE_AGENT); }
__device__ __forceinline__ unsigned xb_xcc_id() { return (unsigned)__builtin_amdgcn_s_getreg((3 << 11) | 20) & 0xFu; }
#define XB_SPIN(cond, bar) do { unsigned _sp = 0; while (cond) { __builtin_amdgcn_s_sleep(1); \
    if ((++_sp & 255u) == 0u) { if (xb_ld(&(bar)[XB_TMO])) break; if (_sp > XB_SPIN_CAP) { atomicAdd(&(bar)[XB_TMO], 1u); break; } } } } while (0)

struct XcdBarrier {
    unsigned* bar; unsigned x;
    volatile LAS unsigned* st;
};

__device__ __forceinline__ XcdBarrier xcd_barrier_post(unsigned* bar, volatile LAS unsigned* st) {
    XcdBarrier b; b.bar = bar; b.x = xb_xcc_id(); b.st = st;
    if (threadIdx.x == 0) (void)xb_add(&bar[XB_XCNT(b.x)], 1u);
    return b;
}
__device__ __forceinline__ void xcd_barrier_complete(unsigned* bar, unsigned x, unsigned& nloc, unsigned& nx) {
    const unsigned G = gridDim.x * gridDim.y * gridDim.z;
    unsigned sum, cnt, mine, sp = 0u;
    for (;;) {
        sum = 0u; cnt = 0u; mine = 0u;
#pragma unroll
        for (unsigned j = 0; j < 16; ++j) { const unsigned c = xb_ld(&bar[XB_XCNT(j)]); sum += c; cnt += (c > 0u) ? 1u : 0u; mine = (j == x) ? c : mine; }
        if (sum == G) break;
        __builtin_amdgcn_s_sleep(1);
        if ((++sp & 255u) == 0u) { if (xb_ld(&bar[XB_TMO])) break; if (sp > XB_SPIN_CAP) { atomicAdd(&bar[XB_TMO], 1u); break; } }
    }
    nloc = mine > 0u ? mine : 1u; nx = cnt > 0u ? cnt : 1u;
}

__device__ __forceinline__ void xcd_barrier(const XcdBarrier& b) {
    asm volatile("s_waitcnt vmcnt(0)" ::: "memory");
    __syncthreads();
    if (threadIdx.x == 0) {
        unsigned* bar = b.bar;
        __builtin_amdgcn_s_waitcnt(0);
        unsigned nloc = b.st[0], nx = b.st[1];
        if (nloc == 0u) { xcd_barrier_complete(bar, b.x, nloc, nx); b.st[0] = nloc; b.st[1] = nx; }
        const unsigned old = xb_add(&bar[XB_XSUB(b.x)], 1u);
        const unsigned gen = old / nloc;
        if (old + 1u == (gen + 1u) * nloc) {
            __builtin_amdgcn_fence(__ATOMIC_RELEASE, "agent");
            asm volatile("s_waitcnt vmcnt(0)" ::: "memory");
            const unsigned og = xb_add(&bar[XB_TOP], 1u);
            const unsigned tg = og / nx;
            if (og + 1u == (tg + 1u) * nx) xb_add(&bar[XB_TOPGEN], 1u);
            else XB_SPIN(xb_ld(&bar[XB_TOPGEN]) == tg, bar);
            __builtin_amdgcn_fence(__ATOMIC_ACQUIRE, "agent");
            xb_add(&bar[XB_XGEN(b.x)], 1u);
            asm volatile("s_waitcnt vmcnt(0)" ::: "memory");
        } else {
            XB_SPIN(xb_ld(&bar[XB_XGEN(b.x)]) == gen, bar);
            __builtin_amdgcn_fence(__ATOMIC_ACQUIRE, "agent");
            asm volatile("s_waitcnt vmcnt(0)" ::: "memory");
        }
    }
    __syncthreads();
}
constexpr int NWAVES = 8, NTHR = 512;
constexpr int D = 1024, MP = 16384, NSB = 16, SSEQ = 16, MS = NSB * SSEQ, M = MP + MS;
constexpr int NIN = 3076, NPROJ = 3072, DFF = 2816, NGU = 2 * DFF;
constexpr int NCHP = 256, NCH = NCHP + NSB;
constexpr int PC_Q = 0, PC_K = 256, PC_V = 512, PC_Z = 768, PC_X = 1024, PC_B = 1280, PC_C = 1536, PC_CQ = 1792, PC_CF = 2048, PC_CI = 2304, PC_CG = 2560, PC_DX = 2816;
constexpr float EPS = 1e-6f;
enum { I_XP = 0, I_XS, I_CK, I_CV, I_SCONV, I_SSSM, I_SHGRN, I_SPOOL, I_N1, I_WIN, I_AREL, I_CW, I_CB, I_DTB, I_ALOG, I_BD, I_BNRM, I_LB, I_CNRM, I_PW, I_PS, I_WOUT, I_N2, I_WGU, I_WDN, I_NF, N_IN };
constexpr size_t O_YP = 0, O_YS = O_YP + (size_t)MP * D, O_PK = O_YS + (size_t)MS * D, O_PV = O_PK + 2 * 512 * 256, O_PCONV = O_PV + 2 * 512 * 256, O_PSSM = O_PCONV + 2 * 3 * 768,
                 O_PHGRN = O_PSSM + 2 * 4 * 64 * 128, O_PPOOL = O_PHGRN + 2 * 4 * 64 * 64, O_SK = O_PPOOL + 2 * 15 * 256, O_SV = O_SK + (size_t)2 * 16 * 512 * 256,
                 O_SCONV = O_SV + (size_t)2 * 16 * 512 * 256, O_SSSM = O_SCONV + 2 * 16 * 3 * 768, O_SHGRN = O_SSSM + 2 * 16 * 4 * 64 * 128, O_SPOOL = O_SHGRN + 2 * 16 * 4 * 64 * 64,
                 O_END = O_SPOOL + 2 * 16 * 15 * 256;
constexpr size_t MiB = 1u << 20;
constexpr size_t WS_CTL = 0, CTL_ZERO_BYTES = 64 * 1024;
constexpr size_t WL_IN = 0, WL_OUT = 6 * MiB, WL_GU = 8 * MiB, WL_DN = 19 * MiB, WL_STRIDE = 24 * MiB + MiB / 2;
constexpr size_t WS_W = 1 * MiB;
constexpr size_t WS_XN = 50 * MiB;
constexpr size_t WS_PROJ = 83 * MiB;
constexpr size_t WS_STB = 181 * MiB;
constexpr size_t WS_XT = 198 * MiB;
constexpr size_t WS_HALO = 207 * MiB;
constexpr size_t WS_RH = 208 * MiB + MiB / 2;
constexpr size_t WS_STC = 215 * MiB;
constexpr size_t WS_VT = 223 * MiB + MiB / 2;
constexpr size_t WS_DT = 232 * MiB;
constexpr size_t WS_DECB = 233 * MiB;
constexpr size_t WS_DECC = 233 * MiB + 64 * 1024;
constexpr size_t WS_ACS = 233 * MiB + 384 * 1024, WS_DTV = 233 * MiB + 704 * 1024;
constexpr size_t WS_VTA = 234 * MiB;
constexpr size_t WS_END = 243 * MiB;
static_assert(WS_VTA + (size_t)256 * M * 2 <= WS_END, "ws map 2");
constexpr int CW_QUEUE = 512;
static_assert(WS_XN + (size_t)M * D * 2 <= WS_PROJ && WS_PROJ + (size_t)M * NPROJ * 2 <= WS_STB && WS_STB + (size_t)NCH * 4 * 64 * 128 * 2 <= WS_XT && WS_XT + (size_t)NCH * 256 * 64 * 2 <= WS_HALO && WS_HALO + (size_t)256 * 3 * 768 * 2 <= WS_STC && WS_RH + (size_t)NCH * 1280 * 4 <= WS_STC && WS_STC + (size_t)NCH * 4 * 64 * 64 * 2 <= WS_VT && WS_VT + (size_t)NCH * 256 * 64 * 2 <= WS_DT, "ws map");
static_assert(WL_DN + (size_t)D * DFF * 2 <= WL_STRIDE && WS_W + 2 * WL_STRIDE <= WS_XN, "weight map");
constexpr size_t WS_WPT = 128 * 1024;
constexpr size_t WS_RS = 256 * 1024;
constexpr size_t WS_XN2 = 181 * MiB;
static_assert(WS_XN2 + (size_t)M * D * 2 <= 232 * MiB && WS_RS + 2 * (size_t)M * 4 <= MiB, "ws map 3");
constexpr int CW_BAR = 1024;
constexpr int LDS_BYTES = 163840;
constexpr int MISC_OFF = LDS_BYTES - 256;
constexpr int RING_OFF = 0;
typedef LAS float lf32;
typedef float f32x2 __attribute__((ext_vector_type(2)));
struct Args { const float* in[N_IN]; float* out; unsigned char* ws; };
struct Frame {
    LAS unsigned char* lds;
    float* out; unsigned char* ws;
};
__device__ __forceinline__ float* inp(int i) { asm volatile("" : "+s"(i)); return ((float* const __attribute__((address_space(4)))*)__builtin_amdgcn_kernarg_segment_ptr())[i]; }
__device__ __forceinline__ unsigned char* opq(unsigned char* p) { asm volatile("" : "+s"(p)); return p; }
#define ITEM_IDS() int tid_ = threadIdx.x; asm volatile("" : "+v"(tid_)); const int wave_ = __builtin_amdgcn_readfirstlane(tid_ >> 6); const int lane_ = tid_ & 63; (void)lane_; (void)wave_
#define F_XN ((bf16*)opq(F.ws + WS_XN))
#define F_PROJ ((bf16*)opq(F.ws + WS_PROJ))
#define F_ACT ((bf16*)opq(F.ws + WS_PROJ))
#define F_STB ((bf16*)opq(F.ws + WS_STB))
#define F_XT ((bf16*)opq(F.ws + WS_XT))
#define F_HALO ((bf16*)opq(F.ws + WS_HALO))
#define F_ACS ((float*)opq(F.ws + WS_ACS))
#define F_DTV ((float*)opq(F.ws + WS_DTV))
#define F_STC ((bf16*)opq(F.ws + WS_STC))
#define F_VT ((bf16*)opq(F.ws + WS_VT))
#define F_RH ((float*)opq(F.ws + WS_RH))
#define F_VTA ((bf16*)opq(F.ws + WS_VTA))
#define F_WPT ((bf16*)opq(F.ws + WS_WPT))
#define F_RS ((float*)opq(F.ws + WS_RS))
#define F_XN2 ((bf16*)opq(F.ws + WS_XN2))
#define F_DT ((float*)opq(F.ws + WS_DT))
#define F_DECB ((float*)opq(F.ws + WS_DECB))
#define F_DECC ((float*)opq(F.ws + WS_DECC))
#define F_X    (F.out)
__device__ __forceinline__ float bf_lo(unsigned w) { return __builtin_bit_cast(float, w << 16); }
__device__ __forceinline__ float bf_hi(unsigned w) { return __builtin_bit_cast(float, w & 0xffff0000u); }
__device__ __forceinline__ float bf1(bf16 b) { return __builtin_bit_cast(float, (unsigned)b << 16); }
__device__ __forceinline__ void unpack8(const v4u w, float (&v)[8]) { v[0] = bf_lo(w.x); v[1] = bf_hi(w.x); v[2] = bf_lo(w.y); v[3] = bf_hi(w.y); v[4] = bf_lo(w.z); v[5] = bf_hi(w.z); v[6] = bf_lo(w.w); v[7] = bf_hi(w.w); }
__device__ __forceinline__ v4u pack8(const float (&v)[8]) { v4u o; o.x = pk2(v[0], v[1]); o.y = pk2(v[2], v[3]); o.z = pk2(v[4], v[5]); o.w = pk2(v[6], v[7]); return o; }
__device__ __forceinline__ float shx(int lane, float v, int o) { return __builtin_bit_cast(float, __builtin_amdgcn_ds_bpermute((lane ^ o) << 2, __builtin_bit_cast(int, v))); }
__device__ __forceinline__ float shu(int lane, float v, int o) { return __builtin_bit_cast(float, __builtin_amdgcn_ds_bpermute((lane - o) << 2, __builtin_bit_cast(int, v))); }
__device__ __forceinline__ float shi(float v, int idx) { return __builtin_bit_cast(float, __builtin_amdgcn_ds_bpermute(idx << 2, __builtin_bit_cast(int, v))); }
__device__ __forceinline__ float wave_sum_l(int lane, float v) {
#pragma unroll
    for (int o = 1; o < 64; o <<= 1) v += shx(lane, v, o);
    return v;
}
__device__ __forceinline__ float sum16_l(int lane, float v) {
#pragma unroll
    for (int o = 1; o < 16; o <<= 1) v += shx(lane, v, o);
    return v;
}
__device__ __forceinline__ float max16_l(int lane, float v) {
#pragma unroll
    for (int o = 1; o < 16; o <<= 1) v = fmaxf(v, shx(lane, v, o));
    return v;
}
__device__ __forceinline__ float rcp_f(float x) { return __builtin_amdgcn_rcpf(x); }
__device__ __forceinline__ float rsq_f(float x) { return __builtin_amdgcn_rsqf(x); }
__device__ __forceinline__ float sigmoid_f(float x) { return rcp_f(1.0f + __expf(-x)); }
__device__ __forceinline__ float silu_g(float x) { return x * rcp_f(1.0f + __expf(-x)); }
__device__ __forceinline__ float softplus_f(float x) { const float e = __expf(x); return x > 20.f ? x : (e < 0.01f ? e * (1.0f - e * (0.5f - e * (1.0f / 3.0f))) : __logf(1.0f + e)); }
__device__ __forceinline__ f32x4 mfma4(float a, float b, f32x4 c) { return __builtin_amdgcn_mfma_f32_16x16x4f32(a, b, c, 0, 0, 0); }

struct Chunk { int ci, row0, nrows, b; };
__device__ __forceinline__ Chunk chunk_of(int ci) { Chunk c; c.ci = ci; if (ci < NCHP) { c.row0 = 64 * ci; c.nrows = 64; c.b = -1; } else { c.b = ci - NCHP; c.row0 = MP + SSEQ * c.b; c.nrows = SSEQ; } return c; }

__device__ __forceinline__ void tr_item64(const float* W, int ldw, int K, bf16* WT, int k0, int nd0, int ns0, float scale, lf32* scr, int lane) {
    f32x4 wv_[16];
    const int rq = lane >> 4, c4 = (lane & 15) * 4;
#pragma unroll
    for (int i = 0; i < 16; ++i) wv_[i] = *(const f32x4*)(W + (size_t)(k0 + 4 * i + rq) * ldw + ns0 + c4);
#pragma unroll
    for (int i = 0; i < 16; ++i) { lf32* d = scr + (4 * i + rq) * 65 + c4; d[0] = wv_[i].x; d[1] = wv_[i].y; d[2] = wv_[i].z; d[3] = wv_[i].w; }
    LDS_WAIT(); asm volatile("" ::: "memory");
    const int c = lane & 7;
#pragma unroll
    for (int j = 0; j < 8; ++j) { const int n = (lane >> 3) + 8 * j; const lf32* s = scr + (8 * c) * 65 + n;
        v4u o; o.x = pk2(s[0 * 65] * scale, s[1 * 65] * scale); o.y = pk2(s[2 * 65] * scale, s[3 * 65] * scale); o.z = pk2(s[4 * 65] * scale, s[5 * 65] * scale); o.w = pk2(s[6 * 65] * scale, s[7 * 65] * scale);
        *(GAS v4u*)(WT + (size_t)(nd0 + n) * K + k0 + 8 * c) = o; }
    LDS_WAIT(); asm volatile("" ::: "memory");
}
__device__ __forceinline__ void tr_item(const float* W, int ldw, int K, bf16* WT, int k0, int nd0, int ns0, float scale, lf32* scr, int lane) {
    float wv_[32];
#pragma unroll
    for (int i = 0; i < 32; ++i) wv_[i] = W[(size_t)(k0 + 2 * i + (lane >> 5)) * ldw + ns0 + (lane & 31)];
#pragma unroll
    for (int i = 0; i < 32; ++i) scr[(2 * i + (lane >> 5)) * 33 + (lane & 31)] = wv_[i];
    LDS_WAIT(); asm volatile("" ::: "memory");
    const int c = lane & 7;
#pragma unroll
    for (int j = 0; j < 4; ++j) { const int n = (lane >> 3) + 8 * j; const lf32* s = scr + (8 * c) * 33 + n;
        v4u o; o.x = pk2(s[0 * 33] * scale, s[1 * 33] * scale); o.y = pk2(s[2 * 33] * scale, s[3 * 33] * scale); o.z = pk2(s[4 * 33] * scale, s[5 * 33] * scale); o.w = pk2(s[6 * 33] * scale, s[7 * 33] * scale);
        *(GAS v4u*)(WT + (size_t)(nd0 + n) * K + k0 + 8 * c) = o; }
    LDS_WAIT(); asm volatile("" ::: "memory");
}
__device__ __forceinline__ void p0_weights(Frame& F, int l, int gw, int NGW, bool pool) {
    ITEM_IDS();
    lf32* scr = (lf32*)(F.lds + wave_ * 16896);
    constexpr int I_INA = 16 * 28, I_INB = 16 * 40, I_OUT = 16 * 16, I_GU = 16 * 88, I_DN = 44 * 16, I_L = I_INA + I_INB + I_OUT + I_GU + I_DN;
    unsigned char* wl = F.ws + WS_W + (size_t)l * WL_STRIDE;
    for (int it = gw; it < I_L; it += NGW) {
        int r = it;
        if (r < I_INA) { const int kb = r / 28, nb = r % 28, nd0 = 64 * nb; tr_item64(inp(I_WIN) + (size_t)l * D * NIN, NIN, D, (bf16*)(wl + WL_IN), 64 * kb, nd0, nd0, nd0 < 256 ? 0.125f : 1.0f, scr, lane_); continue; } r -= I_INA;
        if (r < I_INB) { const int kb = r / 40, nb = r % 40, nd0 = 1792 + 32 * nb; tr_item(inp(I_WIN) + (size_t)l * D * NIN, NIN, D, (bf16*)(wl + WL_IN), 64 * kb, nd0, nd0 + 4, 1.0f, scr, lane_); continue; } r -= I_INB;
        if (r < I_OUT) { const int kb = r / 16, nb = r % 16; tr_item64(inp(I_WOUT) + (size_t)l * D * D, D, D, (bf16*)(wl + WL_OUT), 64 * kb, 64 * nb, 64 * nb, 1.0f, scr, lane_); continue; } r -= I_OUT;
        if (r < I_GU) { const int kb = r / 88, nb = r % 88, nd0 = 64 * nb, pn = nd0 >> 8, bj = (nd0 >> 7) & 1, c = nd0 & 127; tr_item64(inp(I_WGU) + (size_t)l * D * NGU, NGU, D, (bf16*)(wl + WL_GU), 64 * kb, nd0, bj * DFF + 128 * pn + c, 1.0f, scr, lane_); continue; } r -= I_GU;
        { const int kb = r / 16, nb = r % 16; tr_item64(inp(I_WDN) + (size_t)l * DFF * D, D, DFF, (bf16*)(wl + WL_DN), 64 * kb, 64 * nb, 64 * nb, 1.0f, scr, lane_); }
    }
    if (pool) { const float* pw = inp(I_PW); for (int i = ((int)blockIdx.x) * NTHR + tid_; i < 2 * 4 * 64 * 64; i += ((int)gridDim.x) * NTHR) { const int c = i & 63, d = (i >> 6) & 63, lg = i >> 12; F_WPT[i] = (bf16)f2bf(pw[(size_t)(lg * 64 + c) * 64 + d]); } }
}
template <bool WITH_DT, bool FINAL>
__device__ __forceinline__ void norm_rows(Frame& F, const float* xlo, const float* xhi, const float* w, const float* wdt  ) {
    ITEM_IDS();
    lf32* wl = (lf32*)F.lds;
    if (WITH_DT) { for (int k = tid_; k < D; k += NTHR) { const f32x4 v = *(const f32x4*)(wdt + (size_t)k * NIN + 1792); *(LAS f32x4*)(wl + 4 * k) = v; } __syncthreads(); }
    const int gw = ((int)blockIdx.x) * NWAVES + wave_, NGW = ((int)gridDim.x) * NWAVES;
    f32x4 wv[4];
#pragma unroll
    for (int j = 0; j < 4; ++j) wv[j] = *(const f32x4*)(w + 256 * j + 4 * lane_);
    for (int m0 = gw; m0 < M; m0 += 4 * NGW) {
        f32x4 v[4][4];
#pragma unroll
        for (int q = 0; q < 4; ++q) { const int m = m0 + q * NGW; if (m < M) { const float* xr = (m < MP ? xlo : xhi) + (size_t)m * D;
#pragma unroll
            for (int j = 0; j < 4; ++j) v[q][j] = *(const f32x4*)(xr + 256 * j + 4 * lane_); } }
#pragma unroll
        for (int q = 0; q < 4; ++q) { const int m = m0 + q * NGW; if (m < M) {
            float s = 0.f;
#pragma unroll
            for (int j = 0; j < 4; ++j) s += (v[q][j].x * v[q][j].x + v[q][j].y * v[q][j].y) + (v[q][j].z * v[q][j].z + v[q][j].w * v[q][j].w);
            const float rstd = rsq_f(wave_sum_l(lane_, s) * (1.0f / D) + EPS);
#pragma unroll
            for (int j = 0; j < 4; ++j) v[q][j] = v[q][j] * rstd * wv[j];
            if (FINAL) {
#pragma unroll
                for (int j = 0; j < 4; ++j) *(f32x4*)(F.out + (size_t)m * D + 256 * j + 4 * lane_) = v[q][j];
            } else {
                GAS unsigned long long* o8 = (GAS unsigned long long*)(F_XN + (size_t)m * D) + lane_;
#pragma unroll
                for (int j = 0; j < 4; ++j) o8[64 * j] = (unsigned long long)pk2(v[q][j].x, v[q][j].y) | ((unsigned long long)pk2(v[q][j].z, v[q][j].w) << 32);
            }
            if (WITH_DT) {
                f32x4 a = {0.f, 0.f, 0.f, 0.f};
#pragma unroll
                for (int j = 0; j < 4; ++j) { const LAS f32x4* wp = (const LAS f32x4*)(wl + 4 * (256 * j + 4 * lane_));
                    a += wp[0] * v[q][j].x; a += wp[1] * v[q][j].y; a += wp[2] * v[q][j].z; a += wp[3] * v[q][j].w; }
                a.x = wave_sum_l(lane_, a.x); a.y = wave_sum_l(lane_, a.y); a.z = wave_sum_l(lane_, a.z); a.w = wave_sum_l(lane_, a.w);
                if (lane_ == 0) *(f32x4*)(F_DT + (size_t)m * 4) = a;
            } } }
    }
    if (WITH_DT) __syncthreads();
}
constexpr int PL_RAW = 0, PL_PL = 79 * 256 * 4, PL_END = PL_PL + 64 * 264 * 2;
static_assert(PL_END <= MISC_OFF, "pool LDS map");
__device__ __forceinline__ void pool_item(Frame& F, int layer, int ci) {
    ITEM_IDS();
    const Chunk c = chunk_of(ci);
    lf32* raw = (lf32*)(F.lds + PL_RAW);
    LAS bf16* Pl = (LAS bf16*)(F.lds + PL_PL);
    const float* spool = inp(I_SPOOL) + (size_t)(layer * NSB + (c.b < 0 ? 0 : c.b)) * 15 * 256;
    v4u pw[5]; f32x4 pf[5][2];
#pragma unroll
    for (int q = 0; q < 5; ++q) { const int it = tid_ + q * NTHR; pw[q] = (v4u){0u, 0u, 0u, 0u}; pf[q][0] = (f32x4){0.f, 0.f, 0.f, 0.f}; pf[q][1] = pf[q][0];
        if (it < 79 * 32) { const int rr = it >> 5, cg = it & 31, r = rr - 15;
            if (r < c.nrows) { if (r >= 0 || (c.b < 0 && c.row0 + r >= 0)) pw[q] = *(const v4u*)(F_PROJ + (size_t)(c.row0 + r) * NPROJ + PC_DX + 8 * cg);
                               else if (c.b >= 0) { const float* s = spool + (size_t)(15 + r) * 256 + 8 * cg; pf[q][0] = *(const f32x4*)s; pf[q][1] = *(const f32x4*)(s + 4); } } } }
#pragma unroll
    for (int q = 0; q < 5; ++q) { const int it = tid_ + q * NTHR;
        if (it < 79 * 32) { const int rr = it >> 5, cg = it & 31, r = rr - 15; float v[8];
            if (c.b >= 0 && r < 0) { v[0] = pf[q][0].x; v[1] = pf[q][0].y; v[2] = pf[q][0].z; v[3] = pf[q][0].w; v[4] = pf[q][1].x; v[5] = pf[q][1].y; v[6] = pf[q][1].z; v[7] = pf[q][1].w; } else unpack8(pw[q], v);
            *(LAS f32x4*)(raw + rr * 256 + 8 * cg) = (f32x4){v[0], v[1], v[2], v[3]}; *(LAS f32x4*)(raw + rr * 256 + 8 * cg + 4) = (f32x4){v[4], v[5], v[6], v[7]}; } }
    __syncthreads();
    { const int ch = tid_ & 255, half = tid_ >> 8, win = 2 << (ch >> 6); const float inv = 1.0f / (float)win;
      const lf32* rp = raw + (32 * half + 15) * 256 + ch;
      float s = 0.f; for (int q = 1; q < win; ++q) s += rp[-q * 256];
#pragma unroll 8
      for (int r = 0; r < 32; ++r) { const float x = rp[r * 256], xo = rp[(r - win + 1) * 256]; s += x; Pl[(32 * half + r) * 264 + ch] = (bf16)f2bf(s * inv - x); s -= xo; } }
    __syncthreads();
    const int tb = wave_ >> 1, g0 = 2 * (wave_ & 1), kq = lane_ >> 4, fr = lane_ & 15;
    const bf16* wt = F_WPT + (size_t)layer * 4 * 64 * 64; const float* sc = inp(I_PS) + (size_t)layer * 256;
#pragma unroll
    for (int gg = 0; gg < 2; ++gg) {
        const int g = g0 + gg;
        bf16x8 bw[4][2];
#pragma unroll
        for (int t = 0; t < 4; ++t)
#pragma unroll
            for (int ks = 0; ks < 2; ++ks) bw[t][ks] = *(const bf16x8*)(wt + (size_t)(g * 64 + t * 16 + fr) * 64 + 32 * ks + 8 * kq);
        bf16x8 a[2];
#pragma unroll
        for (int ks = 0; ks < 2; ++ks) a[ks] = *(const LAS bf16x8*)(Pl + (tb * 16 + fr) * 264 + g * 64 + 32 * ks + 8 * kq);
#pragma unroll
        for (int t = 0; t < 4; ++t) { f32x4 acc = {0.f, 0.f, 0.f, 0.f};
#pragma unroll
            for (int ks = 0; ks < 2; ++ks) acc = __builtin_amdgcn_mfma_f32_16x16x32_bf16(a[ks], bw[t][ks], acc, 0, 0, 0);
            const float s = sc[g * 64 + t * 16 + fr];
#pragma unroll
            for (int r = 0; r < 4; ++r) { const int row = tb * 16 + 4 * kq + r; if (row < c.nrows) F_XN[(size_t)(c.row0 + row) * D + 768 + g * 64 + t * 16 + fr] = (bf16)f2bf(acc[r] * s); } }
    }
    __syncthreads();
}

__device__ __forceinline__ void copy_cache(Frame& F, int layer, int b0, int nb) {
    ITEM_IDS();
    const int gt = b0 * NTHR + tid_, GT = nb * NTHR;
    float* out = F.out; const float* ckp = inp(I_CK); const float* cvp = inp(I_CV);
    for (int base = gt; base < 32 * 31744; base += 8 * GT) {
        f32x4 v[8];
#pragma unroll
        for (int q = 0; q < 8; ++q) { const int i = base + q * GT; if (i < 32 * 31744) { const int wb = i / 31744, e = i - wb * 31744; const int which = wb >> 4, b = wb & 15;
            v[q] = *(const f32x4*)((which ? cvp : ckp) + ((size_t)(layer * NSB + b) * 512 + 16) * 256 + 4 * (size_t)e); } }
#pragma unroll
        for (int q = 0; q < 8; ++q) { const int i = base + q * GT; if (i < 32 * 31744) { const int wb = i / 31744, e = i - wb * 31744; const int which = wb >> 4, b = wb & 15;
            *(f32x4*)(out + (which ? O_SV : O_SK) + (size_t)(layer * NSB + b) * 512 * 256 + 4 * (size_t)e) = v[q]; } }
    }
}
__device__ __forceinline__ void copy_small(Frame& F, int layer, int b0, int nb) {
    ITEM_IDS();
    const int gt = b0 * NTHR + tid_, GT = nb * NTHR;
    float* out = F.out;
    constexpr int T_P = 2 * 512 * 32, T_S = 2 * 16 * 16 * 32, T_D = 17 * 15 * 32, T_ALL = T_P + T_S + T_D;
    for (int base = gt; base < T_ALL; base += 4 * GT) {
        v4u w[4];
#pragma unroll
        for (int q = 0; q < 4; ++q) { int t = base + q * GT; if (t < T_ALL) { size_t src;
            if (t < T_P) { const int which = t >> 14, j = (t >> 5) & 511, cg = t & 31; src = (size_t)(MP - 512 + j) * NPROJ + (which ? PC_V : PC_K) + 8 * cg; }
            else if (t < T_P + T_S) { t -= T_P; const int which = t >> 13, b = (t >> 9) & 15, j = (t >> 5) & 15, cg = t & 31; src = (size_t)(MP + 16 * b + j) * NPROJ + (which ? PC_V : PC_K) + 8 * cg; }
            else { t -= T_P + T_S; const int b = t / 480, rr = (t / 32) % 15, cg = t & 31; src = (size_t)(b == 0 ? MP - 15 + rr : MP + 16 * (b - 1) + 1 + rr) * NPROJ + PC_DX + 8 * cg; }
            w[q] = *(const v4u*)(F_PROJ + src); } }
#pragma unroll
        for (int q = 0; q < 4; ++q) { int t = base + q * GT; if (t < T_ALL) { size_t dst;
            if (t < T_P) { const int which = t >> 14, j = (t >> 5) & 511, cg = t & 31; dst = (which ? O_PV : O_PK) + (size_t)layer * 512 * 256 + j * 256 + 8 * cg; }
            else if (t < T_P + T_S) { t -= T_P; const int which = t >> 13, b = (t >> 9) & 15, j = (t >> 5) & 15, cg = t & 31; dst = (which ? O_SV : O_SK) + ((size_t)(layer * NSB + b) * 512 + 496 + j) * 256 + 8 * cg; }
            else { t -= T_P + T_S; const int b = t / 480, rr = (t / 32) % 15, cg = t & 31; dst = (b == 0 ? O_PPOOL + (size_t)layer * 3840 : O_SPOOL + (size_t)(layer * NSB + b - 1) * 3840) + rr * 256 + 8 * cg; }
            float v[8]; unpack8(w[q], v); *(f32x4*)(out + dst) = (f32x4){v[0], v[1], v[2], v[3]}; *(f32x4*)(out + dst + 4) = (f32x4){v[4], v[5], v[6], v[7]}; } }
    }
}
constexpr int KS_LD = 72, PS_LD = 584;
constexpr int AT_KS = 0, AT_VT = 576 * KS_LD * 2, AT_ST = AT_VT + 64 * PS_LD * 2, AT_BIAS = AT_ST + 1024;
static_assert(AT_BIAS + 4 * 260 * 4 <= MISC_OFF, "attention LDS map");
__device__ __forceinline__ void attn_bias_load(Frame& F, int layer) { const float* arel = inp(I_AREL) + (size_t)layer * 257 * 4; lf32* b = (lf32*)(F.lds + AT_BIAS); ITEM_IDS(); for (int i = tid_; i < 257 * 4; i += NTHR) b[260 * (i & 3) + (i >> 2)] = arel[i]; }
__device__ __forceinline__ void attn_item(Frame& F, int layer, int ci, int h) {
    ITEM_IDS();
    const Chunk c = chunk_of(ci);
    LAS bf16* Ks = (LAS bf16*)(F.lds + AT_KS); LAS bf16* Ps = Ks; LAS bf16* Vt = (LAS bf16*)(F.lds + AT_VT);
    lf32* mx = (lf32*)(F.lds + AT_ST); lf32* sm = mx + 128; lf32* bias = (lf32*)(F.lds + AT_BIAS) + 260 * h;
    const int jlo = (c.b < 0) ? (ci < 8 ? 64 * (8 - ci) : 0) : 0;
    const int jval = (c.b < 0) ? 576 : 528;
    const float* ckp = inp(I_CK); const float* cvp = inp(I_CV);
    bf16x8 qa0 = {0, 0, 0, 0, 0, 0, 0, 0}, qa1 = qa0;
    if (c.b < 0 || (wave_ >> 1) == 0) { const bf16* qp = F_PROJ + (size_t)(c.row0 + (wave_ >> 1) * 16 + (lane_ & 15)) * NPROJ + PC_Q + 64 * h + 8 * (lane_ >> 4); qa0 = *(const bf16x8*)qp; qa1 = *(const bf16x8*)(qp + 32); }
    if (c.b < 0) {
        const bf16* kg = F_PROJ + (long)(c.row0 - 512) * NPROJ + PC_K + 64 * h;
        const bf16* vg = F_VTA + (long)(64 * h) * M + (long)(c.row0 - 512);
        const int npc = (576 - jlo) >> 3, nk = (576 - jlo) * 8, nv = 64 * npc;
        v4u kr[9], vr[9];
#pragma unroll
        for (int q = 0; q < 9; ++q) { const int it = tid_ + q * NTHR;
            if (it < nk) kr[q] = *(const v4u*)(kg + (long)(jlo + (it >> 3)) * NPROJ + 8 * (it & 7));
            if (it < nv) { const int d = it / npc, pc = it - d * npc; vr[q] = *(const v4u*)(vg + (long)d * M + jlo + 8 * pc); } }
#pragma unroll
        for (int q = 0; q < 9; ++q) { const int it = tid_ + q * NTHR;
            if (it < nk) *(LAS v4u*)(Ks + (jlo + (it >> 3)) * KS_LD + 8 * (it & 7)) = kr[q];
            if (it < nv) { const int d = it / npc, pc = it - d * npc; *(LAS v4u*)(Vt + d * PS_LD + jlo + 8 * pc) = vr[q]; } }
    } else {
    for (int it = tid_; it < (576 - jlo) * 8; it += NTHR) {
        const int j = jlo + (it >> 3), dg = it & 7;
        v4u kw, vw;
        if (j < 512) { const size_t o = (((size_t)(layer * NSB + c.b) * 512 + j) * 4 + h) * 64 + 8 * dg; const float* kp = ckp + o; const float* vp = cvp + o;
            const f32x4 k0 = *(const f32x4*)kp, k1 = *(const f32x4*)(kp + 4), v0 = *(const f32x4*)vp, v1 = *(const f32x4*)(vp + 4);
            kw.x = pk2(k0.x, k0.y); kw.y = pk2(k0.z, k0.w); kw.z = pk2(k1.x, k1.y); kw.w = pk2(k1.z, k1.w); vw.x = pk2(v0.x, v0.y); vw.y = pk2(v0.z, v0.w); vw.z = pk2(v1.x, v1.y); vw.w = pk2(v1.z, v1.w); }
        else if (j < 528) { const size_t row = (size_t)(c.row0 + j - 512); kw = *(const v4u*)(F_PROJ + row * NPROJ + PC_K + 64 * h + 8 * dg); vw = *(const v4u*)(F_PROJ + row * NPROJ + PC_V + 64 * h + 8 * dg); }
        else { kw = (v4u){0u, 0u, 0u, 0u}; vw = kw; }
        *(LAS v4u*)(Ks + j * KS_LD + 8 * dg) = kw;
        LAS bf16* vt = Vt + (8 * dg) * PS_LD + j;
        vt[0 * PS_LD] = (bf16)(vw.x & 0xffffu); vt[1 * PS_LD] = (bf16)(vw.x >> 16); vt[2 * PS_LD] = (bf16)(vw.y & 0xffffu); vt[3 * PS_LD] = (bf16)(vw.y >> 16);
        vt[4 * PS_LD] = (bf16)(vw.z & 0xffffu); vt[5 * PS_LD] = (bf16)(vw.z >> 16); vt[6 * PS_LD] = (bf16)(vw.w & 0xffffu); vt[7 * PS_LD] = (bf16)(vw.w >> 16);
    }
    }
    __syncthreads();
    const int qb = wave_ >> 1, kh = wave_ & 1, kq = lane_ >> 4, fr = lane_ & 15;
    const bool active = (c.b < 0) || (qb == 0);
    const int ntw = (576 - jlo) / 32;
    const int kbase = jlo + kh * ntw * 16;
    f32x4 s[18];
    float mloc = -3.0e38f;
    const int iq = qb * 16 + fr;
    if (active) {
#pragma unroll
        for (int t = 0; t < 18; ++t) {
            s[t] = (f32x4){0.f, 0.f, 0.f, 0.f};
            if (t < ntw) {
                const LAS bf16* kp = Ks + (kbase + t * 16 + fr) * KS_LD + 8 * kq;
                const bf16x8 kb0 = *(const LAS bf16x8*)kp, kb1 = *(const LAS bf16x8*)(kp + 32);
                s[t] = __builtin_amdgcn_mfma_f32_16x16x32_bf16(kb0, qa0, s[t], 0, 0, 0);
                s[t] = __builtin_amdgcn_mfma_f32_16x16x32_bf16(kb1, qa1, s[t], 0, 0, 0);
#pragma unroll
                for (int r = 0; r < 4; ++r) { const int j = kbase + t * 16 + 4 * kq + r; int rel = 512 + iq - j; rel = rel > 128 ? 128 : rel; float v = s[t][r] + bias[rel + 128]; if (j >= jval) v = -1.0e30f; s[t][r] = v; mloc = fmaxf(mloc, v); }
            }
        }
        mloc = fmaxf(mloc, shx(lane_, mloc, 16)); mloc = fmaxf(mloc, shx(lane_, mloc, 32));
        if (kq == 0) mx[iq * 2 + kh] = mloc;
    }
    __syncthreads();
    if (active) {
        mloc = fmaxf(mx[iq * 2], mx[iq * 2 + 1]);
        float lsum = 0.f;
#pragma unroll
        for (int t = 0; t < 18; ++t) if (t < ntw) {
            const float p0 = __expf(s[t][0] - mloc), p1 = __expf(s[t][1] - mloc), p2 = __expf(s[t][2] - mloc), p3 = __expf(s[t][3] - mloc);
            lsum += (p0 + p1) + (p2 + p3);
            *(LAS f32x2*)(Ps + iq * PS_LD + kbase + t * 16 + 4 * kq) = __builtin_bit_cast(f32x2, (unsigned long long)pk2(p0, p1) | ((unsigned long long)pk2(p2, p3) << 32));
        }
        lsum += shx(lane_, lsum, 16); lsum += shx(lane_, lsum, 32);
        if (kq == 0) sm[iq * 2 + kh] = lsum;
    }
    __syncthreads();
    if (active) {
        f32x4 o[2] = {(f32x4){0.f, 0.f, 0.f, 0.f}, (f32x4){0.f, 0.f, 0.f, 0.f}};
        const int nks = (576 - jlo) / 32;
#pragma unroll 2
        for (int ks = 0; ks < nks; ++ks) {
            const int j0 = jlo + 32 * ks + 8 * kq;
            const bf16x8 pa = *(const LAS bf16x8*)(Ps + iq * PS_LD + j0);
#pragma unroll
            for (int t = 0; t < 2; ++t) { const bf16x8 vb = *(const LAS bf16x8*)(Vt + (kh * 32 + t * 16 + fr) * PS_LD + j0); o[t] = __builtin_amdgcn_mfma_f32_16x16x32_bf16(vb, pa, o[t], 0, 0, 0); }
        }
        const float inv = rcp_f(sm[iq * 2] + sm[iq * 2 + 1]);
#pragma unroll
        for (int t = 0; t < 2; ++t) *(f32x2*)(F_XN + (size_t)(c.row0 + iq) * D + 64 * h + kh * 32 + t * 16 + 4 * kq) =
            __builtin_bit_cast(f32x2, (unsigned long long)pk2(o[t][0] * inv, o[t][1] * inv) | ((unsigned long long)pk2(o[t][2] * inv, o[t][3] * inv) << 32));
    }
    __syncthreads();
}
__device__ __forceinline__ void scan_phase(Frame& F, int layer) {
    ITEM_IDS();
    lf32* db = (lf32*)F.lds; lf32* dcl = db + NCHP * 4;
    for (int i = tid_; i < NCHP * 4; i += NTHR) db[i] = F_DECB[i];
    __syncthreads();
    constexpr int NSCAN = 48;
    if (((int)blockIdx.x) < NSCAN) {
        const int u = ((int)blockIdx.x) * NTHR + tid_;
        if (u < 16384) {
            unsigned* st = (unsigned*)F_STB + u; const int hb = u >> 12;
            float r0 = 0.f, r1 = 0.f;
            for (int c0 = 0; c0 < NCHP; c0 += 64) {
                unsigned sl[64];
#pragma unroll
                for (int i = 0; i < 64; ++i) sl[i] = st[(size_t)(c0 + i) * 16384];
#pragma unroll
                for (int i = 0; i < 64; ++i) { const float d0 = db[(c0 + i) * 4 + hb]; st[(size_t)(c0 + i) * 16384] = pk2(r0, r1); r0 = d0 * r0 + bf_lo(sl[i]); r1 = d0 * r1 + bf_hi(sl[i]); }
            }
            *(f32x2*)(F.out + O_PSSM + (size_t)layer * 32768 + 2 * u) = (f32x2){r0, r1};
        } else {
            const int u2 = u - 16384;
            unsigned* st = (unsigned*)F_STC + u2; const int hk = (u2 >> 11) * 64 + 2 * (u2 & 31); const float* dg = F_DECC + hk;
            float r0 = 0.f, r1 = 0.f;
            for (int c0 = 0; c0 < NCHP; c0 += 32) {
                unsigned sl[32]; f32x2 dd[32];
#pragma unroll
                for (int i = 0; i < 32; ++i) { sl[i] = st[(size_t)(c0 + i) * 8192]; dd[i] = *(const f32x2*)(dg + (size_t)(c0 + i) * 256); }
#pragma unroll
                for (int i = 0; i < 32; ++i) { st[(size_t)(c0 + i) * 8192] = pk2(r0, r1); r0 = dd[i].x * r0 + bf_lo(sl[i]); r1 = dd[i].y * r1 + bf_hi(sl[i]); }
            }
            const int v = (u2 >> 5) & 63; float* o = F.out + O_PHGRN + (size_t)layer * 16384 + (size_t)hk * 64 + v; o[0] = r0; o[64] = r1;
        }
    }
    else {
        const int nb = ((int)gridDim.x) - NSCAN, b0 = ((int)blockIdx.x) - NSCAN;
        copy_small(F, layer, b0, nb);
        const float* sssm = inp(I_SSSM) + (size_t)layer * NSB * 32768; const float* shgrn = inp(I_SHGRN) + (size_t)layer * NSB * 16384;
        float* osb = F.out + O_SSSM + (size_t)layer * NSB * 32768; float* osc = F.out + O_SHGRN + (size_t)layer * NSB * 16384;
        for (int t = b0 * NTHR + tid_; t < NSB * 8192; t += nb * NTHR) {
            const int b = t >> 13, e = (t & 8191) * 4; const f32x4 s0 = *(const f32x4*)(sssm + (size_t)b * 32768 + e); const unsigned long long w = *(const unsigned long long*)(F_STB + (size_t)(NCHP + b) * 32768 + e);
            const float d = F_DECB[(NCHP + b) * 4 + (e >> 13)];
            *(f32x4*)(osb + (size_t)b * 32768 + e) = (f32x4){d * s0.x + bf_lo((unsigned)w), d * s0.y + bf_hi((unsigned)w), d * s0.z + bf_lo((unsigned)(w >> 32)), d * s0.w + bf_hi((unsigned)(w >> 32))}; }
        for (int t = b0 * NTHR + tid_; t < NSB * 4096; t += nb * NTHR) {
            const int b = t >> 12, e2 = (t & 4095) * 4, hk = e2 >> 6, v = e2 & 63; const f32x4 s0 = *(const f32x4*)(shgrn + (size_t)b * 16384 + e2);
            const bf16* sp = F_STC + (size_t)(NCHP + b) * 16384 + (size_t)((hk >> 6) * 64 + v) * 64 + (hk & 63); const float d = F_DECC[(size_t)(NCHP + b) * 256 + hk];
            *(f32x4*)(osc + (size_t)b * 16384 + e2) = (f32x4){d * s0.x + bf1(sp[0]), d * s0.y + bf1(sp[64]), d * s0.z + bf1(sp[128]), d * s0.w + bf1(sp[192])}; }
    }
}
constexpr int SP_XT = 0, SP_BT = 256 * 72 * 2, SP_ACS = 2 * 256 * 72 * 2, SP_DTV = SP_ACS + 1024, SP_SJ = SP_DTV + 1024, SP_END = SP_SJ + 1024;
static_assert(SP_END <= MISC_OFF, "ssd_prep LDS map");
__device__ __forceinline__ void ssd_prep_item(Frame& F, int layer, int ci) {
    ITEM_IDS();
    const Chunk c = chunk_of(ci);
    LAS bf16* XTl = (LAS bf16*)(F.lds + SP_XT); LAS bf16* BTl = (LAS bf16*)(F.lds + SP_BT);
    lf32* acs = (lf32*)(F.lds + SP_ACS); lf32* dtv = (lf32*)(F.lds + SP_DTV); lf32* sj = (lf32*)(F.lds + SP_SJ);
    const int cg = tid_ % 96, seg = tid_ / 96, col = 8 * cg;
    const bool act = seg < 4 && 16 * seg < c.nrows;
    bf16* prow = F_PROJ + (size_t)c.row0 * NPROJ + PC_X + col;
    v4u raw[19];
    if (act) {
#pragma unroll
        for (int q = 0; q < 19; ++q) { const int r = 16 * seg - 3 + q;
            if (r >= 0) raw[q] = *(const v4u*)(prow + (size_t)r * NPROJ);
            else if (c.b < 0) { if (ci > 0) raw[q] = *(const v4u*)(F_HALO + ((size_t)(ci - 1) * 3 + (3 + r)) * 768 + col); else raw[q] = (v4u){0u, 0u, 0u, 0u}; }
            else { const float* s = inp(I_SCONV) + ((size_t)(layer * NSB + c.b) * 3 + (3 + r)) * 768 + col; const f32x4 a = *(const f32x4*)s, b2 = *(const f32x4*)(s + 4);
                raw[q].x = pk2(a.x, a.y); raw[q].y = pk2(a.z, a.w); raw[q].z = pk2(b2.x, b2.y); raw[q].w = pk2(b2.z, b2.w); } }
    }
    if (wave_ == 6) { const int r = lane_; const float* dtb = inp(I_DTB) + layer * 4; const float* alg = inp(I_ALOG) + layer * 4;
        f32x4 raw4 = {0.f, 0.f, 0.f, 0.f}; if (r < c.nrows) raw4 = *(const f32x4*)(F_DT + (size_t)(c.row0 + r) * 4);
        f32x4 dt4, ac4;
#pragma unroll
        for (int h = 0; h < 4; ++h) { float dt = 0.f; if (r < c.nrows) dt = softplus_f(raw4[h] + dtb[h]); float v = -__expf(alg[h]) * dt;
#pragma unroll
            for (int o = 1; o < 64; o <<= 1) { const float t = shu(lane_, v, o); if (lane_ >= o) v += t; }
            const float last = shi(v, 63);
            dt4[h] = dt; ac4[h] = v; acs[r * 4 + h] = v; dtv[r * 4 + h] = dt; sj[h * 64 + r] = dt * __expf(last - v);
            if (r == 63) F_DECB[ci * 4 + h] = __expf(last); }
        if (r < c.nrows) { *(f32x4*)(F_DTV + (size_t)(c.row0 + r) * 4) = dt4; *(f32x4*)(F_ACS + (size_t)(c.row0 + r) * 4) = ac4; } }
    if (c.nrows < 64) { for (int i = tid_; i < 2 * 256 * 72 / 2; i += NTHR) ((LAS unsigned*)XTl)[i] = 0u; }
    asm volatile("s_waitcnt vmcnt(0)" ::: "memory");
    __syncthreads();
    if (act) {
        if (ci == NCHP - 1 && seg == 3) {
#pragma unroll
            for (int q = 0; q < 3; ++q) { float v[8]; unpack8(raw[16 + q], v); float* o = F.out + O_PCONV + (size_t)layer * 2304 + q * 768 + col;
                *(f32x4*)o = (f32x4){v[0], v[1], v[2], v[3]}; *(f32x4*)(o + 4) = (f32x4){v[4], v[5], v[6], v[7]}; } }
        if (c.b >= 0) {
#pragma unroll
            for (int q = 0; q < 3; ++q) { float v[8]; unpack8(raw[16 + q], v); float* o = F.out + O_SCONV + ((size_t)(layer * NSB + c.b) * 3 + q) * 768 + col;
                *(f32x4*)o = (f32x4){v[0], v[1], v[2], v[3]}; *(f32x4*)(o + 4) = (f32x4){v[4], v[5], v[6], v[7]}; } }
        const float* cw = inp(I_CW) + (size_t)layer * 4 * 768 + col; const float* cb = inp(I_CB) + (size_t)layer * 768 + col;
        LAS bf16* tl = (cg < 32) ? XTl + col * 72 : BTl + (col - 256) * 72;
#pragma unroll
        for (int hc = 0; hc < 2; ++hc) {
            float w0[4], w1[4], w2[4], w3[4], bb[4];
#pragma unroll
            for (int e = 0; e < 4; ++e) { bb[e] = cb[4 * hc + e]; w0[e] = cw[4 * hc + e]; w1[e] = cw[768 + 4 * hc + e]; w2[e] = cw[2 * 768 + 4 * hc + e]; w3[e] = cw[3 * 768 + 4 * hc + e]; }
#pragma unroll
            for (int i = 0; i < 16; i += 2) {
                float x[5][4];
#pragma unroll
                for (int q = 0; q < 5; ++q) { const unsigned ua = hc ? raw[i + q].z : raw[i + q].x, ub = hc ? raw[i + q].w : raw[i + q].y; x[q][0] = bf_lo(ua); x[q][1] = bf_hi(ua); x[q][2] = bf_lo(ub); x[q][3] = bf_hi(ub); }
                float ya[4], yb[4];
#pragma unroll
                for (int e = 0; e < 4; ++e) { ya[e] = silu_g(bb[e] + w0[e] * x[0][e] + w1[e] * x[1][e] + w2[e] * x[2][e] + w3[e] * x[3][e]); yb[e] = silu_g(bb[e] + w0[e] * x[1][e] + w1[e] * x[2][e] + w2[e] * x[3][e] + w3[e] * x[4][e]); }
                const int r = 16 * seg + i;
                *(unsigned long long*)(prow + (size_t)r * NPROJ + 4 * hc) = (unsigned long long)pk2(ya[0], ya[1]) | ((unsigned long long)pk2(ya[2], ya[3]) << 32);
                *(unsigned long long*)(prow + (size_t)(r + 1) * NPROJ + 4 * hc) = (unsigned long long)pk2(yb[0], yb[1]) | ((unsigned long long)pk2(yb[2], yb[3]) << 32);
                if (cg < 64) {
#pragma unroll
                    for (int e = 0; e < 4; ++e) *(LAS unsigned*)(tl + (4 * hc + e) * 72 + r) = pk2(ya[e], yb[e]); }
            }
        }
    }
    __syncthreads();
    { const int ch = tid_ >> 1, hf = tid_ & 1; bf16* dst = F_XT + ((size_t)ci * 256 + ch) * 64 + 32 * hf; const LAS bf16* src = XTl + ch * 72 + 32 * hf;
#pragma unroll
      for (int q = 0; q < 4; ++q) *(v4u*)(dst + 8 * q) = *(const LAS v4u*)(src + 8 * q); }
    const int kq = lane_ >> 4, fr = lane_ & 15, h = wave_ >> 1, g = h >> 1;
#pragma unroll
    for (int pi = 0; pi < 2; ++pi) {
        const int pb = 2 * (wave_ & 1) + pi;
        bf16x8 af[2];
#pragma unroll
        for (int ks = 0; ks < 2; ++ks) { float v[8]; unpack8(*(const LAS v4u*)(XTl + (h * 64 + pb * 16 + fr) * 72 + 32 * ks + 8 * kq), v);
#pragma unroll
            for (int e = 0; e < 8; ++e) v[e] *= sj[h * 64 + 32 * ks + 8 * kq + e];
            af[ks] = __builtin_bit_cast(bf16x8, pack8(v)); }
        bf16* dst = F_STB + ((size_t)(ci * 4 + h) * 64 + pb * 16 + 4 * kq) * 128 + fr;
#pragma unroll
        for (int nt = 0; nt < 8; ++nt) {
            f32x4 acc = {0.f, 0.f, 0.f, 0.f};
#pragma unroll
            for (int ks = 0; ks < 2; ++ks) { const bf16x8 bfr = *(const LAS bf16x8*)(BTl + (g * 128 + nt * 16 + fr) * 72 + 32 * ks + 8 * kq); acc = __builtin_amdgcn_mfma_f32_16x16x32_bf16(af[ks], bfr, acc, 0, 0, 0); }
#pragma unroll
            for (int r = 0; r < 4; ++r) dst[r * 128 + nt * 16] = (bf16)f2bf(acc[r]);
        }
    }
    __syncthreads();
}

__device__ __forceinline__ void ssd_out_witem(Frame& F, int layer, int ci, int ib, int wave_, int lane_) {
    const Chunk c = chunk_of(ci);
    const int kq = lane_ >> 4, fr = lane_ & 15;
    constexpr int WSTRIDE = 2560 + 16384; static_assert(8 * WSTRIDE <= MISC_OFF, "per-wave LDS");
    LAS bf16* scr = (LAS bf16*)(F.lds + wave_ * WSTRIDE);
    lf32* ysc = (lf32*)(F.lds + wave_ * WSTRIDE + 2560) + lane_;
    const bf16* P = F_PROJ + (size_t)c.row0 * NPROJ;
    const float* acsg = F_ACS + (size_t)c.row0 * 4; const float* dtg = F_DTV + (size_t)c.row0 * 4;
    const int nks = (ib + 2) >> 1;
    float sq[4] = {0.f, 0.f, 0.f, 0.f};
    const float* bdp = inp(I_BD) + layer * 4;
#pragma unroll
    for (int g = 0; g < 2; ++g) {
        bf16x8 cf[4];
#pragma unroll
        for (int ks = 0; ks < 4; ++ks) cf[ks] = *(const bf16x8*)(P + (size_t)(16 * ib + fr) * NPROJ + PC_C + 128 * g + 32 * ks + 8 * kq);
        f32x4 G[4];
#pragma unroll
        for (int jb = 0; jb < 4; ++jb) { G[jb] = (f32x4){0.f, 0.f, 0.f, 0.f};
            if (jb <= ib) {
#pragma unroll
                for (int ks = 0; ks < 4; ++ks) { const bf16x8 bfr = *(const bf16x8*)(P + (size_t)(16 * jb + fr) * NPROJ + PC_B + 128 * g + 32 * ks + 8 * kq); G[jb] = __builtin_amdgcn_mfma_f32_16x16x32_bf16(cf[ks], bfr, G[jb], 0, 0, 0); } } }
#pragma unroll
        for (int hh = 0; hh < 2; ++hh) {
            const int h = 2 * g + hh;
            float ai[4], ea[4];
#pragma unroll
            for (int r = 0; r < 4; ++r) { ai[r] = acsg[(16 * ib + 4 * kq + r) * 4 + h]; ea[r] = __expf(ai[r]); }
#pragma unroll
            for (int jb = 0; jb < 4; ++jb) { const int j = 16 * jb + fr; float aj = 0.f, dj = 0.f; if (jb <= ib) { aj = acsg[j * 4 + h]; dj = dtg[j * 4 + h]; }
#pragma unroll
                for (int r = 0; r < 4; ++r) { const int i = 16 * ib + 4 * kq + r; const float v = (jb <= ib && j <= i) ? G[jb][r] * __expf(ai[r] - aj) * dj : 0.f; scr[(4 * kq + r) * 72 + j] = (bf16)f2bf(v); } }
            asm volatile("s_waitcnt lgkmcnt(0)" ::: "memory");
            bf16x8 gm[2];
#pragma unroll
            for (int ks = 0; ks < 2; ++ks) gm[ks] = *(const LAS bf16x8*)(scr + fr * 72 + 32 * ks + 8 * kq);
            asm volatile("s_waitcnt lgkmcnt(0)" ::: "memory");
            const bf16* xt = F_XT + ((size_t)ci * 256 + h * 64) * 64;
            const bf16* sin_b = F_STB + (size_t)(ci * 4 + h) * 8192; const float* sin_f = inp(I_SSSM) + (size_t)((layer * NSB + (c.b < 0 ? 0 : c.b)) * 4 + h) * 8192;
#pragma unroll 2
            for (int pt = 0; pt < 4; ++pt) {
                f32x4 a1 = {0.f, 0.f, 0.f, 0.f}, a2 = {0.f, 0.f, 0.f, 0.f};
#pragma unroll
                for (int ks = 0; ks < 2; ++ks) if (ks < nks) { const bf16x8 bfr = *(const bf16x8*)(xt + (size_t)(pt * 16 + fr) * 64 + 32 * ks + 8 * kq); a1 = __builtin_amdgcn_mfma_f32_16x16x32_bf16(gm[ks], bfr, a1, 0, 0, 0); }
#pragma unroll
                for (int ks = 0; ks < 4; ++ks) { bf16x8 bfr;
                    if (c.b < 0) bfr = *(const bf16x8*)(sin_b + (size_t)(pt * 16 + fr) * 128 + 32 * ks + 8 * kq);
                    else { const float* s = sin_f + (size_t)(pt * 16 + fr) * 128 + 32 * ks + 8 * kq; const f32x4 u0 = *(const f32x4*)s, u1 = *(const f32x4*)(s + 4); v4u w; w.x = pk2(u0.x, u0.y); w.y = pk2(u0.z, u0.w); w.z = pk2(u1.x, u1.y); w.w = pk2(u1.z, u1.w); bfr = __builtin_bit_cast(bf16x8, w); }
                    a2 = __builtin_amdgcn_mfma_f32_16x16x32_bf16(cf[ks], bfr, a2, 0, 0, 0); }
                const float dh = bdp[h];
#pragma unroll
                for (int r = 0; r < 4; ++r) { const size_t ro = (size_t)(16 * ib + 4 * kq + r) * NPROJ; const int p = h * 64 + pt * 16 + fr;
                    float y = a1[r] + ea[r] * a2[r] + dh * bf1(P[ro + PC_X + p]);
                    y *= silu_g(bf1(P[ro + PC_Z + p])); ysc[((h * 4 + pt) * 4 + r) * 64] = y; sq[r] += y * y; }
            }
        }
    }
    const float* nw = inp(I_BNRM) + (size_t)layer * 256;
#pragma unroll
    for (int r = 0; r < 4; ++r) { const float rstd = rsq_f(sum16_l(lane_, sq[r]) * (1.0f / 256.0f) + EPS); bf16* o = F_XN + (size_t)(c.row0 + 16 * ib + 4 * kq + r) * D + 256 + fr;
#pragma unroll 4
        for (int q = 0; q < 16; ++q) o[q * 16] = (bf16)f2bf(ysc[(q * 4 + r) * 64] * rstd * nw[q * 16 + fr]); }
}

constexpr int SO_SIN = 0, SO_XT = 4 * 64 * 136 * 2, SO_ACS = SO_XT + 256 * 72 * 2, SO_DTV = SO_ACS + 1024, SO_SS = SO_DTV + 1024, SO_SCR = SO_SS + 512, SO_END = SO_SCR + 8 * 2560;
static_assert(SO_END <= MISC_OFF, "ssd_out_block LDS map");
__device__ __forceinline__ void ssd_out_block(Frame& F, int layer, int ci) {
    ITEM_IDS();
    const int row0 = 64 * ci;
    LAS bf16* SIN = (LAS bf16*)(F.lds + SO_SIN); LAS bf16* XTl = (LAS bf16*)(F.lds + SO_XT);
    lf32* acs = (lf32*)(F.lds + SO_ACS); lf32* dtv = (lf32*)(F.lds + SO_DTV); lf32* ss = (lf32*)(F.lds + SO_SS);
    LAS bf16* scr = (LAS bf16*)(F.lds + SO_SCR + wave_ * 2560);
    const int kq = lane_ >> 4, fr = lane_ & 15, ib = wave_ >> 1, g = wave_ & 1;
    const bf16* P = F_PROJ + (size_t)row0 * NPROJ;
    v4u st[12];
    { const bf16* sg = F_STB + (size_t)ci * 32768; const bf16* xg = F_XT + (size_t)ci * 16384;
#pragma unroll
      for (int q = 0; q < 8; ++q) st[q] = *(const v4u*)(sg + (size_t)(tid_ + q * NTHR) * 8);
#pragma unroll
      for (int q = 0; q < 4; ++q) st[8 + q] = *(const v4u*)(xg + (size_t)(tid_ + q * NTHR) * 8); }
    float a4 = 0.f, d4 = 0.f; if (tid_ < 256) { a4 = F_ACS[(size_t)row0 * 4 + tid_]; d4 = F_DTV[(size_t)row0 * 4 + tid_]; }
    bf16x8 cf[4], bfr[4][4];
#pragma unroll
    for (int ks = 0; ks < 4; ++ks) cf[ks] = *(const bf16x8*)(P + (size_t)(16 * ib + fr) * NPROJ + PC_C + 128 * g + 32 * ks + 8 * kq);
#pragma unroll
    for (int jb = 0; jb < 4; ++jb)
#pragma unroll
        for (int ks = 0; ks < 4; ++ks) { bfr[jb][ks] = (bf16x8){0, 0, 0, 0, 0, 0, 0, 0}; if (jb <= ib) bfr[jb][ks] = *(const bf16x8*)(P + (size_t)(16 * jb + fr) * NPROJ + PC_B + 128 * g + 32 * ks + 8 * kq); }
#pragma unroll
    for (int q = 0; q < 8; ++q) { const int it = tid_ + q * NTHR; *(LAS v4u*)(SIN + (it >> 4) * 136 + 8 * (it & 15)) = st[q]; }
#pragma unroll
    for (int q = 0; q < 4; ++q) { const int it = tid_ + q * NTHR; *(LAS v4u*)(XTl + (it >> 3) * 72 + 8 * (it & 7)) = st[8 + q]; }
    if (tid_ < 256) { acs[tid_] = a4; dtv[tid_] = d4; }
    bf16 zv[2][4][4];
#pragma unroll
    for (int hh = 0; hh < 2; ++hh)
#pragma unroll
        for (int pt = 0; pt < 4; ++pt)
#pragma unroll
            for (int r = 0; r < 4; ++r) zv[hh][pt][r] = P[(size_t)(16 * ib + 4 * kq + r) * NPROJ + PC_Z + (2 * g + hh) * 64 + pt * 16 + fr];
    __syncthreads();
    f32x4 G[4];
#pragma unroll
    for (int jb = 0; jb < 4; ++jb) { G[jb] = (f32x4){0.f, 0.f, 0.f, 0.f};
        if (jb <= ib) {
#pragma unroll
            for (int ks = 0; ks < 4; ++ks) G[jb] = __builtin_amdgcn_mfma_f32_16x16x32_bf16(cf[ks], bfr[jb][ks], G[jb], 0, 0, 0); } }
    const int nks = (ib + 2) >> 1;
    const float* bdp = inp(I_BD) + layer * 4;
    f32x4 yv[2][4]; float sq[4] = {0.f, 0.f, 0.f, 0.f};
#pragma unroll
    for (int hh = 0; hh < 2; ++hh) {
        const int h = 2 * g + hh;
        float ai[4], ea[4];
#pragma unroll
        for (int r = 0; r < 4; ++r) { ai[r] = acs[(16 * ib + 4 * kq + r) * 4 + h]; ea[r] = __expf(ai[r]); }
#pragma unroll
        for (int jb = 0; jb < 4; ++jb) { const int j = 16 * jb + fr; const float aj = acs[j * 4 + h], dj = dtv[j * 4 + h];
#pragma unroll
            for (int r = 0; r < 4; ++r) { const int i = 16 * ib + 4 * kq + r; const float v = (jb <= ib && j <= i) ? G[jb][r] * __expf(ai[r] - aj) * dj : 0.f; scr[(4 * kq + r) * 72 + j] = (bf16)f2bf(v); } }
        asm volatile("s_waitcnt lgkmcnt(0)" ::: "memory");
        bf16x8 gm[2];
#pragma unroll
        for (int ks = 0; ks < 2; ++ks) gm[ks] = *(const LAS bf16x8*)(scr + fr * 72 + 32 * ks + 8 * kq);
        asm volatile("s_waitcnt lgkmcnt(0)" ::: "memory");
        const float dh = bdp[h];
#pragma unroll
        for (int pt = 0; pt < 4; ++pt) {
            f32x4 a1 = {0.f, 0.f, 0.f, 0.f}, a2 = {0.f, 0.f, 0.f, 0.f};
            const LAS bf16* xr = XTl + (h * 64 + pt * 16 + fr) * 72; const LAS bf16* sr = SIN + (h * 64 + pt * 16 + fr) * 136;
#pragma unroll
            for (int ks = 0; ks < 2; ++ks) if (ks < nks) a1 = __builtin_amdgcn_mfma_f32_16x16x32_bf16(gm[ks], *(const LAS bf16x8*)(xr + 32 * ks + 8 * kq), a1, 0, 0, 0);
#pragma unroll
            for (int ks = 0; ks < 4; ++ks) a2 = __builtin_amdgcn_mfma_f32_16x16x32_bf16(cf[ks], *(const LAS bf16x8*)(sr + 32 * ks + 8 * kq), a2, 0, 0, 0);
            const unsigned long long xw = *(const LAS unsigned long long*)(xr + 16 * ib + 4 * kq);
            const float xx[4] = {bf_lo((unsigned)xw), bf_hi((unsigned)xw), bf_lo((unsigned)(xw >> 32)), bf_hi((unsigned)(xw >> 32))};
#pragma unroll
            for (int r = 0; r < 4; ++r) { float y = a1[r] + ea[r] * a2[r] + dh * xx[r]; y *= silu_g(bf1(zv[hh][pt][r])); yv[hh][pt][r] = y; sq[r] += y * y; }
        }
    }
#pragma unroll
    for (int r = 0; r < 4; ++r) { const float q = sum16_l(lane_, sq[r]); if (fr == 0) ss[(16 * ib + 4 * kq + r) * 2 + g] = q; }
    __syncthreads();
    const float* nw = inp(I_BNRM) + (size_t)layer * 256 + 128 * g;
#pragma unroll
    for (int r = 0; r < 4; ++r) { const int i = 16 * ib + 4 * kq + r; const float rstd = rsq_f((ss[i * 2] + ss[i * 2 + 1]) * (1.0f / 256.0f) + EPS); bf16* o = F_XN + (size_t)(row0 + i) * D + 256 + 128 * g + fr;
#pragma unroll
        for (int hh = 0; hh < 2; ++hh)
#pragma unroll
            for (int pt = 0; pt < 4; ++pt) o[hh * 64 + pt * 16] = (bf16)f2bf(yv[hh][pt][r] * rstd * nw[hh * 64 + pt * 16 + fr]); }
    __syncthreads();
}
constexpr int HP_KT = 0, HP_VT = 256 * 72 * 2, HP_HT = 2 * 256 * 72 * 2, HP_END = HP_HT + 4 * 256 * 4;
static_assert(HP_END <= MISC_OFF, "hgrn_prep LDS map");
__device__ __forceinline__ void hgrn_prep_item(Frame& F, int layer, int ci) {
    ITEM_IDS();
    const Chunk c = chunk_of(ci);
    LAS bf16* KTl = (LAS bf16*)(F.lds + HP_KT); LAS bf16* VTl = (LAS bf16*)(F.lds + HP_VT);
    lf32* ht = (lf32*)(F.lds + HP_HT);
    const int cp = tid_ & 127, qt = tid_ >> 7;
    float lb0 = 0.f, lb1 = 0.f; if (layer != 0) { const float* lbp = inp(I_LB) + 2 * cp; lb0 = rcp_f(1.0f + __expf(lbp[0] - lbp[256])); lb1 = rcp_f(1.0f + __expf(lbp[1] - lbp[257])); }
    bf16* pq = F_PROJ + (size_t)(c.row0 + 16 * qt) * NPROJ + PC_CQ + 2 * cp;
    const bool act = 16 * qt < c.nrows;
    unsigned rq[16], rf[16], rv[16];
#pragma unroll
    for (int i = 0; i < 16; ++i) { rq[i] = 0u; rf[i] = 0u; rv[i] = 0u; if (act) { const unsigned* p = (const unsigned*)(pq + (size_t)i * NPROJ); rq[i] = p[0]; rf[i] = p[128]; rv[i] = p[256]; } }
    float b0[16], b1[16], k0[16], k1[16];
    float run0 = 0.f, run1 = 0.f;
#pragma unroll
    for (int i = 0; i < 16; ++i) { float g0 = 0.f, g1 = 0.f; k0[i] = 0.f; k1[i] = 0.f;
        if (act) { const float e0 = __expf(-bf_lo(rf[i])), e1 = __expf(-bf_hi(rf[i])); const float d0 = rcp_f(1.0f + e0), d1 = rcp_f(1.0f + e1);
            g0 = __logf(lb0 + (1.0f - lb0) * d0); g1 = __logf(lb1 + (1.0f - lb1) * d1); k0[i] = (1.0f - lb0) * e0 * d0; k1[i] = (1.0f - lb1) * e1 * d1; }
        run0 += g0; run1 += g1; b0[i] = run0; b1[i] = run1; }
    *(LAS f32x2*)(ht + qt * 256 + 2 * cp) = (f32x2){run0, run1};
    __syncthreads();
    float pre0 = 0.f, pre1 = 0.f, last0 = 0.f, last1 = 0.f;
#pragma unroll
    for (int q = 0; q < 4; ++q) { const f32x2 t = *(const LAS f32x2*)(ht + q * 256 + 2 * cp); if (q < qt) { pre0 += t.x; pre1 += t.y; } last0 += t.x; last1 += t.y; }
    { float* Rg = F_RH + (size_t)ci * 1280 + 2 * cp; *(f32x2*)(Rg + qt * 256) = (f32x2){pre0, pre1};
      if (qt == 3) { *(f32x2*)(Rg + 1024) = (f32x2){last0, last1}; *(f32x2*)(F_DECC + (size_t)ci * 256 + 2 * cp) = (f32x2){__expf(last0), __expf(last1)}; } }
    const float e0 = run0, e1 = run1;
#pragma unroll
    for (int i = 0; i < 16; i += 2) {
        unsigned kt0, kt1;
#pragma unroll
        for (int q = 0; q < 2; ++q) { const int ii = i + q;
            const float qe0 = bf_lo(rq[ii]) * __expf(b0[ii]), qe1 = bf_hi(rq[ii]) * __expf(b1[ii]);
            const float ke0 = k0[ii] * __expf(e0 - b0[ii]), ke1 = k1[ii] * __expf(e1 - b1[ii]);
            const float kd0 = k0[ii] * __expf(fminf(-b0[ii], 80.f)), kd1 = k1[ii] * __expf(fminf(-b1[ii], 80.f));
            if (act && 16 * qt + ii < c.nrows) { unsigned* p = (unsigned*)(pq + (size_t)ii * NPROJ); p[0] = pk2(qe0, qe1); p[128] = pk2(ke0, ke1); p[256] = pk2(kd0, kd1); }
            const float t0 = k0[ii] * __expf(last0 - pre0 - b0[ii]), t1 = k1[ii] * __expf(last1 - pre1 - b1[ii]);
            if (q == 0) { kt0 = f2bf(t0); kt1 = f2bf(t1); } else { kt0 |= f2bf(t0) << 16; kt1 |= f2bf(t1) << 16; } }
        const int j = 16 * qt + i;
        *(LAS unsigned*)(KTl + (2 * cp) * 72 + j) = kt0; *(LAS unsigned*)(KTl + (2 * cp + 1) * 72 + j) = kt1;
        *(LAS unsigned*)(VTl + (2 * cp) * 72 + j) = (rv[i] & 0xffffu) | (rv[i + 1] << 16); *(LAS unsigned*)(VTl + (2 * cp + 1) * 72 + j) = (rv[i] >> 16) | (rv[i + 1] & 0xffff0000u);
    }
    __syncthreads();
    { const int c2 = tid_ >> 1, hf = tid_ & 1; bf16* dst = F_VT + ((size_t)ci * 256 + c2) * 64 + 32 * hf; const LAS bf16* src = VTl + c2 * 72 + 32 * hf;
#pragma unroll
      for (int q = 0; q < 4; ++q) *(v4u*)(dst + 8 * q) = *(const LAS v4u*)(src + 8 * q); }
    const int kq = lane_ >> 4, fr = lane_ & 15, h = wave_ >> 1;
#pragma unroll
    for (int vi = 0; vi < 2; ++vi) {
        const int vb = 2 * (wave_ & 1) + vi;
        bf16x8 af[2];
#pragma unroll
        for (int ks = 0; ks < 2; ++ks) af[ks] = *(const LAS bf16x8*)(VTl + (h * 64 + vb * 16 + fr) * 72 + 32 * ks + 8 * kq);
        bf16* dst = F_STC + ((size_t)(ci * 4 + h) * 64 + vb * 16 + 4 * kq) * 64 + fr;
#pragma unroll
        for (int kb = 0; kb < 4; ++kb) {
            f32x4 acc = {0.f, 0.f, 0.f, 0.f};
#pragma unroll
            for (int ks = 0; ks < 2; ++ks) { const bf16x8 bfr = *(const LAS bf16x8*)(KTl + (h * 64 + kb * 16 + fr) * 72 + 32 * ks + 8 * kq); acc = __builtin_amdgcn_mfma_f32_16x16x32_bf16(af[ks], bfr, acc, 0, 0, 0); }
#pragma unroll
            for (int r = 0; r < 4; ++r) dst[r * 64 + kb * 16] = (bf16)f2bf(acc[r]);
        }
    }
    __syncthreads();
}

__device__ __forceinline__ void hgrn_out_witem(Frame& F, int layer, int ci, int h, int ib, int wave_, int lane_) {
    const Chunk c = chunk_of(ci);
    const int kq = lane_ >> 4, fr = lane_ & 15;
    LAS bf16* scr = (LAS bf16*)(F.lds + wave_ * (2560 + 16384));
    const bf16* P = F_PROJ + (size_t)c.row0 * NPROJ + h * 64;
    const float* Rg = F_RH + (size_t)ci * 1280 + h * 64;
    bf16x8 qf[2]; float qv[2][8], rI[2][8];
#pragma unroll
    for (int ks = 0; ks < 2; ++ks) { qf[ks] = *(const bf16x8*)(P + (size_t)(16 * ib + fr) * NPROJ + PC_CQ + 32 * ks + 8 * kq); unpack8(__builtin_bit_cast(v4u, qf[ks]), qv[ks]);
        const float* rp = Rg + ib * 256 + 32 * ks + 8 * kq; const f32x4 a = *(const f32x4*)rp, b2 = *(const f32x4*)(rp + 4);
        rI[ks][0] = a.x; rI[ks][1] = a.y; rI[ks][2] = a.z; rI[ks][3] = a.w; rI[ks][4] = b2.x; rI[ks][5] = b2.y; rI[ks][6] = b2.z; rI[ks][7] = b2.w; }
#pragma unroll
    for (int J = 0; J < 4; ++J) {
        f32x4 acc = {0.f, 0.f, 0.f, 0.f};
        if (J <= ib) {
#pragma unroll
            for (int ks = 0; ks < 2; ++ks) {
                bf16x8 a = qf[ks];
                if (J < ib) { const float* rp = Rg + (J + 1) * 256 + 32 * ks + 8 * kq; const f32x4 u0 = *(const f32x4*)rp, u1 = *(const f32x4*)(rp + 4); const float rj[8] = {u0.x, u0.y, u0.z, u0.w, u1.x, u1.y, u1.z, u1.w};
                    float v[8];
#pragma unroll
                    for (int e = 0; e < 8; ++e) v[e] = qv[ks][e] * __expf(rI[ks][e] - rj[e]);
                    a = __builtin_bit_cast(bf16x8, pack8(v)); }
                const bf16x8 bfr = *(const bf16x8*)(P + (size_t)(16 * J + fr) * NPROJ + (J < ib ? PC_CF : PC_CI) + 32 * ks + 8 * kq);
                acc = __builtin_amdgcn_mfma_f32_16x16x32_bf16(a, bfr, acc, 0, 0, 0);
            }
        }
#pragma unroll
        for (int r = 0; r < 4; ++r) { const int i = 4 * kq + r, j = fr; const float v = (J < ib || (J == ib && j <= i)) ? acc[r] : 0.f; scr[(4 * kq + r) * 72 + 16 * J + fr] = (bf16)f2bf(v); }
    }
    asm volatile("s_waitcnt lgkmcnt(0)" ::: "memory");
    bf16x8 ga[2];
#pragma unroll
    for (int ks = 0; ks < 2; ++ks) ga[ks] = *(const LAS bf16x8*)(scr + fr * 72 + 32 * ks + 8 * kq);
    asm volatile("s_waitcnt lgkmcnt(0)" ::: "memory");
    bf16x8 qs[2];
#pragma unroll
    for (int ks = 0; ks < 2; ++ks) { float v[8];
#pragma unroll
        for (int e = 0; e < 8; ++e) v[e] = qv[ks][e] * __expf(rI[ks][e]);
        qs[ks] = __builtin_bit_cast(bf16x8, pack8(v)); }
    const int nks = (ib + 2) >> 1;
    const bf16* vt = F_VT + ((size_t)ci * 256 + h * 64) * 64;
    const bf16* sin_b = F_STC + (size_t)(ci * 4 + h) * 4096; const float* sin_f = inp(I_SHGRN) + (size_t)((layer * NSB + (c.b < 0 ? 0 : c.b)) * 4 + h) * 4096;
    f32x4 o[4]; float sq[4] = {0.f, 0.f, 0.f, 0.f};
#pragma unroll
    for (int t = 0; t < 4; ++t) {
        o[t] = (f32x4){0.f, 0.f, 0.f, 0.f};
#pragma unroll
        for (int ks = 0; ks < 2; ++ks) if (ks < nks) { const bf16x8 bfr = *(const bf16x8*)(vt + (size_t)(t * 16 + fr) * 64 + 32 * ks + 8 * kq); o[t] = __builtin_amdgcn_mfma_f32_16x16x32_bf16(ga[ks], bfr, o[t], 0, 0, 0); }
#pragma unroll
        for (int ks = 0; ks < 2; ++ks) { bf16x8 bfr;
            if (c.b < 0) bfr = *(const bf16x8*)(sin_b + (size_t)(t * 16 + fr) * 64 + 32 * ks + 8 * kq);
            else { float v[8];
#pragma unroll
                for (int e = 0; e < 8; ++e) v[e] = sin_f[(size_t)(32 * ks + 8 * kq + e) * 64 + t * 16 + fr];
                bfr = __builtin_bit_cast(bf16x8, pack8(v)); }
            o[t] = __builtin_amdgcn_mfma_f32_16x16x32_bf16(qs[ks], bfr, o[t], 0, 0, 0); }
#pragma unroll
        for (int r = 0; r < 4; ++r) sq[r] += o[t][r] * o[t][r];
    }
    const float* nw = inp(I_CNRM) + (size_t)layer * 256 + h * 64;
#pragma unroll
    for (int r = 0; r < 4; ++r) { const float rstd = rsq_f(sum16_l(lane_, sq[r]) * (1.0f / 64.0f) + EPS); const size_t row = (size_t)(16 * ib + 4 * kq + r);
#pragma unroll
        for (int t = 0; t < 4; ++t) { const int v = t * 16 + fr; const float cg = bf1(P[row * NPROJ + PC_CG + v]);
            F_XN[(size_t)(c.row0 + row) * D + 512 + h * 64 + v] = (bf16)f2bf(o[t][r] * rstd * nw[v] * silu_g(cg)); } }
}

constexpr int HO_KE = 0, HO_VT = 64 * 264 * 2, HO_SIN = HO_VT + 256 * 72 * 2, HO_R = HO_SIN + 256 * 72 * 2, HO_SCR = HO_R + 1280 * 4, HO_END = HO_SCR + 8 * 2304;
static_assert(HO_END <= MISC_OFF, "hgrn_out_block LDS map");
__device__ __forceinline__ void hgrn_out_block(Frame& F, int layer, int ci) {
    ITEM_IDS();
    const int row0 = 64 * ci;
    LAS bf16* KEl = (LAS bf16*)(F.lds + HO_KE); LAS bf16* VTl = (LAS bf16*)(F.lds + HO_VT); LAS bf16* SIN = (LAS bf16*)(F.lds + HO_SIN); lf32* Rl = (lf32*)(F.lds + HO_R);
    LAS bf16* scr = (LAS bf16*)(F.lds + HO_SCR + wave_ * 2304);
    const int kq = lane_ >> 4, fr = lane_ & 15, h = wave_ >> 1, ib0 = 2 * (wave_ & 1);
    const bf16* P = F_PROJ + (size_t)row0 * NPROJ;
    v4u st[13];
    { const bf16* kg = P + PC_CF; const bf16* vg = F_VT + (size_t)ci * 16384; const bf16* sg = F_STC + (size_t)ci * 16384; const float* rg = F_RH + (size_t)ci * 1280;
#pragma unroll
      for (int q = 0; q < 4; ++q) { const int it = tid_ + q * NTHR; st[q] = *(const v4u*)(kg + (size_t)(it >> 5) * NPROJ + 8 * (it & 31)); }
#pragma unroll
      for (int q = 0; q < 4; ++q) st[4 + q] = *(const v4u*)(vg + (size_t)(tid_ + q * NTHR) * 8);
#pragma unroll
      for (int q = 0; q < 4; ++q) st[8 + q] = *(const v4u*)(sg + (size_t)(tid_ + q * NTHR) * 8);
      st[12] = (v4u){0u, 0u, 0u, 0u}; if (tid_ < 320) st[12] = *(const v4u*)(rg + 4 * tid_); }
    bf16x8 qf[2][2], kd[2][2];
#pragma unroll
    for (int bi = 0; bi < 2; ++bi)
#pragma unroll
        for (int ks = 0; ks < 2; ++ks) { const bf16* p = P + (size_t)(16 * (ib0 + bi) + fr) * NPROJ + h * 64 + 32 * ks + 8 * kq; qf[bi][ks] = *(const bf16x8*)(p + PC_CQ); kd[bi][ks] = *(const bf16x8*)(p + PC_CI); }
#pragma unroll
    for (int q = 0; q < 4; ++q) { const int it = tid_ + q * NTHR; *(LAS v4u*)(KEl + (it >> 5) * 264 + 8 * (it & 31)) = st[q]; }
#pragma unroll
    for (int q = 0; q < 4; ++q) { const int it = tid_ + q * NTHR; *(LAS v4u*)(VTl + (it >> 3) * 72 + 8 * (it & 7)) = st[4 + q]; *(LAS v4u*)(SIN + (it >> 3) * 72 + 8 * (it & 7)) = st[8 + q]; }
    if (tid_ < 320) *(LAS v4u*)(Rl + 4 * tid_) = st[12];
    bf16 cgv[2][4][4];
#pragma unroll
    for (int bi = 0; bi < 2; ++bi)
#pragma unroll
        for (int t = 0; t < 4; ++t)
#pragma unroll
            for (int r = 0; r < 4; ++r) cgv[bi][t][r] = P[(size_t)(16 * (ib0 + bi) + 4 * kq + r) * NPROJ + PC_CG + h * 64 + t * 16 + fr];
    __syncthreads();
    const float* nw = inp(I_CNRM) + (size_t)layer * 256 + h * 64;
#pragma unroll
    for (int bi = 0; bi < 2; ++bi) {
        const int ib = ib0 + bi;
        float qv[2][8], rI[2][8];
#pragma unroll
        for (int ks = 0; ks < 2; ++ks) { unpack8(__builtin_bit_cast(v4u, qf[bi][ks]), qv[ks]); const lf32* rp = Rl + ib * 256 + h * 64 + 32 * ks + 8 * kq;
#pragma unroll
            for (int e = 0; e < 8; ++e) rI[ks][e] = rp[e]; }
#pragma unroll
        for (int J = 0; J < 4; ++J) {
            f32x4 acc = {0.f, 0.f, 0.f, 0.f};
            if (J <= ib) {
#pragma unroll
                for (int ks = 0; ks < 2; ++ks) {
                    bf16x8 a = qf[bi][ks], bfr = kd[bi][ks];
                    if (J < ib) { const lf32* rp = Rl + (J + 1) * 256 + h * 64 + 32 * ks + 8 * kq; float v[8];
#pragma unroll
                        for (int e = 0; e < 8; ++e) v[e] = qv[ks][e] * __expf(rI[ks][e] - rp[e]);
                        a = __builtin_bit_cast(bf16x8, pack8(v)); bfr = *(const LAS bf16x8*)(KEl + (16 * J + fr) * 264 + h * 64 + 32 * ks + 8 * kq); }
                    acc = __builtin_amdgcn_mfma_f32_16x16x32_bf16(a, bfr, acc, 0, 0, 0);
                }
            }
#pragma unroll
            for (int r = 0; r < 4; ++r) { const int i = 4 * kq + r, j = fr; const float v = (J < ib || (J == ib && j <= i)) ? acc[r] : 0.f; scr[(4 * kq + r) * 72 + 16 * J + fr] = (bf16)f2bf(v); }
        }
        asm volatile("s_waitcnt lgkmcnt(0)" ::: "memory");
        bf16x8 ga[2];
#pragma unroll
        for (int ks = 0; ks < 2; ++ks) ga[ks] = *(const LAS bf16x8*)(scr + fr * 72 + 32 * ks + 8 * kq);
        asm volatile("s_waitcnt lgkmcnt(0)" ::: "memory");
        bf16x8 qs[2];
#pragma unroll
        for (int ks = 0; ks < 2; ++ks) { float v[8];
#pragma unroll
            for (int e = 0; e < 8; ++e) v[e] = qv[ks][e] * __expf(rI[ks][e]);
            qs[ks] = __builtin_bit_cast(bf16x8, pack8(v)); }
        const int nks = (ib + 2) >> 1;
        f32x4 o[4]; float sq[4] = {0.f, 0.f, 0.f, 0.f};
#pragma unroll
        for (int t = 0; t < 4; ++t) {
            o[t] = (f32x4){0.f, 0.f, 0.f, 0.f};
#pragma unroll
            for (int ks = 0; ks < 2; ++ks) if (ks < nks) o[t] = __builtin_amdgcn_mfma_f32_16x16x32_bf16(ga[ks], *(const LAS bf16x8*)(VTl + (h * 64 + t * 16 + fr) * 72 + 32 * ks + 8 * kq), o[t], 0, 0, 0);
#pragma unroll
            for (int ks = 0; ks < 2; ++ks) o[t] = __builtin_amdgcn_mfma_f32_16x16x32_bf16(qs[ks], *(const LAS bf16x8*)(SIN + (h * 64 + t * 16 + fr) * 72 + 32 * ks + 8 * kq), o[t], 0, 0, 0);
#pragma unroll
            for (int r = 0; r < 4; ++r) sq[r] += o[t][r] * o[t][r];
        }
#pragma unroll
        for (int r = 0; r < 4; ++r) { const float rstd = rsq_f(sum16_l(lane_, sq[r]) * (1.0f / 64.0f) + EPS); bf16* op = F_XN + (size_t)(row0 + 16 * ib + 4 * kq + r) * D + 512 + h * 64 + fr;
#pragma unroll
            for (int t = 0; t < 4; ++t) op[t * 16] = (bf16)f2bf(o[t][r] * rstd * nw[t * 16 + fr] * silu_g(bf1(cgv[bi][t][r]))); }
    }
    __syncthreads();
}
template <int MODE>
__device__ __forceinline__ void mini_gemm(Frame& F, const bf16* A, const bf16* Bt, int K, int ncb, bf16* O, int ldo, const float* res, float* C, const float* nw = nullptr, bf16* xo = nullptr, float* rs = nullptr) {
    ITEM_IDS();
    const int kq = lane_ >> 4, fr = lane_ & 15;
    for (int wi = ((int)blockIdx.x) * NWAVES + wave_; wi < 16 * ncb; wi += ((int)gridDim.x) * NWAVES) {
        const int rb = wi & 15, cb = wi >> 4;
        const bf16* ap = A + (size_t)(MP + 16 * rb + fr) * K + 8 * kq;
        const int c = 16 * cb + fr;
        const bf16* bp = Bt + (size_t)(MODE == 2 ? ((c >> 7) * 256 + (c & 127)) : c) * K + 8 * kq;
        f32x4 acc0 = {0.f, 0.f, 0.f, 0.f}, acc1 = {0.f, 0.f, 0.f, 0.f};
#pragma unroll 8
        for (int k0 = 0; k0 < K; k0 += 32) {
            const bf16x8 a = *(const bf16x8*)(ap + k0), b0 = *(const bf16x8*)(bp + k0);
            acc0 = __builtin_amdgcn_mfma_f32_16x16x32_bf16(a, b0, acc0, 0, 0, 0);
            if (MODE == 2) { const bf16x8 b1 = *(const bf16x8*)(bp + (size_t)128 * K + k0); acc1 = __builtin_amdgcn_mfma_f32_16x16x32_bf16(a, b1, acc1, 0, 0, 0); }
        }
#pragma unroll
        for (int r = 0; r < 4; ++r) { const size_t row = (size_t)(MP + 16 * rb + 4 * kq + r);
            if (MODE == 0) { const bf16 ob = (bf16)f2bf(acc0[r]); O[row * ldo + c] = ob; if (c >= PC_V && c < PC_V + 256) F_VTA[(size_t)(c - PC_V) * M + row] = ob; }
            if (MODE == 1) { const float x = res[row * 1024 + c] + acc0[r]; C[row * 1024 + c] = x;
                if (nw) { xo[row * 1024 + c] = (bf16)f2bf(x * nw[c]); const float q = sum16_l(lane_, x * x); if (fr == 0) atomicAdd(rs + row, q); } }
            if (MODE == 2) O[row * ldo + c] = (bf16)f2bf(silu_g(acc0[r]) * acc1[r]); }
    }
}
__device__ __forceinline__ void sample_mix_item(Frame& F, int layer, int b) {
    ssd_prep_item(F, layer, NCHP + b);
    hgrn_prep_item(F, layer, NCHP + b);
    asm volatile("s_waitcnt vmcnt(0)" ::: "memory");
    __syncthreads();
    __builtin_amdgcn_fence(__ATOMIC_ACQUIRE, "agent");
    asm volatile("s_waitcnt vmcnt(0)" ::: "memory");
    { ITEM_IDS();
      if (wave_ == 0) ssd_out_witem(F, layer, NCHP + b, 0, wave_, lane_);
      else if (wave_ <= 4) hgrn_out_witem(F, layer, NCHP + b, wave_ - 1, 0, wave_, lane_); }
    __syncthreads();
}
__device__ __forceinline__ void p2_phase(Frame& F, int layer, volatile LAS unsigned* MISC) {
    constexpr int NS = NSB, NA = NCH * 4, NB = NCHP, NC = NCHP, ND = NCH, NE = 64, NW = 432;
    const int NTOT = NS + NA + NB + NC + ND + NE + (layer == 0 ? NW : 0);
    unsigned* head = (unsigned*)(F.ws + WS_CTL) + CW_QUEUE + 64 * layer;
    attn_bias_load(F, layer);
    unsigned nxt = 0u; if (threadIdx.x == 0) nxt = __hip_atomic_fetch_add(head, 1u, __ATOMIC_RELAXED, __HIP_MEMORY_SCOPE_AGENT);
    for (;;) {
        __syncthreads();
        if (threadIdx.x == 0) MISC[12] = nxt;
        __syncthreads();
        int it = (int)MISC[12];
        if (it >= NTOT) break;
        if (threadIdx.x == 0) nxt = __hip_atomic_fetch_add(head, 1u, __ATOMIC_RELAXED, __HIP_MEMORY_SCOPE_AGENT);
        if (it < NS) { sample_mix_item(F, layer, it); continue; } it -= NS;
        if (it < NA) { const int i2 = it - NSB * 4; const int ci = it < NSB * 4 ? NCHP + (it >> 2) : NCHP - 1 - (i2 >> 2); attn_item(F, layer, ci, it & 3); }
        else if (it < NA + NB) ssd_prep_item(F, layer, it - NA);
        else if (it < NA + NB + NC) hgrn_prep_item(F, layer, it - NA - NB);
        else if (it < NA + NB + NC + ND) pool_item(F, layer, it - NA - NB - NC);
        else if (it < NA + NB + NC + ND + NE) copy_cache(F, layer, it - NA - NB - NC - ND, NE);
        else { ITEM_IDS(); p0_weights(F, 1, (it - NA - NB - NC - ND - NE) * NWAVES + wave_, NW * NWAVES, false); }
    }
}
__device__ __forceinline__ void p4_phase(Frame& F, int layer) {
    for (int ci = ((int)blockIdx.x); ci < NCHP; ci += ((int)gridDim.x)) { ssd_out_block(F, layer, ci); hgrn_out_block(F, layer, ci); }
}

__global__ void __launch_bounds__(NTHR, 2) fwd_kernel(Args args) {
    extern __shared__ __attribute__((aligned(16))) unsigned char lds[];
    Frame F;
    F.lds = (LAS unsigned char*)lds;
    F.out = args.out; F.ws = args.ws;
    volatile LAS unsigned* MISC = (volatile LAS unsigned*)(F.lds + MISC_OFF);
    if (threadIdx.x < 64) MISC[threadIdx.x] = 0u;
    __syncthreads();
    (void)xcd_barrier_post((unsigned*)(args.ws + WS_CTL) + CW_BAR, MISC + 8);
#define GRID_BAR() do { XcdBarrier bar_; bar_.bar = (unsigned*)((unsigned char*)inp(N_IN + 1) + WS_CTL) + CW_BAR; bar_.x = xb_xcc_id(); bar_.st = MISC + 8; xcd_barrier(bar_); \
        F.out = (float*)inp(N_IN); F.ws = (unsigned char*)inp(N_IN + 1); } while (0)
#ifdef TPROBE
    const bool stamper = (blockIdx.x == 0 && threadIdx.x == 0); int n_stamp = 0;
#define STAMP() do { if (stamper) MISC[16 + n_stamp] = (unsigned)__builtin_amdgcn_s_memrealtime(); ++n_stamp; } while (0)
#else
#define STAMP() do { } while (0)
#endif
    STAMP();

    { float* rsz = F_RS; for (int i = (int)blockIdx.x * NTHR + (int)threadIdx.x; i < 2 * M; i += (int)gridDim.x * NTHR) rsz[i] = 0.f; }
    p0_weights(F, 0, ((int)blockIdx.x) * NWAVES + __builtin_amdgcn_readfirstlane((int)(threadIdx.x >> 6)), ((int)gridDim.x) * NWAVES, true);
    __syncthreads();
    norm_rows<true, false>(F, inp(I_XP), inp(I_XS) - (size_t)MP * D, inp(I_N1), inp(I_WIN));
    GRID_BAR(); STAMP();
#pragma unroll 1
    for (int layer = 0; layer < 2; ++layer) {
        unsigned char* wl = F.ws + WS_W + (size_t)layer * WL_STRIDE;
        mini_gemm<0>(F, F_XN, (const bf16*)(wl + WL_IN), D, NPROJ / 16, F_PROJ, NPROJ, nullptr, nullptr);
        { pg8::Gemm g{F_XN, (const bf16*)(wl + WL_IN), MP, NPROJ, D}; pg8::StaticOrder S; S.init(MP, NPROJ, ((int)gridDim.x), ((int)blockIdx.x));
          pg8::EpiBf16 E{F_PROJ, NPROJ, F_HALO, F_VTA, M};
          pg8::gemm_phase<pg8::EpiBf16, pg8::StaticOrder, true, true>(F.lds + RING_OFF, g, S, E); }
        GRID_BAR(); STAMP();
        p2_phase(F, layer, MISC);
        GRID_BAR(); STAMP();
        scan_phase(F, layer);
        GRID_BAR(); STAMP();
        p4_phase(F, layer);
        GRID_BAR(); STAMP();
        mini_gemm<1>(F, F_XN, (const bf16*)(wl + WL_OUT), D, D / 16, nullptr, 0, layer == 0 ? inp(I_XS) - (size_t)MP * D : F_X, F_X, inp(I_N2) + (size_t)layer * D, F_XN2, F_RS + (size_t)layer * M);
        { pg8::Gemm g{F_XN, (const bf16*)(wl + WL_OUT), MP, D, D}; pg8::StaticOrder S; S.init(MP, D, ((int)gridDim.x), ((int)blockIdx.x));
          pg8::EpiRes E{layer == 0 ? inp(I_XP) : F_X, layer == 0 ? inp(I_XS) - (size_t)MP * D : F_X, F_X, inp(I_N2) + (size_t)layer * D, F_XN2, F_RS + (size_t)layer * M};
          pg8::gemm_phase<pg8::EpiRes, pg8::StaticOrder, true, true>(F.lds + RING_OFF, g, S, E); }
        GRID_BAR(); STAMP();
        { pg8::Gemm g{F_XN2, (const bf16*)(wl + WL_GU), M, NGU, D}; pg8::StaticOrder S; S.init(M, NGU, ((int)gridDim.x), ((int)blockIdx.x));
          pg8::EpiSwiGLU E{F_ACT, DFF, F_RS + (size_t)layer * M};
          pg8::gemm_phase<pg8::EpiSwiGLU, pg8::StaticOrder, true, true>(F.lds + RING_OFF, g, S, E); }
        GRID_BAR(); STAMP();
        mini_gemm<1>(F, F_ACT, (const bf16*)(wl + WL_DN), DFF, D / 16, nullptr, 0, F_X, F_X);
        { pg8::Gemm g{F_ACT, (const bf16*)(wl + WL_DN), MP, D, DFF}; pg8::StaticOrder S; S.init(MP, D, ((int)gridDim.x), ((int)blockIdx.x));
          pg8::EpiRes E{F_X, F_X, F_X, nullptr, nullptr, nullptr};
          pg8::gemm_phase<pg8::EpiRes, pg8::StaticOrder, true, true>(F.lds + RING_OFF, g, S, E); }
        GRID_BAR(); STAMP();
        if (layer == 0) { norm_rows<true, false>(F, F_X, F_X, inp(I_N1) + D, inp(I_WIN) + (size_t)D * NIN); GRID_BAR(); STAMP(); }
        else { norm_rows<false, true>(F, F_X, F_X, inp(I_NF), nullptr); STAMP(); }
    }
#ifdef TPROBE
    if (stamper) {
        unsigned v[10]; v[0] = MISC[17] - MISC[16];
        for (int j = 1; j < 9; ++j) v[j] = (MISC[17 + j] - MISC[16 + j]) + (MISC[25 + j] - MISC[24 + j]);
        v[9] = (MISC[33] - MISC[16]) / 4;
        const unsigned dl = 800000u + 16u * v[TPROBE];
        const unsigned t0 = MISC[16];
        while ((unsigned)((unsigned)__builtin_amdgcn_s_memrealtime() - t0) < dl) __builtin_amdgcn_s_sleep(32);
    }
#endif
}

extern "C" void kernel_launch(void* const* d_in, const int* in_sizes, int n_in, void* d_out, int out_size, void* d_ws, size_t ws_size, hipStream_t stream) {
    static int grid = 0;
    if (grid == 0) {
        if (n_in != N_IN || (size_t)out_size != O_END || ws_size < WS_END) { fprintf(stderr, "kernel_launch: unexpected shapes (n_in %d, out %d, ws %zu)\n", n_in, out_size, ws_size); grid = -1; return; }
        int dev = 0, cus = 0, per_cu = 0;
        if (hipGetDevice(&dev) != hipSuccess || hipDeviceGetAttribute(&cus, hipDeviceAttributeMultiprocessorCount, dev) != hipSuccess) { grid = -1; return; }
        if (hipFuncSetAttribute((const void*)fwd_kernel, hipFuncAttributeMaxDynamicSharedMemorySize, LDS_BYTES) != hipSuccess) { fprintf(stderr, "kernel_launch: hipFuncSetAttribute failed\n"); grid = -1; return; }
        if (hipOccupancyMaxActiveBlocksPerMultiprocessor(&per_cu, (const void*)fwd_kernel, NTHR, LDS_BYTES) != hipSuccess || per_cu < 1) { fprintf(stderr, "kernel_launch: occupancy query says %d blocks per CU\n", per_cu); (void)hipGetLastError(); grid = -1; return; }
        grid = cus;
        if (grid < 64) { fprintf(stderr, "kernel_launch: needs at least 64 CUs (got %d)\n", cus); grid = -1; return; }
    }
    if (grid < 0) return;
    if (hipMemsetAsync((char*)d_ws + WS_CTL, 0, CTL_ZERO_BYTES, stream) != hipSuccess) { fprintf(stderr, "kernel_launch: hipMemsetAsync failed\n"); return; }
    Args a{};
    for (int i = 0; i < N_IN; ++i) a.in[i] = (const float*)d_in[i];
    a.out = (float*)d_out; a.ws = (unsigned char*)d_ws;
    void* kargs[] = {&a};
    hipError_t e = hipLaunchCooperativeKernel((const void*)fwd_kernel, dim3(grid), dim3(NTHR), kargs, LDS_BYTES, stream);
    if (e != hipSuccess) { fprintf(stderr, "kernel_launch: cooperative launch failed: %s (grid %d)\n", hipGetErrorString(e), grid); }
}
```

```cpp
#include <hip/hip_runtime.h>
#include <cstdio>
#include <cstdint>
namespace pg8 {
#define PG8_LAS __attribute__((address_space(3)))
typedef unsigned short bf16_t;
typedef short bf16x8 __attribute__((ext_vector_type(8)));
typedef float f32x4 __attribute__((ext_vector_type(4)));
typedef unsigned u32x4 __attribute__((ext_vector_type(4)));
constexpr int BM = 256, BK = 64, HALF = 128, HTB = HALF * BK * 2  , STAGE_BYTES = 8 * HTB, NXCD = 8, WGM = 8;

__host__ __device__ __forceinline__ int lds_byte(int r, int c) { const int st = (r >> 4) * 2 + (c >> 5), rr = r & 15, cc = c & 31, ob = rr * 64 + cc * 2; return st * 1024 + (ob ^ (((ob >> 9) & 1) << 5)); }
__host__ __device__ __forceinline__ void stage_rc(int b, int& R, int& C) { const int st = b / 1024, sb = b % 1024, swz = sb ^ (((sb >> 9) & 1) << 5); R = (st >> 1) * 16 + swz / 64; C = (st & 1) * 32 + (swz % 64) / 2; }
__host__ __device__ __forceinline__ int perm32(int rho) { const int n = rho >> 4, i = rho & 15; return 8 * (i >> 2) + 4 * n + (i & 3); }

struct Unit { int pm, pn; };
struct Gemm { const bf16_t* A; const bf16_t* Bt; int M, N, K; };

struct StaticOrder {
    int nM, nN, nwg, G, c;
    __host__ __device__ void init(int M, int N, int G_, int c_) { nM = M / BM; nN = N / BM; nwg = nM * nN; G = G_; c = c_; }
    __host__ __device__ bool next(int i, Unit& u) const {
        const long L = (long)i * G + c; if (L >= nwg) return false;
        int wgid = (int)L; { const int q = nwg / NXCD, r = nwg % NXCD, xcd = wgid % NXCD, off = wgid / NXCD; wgid = (xcd < r ? xcd * (q + 1) : r * (q + 1) + (xcd - r) * q) + off; }
        const int nig = WGM * nN, gid = wgid / nig, fm = gid * WGM, gsz = (nM - fm) < WGM ? (nM - fm) : WGM;
        u.pm = fm + ((wgid % nig) % gsz); u.pn = (wgid % nig) / gsz; return true;
    }
    __device__ __forceinline__ void a_ready(const Unit&) const {}
    __device__ __forceinline__ void done(const Unit&) const {}
};

__device__ __forceinline__ unsigned cvt_pk_bf16(float lo, float hi) { unsigned r; asm volatile("v_cvt_pk_bf16_f32 %0, %1, %2" : "=v"(r) : "v"(lo), "v"(hi)); return r; }
__device__ __forceinline__ float silu_f(float x) { return x * __builtin_amdgcn_rcpf(1.0f + __expf(-x)); }
struct EpiBf16 {
    static constexpr bool PERM = true, AFTER_DRAIN = false;
    bf16_t* O; int ldc; bf16_t* halo; bf16_t* vta; int vld;
    __device__ __forceinline__ void operator()(const f32x4 (&acc)[2][2][4][2], const Unit& u, int wr, int wc, int fr, int fq) const {
        const int row0 = u.pm * BM + wr * 64 + fr, col0 = u.pn * BM + wc * 32 + 8 * fq;
        const bool hz = halo != nullptr && u.pn >= 4 && u.pn <= 6;
#pragma unroll
        for (int ai = 0; ai < 2; ++ai)
#pragma unroll
            for (int m = 0; m < 4; ++m) { const int row = row0 + ai * HALF + m * 16; bf16_t* rowp = O + (size_t)row * ldc + col0;
#pragma unroll
                for (int bj = 0; bj < 2; ++bj) { const f32x4 v0 = acc[ai][bj][m][0], v1 = acc[ai][bj][m][1];
                    u32x4 w; w.x = cvt_pk_bf16(v0[0], v0[1]); w.y = cvt_pk_bf16(v0[2], v0[3]); w.z = cvt_pk_bf16(v1[0], v1[1]); w.w = cvt_pk_bf16(v1[2], v1[3]);
                    *(u32x4*)(rowp + bj * HALF) = w;
                    if (hz && (row & 63) >= 61) *(u32x4*)(halo + ((size_t)(row >> 6) * 3 + (row & 63) - 61) * 768 + (col0 - 1024) + bj * HALF) = w;
                    if (vta != nullptr && u.pn == 2) { bf16_t* vp = vta + (size_t)(col0 - 512 + bj * HALF) * vld + row;
                        vp[0] = (bf16_t)(w.x & 0xffffu); vp[(size_t)vld] = (bf16_t)(w.x >> 16); vp[(size_t)2 * vld] = (bf16_t)(w.y & 0xffffu); vp[(size_t)3 * vld] = (bf16_t)(w.y >> 16);
                        vp[(size_t)4 * vld] = (bf16_t)(w.z & 0xffffu); vp[(size_t)5 * vld] = (bf16_t)(w.z >> 16); vp[(size_t)6 * vld] = (bf16_t)(w.w & 0xffffu); vp[(size_t)7 * vld] = (bf16_t)(w.w >> 16); } } }
    }
};
struct EpiRes {
    static constexpr bool PERM = false, AFTER_DRAIN = false;
    const float* rlo; const float* rhi; float* C; const float* nw; bf16_t* xo; float* rs;
    __device__ __forceinline__ void operator()(const f32x4 (&acc)[2][2][4][2], const Unit& u, int wr, int wc, int fr, int fq) const {
        const int row0 = u.pm * BM + wr * 64 + fr, col0 = u.pn * BM + wc * 32 + 4 * fq;
        const float* rb = (u.pm < 64) ? rlo : rhi;
        f32x4 wv[2][2];
        if (nw) {
#pragma unroll
            for (int bj = 0; bj < 2; ++bj)
#pragma unroll
                for (int n = 0; n < 2; ++n) wv[bj][n] = *(const f32x4*)(nw + col0 + bj * HALF + n * 16); }
#pragma unroll
        for (int ai = 0; ai < 2; ++ai)
#pragma unroll
            for (int m = 0; m < 4; ++m) { const int row = row0 + ai * HALF + m * 16; const size_t off = (size_t)row * 1024 + col0; float ss = 0.f;
#pragma unroll
                for (int bj = 0; bj < 2; ++bj)
#pragma unroll
                    for (int n = 0; n < 2; ++n) { const f32x4 r = *(const f32x4*)(rb + off + bj * HALF + n * 16); const f32x4 x = r + acc[ai][bj][m][n]; *(f32x4*)(C + off + bj * HALF + n * 16) = x;
                        if (nw) { ss += (x[0] * x[0] + x[1] * x[1]) + (x[2] * x[2] + x[3] * x[3]); const f32x4 y = x * wv[bj][n];
                            *(unsigned long long*)(xo + off + bj * HALF + n * 16) = (unsigned long long)cvt_pk_bf16(y[0], y[1]) | ((unsigned long long)cvt_pk_bf16(y[2], y[3]) << 32); } }
                if (nw) { const int lane = fq * 16 + fr;
                    ss += __builtin_bit_cast(float, __builtin_amdgcn_ds_bpermute((lane ^ 16) << 2, __builtin_bit_cast(int, ss)));
                    ss += __builtin_bit_cast(float, __builtin_amdgcn_ds_bpermute((lane ^ 32) << 2, __builtin_bit_cast(int, ss)));
                    if (fq == 0) atomicAdd(rs + row, ss); }
                asm volatile("" ::: "memory"); }
    }
};
struct EpiSwiGLU {
    static constexpr bool PERM = true, AFTER_DRAIN = false;
    bf16_t* O; int ldc; const float* rs;
    __device__ __forceinline__ void operator()(const f32x4 (&acc)[2][2][4][2], const Unit& u, int wr, int wc, int fr, int fq) const {
        const int row0 = u.pm * BM + wr * 64 + fr, col0 = u.pn * HALF + wc * 32 + 8 * fq;
#pragma unroll
        for (int ai = 0; ai < 2; ++ai)
#pragma unroll
            for (int m = 0; m < 4; ++m) { const int row = row0 + ai * HALF + m * 16; bf16_t* rowp = O + (size_t)row * ldc + col0;
                const float rstd = __builtin_amdgcn_rsqf(rs[row] * (1.0f / 1024.0f) + 1e-6f);
                const f32x4 g0 = acc[ai][0][m][0] * rstd, g1 = acc[ai][0][m][1] * rstd, u0 = acc[ai][1][m][0] * rstd, u1 = acc[ai][1][m][1] * rstd;
                u32x4 w; w.x = cvt_pk_bf16(silu_f(g0[0]) * u0[0], silu_f(g0[1]) * u0[1]); w.y = cvt_pk_bf16(silu_f(g0[2]) * u0[2], silu_f(g0[3]) * u0[3]);
                w.z = cvt_pk_bf16(silu_f(g1[0]) * u1[0], silu_f(g1[1]) * u1[1]); w.w = cvt_pk_bf16(silu_f(g1[2]) * u1[2], silu_f(g1[3]) * u1[3]);
                *(u32x4*)rowp = w; }
    }
};
template <class Epi, class Sched, bool ALIGN_EPI = false, bool SP2 = false>
__device__ __forceinline__ void gemm_phase(PG8_LAS unsigned char* lds, const Gemm g, const Sched& S, const Epi& E) {
    int tid0 = threadIdx.x; asm volatile("" : "+v"(tid0));
    const int tid = tid0, wid = __builtin_amdgcn_readfirstlane(tid >> 6), lane = tid & 63, wr = wid >> 2, wc = wid & 3, fr = lane & 15, fq = lane >> 4;
    const int K = g.K, nt = K / BK;
    unsigned voffA[2], voffB[2];
#pragma unroll
    for (int i = 0; i < 2; ++i) { int R, C; stage_rc(tid * 16 + i * 8192, R, C); const int Rb = Epi::PERM ? ((R & ~31) + perm32(R & 31)) : R;
        voffA[i] = (unsigned)(R * K + C) * 2u; voffB[i] = (unsigned)(Rb * K + C) * 2u; }
    const size_t kstep = (size_t)(BK * 2);
    const size_t hstep = (size_t)HALF * K * 2;
    const size_t tstep = 2 * hstep;
    const unsigned ldsw = (unsigned)wid * 1024u;
    const int aoff = lds_byte(wr * 64 + fr, fq * 8), boff = lds_byte(wc * 32 + fr, fq * 8);
#define PG8_SA(b, h) (((b) * 2 + (h)) * HTB)
#define PG8_SB(b, h) ((4 + (b) * 2 + (h)) * HTB)
#define PG8_STAGE(bufoff, gbase, voff) do { _Pragma("unroll") for (int _i = 0; _i < 2; ++_i) \
        __builtin_amdgcn_global_load_lds((const unsigned*)((const char*)(gbase) + (voff)[_i]), (PG8_LAS unsigned*)(lds + (bufoff) + ldsw + _i * 8192), 16, 0, 0); } while (0)
#define PG8_LDA(dst, b, h) do { _Pragma("unroll") for (int m = 0; m < 4; ++m) _Pragma("unroll") for (int k = 0; k < 2; ++k) dst[m][k] = *(const PG8_LAS bf16x8*)(lds + PG8_SA(b, h) + aoff + m * 2048 + k * 1024); } while (0)
#define PG8_LDB(dst, b, h) do { _Pragma("unroll") for (int n = 0; n < 2; ++n) _Pragma("unroll") for (int k = 0; k < 2; ++k) dst[n][k] = *(const PG8_LAS bf16x8*)(lds + PG8_SB(b, h) + boff + n * 2048 + k * 1024); } while (0)
#define PG8_MMA(ai, bj, At, Bt) do { __builtin_amdgcn_s_setprio(1); _Pragma("unroll") for (int m = 0; m < 4; ++m) _Pragma("unroll") for (int n = 0; n < 2; ++n) _Pragma("unroll") for (int k = 0; k < 2; ++k) \
        acc[ai][bj][m][n] = __builtin_amdgcn_mfma_f32_16x16x32_bf16(Bt[n][k], At[m][k], acc[ai][bj][m][n], 0, 0, 0); __builtin_amdgcn_s_setprio(0); } while (0)
#define PG8_WAIT_V(n) asm volatile("s_waitcnt vmcnt(" #n ")" ::: "memory")
#define PG8_WAIT_L(n) asm volatile("s_waitcnt lgkmcnt(" #n ")" ::: "memory")
#define PG8_BAR __builtin_amdgcn_s_barrier()
#define PG8_SCHED __builtin_amdgcn_sched_barrier(0)
    Unit cur, nxt; int ui = 0;
    if (!S.next(0, cur)) return;
    f32x4 acc[2][2][4][2];
#pragma unroll
    for (int a = 0; a < 2; ++a)
#pragma unroll
        for (int b = 0; b < 2; ++b)
#pragma unroll
            for (int m = 0; m < 4; ++m)
#pragma unroll
                for (int n = 0; n < 2; ++n) acc[a][b][m][n] = (f32x4){0.f, 0.f, 0.f, 0.f};
    bf16x8 At[4][2], B0[2][2], B1[2][2];
    const char* cA = (const char*)g.A + (size_t)cur.pm * tstep; const char* cB = (const char*)g.Bt + (size_t)cur.pn * tstep;
    S.a_ready(cur);
    if constexpr (SP2) {
        PG8_STAGE(PG8_SB(0, 0), cB, voffB); PG8_STAGE(PG8_SB(0, 1), cB + hstep, voffB); PG8_STAGE(PG8_SA(0, 0), cA, voffA); PG8_STAGE(PG8_SA(0, 1), cA + hstep, voffA);
        if (wr == 1) PG8_BAR;
        PG8_WAIT_V(2); PG8_BAR;
        PG8_STAGE(PG8_SB(1, 0), cB + kstep, voffB); PG8_STAGE(PG8_SA(1, 0), cA + kstep, voffA); PG8_STAGE(PG8_SB(1, 1), cB + hstep + kstep, voffB);
        PG8_WAIT_V(6); PG8_BAR;
    } else {
        PG8_STAGE(PG8_SB(0, 0), cB, voffB); PG8_STAGE(PG8_SA(0, 0), cA, voffA); PG8_STAGE(PG8_SB(0, 1), cB + hstep, voffB); PG8_STAGE(PG8_SA(0, 1), cA + hstep, voffA);
        if (wr == 1) PG8_BAR;
        PG8_WAIT_V(4); PG8_BAR;
        PG8_STAGE(PG8_SB(1, 0), cB + kstep, voffB); PG8_STAGE(PG8_SA(1, 0), cA + kstep, voffA); PG8_STAGE(PG8_SB(1, 1), cB + hstep + kstep, voffB);
        PG8_WAIT_V(6); PG8_BAR;
    }
    for (;;) {
        const bool has_next = S.next(ui + 1, nxt);
        const char* nA = has_next ? (const char*)g.A + (size_t)nxt.pm * tstep : cA; const char* nB = has_next ? (const char*)g.Bt + (size_t)nxt.pn * tstep : cB;
        for (int t = 0; t < nt; t += 2) {
            const bool last = (t == nt - 2);
            const char* a1 = cA + (size_t)(t + 1) * kstep;
            const char* a2 = last ? nA : cA + (size_t)(t + 2) * kstep; const char* b2 = last ? nB : cB + (size_t)(t + 2) * kstep;
            const char* a3 = a2 + kstep; const char* b3 = b2 + kstep;
            if (last && has_next) S.a_ready(nxt);
            if constexpr (SP2) {
            PG8_LDB(B0, 0, 0); PG8_LDB(B1, 0, 1); PG8_SCHED; PG8_LDA(At, 0, 0); PG8_STAGE(PG8_SA(1, 1), a1 + hstep, voffA);
            PG8_WAIT_V(8); PG8_WAIT_L(0); PG8_BAR; PG8_MMA(0, 0, At, B0); PG8_MMA(0, 1, At, B1); PG8_BAR; PG8_SCHED;
            PG8_LDA(At, 0, 1); PG8_STAGE(PG8_SB(0, 0), b2, voffB); PG8_STAGE(PG8_SB(0, 1), b2 + hstep, voffB); PG8_STAGE(PG8_SA(0, 0), a2, voffA);
            PG8_WAIT_V(8); PG8_WAIT_L(0); PG8_BAR; PG8_MMA(1, 0, At, B0); PG8_MMA(1, 1, At, B1); PG8_BAR; PG8_SCHED;
            PG8_LDB(B0, 1, 0); PG8_LDB(B1, 1, 1); PG8_SCHED; PG8_LDA(At, 1, 0); PG8_STAGE(PG8_SA(0, 1), a2 + hstep, voffA);
            PG8_WAIT_V(8); PG8_WAIT_L(0); PG8_BAR; PG8_MMA(0, 0, At, B0); PG8_MMA(0, 1, At, B1); PG8_BAR; PG8_SCHED;
            PG8_LDA(At, 1, 1); PG8_STAGE(PG8_SB(1, 0), b3, voffB); PG8_STAGE(PG8_SB(1, 1), b3 + hstep, voffB); PG8_STAGE(PG8_SA(1, 0), a3, voffA);
            PG8_WAIT_V(8); PG8_WAIT_L(0); PG8_BAR; PG8_MMA(1, 0, At, B0); PG8_MMA(1, 1, At, B1); PG8_BAR; PG8_SCHED;
            } else {
            PG8_LDB(B0, 0, 0); PG8_SCHED; PG8_LDA(At, 0, 0); PG8_STAGE(PG8_SA(1, 1), a1 + hstep, voffA);
            PG8_WAIT_L(8); PG8_BAR; PG8_WAIT_L(0); PG8_MMA(0, 0, At, B0); PG8_BAR; PG8_SCHED;
            PG8_LDB(B1, 0, 1); PG8_STAGE(PG8_SB(0, 0), b2, voffB);
            PG8_BAR; PG8_WAIT_L(0); PG8_MMA(0, 1, At, B1); PG8_BAR;
            PG8_LDA(At, 0, 1); PG8_STAGE(PG8_SA(0, 0), a2, voffA);
            PG8_BAR; PG8_WAIT_L(0); PG8_MMA(1, 0, At, B0); PG8_BAR; PG8_SCHED;
            PG8_STAGE(PG8_SB(0, 1), b2 + hstep, voffB);
            PG8_WAIT_V(6); PG8_BAR; PG8_MMA(1, 1, At, B1); PG8_BAR;
            PG8_LDB(B0, 1, 0); PG8_SCHED; PG8_LDA(At, 1, 0); PG8_STAGE(PG8_SA(0, 1), a2 + hstep, voffA);
            PG8_WAIT_L(8); PG8_BAR; PG8_WAIT_L(0); PG8_MMA(0, 0, At, B0); PG8_BAR; PG8_SCHED;
            PG8_LDB(B1, 1, 1); PG8_STAGE(PG8_SB(1, 0), b3, voffB);
            PG8_BAR; PG8_WAIT_L(0); PG8_MMA(0, 1, At, B1); PG8_BAR;
            PG8_LDA(At, 1, 1); PG8_STAGE(PG8_SA(1, 0), a3, voffA);
            PG8_BAR; PG8_WAIT_L(0); PG8_MMA(1, 0, At, B0); PG8_BAR; PG8_SCHED;
            PG8_STAGE(PG8_SB(1, 1), b3 + hstep, voffB);
            PG8_WAIT_V(6); PG8_BAR; PG8_MMA(1, 1, At, B1); PG8_BAR;
            }
        }
        if constexpr (ALIGN_EPI) { if (wr == 0) PG8_BAR; }
        if constexpr (!Epi::AFTER_DRAIN) { E(acc, cur, wr, wc, fr, fq); S.done(cur); }
        if (!has_next) break;
#pragma unroll
        for (int a = 0; a < 2; ++a)
#pragma unroll
            for (int b = 0; b < 2; ++b)
#pragma unroll
                for (int m = 0; m < 4; ++m)
#pragma unroll
                    for (int n = 0; n < 2; ++n) acc[a][b][m][n] = (f32x4){0.f, 0.f, 0.f, 0.f};
        cur = nxt; cA = nA; cB = nB; ++ui;
        if constexpr (ALIGN_EPI) { if (wr == 1) PG8_BAR; }
    }
    PG8_WAIT_V(0);
    if constexpr (!ALIGN_EPI) { if (wr == 0) PG8_BAR; }
    PG8_BAR;
    if constexpr (Epi::AFTER_DRAIN) { E.fused(acc, cur, wr, wc, fr, fq, lds, wid, lane); S.done(cur); }
#undef PG8_SA
#undef PG8_SB
#undef PG8_STAGE
#undef PG8_LDA
#undef PG8_LDB
#undef PG8_MMA
#undef PG8_WAIT_V
#undef PG8_WAIT_L
#undef PG8_BAR
#undef PG8_SCHED
}
}
#define GAS __attribute__((address_space(1)))
#define LAS __attribute__((address_space(3)))
typedef unsigned short bf16;
typedef unsigned v4u __attribute__((ext_vector_type(4)));
typedef float f32x4 __attribute__((ext_vector_type(4)));
typedef short bf16x8 __attribute__((ext_vector_type(8)));
typedef GAS unsigned gu32;
typedef GAS unsigned long long gu64;
#define RLX_AGENT __ATOMIC_RELAXED, __HIP_MEMORY_SCOPE_AGENT
#define LDS_WAIT() asm volatile("s_waitcnt lgkmcnt(0)" ::: "memory")
#define VM_WAIT() asm volatile("s_waitcnt vmcnt(0)" ::: "memory")
__device__ __forceinline__ unsigned long long rt() { return __builtin_amdgcn_s_memrealtime(); }
__device__ __forceinline__ unsigned f2bf(float f) { unsigned u = __builtin_bit_cast(unsigned, f); return (u + 0x7fffu + ((u >> 16) & 1u)) >> 16; }
__device__ __forceinline__ unsigned pk2(float lo, float hi) { return f2bf(lo) | (f2bf(hi) << 16); }
#define XB_TMO      128
#define XB_XCNT(j)  (256  + 64 * (j))
#define XB_XSUB(j)  (1280 + 64 * (j))
#define XB_XGEN(j)  (2304 + 64 * (j))
#define XB_TOP      3328
#define XB_TOPGEN   3392
#define XCD_BAR_WORDS 3456
#define XB_SPIN_CAP (1u << 18)

__device__ __forceinline__ unsigned xb_ld(unsigned* p)              { return __hip_atomic_load(p, __ATOMIC_RELAXED, __HIP_MEMORY_SCOPE_AGENT); }
__device__ __forceinline__ unsigned xb_add(unsigned* p, unsigned v) { return __hip_atomic_fetch_add(p, v, __ATOMIC_RELAXED, __HIP_MEMORY_SCOPE_AGENT); }
__device__ __forceinline__ unsigned xb_xcc_id() { return (unsigned)__builtin_amdgcn_s_getreg((3 << 11) | 20) & 0xFu; }
#define XB_SPIN(cond, bar) do { unsigned _sp = 0; while (cond) { __builtin_amdgcn_s_sleep(1); \
    if ((++_sp & 255u) == 0u) { if (xb_ld(&(bar)[XB_TMO])) break; if (_sp > XB_SPIN_CAP) { atomicAdd(&(bar)[XB_TMO], 1u); break; } } } } while (0)

struct XcdBarrier {
    unsigned* bar; unsigned x;
    volatile LAS unsigned* st;
};

__device__ __forceinline__ XcdBarrier xcd_barrier_post(unsigned* bar, volatile LAS unsigned* st) {
    XcdBarrier b; b.bar = bar; b.x = xb_xcc_id(); b.st = st;
    if (threadIdx.x == 0) (void)xb_add(&bar[XB_XCNT(b.x)], 1u);
    return b;
}
__device__ __forceinline__ void xcd_barrier_complete(unsigned* bar, unsigned x, unsigned& nloc, unsigned& nx) {
    const unsigned G = gridDim.x * gridDim.y * gridDim.z;
    unsigned sum, cnt, mine, sp = 0u;
    for (;;) {
        sum = 0u; cnt = 0u; mine = 0u;
#pragma unroll
        for (unsigned j = 0; j < 16; ++j) { const unsigned c = xb_ld(&bar[XB_XCNT(j)]); sum += c; cnt += (c > 0u) ? 1u : 0u; mine = (j == x) ? c : mine; }
        if (sum == G) break;
        __builtin_amdgcn_s_sleep(1);
        if ((++sp & 255u) == 0u) { if (xb_ld(&bar[XB_TMO])) break; if (sp > XB_SPIN_CAP) { atomicAdd(&bar[XB_TMO], 1u); break; } }
    }
    nloc = mine > 0u ? mine : 1u; nx = cnt > 0u ? cnt : 1u;
}

__device__ __forceinline__ void xcd_barrier(const XcdBarrier& b) {
    asm volatile("s_waitcnt vmcnt(0)" ::: "memory");
    __syncthreads();
    if (threadIdx.x == 0) {
        unsigned* bar = b.bar;
        __builtin_amdgcn_s_waitcnt(0);
        unsigned nloc = b.st[0], nx = b.st[1];
        if (nloc == 0u) { xcd_barrier_complete(bar, b.x, nloc, nx); b.st[0] = nloc; b.st[1] = nx; }
        const unsigned old = xb_add(&bar[XB_XSUB(b.x)], 1u);
        const unsigned gen = old / nloc;
        if (old + 1u == (gen + 1u) * nloc) {
            __builtin_amdgcn_fence(__ATOMIC_RELEASE, "agent");
            asm volatile("s_waitcnt vmcnt(0)" ::: "memory");
            const unsigned og = xb_add(&bar[XB_TOP], 1u);
            const unsigned tg = og / nx;
            if (og + 1u == (tg + 1u) * nx) xb_add(&bar[XB_TOPGEN], 1u);
            else XB_SPIN(xb_ld(&bar[XB_TOPGEN]) == tg, bar);
            __builtin_amdgcn_fence(__ATOMIC_ACQUIRE, "agent");
            xb_add(&bar[XB_XGEN(b.x)], 1u);
            asm volatile("s_waitcnt vmcnt(0)" ::: "memory");
        } else {
            XB_SPIN(xb_ld(&bar[XB_XGEN(b.x)]) == gen, bar);
            __builtin_amdgcn_fence(__ATOMIC_ACQUIRE, "agent");
            asm volatile("s_waitcnt vmcnt(0)" ::: "memory");
        }
    }
    __syncthreads();
}
constexpr int NWAVES = 8, NTHR = 512;
constexpr int D = 1024, MP = 16384, NSB = 16, SSEQ = 16, MS = NSB * SSEQ, M = MP + MS;
constexpr int NIN = 3076, NPROJ = 3072, DFF = 2816, NGU = 2 * DFF;
constexpr int NCHP = 256, NCH = NCHP + NSB;
constexpr int PC_Q = 0, PC_K = 256, PC_V = 512, PC_Z = 768, PC_X = 1024, PC_B = 1280, PC_C = 1536, PC_CQ = 1792, PC_CF = 2048, PC_CI = 2304, PC_CG = 2560, PC_DX = 2816;
constexpr float EPS = 1e-6f;
enum { I_XP = 0, I_XS, I_CK, I_CV, I_SCONV, I_SSSM, I_SHGRN, I_SPOOL, I_N1, I_WIN, I_AREL, I_CW, I_CB, I_DTB, I_ALOG, I_BD, I_BNRM, I_LB, I_CNRM, I_PW, I_PS, I_WOUT, I_N2, I_WGU, I_WDN, I_NF, N_IN };
constexpr size_t O_YP = 0, O_YS = O_YP + (size_t)MP * D, O_PK = O_YS + (size_t)MS * D, O_PV = O_PK + 2 * 512 * 256, O_PCONV = O_PV + 2 * 512 * 256, O_PSSM = O_PCONV + 2 * 3 * 768,
                 O_PHGRN = O_PSSM + 2 * 4 * 64 * 128, O_PPOOL = O_PHGRN + 2 * 4 * 64 * 64, O_SK = O_PPOOL + 2 * 15 * 256, O_SV = O_SK + (size_t)2 * 16 * 512 * 256,
                 O_SCONV = O_SV + (size_t)2 * 16 * 512 * 256, O_SSSM = O_SCONV + 2 * 16 * 3 * 768, O_SHGRN = O_SSSM + 2 * 16 * 4 * 64 * 128, O_SPOOL = O_SHGRN + 2 * 16 * 4 * 64 * 64,
                 O_END = O_SPOOL + 2 * 16 * 15 * 256;
constexpr size_t MiB = 1u << 20;
constexpr size_t WS_CTL = 0, CTL_ZERO_BYTES = 64 * 1024;
constexpr size_t WL_IN = 0, WL_OUT = 6 * MiB, WL_GU = 8 * MiB, WL_DN = 19 * MiB, WL_STRIDE = 24 * MiB + MiB / 2;
constexpr size_t WS_W = 1 * MiB;
constexpr size_t WS_XN = 50 * MiB;
constexpr size_t WS_PROJ = 83 * MiB;
constexpr size_t WS_STB = 181 * MiB;
constexpr size_t WS_XT = 198 * MiB;
constexpr size_t WS_HALO = 207 * MiB;
constexpr size_t WS_RH = 208 * MiB + MiB / 2;
constexpr size_t WS_STC = 215 * MiB;
constexpr size_t WS_VT = 223 * MiB + MiB / 2;
constexpr size_t WS_DT = 232 * MiB;
constexpr size_t WS_DECB = 233 * MiB;
constexpr size_t WS_DECC = 233 * MiB + 64 * 1024;
constexpr size_t WS_ACS = 233 * MiB + 384 * 1024, WS_DTV = 233 * MiB + 704 * 1024;
constexpr size_t WS_VTA = 234 * MiB;
constexpr size_t WS_END = 243 * MiB;
static_assert(WS_VTA + (size_t)256 * M * 2 <= WS_END, "ws map 2");
constexpr int CW_QUEUE = 512;
static_assert(WS_XN + (size_t)M * D * 2 <= WS_PROJ && WS_PROJ + (size_t)M * NPROJ * 2 <= WS_STB && WS_STB + (size_t)NCH * 4 * 64 * 128 * 2 <= WS_XT && WS_XT + (size_t)NCH * 256 * 64 * 2 <= WS_HALO && WS_HALO + (size_t)256 * 3 * 768 * 2 <= WS_STC && WS_RH + (size_t)NCH * 1280 * 4 <= WS_STC && WS_STC + (size_t)NCH * 4 * 64 * 64 * 2 <= WS_VT && WS_VT + (size_t)NCH * 256 * 64 * 2 <= WS_DT, "ws map");
static_assert(WL_DN + (size_t)D * DFF * 2 <= WL_STRIDE && WS_W + 2 * WL_STRIDE <= WS_XN, "weight map");
constexpr size_t WS_WPT = 128 * 1024;
constexpr size_t WS_RS = 256 * 1024;
constexpr size_t WS_XN2 = 181 * MiB;
static_assert(WS_XN2 + (size_t)M * D * 2 <= 232 * MiB && WS_RS + 2 * (size_t)M * 4 <= MiB, "ws map 3");
constexpr int CW_BAR = 1024;
constexpr int LDS_BYTES = 163840;
constexpr int MISC_OFF = LDS_BYTES - 256;
constexpr int RING_OFF = 0;
typedef LAS float lf32;
typedef float f32x2 __attribute__((ext_vector_type(2)));
struct Args { const float* in[N_IN]; float* out; unsigned char* ws; };
struct Frame {
    LAS unsigned char* lds;
    float* out; unsigned char* ws;
};
__device__ __forceinline__ float* inp(int i) { asm volatile("" : "+s"(i)); return ((float* const __attribute__((address_space(4)))*)__builtin_amdgcn_kernarg_segment_ptr())[i]; }
__device__ __forceinline__ unsigned char* opq(unsigned char* p) { asm volatile("" : "+s"(p)); return p; }
#define ITEM_IDS() int tid_ = threadIdx.x; asm volatile("" : "+v"(tid_)); const int wave_ = __builtin_amdgcn_readfirstlane(tid_ >> 6); const int lane_ = tid_ & 63; (void)lane_; (void)wave_
#define F_XN ((bf16*)opq(F.ws + WS_XN))
#define F_PROJ ((bf16*)opq(F.ws + WS_PROJ))
#define F_ACT ((bf16*)opq(F.ws + WS_PROJ))
#define F_STB ((bf16*)opq(F.ws + WS_STB))
#define F_XT ((bf16*)opq(F.ws + WS_XT))
#define F_HALO ((bf16*)opq(F.ws + WS_HALO))
#define F_ACS ((float*)opq(F.ws + WS_ACS))
#define F_DTV ((float*)opq(F.ws + WS_DTV))
#define F_STC ((bf16*)opq(F.ws + WS_STC))
#define F_VT ((bf16*)opq(F.ws + WS_VT))
#define F_RH ((float*)opq(F.ws + WS_RH))
#define F_VTA ((bf16*)opq(F.ws + WS_VTA))
#define F_WPT ((bf16*)opq(F.ws + WS_WPT))
#define F_RS ((float*)opq(F.ws + WS_RS))
#define F_XN2 ((bf16*)opq(F.ws + WS_XN2))
#define F_DT ((float*)opq(F.ws + WS_DT))
#define F_DECB ((float*)opq(F.ws + WS_DECB))
#define F_DECC ((float*)opq(F.ws + WS_DECC))
#define F_X    (F.out)
__device__ __forceinline__ float bf_lo(unsigned w) { return __builtin_bit_cast(float, w << 16); }
__device__ __forceinline__ float bf_hi(unsigned w) { return __builtin_bit_cast(float, w & 0xffff0000u); }
__device__ __forceinline__ float bf1(bf16 b) { return __builtin_bit_cast(float, (unsigned)b << 16); }
__device__ __forceinline__ void unpack8(const v4u w, float (&v)[8]) { v[0] = bf_lo(w.x); v[1] = bf_hi(w.x); v[2] = bf_lo(w.y); v[3] = bf_hi(w.y); v[4] = bf_lo(w.z); v[5] = bf_hi(w.z); v[6] = bf_lo(w.w); v[7] = bf_hi(w.w); }
__device__ __forceinline__ v4u pack8(const float (&v)[8]) { v4u o; o.x = pk2(v[0], v[1]); o.y = pk2(v[2], v[3]); o.z = pk2(v[4], v[5]); o.w = pk2(v[6], v[7]); return o; }
__device__ __forceinline__ float shx(int lane, float v, int o) { return __builtin_bit_cast(float, __builtin_amdgcn_ds_bpermute((lane ^ o) << 2, __builtin_bit_cast(int, v))); }
__device__ __forceinline__ float shu(int lane, float v, int o) { return __builtin_bit_cast(float, __builtin_amdgcn_ds_bpermute((lane - o) << 2, __builtin_bit_cast(int, v))); }
__device__ __forceinline__ float shi(float v, int idx) { return __builtin_bit_cast(float, __builtin_amdgcn_ds_bpermute(idx << 2, __builtin_bit_cast(int, v))); }
__device__ __forceinline__ float wave_sum_l(int lane, float v) {
#pragma unroll
    for (int o = 1; o < 64; o <<= 1) v += shx(lane, v, o);
    return v;
}
__device__ __forceinline__ float sum16_l(int lane, float v) {
#pragma unroll
    for (int o = 1; o < 16; o <<= 1) v += shx(lane, v, o);
    return v;
}
__device__ __forceinline__ float max16_l(int lane, float v) {
#pragma unroll
    for (int o = 1; o < 16; o <<= 1) v = fmaxf(v, shx(lane, v, o));
    return v;
}
__device__ __forceinline__ float rcp_f(float x) { return __builtin_amdgcn_rcpf(x); }
__device__ __forceinline__ float rsq_f(float x) { return __builtin_amdgcn_rsqf(x); }
__device__ __forceinline__ float sigmoid_f(float x) { return rcp_f(1.0f + __expf(-x)); }
__device__ __forceinline__ float silu_g(float x) { return x * rcp_f(1.0f + __expf(-x)); }
__device__ __forceinline__ float softplus_f(float x) { const float e = __expf(x); return x > 20.f ? x : (e < 0.01f ? e * (1.0f - e * (0.5f - e * (1.0f / 3.0f))) : __logf(1.0f + e)); }
__device__ __forceinline__ f32x4 mfma4(float a, float b, f32x4 c) { return __builtin_amdgcn_mfma_f32_16x16x4f32(a, b, c, 0, 0, 0); }

struct Chunk { int ci, row0, nrows, b; };
__device__ __forceinline__ Chunk chunk_of(int ci) { Chunk c; c.ci = ci; if (ci < NCHP) { c.row0 = 64 * ci; c.nrows = 64; c.b = -1; } else { c.b = ci - NCHP; c.row0 = MP + SSEQ * c.b; c.nrows = SSEQ; } return c; }

__device__ __forceinline__ void tr_item64(const float* W, int ldw, int K, bf16* WT, int k0, int nd0, int ns0, float scale, lf32* scr, int lane) {
    f32x4 wv_[16];
    const int rq = lane >> 4, c4 = (lane & 15) * 4;
#pragma unroll
    for (int i = 0; i < 16; ++i) wv_[i] = *(const f32x4*)(W + (size_t)(k0 + 4 * i + rq) * ldw + ns0 + c4);
#pragma unroll
    for (int i = 0; i < 16; ++i) { lf32* d = scr + (4 * i + rq) * 65 + c4; d[0] = wv_[i].x; d[1] = wv_[i].y; d[2] = wv_[i].z; d[3] = wv_[i].w; }
    LDS_WAIT(); asm volatile("" ::: "memory");
    const int c = lane & 7;
#pragma unroll
    for (int j = 0; j < 8; ++j) { const int n = (lane >> 3) + 8 * j; const lf32* s = scr + (8 * c) * 65 + n;
        v4u o; o.x = pk2(s[0 * 65] * scale, s[1 * 65] * scale); o.y = pk2(s[2 * 65] * scale, s[3 * 65] * scale); o.z = pk2(s[4 * 65] * scale, s[5 * 65] * scale); o.w = pk2(s[6 * 65] * scale, s[7 * 65] * scale);
        *(GAS v4u*)(WT + (size_t)(nd0 + n) * K + k0 + 8 * c) = o; }
    LDS_WAIT(); asm volatile("" ::: "memory");
}
__device__ __forceinline__ void tr_item(const float* W, int ldw, int K, bf16* WT, int k0, int nd0, int ns0, float scale, lf32* scr, int lane) {
    float wv_[32];
#pragma unroll
    for (int i = 0; i < 32; ++i) wv_[i] = W[(size_t)(k0 + 2 * i + (lane >> 5)) * ldw + ns0 + (lane & 31)];
#pragma unroll
    for (int i = 0; i < 32; ++i) scr[(2 * i + (lane >> 5)) * 33 + (lane & 31)] = wv_[i];
    LDS_WAIT(); asm volatile("" ::: "memory");
    const int c = lane & 7;
#pragma unroll
    for (int j = 0; j < 4; ++j) { const int n = (lane >> 3) + 8 * j; const lf32* s = scr + (8 * c) * 33 + n;
        v4u o; o.x = pk2(s[0 * 33] * scale, s[1 * 33] * scale); o.y = pk2(s[2 * 33] * scale, s[3 * 33] * scale); o.z = pk2(s[4 * 33] * scale, s[5 * 33] * scale); o.w = pk2(s[6 * 33] * scale, s[7 * 33] * scale);
        *(GAS v4u*)(WT + (size_t)(nd0 + n) * K + k0 + 8 * c) = o; }
    LDS_WAIT(); asm volatile("" ::: "memory");
}
__device__ __forceinline__ void p0_weights(Frame& F, int l, int gw, int NGW, bool pool) {
    ITEM_IDS();
    lf32* scr = (lf32*)(F.lds + wave_ * 16896);
    constexpr int I_INA = 16 * 28, I_INB = 16 * 40, I_OUT = 16 * 16, I_GU = 16 * 88, I_DN = 44 * 16, I_L = I_INA + I_INB + I_OUT + I_GU + I_DN;
    unsigned char* wl = F.ws + WS_W + (size_t)l * WL_STRIDE;
    for (int it = gw; it < I_L; it += NGW) {
        int r = it;
        if (r < I_INA) { const int kb = r / 28, nb = r % 28, nd0 = 64 * nb; tr_item64(inp(I_WIN) + (size_t)l * D * NIN, NIN, D, (bf16*)(wl + WL_IN), 64 * kb, nd0, nd0, nd0 < 256 ? 0.125f : 1.0f, scr, lane_); continue; } r -= I_INA;
        if (r < I_INB) { const int kb = r / 40, nb = r % 40, nd0 = 1792 + 32 * nb; tr_item(inp(I_WIN) + (size_t)l * D * NIN, NIN, D, (bf16*)(wl + WL_IN), 64 * kb, nd0, nd0 + 4, 1.0f, scr, lane_); continue; } r -= I_INB;
        if (r < I_OUT) { const int kb = r / 16, nb = r % 16; tr_item64(inp(I_WOUT) + (size_t)l * D * D, D, D, (bf16*)(wl + WL_OUT), 64 * kb, 64 * nb, 64 * nb, 1.0f, scr, lane_); continue; } r -= I_OUT;
        if (r < I_GU) { const int kb = r / 88, nb = r % 88, nd0 = 64 * nb, pn = nd0 >> 8, bj = (nd0 >> 7) & 1, c = nd0 & 127; tr_item64(inp(I_WGU) + (size_t)l * D * NGU, NGU, D, (bf16*)(wl + WL_GU), 64 * kb, nd0, bj * DFF + 128 * pn + c, 1.0f, scr, lane_); continue; } r -= I_GU;
        { const int kb = r / 16, nb = r % 16; tr_item64(inp(I_WDN) + (size_t)l * DFF * D, D, DFF, (bf16*)(wl + WL_DN), 64 * kb, 64 * nb, 64 * nb, 1.0f, scr, lane_); }
    }
    if (pool) { const float* pw = inp(I_PW); for (int i = ((int)blockIdx.x) * NTHR + tid_; i < 2 * 4 * 64 * 64; i += ((int)gridDim.x) * NTHR) { const int c = i & 63, d = (i >> 6) & 63, lg = i >> 12; F_WPT[i] = (bf16)f2bf(pw[(size_t)(lg * 64 + c) * 64 + d]); } }
}
template <bool WITH_DT, bool FINAL>
__device__ __forceinline__ void norm_rows(Frame& F, const float* xlo, const float* xhi, const float* w, const float* wdt  ) {
    ITEM_IDS();
    lf32* wl = (lf32*)F.lds;
    if (WITH_DT) { for (int k = tid_; k < D; k += NTHR) { const f32x4 v = *(const f32x4*)(wdt + (size_t)k * NIN + 1792); *(LAS f32x4*)(wl + 4 * k) = v; } __syncthreads(); }
    const int gw = ((int)blockIdx.x) * NWAVES + wave_, NGW = ((int)gridDim.x) * NWAVES;
    f32x4 wv[4];
#pragma unroll
    for (int j = 0; j < 4; ++j) wv[j] = *(const f32x4*)(w + 256 * j + 4 * lane_);
    for (int m0 = gw; m0 < M; m0 += 4 * NGW) {
        f32x4 v[4][4];
#pragma unroll
        for (int q = 0; q < 4; ++q) { const int m = m0 + q * NGW; if (m < M) { const float* xr = (m < MP ? xlo : xhi) + (size_t)m * D;
#pragma unroll
            for (int j = 0; j < 4; ++j) v[q][j] = *(const f32x4*)(xr + 256 * j + 4 * lane_); } }
#pragma unroll
        for (int q = 0; q < 4; ++q) { const int m = m0 + q * NGW; if (m < M) {
            float s = 0.f;
#pragma unroll
            for (int j = 0; j < 4; ++j) s += (v[q][j].x * v[q][j].x + v[q][j].y * v[q][j].y) + (v[q][j].z * v[q][j].z + v[q][j].w * v[q][j].w);
            const float rstd = rsq_f(wave_sum_l(lane_, s) * (1.0f / D) + EPS);
#pragma unroll
            for (int j = 0; j < 4; ++j) v[q][j] = v[q][j] * rstd * wv[j];
            if (FINAL) {
#pragma unroll
                for (int j = 0; j < 4; ++j) *(f32x4*)(F.out + (size_t)m * D + 256 * j + 4 * lane_) = v[q][j];
            } else {
                GAS unsigned long long* o8 = (GAS unsigned long long*)(F_XN + (size_t)m * D) + lane_;
#pragma unroll
                for (int j = 0; j < 4; ++j) o8[64 * j] = (unsigned long long)pk2(v[q][j].x, v[q][j].y) | ((unsigned long long)pk2(v[q][j].z, v[q][j].w) << 32);
            }
            if (WITH_DT) {
                f32x4 a = {0.f, 0.f, 0.f, 0.f};
#pragma unroll
                for (int j = 0; j < 4; ++j) { const LAS f32x4* wp = (const LAS f32x4*)(wl + 4 * (256 * j + 4 * lane_));
                    a += wp[0] * v[q][j].x; a += wp[1] * v[q][j].y; a += wp[2] * v[q][j].z; a += wp[3] * v[q][j].w; }
                a.x = wave_sum_l(lane_, a.x); a.y = wave_sum_l(lane_, a.y); a.z = wave_sum_l(lane_, a.z); a.w = wave_sum_l(lane_, a.w);
                if (lane_ == 0) *(f32x4*)(F_DT + (size_t)m * 4) = a;
            } } }
    }
    if (WITH_DT) __syncthreads();
}
constexpr int PL_RAW = 0, PL_PL = 79 * 256 * 4, PL_END = PL_PL + 64 * 264 * 2;
static_assert(PL_END <= MISC_OFF, "pool LDS map");
__device__ __forceinline__ void pool_item(Frame& F, int layer, int ci) {
    ITEM_IDS();
    const Chunk c = chunk_of(ci);
    lf32* raw = (lf32*)(F.lds + PL_RAW);
    LAS bf16* Pl = (LAS bf16*)(F.lds + PL_PL);
    const float* spool = inp(I_SPOOL) + (size_t)(layer * NSB + (c.b < 0 ? 0 : c.b)) * 15 * 256;
    v4u pw[5]; f32x4 pf[5][2];
#pragma unroll
    for (int q = 0; q < 5; ++q) { const int it = tid_ + q * NTHR; pw[q] = (v4u){0u, 0u, 0u, 0u}; pf[q][0] = (f32x4){0.f, 0.f, 0.f, 0.f}; pf[q][1] = pf[q][0];
        if (it < 79 * 32) { const int rr = it >> 5, cg = it & 31, r = rr - 15;
            if (r < c.nrows) { if (r >= 0 || (c.b < 0 && c.row0 + r >= 0)) pw[q] = *(const v4u*)(F_PROJ + (size_t)(c.row0 + r) * NPROJ + PC_DX + 8 * cg);
                               else if (c.b >= 0) { const float* s = spool + (size_t)(15 + r) * 256 + 8 * cg; pf[q][0] = *(const f32x4*)s; pf[q][1] = *(const f32x4*)(s + 4); } } } }
#pragma unroll
    for (int q = 0; q < 5; ++q) { const int it = tid_ + q * NTHR;
        if (it < 79 * 32) { const int rr = it >> 5, cg = it & 31, r = rr - 15; float v[8];
            if (c.b >= 0 && r < 0) { v[0] = pf[q][0].x; v[1] = pf[q][0].y; v[2] = pf[q][0].z; v[3] = pf[q][0].w; v[4] = pf[q][1].x; v[5] = pf[q][1].y; v[6] = pf[q][1].z; v[7] = pf[q][1].w; } else unpack8(pw[q], v);
            *(LAS f32x4*)(raw + rr * 256 + 8 * cg) = (f32x4){v[0], v[1], v[2], v[3]}; *(LAS f32x4*)(raw + rr * 256 + 8 * cg + 4) = (f32x4){v[4], v[5], v[6], v[7]}; } }
    __syncthreads();
    { const int ch = tid_ & 255, half = tid_ >> 8, win = 2 << (ch >> 6); const float inv = 1.0f / (float)win;
      const lf32* rp = raw + (32 * half + 15) * 256 + ch;
      float s = 0.f; for (int q = 1; q < win; ++q) s += rp[-q * 256];
#pragma unroll 8
      for (int r = 0; r < 32; ++r) { const float x = rp[r * 256], xo = rp[(r - win + 1) * 256]; s += x; Pl[(32 * half + r) * 264 + ch] = (bf16)f2bf(s * inv - x); s -= xo; } }
    __syncthreads();
    const int tb = wave_ >> 1, g0 = 2 * (wave_ & 1), kq = lane_ >> 4, fr = lane_ & 15;
    const bf16* wt = F_WPT + (size_t)layer * 4 * 64 * 64; const float* sc = inp(I_PS) + (size_t)layer * 256;
#pragma unroll
    for (int gg = 0; gg < 2; ++gg) {
        const int g = g0 + gg;
        bf16x8 bw[4][2];
#pragma unroll
        for (int t = 0; t < 4; ++t)
#pragma unroll
            for (int ks = 0; ks < 2; ++ks) bw[t][ks] = *(const bf16x8*)(wt + (size_t)(g * 64 + t * 16 + fr) * 64 + 32 * ks + 8 * kq);
        bf16x8 a[2];
#pragma unroll
        for (int ks = 0; ks < 2; ++ks) a[ks] = *(const LAS bf16x8*)(Pl + (tb * 16 + fr) * 264 + g * 64 + 32 * ks + 8 * kq);
#pragma unroll
        for (int t = 0; t < 4; ++t) { f32x4 acc = {0.f, 0.f, 0.f, 0.f};
#pragma unroll
            for (int ks = 0; ks < 2; ++ks) acc = __builtin_amdgcn_mfma_f32_16x16x32_bf16(a[ks], bw[t][ks], acc, 0, 0, 0);
            const float s = sc[g * 64 + t * 16 + fr];
#pragma unroll
            for (int r = 0; r < 4; ++r) { const int row = tb * 16 + 4 * kq + r; if (row < c.nrows) F_XN[(size_t)(c.row0 + row) * D + 768 + g * 64 + t * 16 + fr] = (bf16)f2bf(acc[r] * s); } }
    }
    __syncthreads();
}

__device__ __forceinline__ void copy_cache(Frame& F, int layer, int b0, int nb) {
    ITEM_IDS();
    const int gt = b0 * NTHR + tid_, GT = nb * NTHR;
    float* out = F.out; const float* ckp = inp(I_CK); const float* cvp = inp(I_CV);
    for (int base = gt; base < 32 * 31744; base += 8 * GT) {
        f32x4 v[8];
#pragma unroll
        for (int q = 0; q < 8; ++q) { const int i = base + q * GT; if (i < 32 * 31744) { const int wb = i / 31744, e = i - wb * 31744; const int which = wb >> 4, b = wb & 15;
            v[q] = *(const f32x4*)((which ? cvp : ckp) + ((size_t)(layer * NSB + b) * 512 + 16) * 256 + 4 * (size_t)e); } }
#pragma unroll
        for (int q = 0; q < 8; ++q) { const int i = base + q * GT; if (i < 32 * 31744) { const int wb = i / 31744, e = i - wb * 31744; const int which = wb >> 4, b = wb & 15;
            *(f32x4*)(out + (which ? O_SV : O_SK) + (size_t)(layer * NSB + b) * 512 * 256 + 4 * (size_t)e) = v[q]; } }
    }
}
__device__ __forceinline__ void copy_small(Frame& F, int layer, int b0, int nb) {
    ITEM_IDS();
    const int gt = b0 * NTHR + tid_, GT = nb * NTHR;
    float* out = F.out;
    constexpr int T_P = 2 * 512 * 32, T_S = 2 * 16 * 16 * 32, T_D = 17 * 15 * 32, T_ALL = T_P + T_S + T_D;
    for (int base = gt; base < T_ALL; base += 4 * GT) {
        v4u w[4];
#pragma unroll
        for (int q = 0; q < 4; ++q) { int t = base + q * GT; if (t < T_ALL) { size_t src;
            if (t < T_P) { const int which = t >> 14, j = (t >> 5) & 511, cg = t & 31; src = (size_t)(MP - 512 + j) * NPROJ + (which ? PC_V : PC_K) + 8 * cg; }
            else if (t < T_P + T_S) { t -= T_P; const int which = t >> 13, b = (t >> 9) & 15, j = (t >> 5) & 15, cg = t & 31; src = (size_t)(MP + 16 * b + j) * NPROJ + (which ? PC_V : PC_K) + 8 * cg; }
            else { t -= T_P + T_S; const int b = t / 480, rr = (t / 32) % 15, cg = t & 31; src = (size_t)(b == 0 ? MP - 15 + rr : MP + 16 * (b - 1) + 1 + rr) * NPROJ + PC_DX + 8 * cg; }
            w[q] = *(const v4u*)(F_PROJ + src); } }
#pragma unroll
        for (int q = 0; q < 4; ++q) { int t = base + q * GT; if (t < T_ALL) { size_t dst;
            if (t < T_P) { const int which = t >> 14, j = (t >> 5) & 511, cg = t & 31; dst = (which ? O_PV : O_PK) + (size_t)layer * 512 * 256 + j * 256 + 8 * cg; }
            else if (t < T_P + T_S) { t -= T_P; const int which = t >> 13, b = (t >> 9) & 15, j = (t >> 5) & 15, cg = t & 31; dst = (which ? O_SV : O_SK) + ((size_t)(layer * NSB + b) * 512 + 496 + j) * 256 + 8 * cg; }
            else { t -= T_P + T_S; const int b = t / 480, rr = (t / 32) % 15, cg = t & 31; dst = (b == 0 ? O_PPOOL + (size_t)layer * 3840 : O_SPOOL + (size_t)(layer * NSB + b - 1) * 3840) + rr * 256 + 8 * cg; }
            float v[8]; unpack8(w[q], v); *(f32x4*)(out + dst) = (f32x4){v[0], v[1], v[2], v[3]}; *(f32x4*)(out + dst + 4) = (f32x4){v[4], v[5], v[6], v[7]}; } }
    }
}
constexpr int KS_LD = 72, PS_LD = 584;
constexpr int AT_KS = 0, AT_VT = 576 * KS_LD * 2, AT_ST = AT_VT + 64 * PS_LD * 2, AT_BIAS = AT_ST + 1024;
static_assert(AT_BIAS + 4 * 260 * 4 <= MISC_OFF, "attention LDS map");
__device__ __forceinline__ void attn_bias_load(Frame& F, int layer) { const float* arel = inp(I_AREL) + (size_t)layer * 257 * 4; lf32* b = (lf32*)(F.lds + AT_BIAS); ITEM_IDS(); for (int i = tid_; i < 257 * 4; i += NTHR) b[260 * (i & 3) + (i >> 2)] = arel[i]; }
__device__ __forceinline__ void attn_item(Frame& F, int layer, int ci, int h) {
    ITEM_IDS();
    const Chunk c = chunk_of(ci);
    LAS bf16* Ks = (LAS bf16*)(F.lds + AT_KS); LAS bf16* Ps = Ks; LAS bf16* Vt = (LAS bf16*)(F.lds + AT_VT);
    lf32* mx = (lf32*)(F.lds + AT_ST); lf32* sm = mx + 128; lf32* bias = (lf32*)(F.lds + AT_BIAS) + 260 * h;
    const int jlo = (c.b < 0) ? (ci < 8 ? 64 * (8 - ci) : 0) : 0;
    const int jval = (c.b < 0) ? 576 : 528;
    const float* ckp = inp(I_CK); const float* cvp = inp(I_CV);
    bf16x8 qa0 = {0, 0, 0, 0, 0, 0, 0, 0}, qa1 = qa0;
    if (c.b < 0 || (wave_ >> 1) == 0) { const bf16* qp = F_PROJ + (size_t)(c.row0 + (wave_ >> 1) * 16 + (lane_ & 15)) * NPROJ + PC_Q + 64 * h + 8 * (lane_ >> 4); qa0 = *(const bf16x8*)qp; qa1 = *(const bf16x8*)(qp + 32); }
    if (c.b < 0) {
        const bf16* kg = F_PROJ + (long)(c.row0 - 512) * NPROJ + PC_K + 64 * h;
        const bf16* vg = F_VTA + (long)(64 * h) * M + (long)(c.row0 - 512);
        const int npc = (576 - jlo) >> 3, nk = (576 - jlo) * 8, nv = 64 * npc;
        v4u kr[9], vr[9];
#pragma unroll
        for (int q = 0; q < 9; ++q) { const int it = tid_ + q * NTHR;
            if (it < nk) kr[q] = *(const v4u*)(kg + (long)(jlo + (it >> 3)) * NPROJ + 8 * (it & 7));
            if (it < nv) { const int d = it / npc, pc = it - d * npc; vr[q] = *(const v4u*)(vg + (long)d * M + jlo + 8 * pc); } }
#pragma unroll
        for (int q = 0; q < 9; ++q) { const int it = tid_ + q * NTHR;
            if (it < nk) *(LAS v4u*)(Ks + (jlo + (it >> 3)) * KS_LD + 8 * (it & 7)) = kr[q];
            if (it < nv) { const int d = it / npc, pc = it - d * npc; *(LAS v4u*)(Vt + d * PS_LD + jlo + 8 * pc) = vr[q]; } }
    } else {
    for (int it = tid_; it < (576 - jlo) * 8; it += NTHR) {
        const int j = jlo + (it >> 3), dg = it & 7;
        v4u kw, vw;
        if (j < 512) { const size_t o = (((size_t)(layer * NSB + c.b) * 512 + j) * 4 + h) * 64 + 8 * dg; const float* kp = ckp + o; const float* vp = cvp + o;
            const f32x4 k0 = *(const f32x4*)kp, k1 = *(const f32x4*)(kp + 4), v0 = *(const f32x4*)vp, v1 = *(const f32x4*)(vp + 4);
            kw.x = pk2(k0.x, k0.y); kw.y = pk2(k0.z, k0.w); kw.z = pk2(k1.x, k1.y); kw.w = pk2(k1.z, k1.w); vw.x = pk2(v0.x, v0.y); vw.y = pk2(v0.z, v0.w); vw.z = pk2(v1.x, v1.y); vw.w = pk2(v1.z, v1.w); }
        else if (j < 528) { const size_t row = (size_t)(c.row0 + j - 512); kw = *(const v4u*)(F_PROJ + row * NPROJ + PC_K + 64 * h + 8 * dg); vw = *(const v4u*)(F_PROJ + row * NPROJ + PC_V + 64 * h + 8 * dg); }
        else { kw = (v4u){0u, 0u, 0u, 0u}; vw = kw; }
        *(LAS v4u*)(Ks + j * KS_LD + 8 * dg) = kw;
        LAS bf16* vt = Vt + (8 * dg) * PS_LD + j;
        vt[0 * PS_LD] = (bf16)(vw.x & 0xffffu); vt[1 * PS_LD] = (bf16)(vw.x >> 16); vt[2 * PS_LD] = (bf16)(vw.y & 0xffffu); vt[3 * PS_LD] = (bf16)(vw.y >> 16);
        vt[4 * PS_LD] = (bf16)(vw.z & 0xffffu); vt[5 * PS_LD] = (bf16)(vw.z >> 16); vt[6 * PS_LD] = (bf16)(vw.w & 0xffffu); vt[7 * PS_LD] = (bf16)(vw.w >> 16);
    }
    }
    __syncthreads();
    const int qb = wave_ >> 1, kh = wave_ & 1, kq = lane_ >> 4, fr = lane_ & 15;
    const bool active = (c.b < 0) || (qb == 0);
    const int ntw = (576 - jlo) / 32;
    const int kbase = jlo + kh * ntw * 16;
    f32x4 s[18];
    float mloc = -3.0e38f;
    const int iq = qb * 16 + fr;
    if (active) {
#pragma unroll
        for (int t = 0; t < 18; ++t) {
            s[t] = (f32x4){0.f, 0.f, 0.f, 0.f};
            if (t < ntw) {
                const LAS bf16* kp = Ks + (kbase + t * 16 + fr) * KS_LD + 8 * kq;
                const bf16x8 kb0 = *(const LAS bf16x8*)kp, kb1 = *(const LAS bf16x8*)(kp + 32);
                s[t] = __builtin_amdgcn_mfma_f32_16x16x32_bf16(kb0, qa0, s[t], 0, 0, 0);
                s[t] = __builtin_amdgcn_mfma_f32_16x16x32_bf16(kb1, qa1, s[t], 0, 0, 0);
#pragma unroll
                for (int r = 0; r < 4; ++r) { const int j = kbase + t * 16 + 4 * kq + r; int rel = 512 + iq - j; rel = rel > 128 ? 128 : rel; float v = s[t][r] + bias[rel + 128]; if (j >= jval) v = -1.0e30f; s[t][r] = v; mloc = fmaxf(mloc, v); }
            }
        }
        mloc = fmaxf(mloc, shx(lane_, mloc, 16)); mloc = fmaxf(mloc, shx(lane_, mloc, 32));
        if (kq == 0) mx[iq * 2 + kh] = mloc;
    }
    __syncthreads();
    if (active) {
        mloc = fmaxf(mx[iq * 2], mx[iq * 2 + 1]);
        float lsum = 0.f;
#pragma unroll
        for (int t = 0; t < 18; ++t) if (t < ntw) {
            const float p0 = __expf(s[t][0] - mloc), p1 = __expf(s[t][1] - mloc), p2 = __expf(s[t][2] - mloc), p3 = __expf(s[t][3] - mloc);
            lsum += (p0 + p1) + (p2 + p3);
            *(LAS f32x2*)(Ps + iq * PS_LD + kbase + t * 16 + 4 * kq) = __builtin_bit_cast(f32x2, (unsigned long long)pk2(p0, p1) | ((unsigned long long)pk2(p2, p3) << 32));
        }
        lsum += shx(lane_, lsum, 16); lsum += shx(lane_, lsum, 32);
        if (kq == 0) sm[iq * 2 + kh] = lsum;
    }
    __syncthreads();
    if (active) {
        f32x4 o[2] = {(f32x4){0.f, 0.f, 0.f, 0.f}, (f32x4){0.f, 0.f, 0.f, 0.f}};
        const int nks = (576 - jlo) / 32;
#pragma unroll 2
        for (int ks = 0; ks < nks; ++ks) {
            const int j0 = jlo + 32 * ks + 8 * kq;
            const bf16x8 pa = *(const LAS bf16x8*)(Ps + iq * PS_LD + j0);
#pragma unroll
            for (int t = 0; t < 2; ++t) { const bf16x8 vb = *(const LAS bf16x8*)(Vt + (kh * 32 + t * 16 + fr) * PS_LD + j0); o[t] = __builtin_amdgcn_mfma_f32_16x16x32_bf16(vb, pa, o[t], 0, 0, 0); }
        }
        const float inv = rcp_f(sm[iq * 2] + sm[iq * 2 + 1]);
#pragma unroll
        for (int t = 0; t < 2; ++t) *(f32x2*)(F_XN + (size_t)(c.row0 + iq) * D + 64 * h + kh * 32 + t * 16 + 4 * kq) =
            __builtin_bit_cast(f32x2, (unsigned long long)pk2(o[t][0] * inv, o[t][1] * inv) | ((unsigned long long)pk2(o[t][2] * inv, o[t][3] * inv) << 32));
    }
    __syncthreads();
}
__device__ __forceinline__ void scan_phase(Frame& F, int layer) {
    ITEM_IDS();
    lf32* db = (lf32*)F.lds; lf32* dcl = db + NCHP * 4;
    for (int i = tid_; i < NCHP * 4; i += NTHR) db[i] = F_DECB[i];
    __syncthreads();
    constexpr int NSCAN = 48;
    if (((int)blockIdx.x) < NSCAN) {
        const int u = ((int)blockIdx.x) * NTHR + tid_;
        if (u < 16384) {
            unsigned* st = (unsigned*)F_STB + u; const int hb = u >> 12;
            float r0 = 0.f, r1 = 0.f;
            for (int c0 = 0; c0 < NCHP; c0 += 64) {
                unsigned sl[64];
#pragma unroll
                for (int i = 0; i < 64; ++i) sl[i] = st[(size_t)(c0 + i) * 16384];
#pragma unroll
                for (int i = 0; i < 64; ++i) { const float d0 = db[(c0 + i) * 4 + hb]; st[(size_t)(c0 + i) * 16384] = pk2(r0, r1); r0 = d0 * r0 + bf_lo(sl[i]); r1 = d0 * r1 + bf_hi(sl[i]); }
            }
            *(f32x2*)(F.out + O_PSSM + (size_t)layer * 32768 + 2 * u) = (f32x2){r0, r1};
        } else {
            const int u2 = u - 16384;
            unsigned* st = (unsigned*)F_STC + u2; const int hk = (u2 >> 11) * 64 + 2 * (u2 & 31); const float* dg = F_DECC + hk;
            float r0 = 0.f, r1 = 0.f;
            for (int c0 = 0; c0 < NCHP; c0 += 32) {
                unsigned sl[32]; f32x2 dd[32];
#pragma unroll
                for (int i = 0; i < 32; ++i) { sl[i] = st[(size_t)(c0 + i) * 8192]; dd[i] = *(const f32x2*)(dg + (size_t)(c0 + i) * 256); }
#pragma unroll
                for (int i = 0; i < 32; ++i) { st[(size_t)(c0 + i) * 8192] = pk2(r0, r1); r0 = dd[i].x * r0 + bf_lo(sl[i]); r1 = dd[i].y * r1 + bf_hi(sl[i]); }
            }
            const int v = (u2 >> 5) & 63; float* o = F.out + O_PHGRN + (size_t)layer * 16384 + (size_t)hk * 64 + v; o[0] = r0; o[64] = r1;
        }
    }
    else {
        const int nb = ((int)gridDim.x) - NSCAN, b0 = ((int)blockIdx.x) - NSCAN;
        copy_small(F, layer, b0, nb);
        const float* sssm = inp(I_SSSM) + (size_t)layer * NSB * 32768; const float* shgrn = inp(I_SHGRN) + (size_t)layer * NSB * 16384;
        float* osb = F.out + O_SSSM + (size_t)layer * NSB * 32768; float* osc = F.out + O_SHGRN + (size_t)layer * NSB * 16384;
        for (int t = b0 * NTHR + tid_; t < NSB * 8192; t += nb * NTHR) {
            const int b = t >> 13, e = (t & 8191) * 4; const f32x4 s0 = *(const f32x4*)(sssm + (size_t)b * 32768 + e); const unsigned long long w = *(const unsigned long long*)(F_STB + (size_t)(NCHP + b) * 32768 + e);
            const float d = F_DECB[(NCHP + b) * 4 + (e >> 13)];
            *(f32x4*)(osb + (size_t)b * 32768 + e) = (f32x4){d * s0.x + bf_lo((unsigned)w), d * s0.y + bf_hi((unsigned)w), d * s0.z + bf_lo((unsigned)(w >> 32)), d * s0.w + bf_hi((unsigned)(w >> 32))}; }
        for (int t = b0 * NTHR + tid_; t < NSB * 4096; t += nb * NTHR) {
            const int b = t >> 12, e2 = (t & 4095) * 4, hk = e2 >> 6, v = e2 & 63; const f32x4 s0 = *(const f32x4*)(shgrn + (size_t)b * 16384 + e2);
            const bf16* sp = F_STC + (size_t)(NCHP + b) * 16384 + (size_t)((hk >> 6) * 64 + v) * 64 + (hk & 63); const float d = F_DECC[(size_t)(NCHP + b) * 256 + hk];
            *(f32x4*)(osc + (size_t)b * 16384 + e2) = (f32x4){d * s0.x + bf1(sp[0]), d * s0.y + bf1(sp[64]), d * s0.z + bf1(sp[128]), d * s0.w + bf1(sp[192])}; }
    }
}
constexpr int SP_XT = 0, SP_BT = 256 * 72 * 2, SP_ACS = 2 * 256 * 72 * 2, SP_DTV = SP_ACS + 1024, SP_SJ = SP_DTV + 1024, SP_END = SP_SJ + 1024;
static_assert(SP_END <= MISC_OFF, "ssd_prep LDS map");
__device__ __forceinline__ void ssd_prep_item(Frame& F, int layer, int ci) {
    ITEM_IDS();
    const Chunk c = chunk_of(ci);
    LAS bf16* XTl = (LAS bf16*)(F.lds + SP_XT); LAS bf16* BTl = (LAS bf16*)(F.lds + SP_BT);
    lf32* acs = (lf32*)(F.lds + SP_ACS); lf32* dtv = (lf32*)(F.lds + SP_DTV); lf32* sj = (lf32*)(F.lds + SP_SJ);
    const int cg = tid_ % 96, seg = tid_ / 96, col = 8 * cg;
    const bool act = seg < 4 && 16 * seg < c.nrows;
    bf16* prow = F_PROJ + (size_t)c.row0 * NPROJ + PC_X + col;
    v4u raw[19];
    if (act) {
#pragma unroll
        for (int q = 0; q < 19; ++q) { const int r = 16 * seg - 3 + q;
            if (r >= 0) raw[q] = *(const v4u*)(prow + (size_t)r * NPROJ);
            else if (c.b < 0) { if (ci > 0) raw[q] = *(const v4u*)(F_HALO + ((size_t)(ci - 1) * 3 + (3 + r)) * 768 + col); else raw[q] = (v4u){0u, 0u, 0u, 0u}; }
            else { const float* s = inp(I_SCONV) + ((size_t)(layer * NSB + c.b) * 3 + (3 + r)) * 768 + col; const f32x4 a = *(const f32x4*)s, b2 = *(const f32x4*)(s + 4);
                raw[q].x = pk2(a.x, a.y); raw[q].y = pk2(a.z, a.w); raw[q].z = pk2(b2.x, b2.y); raw[q].w = pk2(b2.z, b2.w); } }
    }
    if (wave_ == 6) { const int r = lane_; const float* dtb = inp(I_DTB) + layer * 4; const float* alg = inp(I_ALOG) + layer * 4;
        f32x4 raw4 = {0.f, 0.f, 0.f, 0.f}; if (r < c.nrows) raw4 = *(const f32x4*)(F_DT + (size_t)(c.row0 + r) * 4);
        f32x4 dt4, ac4;
#pragma unroll
        for (int h = 0; h < 4; ++h) { float dt = 0.f; if (r < c.nrows) dt = softplus_f(raw4[h] + dtb[h]); float v = -__expf(alg[h]) * dt;
#pragma unroll
            for (int o = 1; o < 64; o <<= 1) { const float t = shu(lane_, v, o); if (lane_ >= o) v += t; }
            const float last = shi(v, 63);
            dt4[h] = dt; ac4[h] = v; acs[r * 4 + h] = v; dtv[r * 4 + h] = dt; sj[h * 64 + r] = dt * __expf(last - v);
            if (r == 63) F_DECB[ci * 4 + h] = __expf(last); }
        if (r < c.nrows) { *(f32x4*)(F_DTV + (size_t)(c.row0 + r) * 4) = dt4; *(f32x4*)(F_ACS + (size_t)(c.row0 + r) * 4) = ac4; } }
    if (c.nrows < 64) { for (int i = tid_; i < 2 * 256 * 72 / 2; i += NTHR) ((LAS unsigned*)XTl)[i] = 0u; }
    asm volatile("s_waitcnt vmcnt(0)" ::: "memory");
    __syncthreads();
    if (act) {
        if (ci == NCHP - 1 && seg == 3) {
#pragma unroll
            for (int q = 0; q < 3; ++q) { float v[8]; unpack8(raw[16 + q], v); float* o = F.out + O_PCONV + (size_t)layer * 2304 + q * 768 + col;
                *(f32x4*)o = (f32x4){v[0], v[1], v[2], v[3]}; *(f32x4*)(o + 4) = (f32x4){v[4], v[5], v[6], v[7]}; } }
        if (c.b >= 0) {
#pragma unroll
            for (int q = 0; q < 3; ++q) { float v[8]; unpack8(raw[16 + q], v); float* o = F.out + O_SCONV + ((size_t)(layer * NSB + c.b) * 3 + q) * 768 + col;
                *(f32x4*)o = (f32x4){v[0], v[1], v[2], v[3]}; *(f32x4*)(o + 4) = (f32x4){v[4], v[5], v[6], v[7]}; } }
        const float* cw = inp(I_CW) + (size_t)layer * 4 * 768 + col; const float* cb = inp(I_CB) + (size_t)layer * 768 + col;
        LAS bf16* tl = (cg < 32) ? XTl + col * 72 : BTl + (col - 256) * 72;
#pragma unroll
        for (int hc = 0; hc < 2; ++hc) {
            float w0[4], w1[4], w2[4], w3[4], bb[4];
#pragma unroll
            for (int e = 0; e < 4; ++e) { bb[e] = cb[4 * hc + e]; w0[e] = cw[4 * hc + e]; w1[e] = cw[768 + 4 * hc + e]; w2[e] = cw[2 * 768 + 4 * hc + e]; w3[e] = cw[3 * 768 + 4 * hc + e]; }
#pragma unroll
            for (int i = 0; i < 16; i += 2) {
                float x[5][4];
#pragma unroll
                for (int q = 0; q < 5; ++q) { const unsigned ua = hc ? raw[i + q].z : raw[i + q].x, ub = hc ? raw[i + q].w : raw[i + q].y; x[q][0] = bf_lo(ua); x[q][1] = bf_hi(ua); x[q][2] = bf_lo(ub); x[q][3] = bf_hi(ub); }
                float ya[4], yb[4];
#pragma unroll
                for (int e = 0; e < 4; ++e) { ya[e] = silu_g(bb[e] + w0[e] * x[0][e] + w1[e] * x[1][e] + w2[e] * x[2][e] + w3[e] * x[3][e]); yb[e] = silu_g(bb[e] + w0[e] * x[1][e] + w1[e] * x[2][e] + w2[e] * x[3][e] + w3[e] * x[4][e]); }
                const int r = 16 * seg + i;
                *(unsigned long long*)(prow + (size_t)r * NPROJ + 4 * hc) = (unsigned long long)pk2(ya[0], ya[1]) | ((unsigned long long)pk2(ya[2], ya[3]) << 32);
                *(unsigned long long*)(prow + (size_t)(r + 1) * NPROJ + 4 * hc) = (unsigned long long)pk2(yb[0], yb[1]) | ((unsigned long long)pk2(yb[2], yb[3]) << 32);
                if (cg < 64) {
#pragma unroll
                    for (int e = 0; e < 4; ++e) *(LAS unsigned*)(tl + (4 * hc + e) * 72 + r) = pk2(ya[e], yb[e]); }
            }
        }
    }
    __syncthreads();
    { const int ch = tid_ >> 1, hf = tid_ & 1; bf16* dst = F_XT + ((size_t)ci * 256 + ch) * 64 + 32 * hf; const LAS bf16* src = XTl + ch * 72 + 32 * hf;
#pragma unroll
      for (int q = 0; q < 4; ++q) *(v4u*)(dst + 8 * q) = *(const LAS v4u*)(src + 8 * q); }
    const int kq = lane_ >> 4, fr = lane_ & 15, h = wave_ >> 1, g = h >> 1;
#pragma unroll
    for (int pi = 0; pi < 2; ++pi) {
        const int pb = 2 * (wave_ & 1) + pi;
        bf16x8 af[2];
#pragma unroll
        for (int ks = 0; ks < 2; ++ks) { float v[8]; unpack8(*(const LAS v4u*)(XTl + (h * 64 + pb * 16 + fr) * 72 + 32 * ks + 8 * kq), v);
#pragma unroll
            for (int e = 0; e < 8; ++e) v[e] *= sj[h * 64 + 32 * ks + 8 * kq + e];
            af[ks] = __builtin_bit_cast(bf16x8, pack8(v)); }
        bf16* dst = F_STB + ((size_t)(ci * 4 + h) * 64 + pb * 16 + 4 * kq) * 128 + fr;
#pragma unroll
        for (int nt = 0; nt < 8; ++nt) {
            f32x4 acc = {0.f, 0.f, 0.f, 0.f};
#pragma unroll
            for (int ks = 0; ks < 2; ++ks) { const bf16x8 bfr = *(const LAS bf16x8*)(BTl + (g * 128 + nt * 16 + fr) * 72 + 32 * ks + 8 * kq); acc = __builtin_amdgcn_mfma_f32_16x16x32_bf16(af[ks], bfr, acc, 0, 0, 0); }
#pragma unroll
            for (int r = 0; r < 4; ++r) dst[r * 128 + nt * 16] = (bf16)f2bf(acc[r]);
        }
    }
    __syncthreads();
}

__device__ __forceinline__ void ssd_out_witem(Frame& F, int layer, int ci, int ib, int wave_, int lane_) {
    const Chunk c = chunk_of(ci);
    const int kq = lane_ >> 4, fr = lane_ & 15;
    constexpr int WSTRIDE = 2560 + 16384; static_assert(8 * WSTRIDE <= MISC_OFF, "per-wave LDS");
    LAS bf16* scr = (LAS bf16*)(F.lds + wave_ * WSTRIDE);
    lf32* ysc = (lf32*)(F.lds + wave_ * WSTRIDE + 2560) + lane_;
    const bf16* P = F_PROJ + (size_t)c.row0 * NPROJ;
    const float* acsg = F_ACS + (size_t)c.row0 * 4; const float* dtg = F_DTV + (size_t)c.row0 * 4;
    const int nks = (ib + 2) >> 1;
    float sq[4] = {0.f, 0.f, 0.f, 0.f};
    const float* bdp = inp(I_BD) + layer * 4;
#pragma unroll
    for (int g = 0; g < 2; ++g) {
        bf16x8 cf[4];
#pragma unroll
        for (int ks = 0; ks < 4; ++ks) cf[ks] = *(const bf16x8*)(P + (size_t)(16 * ib + fr) * NPROJ + PC_C + 128 * g + 32 * ks + 8 * kq);
        f32x4 G[4];
#pragma unroll
        for (int jb = 0; jb < 4; ++jb) { G[jb] = (f32x4){0.f, 0.f, 0.f, 0.f};
            if (jb <= ib) {
#pragma unroll
                for (int ks = 0; ks < 4; ++ks) { const bf16x8 bfr = *(const bf16x8*)(P + (size_t)(16 * jb + fr) * NPROJ + PC_B + 128 * g + 32 * ks + 8 * kq); G[jb] = __builtin_amdgcn_mfma_f32_16x16x32_bf16(cf[ks], bfr, G[jb], 0, 0, 0); } } }
#pragma unroll
        for (int hh = 0; hh < 2; ++hh) {
            const int h = 2 * g + hh;
            float ai[4], ea[4];
#pragma unroll
            for (int r = 0; r < 4; ++r) { ai[r] = acsg[(16 * ib + 4 * kq + r) * 4 + h]; ea[r] = __expf(ai[r]); }
#pragma unroll
            for (int jb = 0; jb < 4; ++jb) { const int j = 16 * jb + fr; float aj = 0.f, dj = 0.f; if (jb <= ib) { aj = acsg[j * 4 + h]; dj = dtg[j * 4 + h]; }
#pragma unroll
                for (int r = 0; r < 4; ++r) { const int i = 16 * ib + 4 * kq + r; const float v = (jb <= ib && j <= i) ? G[jb][r] * __expf(ai[r] - aj) * dj : 0.f; scr[(4 * kq + r) * 72 + j] = (bf16)f2bf(v); } }
            asm volatile("s_waitcnt lgkmcnt(0)" ::: "memory");
            bf16x8 gm[2];
#pragma unroll
            for (int ks = 0; ks < 2; ++ks) gm[ks] = *(const LAS bf16x8*)(scr + fr * 72 + 32 * ks + 8 * kq);
            asm volatile("s_waitcnt lgkmcnt(0)" ::: "memory");
            const bf16* xt = F_XT + ((size_t)ci * 256 + h * 64) * 64;
            const bf16* sin_b = F_STB + (size_t)(ci * 4 + h) * 8192; const float* sin_f = inp(I_SSSM) + (size_t)((layer * NSB + (c.b < 0 ? 0 : c.b)) * 4 + h) * 8192;
#pragma unroll 2
            for (int pt = 0; pt < 4; ++pt) {
                f32x4 a1 = {0.f, 0.f, 0.f, 0.f}, a2 = {0.f, 0.f, 0.f, 0.f};
#pragma unroll
                for (int ks = 0; ks < 2; ++ks) if (ks < nks) { const bf16x8 bfr = *(const bf16x8*)(xt + (size_t)(pt * 16 + fr) * 64 + 32 * ks + 8 * kq); a1 = __builtin_amdgcn_mfma_f32_16x16x32_bf16(gm[ks], bfr, a1, 0, 0, 0); }
#pragma unroll
                for (int ks = 0; ks < 4; ++ks) { bf16x8 bfr;
                    if (c.b < 0) bfr = *(const bf16x8*)(sin_b + (size_t)(pt * 16 + fr) * 128 + 32 * ks + 8 * kq);
                    else { const float* s = sin_f + (size_t)(pt * 16 + fr) * 128 + 32 * ks + 8 * kq; const f32x4 u0 = *(const f32x4*)s, u1 = *(const f32x4*)(s + 4); v4u w; w.x = pk2(u0.x, u0.y); w.y = pk2(u0.z, u0.w); w.z = pk2(u1.x, u1.y); w.w = pk2(u1.z, u1.w); bfr = __builtin_bit_cast(bf16x8, w); }
                    a2 = __builtin_amdgcn_mfma_f32_16x16x32_bf16(cf[ks], bfr, a2, 0, 0, 0); }
                const float dh = bdp[h];
#pragma unroll
                for (int r = 0; r < 4; ++r) { const size_t ro = (size_t)(16 * ib + 4 * kq + r) * NPROJ; const int p = h * 64 + pt * 16 + fr;
                    float y = a1[r] + ea[r] * a2[r] + dh * bf1(P[ro + PC_X + p]);
                    y *= silu_g(bf1(P[ro + PC_Z + p])); ysc[((h * 4 + pt) * 4 + r) * 64] = y; sq[r] += y * y; }
            }
        }
    }
    const float* nw = inp(I_BNRM) + (size_t)layer * 256;
#pragma unroll
    for (int r = 0; r < 4; ++r) { const float rstd = rsq_f(sum16_l(lane_, sq[r]) * (1.0f / 256.0f) + EPS); bf16* o = F_XN + (size_t)(c.row0 + 16 * ib + 4 * kq + r) * D + 256 + fr;
#pragma unroll 4
        for (int q = 0; q < 16; ++q) o[q * 16] = (bf16)f2bf(ysc[(q * 4 + r) * 64] * rstd * nw[q * 16 + fr]); }
}

constexpr int SO_SIN = 0, SO_XT = 4 * 64 * 136 * 2, SO_ACS = SO_XT + 256 * 72 * 2, SO_DTV = SO_ACS + 1024, SO_SS = SO_DTV + 1024, SO_SCR = SO_SS + 512, SO_END = SO_SCR + 8 * 2560;
static_assert(SO_END <= MISC_OFF, "ssd_out_block LDS map");
__device__ __forceinline__ void ssd_out_block(Frame& F, int layer, int ci) {
    ITEM_IDS();
    const int row0 = 64 * ci;
    LAS bf16* SIN = (LAS bf16*)(F.lds + SO_SIN); LAS bf16* XTl = (LAS bf16*)(F.lds + SO_XT);
    lf32* acs = (lf32*)(F.lds + SO_ACS); lf32* dtv = (lf32*)(F.lds + SO_DTV); lf32* ss = (lf32*)(F.lds + SO_SS);
    LAS bf16* scr = (LAS bf16*)(F.lds + SO_SCR + wave_ * 2560);
    const int kq = lane_ >> 4, fr = lane_ & 15, ib = wave_ >> 1, g = wave_ & 1;
    const bf16* P = F_PROJ + (size_t)row0 * NPROJ;
    v4u st[12];
    { const bf16* sg = F_STB + (size_t)ci * 32768; const bf16* xg = F_XT + (size_t)ci * 16384;
#pragma unroll
      for (int q = 0; q < 8; ++q) st[q] = *(const v4u*)(sg + (size_t)(tid_ + q * NTHR) * 8);
#pragma unroll
      for (int q = 0; q < 4; ++q) st[8 + q] = *(const v4u*)(xg + (size_t)(tid_ + q * NTHR) * 8); }
    float a4 = 0.f, d4 = 0.f; if (tid_ < 256) { a4 = F_ACS[(size_t)row0 * 4 + tid_]; d4 = F_DTV[(size_t)row0 * 4 + tid_]; }
    bf16x8 cf[4], bfr[4][4];
#pragma unroll
    for (int ks = 0; ks < 4; ++ks) cf[ks] = *(const bf16x8*)(P + (size_t)(16 * ib + fr) * NPROJ + PC_C + 128 * g + 32 * ks + 8 * kq);
#pragma unroll
    for (int jb = 0; jb < 4; ++jb)
#pragma unroll
        for (int ks = 0; ks < 4; ++ks) { bfr[jb][ks] = (bf16x8){0, 0, 0, 0, 0, 0, 0, 0}; if (jb <= ib) bfr[jb][ks] = *(const bf16x8*)(P + (size_t)(16 * jb + fr) * NPROJ + PC_B + 128 * g + 32 * ks + 8 * kq); }
#pragma unroll
    for (int q = 0; q < 8; ++q) { const int it = tid_ + q * NTHR; *(LAS v4u*)(SIN + (it >> 4) * 136 + 8 * (it & 15)) = st[q]; }
#pragma unroll
    for (int q = 0; q < 4; ++q) { const int it = tid_ + q * NTHR; *(LAS v4u*)(XTl + (it >> 3) * 72 + 8 * (it & 7)) = st[8 + q]; }
    if (tid_ < 256) { acs[tid_] = a4; dtv[tid_] = d4; }
    bf16 zv[2][4][4];
#pragma unroll
    for (int hh = 0; hh < 2; ++hh)
#pragma unroll
        for (int pt = 0; pt < 4; ++pt)
#pragma unroll
            for (int r = 0; r < 4; ++r) zv[hh][pt][r] = P[(size_t)(16 * ib + 4 * kq + r) * NPROJ + PC_Z + (2 * g + hh) * 64 + pt * 16 + fr];
    __syncthreads();
    f32x4 G[4];
#pragma unroll
    for (int jb = 0; jb < 4; ++jb) { G[jb] = (f32x4){0.f, 0.f, 0.f, 0.f};
        if (jb <= ib) {
#pragma unroll
            for (int ks = 0; ks < 4; ++ks) G[jb] = __builtin_amdgcn_mfma_f32_16x16x32_bf16(cf[ks], bfr[jb][ks], G[jb], 0, 0, 0); } }
    const int nks = (ib + 2) >> 1;
    const float* bdp = inp(I_BD) + layer * 4;
    f32x4 yv[2][4]; float sq[4] = {0.f, 0.f, 0.f, 0.f};
#pragma unroll
    for (int hh = 0; hh < 2; ++hh) {
        const int h = 2 * g + hh;
        float ai[4], ea[4];
#pragma unroll
        for (int r = 0; r < 4; ++r) { ai[r] = acs[(16 * ib + 4 * kq + r) * 4 + h]; ea[r] = __expf(ai[r]); }
#pragma unroll
        for (int jb = 0; jb < 4; ++jb) { const int j = 16 * jb + fr; const float aj = acs[j * 4 + h], dj = dtv[j * 4 + h];
#pragma unroll
            for (int r = 0; r < 4; ++r) { const int i = 16 * ib + 4 * kq + r; const float v = (jb <= ib && j <= i) ? G[jb][r] * __expf(ai[r] - aj) * dj : 0.f; scr[(4 * kq + r) * 72 + j] = (bf16)f2bf(v); } }
        asm volatile("s_waitcnt lgkmcnt(0)" ::: "memory");
        bf16x8 gm[2];
#pragma unroll
        for (int ks = 0; ks < 2; ++ks) gm[ks] = *(const LAS bf16x8*)(scr + fr * 72 + 32 * ks + 8 * kq);
        asm volatile("s_waitcnt lgkmcnt(0)" ::: "memory");
        const float dh = bdp[h];
#pragma unroll
        for (int pt = 0; pt < 4; ++pt) {
            f32x4 a1 = {0.f, 0.f, 0.f, 0.f}, a2 = {0.f, 0.f, 0.f, 0.f};
            const LAS bf16* xr = XTl + (h * 64 + pt * 16 + fr) * 72; const LAS bf16* sr = SIN + (h * 64 + pt * 16 + fr) * 136;
#pragma unroll
            for (int ks = 0; ks < 2; ++ks) if (ks < nks) a1 = __builtin_amdgcn_mfma_f32_16x16x32_bf16(gm[ks], *(const LAS bf16x8*)(xr + 32 * ks + 8 * kq), a1, 0, 0, 0);
#pragma unroll
            for (int ks = 0; ks < 4; ++ks) a2 = __builtin_amdgcn_mfma_f32_16x16x32_bf16(cf[ks], *(const LAS bf16x8*)(sr + 32 * ks + 8 * kq), a2, 0, 0, 0);
            const unsigned long long xw = *(const LAS unsigned long long*)(xr + 16 * ib + 4 * kq);
            const float xx[4] = {bf_lo((unsigned)xw), bf_hi((unsigned)xw), bf_lo((unsigned)(xw >> 32)), bf_hi((unsigned)(xw >> 32))};
#pragma unroll
            for (int r = 0; r < 4; ++r) { float y = a1[r] + ea[r] * a2[r] + dh * xx[r]; y *= silu_g(bf1(zv[hh][pt][r])); yv[hh][pt][r] = y; sq[r] += y * y; }
        }
    }
#pragma unroll
    for (int r = 0; r < 4; ++r) { const float q = sum16_l(lane_, sq[r]); if (fr == 0) ss[(16 * ib + 4 * kq + r) * 2 + g] = q; }
    __syncthreads();
    const float* nw = inp(I_BNRM) + (size_t)layer * 256 + 128 * g;
#pragma unroll
    for (int r = 0; r < 4; ++r) { const int i = 16 * ib + 4 * kq + r; const float rstd = rsq_f((ss[i * 2] + ss[i * 2 + 1]) * (1.0f / 256.0f) + EPS); bf16* o = F_XN + (size_t)(row0 + i) * D + 256 + 128 * g + fr;
#pragma unroll
        for (int hh = 0; hh < 2; ++hh)
#pragma unroll
            for (int pt = 0; pt < 4; ++pt) o[hh * 64 + pt * 16] = (bf16)f2bf(yv[hh][pt][r] * rstd * nw[hh * 64 + pt * 16 + fr]); }
    __syncthreads();
}
constexpr int HP_KT = 0, HP_VT = 256 * 72 * 2, HP_HT = 2 * 256 * 72 * 2, HP_END = HP_HT + 4 * 256 * 4;
static_assert(HP_END <= MISC_OFF, "hgrn_prep LDS map");
__device__ __forceinline__ void hgrn_prep_item(Frame& F, int layer, int ci) {
    ITEM_IDS();
    const Chunk c = chunk_of(ci);
    LAS bf16* KTl = (LAS bf16*)(F.lds + HP_KT); LAS bf16* VTl = (LAS bf16*)(F.lds + HP_VT);
    lf32* ht = (lf32*)(F.lds + HP_HT);
    const int cp = tid_ & 127, qt = tid_ >> 7;
    float lb0 = 0.f, lb1 = 0.f; if (layer != 0) { const float* lbp = inp(I_LB) + 2 * cp; lb0 = rcp_f(1.0f + __expf(lbp[0] - lbp[256])); lb1 = rcp_f(1.0f + __expf(lbp[1] - lbp[257])); }
    bf16* pq = F_PROJ + (size_t)(c.row0 + 16 * qt) * NPROJ + PC_CQ + 2 * cp;
    const bool act = 16 * qt < c.nrows;
    unsigned rq[16], rf[16], rv[16];
#pragma unroll
    for (int i = 0; i < 16; ++i) { rq[i] = 0u; rf[i] = 0u; rv[i] = 0u; if (act) { const unsigned* p = (const unsigned*)(pq + (size_t)i * NPROJ); rq[i] = p[0]; rf[i] = p[128]; rv[i] = p[256]; } }
    float b0[16], b1[16], k0[16], k1[16];
    float run0 = 0.f, run1 = 0.f;
#pragma unroll
    for (int i = 0; i < 16; ++i) { float g0 = 0.f, g1 = 0.f; k0[i] = 0.f; k1[i] = 0.f;
        if (act) { const float e0 = __expf(-bf_lo(rf[i])), e1 = __expf(-bf_hi(rf[i])); const float d0 = rcp_f(1.0f + e0), d1 = rcp_f(1.0f + e1);
            g0 = __logf(lb0 + (1.0f - lb0) * d0); g1 = __logf(lb1 + (1.0f - lb1) * d1); k0[i] = (1.0f - lb0) * e0 * d0; k1[i] = (1.0f - lb1) * e1 * d1; }
        run0 += g0; run1 += g1; b0[i] = run0; b1[i] = run1; }
    *(LAS f32x2*)(ht + qt * 256 + 2 * cp) = (f32x2){run0, run1};
    __syncthreads();
    float pre0 = 0.f, pre1 = 0.f, last0 = 0.f, last1 = 0.f;
#pragma unroll
    for (int q = 0; q < 4; ++q) { const f32x2 t = *(const LAS f32x2*)(ht + q * 256 + 2 * cp); if (q < qt) { pre0 += t.x; pre1 += t.y; } last0 += t.x; last1 += t.y; }
    { float* Rg = F_RH + (size_t)ci * 1280 + 2 * cp; *(f32x2*)(Rg + qt * 256) = (f32x2){pre0, pre1};
      if (qt == 3) { *(f32x2*)(Rg + 1024) = (f32x2){last0, last1}; *(f32x2*)(F_DECC + (size_t)ci * 256 + 2 * cp) = (f32x2){__expf(last0), __expf(last1)}; } }
    const float e0 = run0, e1 = run1;
#pragma unroll
    for (int i = 0; i < 16; i += 2) {
        unsigned kt0, kt1;
#pragma unroll
        for (int q = 0; q < 2; ++q) { const int ii = i + q;
            const float qe0 = bf_lo(rq[ii]) * __expf(b0[ii]), qe1 = bf_hi(rq[ii]) * __expf(b1[ii]);
            const float ke0 = k0[ii] * __expf(e0 - b0[ii]), ke1 = k1[ii] * __expf(e1 - b1[ii]);
            const float kd0 = k0[ii] * __expf(fminf(-b0[ii], 80.f)), kd1 = k1[ii] * __expf(fminf(-b1[ii], 80.f));
            if (act && 16 * qt + ii < c.nrows) { unsigned* p = (unsigned*)(pq + (size_t)ii * NPROJ); p[0] = pk2(qe0, qe1); p[128] = pk2(ke0, ke1); p[256] = pk2(kd0, kd1); }
            const float t0 = k0[ii] * __expf(last0 - pre0 - b0[ii]), t1 = k1[ii] * __expf(last1 - pre1 - b1[ii]);
            if (q == 0) { kt0 = f2bf(t0); kt1 = f2bf(t1); } else { kt0 |= f2bf(t0) << 16; kt1 |= f2bf(t1) << 16; } }
        const int j = 16 * qt + i;
        *(LAS unsigned*)(KTl + (2 * cp) * 72 + j) = kt0; *(LAS unsigned*)(KTl + (2 * cp + 1) * 72 + j) = kt1;
        *(LAS unsigned*)(VTl + (2 * cp) * 72 + j) = (rv[i] & 0xffffu) | (rv[i + 1] << 16); *(LAS unsigned*)(VTl + (2 * cp + 1) * 72 + j) = (rv[i] >> 16) | (rv[i + 1] & 0xffff0000u);
    }
    __syncthreads();
    { const int c2 = tid_ >> 1, hf = tid_ & 1; bf16* dst = F_VT + ((size_t)ci * 256 + c2) * 64 + 32 * hf; const LAS bf16* src = VTl + c2 * 72 + 32 * hf;
#pragma unroll
      for (int q = 0; q < 4; ++q) *(v4u*)(dst + 8 * q) = *(const LAS v4u*)(src + 8 * q); }
    const int kq = lane_ >> 4, fr = lane_ & 15, h = wave_ >> 1;
#pragma unroll
    for (int vi = 0; vi < 2; ++vi) {
        const int vb = 2 * (wave_ & 1) + vi;
        bf16x8 af[2];
#pragma unroll
        for (int ks = 0; ks < 2; ++ks) af[ks] = *(const LAS bf16x8*)(VTl + (h * 64 + vb * 16 + fr) * 72 + 32 * ks + 8 * kq);
        bf16* dst = F_STC + ((size_t)(ci * 4 + h) * 64 + vb * 16 + 4 * kq) * 64 + fr;
#pragma unroll
        for (int kb = 0; kb < 4; ++kb) {
            f32x4 acc = {0.f, 0.f, 0.f, 0.f};
#pragma unroll
            for (int ks = 0; ks < 2; ++ks) { const bf16x8 bfr = *(const LAS bf16x8*)(KTl + (h * 64 + kb * 16 + fr) * 72 + 32 * ks + 8 * kq); acc = __builtin_amdgcn_mfma_f32_16x16x32_bf16(af[ks], bfr, acc, 0, 0, 0); }
#pragma unroll
            for (int r = 0; r < 4; ++r) dst[r * 64 + kb * 16] = (bf16)f2bf(acc[r]);
        }
    }
    __syncthreads();
}

__device__ __forceinline__ void hgrn_out_witem(Frame& F, int layer, int ci, int h, int ib, int wave_, int lane_) {
    const Chunk c = chunk_of(ci);
    const int kq = lane_ >> 4, fr = lane_ & 15;
    LAS bf16* scr = (LAS bf16*)(F.lds + wave_ * (2560 + 16384));
    const bf16* P = F_PROJ + (size_t)c.row0 * NPROJ + h * 64;
    const float* Rg = F_RH + (size_t)ci * 1280 + h * 64;
    bf16x8 qf[2]; float qv[2][8], rI[2][8];
#pragma unroll
    for (int ks = 0; ks < 2; ++ks) { qf[ks] = *(const bf16x8*)(P + (size_t)(16 * ib + fr) * NPROJ + PC_CQ + 32 * ks + 8 * kq); unpack8(__builtin_bit_cast(v4u, qf[ks]), qv[ks]);
        const float* rp = Rg + ib * 256 + 32 * ks + 8 * kq; const f32x4 a = *(const f32x4*)rp, b2 = *(const f32x4*)(rp + 4);
        rI[ks][0] = a.x; rI[ks][1] = a.y; rI[ks][2] = a.z; rI[ks][3] = a.w; rI[ks][4] = b2.x; rI[ks][5] = b2.y; rI[ks][6] = b2.z; rI[ks][7] = b2.w; }
#pragma unroll
    for (int J = 0; J < 4; ++J) {
        f32x4 acc = {0.f, 0.f, 0.f, 0.f};
        if (J <= ib) {
#pragma unroll
            for (int ks = 0; ks < 2; ++ks) {
                bf16x8 a = qf[ks];
                if (J < ib) { const float* rp = Rg + (J + 1) * 256 + 32 * ks + 8 * kq; const f32x4 u0 = *(const f32x4*)rp, u1 = *(const f32x4*)(rp + 4); const float rj[8] = {u0.x, u0.y, u0.z, u0.w, u1.x, u1.y, u1.z, u1.w};
                    float v[8];
#pragma unroll
                    for (int e = 0; e < 8; ++e) v[e] = qv[ks][e] * __expf(rI[ks][e] - rj[e]);
                    a = __builtin_bit_cast(bf16x8, pack8(v)); }
                const bf16x8 bfr = *(const bf16x8*)(P + (size_t)(16 * J + fr) * NPROJ + (J < ib ? PC_CF : PC_CI) + 32 * ks + 8 * kq);
                acc = __builtin_amdgcn_mfma_f32_16x16x32_bf16(a, bfr, acc, 0, 0, 0);
            }
        }
#pragma unroll
        for (int r = 0; r < 4; ++r) { const int i = 4 * kq + r, j = fr; const float v = (J < ib || (J == ib && j <= i)) ? acc[r] : 0.f; scr[(4 * kq + r) * 72 + 16 * J + fr] = (bf16)f2bf(v); }
    }
    asm volatile("s_waitcnt lgkmcnt(0)" ::: "memory");
    bf16x8 ga[2];
#pragma unroll
    for (int ks = 0; ks < 2; ++ks) ga[ks] = *(const LAS bf16x8*)(scr + fr * 72 + 32 * ks + 8 * kq);
    asm volatile("s_waitcnt lgkmcnt(0)" ::: "memory");
    bf16x8 qs[2];
#pragma unroll
    for (int ks = 0; ks < 2; ++ks) { float v[8];
#pragma unroll
        for (int e = 0; e < 8; ++e) v[e] = qv[ks][e] * __expf(rI[ks][e]);
        qs[ks] = __builtin_bit_cast(bf16x8, pack8(v)); }
    const int nks = (ib + 2) >> 1;
    const bf16* vt = F_VT + ((size_t)ci * 256 + h * 64) * 64;
    const bf16* sin_b = F_STC + (size_t)(ci * 4 + h) * 4096; const float* sin_f = inp(I_SHGRN) + (size_t)((layer * NSB + (c.b < 0 ? 0 : c.b)) * 4 + h) * 4096;
    f32x4 o[4]; float sq[4] = {0.f, 0.f, 0.f, 0.f};
#pragma unroll
    for (int t = 0; t < 4; ++t) {
        o[t] = (f32x4){0.f, 0.f, 0.f, 0.f};
#pragma unroll
        for (int ks = 0; ks < 2; ++ks) if (ks < nks) { const bf16x8 bfr = *(const bf16x8*)(vt + (size_t)(t * 16 + fr) * 64 + 32 * ks + 8 * kq); o[t] = __builtin_amdgcn_mfma_f32_16x16x32_bf16(ga[ks], bfr, o[t], 0, 0, 0); }
#pragma unroll
        for (int ks = 0; ks < 2; ++ks) { bf16x8 bfr;
            if (c.b < 0) bfr = *(const bf16x8*)(sin_b + (size_t)(t * 16 + fr) * 64 + 32 * ks + 8 * kq);
            else { float v[8];
#pragma unroll
                for (int e = 0; e < 8; ++e) v[e] = sin_f[(size_t)(32 * ks + 8 * kq + e) * 64 + t * 16 + fr];
                bfr = __builtin_bit_cast(bf16x8, pack8(v)); }
            o[t] = __builtin_amdgcn_mfma_f32_16x16x32_bf16(qs[ks], bfr, o[t], 0, 0, 0); }
#pragma unroll
        for (int r = 0; r < 4; ++r) sq[r] += o[t][r] * o[t][r];
    }
    const float* nw = inp(I_CNRM) + (size_t)layer * 256 + h * 64;
#pragma unroll
    for (int r = 0; r < 4; ++r) { const float rstd = rsq_f(sum16_l(lane_, sq[r]) * (1.0f / 64.0f) + EPS); const size_t row = (size_t)(16 * ib + 4 * kq + r);
#pragma unroll
        for (int t = 0; t < 4; ++t) { const int v = t * 16 + fr; const float cg = bf1(P[row * NPROJ + PC_CG + v]);
            F_XN[(size_t)(c.row0 + row) * D + 512 + h * 64 + v] = (bf16)f2bf(o[t][r] * rstd * nw[v] * silu_g(cg)); } }
}

constexpr int HO_KE = 0, HO_VT = 64 * 264 * 2, HO_SIN = HO_VT + 256 * 72 * 2, HO_R = HO_SIN + 256 * 72 * 2, HO_SCR = HO_R + 1280 * 4, HO_END = HO_SCR + 8 * 2304;
static_assert(HO_END <= MISC_OFF, "hgrn_out_block LDS map");
__device__ __forceinline__ void hgrn_out_block(Frame& F, int layer, int ci) {
    ITEM_IDS();
    const int row0 = 64 * ci;
    LAS bf16* KEl = (LAS bf16*)(F.lds + HO_KE); LAS bf16* VTl = (LAS bf16*)(F.lds + HO_VT); LAS bf16* SIN = (LAS bf16*)(F.lds + HO_SIN); lf32* Rl = (lf32*)(F.lds + HO_R);
    LAS bf16* scr = (LAS bf16*)(F.lds + HO_SCR + wave_ * 2304);
    const int kq = lane_ >> 4, fr = lane_ & 15, h = wave_ >> 1, ib0 = 2 * (wave_ & 1);
    const bf16* P = F_PROJ + (size_t)row0 * NPROJ;
    v4u st[13];
    { const bf16* kg = P + PC_CF; const bf16* vg = F_VT + (size_t)ci * 16384; const bf16* sg = F_STC + (size_t)ci * 16384; const float* rg = F_RH + (size_t)ci * 1280;
#pragma unroll
      for (int q = 0; q < 4; ++q) { const int it = tid_ + q * NTHR; st[q] = *(const v4u*)(kg + (size_t)(it >> 5) * NPROJ + 8 * (it & 31)); }
#pragma unroll
      for (int q = 0; q < 4; ++q) st[4 + q] = *(const v4u*)(vg + (size_t)(tid_ + q * NTHR) * 8);
#pragma unroll
      for (int q = 0; q < 4; ++q) st[8 + q] = *(const v4u*)(sg + (size_t)(tid_ + q * NTHR) * 8);
      st[12] = (v4u){0u, 0u, 0u, 0u}; if (tid_ < 320) st[12] = *(const v4u*)(rg + 4 * tid_); }
    bf16x8 qf[2][2], kd[2][2];
#pragma unroll
    for (int bi = 0; bi < 2; ++bi)
#pragma unroll
        for (int ks = 0; ks < 2; ++ks) { const bf16* p = P + (size_t)(16 * (ib0 + bi) + fr) * NPROJ + h * 64 + 32 * ks + 8 * kq; qf[bi][ks] = *(const bf16x8*)(p + PC_CQ); kd[bi][ks] = *(const bf16x8*)(p + PC_CI); }
#pragma unroll
    for (int q = 0; q < 4; ++q) { const int it = tid_ + q * NTHR; *(LAS v4u*)(KEl + (it >> 5) * 264 + 8 * (it & 31)) = st[q]; }
#pragma unroll
    for (int q = 0; q < 4; ++q) { const int it = tid_ + q * NTHR; *(LAS v4u*)(VTl + (it >> 3) * 72 + 8 * (it & 7)) = st[4 + q]; *(LAS v4u*)(SIN + (it >> 3) * 72 + 8 * (it & 7)) = st[8 + q]; }
    if (tid_ < 320) *(LAS v4u*)(Rl + 4 * tid_) = st[12];
    bf16 cgv[2][4][4];
#pragma unroll
    for (int bi = 0; bi < 2; ++bi)
#pragma unroll
        for (int t = 0; t < 4; ++t)
#pragma unroll
            for (int r = 0; r < 4; ++r) cgv[bi][t][r] = P[(size_t)(16 * (ib0 + bi) + 4 * kq + r) * NPROJ + PC_CG + h * 64 + t * 16 + fr];
    __syncthreads();
    const float* nw = inp(I_CNRM) + (size_t)layer * 256 + h * 64;
#pragma unroll
    for (int bi = 0; bi < 2; ++bi) {
        const int ib = ib0 + bi;
        float qv[2][8], rI[2][8];
#pragma unroll
        for (int ks = 0; ks < 2; ++ks) { unpack8(__builtin_bit_cast(v4u, qf[bi][ks]), qv[ks]); const lf32* rp = Rl + ib * 256 + h * 64 + 32 * ks + 8 * kq;
#pragma unroll
            for (int e = 0; e < 8; ++e) rI[ks][e] = rp[e]; }
#pragma unroll
        for (int J = 0; J < 4; ++J) {
            f32x4 acc = {0.f, 0.f, 0.f, 0.f};
            if (J <= ib) {
#pragma unroll
                for (int ks = 0; ks < 2; ++ks) {
                    bf16x8 a = qf[bi][ks], bfr = kd[bi][ks];
                    if (J < ib) { const lf32* rp = Rl + (J + 1) * 256 + h * 64 + 32 * ks + 8 * kq; float v[8];
#pragma unroll
                        for (int e = 0; e < 8; ++e) v[e] = qv[ks][e] * __expf(rI[ks][e] - rp[e]);
                        a = __builtin_bit_cast(bf16x8, pack8(v)); bfr = *(const LAS bf16x8*)(KEl + (16 * J + fr) * 264 + h * 64 + 32 * ks + 8 * kq); }
                    acc = __builtin_amdgcn_mfma_f32_16x16x32_bf16(a, bfr, acc, 0, 0, 0);
                }
            }
#pragma unroll
            for (int r = 0; r < 4; ++r) { const int i = 4 * kq + r, j = fr; const float v = (J < ib || (J == ib && j <= i)) ? acc[r] : 0.f; scr[(4 * kq + r) * 72 + 16 * J + fr] = (bf16)f2bf(v); }
        }
        asm volatile("s_waitcnt lgkmcnt(0)" ::: "memory");
        bf16x8 ga[2];
#pragma unroll
        for (int ks = 0; ks < 2; ++ks) ga[ks] = *(const LAS bf16x8*)(scr + fr * 72 + 32 * ks + 8 * kq);
        asm volatile("s_waitcnt lgkmcnt(0)" ::: "memory");
        bf16x8 qs[2];
#pragma unroll
        for (int ks = 0; ks < 2; ++ks) { float v[8];
#pragma unroll
            for (int e = 0; e < 8; ++e) v[e] = qv[ks][e] * __expf(rI[ks][e]);
            qs[ks] = __builtin_bit_cast(bf16x8, pack8(v)); }
        const int nks = (ib + 2) >> 1;
        f32x4 o[4]; float sq[4] = {0.f, 0.f, 0.f, 0.f};
#pragma unroll
        for (int t = 0; t < 4; ++t) {
            o[t] = (f32x4){0.f, 0.f, 0.f, 0.f};
#pragma unroll
            for (int ks = 0; ks < 2; ++ks) if (ks < nks) o[t] = __builtin_amdgcn_mfma_f32_16x16x32_bf16(ga[ks], *(const LAS bf16x8*)(VTl + (h * 64 + t * 16 + fr) * 72 + 32 * ks + 8 * kq), o[t], 0, 0, 0);
#pragma unroll
            for (int ks = 0; ks < 2; ++ks) o[t] = __builtin_amdgcn_mfma_f32_16x16x32_bf16(qs[ks], *(const LAS bf16x8*)(SIN + (h * 64 + t * 16 + fr) * 72 + 32 * ks + 8 * kq), o[t], 0, 0, 0);
#pragma unroll
            for (int r = 0; r < 4; ++r) sq[r] += o[t][r] * o[t][r];
        }
#pragma unroll
        for (int r = 0; r < 4; ++r) { const float rstd = rsq_f(sum16_l(lane_, sq[r]) * (1.0f / 64.0f) + EPS); bf16* op = F_XN + (size_t)(row0 + 16 * ib + 4 * kq + r) * D + 512 + h * 64 + fr;
#pragma unroll
            for (int t = 0; t < 4; ++t) op[t * 16] = (bf16)f2bf(o[t][r] * rstd * nw[t * 16 + fr] * silu_g(bf1(cgv[bi][t][r]))); }
    }
    __syncthreads();
}
template <int MODE>
__device__ __forceinline__ void mini_gemm(Frame& F, const bf16* A, const bf16* Bt, int K, int ncb, bf16* O, int ldo, const float* res, float* C, const float* nw = nullptr, bf16* xo = nullptr, float* rs = nullptr) {
    ITEM_IDS();
    const int kq = lane_ >> 4, fr = lane_ & 15;
    for (int wi = ((int)blockIdx.x) * NWAVES + wave_; wi < 16 * ncb; wi += ((int)gridDim.x) * NWAVES) {
        const int rb = wi & 15, cb = wi >> 4;
        const bf16* ap = A + (size_t)(MP + 16 * rb + fr) * K + 8 * kq;
        const int c = 16 * cb + fr;
        const bf16* bp = Bt + (size_t)(MODE == 2 ? ((c >> 7) * 256 + (c & 127)) : c) * K + 8 * kq;
        f32x4 acc0 = {0.f, 0.f, 0.f, 0.f}, acc1 = {0.f, 0.f, 0.f, 0.f};
#pragma unroll 8
        for (int k0 = 0; k0 < K; k0 += 32) {
            const bf16x8 a = *(const bf16x8*)(ap + k0), b0 = *(const bf16x8*)(bp + k0);
            acc0 = __builtin_amdgcn_mfma_f32_16x16x32_bf16(a, b0, acc0, 0, 0, 0);
            if (MODE == 2) { const bf16x8 b1 = *(const bf16x8*)(bp + (size_t)128 * K + k0); acc1 = __builtin_amdgcn_mfma_f32_16x16x32_bf16(a, b1, acc1, 0, 0, 0); }
        }
#pragma unroll
        for (int r = 0; r < 4; ++r) { const size_t row = (size_t)(MP + 16 * rb + 4 * kq + r);
            if (MODE == 0) { const bf16 ob = (bf16)f2bf(acc0[r]); O[row * ldo + c] = ob; if (c >= PC_V && c < PC_V + 256) F_VTA[(size_t)(c - PC_V) * M + row] = ob; }
            if (MODE == 1) { const float x = res[row * 1024 + c] + acc0[r]; C[row * 1024 + c] = x;
                if (nw) { xo[row * 1024 + c] = (bf16)f2bf(x * nw[c]); const float q = sum16_l(lane_, x * x); if (fr == 0) atomicAdd(rs + row, q); } }
            if (MODE == 2) O[row * ldo + c] = (bf16)f2bf(silu_g(acc0[r]) * acc1[r]); }
    }
}

template <int MODE, int KS>
__device__ __forceinline__ void mini_gemm2(Frame& F, const bf16* A, const bf16* Bt, int K, int ncb32, bf16* O, int ldo, const float* res, float* C, const float* nw = nullptr, bf16* xo = nullptr, float* rs = nullptr) {
    ITEM_IDS();
    const int kq = lane_ >> 4, fr = lane_ & 15;
    LAS f32x4* red = (LAS f32x4*)F.lds;
    for (int it = (int)blockIdx.x; it < 8 * ncb32; it += (int)gridDim.x) {
        const int rb = it & 7, cb = it >> 3;
        const bf16* ap = A + (size_t)(MP + 32 * rb + fr) * K + wave_ * (KS * 32) + 8 * kq;
        const bf16* bp = Bt + (size_t)(32 * cb + fr) * K + wave_ * (KS * 32) + 8 * kq;
        f32x4 acc[2][2] = {{(f32x4){0.f, 0.f, 0.f, 0.f}, (f32x4){0.f, 0.f, 0.f, 0.f}}, {(f32x4){0.f, 0.f, 0.f, 0.f}, (f32x4){0.f, 0.f, 0.f, 0.f}}};
#pragma unroll (KS > 6 ? 6 : KS)
        for (int ks = 0; ks < KS; ++ks) {
            bf16x8 a[2], b[2];
#pragma unroll
            for (int i = 0; i < 2; ++i) { a[i] = *(const bf16x8*)(ap + (size_t)(16 * i) * K + 32 * ks); b[i] = *(const bf16x8*)(bp + (size_t)(16 * i) * K + 32 * ks); }
#pragma unroll
            for (int i = 0; i < 2; ++i)
#pragma unroll
                for (int j = 0; j < 2; ++j) acc[i][j] = __builtin_amdgcn_mfma_f32_16x16x32_bf16(a[i], b[j], acc[i][j], 0, 0, 0);
        }
#pragma unroll
        for (int i = 0; i < 2; ++i)
#pragma unroll
            for (int j = 0; j < 2; ++j) red[(wave_ * 4 + 2 * i + j) * 64 + lane_] = acc[i][j];
        __syncthreads();
        if (wave_ < 4) {
            const int qi = wave_ >> 1, qj = wave_ & 1;
            f32x4 s = red[wave_ * 64 + lane_];
#pragma unroll
            for (int w = 1; w < 8; ++w) s += red[(w * 4 + wave_) * 64 + lane_];
            const int c = 32 * cb + 16 * qj + fr;
#pragma unroll
            for (int r = 0; r < 4; ++r) { const size_t row = (size_t)(MP + 32 * rb + 16 * qi + 4 * kq + r);
                if (MODE == 0) { const bf16 ob = (bf16)f2bf(s[r]); O[row * ldo + c] = ob; if (c >= PC_V && c < PC_V + 256) F_VTA[(size_t)(c - PC_V) * M + row] = ob; }
                if (MODE == 1) { const float x = res[row * 1024 + c] + s[r]; C[row * 1024 + c] = x;
                    if (nw) { xo[row * 1024 + c] = (bf16)f2bf(x * nw[c]); const float q = sum16_l(lane_, x * x); if (fr == 0) atomicAdd(rs + row, q); } } }
        }
        __syncthreads();
    }
}
__device__ __forceinline__ void sample_mix_item(Frame& F, int layer, int b) {
    ssd_prep_item(F, layer, NCHP + b);
    hgrn_prep_item(F, layer, NCHP + b);
    asm volatile("s_waitcnt vmcnt(0)" ::: "memory");
    __syncthreads();
    __builtin_amdgcn_fence(__ATOMIC_ACQUIRE, "agent");
    asm volatile("s_waitcnt vmcnt(0)" ::: "memory");
    { ITEM_IDS();
      if (wave_ == 0) ssd_out_witem(F, layer, NCHP + b, 0, wave_, lane_);
      else if (wave_ <= 4) hgrn_out_witem(F, layer, NCHP + b, wave_ - 1, 0, wave_, lane_); }
    __syncthreads();
}
__device__ __forceinline__ void p2_phase(Frame& F, int layer, volatile LAS unsigned* MISC) {
    constexpr int NS = NSB, NA = NCH * 4, NB = NCHP, NC = NCHP, ND = NCH, NE = 64, NW = 432;
    const int NTOT = NS + NA + NB + NC + ND + NE + (layer == 0 ? NW : 0);
    unsigned* head = (unsigned*)(F.ws + WS_CTL) + CW_QUEUE + 64 * layer;
    attn_bias_load(F, layer);
    unsigned nxt = 0u; if (threadIdx.x == 0) nxt = __hip_atomic_fetch_add(head, 1u, __ATOMIC_RELAXED, __HIP_MEMORY_SCOPE_AGENT);
    for (;;) {
        __syncthreads();
        if (threadIdx.x == 0) MISC[12] = nxt;
        __syncthreads();
        int it = (int)MISC[12];
        if (it >= NTOT) break;
        if (threadIdx.x == 0) nxt = __hip_atomic_fetch_add(head, 1u, __ATOMIC_RELAXED, __HIP_MEMORY_SCOPE_AGENT);
        if (it < NS) { sample_mix_item(F, layer, it); continue; } it -= NS;
        if (it < NA) { const int i2 = it - NSB * 4; const int ci = it < NSB * 4 ? NCHP + (it >> 2) : NCHP - 1 - (i2 >> 2); attn_item(F, layer, ci, it & 3); }
        else if (it < NA + NB) ssd_prep_item(F, layer, it - NA);
        else if (it < NA + NB + NC) hgrn_prep_item(F, layer, it - NA - NB);
        else if (it < NA + NB + NC + ND) pool_item(F, layer, it - NA - NB - NC);
        else if (it < NA + NB + NC + ND + NE) copy_cache(F, layer, it - NA - NB - NC - ND, NE);
        else { ITEM_IDS(); p0_weights(F, 1, (it - NA - NB - NC - ND - NE) * NWAVES + wave_, NW * NWAVES, false); }
    }
}
__device__ __forceinline__ void p4_phase(Frame& F, int layer) {
    for (int ci = ((int)blockIdx.x); ci < NCHP; ci += ((int)gridDim.x)) { ssd_out_block(F, layer, ci); hgrn_out_block(F, layer, ci); }
}

__global__ void __launch_bounds__(NTHR, 2) fwd_kernel(Args args) {
    extern __shared__ __attribute__((aligned(16))) unsigned char lds[];
    Frame F;
    F.lds = (LAS unsigned char*)lds;
    F.out = args.out; F.ws = args.ws;
    volatile LAS unsigned* MISC = (volatile LAS unsigned*)(F.lds + MISC_OFF);
    if (threadIdx.x < 64) MISC[threadIdx.x] = 0u;
    __syncthreads();
    (void)xcd_barrier_post((unsigned*)(args.ws + WS_CTL) + CW_BAR, MISC + 8);
#define GRID_BAR() do { XcdBarrier bar_; bar_.bar = (unsigned*)((unsigned char*)inp(N_IN + 1) + WS_CTL) + CW_BAR; bar_.x = xb_xcc_id(); bar_.st = MISC + 8; xcd_barrier(bar_); \
        F.out = (float*)inp(N_IN); F.ws = (unsigned char*)inp(N_IN + 1); } while (0)
#ifdef TPROBE
    const bool stamper = (blockIdx.x == 0 && threadIdx.x == 0); int n_stamp = 0;
#define STAMP() do { if (stamper) MISC[16 + n_stamp] = (unsigned)__builtin_amdgcn_s_memrealtime(); ++n_stamp; } while (0)
#else
#define STAMP() do { } while (0)
#endif
    STAMP();

    { float* rsz = F_RS; for (int i = (int)blockIdx.x * NTHR + (int)threadIdx.x; i < 2 * M; i += (int)gridDim.x * NTHR) rsz[i] = 0.f; }
    p0_weights(F, 0, ((int)blockIdx.x) * NWAVES + __builtin_amdgcn_readfirstlane((int)(threadIdx.x >> 6)), ((int)gridDim.x) * NWAVES, true);
    __syncthreads();
    norm_rows<true, false>(F, inp(I_XP), inp(I_XS) - (size_t)MP * D, inp(I_N1), inp(I_WIN));
    GRID_BAR(); STAMP();
#pragma unroll 1
    for (int layer = 0; layer < 2; ++layer) {
        unsigned char* wl = F.ws + WS_W + (size_t)layer * WL_STRIDE;
        mini_gemm2<0, 4>(F, F_XN, (const bf16*)(wl + WL_IN), D, NPROJ / 32, F_PROJ, NPROJ, nullptr, nullptr);
        { pg8::Gemm g{F_XN, (const bf16*)(wl + WL_IN), MP, NPROJ, D}; pg8::StaticOrder S; S.init(MP, NPROJ, ((int)gridDim.x), ((int)blockIdx.x));
          pg8::EpiBf16 E{F_PROJ, NPROJ, F_HALO, F_VTA, M};
          pg8::gemm_phase<pg8::EpiBf16, pg8::StaticOrder, true, true>(F.lds + RING_OFF, g, S, E); }
        GRID_BAR(); STAMP();
        p2_phase(F, layer, MISC);
        GRID_BAR(); STAMP();
        scan_phase(F, layer);
        GRID_BAR(); STAMP();
        p4_phase(F, layer);
        GRID_BAR(); STAMP();
        mini_gemm2<1, 4>(F, F_XN, (const bf16*)(wl + WL_OUT), D, D / 32, nullptr, 0, layer == 0 ? inp(I_XS) - (size_t)MP * D : F_X, F_X, inp(I_N2) + (size_t)layer * D, F_XN2, F_RS + (size_t)layer * M);
        { pg8::Gemm g{F_XN, (const bf16*)(wl + WL_OUT), MP, D, D}; pg8::StaticOrder S; S.init(MP, D, ((int)gridDim.x), ((int)blockIdx.x));
          pg8::EpiRes E{layer == 0 ? inp(I_XP) : F_X, layer == 0 ? inp(I_XS) - (size_t)MP * D : F_X, F_X, inp(I_N2) + (size_t)layer * D, F_XN2, F_RS + (size_t)layer * M};
          pg8::gemm_phase<pg8::EpiRes, pg8::StaticOrder, true, true>(F.lds + RING_OFF, g, S, E); }
        GRID_BAR(); STAMP();
        { pg8::Gemm g{F_XN2, (const bf16*)(wl + WL_GU), M, NGU, D}; pg8::StaticOrder S; S.init(M, NGU, ((int)gridDim.x), ((int)blockIdx.x));
          pg8::EpiSwiGLU E{F_ACT, DFF, F_RS + (size_t)layer * M};
          pg8::gemm_phase<pg8::EpiSwiGLU, pg8::StaticOrder, true, true>(F.lds + RING_OFF, g, S, E); }
        GRID_BAR(); STAMP();
        mini_gemm2<1, 11>(F, F_ACT, (const bf16*)(wl + WL_DN), DFF, D / 32, nullptr, 0, F_X, F_X);
        { pg8::Gemm g{F_ACT, (const bf16*)(wl + WL_DN), MP, D, DFF}; pg8::StaticOrder S; S.init(MP, D, ((int)gridDim.x), ((int)blockIdx.x));
          pg8::EpiRes E{F_X, F_X, F_X, nullptr, nullptr, nullptr};
          pg8::gemm_phase<pg8::EpiRes, pg8::StaticOrder, true, true>(F.lds + RING_OFF, g, S, E); }
        GRID_BAR(); STAMP();
        if (layer == 0) { norm_rows<true, false>(F, F_X, F_X, inp(I_N1) + D, inp(I_WIN) + (size_t)D * NIN); GRID_BAR(); STAMP(); }
        else { norm_rows<false, true>(F, F_X, F_X, inp(I_NF), nullptr); STAMP(); }
    }
#ifdef TPROBE
    if (stamper) {
        unsigned v[10]; v[0] = MISC[17] - MISC[16];
        for (int j = 1; j < 9; ++j) v[j] = (MISC[17 + j] - MISC[16 + j]) + (MISC[25 + j] - MISC[24 + j]);
        v[9] = (MISC[33] - MISC[16]) / 4;
        const unsigned dl = 800000u + 16u * v[TPROBE];
        const unsigned t0 = MISC[16];
        while ((unsigned)((unsigned)__builtin_amdgcn_s_memrealtime() - t0) < dl) __builtin_amdgcn_s_sleep(32);
    }
#endif
}

extern "C" void kernel_launch(void* const* d_in, const int* in_sizes, int n_in, void* d_out, int out_size, void* d_ws, size_t ws_size, hipStream_t stream) {
    static int grid = 0;
    if (grid == 0) {
        if (n_in != N_IN || (size_t)out_size != O_END || ws_size < WS_END) { fprintf(stderr, "kernel_launch: unexpected shapes (n_in %d, out %d, ws %zu)\n", n_in, out_size, ws_size); grid = -1; return; }
        int dev = 0, cus = 0, per_cu = 0;
        if (hipGetDevice(&dev) != hipSuccess || hipDeviceGetAttribute(&cus, hipDeviceAttributeMultiprocessorCount, dev) != hipSuccess) { grid = -1; return; }
        if (hipFuncSetAttribute((const void*)fwd_kernel, hipFuncAttributeMaxDynamicSharedMemorySize, LDS_BYTES) != hipSuccess) { fprintf(stderr, "kernel_launch: hipFuncSetAttribute failed\n"); grid = -1; return; }
        if (hipOccupancyMaxActiveBlocksPerMultiprocessor(&per_cu, (const void*)fwd_kernel, NTHR, LDS_BYTES) != hipSuccess || per_cu < 1) { fprintf(stderr, "kernel_launch: occupancy query says %d blocks per CU\n", per_cu); (void)hipGetLastError(); grid = -1; return; }
        grid = cus;
        if (grid < 64) { fprintf(stderr, "kernel_launch: needs at least 64 CUs (got %d)\n", cus); grid = -1; return; }
    }
    if (grid < 0) return;
    if (hipMemsetAsync((char*)d_ws + WS_CTL, 0, CTL_ZERO_BYTES, stream) != hipSuccess) { fprintf(stderr, "kernel_launch: hipMemsetAsync failed\n"); return; }
    Args a{};
    for (int i = 0; i < N_IN; ++i) a.in[i] = (const float*)d_in[i];
    a.out = (float*)d_out; a.ws = (unsigned char*)d_ws;
    void* kargs[] = {&a};
    hipError_t e = hipLaunchCooperativeKernel((const void*)fwd_kernel, dim3(grid), dim3(NTHR), kargs, LDS_BYTES, stream);
    if (e != hipSuccess) { fprintf(stderr, "kernel_launch: cooperative launch failed: %s (grid %d)\n", hipGetErrorString(e), grid); }
}
```

```cpp
#include <hip/hip_runtime.h>
#include <cstdio>
#include <cstdint>
namespace pg8 {
#define PG8_LAS __attribute__((address_space(3)))
typedef unsigned short bf16_t;
typedef short bf16x8 __attribute__((ext_vector_type(8)));
typedef float f32x4 __attribute__((ext_vector_type(4)));
typedef unsigned u32x4 __attribute__((ext_vector_type(4)));
constexpr int BM = 256, BK = 64, HALF = 128, HTB = HALF * BK * 2  , STAGE_BYTES = 8 * HTB, NXCD = 8, WGM = 8;

__host__ __device__ __forceinline__ int lds_byte(int r, int c) { const int st = (r >> 4) * 2 + (c >> 5), rr = r & 15, cc = c & 31, ob = rr * 64 + cc * 2; return st * 1024 + (ob ^ (((ob >> 9) & 1) << 5)); }
__host__ __device__ __forceinline__ void stage_rc(int b, int& R, int& C) { const int st = b / 1024, sb = b % 1024, swz = sb ^ (((sb >> 9) & 1) << 5); R = (st >> 1) * 16 + swz / 64; C = (st & 1) * 32 + (swz % 64) / 2; }
__host__ __device__ __forceinline__ int perm32(int rho) { const int n = rho >> 4, i = rho & 15; return 8 * (i >> 2) + 4 * n + (i & 3); }

struct Unit { int pm, pn; };
struct Gemm { const bf16_t* A; const bf16_t* Bt; int M, N, K; };

struct StaticOrder {
    int nM, nN, nwg, G, c;
    __host__ __device__ void init(int M, int N, int G_, int c_) { nM = M / BM; nN = N / BM; nwg = nM * nN; G = G_; c = c_; }
    __host__ __device__ bool next(int i, Unit& u) const {
        const long L = (long)i * G + c; if (L >= nwg) return false;
        int wgid = (int)L; { const int q = nwg / NXCD, r = nwg % NXCD, xcd = wgid % NXCD, off = wgid / NXCD; wgid = (xcd < r ? xcd * (q + 1) : r * (q + 1) + (xcd - r) * q) + off; }
        const int nig = WGM * nN, gid = wgid / nig, fm = gid * WGM, gsz = (nM - fm) < WGM ? (nM - fm) : WGM;
        u.pm = fm + ((wgid % nig) % gsz); u.pn = (wgid % nig) / gsz; return true;
    }
    __device__ __forceinline__ void a_ready(const Unit&) const {}
    __device__ __forceinline__ void done(const Unit&) const {}
};

__device__ __forceinline__ unsigned cvt_pk_bf16(float lo, float hi) { unsigned r; asm volatile("v_cvt_pk_bf16_f32 %0, %1, %2" : "=v"(r) : "v"(lo), "v"(hi)); return r; }
__device__ __forceinline__ float silu_f(float x) { return x * __builtin_amdgcn_rcpf(1.0f + __expf(-x)); }
struct EpiBf16 {
    static constexpr bool PERM = true, AFTER_DRAIN = false;
    bf16_t* O; int ldc; bf16_t* halo; bf16_t* vta; int vld;
    __device__ __forceinline__ void operator()(const f32x4 (&acc)[2][2][4][2], const Unit& u, int wr, int wc, int fr, int fq) const {
        const int row0 = u.pm * BM + wr * 64 + fr, col0 = u.pn * BM + wc * 32 + 8 * fq;
        const bool hz = halo != nullptr && u.pn >= 4 && u.pn <= 6;
#pragma unroll
        for (int ai = 0; ai < 2; ++ai)
#pragma unroll
            for (int m = 0; m < 4; ++m) { const int row = row0 + ai * HALF + m * 16; bf16_t* rowp = O + (size_t)row * ldc + col0;
#pragma unroll
                for (int bj = 0; bj < 2; ++bj) { const f32x4 v0 = acc[ai][bj][m][0], v1 = acc[ai][bj][m][1];
                    u32x4 w; w.x = cvt_pk_bf16(v0[0], v0[1]); w.y = cvt_pk_bf16(v0[2], v0[3]); w.z = cvt_pk_bf16(v1[0], v1[1]); w.w = cvt_pk_bf16(v1[2], v1[3]);
                    *(u32x4*)(rowp + bj * HALF) = w;
                    if (hz && (row & 63) >= 61) *(u32x4*)(halo + ((size_t)(row >> 6) * 3 + (row & 63) - 61) * 768 + (col0 - 1024) + bj * HALF) = w;
                    if (vta != nullptr && u.pn == 2) { bf16_t* vp = vta + (size_t)(col0 - 512 + bj * HALF) * vld + row;
                        vp[0] = (bf16_t)(w.x & 0xffffu); vp[(size_t)vld] = (bf16_t)(w.x >> 16); vp[(size_t)2 * vld] = (bf16_t)(w.y & 0xffffu); vp[(size_t)3 * vld] = (bf16_t)(w.y >> 16);
                        vp[(size_t)4 * vld] = (bf16_t)(w.z & 0xffffu); vp[(size_t)5 * vld] = (bf16_t)(w.z >> 16); vp[(size_t)6 * vld] = (bf16_t)(w.w & 0xffffu); vp[(size_t)7 * vld] = (bf16_t)(w.w >> 16); } } }
    }
};
struct EpiRes {
    static constexpr bool PERM = false, AFTER_DRAIN = false;
    const float* rlo; const float* rhi; float* C; const float* nw; bf16_t* xo; float* rs; const bf16_t* rbf; const float* rw; bf16_t* Cb;
    __device__ __forceinline__ void operator()(const f32x4 (&acc)[2][2][4][2], const Unit& u, int wr, int wc, int fr, int fq) const {
        const int row0 = u.pm * BM + wr * 64 + fr, col0 = u.pn * BM + wc * 32 + 4 * fq;
        const float* rb = (u.pm < 64) ? rlo : rhi;
        f32x4 wv[2][2];
        if (nw || rbf) {
#pragma unroll
            for (int bj = 0; bj < 2; ++bj)
#pragma unroll
                for (int n = 0; n < 2; ++n) { if (nw) wv[bj][n] = *(const f32x4*)(nw + col0 + bj * HALF + n * 16);
                    else if (rw) { const f32x4 t = *(const f32x4*)(rw + col0 + bj * HALF + n * 16); wv[bj][n] = (f32x4){__builtin_amdgcn_rcpf(t[0]), __builtin_amdgcn_rcpf(t[1]), __builtin_amdgcn_rcpf(t[2]), __builtin_amdgcn_rcpf(t[3])}; }
                    else wv[bj][n] = (f32x4){1.f, 1.f, 1.f, 1.f}; } }
#pragma unroll
        for (int ai = 0; ai < 2; ++ai)
#pragma unroll
        for (int mh = 0; mh < 2; ++mh) {
            f32x4 rv[2][2][2];
#pragma unroll
            for (int m2 = 0; m2 < 2; ++m2)
#pragma unroll
                for (int bj = 0; bj < 2; ++bj)
#pragma unroll
                    for (int n = 0; n < 2; ++n) { const size_t o = (size_t)(row0 + ai * HALF + (2 * mh + m2) * 16) * 1024 + col0 + bj * HALF + n * 16;
                        if (rbf) { const unsigned long long w = *(const unsigned long long*)(rbf + o); const unsigned lo = (unsigned)w, hi = (unsigned)(w >> 32);
                            rv[m2][bj][n] = (f32x4){__builtin_bit_cast(float, lo << 16), __builtin_bit_cast(float, lo & 0xffff0000u), __builtin_bit_cast(float, hi << 16), __builtin_bit_cast(float, hi & 0xffff0000u)}; if (!nw) rv[m2][bj][n] = rv[m2][bj][n] * wv[bj][n]; }
                        else rv[m2][bj][n] = *(const f32x4*)(rb + o); }
#pragma unroll
            for (int m2 = 0; m2 < 2; ++m2) { const int m = 2 * mh + m2; const int row = row0 + ai * HALF + m * 16; const size_t off = (size_t)row * 1024 + col0; float ss = 0.f;
#pragma unroll
                for (int bj = 0; bj < 2; ++bj)
#pragma unroll
                    for (int n = 0; n < 2; ++n) { const f32x4 x = rv[m2][bj][n] + acc[ai][bj][m][n]; if (C) *(f32x4*)(C + off + bj * HALF + n * 16) = x;
                        if (Cb) *(unsigned long long*)(Cb + off + bj * HALF + n * 16) = (unsigned long long)cvt_pk_bf16(x[0], x[1]) | ((unsigned long long)cvt_pk_bf16(x[2], x[3]) << 32);
                        if (nw) { ss += (x[0] * x[0] + x[1] * x[1]) + (x[2] * x[2] + x[3] * x[3]); const f32x4 y = x * wv[bj][n];
                            *(unsigned long long*)(xo + off + bj * HALF + n * 16) = (unsigned long long)cvt_pk_bf16(y[0], y[1]) | ((unsigned long long)cvt_pk_bf16(y[2], y[3]) << 32); } }
                if (nw) { const int lane = fq * 16 + fr;
                    ss += __builtin_bit_cast(float, __builtin_amdgcn_ds_bpermute((lane ^ 16) << 2, __builtin_bit_cast(int, ss)));
                    ss += __builtin_bit_cast(float, __builtin_amdgcn_ds_bpermute((lane ^ 32) << 2, __builtin_bit_cast(int, ss)));
                    if (fq == 0) atomicAdd(rs + row, ss); } }
            asm volatile("" ::: "memory");
        }
    }
};
struct EpiSwiGLU {
    static constexpr bool PERM = true, AFTER_DRAIN = false;
    bf16_t* O; int ldc; const float* rs;
    __device__ __forceinline__ void operator()(const f32x4 (&acc)[2][2][4][2], const Unit& u, int wr, int wc, int fr, int fq) const {
        const int row0 = u.pm * BM + wr * 64 + fr, col0 = u.pn * HALF + wc * 32 + 8 * fq;
#pragma unroll
        for (int ai = 0; ai < 2; ++ai)
#pragma unroll
            for (int m = 0; m < 4; ++m) { const int row = row0 + ai * HALF + m * 16; bf16_t* rowp = O + (size_t)row * ldc + col0;
                const float rstd = __builtin_amdgcn_rsqf(rs[row] * (1.0f / 1024.0f) + 1e-6f);
                const f32x4 g0 = acc[ai][0][m][0] * rstd, g1 = acc[ai][0][m][1] * rstd, u0 = acc[ai][1][m][0] * rstd, u1 = acc[ai][1][m][1] * rstd;
                u32x4 w; w.x = cvt_pk_bf16(silu_f(g0[0]) * u0[0], silu_f(g0[1]) * u0[1]); w.y = cvt_pk_bf16(silu_f(g0[2]) * u0[2], silu_f(g0[3]) * u0[3]);
                w.z = cvt_pk_bf16(silu_f(g1[0]) * u1[0], silu_f(g1[1]) * u1[1]); w.w = cvt_pk_bf16(silu_f(g1[2]) * u1[2], silu_f(g1[3]) * u1[3]);
                *(u32x4*)rowp = w; }
    }
};
template <class Epi, class Sched, bool ALIGN_EPI = false, bool SP2 = false>
__device__ __forceinline__ void gemm_phase(PG8_LAS unsigned char* lds, const Gemm g, const Sched& S, const Epi& E) {
    int tid0 = threadIdx.x; asm volatile("" : "+v"(tid0));
    const int tid = tid0, wid = __builtin_amdgcn_readfirstlane(tid >> 6), lane = tid & 63, wr = wid >> 2, wc = wid & 3, fr = lane & 15, fq = lane >> 4;
    const int K = g.K, nt = K / BK;
    unsigned voffA[2], voffB[2];
#pragma unroll
    for (int i = 0; i < 2; ++i) { int R, C; stage_rc(tid * 16 + i * 8192, R, C); const int Rb = Epi::PERM ? ((R & ~31) + perm32(R & 31)) : R;
        voffA[i] = (unsigned)(R * K + C) * 2u; voffB[i] = (unsigned)(Rb * K + C) * 2u; }
    const size_t kstep = (size_t)(BK * 2);
    const size_t hstep = (size_t)HALF * K * 2;
    const size_t tstep = 2 * hstep;
    const unsigned ldsw = (unsigned)wid * 1024u;
    const int aoff = lds_byte(wr * 64 + fr, fq * 8), boff = lds_byte(wc * 32 + fr, fq * 8);
#define PG8_SA(b, h) (((b) * 2 + (h)) * HTB)
#define PG8_SB(b, h) ((4 + (b) * 2 + (h)) * HTB)
#define PG8_STAGE(bufoff, gbase, voff) do { _Pragma("unroll") for (int _i = 0; _i < 2; ++_i) \
        __builtin_amdgcn_global_load_lds((const unsigned*)((const char*)(gbase) + (voff)[_i]), (PG8_LAS unsigned*)(lds + (bufoff) + ldsw + _i * 8192), 16, 0, 0); } while (0)
#define PG8_LDA(dst, b, h) do { _Pragma("unroll") for (int m = 0; m < 4; ++m) _Pragma("unroll") for (int k = 0; k < 2; ++k) dst[m][k] = *(const PG8_LAS bf16x8*)(lds + PG8_SA(b, h) + aoff + m * 2048 + k * 1024); } while (0)
#define PG8_LDB(dst, b, h) do { _Pragma("unroll") for (int n = 0; n < 2; ++n) _Pragma("unroll") for (int k = 0; k < 2; ++k) dst[n][k] = *(const PG8_LAS bf16x8*)(lds + PG8_SB(b, h) + boff + n * 2048 + k * 1024); } while (0)
#define PG8_MMA(ai, bj, At, Bt) do { __builtin_amdgcn_s_setprio(1); _Pragma("unroll") for (int m = 0; m < 4; ++m) _Pragma("unroll") for (int n = 0; n < 2; ++n) _Pragma("unroll") for (int k = 0; k < 2; ++k) \
        acc[ai][bj][m][n] = __builtin_amdgcn_mfma_f32_16x16x32_bf16(Bt[n][k], At[m][k], acc[ai][bj][m][n], 0, 0, 0); __builtin_amdgcn_s_setprio(0); } while (0)
#define PG8_WAIT_V(n) asm volatile("s_waitcnt vmcnt(" #n ")" ::: "memory")
#define PG8_WAIT_L(n) asm volatile("s_waitcnt lgkmcnt(" #n ")" ::: "memory")
#define PG8_BAR __builtin_amdgcn_s_barrier()
#define PG8_SCHED __builtin_amdgcn_sched_barrier(0)
    Unit cur, nxt; int ui = 0;
    if (!S.next(0, cur)) return;
    f32x4 acc[2][2][4][2];
#pragma unroll
    for (int a = 0; a < 2; ++a)
#pragma unroll
        for (int b = 0; b < 2; ++b)
#pragma unroll
            for (int m = 0; m < 4; ++m)
#pragma unroll
                for (int n = 0; n < 2; ++n) acc[a][b][m][n] = (f32x4){0.f, 0.f, 0.f, 0.f};
    bf16x8 At[4][2], B0[2][2], B1[2][2];
    const char* cA = (const char*)g.A + (size_t)cur.pm * tstep; const char* cB = (const char*)g.Bt + (size_t)cur.pn * tstep;
    S.a_ready(cur);
    if constexpr (SP2) {
        PG8_STAGE(PG8_SB(0, 0), cB, voffB); PG8_STAGE(PG8_SB(0, 1), cB + hstep, voffB); PG8_STAGE(PG8_SA(0, 0), cA, voffA); PG8_STAGE(PG8_SA(0, 1), cA + hstep, voffA);
        if (wr == 1) PG8_BAR;
        PG8_WAIT_V(2); PG8_BAR;
        PG8_STAGE(PG8_SB(1, 0), cB + kstep, voffB); PG8_STAGE(PG8_SA(1, 0), cA + kstep, voffA); PG8_STAGE(PG8_SB(1, 1), cB + hstep + kstep, voffB);
        PG8_WAIT_V(6); PG8_BAR;
    } else {
        PG8_STAGE(PG8_SB(0, 0), cB, voffB); PG8_STAGE(PG8_SA(0, 0), cA, voffA); PG8_STAGE(PG8_SB(0, 1), cB + hstep, voffB); PG8_STAGE(PG8_SA(0, 1), cA + hstep, voffA);
        if (wr == 1) PG8_BAR;
        PG8_WAIT_V(4); PG8_BAR;
        PG8_STAGE(PG8_SB(1, 0), cB + kstep, voffB); PG8_STAGE(PG8_SA(1, 0), cA + kstep, voffA); PG8_STAGE(PG8_SB(1, 1), cB + hstep + kstep, voffB);
        PG8_WAIT_V(6); PG8_BAR;
    }
    for (;;) {
        const bool has_next = S.next(ui + 1, nxt);
        const char* nA = has_next ? (const char*)g.A + (size_t)nxt.pm * tstep : cA; const char* nB = has_next ? (const char*)g.Bt + (size_t)nxt.pn * tstep : cB;
        for (int t = 0; t < nt; t += 2) {
            const bool last = (t == nt - 2);
            const char* a1 = cA + (size_t)(t + 1) * kstep;
            const char* a2 = last ? nA : cA + (size_t)(t + 2) * kstep; const char* b2 = last ? nB : cB + (size_t)(t + 2) * kstep;
            const char* a3 = a2 + kstep; const char* b3 = b2 + kstep;
            if (last && has_next) S.a_ready(nxt);
            if constexpr (SP2) {
            PG8_LDB(B0, 0, 0); PG8_LDB(B1, 0, 1); PG8_SCHED; PG8_LDA(At, 0, 0); PG8_STAGE(PG8_SA(1, 1), a1 + hstep, voffA);
            PG8_WAIT_V(8); PG8_WAIT_L(0); PG8_BAR; PG8_MMA(0, 0, At, B0); PG8_MMA(0, 1, At, B1); PG8_BAR; PG8_SCHED;
            PG8_LDA(At, 0, 1); PG8_STAGE(PG8_SB(0, 0), b2, voffB); PG8_STAGE(PG8_SB(0, 1), b2 + hstep, voffB); PG8_STAGE(PG8_SA(0, 0), a2, voffA);
            PG8_WAIT_V(8); PG8_WAIT_L(0); PG8_BAR; PG8_MMA(1, 0, At, B0); PG8_MMA(1, 1, At, B1); PG8_BAR; PG8_SCHED;
            PG8_LDB(B0, 1, 0); PG8_LDB(B1, 1, 1); PG8_SCHED; PG8_LDA(At, 1, 0); PG8_STAGE(PG8_SA(0, 1), a2 + hstep, voffA);
            PG8_WAIT_V(8); PG8_WAIT_L(0); PG8_BAR; PG8_MMA(0, 0, At, B0); PG8_MMA(0, 1, At, B1); PG8_BAR; PG8_SCHED;
            PG8_LDA(At, 1, 1); PG8_STAGE(PG8_SB(1, 0), b3, voffB); PG8_STAGE(PG8_SB(1, 1), b3 + hstep, voffB); PG8_STAGE(PG8_SA(1, 0), a3, voffA);
            PG8_WAIT_V(8); PG8_WAIT_L(0); PG8_BAR; PG8_MMA(1, 0, At, B0); PG8_MMA(1, 1, At, B1); PG8_BAR; PG8_SCHED;
            } else {
            PG8_LDB(B0, 0, 0); PG8_SCHED; PG8_LDA(At, 0, 0); PG8_STAGE(PG8_SA(1, 1), a1 + hstep, voffA);
            PG8_WAIT_L(8); PG8_BAR; PG8_WAIT_L(0); PG8_MMA(0, 0, At, B0); PG8_BAR; PG8_SCHED;
            PG8_LDB(B1, 0, 1); PG8_STAGE(PG8_SB(0, 0), b2, voffB);
            PG8_BAR; PG8_WAIT_L(0); PG8_MMA(0, 1, At, B1); PG8_BAR;
            PG8_LDA(At, 0, 1); PG8_STAGE(PG8_SA(0, 0), a2, voffA);
            PG8_BAR; PG8_WAIT_L(0); PG8_MMA(1, 0, At, B0); PG8_BAR; PG8_SCHED;
            PG8_STAGE(PG8_SB(0, 1), b2 + hstep, voffB);
            PG8_WAIT_V(6); PG8_BAR; PG8_MMA(1, 1, At, B1); PG8_BAR;
            PG8_LDB(B0, 1, 0); PG8_SCHED; PG8_LDA(At, 1, 0); PG8_STAGE(PG8_SA(0, 1), a2 + hstep, voffA);
            PG8_WAIT_L(8); PG8_BAR; PG8_WAIT_L(0); PG8_MMA(0, 0, At, B0); PG8_BAR; PG8_SCHED;
            PG8_LDB(B1, 1, 1); PG8_STAGE(PG8_SB(1, 0), b3, voffB);
            PG8_BAR; PG8_WAIT_L(0); PG8_MMA(0, 1, At, B1); PG8_BAR;
            PG8_LDA(At, 1, 1); PG8_STAGE(PG8_SA(1, 0), a3, voffA);
            PG8_BAR; PG8_WAIT_L(0); PG8_MMA(1, 0, At, B0); PG8_BAR; PG8_SCHED;
            PG8_STAGE(PG8_SB(1, 1), b3 + hstep, voffB);
            PG8_WAIT_V(6); PG8_BAR; PG8_MMA(1, 1, At, B1); PG8_BAR;
            }
        }
        if constexpr (ALIGN_EPI) { if (wr == 0) PG8_BAR; }
        if constexpr (!Epi::AFTER_DRAIN) { E(acc, cur, wr, wc, fr, fq); S.done(cur); }
        if (!has_next) break;
#pragma unroll
        for (int a = 0; a < 2; ++a)
#pragma unroll
            for (int b = 0; b < 2; ++b)
#pragma unroll
                for (int m = 0; m < 4; ++m)
#pragma unroll
                    for (int n = 0; n < 2; ++n) acc[a][b][m][n] = (f32x4){0.f, 0.f, 0.f, 0.f};
        cur = nxt; cA = nA; cB = nB; ++ui;
        if constexpr (ALIGN_EPI) { if (wr == 1) PG8_BAR; }
    }
    PG8_WAIT_V(0);
    if constexpr (!ALIGN_EPI) { if (wr == 0) PG8_BAR; }
    PG8_BAR;
    if constexpr (Epi::AFTER_DRAIN) { E.fused(acc, cur, wr, wc, fr, fq, lds, wid, lane); S.done(cur); }
#undef PG8_SA
#undef PG8_SB
#undef PG8_STAGE
#undef PG8_LDA
#undef PG8_LDB
#undef PG8_MMA
#undef PG8_WAIT_V
#undef PG8_WAIT_L
#undef PG8_BAR
#undef PG8_SCHED
}
}
#define GAS __attribute__((address_space(1)))
#define LAS __attribute__((address_space(3)))
typedef unsigned short bf16;
typedef unsigned v4u __attribute__((ext_vector_type(4)));
typedef float f32x4 __attribute__((ext_vector_type(4)));
typedef short bf16x8 __attribute__((ext_vector_type(8)));
typedef GAS unsigned gu32;
typedef GAS unsigned long long gu64;
#define RLX_AGENT __ATOMIC_RELAXED, __HIP_MEMORY_SCOPE_AGENT
#define LDS_WAIT() asm volatile("s_waitcnt lgkmcnt(0)" ::: "memory")
#define VM_WAIT() asm volatile("s_waitcnt vmcnt(0)" ::: "memory")
__device__ __forceinline__ unsigned long long rt() { return __builtin_amdgcn_s_memrealtime(); }
__device__ __forceinline__ unsigned f2bf(float f) { unsigned u = __builtin_bit_cast(unsigned, f); return (u + 0x7fffu + ((u >> 16) & 1u)) >> 16; }
__device__ __forceinline__ unsigned pk2(float lo, float hi) { return f2bf(lo) | (f2bf(hi) << 16); }
#define XB_TMO      128
#define XB_XCNT(j)  (256  + 64 * (j))
#define XB_XSUB(j)  (1280 + 64 * (j))
#define XB_XGEN(j)  (2304 + 64 * (j))
#define XB_TOP      3328
#define XB_TOPGEN   3392
#define XCD_BAR_WORDS 3456
#define XB_SPIN_CAP (1u << 18)

__device__ __forceinline__ unsigned xb_ld(unsigned* p)              { return __hip_atomic_load(p, __ATOMIC_RELAXED, __HIP_MEMORY_SCOPE_AGENT); }
__device__ __forceinline__ unsigned xb_add(unsigned* p, unsigned v) { return __hip_atomic_fetch_add(p, v, __ATOMIC_RELAXED, __HIP_MEMORY_SCOPE_AGENT); }
__device__ __forceinline__ unsigned xb_xcc_id() { return (unsigned)__builtin_amdgcn_s_getreg((3 << 11) | 20) & 0xFu; }
#define XB_SPIN(cond, bar) do { unsigned _sp = 0; while (cond) { __builtin_amdgcn_s_sleep(1); \
    if ((++_sp & 255u) == 0u) { if (xb_ld(&(bar)[XB_TMO])) break; if (_sp > XB_SPIN_CAP) { atomicAdd(&(bar)[XB_TMO], 1u); break; } } } } while (0)

struct XcdBarrier {
    unsigned* bar; unsigned x;
    volatile LAS unsigned* st;
};

__device__ __forceinline__ XcdBarrier xcd_barrier_post(unsigned* bar, volatile LAS unsigned* st) {
    XcdBarrier b; b.bar = bar; b.x = xb_xcc_id(); b.st = st;
    if (threadIdx.x == 0) (void)xb_add(&bar[XB_XCNT(b.x)], 1u);
    return b;
}
__device__ __forceinline__ void xcd_barrier_complete(unsigned* bar, unsigned x, unsigned& nloc, unsigned& nx) {
    const unsigned G = gridDim.x * gridDim.y * gridDim.z;
    unsigned sum, cnt, mine, sp = 0u;
    for (;;) {
        sum = 0u; cnt = 0u; mine = 0u;
#pragma unroll
        for (unsigned j = 0; j < 16; ++j) { const unsigned c = xb_ld(&bar[XB_XCNT(j)]); sum += c; cnt += (c > 0u) ? 1u : 0u; mine = (j == x) ? c : mine; }
        if (sum == G) break;
        __builtin_amdgcn_s_sleep(1);
        if ((++sp & 255u) == 0u) { if (xb_ld(&bar[XB_TMO])) break; if (sp > XB_SPIN_CAP) { atomicAdd(&bar[XB_TMO], 1u); break; } }
    }
    nloc = mine > 0u ? mine : 1u; nx = cnt > 0u ? cnt : 1u;
}

__device__ __forceinline__ void xcd_barrier(const XcdBarrier& b) {
    asm volatile("s_waitcnt vmcnt(0)" ::: "memory");
    __syncthreads();
    if (threadIdx.x == 0) {
        unsigned* bar = b.bar;
        __builtin_amdgcn_s_waitcnt(0);
        unsigned nloc = b.st[0], nx = b.st[1];
        if (nloc == 0u) { xcd_barrier_complete(bar, b.x, nloc, nx); b.st[0] = nloc; b.st[1] = nx; }
        const unsigned old = xb_add(&bar[XB_XSUB(b.x)], 1u);
        const unsigned gen = old / nloc;
        if (old + 1u == (gen + 1u) * nloc) {
            __builtin_amdgcn_fence(__ATOMIC_RELEASE, "agent");
            asm volatile("s_waitcnt vmcnt(0)" ::: "memory");
            const unsigned og = xb_add(&bar[XB_TOP], 1u);
            const unsigned tg = og / nx;
            if (og + 1u == (tg + 1u) * nx) xb_add(&bar[XB_TOPGEN], 1u);
            else XB_SPIN(xb_ld(&bar[XB_TOPGEN]) == tg, bar);
            __builtin_amdgcn_fence(__ATOMIC_ACQUIRE, "agent");
            xb_add(&bar[XB_XGEN(b.x)], 1u);
            asm volatile("s_waitcnt vmcnt(0)" ::: "memory");
        } else {
            XB_SPIN(xb_ld(&bar[XB_XGEN(b.x)]) == gen, bar);
            __builtin_amdgcn_fence(__ATOMIC_ACQUIRE, "agent");
            asm volatile("s_waitcnt vmcnt(0)" ::: "memory");
        }
    }
    __syncthreads();
}
constexpr int NWAVES = 8, NTHR = 512;
constexpr int D = 1024, MP = 16384, NSB = 16, SSEQ = 16, MS = NSB * SSEQ, M = MP + MS;
constexpr int NIN = 3076, NPROJ = 3072, DFF = 2816, NGU = 2 * DFF;
constexpr int NCHP = 256, NCH = NCHP + NSB;
constexpr int PC_Q = 0, PC_K = 256, PC_V = 512, PC_Z = 768, PC_X = 1024, PC_B = 1280, PC_C = 1536, PC_CQ = 1792, PC_CF = 2048, PC_CI = 2304, PC_CG = 2560, PC_DX = 2816;
constexpr float EPS = 1e-6f;
enum { I_XP = 0, I_XS, I_CK, I_CV, I_SCONV, I_SSSM, I_SHGRN, I_SPOOL, I_N1, I_WIN, I_AREL, I_CW, I_CB, I_DTB, I_ALOG, I_BD, I_BNRM, I_LB, I_CNRM, I_PW, I_PS, I_WOUT, I_N2, I_WGU, I_WDN, I_NF, N_IN };
constexpr size_t O_YP = 0, O_YS = O_YP + (size_t)MP * D, O_PK = O_YS + (size_t)MS * D, O_PV = O_PK + 2 * 512 * 256, O_PCONV = O_PV + 2 * 512 * 256, O_PSSM = O_PCONV + 2 * 3 * 768,
                 O_PHGRN = O_PSSM + 2 * 4 * 64 * 128, O_PPOOL = O_PHGRN + 2 * 4 * 64 * 64, O_SK = O_PPOOL + 2 * 15 * 256, O_SV = O_SK + (size_t)2 * 16 * 512 * 256,
                 O_SCONV = O_SV + (size_t)2 * 16 * 512 * 256, O_SSSM = O_SCONV + 2 * 16 * 3 * 768, O_SHGRN = O_SSSM + 2 * 16 * 4 * 64 * 128, O_SPOOL = O_SHGRN + 2 * 16 * 4 * 64 * 64,
                 O_END = O_SPOOL + 2 * 16 * 15 * 256;
constexpr size_t MiB = 1u << 20;
constexpr size_t WS_CTL = 0, CTL_ZERO_BYTES = 64 * 1024;
constexpr size_t WL_IN = 0, WL_OUT = 6 * MiB, WL_GU = 8 * MiB, WL_DN = 19 * MiB, WL_STRIDE = 24 * MiB + MiB / 2;
constexpr size_t WS_W = 1 * MiB;
constexpr size_t WS_XN = 50 * MiB;
constexpr size_t WS_PROJ = 83 * MiB;
constexpr size_t WS_STB = 181 * MiB;
constexpr size_t WS_XT = 198 * MiB;
constexpr size_t WS_HALO = 207 * MiB;
constexpr size_t WS_RH = 208 * MiB + MiB / 2;
constexpr size_t WS_STC = 215 * MiB;
constexpr size_t WS_VT = 223 * MiB + MiB / 2;
constexpr size_t WS_DT = 232 * MiB;
constexpr size_t WS_DECB = 233 * MiB;
constexpr size_t WS_DECC = 233 * MiB + 64 * 1024;
constexpr size_t WS_ACS = 233 * MiB + 384 * 1024, WS_DTV = 233 * MiB + 704 * 1024;
constexpr size_t WS_VTA = 234 * MiB;
constexpr size_t WS_END = 243 * MiB;
static_assert(WS_VTA + (size_t)256 * M * 2 <= WS_END, "ws map 2");
constexpr int CW_QUEUE = 512;
static_assert(WS_XN + (size_t)M * D * 2 <= WS_PROJ && WS_PROJ + (size_t)M * NPROJ * 2 <= WS_STB && WS_STB + (size_t)NCH * 4 * 64 * 128 * 2 <= WS_XT && WS_XT + (size_t)NCH * 256 * 64 * 2 <= WS_HALO && WS_HALO + (size_t)256 * 3 * 768 * 2 <= WS_STC && WS_RH + (size_t)NCH * 1280 * 4 <= WS_STC && WS_STC + (size_t)NCH * 4 * 64 * 64 * 2 <= WS_VT && WS_VT + (size_t)NCH * 256 * 64 * 2 <= WS_DT, "ws map");
static_assert(WL_DN + (size_t)D * DFF * 2 <= WL_STRIDE && WS_W + 2 * WL_STRIDE <= WS_XN, "weight map");
constexpr size_t WS_WPT = 128 * 1024;
constexpr size_t WS_RS = 256 * 1024;
constexpr size_t WS_XN2 = 181 * MiB;
static_assert(WS_XN2 + (size_t)M * D * 2 <= 232 * MiB && WS_RS + 2 * (size_t)M * 4 <= MiB, "ws map 3");
constexpr int CW_BAR = 1024;
constexpr int LDS_BYTES = 163840;
constexpr int MISC_OFF = LDS_BYTES - 256;
constexpr int RING_OFF = 0;
typedef LAS float lf32;
typedef float f32x2 __attribute__((ext_vector_type(2)));
struct Args { const float* in[N_IN]; float* out; unsigned char* ws; };
struct Frame {
    LAS unsigned char* lds;
    float* out; unsigned char* ws;
};
__device__ __forceinline__ float* inp(int i) { asm volatile("" : "+s"(i)); return ((float* const __attribute__((address_space(4)))*)__builtin_amdgcn_kernarg_segment_ptr())[i]; }
__device__ __forceinline__ unsigned char* opq(unsigned char* p) { asm volatile("" : "+s"(p)); return p; }
#define ITEM_IDS() int tid_ = threadIdx.x; asm volatile("" : "+v"(tid_)); const int wave_ = __builtin_amdgcn_readfirstlane(tid_ >> 6); const int lane_ = tid_ & 63; (void)lane_; (void)wave_
#define F_XN ((bf16*)opq(F.ws + WS_XN))
#define F_PROJ ((bf16*)opq(F.ws + WS_PROJ))
#define F_ACT ((bf16*)opq(F.ws + WS_PROJ))
#define F_STB ((bf16*)opq(F.ws + WS_STB))
#define F_XT ((bf16*)opq(F.ws + WS_XT))
#define F_HALO ((bf16*)opq(F.ws + WS_HALO))
#define F_ACS ((float*)opq(F.ws + WS_ACS))
#define F_DTV ((float*)opq(F.ws + WS_DTV))
#define F_STC ((bf16*)opq(F.ws + WS_STC))
#define F_VT ((bf16*)opq(F.ws + WS_VT))
#define F_RH ((float*)opq(F.ws + WS_RH))
#define F_VTA ((bf16*)opq(F.ws + WS_VTA))
#define F_WPT ((bf16*)opq(F.ws + WS_WPT))
#define F_RS ((float*)opq(F.ws + WS_RS))
#define F_XN2 ((bf16*)opq(F.ws + WS_XN2))
#define F_DT ((float*)opq(F.ws + WS_DT))
#define F_DECB ((float*)opq(F.ws + WS_DECB))
#define F_DECC ((float*)opq(F.ws + WS_DECC))
#define F_X    (F.out)
__device__ __forceinline__ float bf_lo(unsigned w) { return __builtin_bit_cast(float, w << 16); }
__device__ __forceinline__ float bf_hi(unsigned w) { return __builtin_bit_cast(float, w & 0xffff0000u); }
__device__ __forceinline__ float bf1(bf16 b) { return __builtin_bit_cast(float, (unsigned)b << 16); }
__device__ __forceinline__ void unpack8(const v4u w, float (&v)[8]) { v[0] = bf_lo(w.x); v[1] = bf_hi(w.x); v[2] = bf_lo(w.y); v[3] = bf_hi(w.y); v[4] = bf_lo(w.z); v[5] = bf_hi(w.z); v[6] = bf_lo(w.w); v[7] = bf_hi(w.w); }
__device__ __forceinline__ v4u pack8(const float (&v)[8]) { v4u o; o.x = pk2(v[0], v[1]); o.y = pk2(v[2], v[3]); o.z = pk2(v[4], v[5]); o.w = pk2(v[6], v[7]); return o; }
__device__ __forceinline__ float shx(int lane, float v, int o) { return __builtin_bit_cast(float, __builtin_amdgcn_ds_bpermute((lane ^ o) << 2, __builtin_bit_cast(int, v))); }
__device__ __forceinline__ float shu(int lane, float v, int o) { return __builtin_bit_cast(float, __builtin_amdgcn_ds_bpermute((lane - o) << 2, __builtin_bit_cast(int, v))); }
__device__ __forceinline__ float shi(float v, int idx) { return __builtin_bit_cast(float, __builtin_amdgcn_ds_bpermute(idx << 2, __builtin_bit_cast(int, v))); }
__device__ __forceinline__ float wave_sum_l(int lane, float v) {
#pragma unroll
    for (int o = 1; o < 64; o <<= 1) v += shx(lane, v, o);
    return v;
}
__device__ __forceinline__ float sum16_l(int lane, float v) {
#pragma unroll
    for (int o = 1; o < 16; o <<= 1) v += shx(lane, v, o);
    return v;
}
__device__ __forceinline__ float max16_l(int lane, float v) {
#pragma unroll
    for (int o = 1; o < 16; o <<= 1) v = fmaxf(v, shx(lane, v, o));
    return v;
}
__device__ __forceinline__ float rcp_f(float x) { return __builtin_amdgcn_rcpf(x); }
__device__ __forceinline__ float rsq_f(float x) { return __builtin_amdgcn_rsqf(x); }
__device__ __forceinline__ float sigmoid_f(float x) { return rcp_f(1.0f + __expf(-x)); }
__device__ __forceinline__ float silu_g(float x) { return x * rcp_f(1.0f + __expf(-x)); }
__device__ __forceinline__ float softplus_f(float x) { const float e = __expf(x); return x > 20.f ? x : (e < 0.01f ? e * (1.0f - e * (0.5f - e * (1.0f / 3.0f))) : __logf(1.0f + e)); }
__device__ __forceinline__ f32x4 mfma4(float a, float b, f32x4 c) { return __builtin_amdgcn_mfma_f32_16x16x4f32(a, b, c, 0, 0, 0); }

struct Chunk { int ci, row0, nrows, b; };
__device__ __forceinline__ Chunk chunk_of(int ci) { Chunk c; c.ci = ci; if (ci < NCHP) { c.row0 = 64 * ci; c.nrows = 64; c.b = -1; } else { c.b = ci - NCHP; c.row0 = MP + SSEQ * c.b; c.nrows = SSEQ; } return c; }

__device__ __forceinline__ void tr_item64(const float* W, int ldw, int K, bf16* WT, int k0, int nd0, int ns0, float scale, lf32* scr, int lane) {
    f32x4 wv_[16];
    const int rq = lane >> 4, c4 = (lane & 15) * 4;
#pragma unroll
    for (int i = 0; i < 16; ++i) wv_[i] = *(const f32x4*)(W + (size_t)(k0 + 4 * i + rq) * ldw + ns0 + c4);
#pragma unroll
    for (int i = 0; i < 16; ++i) { lf32* d = scr + (4 * i + rq) * 65 + c4; d[0] = wv_[i].x; d[1] = wv_[i].y; d[2] = wv_[i].z; d[3] = wv_[i].w; }
    LDS_WAIT(); asm volatile("" ::: "memory");
    const int c = lane & 7;
#pragma unroll
    for (int j = 0; j < 8; ++j) { const int n = (lane >> 3) + 8 * j; const lf32* s = scr + (8 * c) * 65 + n;
        v4u o; o.x = pk2(s[0 * 65] * scale, s[1 * 65] * scale); o.y = pk2(s[2 * 65] * scale, s[3 * 65] * scale); o.z = pk2(s[4 * 65] * scale, s[5 * 65] * scale); o.w = pk2(s[6 * 65] * scale, s[7 * 65] * scale);
        *(GAS v4u*)(WT + (size_t)(nd0 + n) * K + k0 + 8 * c) = o; }
    LDS_WAIT(); asm volatile("" ::: "memory");
}
__device__ __forceinline__ void tr_item(const float* W, int ldw, int K, bf16* WT, int k0, int nd0, int ns0, float scale, lf32* scr, int lane) {
    float wv_[32];
#pragma unroll
    for (int i = 0; i < 32; ++i) wv_[i] = W[(size_t)(k0 + 2 * i + (lane >> 5)) * ldw + ns0 + (lane & 31)];
#pragma unroll
    for (int i = 0; i < 32; ++i) scr[(2 * i + (lane >> 5)) * 33 + (lane & 31)] = wv_[i];
    LDS_WAIT(); asm volatile("" ::: "memory");
    const int c = lane & 7;
#pragma unroll
    for (int j = 0; j < 4; ++j) { const int n = (lane >> 3) + 8 * j; const lf32* s = scr + (8 * c) * 33 + n;
        v4u o; o.x = pk2(s[0 * 33] * scale, s[1 * 33] * scale); o.y = pk2(s[2 * 33] * scale, s[3 * 33] * scale); o.z = pk2(s[4 * 33] * scale, s[5 * 33] * scale); o.w = pk2(s[6 * 33] * scale, s[7 * 33] * scale);
        *(GAS v4u*)(WT + (size_t)(nd0 + n) * K + k0 + 8 * c) = o; }
    LDS_WAIT(); asm volatile("" ::: "memory");
}
__device__ __forceinline__ void p0_weights(Frame& F, int l, int gw, int NGW, bool pool) {
    ITEM_IDS();
    lf32* scr = (lf32*)(F.lds + wave_ * 16896);
    constexpr int I_INA = 16 * 28, I_INB = 16 * 40, I_OUT = 16 * 16, I_GU = 16 * 88, I_DN = 44 * 16, I_L = I_INA + I_INB + I_OUT + I_GU + I_DN;
    unsigned char* wl = F.ws + WS_W + (size_t)l * WL_STRIDE;
    for (int it = gw; it < I_L; it += NGW) {
        int r = it;
        if (r < I_INA) { const int kb = r / 28, nb = r % 28, nd0 = 64 * nb; tr_item64(inp(I_WIN) + (size_t)l * D * NIN, NIN, D, (bf16*)(wl + WL_IN), 64 * kb, nd0, nd0, nd0 < 256 ? 0.125f : 1.0f, scr, lane_); continue; } r -= I_INA;
        if (r < I_INB) { const int kb = r / 40, nb = r % 40, nd0 = 1792 + 32 * nb; tr_item(inp(I_WIN) + (size_t)l * D * NIN, NIN, D, (bf16*)(wl + WL_IN), 64 * kb, nd0, nd0 + 4, 1.0f, scr, lane_); continue; } r -= I_INB;
        if (r < I_OUT) { const int kb = r / 16, nb = r % 16; tr_item64(inp(I_WOUT) + (size_t)l * D * D, D, D, (bf16*)(wl + WL_OUT), 64 * kb, 64 * nb, 64 * nb, 1.0f, scr, lane_); continue; } r -= I_OUT;
        if (r < I_GU) { const int kb = r / 88, nb = r % 88, nd0 = 64 * nb, pn = nd0 >> 8, bj = (nd0 >> 7) & 1, c = nd0 & 127; tr_item64(inp(I_WGU) + (size_t)l * D * NGU, NGU, D, (bf16*)(wl + WL_GU), 64 * kb, nd0, bj * DFF + 128 * pn + c, 1.0f, scr, lane_); continue; } r -= I_GU;
        { const int kb = r / 16, nb = r % 16; tr_item64(inp(I_WDN) + (size_t)l * DFF * D, D, DFF, (bf16*)(wl + WL_DN), 64 * kb, 64 * nb, 64 * nb, 1.0f, scr, lane_); }
    }
    if (pool) { const float* pw = inp(I_PW); for (int i = ((int)blockIdx.x) * NTHR + tid_; i < 2 * 4 * 64 * 64; i += ((int)gridDim.x) * NTHR) { const int c = i & 63, d = (i >> 6) & 63, lg = i >> 12; F_WPT[i] = (bf16)f2bf(pw[(size_t)(lg * 64 + c) * 64 + d]); } }
}
template <bool WITH_DT, bool FINAL>
__device__ __forceinline__ void norm_rows(Frame& F, const float* xlo, const float* xhi, const float* w, const float* wdt  , const bf16* xb = nullptr  ) {
    ITEM_IDS();
    lf32* wl = (lf32*)F.lds;
    if (WITH_DT) { for (int k = tid_; k < D; k += NTHR) { const f32x4 v = *(const f32x4*)(wdt + (size_t)k * NIN + 1792); *(LAS f32x4*)(wl + 4 * k) = v; } __syncthreads(); }
    const int gw = ((int)blockIdx.x) * NWAVES + wave_, NGW = ((int)gridDim.x) * NWAVES;
    f32x4 wv[4];
#pragma unroll
    for (int j = 0; j < 4; ++j) wv[j] = *(const f32x4*)(w + 256 * j + 4 * lane_);
    for (int m0 = gw; m0 < M; m0 += 4 * NGW) {
        f32x4 v[4][4];
#pragma unroll
        for (int q = 0; q < 4; ++q) { const int m = m0 + q * NGW; if (m < M) {
            if (xb) {
#pragma unroll
                for (int j = 0; j < 4; ++j) { const unsigned long long t = *(const unsigned long long*)(xb + (size_t)m * D + 256 * j + 4 * lane_); v[q][j] = (f32x4){bf_lo((unsigned)t), bf_hi((unsigned)t), bf_lo((unsigned)(t >> 32)), bf_hi((unsigned)(t >> 32))}; }
            } else { const float* xr = (m < MP ? xlo : xhi) + (size_t)m * D;
#pragma unroll
                for (int j = 0; j < 4; ++j) v[q][j] = *(const f32x4*)(xr + 256 * j + 4 * lane_); } } }
#pragma unroll
        for (int q = 0; q < 4; ++q) { const int m = m0 + q * NGW; if (m < M) {
            float s = 0.f;
#pragma unroll
            for (int j = 0; j < 4; ++j) s += (v[q][j].x * v[q][j].x + v[q][j].y * v[q][j].y) + (v[q][j].z * v[q][j].z + v[q][j].w * v[q][j].w);
            const float rstd = rsq_f(wave_sum_l(lane_, s) * (1.0f / D) + EPS);
#pragma unroll
            for (int j = 0; j < 4; ++j) v[q][j] = v[q][j] * rstd * wv[j];
            if (FINAL) {
#pragma unroll
                for (int j = 0; j < 4; ++j) *(f32x4*)(F.out + (size_t)m * D + 256 * j + 4 * lane_) = v[q][j];
            } else {
                GAS unsigned long long* o8 = (GAS unsigned long long*)(F_XN + (size_t)m * D) + lane_;
#pragma unroll
                for (int j = 0; j < 4; ++j) o8[64 * j] = (unsigned long long)pk2(v[q][j].x, v[q][j].y) | ((unsigned long long)pk2(v[q][j].z, v[q][j].w) << 32);
            }
            if (WITH_DT) {
                f32x4 a = {0.f, 0.f, 0.f, 0.f};
#pragma unroll
                for (int j = 0; j < 4; ++j) { const LAS f32x4* wp = (const LAS f32x4*)(wl + 4 * (256 * j + 4 * lane_));
                    a += wp[0] * v[q][j].x; a += wp[1] * v[q][j].y; a += wp[2] * v[q][j].z; a += wp[3] * v[q][j].w; }
                a.x = wave_sum_l(lane_, a.x); a.y = wave_sum_l(lane_, a.y); a.z = wave_sum_l(lane_, a.z); a.w = wave_sum_l(lane_, a.w);
                if (lane_ == 0) *(f32x4*)(F_DT + (size_t)m * 4) = a;
            } } }
    }
    if (WITH_DT) __syncthreads();
}
constexpr int PL_RAW = 0, PL_PL = 79 * 256 * 4, PL_END = PL_PL + 64 * 264 * 2;
static_assert(PL_END <= MISC_OFF, "pool LDS map");
__device__ __forceinline__ void pool_item(Frame& F, int layer, int ci) {
    ITEM_IDS();
    const Chunk c = chunk_of(ci);
    lf32* raw = (lf32*)(F.lds + PL_RAW);
    LAS bf16* Pl = (LAS bf16*)(F.lds + PL_PL);
    const float* spool = inp(I_SPOOL) + (size_t)(layer * NSB + (c.b < 0 ? 0 : c.b)) * 15 * 256;
    v4u pw[5]; f32x4 pf[5][2];
#pragma unroll
    for (int q = 0; q < 5; ++q) { const int it = tid_ + q * NTHR; pw[q] = (v4u){0u, 0u, 0u, 0u}; pf[q][0] = (f32x4){0.f, 0.f, 0.f, 0.f}; pf[q][1] = pf[q][0];
        if (it < 79 * 32) { const int rr = it >> 5, cg = it & 31, r = rr - 15;
            if (r < c.nrows) { if (r >= 0 || (c.b < 0 && c.row0 + r >= 0)) pw[q] = *(const v4u*)(F_PROJ + (size_t)(c.row0 + r) * NPROJ + PC_DX + 8 * cg);
                               else if (c.b >= 0) { const float* s = spool + (size_t)(15 + r) * 256 + 8 * cg; pf[q][0] = *(const f32x4*)s; pf[q][1] = *(const f32x4*)(s + 4); } } } }
#pragma unroll
    for (int q = 0; q < 5; ++q) { const int it = tid_ + q * NTHR;
        if (it < 79 * 32) { const int rr = it >> 5, cg = it & 31, r = rr - 15; float v[8];
            if (c.b >= 0 && r < 0) { v[0] = pf[q][0].x; v[1] = pf[q][0].y; v[2] = pf[q][0].z; v[3] = pf[q][0].w; v[4] = pf[q][1].x; v[5] = pf[q][1].y; v[6] = pf[q][1].z; v[7] = pf[q][1].w; } else unpack8(pw[q], v);
            *(LAS f32x4*)(raw + rr * 256 + 8 * cg) = (f32x4){v[0], v[1], v[2], v[3]}; *(LAS f32x4*)(raw + rr * 256 + 8 * cg + 4) = (f32x4){v[4], v[5], v[6], v[7]}; } }
    __syncthreads();
    { const int ch = tid_ & 255, half = tid_ >> 8, win = 2 << (ch >> 6); const float inv = 1.0f / (float)win;
      const lf32* rp = raw + (32 * half + 15) * 256 + ch;
      float s = 0.f; for (int q = 1; q < win; ++q) s += rp[-q * 256];
#pragma unroll 8
      for (int r = 0; r < 32; ++r) { const float x = rp[r * 256], xo = rp[(r - win + 1) * 256]; s += x; Pl[(32 * half + r) * 264 + ch] = (bf16)f2bf(s * inv - x); s -= xo; } }
    __syncthreads();
    const int tb = wave_ >> 1, g0 = 2 * (wave_ & 1), kq = lane_ >> 4, fr = lane_ & 15;
    const bf16* wt = F_WPT + (size_t)layer * 4 * 64 * 64; const float* sc = inp(I_PS) + (size_t)layer * 256;
#pragma unroll
    for (int gg = 0; gg < 2; ++gg) {
        const int g = g0 + gg;
        bf16x8 bw[4][2];
#pragma unroll
        for (int t = 0; t < 4; ++t)
#pragma unroll
            for (int ks = 0; ks < 2; ++ks) bw[t][ks] = *(const bf16x8*)(wt + (size_t)(g * 64 + t * 16 + fr) * 64 + 32 * ks + 8 * kq);
        bf16x8 a[2];
#pragma unroll
        for (int ks = 0; ks < 2; ++ks) a[ks] = *(const LAS bf16x8*)(Pl + (tb * 16 + fr) * 264 + g * 64 + 32 * ks + 8 * kq);
#pragma unroll
        for (int t = 0; t < 4; ++t) { f32x4 acc = {0.f, 0.f, 0.f, 0.f};
#pragma unroll
            for (int ks = 0; ks < 2; ++ks) acc = __builtin_amdgcn_mfma_f32_16x16x32_bf16(a[ks], bw[t][ks], acc, 0, 0, 0);
            const float s = sc[g * 64 + t * 16 + fr];
#pragma unroll
            for (int r = 0; r < 4; ++r) { const int row = tb * 16 + 4 * kq + r; if (row < c.nrows) F_XN[(size_t)(c.row0 + row) * D + 768 + g * 64 + t * 16 + fr] = (bf16)f2bf(acc[r] * s); } }
    }
    __syncthreads();
}

__device__ __forceinline__ void copy_cache(Frame& F, int layer, int b0, int nb) {
    ITEM_IDS();
    const int gt = b0 * NTHR + tid_, GT = nb * NTHR;
    float* out = F.out; const float* ckp = inp(I_CK); const float* cvp = inp(I_CV);
    for (int base = gt; base < 32 * 31744; base += 8 * GT) {
        f32x4 v[8];
#pragma unroll
        for (int q = 0; q < 8; ++q) { const int i = base + q * GT; if (i < 32 * 31744) { const int wb = i / 31744, e = i - wb * 31744; const int which = wb >> 4, b = wb & 15;
            v[q] = *(const f32x4*)((which ? cvp : ckp) + ((size_t)(layer * NSB + b) * 512 + 16) * 256 + 4 * (size_t)e); } }
#pragma unroll
        for (int q = 0; q < 8; ++q) { const int i = base + q * GT; if (i < 32 * 31744) { const int wb = i / 31744, e = i - wb * 31744; const int which = wb >> 4, b = wb & 15;
            *(f32x4*)(out + (which ? O_SV : O_SK) + (size_t)(layer * NSB + b) * 512 * 256 + 4 * (size_t)e) = v[q]; } }
    }
}
__device__ __forceinline__ void copy_small(Frame& F, int layer, int b0, int nb) {
    ITEM_IDS();
    const int gt = b0 * NTHR + tid_, GT = nb * NTHR;
    float* out = F.out;
    constexpr int T_P = 2 * 512 * 32, T_S = 2 * 16 * 16 * 32, T_D = 17 * 15 * 32, T_ALL = T_P + T_S + T_D;
    for (int base = gt; base < T_ALL; base += 4 * GT) {
        v4u w[4];
#pragma unroll
        for (int q = 0; q < 4; ++q) { int t = base + q * GT; if (t < T_ALL) { size_t src;
            if (t < T_P) { const int which = t >> 14, j = (t >> 5) & 511, cg = t & 31; src = (size_t)(MP - 512 + j) * NPROJ + (which ? PC_V : PC_K) + 8 * cg; }
            else if (t < T_P + T_S) { t -= T_P; const int which = t >> 13, b = (t >> 9) & 15, j = (t >> 5) & 15, cg = t & 31; src = (size_t)(MP + 16 * b + j) * NPROJ + (which ? PC_V : PC_K) + 8 * cg; }
            else { t -= T_P + T_S; const int b = t / 480, rr = (t / 32) % 15, cg = t & 31; src = (size_t)(b == 0 ? MP - 15 + rr : MP + 16 * (b - 1) + 1 + rr) * NPROJ + PC_DX + 8 * cg; }
            w[q] = *(const v4u*)(F_PROJ + src); } }
#pragma unroll
        for (int q = 0; q < 4; ++q) { int t = base + q * GT; if (t < T_ALL) { size_t dst;
            if (t < T_P) { const int which = t >> 14, j = (t >> 5) & 511, cg = t & 31; dst = (which ? O_PV : O_PK) + (size_t)layer * 512 * 256 + j * 256 + 8 * cg; }
            else if (t < T_P + T_S) { t -= T_P; const int which = t >> 13, b = (t >> 9) & 15, j = (t >> 5) & 15, cg = t & 31; dst = (which ? O_SV : O_SK) + ((size_t)(layer * NSB + b) * 512 + 496 + j) * 256 + 8 * cg; }
            else { t -= T_P + T_S; const int b = t / 480, rr = (t / 32) % 15, cg = t & 31; dst = (b == 0 ? O_PPOOL + (size_t)layer * 3840 : O_SPOOL + (size_t)(layer * NSB + b - 1) * 3840) + rr * 256 + 8 * cg; }
            float v[8]; unpack8(w[q], v); *(f32x4*)(out + dst) = (f32x4){v[0], v[1], v[2], v[3]}; *(f32x4*)(out + dst + 4) = (f32x4){v[4], v[5], v[6], v[7]}; } }
    }
}
constexpr int KS_LD = 72, PS_LD = 584;
constexpr int AT_KS = 0, AT_VT = 576 * KS_LD * 2, AT_ST = AT_VT + 64 * PS_LD * 2, AT_BIAS = AT_ST + 1024;
static_assert(AT_BIAS + 4 * 260 * 4 <= MISC_OFF, "attention LDS map");
__device__ __forceinline__ void attn_bias_load(Frame& F, int layer) { const float* arel = inp(I_AREL) + (size_t)layer * 257 * 4; lf32* b = (lf32*)(F.lds + AT_BIAS); ITEM_IDS(); for (int i = tid_; i < 257 * 4; i += NTHR) b[260 * (i & 3) + (i >> 2)] = arel[i]; }
__device__ __forceinline__ void attn_item(Frame& F, int layer, int ci, int h) {
    ITEM_IDS();
    const Chunk c = chunk_of(ci);
    LAS bf16* Ks = (LAS bf16*)(F.lds + AT_KS); LAS bf16* Ps = Ks; LAS bf16* Vt = (LAS bf16*)(F.lds + AT_VT);
    lf32* mx = (lf32*)(F.lds + AT_ST); lf32* sm = mx + 128; lf32* bias = (lf32*)(F.lds + AT_BIAS) + 260 * h;
    const int jlo = (c.b < 0) ? (ci < 8 ? 64 * (8 - ci) : 0) : 0;
    const int jval = (c.b < 0) ? 576 : 528;
    const float* ckp = inp(I_CK); const float* cvp = inp(I_CV);
    bf16x8 qa0 = {0, 0, 0, 0, 0, 0, 0, 0}, qa1 = qa0;
    if (c.b < 0 || (wave_ >> 1) == 0) { const bf16* qp = F_PROJ + (size_t)(c.row0 + (wave_ >> 1) * 16 + (lane_ & 15)) * NPROJ + PC_Q + 64 * h + 8 * (lane_ >> 4); qa0 = *(const bf16x8*)qp; qa1 = *(const bf16x8*)(qp + 32); }
    if (c.b < 0) {
        const bf16* kg = F_PROJ + (long)(c.row0 - 512) * NPROJ + PC_K + 64 * h;
        const bf16* vg = F_VTA + (long)(64 * h) * M + (long)(c.row0 - 512);
        const int npc = (576 - jlo) >> 3, nk = (576 - jlo) * 8, nv = 64 * npc;
        v4u kr[9], vr[9];
#pragma unroll
        for (int q = 0; q < 9; ++q) { const int it = tid_ + q * NTHR;
            if (it < nk) kr[q] = *(const v4u*)(kg + (long)(jlo + (it >> 3)) * NPROJ + 8 * (it & 7));
            if (it < nv) { const int d = it / npc, pc = it - d * npc; vr[q] = *(const v4u*)(vg + (long)d * M + jlo + 8 * pc); } }
#pragma unroll
        for (int q = 0; q < 9; ++q) { const int it = tid_ + q * NTHR;
            if (it < nk) *(LAS v4u*)(Ks + (jlo + (it >> 3)) * KS_LD + 8 * (it & 7)) = kr[q];
            if (it < nv) { const int d = it / npc, pc = it - d * npc; *(LAS v4u*)(Vt + d * PS_LD + jlo + 8 * pc) = vr[q]; } }
    } else {
    for (int it = tid_; it < (576 - jlo) * 8; it += NTHR) {
        const int j = jlo + (it >> 3), dg = it & 7;
        v4u kw, vw;
        if (j < 512) { const size_t o = (((size_t)(layer * NSB + c.b) * 512 + j) * 4 + h) * 64 + 8 * dg; const float* kp = ckp + o; const float* vp = cvp + o;
            const f32x4 k0 = *(const f32x4*)kp, k1 = *(const f32x4*)(kp + 4), v0 = *(const f32x4*)vp, v1 = *(const f32x4*)(vp + 4);
            kw.x = pk2(k0.x, k0.y); kw.y = pk2(k0.z, k0.w); kw.z = pk2(k1.x, k1.y); kw.w = pk2(k1.z, k1.w); vw.x = pk2(v0.x, v0.y); vw.y = pk2(v0.z, v0.w); vw.z = pk2(v1.x, v1.y); vw.w = pk2(v1.z, v1.w); }
        else if (j < 528) { const size_t row = (size_t)(c.row0 + j - 512); kw = *(const v4u*)(F_PROJ + row * NPROJ + PC_K + 64 * h + 8 * dg); vw = *(const v4u*)(F_PROJ + row * NPROJ + PC_V + 64 * h + 8 * dg); }
        else { kw = (v4u){0u, 0u, 0u, 0u}; vw = kw; }
        *(LAS v4u*)(Ks + j * KS_LD + 8 * dg) = kw;
        LAS bf16* vt = Vt + (8 * dg) * PS_LD + j;
        vt[0 * PS_LD] = (bf16)(vw.x & 0xffffu); vt[1 * PS_LD] = (bf16)(vw.x >> 16); vt[2 * PS_LD] = (bf16)(vw.y & 0xffffu); vt[3 * PS_LD] = (bf16)(vw.y >> 16);
        vt[4 * PS_LD] = (bf16)(vw.z & 0xffffu); vt[5 * PS_LD] = (bf16)(vw.z >> 16); vt[6 * PS_LD] = (bf16)(vw.w & 0xffffu); vt[7 * PS_LD] = (bf16)(vw.w >> 16);
    }
    }
    __syncthreads();
    const int qb = wave_ >> 1, kh = wave_ & 1, kq = lane_ >> 4, fr = lane_ & 15;
    const bool active = (c.b < 0) || (qb == 0);
    const int ntw = (576 - jlo) / 32;
    const int kbase = jlo + kh * ntw * 16;
    f32x4 s[18];
    float mloc = -3.0e38f;
    const int iq = qb * 16 + fr;
    if (active) {
#pragma unroll
        for (int t = 0; t < 18; ++t) {
            s[t] = (f32x4){0.f, 0.f, 0.f, 0.f};
            if (t < ntw) {
                const LAS bf16* kp = Ks + (kbase + t * 16 + fr) * KS_LD + 8 * kq;
                const bf16x8 kb0 = *(const LAS bf16x8*)kp, kb1 = *(const LAS bf16x8*)(kp + 32);
                s[t] = __builtin_amdgcn_mfma_f32_16x16x32_bf16(kb0, qa0, s[t], 0, 0, 0);
                s[t] = __builtin_amdgcn_mfma_f32_16x16x32_bf16(kb1, qa1, s[t], 0, 0, 0);
#pragma unroll
                for (int r = 0; r < 4; ++r) { const int j = kbase + t * 16 + 4 * kq + r; int rel = 512 + iq - j; rel = rel > 128 ? 128 : rel; float v = s[t][r] + bias[rel + 128]; if (j >= jval) v = -1.0e30f; s[t][r] = v; mloc = fmaxf(mloc, v); }
            }
        }
        mloc = fmaxf(mloc, shx(lane_, mloc, 16)); mloc = fmaxf(mloc, shx(lane_, mloc, 32));
        if (kq == 0) mx[iq * 2 + kh] = mloc;
    }
    __syncthreads();
    if (active) {
        mloc = fmaxf(mx[iq * 2], mx[iq * 2 + 1]);
        float lsum = 0.f;
#pragma unroll
        for (int t = 0; t < 18; ++t) if (t < ntw) {
            const float p0 = __expf(s[t][0] - mloc), p1 = __expf(s[t][1] - mloc), p2 = __expf(s[t][2] - mloc), p3 = __expf(s[t][3] - mloc);
            lsum += (p0 + p1) + (p2 + p3);
            *(LAS f32x2*)(Ps + iq * PS_LD + kbase + t * 16 + 4 * kq) = __builtin_bit_cast(f32x2, (unsigned long long)pk2(p0, p1) | ((unsigned long long)pk2(p2, p3) << 32));
        }
        lsum += shx(lane_, lsum, 16); lsum += shx(lane_, lsum, 32);
        if (kq == 0) sm[iq * 2 + kh] = lsum;
    }
    __syncthreads();
    if (active) {
        f32x4 o[2] = {(f32x4){0.f, 0.f, 0.f, 0.f}, (f32x4){0.f, 0.f, 0.f, 0.f}};
        const int nks = (576 - jlo) / 32;
#pragma unroll 2
        for (int ks = 0; ks < nks; ++ks) {
            const int j0 = jlo + 32 * ks + 8 * kq;
            const bf16x8 pa = *(const LAS bf16x8*)(Ps + iq * PS_LD + j0);
#pragma unroll
            for (int t = 0; t < 2; ++t) { const bf16x8 vb = *(const LAS bf16x8*)(Vt + (kh * 32 + t * 16 + fr) * PS_LD + j0); o[t] = __builtin_amdgcn_mfma_f32_16x16x32_bf16(vb, pa, o[t], 0, 0, 0); }
        }
        const float inv = rcp_f(sm[iq * 2] + sm[iq * 2 + 1]);
#pragma unroll
        for (int t = 0; t < 2; ++t) *(f32x2*)(F_XN + (size_t)(c.row0 + iq) * D + 64 * h + kh * 32 + t * 16 + 4 * kq) =
            __builtin_bit_cast(f32x2, (unsigned long long)pk2(o[t][0] * inv, o[t][1] * inv) | ((unsigned long long)pk2(o[t][2] * inv, o[t][3] * inv) << 32));
    }
    __syncthreads();
}
__device__ __forceinline__ void scan_phase(Frame& F, int layer) {
    ITEM_IDS();
    lf32* db = (lf32*)F.lds; lf32* dcl = db + NCHP * 4;
    for (int i = tid_; i < NCHP * 4; i += NTHR) db[i] = F_DECB[i];
    __syncthreads();
    constexpr int NSCAN = 48;
    if (((int)blockIdx.x) < NSCAN) {
        const int u = ((int)blockIdx.x) * NTHR + tid_;
        if (u < 16384) {
            unsigned* st = (unsigned*)F_STB + u; const int hb = u >> 12;
            float r0 = 0.f, r1 = 0.f;
            for (int c0 = 0; c0 < NCHP; c0 += 64) {
                unsigned sl[64];
#pragma unroll
                for (int i = 0; i < 64; ++i) sl[i] = st[(size_t)(c0 + i) * 16384];
#pragma unroll
                for (int i = 0; i < 64; ++i) { const float d0 = db[(c0 + i) * 4 + hb]; st[(size_t)(c0 + i) * 16384] = pk2(r0, r1); r0 = d0 * r0 + bf_lo(sl[i]); r1 = d0 * r1 + bf_hi(sl[i]); }
            }
            *(f32x2*)(F.out + O_PSSM + (size_t)layer * 32768 + 2 * u) = (f32x2){r0, r1};
        } else {
            const int u2 = u - 16384;
            unsigned* st = (unsigned*)F_STC + u2; const int hk = (u2 >> 11) * 64 + 2 * (u2 & 31); const float* dg = F_DECC + hk;
            float r0 = 0.f, r1 = 0.f;
            for (int c0 = 0; c0 < NCHP; c0 += 32) {
                unsigned sl[32]; f32x2 dd[32];
#pragma unroll
                for (int i = 0; i < 32; ++i) { sl[i] = st[(size_t)(c0 + i) * 8192]; dd[i] = *(const f32x2*)(dg + (size_t)(c0 + i) * 256); }
#pragma unroll
                for (int i = 0; i < 32; ++i) { st[(size_t)(c0 + i) * 8192] = pk2(r0, r1); r0 = dd[i].x * r0 + bf_lo(sl[i]); r1 = dd[i].y * r1 + bf_hi(sl[i]); }
            }
            const int v = (u2 >> 5) & 63; float* o = F.out + O_PHGRN + (size_t)layer * 16384 + (size_t)hk * 64 + v; o[0] = r0; o[64] = r1;
        }
    }
    else {
        const int nb = ((int)gridDim.x) - NSCAN, b0 = ((int)blockIdx.x) - NSCAN;
        copy_small(F, layer, b0, nb);
        const float* sssm = inp(I_SSSM) + (size_t)layer * NSB * 32768; const float* shgrn = inp(I_SHGRN) + (size_t)layer * NSB * 16384;
        float* osb = F.out + O_SSSM + (size_t)layer * NSB * 32768; float* osc = F.out + O_SHGRN + (size_t)layer * NSB * 16384;
        for (int t = b0 * NTHR + tid_; t < NSB * 8192; t += nb * NTHR) {
            const int b = t >> 13, e = (t & 8191) * 4; const f32x4 s0 = *(const f32x4*)(sssm + (size_t)b * 32768 + e); const unsigned long long w = *(const unsigned long long*)(F_STB + (size_t)(NCHP + b) * 32768 + e);
            const float d = F_DECB[(NCHP + b) * 4 + (e >> 13)];
            *(f32x4*)(osb + (size_t)b * 32768 + e) = (f32x4){d * s0.x + bf_lo((unsigned)w), d * s0.y + bf_hi((unsigned)w), d * s0.z + bf_lo((unsigned)(w >> 32)), d * s0.w + bf_hi((unsigned)(w >> 32))}; }
        for (int t = b0 * NTHR + tid_; t < NSB * 4096; t += nb * NTHR) {
            const int b = t >> 12, e2 = (t & 4095) * 4, hk = e2 >> 6, v = e2 & 63; const f32x4 s0 = *(const f32x4*)(shgrn + (size_t)b * 16384 + e2);
            const bf16* sp = F_STC + (size_t)(NCHP + b) * 16384 + (size_t)((hk >> 6) * 64 + v) * 64 + (hk & 63); const float d = F_DECC[(size_t)(NCHP + b) * 256 + hk];
            *(f32x4*)(osc + (size_t)b * 16384 + e2) = (f32x4){d * s0.x + bf1(sp[0]), d * s0.y + bf1(sp[64]), d * s0.z + bf1(sp[128]), d * s0.w + bf1(sp[192])}; }
    }
}
constexpr int SP_XT = 0, SP_BT = 256 * 72 * 2, SP_ACS = 2 * 256 * 72 * 2, SP_DTV = SP_ACS + 1024, SP_SJ = SP_DTV + 1024, SP_END = SP_SJ + 1024;
static_assert(SP_END <= MISC_OFF, "ssd_prep LDS map");
__device__ __forceinline__ void ssd_prep_item(Frame& F, int layer, int ci) {
    ITEM_IDS();
    const Chunk c = chunk_of(ci);
    LAS bf16* XTl = (LAS bf16*)(F.lds + SP_XT); LAS bf16* BTl = (LAS bf16*)(F.lds + SP_BT);
    lf32* acs = (lf32*)(F.lds + SP_ACS); lf32* dtv = (lf32*)(F.lds + SP_DTV); lf32* sj = (lf32*)(F.lds + SP_SJ);
    const int cg = tid_ % 96, seg = tid_ / 96, col = 8 * cg;
    const bool act = seg < 4 && 16 * seg < c.nrows;
    bf16* prow = F_PROJ + (size_t)c.row0 * NPROJ + PC_X + col;
    v4u raw[19];
    if (act) {
#pragma unroll
        for (int q = 0; q < 19; ++q) { const int r = 16 * seg - 3 + q;
            if (r >= 0) raw[q] = *(const v4u*)(prow + (size_t)r * NPROJ);
            else if (c.b < 0) { if (ci > 0) raw[q] = *(const v4u*)(F_HALO + ((size_t)(ci - 1) * 3 + (3 + r)) * 768 + col); else raw[q] = (v4u){0u, 0u, 0u, 0u}; }
            else { const float* s = inp(I_SCONV) + ((size_t)(layer * NSB + c.b) * 3 + (3 + r)) * 768 + col; const f32x4 a = *(const f32x4*)s, b2 = *(const f32x4*)(s + 4);
                raw[q].x = pk2(a.x, a.y); raw[q].y = pk2(a.z, a.w); raw[q].z = pk2(b2.x, b2.y); raw[q].w = pk2(b2.z, b2.w); } }
    }
    if (wave_ == 6) { const int r = lane_; const float* dtb = inp(I_DTB) + layer * 4; const float* alg = inp(I_ALOG) + layer * 4;
        f32x4 raw4 = {0.f, 0.f, 0.f, 0.f}; if (r < c.nrows) raw4 = *(const f32x4*)(F_DT + (size_t)(c.row0 + r) * 4);
        f32x4 dt4, ac4;
#pragma unroll
        for (int h = 0; h < 4; ++h) { float dt = 0.f; if (r < c.nrows) dt = softplus_f(raw4[h] + dtb[h]); float v = -__expf(alg[h]) * dt;
#pragma unroll
            for (int o = 1; o < 64; o <<= 1) { const float t = shu(lane_, v, o); if (lane_ >= o) v += t; }
            const float last = shi(v, 63);
            dt4[h] = dt; ac4[h] = v; acs[r * 4 + h] = v; dtv[r * 4 + h] = dt; sj[h * 64 + r] = dt * __expf(last - v);
            if (r == 63) F_DECB[ci * 4 + h] = __expf(last); }
        if (r < c.nrows) { *(f32x4*)(F_DTV + (size_t)(c.row0 + r) * 4) = dt4; *(f32x4*)(F_ACS + (size_t)(c.row0 + r) * 4) = ac4; } }
    if (c.nrows < 64) { for (int i = tid_; i < 2 * 256 * 72 / 2; i += NTHR) ((LAS unsigned*)XTl)[i] = 0u; }
    asm volatile("s_waitcnt vmcnt(0)" ::: "memory");
    __syncthreads();
    if (act) {
        if (ci == NCHP - 1 && seg == 3) {
#pragma unroll
            for (int q = 0; q < 3; ++q) { float v[8]; unpack8(raw[16 + q], v); float* o = F.out + O_PCONV + (size_t)layer * 2304 + q * 768 + col;
                *(f32x4*)o = (f32x4){v[0], v[1], v[2], v[3]}; *(f32x4*)(o + 4) = (f32x4){v[4], v[5], v[6], v[7]}; } }
        if (c.b >= 0) {
#pragma unroll
            for (int q = 0; q < 3; ++q) { float v[8]; unpack8(raw[16 + q], v); float* o = F.out + O_SCONV + ((size_t)(layer * NSB + c.b) * 3 + q) * 768 + col;
                *(f32x4*)o = (f32x4){v[0], v[1], v[2], v[3]}; *(f32x4*)(o + 4) = (f32x4){v[4], v[5], v[6], v[7]}; } }
        const float* cw = inp(I_CW) + (size_t)layer * 4 * 768 + col; const float* cb = inp(I_CB) + (size_t)layer * 768 + col;
        LAS bf16* tl = (cg < 32) ? XTl + col * 72 : BTl + (col - 256) * 72;
#pragma unroll
        for (int hc = 0; hc < 2; ++hc) {
            float w0[4], w1[4], w2[4], w3[4], bb[4];
#pragma unroll
            for (int e = 0; e < 4; ++e) { bb[e] = cb[4 * hc + e]; w0[e] = cw[4 * hc + e]; w1[e] = cw[768 + 4 * hc + e]; w2[e] = cw[2 * 768 + 4 * hc + e]; w3[e] = cw[3 * 768 + 4 * hc + e]; }
#pragma unroll
            for (int i = 0; i < 16; i += 2) {
                float x[5][4];
#pragma unroll
                for (int q = 0; q < 5; ++q) { const unsigned ua = hc ? raw[i + q].z : raw[i + q].x, ub = hc ? raw[i + q].w : raw[i + q].y; x[q][0] = bf_lo(ua); x[q][1] = bf_hi(ua); x[q][2] = bf_lo(ub); x[q][3] = bf_hi(ub); }
                float ya[4], yb[4];
#pragma unroll
                for (int e = 0; e < 4; ++e) { ya[e] = silu_g(bb[e] + w0[e] * x[0][e] + w1[e] * x[1][e] + w2[e] * x[2][e] + w3[e] * x[3][e]); yb[e] = silu_g(bb[e] + w0[e] * x[1][e] + w1[e] * x[2][e] + w2[e] * x[3][e] + w3[e] * x[4][e]); }
                const int r = 16 * seg + i;
                *(unsigned long long*)(prow + (size_t)r * NPROJ + 4 * hc) = (unsigned long long)pk2(ya[0], ya[1]) | ((unsigned long long)pk2(ya[2], ya[3]) << 32);
                *(unsigned long long*)(prow + (size_t)(r + 1) * NPROJ + 4 * hc) = (unsigned long long)pk2(yb[0], yb[1]) | ((unsigned long long)pk2(yb[2], yb[3]) << 32);
                if (cg < 64) {
#pragma unroll
                    for (int e = 0; e < 4; ++e) *(LAS unsigned*)(tl + (4 * hc + e) * 72 + r) = pk2(ya[e], yb[e]); }
            }
        }
    }
    __syncthreads();
    { const int ch = tid_ >> 1, hf = tid_ & 1; bf16* dst = F_XT + ((size_t)ci * 256 + ch) * 64 + 32 * hf; const LAS bf16* src = XTl + ch * 72 + 32 * hf;
#pragma unroll
      for (int q = 0; q < 4; ++q) *(v4u*)(dst + 8 * q) = *(const LAS v4u*)(src + 8 * q); }
    const int kq = lane_ >> 4, fr = lane_ & 15, h = wave_ >> 1, g = h >> 1;
#pragma unroll
    for (int pi = 0; pi < 2; ++pi) {
        const int pb = 2 * (wave_ & 1) + pi;
        bf16x8 af[2];
#pragma unroll
        for (int ks = 0; ks < 2; ++ks) { float v[8]; unpack8(*(const LAS v4u*)(XTl + (h * 64 + pb * 16 + fr) * 72 + 32 * ks + 8 * kq), v);
#pragma unroll
            for (int e = 0; e < 8; ++e) v[e] *= sj[h * 64 + 32 * ks + 8 * kq + e];
            af[ks] = __builtin_bit_cast(bf16x8, pack8(v)); }
        bf16* dst = F_STB + ((size_t)(ci * 4 + h) * 64 + pb * 16 + 4 * kq) * 128 + fr;
#pragma unroll
        for (int nt = 0; nt < 8; ++nt) {
            f32x4 acc = {0.f, 0.f, 0.f, 0.f};
#pragma unroll
            for (int ks = 0; ks < 2; ++ks) { const bf16x8 bfr = *(const LAS bf16x8*)(BTl + (g * 128 + nt * 16 + fr) * 72 + 32 * ks + 8 * kq); acc = __builtin_amdgcn_mfma_f32_16x16x32_bf16(af[ks], bfr, acc, 0, 0, 0); }
#pragma unroll
            for (int r = 0; r < 4; ++r) dst[r * 128 + nt * 16] = (bf16)f2bf(acc[r]);
        }
    }
    __syncthreads();
}

__device__ __forceinline__ void ssd_out_witem(Frame& F, int layer, int ci, int ib, int wave_, int lane_) {
    const Chunk c = chunk_of(ci);
    const int kq = lane_ >> 4, fr = lane_ & 15;
    constexpr int WSTRIDE = 2560 + 16384; static_assert(8 * WSTRIDE <= MISC_OFF, "per-wave LDS");
    LAS bf16* scr = (LAS bf16*)(F.lds + wave_ * WSTRIDE);
    lf32* ysc = (lf32*)(F.lds + wave_ * WSTRIDE + 2560) + lane_;
    const bf16* P = F_PROJ + (size_t)c.row0 * NPROJ;
    const float* acsg = F_ACS + (size_t)c.row0 * 4; const float* dtg = F_DTV + (size_t)c.row0 * 4;
    const int nks = (ib + 2) >> 1;
    float sq[4] = {0.f, 0.f, 0.f, 0.f};
    const float* bdp = inp(I_BD) + layer * 4;
#pragma unroll
    for (int g = 0; g < 2; ++g) {
        bf16x8 cf[4];
#pragma unroll
        for (int ks = 0; ks < 4; ++ks) cf[ks] = *(const bf16x8*)(P + (size_t)(16 * ib + fr) * NPROJ + PC_C + 128 * g + 32 * ks + 8 * kq);
        f32x4 G[4];
#pragma unroll
        for (int jb = 0; jb < 4; ++jb) { G[jb] = (f32x4){0.f, 0.f, 0.f, 0.f};
            if (jb <= ib) {
#pragma unroll
                for (int ks = 0; ks < 4; ++ks) { const bf16x8 bfr = *(const bf16x8*)(P + (size_t)(16 * jb + fr) * NPROJ + PC_B + 128 * g + 32 * ks + 8 * kq); G[jb] = __builtin_amdgcn_mfma_f32_16x16x32_bf16(cf[ks], bfr, G[jb], 0, 0, 0); } } }
#pragma unroll
        for (int hh = 0; hh < 2; ++hh) {
            const int h = 2 * g + hh;
            float ai[4], ea[4];
#pragma unroll
            for (int r = 0; r < 4; ++r) { ai[r] = acsg[(16 * ib + 4 * kq + r) * 4 + h]; ea[r] = __expf(ai[r]); }
#pragma unroll
            for (int jb = 0; jb < 4; ++jb) { const int j = 16 * jb + fr; float aj = 0.f, dj = 0.f; if (jb <= ib) { aj = acsg[j * 4 + h]; dj = dtg[j * 4 + h]; }
#pragma unroll
                for (int r = 0; r < 4; ++r) { const int i = 16 * ib + 4 * kq + r; const float v = (jb <= ib && j <= i) ? G[jb][r] * __expf(ai[r] - aj) * dj : 0.f; scr[(4 * kq + r) * 72 + j] = (bf16)f2bf(v); } }
            asm volatile("s_waitcnt lgkmcnt(0)" ::: "memory");
            bf16x8 gm[2];
#pragma unroll
            for (int ks = 0; ks < 2; ++ks) gm[ks] = *(const LAS bf16x8*)(scr + fr * 72 + 32 * ks + 8 * kq);
            asm volatile("s_waitcnt lgkmcnt(0)" ::: "memory");
            const bf16* xt = F_XT + ((size_t)ci * 256 + h * 64) * 64;
            const bf16* sin_b = F_STB + (size_t)(ci * 4 + h) * 8192; const float* sin_f = inp(I_SSSM) + (size_t)((layer * NSB + (c.b < 0 ? 0 : c.b)) * 4 + h) * 8192;
#pragma unroll 2
            for (int pt = 0; pt < 4; ++pt) {
                f32x4 a1 = {0.f, 0.f, 0.f, 0.f}, a2 = {0.f, 0.f, 0.f, 0.f};
#pragma unroll
                for (int ks = 0; ks < 2; ++ks) if (ks < nks) { const bf16x8 bfr = *(const bf16x8*)(xt + (size_t)(pt * 16 + fr) * 64 + 32 * ks + 8 * kq); a1 = __builtin_amdgcn_mfma_f32_16x16x32_bf16(gm[ks], bfr, a1, 0, 0, 0); }
#pragma unroll
                for (int ks = 0; ks < 4; ++ks) { bf16x8 bfr;
                    if (c.b < 0) bfr = *(const bf16x8*)(sin_b + (size_t)(pt * 16 + fr) * 128 + 32 * ks + 8 * kq);
                    else { const float* s = sin_f + (size_t)(pt * 16 + fr) * 128 + 32 * ks + 8 * kq; const f32x4 u0 = *(const f32x4*)s, u1 = *(const f32x4*)(s + 4); v4u w; w.x = pk2(u0.x, u0.y); w.y = pk2(u0.z, u0.w); w.z = pk2(u1.x, u1.y); w.w = pk2(u1.z, u1.w); bfr = __builtin_bit_cast(bf16x8, w); }
                    a2 = __builtin_amdgcn_mfma_f32_16x16x32_bf16(cf[ks], bfr, a2, 0, 0, 0); }
                const float dh = bdp[h];
#pragma unroll
                for (int r = 0; r < 4; ++r) { const size_t ro = (size_t)(16 * ib + 4 * kq + r) * NPROJ; const int p = h * 64 + pt * 16 + fr;
                    float y = a1[r] + ea[r] * a2[r] + dh * bf1(P[ro + PC_X + p]);
                    y *= silu_g(bf1(P[ro + PC_Z + p])); ysc[((h * 4 + pt) * 4 + r) * 64] = y; sq[r] += y * y; }
            }
        }
    }
    const float* nw = inp(I_BNRM) + (size_t)layer * 256;
#pragma unroll
    for (int r = 0; r < 4; ++r) { const float rstd = rsq_f(sum16_l(lane_, sq[r]) * (1.0f / 256.0f) + EPS); bf16* o = F_XN + (size_t)(c.row0 + 16 * ib + 4 * kq + r) * D + 256 + fr;
#pragma unroll 4
        for (int q = 0; q < 16; ++q) o[q * 16] = (bf16)f2bf(ysc[(q * 4 + r) * 64] * rstd * nw[q * 16 + fr]); }
}

constexpr int SO_SIN = 0, SO_XT = 4 * 64 * 136 * 2, SO_ACS = SO_XT + 256 * 72 * 2, SO_DTV = SO_ACS + 1024, SO_SS = SO_DTV + 1024, SO_SCR = SO_SS + 512, SO_END = SO_SCR + 8 * 2560;
static_assert(SO_END <= MISC_OFF, "ssd_out_block LDS map");
__device__ __forceinline__ void ssd_out_block(Frame& F, int layer, int ci) {
    ITEM_IDS();
    const int row0 = 64 * ci;
    LAS bf16* SIN = (LAS bf16*)(F.lds + SO_SIN); LAS bf16* XTl = (LAS bf16*)(F.lds + SO_XT);
    lf32* acs = (lf32*)(F.lds + SO_ACS); lf32* dtv = (lf32*)(F.lds + SO_DTV); lf32* ss = (lf32*)(F.lds + SO_SS);
    LAS bf16* scr = (LAS bf16*)(F.lds + SO_SCR + wave_ * 2560);
    const int kq = lane_ >> 4, fr = lane_ & 15, ib = wave_ >> 1, g = wave_ & 1;
    const bf16* P = F_PROJ + (size_t)row0 * NPROJ;
    v4u st[12];
    { const bf16* sg = F_STB + (size_t)ci * 32768; const bf16* xg = F_XT + (size_t)ci * 16384;
#pragma unroll
      for (int q = 0; q < 8; ++q) st[q] = *(const v4u*)(sg + (size_t)(tid_ + q * NTHR) * 8);
#pragma unroll
      for (int q = 0; q < 4; ++q) st[8 + q] = *(const v4u*)(xg + (size_t)(tid_ + q * NTHR) * 8); }
    float a4 = 0.f, d4 = 0.f; if (tid_ < 256) { a4 = F_ACS[(size_t)row0 * 4 + tid_]; d4 = F_DTV[(size_t)row0 * 4 + tid_]; }
    bf16x8 cf[4], bfr[4][4];
#pragma unroll
    for (int ks = 0; ks < 4; ++ks) cf[ks] = *(const bf16x8*)(P + (size_t)(16 * ib + fr) * NPROJ + PC_C + 128 * g + 32 * ks + 8 * kq);
#pragma unroll
    for (int jb = 0; jb < 4; ++jb)
#pragma unroll
        for (int ks = 0; ks < 4; ++ks) { bfr[jb][ks] = (bf16x8){0, 0, 0, 0, 0, 0, 0, 0}; if (jb <= ib) bfr[jb][ks] = *(const bf16x8*)(P + (size_t)(16 * jb + fr) * NPROJ + PC_B + 128 * g + 32 * ks + 8 * kq); }
#pragma unroll
    for (int q = 0; q < 8; ++q) { const int it = tid_ + q * NTHR; *(LAS v4u*)(SIN + (it >> 4) * 136 + 8 * (it & 15)) = st[q]; }
#pragma unroll
    for (int q = 0; q < 4; ++q) { const int it = tid_ + q * NTHR; *(LAS v4u*)(XTl + (it >> 3) * 72 + 8 * (it & 7)) = st[8 + q]; }
    if (tid_ < 256) { acs[tid_] = a4; dtv[tid_] = d4; }
    bf16 zv[2][4][4];
#pragma unroll
    for (int hh = 0; hh < 2; ++hh)
#pragma unroll
        for (int pt = 0; pt < 4; ++pt)
#pragma unroll
            for (int r = 0; r < 4; ++r) zv[hh][pt][r] = P[(size_t)(16 * ib + 4 * kq + r) * NPROJ + PC_Z + (2 * g + hh) * 64 + pt * 16 + fr];
    __syncthreads();
    f32x4 G[4];
#pragma unroll
    for (int jb = 0; jb < 4; ++jb) { G[jb] = (f32x4){0.f, 0.f, 0.f, 0.f};
        if (jb <= ib) {
#pragma unroll
            for (int ks = 0; ks < 4; ++ks) G[jb] = __builtin_amdgcn_mfma_f32_16x16x32_bf16(cf[ks], bfr[jb][ks], G[jb], 0, 0, 0); } }
    const int nks = (ib + 2) >> 1;
    const float* bdp = inp(I_BD) + layer * 4;
    f32x4 yv[2][4]; float sq[4] = {0.f, 0.f, 0.f, 0.f};
#pragma unroll
    for (int hh = 0; hh < 2; ++hh) {
        const int h = 2 * g + hh;
        float ai[4], ea[4];
#pragma unroll
        for (int r = 0; r < 4; ++r) { ai[r] = acs[(16 * ib + 4 * kq + r) * 4 + h]; ea[r] = __expf(ai[r]); }
#pragma unroll
        for (int jb = 0; jb < 4; ++jb) { const int j = 16 * jb + fr; const float aj = acs[j * 4 + h], dj = dtv[j * 4 + h];
#pragma unroll
            for (int r = 0; r < 4; ++r) { const int i = 16 * ib + 4 * kq + r; const float v = (jb <= ib && j <= i) ? G[jb][r] * __expf(ai[r] - aj) * dj : 0.f; scr[(4 * kq + r) * 72 + j] = (bf16)f2bf(v); } }
        asm volatile("s_waitcnt lgkmcnt(0)" ::: "memory");
        bf16x8 gm[2];
#pragma unroll
        for (int ks = 0; ks < 2; ++ks) gm[ks] = *(const LAS bf16x8*)(scr + fr * 72 + 32 * ks + 8 * kq);
        asm volatile("s_waitcnt lgkmcnt(0)" ::: "memory");
        const float dh = bdp[h];
#pragma unroll
        for (int pt = 0; pt < 4; ++pt) {
            f32x4 a1 = {0.f, 0.f, 0.f, 0.f}, a2 = {0.f, 0.f, 0.f, 0.f};
            const LAS bf16* xr = XTl + (h * 64 + pt * 16 + fr) * 72; const LAS bf16* sr = SIN + (h * 64 + pt * 16 + fr) * 136;
#pragma unroll
            for (int ks = 0; ks < 2; ++ks) if (ks < nks) a1 = __builtin_amdgcn_mfma_f32_16x16x32_bf16(gm[ks], *(const LAS bf16x8*)(xr + 32 * ks + 8 * kq), a1, 0, 0, 0);
#pragma unroll
            for (int ks = 0; ks < 4; ++ks) a2 = __builtin_amdgcn_mfma_f32_16x16x32_bf16(cf[ks], *(const LAS bf16x8*)(sr + 32 * ks + 8 * kq), a2, 0, 0, 0);
            const unsigned long long xw = *(const LAS unsigned long long*)(xr + 16 * ib + 4 * kq);
            const float xx[4] = {bf_lo((unsigned)xw), bf_hi((unsigned)xw), bf_lo((unsigned)(xw >> 32)), bf_hi((unsigned)(xw >> 32))};
#pragma unroll
            for (int r = 0; r < 4; ++r) { float y = a1[r] + ea[r] * a2[r] + dh * xx[r]; y *= silu_g(bf1(zv[hh][pt][r])); yv[hh][pt][r] = y; sq[r] += y * y; }
        }
    }
#pragma unroll
    for (int r = 0; r < 4; ++r) { const float q = sum16_l(lane_, sq[r]); if (fr == 0) ss[(16 * ib + 4 * kq + r) * 2 + g] = q; }
    __syncthreads();
    const float* nw = inp(I_BNRM) + (size_t)layer * 256 + 128 * g;
#pragma unroll
    for (int r = 0; r < 4; ++r) { const int i = 16 * ib + 4 * kq + r; const float rstd = rsq_f((ss[i * 2] + ss[i * 2 + 1]) * (1.0f / 256.0f) + EPS); bf16* o = F_XN + (size_t)(row0 + i) * D + 256 + 128 * g + fr;
#pragma unroll
        for (int hh = 0; hh < 2; ++hh)
#pragma unroll
            for (int pt = 0; pt < 4; ++pt) o[hh * 64 + pt * 16] = (bf16)f2bf(yv[hh][pt][r] * rstd * nw[hh * 64 + pt * 16 + fr]); }
    __syncthreads();
}
constexpr int HP_KT = 0, HP_VT = 256 * 72 * 2, HP_HT = 2 * 256 * 72 * 2, HP_END = HP_HT + 4 * 256 * 4;
static_assert(HP_END <= MISC_OFF, "hgrn_prep LDS map");
__device__ __forceinline__ void hgrn_prep_item(Frame& F, int layer, int ci) {
    ITEM_IDS();
    const Chunk c = chunk_of(ci);
    LAS bf16* KTl = (LAS bf16*)(F.lds + HP_KT); LAS bf16* VTl = (LAS bf16*)(F.lds + HP_VT);
    lf32* ht = (lf32*)(F.lds + HP_HT);
    const int cp = tid_ & 127, qt = tid_ >> 7;
    float lb0 = 0.f, lb1 = 0.f; if (layer != 0) { const float* lbp = inp(I_LB) + 2 * cp; lb0 = rcp_f(1.0f + __expf(lbp[0] - lbp[256])); lb1 = rcp_f(1.0f + __expf(lbp[1] - lbp[257])); }
    bf16* pq = F_PROJ + (size_t)(c.row0 + 16 * qt) * NPROJ + PC_CQ + 2 * cp;
    const bool act = 16 * qt < c.nrows;
    unsigned rq[16], rf[16], rv[16];
#pragma unroll
    for (int i = 0; i < 16; ++i) { rq[i] = 0u; rf[i] = 0u; rv[i] = 0u; if (act) { const unsigned* p = (const unsigned*)(pq + (size_t)i * NPROJ); rq[i] = p[0]; rf[i] = p[128]; rv[i] = p[256]; } }
    float b0[16], b1[16], k0[16], k1[16];
    float run0 = 0.f, run1 = 0.f;
#pragma unroll
    for (int i = 0; i < 16; ++i) { float g0 = 0.f, g1 = 0.f; k0[i] = 0.f; k1[i] = 0.f;
        if (act) { const float e0 = __expf(-bf_lo(rf[i])), e1 = __expf(-bf_hi(rf[i])); const float d0 = rcp_f(1.0f + e0), d1 = rcp_f(1.0f + e1);
            g0 = __logf(lb0 + (1.0f - lb0) * d0); g1 = __logf(lb1 + (1.0f - lb1) * d1); k0[i] = (1.0f - lb0) * e0 * d0; k1[i] = (1.0f - lb1) * e1 * d1; }
        run0 += g0; run1 += g1; b0[i] = run0; b1[i] = run1; }
    *(LAS f32x2*)(ht + qt * 256 + 2 * cp) = (f32x2){run0, run1};
    __syncthreads();
    float pre0 = 0.f, pre1 = 0.f, last0 = 0.f, last1 = 0.f;
#pragma unroll
    for (int q = 0; q < 4; ++q) { const f32x2 t = *(const LAS f32x2*)(ht + q * 256 + 2 * cp); if (q < qt) { pre0 += t.x; pre1 += t.y; } last0 += t.x; last1 += t.y; }
    { float* Rg = F_RH + (size_t)ci * 1280 + 2 * cp; *(f32x2*)(Rg + qt * 256) = (f32x2){pre0, pre1};
      if (qt == 3) { *(f32x2*)(Rg + 1024) = (f32x2){last0, last1}; *(f32x2*)(F_DECC + (size_t)ci * 256 + 2 * cp) = (f32x2){__expf(last0), __expf(last1)}; } }
    const float e0 = run0, e1 = run1;
#pragma unroll
    for (int i = 0; i < 16; i += 2) {
        unsigned kt0, kt1;
#pragma unroll
        for (int q = 0; q < 2; ++q) { const int ii = i + q;
            const float qe0 = bf_lo(rq[ii]) * __expf(b0[ii]), qe1 = bf_hi(rq[ii]) * __expf(b1[ii]);
            const float ke0 = k0[ii] * __expf(e0 - b0[ii]), ke1 = k1[ii] * __expf(e1 - b1[ii]);
            const float kd0 = k0[ii] * __expf(fminf(-b0[ii], 80.f)), kd1 = k1[ii] * __expf(fminf(-b1[ii], 80.f));
            if (act && 16 * qt + ii < c.nrows) { unsigned* p = (unsigned*)(pq + (size_t)ii * NPROJ); p[0] = pk2(qe0, qe1); p[128] = pk2(ke0, ke1); p[256] = pk2(kd0, kd1); }
            const float t0 = k0[ii] * __expf(last0 - pre0 - b0[ii]), t1 = k1[ii] * __expf(last1 - pre1 - b1[ii]);
            if (q == 0) { kt0 = f2bf(t0); kt1 = f2bf(t1); } else { kt0 |= f2bf(t0) << 16; kt1 |= f2bf(t1) << 16; } }
        const int j = 16 * qt + i;
        *(LAS unsigned*)(KTl + (2 * cp) * 72 + j) = kt0; *(LAS unsigned*)(KTl + (2 * cp + 1) * 72 + j) = kt1;
        *(LAS unsigned*)(VTl + (2 * cp) * 72 + j) = (rv[i] & 0xffffu) | (rv[i + 1] << 16); *(LAS unsigned*)(VTl + (2 * cp + 1) * 72 + j) = (rv[i] >> 16) | (rv[i + 1] & 0xffff0000u);
    }
    __syncthreads();
    { const int c2 = tid_ >> 1, hf = tid_ & 1; bf16* dst = F_VT + ((size_t)ci * 256 + c2) * 64 + 32 * hf; const LAS bf16* src = VTl + c2 * 72 + 32 * hf;
#pragma unroll
      for (int q = 0; q < 4; ++q) *(v4u*)(dst + 8 * q) = *(const LAS v4u*)(src + 8 * q); }
    const int kq = lane_ >> 4, fr = lane_ & 15, h = wave_ >> 1;
#pragma unroll
    for (int vi = 0; vi < 2; ++vi) {
        const int vb = 2 * (wave_ & 1) + vi;
        bf16x8 af[2];
#pragma unroll
        for (int ks = 0; ks < 2; ++ks) af[ks] = *(const LAS bf16x8*)(VTl + (h * 64 + vb * 16 + fr) * 72 + 32 * ks + 8 * kq);
        bf16* dst = F_STC + ((size_t)(ci * 4 + h) * 64 + vb * 16 + 4 * kq) * 64 + fr;
#pragma unroll
        for (int kb = 0; kb < 4; ++kb) {
            f32x4 acc = {0.f, 0.f, 0.f, 0.f};
#pragma unroll
            for (int ks = 0; ks < 2; ++ks) { const bf16x8 bfr = *(const LAS bf16x8*)(KTl + (h * 64 + kb * 16 + fr) * 72 + 32 * ks + 8 * kq); acc = __builtin_amdgcn_mfma_f32_16x16x32_bf16(af[ks], bfr, acc, 0, 0, 0); }
#pragma unroll
            for (int r = 0; r < 4; ++r) dst[r * 64 + kb * 16] = (bf16)f2bf(acc[r]);
        }
    }
    __syncthreads();
}

__device__ __forceinline__ void hgrn_out_witem(Frame& F, int layer, int ci, int h, int ib, int wave_, int lane_) {
    const Chunk c = chunk_of(ci);
    const int kq = lane_ >> 4, fr = lane_ & 15;
    LAS bf16* scr = (LAS bf16*)(F.lds + wave_ * (2560 + 16384));
    const bf16* P = F_PROJ + (size_t)c.row0 * NPROJ + h * 64;
    const float* Rg = F_RH + (size_t)ci * 1280 + h * 64;
    bf16x8 qf[2]; float qv[2][8], rI[2][8];
#pragma unroll
    for (int ks = 0; ks < 2; ++ks) { qf[ks] = *(const bf16x8*)(P + (size_t)(16 * ib + fr) * NPROJ + PC_CQ + 32 * ks + 8 * kq); unpack8(__builtin_bit_cast(v4u, qf[ks]), qv[ks]);
        const float* rp = Rg + ib * 256 + 32 * ks + 8 * kq; const f32x4 a = *(const f32x4*)rp, b2 = *(const f32x4*)(rp + 4);
        rI[ks][0] = a.x; rI[ks][1] = a.y; rI[ks][2] = a.z; rI[ks][3] = a.w; rI[ks][4] = b2.x; rI[ks][5] = b2.y; rI[ks][6] = b2.z; rI[ks][7] = b2.w; }
#pragma unroll
    for (int J = 0; J < 4; ++J) {
        f32x4 acc = {0.f, 0.f, 0.f, 0.f};
        if (J <= ib) {
#pragma unroll
            for (int ks = 0; ks < 2; ++ks) {
                bf16x8 a = qf[ks];
                if (J < ib) { const float* rp = Rg + (J + 1) * 256 + 32 * ks + 8 * kq; const f32x4 u0 = *(const f32x4*)rp, u1 = *(const f32x4*)(rp + 4); const float rj[8] = {u0.x, u0.y, u0.z, u0.w, u1.x, u1.y, u1.z, u1.w};
                    float v[8];
#pragma unroll
                    for (int e = 0; e < 8; ++e) v[e] = qv[ks][e] * __expf(rI[ks][e] - rj[e]);
                    a = __builtin_bit_cast(bf16x8, pack8(v)); }
                const bf16x8 bfr = *(const bf16x8*)(P + (size_t)(16 * J + fr) * NPROJ + (J < ib ? PC_CF : PC_CI) + 32 * ks + 8 * kq);
                acc = __builtin_amdgcn_mfma_f32_16x16x32_bf16(a, bfr, acc, 0, 0, 0);
            }
        }
#pragma unroll
        for (int r = 0; r < 4; ++r) { const int i = 4 * kq + r, j = fr; const float v = (J < ib || (J == ib && j <= i)) ? acc[r] : 0.f; scr[(4 * kq + r) * 72 + 16 * J + fr] = (bf16)f2bf(v); }
    }
    asm volatile("s_waitcnt lgkmcnt(0)" ::: "memory");
    bf16x8 ga[2];
#pragma unroll
    for (int ks = 0; ks < 2; ++ks) ga[ks] = *(const LAS bf16x8*)(scr + fr * 72 + 32 * ks + 8 * kq);
    asm volatile("s_waitcnt lgkmcnt(0)" ::: "memory");
    bf16x8 qs[2];
#pragma unroll
    for (int ks = 0; ks < 2; ++ks) { float v[8];
#pragma unroll
        for (int e = 0; e < 8; ++e) v[e] = qv[ks][e] * __expf(rI[ks][e]);
        qs[ks] = __builtin_bit_cast(bf16x8, pack8(v)); }
    const int nks = (ib + 2) >> 1;
    const bf16* vt = F_VT + ((size_t)ci * 256 + h * 64) * 64;
    const bf16* sin_b = F_STC + (size_t)(ci * 4 + h) * 4096; const float* sin_f = inp(I_SHGRN) + (size_t)((layer * NSB + (c.b < 0 ? 0 : c.b)) * 4 + h) * 4096;
    f32x4 o[4]; float sq[4] = {0.f, 0.f, 0.f, 0.f};
#pragma unroll
    for (int t = 0; t < 4; ++t) {
        o[t] = (f32x4){0.f, 0.f, 0.f, 0.f};
#pragma unroll
        for (int ks = 0; ks < 2; ++ks) if (ks < nks) { const bf16x8 bfr = *(const bf16x8*)(vt + (size_t)(t * 16 + fr) * 64 + 32 * ks + 8 * kq); o[t] = __builtin_amdgcn_mfma_f32_16x16x32_bf16(ga[ks], bfr, o[t], 0, 0, 0); }
#pragma unroll
        for (int ks = 0; ks < 2; ++ks) { bf16x8 bfr;
            if (c.b < 0) bfr = *(const bf16x8*)(sin_b + (size_t)(t * 16 + fr) * 64 + 32 * ks + 8 * kq);
            else { float v[8];
#pragma unroll
                for (int e = 0; e < 8; ++e) v[e] = sin_f[(size_t)(32 * ks + 8 * kq + e) * 64 + t * 16 + fr];
                bfr = __builtin_bit_cast(bf16x8, pack8(v)); }
            o[t] = __builtin_amdgcn_mfma_f32_16x16x32_bf16(qs[ks], bfr, o[t], 0, 0, 0); }
#pragma unroll
        for (int r = 0; r < 4; ++r) sq[r] += o[t][r] * o[t][r];
    }
    const float* nw = inp(I_CNRM) + (size_t)layer * 256 + h * 64;
#pragma unroll
    for (int r = 0; r < 4; ++r) { const float rstd = rsq_f(sum16_l(lane_, sq[r]) * (1.0f / 64.0f) + EPS); const size_t row = (size_t)(16 * ib + 4 * kq + r);
#pragma unroll
        for (int t = 0; t < 4; ++t) { const int v = t * 16 + fr; const float cg = bf1(P[row * NPROJ + PC_CG + v]);
            F_XN[(size_t)(c.row0 + row) * D + 512 + h * 64 + v] = (bf16)f2bf(o[t][r] * rstd * nw[v] * silu_g(cg)); } }
}

constexpr int HO_KE = 0, HO_VT = 64 * 264 * 2, HO_SIN = HO_VT + 256 * 72 * 2, HO_R = HO_SIN + 256 * 72 * 2, HO_SCR = HO_R + 1280 * 4, HO_END = HO_SCR + 8 * 2304;
static_assert(HO_END <= MISC_OFF, "hgrn_out_block LDS map");
__device__ __forceinline__ void hgrn_out_block(Frame& F, int layer, int ci) {
    ITEM_IDS();
    const int row0 = 64 * ci;
    LAS bf16* KEl = (LAS bf16*)(F.lds + HO_KE); LAS bf16* VTl = (LAS bf16*)(F.lds + HO_VT); LAS bf16* SIN = (LAS bf16*)(F.lds + HO_SIN); lf32* Rl = (lf32*)(F.lds + HO_R);
    LAS bf16* scr = (LAS bf16*)(F.lds + HO_SCR + wave_ * 2304);
    const int kq = lane_ >> 4, fr = lane_ & 15, h = wave_ >> 1, ib0 = 2 * (wave_ & 1);
    const bf16* P = F_PROJ + (size_t)row0 * NPROJ;
    v4u st[13];
    { const bf16* kg = P + PC_CF; const bf16* vg = F_VT + (size_t)ci * 16384; const bf16* sg = F_STC + (size_t)ci * 16384; const float* rg = F_RH + (size_t)ci * 1280;
#pragma unroll
      for (int q = 0; q < 4; ++q) { const int it = tid_ + q * NTHR; st[q] = *(const v4u*)(kg + (size_t)(it >> 5) * NPROJ + 8 * (it & 31)); }
#pragma unroll
      for (int q = 0; q < 4; ++q) st[4 + q] = *(const v4u*)(vg + (size_t)(tid_ + q * NTHR) * 8);
#pragma unroll
      for (int q = 0; q < 4; ++q) st[8 + q] = *(const v4u*)(sg + (size_t)(tid_ + q * NTHR) * 8);
      st[12] = (v4u){0u, 0u, 0u, 0u}; if (tid_ < 320) st[12] = *(const v4u*)(rg + 4 * tid_); }
    bf16x8 qf[2][2], kd[2][2];
#pragma unroll
    for (int bi = 0; bi < 2; ++bi)
#pragma unroll
        for (int ks = 0; ks < 2; ++ks) { const bf16* p = P + (size_t)(16 * (ib0 + bi) + fr) * NPROJ + h * 64 + 32 * ks + 8 * kq; qf[bi][ks] = *(const bf16x8*)(p + PC_CQ); kd[bi][ks] = *(const bf16x8*)(p + PC_CI); }
#pragma unroll
    for (int q = 0; q < 4; ++q) { const int it = tid_ + q * NTHR; *(LAS v4u*)(KEl + (it >> 5) * 264 + 8 * (it & 31)) = st[q]; }
#pragma unroll
    for (int q = 0; q < 4; ++q) { const int it = tid_ + q * NTHR; *(LAS v4u*)(VTl + (it >> 3) * 72 + 8 * (it & 7)) = st[4 + q]; *(LAS v4u*)(SIN + (it >> 3) * 72 + 8 * (it & 7)) = st[8 + q]; }
    if (tid_ < 320) *(LAS v4u*)(Rl + 4 * tid_) = st[12];
    bf16 cgv[2][4][4];
#pragma unroll
    for (int bi = 0; bi < 2; ++bi)
#pragma unroll
        for (int t = 0; t < 4; ++t)
#pragma unroll
            for (int r = 0; r < 4; ++r) cgv[bi][t][r] = P[(size_t)(16 * (ib0 + bi) + 4 * kq + r) * NPROJ + PC_CG + h * 64 + t * 16 + fr];
    __syncthreads();
    const float* nw = inp(I_CNRM) + (size_t)layer * 256 + h * 64;
#pragma unroll
    for (int bi = 0; bi < 2; ++bi) {
        const int ib = ib0 + bi;
        float qv[2][8], rI[2][8];
#pragma unroll
        for (int ks = 0; ks < 2; ++ks) { unpack8(__builtin_bit_cast(v4u, qf[bi][ks]), qv[ks]); const lf32* rp = Rl + ib * 256 + h * 64 + 32 * ks + 8 * kq;
#pragma unroll
            for (int e = 0; e < 8; ++e) rI[ks][e] = rp[e]; }
#pragma unroll
        for (int J = 0; J < 4; ++J) {
            f32x4 acc = {0.f, 0.f, 0.f, 0.f};
            if (J <= ib) {
#pragma unroll
                for (int ks = 0; ks < 2; ++ks) {
                    bf16x8 a = qf[bi][ks], bfr = kd[bi][ks];
                    if (J < ib) { const lf32* rp = Rl + (J + 1) * 256 + h * 64 + 32 * ks + 8 * kq; float v[8];
#pragma unroll
                        for (int e = 0; e < 8; ++e) v[e] = qv[ks][e] * __expf(rI[ks][e] - rp[e]);
                        a = __builtin_bit_cast(bf16x8, pack8(v)); bfr = *(const LAS bf16x8*)(KEl + (16 * J + fr) * 264 + h * 64 + 32 * ks + 8 * kq); }
                    acc = __builtin_amdgcn_mfma_f32_16x16x32_bf16(a, bfr, acc, 0, 0, 0);
                }
            }
#pragma unroll
            for (int r = 0; r < 4; ++r) { const int i = 4 * kq + r, j = fr; const float v = (J < ib || (J == ib && j <= i)) ? acc[r] : 0.f; scr[(4 * kq + r) * 72 + 16 * J + fr] = (bf16)f2bf(v); }
        }
        asm volatile("s_waitcnt lgkmcnt(0)" ::: "memory");
        bf16x8 ga[2];
#pragma unroll
        for (int ks = 0; ks < 2; ++ks) ga[ks] = *(const LAS bf16x8*)(scr + fr * 72 + 32 * ks + 8 * kq);
        asm volatile("s_waitcnt lgkmcnt(0)" ::: "memory");
        bf16x8 qs[2];
#pragma unroll
        for (int ks = 0; ks < 2; ++ks) { float v[8];
#pragma unroll
            for (int e = 0; e < 8; ++e) v[e] = qv[ks][e] * __expf(rI[ks][e]);
            qs[ks] = __builtin_bit_cast(bf16x8, pack8(v)); }
        const int nks = (ib + 2) >> 1;
        f32x4 o[4]; float sq[4] = {0.f, 0.f, 0.f, 0.f};
#pragma unroll
        for (int t = 0; t < 4; ++t) {
            o[t] = (f32x4){0.f, 0.f, 0.f, 0.f};
#pragma unroll
            for (int ks = 0; ks < 2; ++ks) if (ks < nks) o[t] = __builtin_amdgcn_mfma_f32_16x16x32_bf16(ga[ks], *(const LAS bf16x8*)(VTl + (h * 64 + t * 16 + fr) * 72 + 32 * ks + 8 * kq), o[t], 0, 0, 0);
#pragma unroll
            for (int ks = 0; ks < 2; ++ks) o[t] = __builtin_amdgcn_mfma_f32_16x16x32_bf16(qs[ks], *(const LAS bf16x8*)(SIN + (h * 64 + t * 16 + fr) * 72 + 32 * ks + 8 * kq), o[t], 0, 0, 0);
#pragma unroll
            for (int r = 0; r < 4; ++r) sq[r] += o[t][r] * o[t][r];
        }
#pragma unroll
        for (int r = 0; r < 4; ++r) { const float rstd = rsq_f(sum16_l(lane_, sq[r]) * (1.0f / 64.0f) + EPS); bf16* op = F_XN + (size_t)(row0 + 16 * ib + 4 * kq + r) * D + 512 + h * 64 + fr;
#pragma unroll
            for (int t = 0; t < 4; ++t) op[t * 16] = (bf16)f2bf(o[t][r] * rstd * nw[t * 16 + fr] * silu_g(bf1(cgv[bi][t][r]))); }
    }
    __syncthreads();
}
template <int MODE>
__device__ __forceinline__ void mini_gemm(Frame& F, const bf16* A, const bf16* Bt, int K, int ncb, bf16* O, int ldo, const float* res, float* C, const float* nw = nullptr, bf16* xo = nullptr, float* rs = nullptr) {
    ITEM_IDS();
    const int kq = lane_ >> 4, fr = lane_ & 15;
    for (int wi = ((int)blockIdx.x) * NWAVES + wave_; wi < 16 * ncb; wi += ((int)gridDim.x) * NWAVES) {
        const int rb = wi & 15, cb = wi >> 4;
        const bf16* ap = A + (size_t)(MP + 16 * rb + fr) * K + 8 * kq;
        const int c = 16 * cb + fr;
        const bf16* bp = Bt + (size_t)(MODE == 2 ? ((c >> 7) * 256 + (c & 127)) : c) * K + 8 * kq;
        f32x4 acc0 = {0.f, 0.f, 0.f, 0.f}, acc1 = {0.f, 0.f, 0.f, 0.f};
#pragma unroll 8
        for (int k0 = 0; k0 < K; k0 += 32) {
            const bf16x8 a = *(const bf16x8*)(ap + k0), b0 = *(const bf16x8*)(bp + k0);
            acc0 = __builtin_amdgcn_mfma_f32_16x16x32_bf16(a, b0, acc0, 0, 0, 0);
            if (MODE == 2) { const bf16x8 b1 = *(const bf16x8*)(bp + (size_t)128 * K + k0); acc1 = __builtin_amdgcn_mfma_f32_16x16x32_bf16(a, b1, acc1, 0, 0, 0); }
        }
#pragma unroll
        for (int r = 0; r < 4; ++r) { const size_t row = (size_t)(MP + 16 * rb + 4 * kq + r);
            if (MODE == 0) { const bf16 ob = (bf16)f2bf(acc0[r]); O[row * ldo + c] = ob; if (c >= PC_V && c < PC_V + 256) F_VTA[(size_t)(c - PC_V) * M + row] = ob; }
            if (MODE == 1) { const float x = res[row * 1024 + c] + acc0[r]; C[row * 1024 + c] = x;
                if (nw) { xo[row * 1024 + c] = (bf16)f2bf(x * nw[c]); const float q = sum16_l(lane_, x * x); if (fr == 0) atomicAdd(rs + row, q); } }
            if (MODE == 2) O[row * ldo + c] = (bf16)f2bf(silu_g(acc0[r]) * acc1[r]); }
    }
}

template <int MODE, int KS>
__device__ __forceinline__ void mini_gemm2(Frame& F, const bf16* A, const bf16* Bt, int K, int ncb32, bf16* O, int ldo, const float* res, float* C, const float* nw = nullptr, bf16* xo = nullptr, float* rs = nullptr, const bf16* rbf = nullptr, const float* rw = nullptr, bf16* Cb = nullptr) {
    ITEM_IDS();
    const int kq = lane_ >> 4, fr = lane_ & 15;
    LAS f32x4* red = (LAS f32x4*)F.lds;
    for (int it = (int)blockIdx.x; it < 8 * ncb32; it += (int)gridDim.x) {
        const int rb = it & 7, cb = it >> 3;
        const bf16* ap = A + (size_t)(MP + 32 * rb + fr) * K + wave_ * (KS * 32) + 8 * kq;
        const bf16* bp = Bt + (size_t)(32 * cb + fr) * K + wave_ * (KS * 32) + 8 * kq;
        f32x4 acc[2][2] = {{(f32x4){0.f, 0.f, 0.f, 0.f}, (f32x4){0.f, 0.f, 0.f, 0.f}}, {(f32x4){0.f, 0.f, 0.f, 0.f}, (f32x4){0.f, 0.f, 0.f, 0.f}}};
#pragma unroll (KS > 6 ? 6 : KS)
        for (int ks = 0; ks < KS; ++ks) {
            bf16x8 a[2], b[2];
#pragma unroll
            for (int i = 0; i < 2; ++i) { a[i] = *(const bf16x8*)(ap + (size_t)(16 * i) * K + 32 * ks); b[i] = *(const bf16x8*)(bp + (size_t)(16 * i) * K + 32 * ks); }
#pragma unroll
            for (int i = 0; i < 2; ++i)
#pragma unroll
                for (int j = 0; j < 2; ++j) acc[i][j] = __builtin_amdgcn_mfma_f32_16x16x32_bf16(a[i], b[j], acc[i][j], 0, 0, 0);
        }
#pragma unroll
        for (int i = 0; i < 2; ++i)
#pragma unroll
            for (int j = 0; j < 2; ++j) red[(wave_ * 4 + 2 * i + j) * 64 + lane_] = acc[i][j];
        __syncthreads();
        if (wave_ < 4) {
            const int qi = wave_ >> 1, qj = wave_ & 1;
            f32x4 s = red[wave_ * 64 + lane_];
#pragma unroll
            for (int w = 1; w < 8; ++w) s += red[(w * 4 + wave_) * 64 + lane_];
            const int c = 32 * cb + 16 * qj + fr;
#pragma unroll
            for (int r = 0; r < 4; ++r) { const size_t row = (size_t)(MP + 32 * rb + 16 * qi + 4 * kq + r);
                if (MODE == 0) { const bf16 ob = (bf16)f2bf(s[r]); O[row * ldo + c] = ob; if (c >= PC_V && c < PC_V + 256) F_VTA[(size_t)(c - PC_V) * M + row] = ob; }
                if (MODE == 1) { const float x = (rbf ? bf1(rbf[row * 1024 + c]) * (rw ? rcp_f(rw[c]) : 1.0f) : res[row * 1024 + c]) + s[r]; if (C) C[row * 1024 + c] = x; if (Cb) Cb[row * 1024 + c] = (bf16)f2bf(x);
                    if (nw) { xo[row * 1024 + c] = (bf16)f2bf(x * nw[c]); const float q = sum16_l(lane_, x * x); if (fr == 0) atomicAdd(rs + row, q); } } }
        }
        __syncthreads();
    }
}
__device__ __forceinline__ void sample_mix_item(Frame& F, int layer, int b) {
    ssd_prep_item(F, layer, NCHP + b);
    hgrn_prep_item(F, layer, NCHP + b);
    asm volatile("s_waitcnt vmcnt(0)" ::: "memory");
    __syncthreads();
    __builtin_amdgcn_fence(__ATOMIC_ACQUIRE, "agent");
    asm volatile("s_waitcnt vmcnt(0)" ::: "memory");
    { ITEM_IDS();
      if (wave_ == 0) ssd_out_witem(F, layer, NCHP + b, 0, wave_, lane_);
      else if (wave_ <= 4) hgrn_out_witem(F, layer, NCHP + b, wave_ - 1, 0, wave_, lane_); }
    __syncthreads();
}
__device__ __forceinline__ void p2_phase(Frame& F, int layer, volatile LAS unsigned* MISC) {
    constexpr int NS = NSB, NA = NCH * 4, NB = NCHP, NC = NCHP, ND = NCH, NE = 64, NW = 432;
    const int NTOT = NS + NA + NB + NC + ND + NE + (layer == 0 ? NW : 0);
    unsigned* head = (unsigned*)(F.ws + WS_CTL) + CW_QUEUE + 64 * layer;
    attn_bias_load(F, layer);
    unsigned nxt = 0u; if (threadIdx.x == 0) nxt = __hip_atomic_fetch_add(head, 1u, __ATOMIC_RELAXED, __HIP_MEMORY_SCOPE_AGENT);
    for (;;) {
        __syncthreads();
        if (threadIdx.x == 0) MISC[12] = nxt;
        __syncthreads();
        int it = (int)MISC[12];
        if (it >= NTOT) break;
        if (threadIdx.x == 0) nxt = __hip_atomic_fetch_add(head, 1u, __ATOMIC_RELAXED, __HIP_MEMORY_SCOPE_AGENT);
        if (it < NS) { sample_mix_item(F, layer, it); continue; } it -= NS;
        if (it < NA) { const int i2 = it - NSB * 4; const int ci = it < NSB * 4 ? NCHP + (it >> 2) : NCHP - 1 - (i2 >> 2); attn_item(F, layer, ci, it & 3); }
        else if (it < NA + NB) ssd_prep_item(F, layer, it - NA);
        else if (it < NA + NB + NC) hgrn_prep_item(F, layer, it - NA - NB);
        else if (it < NA + NB + NC + ND) pool_item(F, layer, it - NA - NB - NC);
        else if (it < NA + NB + NC + ND + NE) copy_cache(F, layer, it - NA - NB - NC - ND, NE);
        else { ITEM_IDS(); p0_weights(F, 1, (it - NA - NB - NC - ND - NE) * NWAVES + wave_, NW * NWAVES, false); }
    }
}
__device__ __forceinline__ void p4_phase(Frame& F, int layer) {
    for (int ci = ((int)blockIdx.x); ci < NCHP; ci += ((int)gridDim.x)) { ssd_out_block(F, layer, ci); hgrn_out_block(F, layer, ci); }
}

__global__ void __launch_bounds__(NTHR, 2) fwd_kernel(Args args) {
    extern __shared__ __attribute__((aligned(16))) unsigned char lds[];
    Frame F;
    F.lds = (LAS unsigned char*)lds;
    F.out = args.out; F.ws = args.ws;
    volatile LAS unsigned* MISC = (volatile LAS unsigned*)(F.lds + MISC_OFF);
    if (threadIdx.x < 64) MISC[threadIdx.x] = 0u;
    __syncthreads();
    (void)xcd_barrier_post((unsigned*)(args.ws + WS_CTL) + CW_BAR, MISC + 8);
#define GRID_BAR() do { XcdBarrier bar_; bar_.bar = (unsigned*)((unsigned char*)inp(N_IN + 1) + WS_CTL) + CW_BAR; bar_.x = xb_xcc_id(); bar_.st = MISC + 8; xcd_barrier(bar_); \
        F.out = (float*)inp(N_IN); F.ws = (unsigned char*)inp(N_IN + 1); } while (0)
#ifdef TPROBE
    const bool stamper = (blockIdx.x == 0 && threadIdx.x == 0); int n_stamp = 0;
#define STAMP() do { if (stamper) MISC[16 + n_stamp] = (unsigned)__builtin_amdgcn_s_memrealtime(); ++n_stamp; } while (0)
#else
#define STAMP() do { } while (0)
#endif
    STAMP();

    { float* rsz = F_RS; for (int i = (int)blockIdx.x * NTHR + (int)threadIdx.x; i < 2 * M; i += (int)gridDim.x * NTHR) rsz[i] = 0.f; }
    p0_weights(F, 0, ((int)blockIdx.x) * NWAVES + __builtin_amdgcn_readfirstlane((int)(threadIdx.x >> 6)), ((int)gridDim.x) * NWAVES, true);
    __syncthreads();
    norm_rows<true, false>(F, inp(I_XP), inp(I_XS) - (size_t)MP * D, inp(I_N1), inp(I_WIN));
    GRID_BAR(); STAMP();
#pragma unroll 1
    for (int layer = 0; layer < 2; ++layer) {
        unsigned char* wl = F.ws + WS_W + (size_t)layer * WL_STRIDE;
        mini_gemm2<0, 4>(F, F_XN, (const bf16*)(wl + WL_IN), D, NPROJ / 32, F_PROJ, NPROJ, nullptr, nullptr);
        { pg8::Gemm g{F_XN, (const bf16*)(wl + WL_IN), MP, NPROJ, D}; pg8::StaticOrder S; S.init(MP, NPROJ, ((int)gridDim.x), ((int)blockIdx.x));
          pg8::EpiBf16 E{F_PROJ, NPROJ, F_HALO, F_VTA, M};
          pg8::gemm_phase<pg8::EpiBf16, pg8::StaticOrder, true, true>(F.lds + RING_OFF, g, S, E); }
        GRID_BAR(); STAMP();
        p2_phase(F, layer, MISC);
        GRID_BAR(); STAMP();
        scan_phase(F, layer);
        GRID_BAR(); STAMP();
        p4_phase(F, layer);
        GRID_BAR(); STAMP();
        mini_gemm2<1, 4>(F, F_XN, (const bf16*)(wl + WL_OUT), D, D / 32, nullptr, 0, inp(I_XS) - (size_t)MP * D, nullptr, inp(I_N2) + (size_t)layer * D, F_XN2, F_RS + (size_t)layer * M, layer == 0 ? nullptr : (const bf16*)F.out, nullptr);
        { pg8::Gemm g{F_XN, (const bf16*)(wl + WL_OUT), MP, D, D}; pg8::StaticOrder S; S.init(MP, D, ((int)gridDim.x), ((int)blockIdx.x));
          pg8::EpiRes E{inp(I_XP), inp(I_XS) - (size_t)MP * D, nullptr, inp(I_N2) + (size_t)layer * D, F_XN2, F_RS + (size_t)layer * M, layer == 0 ? nullptr : (const bf16*)F.out, nullptr, nullptr};
          pg8::gemm_phase<pg8::EpiRes, pg8::StaticOrder, true, true>(F.lds + RING_OFF, g, S, E); }
        GRID_BAR(); STAMP();
        { pg8::Gemm g{F_XN2, (const bf16*)(wl + WL_GU), M, NGU, D}; pg8::StaticOrder S; S.init(M, NGU, ((int)gridDim.x), ((int)blockIdx.x));
          pg8::EpiSwiGLU E{F_ACT, DFF, F_RS + (size_t)layer * M};
          pg8::gemm_phase<pg8::EpiSwiGLU, pg8::StaticOrder, true, true>(F.lds + RING_OFF, g, S, E); }
        GRID_BAR(); STAMP();
        mini_gemm2<1, 11>(F, F_ACT, (const bf16*)(wl + WL_DN), DFF, D / 32, nullptr, 0, nullptr, nullptr, nullptr, nullptr, nullptr, F_XN2, inp(I_N2) + (size_t)layer * D, layer == 0 ? (bf16*)F.out : F_XN);
        { pg8::Gemm g{F_ACT, (const bf16*)(wl + WL_DN), MP, D, DFF}; pg8::StaticOrder S; S.init(MP, D, ((int)gridDim.x), ((int)blockIdx.x));
          pg8::EpiRes E{nullptr, nullptr, nullptr, nullptr, nullptr, nullptr, F_XN2, inp(I_N2) + (size_t)layer * D, layer == 0 ? (bf16*)F.out : F_XN};
          pg8::gemm_phase<pg8::EpiRes, pg8::StaticOrder, true, true>(F.lds + RING_OFF, g, S, E); }
        GRID_BAR(); STAMP();
        if (layer == 0) { norm_rows<true, false>(F, nullptr, nullptr, inp(I_N1) + D, inp(I_WIN) + (size_t)D * NIN, (const bf16*)F.out); GRID_BAR(); STAMP(); }
        else { norm_rows<false, true>(F, nullptr, nullptr, inp(I_NF), nullptr, F_XN); STAMP(); }
    }
#ifdef TPROBE
    if (stamper) {
        unsigned v[10]; v[0] = MISC[17] - MISC[16];
        for (int j = 1; j < 9; ++j) v[j] = (MISC[17 + j] - MISC[16 + j]) + (MISC[25 + j] - MISC[24 + j]);
        v[9] = (MISC[33] - MISC[16]) / 4;
        const unsigned dl = 800000u + 16u * v[TPROBE];
        const unsigned t0 = MISC[16];
        while ((unsigned)((unsigned)__builtin_amdgcn_s_memrealtime() - t0) < dl) __builtin_amdgcn_s_sleep(32);
    }
#endif
}

extern "C" void kernel_launch(void* const* d_in, const int* in_sizes, int n_in, void* d_out, int out_size, void* d_ws, size_t ws_size, hipStream_t stream) {
    static int grid = 0;
    if (grid == 0) {
        if (n_in != N_IN || (size_t)out_size != O_END || ws_size < WS_END) { fprintf(stderr, "kernel_launch: unexpected shapes (n_in %d, out %d, ws %zu)\n", n_in, out_size, ws_size); grid = -1; return; }
        int dev = 0, cus = 0, per_cu = 0;
        if (hipGetDevice(&dev) != hipSuccess || hipDeviceGetAttribute(&cus, hipDeviceAttributeMultiprocessorCount, dev) != hipSuccess) { grid = -1; return; }
        if (hipFuncSetAttribute((const void*)fwd_kernel, hipFuncAttributeMaxDynamicSharedMemorySize, LDS_BYTES) != hipSuccess) { fprintf(stderr, "kernel_launch: hipFuncSetAttribute failed\n"); grid = -1; return; }
        if (hipOccupancyMaxActiveBlocksPerMultiprocessor(&per_cu, (const void*)fwd_kernel, NTHR, LDS_BYTES) != hipSuccess || per_cu < 1) { fprintf(stderr, "kernel_launch: occupancy query says %d blocks per CU\n", per_cu); (void)hipGetLastError(); grid = -1; return; }
        grid = cus;
        if (grid < 64) { fprintf(stderr, "kernel_launch: needs at least 64 CUs (got %d)\n", cus); grid = -1; return; }
    }
    if (grid < 0) return;
    if (hipMemsetAsync((char*)d_ws + WS_CTL, 0, CTL_ZERO_BYTES, stream) != hipSuccess) { fprintf(stderr, "kernel_launch: hipMemsetAsync failed\n"); return; }
    Args a{};
    for (int i = 0; i < N_IN; ++i) a.in[i] = (const float*)d_in[i];
    a.out = (float*)d_out; a.ws = (unsigned char*)d_ws;
    void* kargs[] = {&a};
    hipError_t e = hipLaunchCooperativeKernel((const void*)fwd_kernel, dim3(grid), dim3(NTHR), kargs, LDS_BYTES, stream);
    if (e != hipSuccess) { fprintf(stderr, "kernel_launch: cooperative launch failed: %s (grid %d)\n", hipGetErrorString(e), grid); }
}
```

```cpp
#include <hip/hip_runtime.h>
#include <cstdio>
#include <cstdint>
namespace pg8 {
#define PG8_LAS __attribute__((address_space(3)))
typedef unsigned short bf16_t;
typedef short bf16x8 __attribute__((ext_vector_type(8)));
typedef float f32x4 __attribute__((ext_vector_type(4)));
typedef unsigned u32x4 __attribute__((ext_vector_type(4)));
constexpr int BM = 256, BK = 64, HALF = 128, HTB = HALF * BK * 2  , STAGE_BYTES = 8 * HTB, NXCD = 8, WGM = 8;

__host__ __device__ __forceinline__ int lds_byte(int r, int c) { const int st = (r >> 4) * 2 + (c >> 5), rr = r & 15, cc = c & 31, ob = rr * 64 + cc * 2; return st * 1024 + (ob ^ (((ob >> 9) & 1) << 5)); }
__host__ __device__ __forceinline__ void stage_rc(int b, int& R, int& C) { const int st = b / 1024, sb = b % 1024, swz = sb ^ (((sb >> 9) & 1) << 5); R = (st >> 1) * 16 + swz / 64; C = (st & 1) * 32 + (swz % 64) / 2; }
__host__ __device__ __forceinline__ int perm32(int rho) { const int n = rho >> 4, i = rho & 15; return 8 * (i >> 2) + 4 * n + (i & 3); }

struct Unit { int pm, pn; };
struct Gemm { const bf16_t* A; const bf16_t* Bt; int M, N, K; };

struct StaticOrder {
    int nM, nN, nwg, G, c;
    __host__ __device__ void init(int M, int N, int G_, int c_) { nM = M / BM; nN = N / BM; nwg = nM * nN; G = G_; c = c_; }
    __host__ __device__ bool next(int i, Unit& u) const {
        const long L = (long)i * G + c; if (L >= nwg) return false;
        int wgid = (int)L; { const int q = nwg / NXCD, r = nwg % NXCD, xcd = wgid % NXCD, off = wgid / NXCD; wgid = (xcd < r ? xcd * (q + 1) : r * (q + 1) + (xcd - r) * q) + off; }
        const int nig = WGM * nN, gid = wgid / nig, fm = gid * WGM, gsz = (nM - fm) < WGM ? (nM - fm) : WGM;
        u.pm = fm + ((wgid % nig) % gsz); u.pn = (wgid % nig) / gsz; return true;
    }
    __device__ __forceinline__ void a_ready(const Unit&) const {}
    __device__ __forceinline__ void done(const Unit&) const {}
};

__device__ __forceinline__ unsigned cvt_pk_bf16(float lo, float hi) { unsigned r; asm volatile("v_cvt_pk_bf16_f32 %0, %1, %2" : "=v"(r) : "v"(lo), "v"(hi)); return r; }
__device__ __forceinline__ float silu_f(float x) { return x * __builtin_amdgcn_rcpf(1.0f + __expf(-x)); }
struct EpiBf16 {
    static constexpr bool PERM = true, AFTER_DRAIN = false;
    bf16_t* O; int ldc; bf16_t* halo; bf16_t* vta; int vld;
    __device__ __forceinline__ void operator()(const f32x4 (&acc)[2][2][4][2], const Unit& u, int wr, int wc, int fr, int fq) const {
        const int row0 = u.pm * BM + wr * 64 + fr, col0 = u.pn * BM + wc * 32 + 8 * fq;
        const bool hz = halo != nullptr && u.pn >= 4 && u.pn <= 6;
#pragma unroll
        for (int ai = 0; ai < 2; ++ai)
#pragma unroll
            for (int m = 0; m < 4; ++m) { const int row = row0 + ai * HALF + m * 16; bf16_t* rowp = O + (size_t)row * ldc + col0;
#pragma unroll
                for (int bj = 0; bj < 2; ++bj) { const f32x4 v0 = acc[ai][bj][m][0], v1 = acc[ai][bj][m][1];
                    u32x4 w; w.x = cvt_pk_bf16(v0[0], v0[1]); w.y = cvt_pk_bf16(v0[2], v0[3]); w.z = cvt_pk_bf16(v1[0], v1[1]); w.w = cvt_pk_bf16(v1[2], v1[3]);
                    *(u32x4*)(rowp + bj * HALF) = w;
                    if (hz && (row & 63) >= 61) *(u32x4*)(halo + ((size_t)(row >> 6) * 3 + (row & 63) - 61) * 768 + (col0 - 1024) + bj * HALF) = w;
                    if (vta != nullptr && u.pn == 2) { bf16_t* vp = vta + (size_t)(col0 - 512 + bj * HALF) * vld + row;
                        vp[0] = (bf16_t)(w.x & 0xffffu); vp[(size_t)vld] = (bf16_t)(w.x >> 16); vp[(size_t)2 * vld] = (bf16_t)(w.y & 0xffffu); vp[(size_t)3 * vld] = (bf16_t)(w.y >> 16);
                        vp[(size_t)4 * vld] = (bf16_t)(w.z & 0xffffu); vp[(size_t)5 * vld] = (bf16_t)(w.z >> 16); vp[(size_t)6 * vld] = (bf16_t)(w.w & 0xffffu); vp[(size_t)7 * vld] = (bf16_t)(w.w >> 16); } } }
    }
};
struct EpiRes {
    static constexpr bool PERM = false, AFTER_DRAIN = false;
    const float* rlo; const float* rhi; float* C; const float* nw; bf16_t* xo; float* rs; const bf16_t* rbf; const float* rw; bf16_t* Cb;
    __device__ __forceinline__ void operator()(const f32x4 (&acc)[2][2][4][2], const Unit& u, int wr, int wc, int fr, int fq) const {
        const int row0 = u.pm * BM + wr * 64 + fr, col0 = u.pn * BM + wc * 32 + 4 * fq;
        const float* rb = (u.pm < 64) ? rlo : rhi;
        f32x4 wv[2][2];
        if (nw || rbf) {
#pragma unroll
            for (int bj = 0; bj < 2; ++bj)
#pragma unroll
                for (int n = 0; n < 2; ++n) { if (nw) wv[bj][n] = *(const f32x4*)(nw + col0 + bj * HALF + n * 16);
                    else if (rw) { const f32x4 t = *(const f32x4*)(rw + col0 + bj * HALF + n * 16); wv[bj][n] = (f32x4){__builtin_amdgcn_rcpf(t[0]), __builtin_amdgcn_rcpf(t[1]), __builtin_amdgcn_rcpf(t[2]), __builtin_amdgcn_rcpf(t[3])}; }
                    else wv[bj][n] = (f32x4){1.f, 1.f, 1.f, 1.f}; } }
#pragma unroll
        for (int ai = 0; ai < 2; ++ai)
#pragma unroll
        for (int mh = 0; mh < 2; ++mh) {
            f32x4 rv[2][2][2];
#pragma unroll
            for (int m2 = 0; m2 < 2; ++m2)
#pragma unroll
                for (int bj = 0; bj < 2; ++bj)
#pragma unroll
                    for (int n = 0; n < 2; ++n) { const size_t o = (size_t)(row0 + ai * HALF + (2 * mh + m2) * 16) * 1024 + col0 + bj * HALF + n * 16;
                        if (rbf) { const unsigned long long w = *(const unsigned long long*)(rbf + o); const unsigned lo = (unsigned)w, hi = (unsigned)(w >> 32);
                            rv[m2][bj][n] = (f32x4){__builtin_bit_cast(float, lo << 16), __builtin_bit_cast(float, lo & 0xffff0000u), __builtin_bit_cast(float, hi << 16), __builtin_bit_cast(float, hi & 0xffff0000u)}; if (!nw) rv[m2][bj][n] = rv[m2][bj][n] * wv[bj][n]; }
                        else rv[m2][bj][n] = *(const f32x4*)(rb + o); }
#pragma unroll
            for (int m2 = 0; m2 < 2; ++m2) { const int m = 2 * mh + m2; const int row = row0 + ai * HALF + m * 16; const size_t off = (size_t)row * 1024 + col0; float ss = 0.f;
#pragma unroll
                for (int bj = 0; bj < 2; ++bj)
#pragma unroll
                    for (int n = 0; n < 2; ++n) { const f32x4 x = rv[m2][bj][n] + acc[ai][bj][m][n]; if (C) *(f32x4*)(C + off + bj * HALF + n * 16) = x;
                        if (Cb) *(unsigned long long*)(Cb + off + bj * HALF + n * 16) = (unsigned long long)cvt_pk_bf16(x[0], x[1]) | ((unsigned long long)cvt_pk_bf16(x[2], x[3]) << 32);
                        if (nw) { ss += (x[0] * x[0] + x[1] * x[1]) + (x[2] * x[2] + x[3] * x[3]); const f32x4 y = x * wv[bj][n];
                            *(unsigned long long*)(xo + off + bj * HALF + n * 16) = (unsigned long long)cvt_pk_bf16(y[0], y[1]) | ((unsigned long long)cvt_pk_bf16(y[2], y[3]) << 32); } }
                if (nw) { const int lane = fq * 16 + fr;
                    ss += __builtin_bit_cast(float, __builtin_amdgcn_ds_bpermute((lane ^ 16) << 2, __builtin_bit_cast(int, ss)));
                    ss += __builtin_bit_cast(float, __builtin_amdgcn_ds_bpermute((lane ^ 32) << 2, __builtin_bit_cast(int, ss)));
                    if (fq == 0) atomicAdd(rs + row, ss); } }
            asm volatile("" ::: "memory");
        }
    }
};
struct EpiSwiGLU {
    static constexpr bool PERM = true, AFTER_DRAIN = false;
    bf16_t* O; int ldc; const float* rs;
    __device__ __forceinline__ void operator()(const f32x4 (&acc)[2][2][4][2], const Unit& u, int wr, int wc, int fr, int fq) const {
        const int row0 = u.pm * BM + wr * 64 + fr, col0 = u.pn * HALF + wc * 32 + 8 * fq;
#pragma unroll
        for (int ai = 0; ai < 2; ++ai)
#pragma unroll
            for (int m = 0; m < 4; ++m) { const int row = row0 + ai * HALF + m * 16; bf16_t* rowp = O + (size_t)row * ldc + col0;
                const float rstd = __builtin_amdgcn_rsqf(rs[row] * (1.0f / 1024.0f) + 1e-6f);
                const f32x4 g0 = acc[ai][0][m][0] * rstd, g1 = acc[ai][0][m][1] * rstd, u0 = acc[ai][1][m][0] * rstd, u1 = acc[ai][1][m][1] * rstd;
                u32x4 w; w.x = cvt_pk_bf16(silu_f(g0[0]) * u0[0], silu_f(g0[1]) * u0[1]); w.y = cvt_pk_bf16(silu_f(g0[2]) * u0[2], silu_f(g0[3]) * u0[3]);
                w.z = cvt_pk_bf16(silu_f(g1[0]) * u1[0], silu_f(g1[1]) * u1[1]); w.w = cvt_pk_bf16(silu_f(g1[2]) * u1[2], silu_f(g1[3]) * u1[3]);
                *(u32x4*)rowp = w; }
    }
};
template <class Epi, class Sched, bool ALIGN_EPI = false, bool SP2 = false>
__device__ __forceinline__ void gemm_phase(PG8_LAS unsigned char* lds, const Gemm g, const Sched& S, const Epi& E) {
    int tid0 = threadIdx.x; asm volatile("" : "+v"(tid0));
    const int tid = tid0, wid = __builtin_amdgcn_readfirstlane(tid >> 6), lane = tid & 63, wr = wid >> 2, wc = wid & 3, fr = lane & 15, fq = lane >> 4;
    const int K = g.K, nt = K / BK;
    unsigned voffA[2], voffB[2];
#pragma unroll
    for (int i = 0; i < 2; ++i) { int R, C; stage_rc(tid * 16 + i * 8192, R, C); const int Rb = Epi::PERM ? ((R & ~31) + perm32(R & 31)) : R;
        voffA[i] = (unsigned)(R * K + C) * 2u; voffB[i] = (unsigned)(Rb * K + C) * 2u; }
    const size_t kstep = (size_t)(BK * 2);
    const size_t hstep = (size_t)HALF * K * 2;
    const size_t tstep = 2 * hstep;
    const unsigned ldsw = (unsigned)wid * 1024u;
    const int aoff = lds_byte(wr * 64 + fr, fq * 8), boff = lds_byte(wc * 32 + fr, fq * 8);
#define PG8_SA(b, h) (((b) * 2 + (h)) * HTB)
#define PG8_SB(b, h) ((4 + (b) * 2 + (h)) * HTB)
#define PG8_STAGE(bufoff, gbase, voff) do { _Pragma("unroll") for (int _i = 0; _i < 2; ++_i) \
        __builtin_amdgcn_global_load_lds((const unsigned*)((const char*)(gbase) + (voff)[_i]), (PG8_LAS unsigned*)(lds + (bufoff) + ldsw + _i * 8192), 16, 0, 0); } while (0)
#define PG8_LDA(dst, b, h) do { _Pragma("unroll") for (int m = 0; m < 4; ++m) _Pragma("unroll") for (int k = 0; k < 2; ++k) dst[m][k] = *(const PG8_LAS bf16x8*)(lds + PG8_SA(b, h) + aoff + m * 2048 + k * 1024); } while (0)
#define PG8_LDB(dst, b, h) do { _Pragma("unroll") for (int n = 0; n < 2; ++n) _Pragma("unroll") for (int k = 0; k < 2; ++k) dst[n][k] = *(const PG8_LAS bf16x8*)(lds + PG8_SB(b, h) + boff + n * 2048 + k * 1024); } while (0)
#define PG8_MMA(ai, bj, At, Bt) do { __builtin_amdgcn_s_setprio(1); _Pragma("unroll") for (int m = 0; m < 4; ++m) _Pragma("unroll") for (int n = 0; n < 2; ++n) _Pragma("unroll") for (int k = 0; k < 2; ++k) \
        acc[ai][bj][m][n] = __builtin_amdgcn_mfma_f32_16x16x32_bf16(Bt[n][k], At[m][k], acc[ai][bj][m][n], 0, 0, 0); __builtin_amdgcn_s_setprio(0); } while (0)
#define PG8_WAIT_V(n) asm volatile("s_waitcnt vmcnt(" #n ")" ::: "memory")
#define PG8_WAIT_L(n) asm volatile("s_waitcnt lgkmcnt(" #n ")" ::: "memory")
#define PG8_BAR __builtin_amdgcn_s_barrier()
#define PG8_SCHED __builtin_amdgcn_sched_barrier(0)
    Unit cur, nxt; int ui = 0;
    if (!S.next(0, cur)) return;
    f32x4 acc[2][2][4][2];
#pragma unroll
    for (int a = 0; a < 2; ++a)
#pragma unroll
        for (int b = 0; b < 2; ++b)
#pragma unroll
            for (int m = 0; m < 4; ++m)
#pragma unroll
                for (int n = 0; n < 2; ++n) acc[a][b][m][n] = (f32x4){0.f, 0.f, 0.f, 0.f};
    bf16x8 At[4][2], B0[2][2], B1[2][2];
    const char* cA = (const char*)g.A + (size_t)cur.pm * tstep; const char* cB = (const char*)g.Bt + (size_t)cur.pn * tstep;
    S.a_ready(cur);
    if constexpr (SP2) {
        PG8_STAGE(PG8_SB(0, 0), cB, voffB); PG8_STAGE(PG8_SB(0, 1), cB + hstep, voffB); PG8_STAGE(PG8_SA(0, 0), cA, voffA); PG8_STAGE(PG8_SA(0, 1), cA + hstep, voffA);
        if (wr == 1) PG8_BAR;
        PG8_WAIT_V(2); PG8_BAR;
        PG8_STAGE(PG8_SB(1, 0), cB + kstep, voffB); PG8_STAGE(PG8_SA(1, 0), cA + kstep, voffA); PG8_STAGE(PG8_SB(1, 1), cB + hstep + kstep, voffB);
        PG8_WAIT_V(6); PG8_BAR;
    } else {
        PG8_STAGE(PG8_SB(0, 0), cB, voffB); PG8_STAGE(PG8_SA(0, 0), cA, voffA); PG8_STAGE(PG8_SB(0, 1), cB + hstep, voffB); PG8_STAGE(PG8_SA(0, 1), cA + hstep, voffA);
        if (wr == 1) PG8_BAR;
        PG8_WAIT_V(4); PG8_BAR;
        PG8_STAGE(PG8_SB(1, 0), cB + kstep, voffB); PG8_STAGE(PG8_SA(1, 0), cA + kstep, voffA); PG8_STAGE(PG8_SB(1, 1), cB + hstep + kstep, voffB);
        PG8_WAIT_V(6); PG8_BAR;
    }
    for (;;) {
        const bool has_next = S.next(ui + 1, nxt);
        const char* nA = has_next ? (const char*)g.A + (size_t)nxt.pm * tstep : cA; const char* nB = has_next ? (const char*)g.Bt + (size_t)nxt.pn * tstep : cB;
        for (int t = 0; t < nt; t += 2) {
            const bool last = (t == nt - 2);
            const char* a1 = cA + (size_t)(t + 1) * kstep;
            const char* a2 = last ? nA : cA + (size_t)(t + 2) * kstep; const char* b2 = last ? nB : cB + (size_t)(t + 2) * kstep;
            const char* a3 = a2 + kstep; const char* b3 = b2 + kstep;
            if (last && has_next) S.a_ready(nxt);
            if constexpr (SP2) {
            PG8_LDB(B0, 0, 0); PG8_LDB(B1, 0, 1); PG8_SCHED; PG8_LDA(At, 0, 0); PG8_STAGE(PG8_SA(1, 1), a1 + hstep, voffA);
            PG8_WAIT_V(8); PG8_WAIT_L(0); PG8_BAR; PG8_MMA(0, 0, At, B0); PG8_MMA(0, 1, At, B1); PG8_BAR; PG8_SCHED;
            PG8_LDA(At, 0, 1); PG8_STAGE(PG8_SB(0, 0), b2, voffB); PG8_STAGE(PG8_SB(0, 1), b2 + hstep, voffB); PG8_STAGE(PG8_SA(0, 0), a2, voffA);
            PG8_WAIT_V(8); PG8_WAIT_L(0); PG8_BAR; PG8_MMA(1, 0, At, B0); PG8_MMA(1, 1, At, B1); PG8_BAR; PG8_SCHED;
            PG8_LDB(B0, 1, 0); PG8_LDB(B1, 1, 1); PG8_SCHED; PG8_LDA(At, 1, 0); PG8_STAGE(PG8_SA(0, 1), a2 + hstep, voffA);
            PG8_WAIT_V(8); PG8_WAIT_L(0); PG8_BAR; PG8_MMA(0, 0, At, B0); PG8_MMA(0, 1, At, B1); PG8_BAR; PG8_SCHED;
            PG8_LDA(At, 1, 1); PG8_STAGE(PG8_SB(1, 0), b3, voffB); PG8_STAGE(PG8_SB(1, 1), b3 + hstep, voffB); PG8_STAGE(PG8_SA(1, 0), a3, voffA);
            PG8_WAIT_V(8); PG8_WAIT_L(0); PG8_BAR; PG8_MMA(1, 0, At, B0); PG8_MMA(1, 1, At, B1); PG8_BAR; PG8_SCHED;
            } else {
            PG8_LDB(B0, 0, 0); PG8_SCHED; PG8_LDA(At, 0, 0); PG8_STAGE(PG8_SA(1, 1), a1 + hstep, voffA);
            PG8_WAIT_L(8); PG8_BAR; PG8_WAIT_L(0); PG8_MMA(0, 0, At, B0); PG8_BAR; PG8_SCHED;
            PG8_LDB(B1, 0, 1); PG8_STAGE(PG8_SB(0, 0), b2, voffB);
            PG8_BAR; PG8_WAIT_L(0); PG8_MMA(0, 1, At, B1); PG8_BAR;
            PG8_LDA(At, 0, 1); PG8_STAGE(PG8_SA(0, 0), a2, voffA);
            PG8_BAR; PG8_WAIT_L(0); PG8_MMA(1, 0, At, B0); PG8_BAR; PG8_SCHED;
            PG8_STAGE(PG8_SB(0, 1), b2 + hstep, voffB);
            PG8_WAIT_V(6); PG8_BAR; PG8_MMA(1, 1, At, B1); PG8_BAR;
            PG8_LDB(B0, 1, 0); PG8_SCHED; PG8_LDA(At, 1, 0); PG8_STAGE(PG8_SA(0, 1), a2 + hstep, voffA);
            PG8_WAIT_L(8); PG8_BAR; PG8_WAIT_L(0); PG8_MMA(0, 0, At, B0); PG8_BAR; PG8_SCHED;
            PG8_LDB(B1, 1, 1); PG8_STAGE(PG8_SB(1, 0), b3, voffB);
            PG8_BAR; PG8_WAIT_L(0); PG8_MMA(0, 1, At, B1); PG8_BAR;
            PG8_LDA(At, 1, 1); PG8_STAGE(PG8_SA(1, 0), a3, voffA);
            PG8_BAR; PG8_WAIT_L(0); PG8_MMA(1, 0, At, B0); PG8_BAR; PG8_SCHED;
            PG8_STAGE(PG8_SB(1, 1), b3 + hstep, voffB);
            PG8_WAIT_V(6); PG8_BAR; PG8_MMA(1, 1, At, B1); PG8_BAR;
            }
        }
        if constexpr (ALIGN_EPI) { if (wr == 0) PG8_BAR; }
        if constexpr (!Epi::AFTER_DRAIN) { E(acc, cur, wr, wc, fr, fq); S.done(cur); }
        if (!has_next) break;
#pragma unroll
        for (int a = 0; a < 2; ++a)
#pragma unroll
            for (int b = 0; b < 2; ++b)
#pragma unroll
                for (int m = 0; m < 4; ++m)
#pragma unroll
                    for (int n = 0; n < 2; ++n) acc[a][b][m][n] = (f32x4){0.f, 0.f, 0.f, 0.f};
        cur = nxt; cA = nA; cB = nB; ++ui;
        if constexpr (ALIGN_EPI) { if (wr == 1) PG8_BAR; }
    }
    PG8_WAIT_V(0);
    if constexpr (!ALIGN_EPI) { if (wr == 0) PG8_BAR; }
    PG8_BAR;
    if constexpr (Epi::AFTER_DRAIN) { E.fused(acc, cur, wr, wc, fr, fq, lds, wid, lane); S.done(cur); }
#undef PG8_SA
#undef PG8_SB
#undef PG8_STAGE
#undef PG8_LDA
#undef PG8_LDB
#undef PG8_MMA
#undef PG8_WAIT_V
#undef PG8_WAIT_L
#undef PG8_BAR
#undef PG8_SCHED
}
}
#define GAS __attribute__((address_space(1)))
#define LAS __attribute__((address_space(3)))
typedef unsigned short bf16;
typedef unsigned v4u __attribute__((ext_vector_type(4)));
typedef float f32x4 __attribute__((ext_vector_type(4)));
typedef short bf16x8 __attribute__((ext_vector_type(8)));
typedef GAS unsigned gu32;
typedef GAS unsigned long long gu64;
#define RLX_AGENT __ATOMIC_RELAXED, __HIP_MEMORY_SCOPE_AGENT
#define LDS_WAIT() asm volatile("s_waitcnt lgkmcnt(0)" ::: "memory")
#define VM_WAIT() asm volatile("s_waitcnt vmcnt(0)" ::: "memory")
__device__ __forceinline__ unsigned long long rt() { return __builtin_amdgcn_s_memrealtime(); }
__device__ __forceinline__ unsigned f2bf(float f) { unsigned u = __builtin_bit_cast(unsigned, f); return (u + 0x7fffu + ((u >> 16) & 1u)) >> 16; }
__device__ __forceinline__ unsigned pk2(float lo, float hi) { return f2bf(lo) | (f2bf(hi) << 16); }
#define XB_TMO      128
#define XB_XCNT(j)  (256  + 64 * (j))
#define XB_XSUB(j)  (1280 + 64 * (j))
#define XB_XGEN(j)  (2304 + 64 * (j))
#define XB_TOP      3328
#define XB_TOPGEN   3392
#define XCD_BAR_WORDS 3456
#define XB_SPIN_CAP (1u << 18)

__device__ __forceinline__ unsigned xb_ld(unsigned* p)              { return __hip_atomic_load(p, __ATOMIC_RELAXED, __HIP_MEMORY_SCOPE_AGENT); }
__device__ __forceinline__ unsigned xb_add(unsigned* p, unsigned v) { return __hip_atomic_fetch_add(p, v, __ATOMIC_RELAXED, __HIP_MEMORY_SCOPE_AGENT); }
__device__ __forceinline__ unsigned xb_xcc_id() { return (unsigned)__builtin_amdgcn_s_getreg((3 << 11) | 20) & 0xFu; }
#define XB_SPIN(cond, bar) do { unsigned _sp = 0; while (cond) { __builtin_amdgcn_s_sleep(1); \
    if ((++_sp & 255u) == 0u) { if (xb_ld(&(bar)[XB_TMO])) break; if (_sp > XB_SPIN_CAP) { atomicAdd(&(bar)[XB_TMO], 1u); break; } } } } while (0)

struct XcdBarrier {
    unsigned* bar; unsigned x;
    volatile LAS unsigned* st;
};

__device__ __forceinline__ XcdBarrier xcd_barrier_post(unsigned* bar, volatile LAS unsigned* st) {
    XcdBarrier b; b.bar = bar; b.x = xb_xcc_id(); b.st = st;
    if (threadIdx.x == 0) (void)xb_add(&bar[XB_XCNT(b.x)], 1u);
    return b;
}
__device__ __forceinline__ void xcd_barrier_complete(unsigned* bar, unsigned x, unsigned& nloc, unsigned& nx) {
    const unsigned G = gridDim.x * gridDim.y * gridDim.z;
    unsigned sum, cnt, mine, sp = 0u;
    for (;;) {
        sum = 0u; cnt = 0u; mine = 0u;
#pragma unroll
        for (unsigned j = 0; j < 16; ++j) { const unsigned c = xb_ld(&bar[XB_XCNT(j)]); sum += c; cnt += (c > 0u) ? 1u : 0u; mine = (j == x) ? c : mine; }
        if (sum == G) break;
        __builtin_amdgcn_s_sleep(1);
        if ((++sp & 255u) == 0u) { if (xb_ld(&bar[XB_TMO])) break; if (sp > XB_SPIN_CAP) { atomicAdd(&bar[XB_TMO], 1u); break; } }
    }
    nloc = mine > 0u ? mine : 1u; nx = cnt > 0u ? cnt : 1u;
}

__device__ __forceinline__ void xcd_barrier(const XcdBarrier& b) {
    asm volatile("s_waitcnt vmcnt(0)" ::: "memory");
    __syncthreads();
    if (threadIdx.x == 0) {
        unsigned* bar = b.bar;
        __builtin_amdgcn_s_waitcnt(0);
        unsigned nloc = b.st[0], nx = b.st[1];
        if (nloc == 0u) { xcd_barrier_complete(bar, b.x, nloc, nx); b.st[0] = nloc; b.st[1] = nx; }
        const unsigned old = xb_add(&bar[XB_XSUB(b.x)], 1u);
        const unsigned gen = old / nloc;
        if (old + 1u == (gen + 1u) * nloc) {
            __builtin_amdgcn_fence(__ATOMIC_RELEASE, "agent");
            asm volatile("s_waitcnt vmcnt(0)" ::: "memory");
            const unsigned og = xb_add(&bar[XB_TOP], 1u);
            const unsigned tg = og / nx;
            if (og + 1u == (tg + 1u) * nx) xb_add(&bar[XB_TOPGEN], 1u);
            else XB_SPIN(xb_ld(&bar[XB_TOPGEN]) == tg, bar);
            __builtin_amdgcn_fence(__ATOMIC_ACQUIRE, "agent");
            xb_add(&bar[XB_XGEN(b.x)], 1u);
            asm volatile("s_waitcnt vmcnt(0)" ::: "memory");
        } else {
            XB_SPIN(xb_ld(&bar[XB_XGEN(b.x)]) == gen, bar);
            __builtin_amdgcn_fence(__ATOMIC_ACQUIRE, "agent");
            asm volatile("s_waitcnt vmcnt(0)" ::: "memory");
        }
    }
    __syncthreads();
}
constexpr int NWAVES = 8, NTHR = 512;
constexpr int D = 1024, MP = 16384, NSB = 16, SSEQ = 16, MS = NSB * SSEQ, M = MP + MS;
constexpr int NIN = 3076, NPROJ = 3072, DFF = 2816, NGU = 2 * DFF;
constexpr int NCHP = 256, NCH = NCHP + NSB;
constexpr int PC_Q = 0, PC_K = 256, PC_V = 512, PC_Z = 768, PC_X = 1024, PC_B = 1280, PC_C = 1536, PC_CQ = 1792, PC_CF = 2048, PC_CI = 2304, PC_CG = 2560, PC_DX = 2816;
constexpr float EPS = 1e-6f;
enum { I_XP = 0, I_XS, I_CK, I_CV, I_SCONV, I_SSSM, I_SHGRN, I_SPOOL, I_N1, I_WIN, I_AREL, I_CW, I_CB, I_DTB, I_ALOG, I_BD, I_BNRM, I_LB, I_CNRM, I_PW, I_PS, I_WOUT, I_N2, I_WGU, I_WDN, I_NF, N_IN };
constexpr size_t O_YP = 0, O_YS = O_YP + (size_t)MP * D, O_PK = O_YS + (size_t)MS * D, O_PV = O_PK + 2 * 512 * 256, O_PCONV = O_PV + 2 * 512 * 256, O_PSSM = O_PCONV + 2 * 3 * 768,
                 O_PHGRN = O_PSSM + 2 * 4 * 64 * 128, O_PPOOL = O_PHGRN + 2 * 4 * 64 * 64, O_SK = O_PPOOL + 2 * 15 * 256, O_SV = O_SK + (size_t)2 * 16 * 512 * 256,
                 O_SCONV = O_SV + (size_t)2 * 16 * 512 * 256, O_SSSM = O_SCONV + 2 * 16 * 3 * 768, O_SHGRN = O_SSSM + 2 * 16 * 4 * 64 * 128, O_SPOOL = O_SHGRN + 2 * 16 * 4 * 64 * 64,
                 O_END = O_SPOOL + 2 * 16 * 15 * 256;
constexpr size_t MiB = 1u << 20;
constexpr size_t WS_CTL = 0, CTL_ZERO_BYTES = 64 * 1024;
constexpr size_t WL_IN = 0, WL_OUT = 6 * MiB, WL_GU = 8 * MiB, WL_DN = 19 * MiB, WL_STRIDE = 24 * MiB + MiB / 2;
constexpr size_t WS_W = 1 * MiB;
constexpr size_t WS_XN = 50 * MiB;
constexpr size_t WS_PROJ = 83 * MiB;
constexpr size_t WS_STB = 181 * MiB;
constexpr size_t WS_XT = 198 * MiB;
constexpr size_t WS_HALO = 207 * MiB;
constexpr size_t WS_RH = 208 * MiB + MiB / 2;
constexpr size_t WS_STC = 215 * MiB;
constexpr size_t WS_VT = 223 * MiB + MiB / 2;
constexpr size_t WS_DT = 232 * MiB;
constexpr size_t WS_DECB = 233 * MiB;
constexpr size_t WS_DECC = 233 * MiB + 64 * 1024;
constexpr size_t WS_ACS = 233 * MiB + 384 * 1024, WS_DTV = 233 * MiB + 704 * 1024;
constexpr size_t WS_VTA = 234 * MiB;
constexpr size_t WS_END = 243 * MiB;
static_assert(WS_VTA + (size_t)256 * M * 2 <= WS_END, "ws map 2");
constexpr int CW_QUEUE = 512;
static_assert(WS_XN + (size_t)M * D * 2 <= WS_PROJ && WS_PROJ + (size_t)M * NPROJ * 2 <= WS_STB && WS_STB + (size_t)NCH * 4 * 64 * 128 * 2 <= WS_XT && WS_XT + (size_t)NCH * 256 * 64 * 2 <= WS_HALO && WS_HALO + (size_t)256 * 3 * 768 * 2 <= WS_STC && WS_RH + (size_t)NCH * 1280 * 4 <= WS_STC && WS_STC + (size_t)NCH * 4 * 64 * 64 * 2 <= WS_VT && WS_VT + (size_t)NCH * 256 * 64 * 2 <= WS_DT, "ws map");
static_assert(WL_DN + (size_t)D * DFF * 2 <= WL_STRIDE && WS_W + 2 * WL_STRIDE <= WS_XN, "weight map");
constexpr size_t WS_WPT = 128 * 1024;
constexpr size_t WS_RS = 256 * 1024;
constexpr size_t WS_XN2 = 181 * MiB;
static_assert(WS_XN2 + (size_t)M * D * 2 <= 232 * MiB && WS_RS + 2 * (size_t)M * 4 <= MiB, "ws map 3");
constexpr int CW_BAR = 1024;
constexpr int LDS_BYTES = 163840;
constexpr int MISC_OFF = LDS_BYTES - 256;
constexpr int RING_OFF = 0;
typedef LAS float lf32;
typedef float f32x2 __attribute__((ext_vector_type(2)));
struct Args { const float* in[N_IN]; float* out; unsigned char* ws; };
struct Frame {
    LAS unsigned char* lds;
    float* out; unsigned char* ws;
};
__device__ __forceinline__ float* inp(int i) { asm volatile("" : "+s"(i)); return ((float* const __attribute__((address_space(4)))*)__builtin_amdgcn_kernarg_segment_ptr())[i]; }
__device__ __forceinline__ unsigned char* opq(unsigned char* p) { asm volatile("" : "+s"(p)); return p; }
#define ITEM_IDS() int tid_ = threadIdx.x; asm volatile("" : "+v"(tid_)); const int wave_ = __builtin_amdgcn_readfirstlane(tid_ >> 6); const int lane_ = tid_ & 63; (void)lane_; (void)wave_
#define F_XN ((bf16*)opq(F.ws + WS_XN))
#define F_PROJ ((bf16*)opq(F.ws + WS_PROJ))
#define F_ACT ((bf16*)opq(F.ws + WS_PROJ))
#define F_STB ((bf16*)opq(F.ws + WS_STB))
#define F_XT ((bf16*)opq(F.ws + WS_XT))
#define F_HALO ((bf16*)opq(F.ws + WS_HALO))
#define F_ACS ((float*)opq(F.ws + WS_ACS))
#define F_DTV ((float*)opq(F.ws + WS_DTV))
#define F_STC ((bf16*)opq(F.ws + WS_STC))
#define F_VT ((bf16*)opq(F.ws + WS_VT))
#define F_RH ((float*)opq(F.ws + WS_RH))
#define F_VTA ((bf16*)opq(F.ws + WS_VTA))
#define F_WPT ((bf16*)opq(F.ws + WS_WPT))
#define F_RS ((float*)opq(F.ws + WS_RS))
#define F_XN2 ((bf16*)opq(F.ws + WS_XN2))
#define F_DT ((float*)opq(F.ws + WS_DT))
#define F_DECB ((float*)opq(F.ws + WS_DECB))
#define F_DECC ((float*)opq(F.ws + WS_DECC))
#define F_X    (F.out)
__device__ __forceinline__ float bf_lo(unsigned w) { return __builtin_bit_cast(float, w << 16); }
__device__ __forceinline__ float bf_hi(unsigned w) { return __builtin_bit_cast(float, w & 0xffff0000u); }
__device__ __forceinline__ float bf1(bf16 b) { return __builtin_bit_cast(float, (unsigned)b << 16); }
__device__ __forceinline__ void unpack8(const v4u w, float (&v)[8]) { v[0] = bf_lo(w.x); v[1] = bf_hi(w.x); v[2] = bf_lo(w.y); v[3] = bf_hi(w.y); v[4] = bf_lo(w.z); v[5] = bf_hi(w.z); v[6] = bf_lo(w.w); v[7] = bf_hi(w.w); }
__device__ __forceinline__ v4u pack8(const float (&v)[8]) { v4u o; o.x = pk2(v[0], v[1]); o.y = pk2(v[2], v[3]); o.z = pk2(v[4], v[5]); o.w = pk2(v[6], v[7]); return o; }
__device__ __forceinline__ float shx(int lane, float v, int o) { return __builtin_bit_cast(float, __builtin_amdgcn_ds_bpermute((lane ^ o) << 2, __builtin_bit_cast(int, v))); }
__device__ __forceinline__ float shu(int lane, float v, int o) { return __builtin_bit_cast(float, __builtin_amdgcn_ds_bpermute((lane - o) << 2, __builtin_bit_cast(int, v))); }
__device__ __forceinline__ float shi(float v, int idx) { return __builtin_bit_cast(float, __builtin_amdgcn_ds_bpermute(idx << 2, __builtin_bit_cast(int, v))); }
__device__ __forceinline__ float wave_sum_l(int lane, float v) {
#pragma unroll
    for (int o = 1; o < 64; o <<= 1) v += shx(lane, v, o);
    return v;
}
__device__ __forceinline__ float sum16_l(int lane, float v) {
#pragma unroll
    for (int o = 1; o < 16; o <<= 1) v += shx(lane, v, o);
    return v;
}
__device__ __forceinline__ float max16_l(int lane, float v) {
#pragma unroll
    for (int o = 1; o < 16; o <<= 1) v = fmaxf(v, shx(lane, v, o));
    return v;
}
__device__ __forceinline__ float rcp_f(float x) { return __builtin_amdgcn_rcpf(x); }
__device__ __forceinline__ float rsq_f(float x) { return __builtin_amdgcn_rsqf(x); }
__device__ __forceinline__ float sigmoid_f(float x) { return rcp_f(1.0f + __expf(-x)); }
__device__ __forceinline__ float silu_g(float x) { return x * rcp_f(1.0f + __expf(-x)); }
__device__ __forceinline__ float softplus_f(float x) { const float e = __expf(x); return x > 20.f ? x : (e < 0.01f ? e * (1.0f - e * (0.5f - e * (1.0f / 3.0f))) : __logf(1.0f + e)); }
__device__ __forceinline__ f32x4 mfma4(float a, float b, f32x4 c) { return __builtin_amdgcn_mfma_f32_16x16x4f32(a, b, c, 0, 0, 0); }

struct Chunk { int ci, row0, nrows, b; };
__device__ __forceinline__ Chunk chunk_of(int ci) { Chunk c; c.ci = ci; if (ci < NCHP) { c.row0 = 64 * ci; c.nrows = 64; c.b = -1; } else { c.b = ci - NCHP; c.row0 = MP + SSEQ * c.b; c.nrows = SSEQ; } return c; }

__device__ __forceinline__ void tr_item64(const float* W, int ldw, int K, bf16* WT, int k0, int nd0, int ns0, float scale, lf32* scr, int lane) {
    f32x4 wv_[16];
    const int rq = lane >> 4, c4 = (lane & 15) * 4;
#pragma unroll
    for (int i = 0; i < 16; ++i) wv_[i] = *(const f32x4*)(W + (size_t)(k0 + 4 * i + rq) * ldw + ns0 + c4);
#pragma unroll
    for (int i = 0; i < 16; ++i) { lf32* d = scr + (4 * i + rq) * 65 + c4; d[0] = wv_[i].x; d[1] = wv_[i].y; d[2] = wv_[i].z; d[3] = wv_[i].w; }
    LDS_WAIT(); asm volatile("" ::: "memory");
    const int c = lane & 7;
#pragma unroll
    for (int j = 0; j < 8; ++j) { const int n = (lane >> 3) + 8 * j; const lf32* s = scr + (8 * c) * 65 + n;
        v4u o; o.x = pk2(s[0 * 65] * scale, s[1 * 65] * scale); o.y = pk2(s[2 * 65] * scale, s[3 * 65] * scale); o.z = pk2(s[4 * 65] * scale, s[5 * 65] * scale); o.w = pk2(s[6 * 65] * scale, s[7 * 65] * scale);
        *(GAS v4u*)(WT + (size_t)(nd0 + n) * K + k0 + 8 * c) = o; }
    LDS_WAIT(); asm volatile("" ::: "memory");
}
__device__ __forceinline__ void tr_item(const float* W, int ldw, int K, bf16* WT, int k0, int nd0, int ns0, float scale, lf32* scr, int lane) {
    float wv_[32];
#pragma unroll
    for (int i = 0; i < 32; ++i) wv_[i] = W[(size_t)(k0 + 2 * i + (lane >> 5)) * ldw + ns0 + (lane & 31)];
#pragma unroll
    for (int i = 0; i < 32; ++i) scr[(2 * i + (lane >> 5)) * 33 + (lane & 31)] = wv_[i];
    LDS_WAIT(); asm volatile("" ::: "memory");
    const int c = lane & 7;
#pragma unroll
    for (int j = 0; j < 4; ++j) { const int n = (lane >> 3) + 8 * j; const lf32* s = scr + (8 * c) * 33 + n;
        v4u o; o.x = pk2(s[0 * 33] * scale, s[1 * 33] * scale); o.y = pk2(s[2 * 33] * scale, s[3 * 33] * scale); o.z = pk2(s[4 * 33] * scale, s[5 * 33] * scale); o.w = pk2(s[6 * 33] * scale, s[7 * 33] * scale);
        *(GAS v4u*)(WT + (size_t)(nd0 + n) * K + k0 + 8 * c) = o; }
    LDS_WAIT(); asm volatile("" ::: "memory");
}
__device__ __forceinline__ void p0_weights(Frame& F, int l, int gw, int NGW, bool pool) {
    ITEM_IDS();
    lf32* scr = (lf32*)(F.lds + wave_ * 16896);
    constexpr int I_INA = 16 * 28, I_INB = 16 * 40, I_OUT = 16 * 16, I_GU = 16 * 88, I_DN = 44 * 16, I_L = I_INA + I_INB + I_OUT + I_GU + I_DN;
    unsigned char* wl = F.ws + WS_W + (size_t)l * WL_STRIDE;
    for (int it = gw; it < I_L; it += NGW) {
        int r = it;
        if (r < I_INA) { const int kb = r / 28, nb = r % 28, nd0 = 64 * nb; tr_item64(inp(I_WIN) + (size_t)l * D * NIN, NIN, D, (bf16*)(wl + WL_IN), 64 * kb, nd0, nd0, nd0 < 256 ? 0.125f : 1.0f, scr, lane_); continue; } r -= I_INA;
        if (r < I_INB) { const int kb = r / 40, nb = r % 40, nd0 = 1792 + 32 * nb; tr_item(inp(I_WIN) + (size_t)l * D * NIN, NIN, D, (bf16*)(wl + WL_IN), 64 * kb, nd0, nd0 + 4, 1.0f, scr, lane_); continue; } r -= I_INB;
        if (r < I_OUT) { const int kb = r / 16, nb = r % 16; tr_item64(inp(I_WOUT) + (size_t)l * D * D, D, D, (bf16*)(wl + WL_OUT), 64 * kb, 64 * nb, 64 * nb, 1.0f, scr, lane_); continue; } r -= I_OUT;
        if (r < I_GU) { const int kb = r / 88, nb = r % 88, nd0 = 64 * nb, pn = nd0 >> 8, bj = (nd0 >> 7) & 1, c = nd0 & 127; tr_item64(inp(I_WGU) + (size_t)l * D * NGU, NGU, D, (bf16*)(wl + WL_GU), 64 * kb, nd0, bj * DFF + 128 * pn + c, 1.0f, scr, lane_); continue; } r -= I_GU;
        { const int kb = r / 16, nb = r % 16; tr_item64(inp(I_WDN) + (size_t)l * DFF * D, D, DFF, (bf16*)(wl + WL_DN), 64 * kb, 64 * nb, 64 * nb, 1.0f, scr, lane_); }
    }
    if (pool) { const float* pw = inp(I_PW); for (int i = ((int)blockIdx.x) * NTHR + tid_; i < 2 * 4 * 64 * 64; i += ((int)gridDim.x) * NTHR) { const int c = i & 63, d = (i >> 6) & 63, lg = i >> 12; F_WPT[i] = (bf16)f2bf(pw[(size_t)(lg * 64 + c) * 64 + d]); } }
}
template <bool WITH_DT, bool FINAL>
__device__ __forceinline__ void norm_rows(Frame& F, const float* xlo, const float* xhi, const float* w, const float* wdt  , const bf16* xb = nullptr  , int gw_ = -1, int ngw_ = 0  ) {
    ITEM_IDS();
    lf32* wl = (lf32*)(F.lds + (gw_ >= 0 ? 135168 : 0));
    if (WITH_DT && gw_ < 0) { for (int k = tid_; k < D; k += NTHR) { const f32x4 v = *(const f32x4*)(wdt + (size_t)k * NIN + 1792); *(LAS f32x4*)(wl + 4 * k) = v; } __syncthreads(); }
    const int gw = gw_ >= 0 ? gw_ : ((int)blockIdx.x) * NWAVES + wave_, NGW = gw_ >= 0 ? ngw_ : ((int)gridDim.x) * NWAVES;
    f32x4 wv[4];
#pragma unroll
    for (int j = 0; j < 4; ++j) wv[j] = *(const f32x4*)(w + 256 * j + 4 * lane_);
    for (int m0 = gw; m0 < M; m0 += 4 * NGW) {
        f32x4 v[4][4];
#pragma unroll
        for (int q = 0; q < 4; ++q) { const int m = m0 + q * NGW; if (m < M) {
            if (xb) {
#pragma unroll
                for (int j = 0; j < 4; ++j) { const unsigned long long t = *(const unsigned long long*)(xb + (size_t)m * D + 256 * j + 4 * lane_); v[q][j] = (f32x4){bf_lo((unsigned)t), bf_hi((unsigned)t), bf_lo((unsigned)(t >> 32)), bf_hi((unsigned)(t >> 32))}; }
            } else { const float* xr = (m < MP ? xlo : xhi) + (size_t)m * D;
#pragma unroll
                for (int j = 0; j < 4; ++j) v[q][j] = *(const f32x4*)(xr + 256 * j + 4 * lane_); } } }
#pragma unroll
        for (int q = 0; q < 4; ++q) { const int m = m0 + q * NGW; if (m < M) {
            float s = 0.f;
#pragma unroll
            for (int j = 0; j < 4; ++j) s += (v[q][j].x * v[q][j].x + v[q][j].y * v[q][j].y) + (v[q][j].z * v[q][j].z + v[q][j].w * v[q][j].w);
            const float rstd = rsq_f(wave_sum_l(lane_, s) * (1.0f / D) + EPS);
#pragma unroll
            for (int j = 0; j < 4; ++j) v[q][j] = v[q][j] * rstd * wv[j];
            if (FINAL) {
#pragma unroll
                for (int j = 0; j < 4; ++j) *(f32x4*)(F.out + (size_t)m * D + 256 * j + 4 * lane_) = v[q][j];
            } else {
                GAS unsigned long long* o8 = (GAS unsigned long long*)(F_XN + (size_t)m * D) + lane_;
#pragma unroll
                for (int j = 0; j < 4; ++j) o8[64 * j] = (unsigned long long)pk2(v[q][j].x, v[q][j].y) | ((unsigned long long)pk2(v[q][j].z, v[q][j].w) << 32);
            }
            if (WITH_DT) {
                f32x4 a = {0.f, 0.f, 0.f, 0.f};
#pragma unroll
                for (int j = 0; j < 4; ++j) { const LAS f32x4* wp = (const LAS f32x4*)(wl + 4 * (256 * j + 4 * lane_));
                    a += wp[0] * v[q][j].x; a += wp[1] * v[q][j].y; a += wp[2] * v[q][j].z; a += wp[3] * v[q][j].w; }
                a.x = wave_sum_l(lane_, a.x); a.y = wave_sum_l(lane_, a.y); a.z = wave_sum_l(lane_, a.z); a.w = wave_sum_l(lane_, a.w);
                if (lane_ == 0) *(f32x4*)(F_DT + (size_t)m * 4) = a;
            } } }
    }
    if (WITH_DT && gw_ < 0) __syncthreads();
}
constexpr int PL_RAW = 0, PL_PL = 79 * 256 * 4, PL_END = PL_PL + 64 * 264 * 2;
static_assert(PL_END <= MISC_OFF, "pool LDS map");
__device__ __forceinline__ void pool_item(Frame& F, int layer, int ci) {
    ITEM_IDS();
    const Chunk c = chunk_of(ci);
    lf32* raw = (lf32*)(F.lds + PL_RAW);
    LAS bf16* Pl = (LAS bf16*)(F.lds + PL_PL);
    const float* spool = inp(I_SPOOL) + (size_t)(layer * NSB + (c.b < 0 ? 0 : c.b)) * 15 * 256;
    v4u pw[5]; f32x4 pf[5][2];
#pragma unroll
    for (int q = 0; q < 5; ++q) { const int it = tid_ + q * NTHR; pw[q] = (v4u){0u, 0u, 0u, 0u}; pf[q][0] = (f32x4){0.f, 0.f, 0.f, 0.f}; pf[q][1] = pf[q][0];
        if (it < 79 * 32) { const int rr = it >> 5, cg = it & 31, r = rr - 15;
            if (r < c.nrows) { if (r >= 0 || (c.b < 0 && c.row0 + r >= 0)) pw[q] = *(const v4u*)(F_PROJ + (size_t)(c.row0 + r) * NPROJ + PC_DX + 8 * cg);
                               else if (c.b >= 0) { const float* s = spool + (size_t)(15 + r) * 256 + 8 * cg; pf[q][0] = *(const f32x4*)s; pf[q][1] = *(const f32x4*)(s + 4); } } } }
#pragma unroll
    for (int q = 0; q < 5; ++q) { const int it = tid_ + q * NTHR;
        if (it < 79 * 32) { const int rr = it >> 5, cg = it & 31, r = rr - 15; float v[8];
            if (c.b >= 0 && r < 0) { v[0] = pf[q][0].x; v[1] = pf[q][0].y; v[2] = pf[q][0].z; v[3] = pf[q][0].w; v[4] = pf[q][1].x; v[5] = pf[q][1].y; v[6] = pf[q][1].z; v[7] = pf[q][1].w; } else unpack8(pw[q], v);
            *(LAS f32x4*)(raw + rr * 256 + 8 * cg) = (f32x4){v[0], v[1], v[2], v[3]}; *(LAS f32x4*)(raw + rr * 256 + 8 * cg + 4) = (f32x4){v[4], v[5], v[6], v[7]}; } }
    __syncthreads();
    { const int ch = tid_ & 255, half = tid_ >> 8, win = 2 << (ch >> 6); const float inv = 1.0f / (float)win;
      const lf32* rp = raw + (32 * half + 15) * 256 + ch;
      float s = 0.f; for (int q = 1; q < win; ++q) s += rp[-q * 256];
#pragma unroll 8
      for (int r = 0; r < 32; ++r) { const float x = rp[r * 256], xo = rp[(r - win + 1) * 256]; s += x; Pl[(32 * half + r) * 264 + ch] = (bf16)f2bf(s * inv - x); s -= xo; } }
    __syncthreads();
    const int tb = wave_ >> 1, g0 = 2 * (wave_ & 1), kq = lane_ >> 4, fr = lane_ & 15;
    const bf16* wt = F_WPT + (size_t)layer * 4 * 64 * 64; const float* sc = inp(I_PS) + (size_t)layer * 256;
#pragma unroll
    for (int gg = 0; gg < 2; ++gg) {
        const int g = g0 + gg;
        bf16x8 bw[4][2];
#pragma unroll
        for (int t = 0; t < 4; ++t)
#pragma unroll
            for (int ks = 0; ks < 2; ++ks) bw[t][ks] = *(const bf16x8*)(wt + (size_t)(g * 64 + t * 16 + fr) * 64 + 32 * ks + 8 * kq);
        bf16x8 a[2];
#pragma unroll
        for (int ks = 0; ks < 2; ++ks) a[ks] = *(const LAS bf16x8*)(Pl + (tb * 16 + fr) * 264 + g * 64 + 32 * ks + 8 * kq);
#pragma unroll
        for (int t = 0; t < 4; ++t) { f32x4 acc = {0.f, 0.f, 0.f, 0.f};
#pragma unroll
            for (int ks = 0; ks < 2; ++ks) acc = __builtin_amdgcn_mfma_f32_16x16x32_bf16(a[ks], bw[t][ks], acc, 0, 0, 0);
            const float s = sc[g * 64 + t * 16 + fr];
#pragma unroll
            for (int r = 0; r < 4; ++r) { const int row = tb * 16 + 4 * kq + r; if (row < c.nrows) F_XN[(size_t)(c.row0 + row) * D + 768 + g * 64 + t * 16 + fr] = (bf16)f2bf(acc[r] * s); } }
    }
    __syncthreads();
}

__device__ __forceinline__ void copy_cache(Frame& F, int layer, int b0, int nb) {
    ITEM_IDS();
    const int gt = b0 * NTHR + tid_, GT = nb * NTHR;
    float* out = F.out; const float* ckp = inp(I_CK); const float* cvp = inp(I_CV);
    for (int base = gt; base < 32 * 31744; base += 8 * GT) {
        f32x4 v[8];
#pragma unroll
        for (int q = 0; q < 8; ++q) { const int i = base + q * GT; if (i < 32 * 31744) { const int wb = i / 31744, e = i - wb * 31744; const int which = wb >> 4, b = wb & 15;
            v[q] = *(const f32x4*)((which ? cvp : ckp) + ((size_t)(layer * NSB + b) * 512 + 16) * 256 + 4 * (size_t)e); } }
#pragma unroll
        for (int q = 0; q < 8; ++q) { const int i = base + q * GT; if (i < 32 * 31744) { const int wb = i / 31744, e = i - wb * 31744; const int which = wb >> 4, b = wb & 15;
            *(f32x4*)(out + (which ? O_SV : O_SK) + (size_t)(layer * NSB + b) * 512 * 256 + 4 * (size_t)e) = v[q]; } }
    }
}
__device__ __forceinline__ void copy_small(Frame& F, int layer, int b0, int nb) {
    ITEM_IDS();
    const int gt = b0 * NTHR + tid_, GT = nb * NTHR;
    float* out = F.out;
    constexpr int T_P = 2 * 512 * 32, T_S = 2 * 16 * 16 * 32, T_D = 17 * 15 * 32, T_ALL = T_P + T_S + T_D;
    for (int base = gt; base < T_ALL; base += 4 * GT) {
        v4u w[4];
#pragma unroll
        for (int q = 0; q < 4; ++q) { int t = base + q * GT; if (t < T_ALL) { size_t src;
            if (t < T_P) { const int which = t >> 14, j = (t >> 5) & 511, cg = t & 31; src = (size_t)(MP - 512 + j) * NPROJ + (which ? PC_V : PC_K) + 8 * cg; }
            else if (t < T_P + T_S) { t -= T_P; const int which = t >> 13, b = (t >> 9) & 15, j = (t >> 5) & 15, cg = t & 31; src = (size_t)(MP + 16 * b + j) * NPROJ + (which ? PC_V : PC_K) + 8 * cg; }
            else { t -= T_P + T_S; const int b = t / 480, rr = (t / 32) % 15, cg = t & 31; src = (size_t)(b == 0 ? MP - 15 + rr : MP + 16 * (b - 1) + 1 + rr) * NPROJ + PC_DX + 8 * cg; }
            w[q] = *(const v4u*)(F_PROJ + src); } }
#pragma unroll
        for (int q = 0; q < 4; ++q) { int t = base + q * GT; if (t < T_ALL) { size_t dst;
            if (t < T_P) { const int which = t >> 14, j = (t >> 5) & 511, cg = t & 31; dst = (which ? O_PV : O_PK) + (size_t)layer * 512 * 256 + j * 256 + 8 * cg; }
            else if (t < T_P + T_S) { t -= T_P; const int which = t >> 13, b = (t >> 9) & 15, j = (t >> 5) & 15, cg = t & 31; dst = (which ? O_SV : O_SK) + ((size_t)(layer * NSB + b) * 512 + 496 + j) * 256 + 8 * cg; }
            else { t -= T_P + T_S; const int b = t / 480, rr = (t / 32) % 15, cg = t & 31; dst = (b == 0 ? O_PPOOL + (size_t)layer * 3840 : O_SPOOL + (size_t)(layer * NSB + b - 1) * 3840) + rr * 256 + 8 * cg; }
            float v[8]; unpack8(w[q], v); *(f32x4*)(out + dst) = (f32x4){v[0], v[1], v[2], v[3]}; *(f32x4*)(out + dst + 4) = (f32x4){v[4], v[5], v[6], v[7]}; } }
    }
}
constexpr int KS_LD = 72, PS_LD = 584;
constexpr int AT_KS = 0, AT_VT = 576 * KS_LD * 2, AT_ST = AT_VT + 64 * PS_LD * 2, AT_BIAS = AT_ST + 1024;
static_assert(AT_BIAS + 4 * 260 * 4 <= MISC_OFF, "attention LDS map");
__device__ __forceinline__ void attn_bias_load(Frame& F, int layer) { const float* arel = inp(I_AREL) + (size_t)layer * 257 * 4; lf32* b = (lf32*)(F.lds + AT_BIAS); ITEM_IDS(); for (int i = tid_; i < 257 * 4; i += NTHR) b[260 * (i & 3) + (i >> 2)] = arel[i]; }
__device__ __forceinline__ void attn_item(Frame& F, int layer, int ci, int h) {
    ITEM_IDS();
    const Chunk c = chunk_of(ci);
    LAS bf16* Ks = (LAS bf16*)(F.lds + AT_KS); LAS bf16* Ps = Ks; LAS bf16* Vt = (LAS bf16*)(F.lds + AT_VT);
    lf32* mx = (lf32*)(F.lds + AT_ST); lf32* sm = mx + 128; lf32* bias = (lf32*)(F.lds + AT_BIAS) + 260 * h;
    const int jlo = (c.b < 0) ? (ci < 8 ? 64 * (8 - ci) : 0) : 0;
    const int jval = (c.b < 0) ? 576 : 528;
    const float* ckp = inp(I_CK); const float* cvp = inp(I_CV);
    bf16x8 qa0 = {0, 0, 0, 0, 0, 0, 0, 0}, qa1 = qa0;
    if (c.b < 0 || (wave_ >> 1) == 0) { const bf16* qp = F_PROJ + (size_t)(c.row0 + (wave_ >> 1) * 16 + (lane_ & 15)) * NPROJ + PC_Q + 64 * h + 8 * (lane_ >> 4); qa0 = *(const bf16x8*)qp; qa1 = *(const bf16x8*)(qp + 32); }
    if (c.b < 0) {
        const bf16* kg = F_PROJ + (long)(c.row0 - 512) * NPROJ + PC_K + 64 * h;
        const bf16* vg = F_VTA + (long)(64 * h) * M + (long)(c.row0 - 512);
        const int npc = (576 - jlo) >> 3, nk = (576 - jlo) * 8, nv = 64 * npc;
        v4u kr[9], vr[9];
#pragma unroll
        for (int q = 0; q < 9; ++q) { const int it = tid_ + q * NTHR;
            if (it < nk) kr[q] = *(const v4u*)(kg + (long)(jlo + (it >> 3)) * NPROJ + 8 * (it & 7));
            if (it < nv) { const int d = it / npc, pc = it - d * npc; vr[q] = *(const v4u*)(vg + (long)d * M + jlo + 8 * pc); } }
#pragma unroll
        for (int q = 0; q < 9; ++q) { const int it = tid_ + q * NTHR;
            if (it < nk) *(LAS v4u*)(Ks + (jlo + (it >> 3)) * KS_LD + 8 * (it & 7)) = kr[q];
            if (it < nv) { const int d = it / npc, pc = it - d * npc; *(LAS v4u*)(Vt + d * PS_LD + jlo + 8 * pc) = vr[q]; } }
    } else {
    for (int it = tid_; it < (576 - jlo) * 8; it += NTHR) {
        const int j = jlo + (it >> 3), dg = it & 7;
        v4u kw, vw;
        if (j < 512) { const size_t o = (((size_t)(layer * NSB + c.b) * 512 + j) * 4 + h) * 64 + 8 * dg; const float* kp = ckp + o; const float* vp = cvp + o;
            const f32x4 k0 = *(const f32x4*)kp, k1 = *(const f32x4*)(kp + 4), v0 = *(const f32x4*)vp, v1 = *(const f32x4*)(vp + 4);
            kw.x = pk2(k0.x, k0.y); kw.y = pk2(k0.z, k0.w); kw.z = pk2(k1.x, k1.y); kw.w = pk2(k1.z, k1.w); vw.x = pk2(v0.x, v0.y); vw.y = pk2(v0.z, v0.w); vw.z = pk2(v1.x, v1.y); vw.w = pk2(v1.z, v1.w); }
        else if (j < 528) { const size_t row = (size_t)(c.row0 + j - 512); kw = *(const v4u*)(F_PROJ + row * NPROJ + PC_K + 64 * h + 8 * dg); vw = *(const v4u*)(F_PROJ + row * NPROJ + PC_V + 64 * h + 8 * dg); }
        else { kw = (v4u){0u, 0u, 0u, 0u}; vw = kw; }
        *(LAS v4u*)(Ks + j * KS_LD + 8 * dg) = kw;
        LAS bf16* vt = Vt + (8 * dg) * PS_LD + j;
        vt[0 * PS_LD] = (bf16)(vw.x & 0xffffu); vt[1 * PS_LD] = (bf16)(vw.x >> 16); vt[2 * PS_LD] = (bf16)(vw.y & 0xffffu); vt[3 * PS_LD] = (bf16)(vw.y >> 16);
        vt[4 * PS_LD] = (bf16)(vw.z & 0xffffu); vt[5 * PS_LD] = (bf16)(vw.z >> 16); vt[6 * PS_LD] = (bf16)(vw.w & 0xffffu); vt[7 * PS_LD] = (bf16)(vw.w >> 16);
    }
    }
    __syncthreads();
    const int qb = wave_ >> 1, kh = wave_ & 1, kq = lane_ >> 4, fr = lane_ & 15;
    const bool active = (c.b < 0) || (qb == 0);
    const int ntw = (576 - jlo) / 32;
    const int kbase = jlo + kh * ntw * 16;
    f32x4 s[18];
    float mloc = -3.0e38f;
    const int iq = qb * 16 + fr;
    if (active) {
#pragma unroll
        for (int t = 0; t < 18; ++t) {
            s[t] = (f32x4){0.f, 0.f, 0.f, 0.f};
            if (t < ntw) {
                const LAS bf16* kp = Ks + (kbase + t * 16 + fr) * KS_LD + 8 * kq;
                const bf16x8 kb0 = *(const LAS bf16x8*)kp, kb1 = *(const LAS bf16x8*)(kp + 32);
                s[t] = __builtin_amdgcn_mfma_f32_16x16x32_bf16(kb0, qa0, s[t], 0, 0, 0);
                s[t] = __builtin_amdgcn_mfma_f32_16x16x32_bf16(kb1, qa1, s[t], 0, 0, 0);
#pragma unroll
                for (int r = 0; r < 4; ++r) { const int j = kbase + t * 16 + 4 * kq + r; int rel = 512 + iq - j; rel = rel > 128 ? 128 : rel; float v = s[t][r] + bias[rel + 128]; if (j >= jval) v = -1.0e30f; s[t][r] = v; mloc = fmaxf(mloc, v); }
            }
        }
        mloc = fmaxf(mloc, shx(lane_, mloc, 16)); mloc = fmaxf(mloc, shx(lane_, mloc, 32));
        if (kq == 0) mx[iq * 2 + kh] = mloc;
    }
    __syncthreads();
    if (active) {
        mloc = fmaxf(mx[iq * 2], mx[iq * 2 + 1]);
        float lsum = 0.f;
#pragma unroll
        for (int t = 0; t < 18; ++t) if (t < ntw) {
            const float p0 = __expf(s[t][0] - mloc), p1 = __expf(s[t][1] - mloc), p2 = __expf(s[t][2] - mloc), p3 = __expf(s[t][3] - mloc);
            lsum += (p0 + p1) + (p2 + p3);
            *(LAS f32x2*)(Ps + iq * PS_LD + kbase + t * 16 + 4 * kq) = __builtin_bit_cast(f32x2, (unsigned long long)pk2(p0, p1) | ((unsigned long long)pk2(p2, p3) << 32));
        }
        lsum += shx(lane_, lsum, 16); lsum += shx(lane_, lsum, 32);
        if (kq == 0) sm[iq * 2 + kh] = lsum;
    }
    __syncthreads();
    if (active) {
        f32x4 o[2] = {(f32x4){0.f, 0.f, 0.f, 0.f}, (f32x4){0.f, 0.f, 0.f, 0.f}};
        const int nks = (576 - jlo) / 32;
#pragma unroll 2
        for (int ks = 0; ks < nks; ++ks) {
            const int j0 = jlo + 32 * ks + 8 * kq;
            const bf16x8 pa = *(const LAS bf16x8*)(Ps + iq * PS_LD + j0);
#pragma unroll
            for (int t = 0; t < 2; ++t) { const bf16x8 vb = *(const LAS bf16x8*)(Vt + (kh * 32 + t * 16 + fr) * PS_LD + j0); o[t] = __builtin_amdgcn_mfma_f32_16x16x32_bf16(vb, pa, o[t], 0, 0, 0); }
        }
        const float inv = rcp_f(sm[iq * 2] + sm[iq * 2 + 1]);
#pragma unroll
        for (int t = 0; t < 2; ++t) *(f32x2*)(F_XN + (size_t)(c.row0 + iq) * D + 64 * h + kh * 32 + t * 16 + 4 * kq) =
            __builtin_bit_cast(f32x2, (unsigned long long)pk2(o[t][0] * inv, o[t][1] * inv) | ((unsigned long long)pk2(o[t][2] * inv, o[t][3] * inv) << 32));
    }
    __syncthreads();
}
__device__ __forceinline__ void scan_phase(Frame& F, int layer) {
    ITEM_IDS();
    lf32* db = (lf32*)F.lds; lf32* dcl = db + NCHP * 4;
    for (int i = tid_; i < NCHP * 4; i += NTHR) db[i] = F_DECB[i];
    if (((int)blockIdx.x) >= 32 && ((int)blockIdx.x) < 48) { const int hh = (((int)blockIdx.x) - 32) >> 2; const float* dg = F_DECC + hh * 64;
        for (int i = tid_; i < NCHP * 16; i += NTHR) *(LAS f32x4*)(dcl + (i >> 4) * 64 + 4 * (i & 15)) = *(const f32x4*)(dg + (size_t)(i >> 4) * 256 + 4 * (i & 15)); }
    __syncthreads();
    constexpr int NSCAN = 48;
    if (((int)blockIdx.x) < NSCAN) {
        const int u = ((int)blockIdx.x) * NTHR + tid_;
        if (u < 16384) {
            unsigned* st = (unsigned*)F_STB + u; const int hb = u >> 12;
            float r0 = 0.f, r1 = 0.f;
            for (int c0 = 0; c0 < NCHP; c0 += 64) {
                unsigned sl[64];
#pragma unroll
                for (int i = 0; i < 64; ++i) sl[i] = st[(size_t)(c0 + i) * 16384];
#pragma unroll
                for (int i = 0; i < 64; ++i) { const float d0 = db[(c0 + i) * 4 + hb]; st[(size_t)(c0 + i) * 16384] = pk2(r0, r1); r0 = d0 * r0 + bf_lo(sl[i]); r1 = d0 * r1 + bf_hi(sl[i]); }
            }
            *(f32x2*)(F.out + O_PSSM + (size_t)layer * 32768 + 2 * u) = (f32x2){r0, r1};
        } else {
            const int u2 = u - 16384;
            unsigned* st = (unsigned*)F_STC + u2; const int hk = (u2 >> 11) * 64 + 2 * (u2 & 31);
            float r0 = 0.f, r1 = 0.f;
            for (int c0 = 0; c0 < NCHP; c0 += 64) {
                unsigned sl[64];
#pragma unroll
                for (int i = 0; i < 64; ++i) sl[i] = st[(size_t)(c0 + i) * 8192];
#pragma unroll
                for (int i = 0; i < 64; ++i) { const f32x2 dd = *(const LAS f32x2*)(dcl + (c0 + i) * 64 + 2 * (u2 & 31)); st[(size_t)(c0 + i) * 8192] = pk2(r0, r1); r0 = dd.x * r0 + bf_lo(sl[i]); r1 = dd.y * r1 + bf_hi(sl[i]); }
            }
            const int v = (u2 >> 5) & 63; float* o = F.out + O_PHGRN + (size_t)layer * 16384 + (size_t)hk * 64 + v; o[0] = r0; o[64] = r1;
        }
    }
    else {
        const int nb = ((int)gridDim.x) - NSCAN, b0 = ((int)blockIdx.x) - NSCAN;
        copy_small(F, layer, b0, nb);
        const float* sssm = inp(I_SSSM) + (size_t)layer * NSB * 32768; const float* shgrn = inp(I_SHGRN) + (size_t)layer * NSB * 16384;
        float* osb = F.out + O_SSSM + (size_t)layer * NSB * 32768; float* osc = F.out + O_SHGRN + (size_t)layer * NSB * 16384;
        for (int t = b0 * NTHR + tid_; t < NSB * 8192; t += nb * NTHR) {
            const int b = t >> 13, e = (t & 8191) * 4; const f32x4 s0 = *(const f32x4*)(sssm + (size_t)b * 32768 + e); const unsigned long long w = *(const unsigned long long*)(F_STB + (size_t)(NCHP + b) * 32768 + e);
            const float d = F_DECB[(NCHP + b) * 4 + (e >> 13)];
            *(f32x4*)(osb + (size_t)b * 32768 + e) = (f32x4){d * s0.x + bf_lo((unsigned)w), d * s0.y + bf_hi((unsigned)w), d * s0.z + bf_lo((unsigned)(w >> 32)), d * s0.w + bf_hi((unsigned)(w >> 32))}; }
        for (int t = b0 * NTHR + tid_; t < NSB * 4096; t += nb * NTHR) {
            const int b = t >> 12, e2 = (t & 4095) * 4, hk = e2 >> 6, v = e2 & 63; const f32x4 s0 = *(const f32x4*)(shgrn + (size_t)b * 16384 + e2);
            const bf16* sp = F_STC + (size_t)(NCHP + b) * 16384 + (size_t)((hk >> 6) * 64 + v) * 64 + (hk & 63); const float d = F_DECC[(size_t)(NCHP + b) * 256 + hk];
            *(f32x4*)(osc + (size_t)b * 16384 + e2) = (f32x4){d * s0.x + bf1(sp[0]), d * s0.y + bf1(sp[64]), d * s0.z + bf1(sp[128]), d * s0.w + bf1(sp[192])}; }
    }
}
constexpr int SP_XT = 0, SP_BT = 256 * 72 * 2, SP_ACS = 2 * 256 * 72 * 2, SP_DTV = SP_ACS + 1024, SP_SJ = SP_DTV + 1024, SP_END = SP_SJ + 1024;
static_assert(SP_END <= MISC_OFF, "ssd_prep LDS map");
__device__ __forceinline__ void ssd_prep_item(Frame& F, int layer, int ci) {
    ITEM_IDS();
    const Chunk c = chunk_of(ci);
    LAS bf16* XTl = (LAS bf16*)(F.lds + SP_XT); LAS bf16* BTl = (LAS bf16*)(F.lds + SP_BT);
    lf32* acs = (lf32*)(F.lds + SP_ACS); lf32* dtv = (lf32*)(F.lds + SP_DTV); lf32* sj = (lf32*)(F.lds + SP_SJ);
    const int cg = tid_ % 96, seg = tid_ / 96, col = 8 * cg;
    const bool act = seg < 4 && 16 * seg < c.nrows;
    bf16* prow = F_PROJ + (size_t)c.row0 * NPROJ + PC_X + col;
    v4u raw[19];
    if (act) {
#pragma unroll
        for (int q = 0; q < 19; ++q) { const int r = 16 * seg - 3 + q;
            if (r >= 0) raw[q] = *(const v4u*)(prow + (size_t)r * NPROJ);
            else if (c.b < 0) { if (ci > 0) raw[q] = *(const v4u*)(F_HALO + ((size_t)(ci - 1) * 3 + (3 + r)) * 768 + col); else raw[q] = (v4u){0u, 0u, 0u, 0u}; }
            else { const float* s = inp(I_SCONV) + ((size_t)(layer * NSB + c.b) * 3 + (3 + r)) * 768 + col; const f32x4 a = *(const f32x4*)s, b2 = *(const f32x4*)(s + 4);
                raw[q].x = pk2(a.x, a.y); raw[q].y = pk2(a.z, a.w); raw[q].z = pk2(b2.x, b2.y); raw[q].w = pk2(b2.z, b2.w); } }
    }
    if (wave_ == 6) { const int r = lane_; const float* dtb = inp(I_DTB) + layer * 4; const float* alg = inp(I_ALOG) + layer * 4;
        f32x4 raw4 = {0.f, 0.f, 0.f, 0.f}; if (r < c.nrows) raw4 = *(const f32x4*)(F_DT + (size_t)(c.row0 + r) * 4);
        f32x4 dt4, ac4;
#pragma unroll
        for (int h = 0; h < 4; ++h) { float dt = 0.f; if (r < c.nrows) dt = softplus_f(raw4[h] + dtb[h]); float v = -__expf(alg[h]) * dt;
#pragma unroll
            for (int o = 1; o < 64; o <<= 1) { const float t = shu(lane_, v, o); if (lane_ >= o) v += t; }
            const float last = shi(v, 63);
            dt4[h] = dt; ac4[h] = v; acs[r * 4 + h] = v; dtv[r * 4 + h] = dt; sj[h * 64 + r] = dt * __expf(last - v);
            if (r == 63) F_DECB[ci * 4 + h] = __expf(last); }
        if (r < c.nrows) { *(f32x4*)(F_DTV + (size_t)(c.row0 + r) * 4) = dt4; *(f32x4*)(F_ACS + (size_t)(c.row0 + r) * 4) = ac4; } }
    if (c.nrows < 64) { for (int i = tid_; i < 2 * 256 * 72 / 2; i += NTHR) ((LAS unsigned*)XTl)[i] = 0u; }
    asm volatile("s_waitcnt vmcnt(0)" ::: "memory");
    __syncthreads();
    if (act) {
        if (ci == NCHP - 1 && seg == 3) {
#pragma unroll
            for (int q = 0; q < 3; ++q) { float v[8]; unpack8(raw[16 + q], v); float* o = F.out + O_PCONV + (size_t)layer * 2304 + q * 768 + col;
                *(f32x4*)o = (f32x4){v[0], v[1], v[2], v[3]}; *(f32x4*)(o + 4) = (f32x4){v[4], v[5], v[6], v[7]}; } }
        if (c.b >= 0) {
#pragma unroll
            for (int q = 0; q < 3; ++q) { float v[8]; unpack8(raw[16 + q], v); float* o = F.out + O_SCONV + ((size_t)(layer * NSB + c.b) * 3 + q) * 768 + col;
                *(f32x4*)o = (f32x4){v[0], v[1], v[2], v[3]}; *(f32x4*)(o + 4) = (f32x4){v[4], v[5], v[6], v[7]}; } }
        const float* cw = inp(I_CW) + (size_t)layer * 4 * 768 + col; const float* cb = inp(I_CB) + (size_t)layer * 768 + col;
        LAS bf16* tl = (cg < 32) ? XTl + col * 72 : BTl + (col - 256) * 72;
#pragma unroll
        for (int hc = 0; hc < 2; ++hc) {
            float w0[4], w1[4], w2[4], w3[4], bb[4];
#pragma unroll
            for (int e = 0; e < 4; ++e) { bb[e] = cb[4 * hc + e]; w0[e] = cw[4 * hc + e]; w1[e] = cw[768 + 4 * hc + e]; w2[e] = cw[2 * 768 + 4 * hc + e]; w3[e] = cw[3 * 768 + 4 * hc + e]; }
#pragma unroll
            for (int i = 0; i < 16; i += 2) {
                float x[5][4];
#pragma unroll
                for (int q = 0; q < 5; ++q) { const unsigned ua = hc ? raw[i + q].z : raw[i + q].x, ub = hc ? raw[i + q].w : raw[i + q].y; x[q][0] = bf_lo(ua); x[q][1] = bf_hi(ua); x[q][2] = bf_lo(ub); x[q][3] = bf_hi(ub); }
                float ya[4], yb[4];
#pragma unroll
                for (int e = 0; e < 4; ++e) { ya[e] = silu_g(bb[e] + w0[e] * x[0][e] + w1[e] * x[1][e] + w2[e] * x[2][e] + w3[e] * x[3][e]); yb[e] = silu_g(bb[e] + w0[e] * x[1][e] + w1[e] * x[2][e] + w2[e] * x[3][e] + w3[e] * x[4][e]); }
                const int r = 16 * seg + i;
                *(unsigned long long*)(prow + (size_t)r * NPROJ + 4 * hc) = (unsigned long long)pk2(ya[0], ya[1]) | ((unsigned long long)pk2(ya[2], ya[3]) << 32);
                *(unsigned long long*)(prow + (size_t)(r + 1) * NPROJ + 4 * hc) = (unsigned long long)pk2(yb[0], yb[1]) | ((unsigned long long)pk2(yb[2], yb[3]) << 32);
                if (cg < 64) {
#pragma unroll
                    for (int e = 0; e < 4; ++e) *(LAS unsigned*)(tl + (4 * hc + e) * 72 + r) = pk2(ya[e], yb[e]); }
            }
        }
    }
    __syncthreads();
    { const int ch = tid_ >> 1, hf = tid_ & 1; bf16* dst = F_XT + ((size_t)ci * 256 + ch) * 64 + 32 * hf; const LAS bf16* src = XTl + ch * 72 + 32 * hf;
#pragma unroll
      for (int q = 0; q < 4; ++q) *(v4u*)(dst + 8 * q) = *(const LAS v4u*)(src + 8 * q); }
    const int kq = lane_ >> 4, fr = lane_ & 15, h = wave_ >> 1, g = h >> 1;
#pragma unroll
    for (int pi = 0; pi < 2; ++pi) {
        const int pb = 2 * (wave_ & 1) + pi;
        bf16x8 af[2];
#pragma unroll
        for (int ks = 0; ks < 2; ++ks) { float v[8]; unpack8(*(const LAS v4u*)(XTl + (h * 64 + pb * 16 + fr) * 72 + 32 * ks + 8 * kq), v);
#pragma unroll
            for (int e = 0; e < 8; ++e) v[e] *= sj[h * 64 + 32 * ks + 8 * kq + e];
            af[ks] = __builtin_bit_cast(bf16x8, pack8(v)); }
        bf16* dst = F_STB + ((size_t)(ci * 4 + h) * 64 + pb * 16 + 4 * kq) * 128 + fr;
#pragma unroll
        for (int nt = 0; nt < 8; ++nt) {
            f32x4 acc = {0.f, 0.f, 0.f, 0.f};
#pragma unroll
            for (int ks = 0; ks < 2; ++ks) { const bf16x8 bfr = *(const LAS bf16x8*)(BTl + (g * 128 + nt * 16 + fr) * 72 + 32 * ks + 8 * kq); acc = __builtin_amdgcn_mfma_f32_16x16x32_bf16(af[ks], bfr, acc, 0, 0, 0); }
#pragma unroll
            for (int r = 0; r < 4; ++r) dst[r * 128 + nt * 16] = (bf16)f2bf(acc[r]);
        }
    }
    __syncthreads();
}

__device__ __forceinline__ void ssd_out_witem(Frame& F, int layer, int ci, int ib, int wave_, int lane_) {
    const Chunk c = chunk_of(ci);
    const int kq = lane_ >> 4, fr = lane_ & 15;
    constexpr int WSTRIDE = 2560 + 16384; static_assert(8 * WSTRIDE <= MISC_OFF, "per-wave LDS");
    LAS bf16* scr = (LAS bf16*)(F.lds + wave_ * WSTRIDE);
    lf32* ysc = (lf32*)(F.lds + wave_ * WSTRIDE + 2560) + lane_;
    const bf16* P = F_PROJ + (size_t)c.row0 * NPROJ;
    const float* acsg = F_ACS + (size_t)c.row0 * 4; const float* dtg = F_DTV + (size_t)c.row0 * 4;
    const int nks = (ib + 2) >> 1;
    float sq[4] = {0.f, 0.f, 0.f, 0.f};
    const float* bdp = inp(I_BD) + layer * 4;
#pragma unroll
    for (int g = 0; g < 2; ++g) {
        bf16x8 cf[4];
#pragma unroll
        for (int ks = 0; ks < 4; ++ks) cf[ks] = *(const bf16x8*)(P + (size_t)(16 * ib + fr) * NPROJ + PC_C + 128 * g + 32 * ks + 8 * kq);
        f32x4 G[4];
#pragma unroll
        for (int jb = 0; jb < 4; ++jb) { G[jb] = (f32x4){0.f, 0.f, 0.f, 0.f};
            if (jb <= ib) {
#pragma unroll
                for (int ks = 0; ks < 4; ++ks) { const bf16x8 bfr = *(const bf16x8*)(P + (size_t)(16 * jb + fr) * NPROJ + PC_B + 128 * g + 32 * ks + 8 * kq); G[jb] = __builtin_amdgcn_mfma_f32_16x16x32_bf16(cf[ks], bfr, G[jb], 0, 0, 0); } } }
#pragma unroll
        for (int hh = 0; hh < 2; ++hh) {
            const int h = 2 * g + hh;
            float ai[4], ea[4];
#pragma unroll
            for (int r = 0; r < 4; ++r) { ai[r] = acsg[(16 * ib + 4 * kq + r) * 4 + h]; ea[r] = __expf(ai[r]); }
#pragma unroll
            for (int jb = 0; jb < 4; ++jb) { const int j = 16 * jb + fr; float aj = 0.f, dj = 0.f; if (jb <= ib) { aj = acsg[j * 4 + h]; dj = dtg[j * 4 + h]; }
#pragma unroll
                for (int r = 0; r < 4; ++r) { const int i = 16 * ib + 4 * kq + r; const float v = (jb <= ib && j <= i) ? G[jb][r] * __expf(ai[r] - aj) * dj : 0.f; scr[(4 * kq + r) * 72 + j] = (bf16)f2bf(v); } }
            asm volatile("s_waitcnt lgkmcnt(0)" ::: "memory");
            bf16x8 gm[2];
#pragma unroll
            for (int ks = 0; ks < 2; ++ks) gm[ks] = *(const LAS bf16x8*)(scr + fr * 72 + 32 * ks + 8 * kq);
            asm volatile("s_waitcnt lgkmcnt(0)" ::: "memory");
            const bf16* xt = F_XT + ((size_t)ci * 256 + h * 64) * 64;
            const bf16* sin_b = F_STB + (size_t)(ci * 4 + h) * 8192; const float* sin_f = inp(I_SSSM) + (size_t)((layer * NSB + (c.b < 0 ? 0 : c.b)) * 4 + h) * 8192;
#pragma unroll 2
            for (int pt = 0; pt < 4; ++pt) {
                f32x4 a1 = {0.f, 0.f, 0.f, 0.f}, a2 = {0.f, 0.f, 0.f, 0.f};
#pragma unroll
                for (int ks = 0; ks < 2; ++ks) if (ks < nks) { const bf16x8 bfr = *(const bf16x8*)(xt + (size_t)(pt * 16 + fr) * 64 + 32 * ks + 8 * kq); a1 = __builtin_amdgcn_mfma_f32_16x16x32_bf16(gm[ks], bfr, a1, 0, 0, 0); }
#pragma unroll
                for (int ks = 0; ks < 4; ++ks) { bf16x8 bfr;
                    if (c.b < 0) bfr = *(const bf16x8*)(sin_b + (size_t)(pt * 16 + fr) * 128 + 32 * ks + 8 * kq);
                    else { const float* s = sin_f + (size_t)(pt * 16 + fr) * 128 + 32 * ks + 8 * kq; const f32x4 u0 = *(const f32x4*)s, u1 = *(const f32x4*)(s + 4); v4u w; w.x = pk2(u0.x, u0.y); w.y = pk2(u0.z, u0.w); w.z = pk2(u1.x, u1.y); w.w = pk2(u1.z, u1.w); bfr = __builtin_bit_cast(bf16x8, w); }
                    a2 = __builtin_amdgcn_mfma_f32_16x16x32_bf16(cf[ks], bfr, a2, 0, 0, 0); }
                const float dh = bdp[h];
#pragma unroll
                for (int r = 0; r < 4; ++r) { const size_t ro = (size_t)(16 * ib + 4 * kq + r) * NPROJ; const int p = h * 64 + pt * 16 + fr;
                    float y = a1[r] + ea[r] * a2[r] + dh * bf1(P[ro + PC_X + p]);
                    y *= silu_g(bf1(P[ro + PC_Z + p])); ysc[((h * 4 + pt) * 4 + r) * 64] = y; sq[r] += y * y; }
            }
        }
    }
    const float* nw = inp(I_BNRM) + (size_t)layer * 256;
#pragma unroll
    for (int r = 0; r < 4; ++r) { const float rstd = rsq_f(sum16_l(lane_, sq[r]) * (1.0f / 256.0f) + EPS); bf16* o = F_XN + (size_t)(c.row0 + 16 * ib + 4 * kq + r) * D + 256 + fr;
#pragma unroll 4
        for (int q = 0; q < 16; ++q) o[q * 16] = (bf16)f2bf(ysc[(q * 4 + r) * 64] * rstd * nw[q * 16 + fr]); }
}

constexpr int SO_SIN = 0, SO_XT = 4 * 64 * 136 * 2, SO_ACS = SO_XT + 256 * 72 * 2, SO_DTV = SO_ACS + 1024, SO_SS = SO_DTV + 1024, SO_SCR = SO_SS + 512, SO_END = SO_SCR + 8 * 2560;
static_assert(SO_END <= MISC_OFF, "ssd_out_block LDS map");
__device__ __forceinline__ void ssd_out_block(Frame& F, int layer, int ci) {
    ITEM_IDS();
    const int row0 = 64 * ci;
    LAS bf16* SIN = (LAS bf16*)(F.lds + SO_SIN); LAS bf16* XTl = (LAS bf16*)(F.lds + SO_XT);
    lf32* acs = (lf32*)(F.lds + SO_ACS); lf32* dtv = (lf32*)(F.lds + SO_DTV); lf32* ss = (lf32*)(F.lds + SO_SS);
    LAS bf16* scr = (LAS bf16*)(F.lds + SO_SCR + wave_ * 2560);
    const int kq = lane_ >> 4, fr = lane_ & 15, ib = wave_ >> 1, g = wave_ & 1;
    const bf16* P = F_PROJ + (size_t)row0 * NPROJ;
    v4u st[12];
    { const bf16* sg = F_STB + (size_t)ci * 32768; const bf16* xg = F_XT + (size_t)ci * 16384;
#pragma unroll
      for (int q = 0; q < 8; ++q) st[q] = *(const v4u*)(sg + (size_t)(tid_ + q * NTHR) * 8);
#pragma unroll
      for (int q = 0; q < 4; ++q) st[8 + q] = *(const v4u*)(xg + (size_t)(tid_ + q * NTHR) * 8); }
    float a4 = 0.f, d4 = 0.f; if (tid_ < 256) { a4 = F_ACS[(size_t)row0 * 4 + tid_]; d4 = F_DTV[(size_t)row0 * 4 + tid_]; }
    bf16x8 cf[4], bfr[4][4];
#pragma unroll
    for (int ks = 0; ks < 4; ++ks) cf[ks] = *(const bf16x8*)(P + (size_t)(16 * ib + fr) * NPROJ + PC_C + 128 * g + 32 * ks + 8 * kq);
#pragma unroll
    for (int jb = 0; jb < 4; ++jb)
#pragma unroll
        for (int ks = 0; ks < 4; ++ks) { bfr[jb][ks] = (bf16x8){0, 0, 0, 0, 0, 0, 0, 0}; if (jb <= ib) bfr[jb][ks] = *(const bf16x8*)(P + (size_t)(16 * jb + fr) * NPROJ + PC_B + 128 * g + 32 * ks + 8 * kq); }
#pragma unroll
    for (int q = 0; q < 8; ++q) { const int it = tid_ + q * NTHR; *(LAS v4u*)(SIN + (it >> 4) * 136 + 8 * (it & 15)) = st[q]; }
#pragma unroll
    for (int q = 0; q < 4; ++q) { const int it = tid_ + q * NTHR; *(LAS v4u*)(XTl + (it >> 3) * 72 + 8 * (it & 7)) = st[8 + q]; }
    if (tid_ < 256) { acs[tid_] = a4; dtv[tid_] = d4; }
    bf16 zv[2][4][4];
#pragma unroll
    for (int hh = 0; hh < 2; ++hh)
#pragma unroll
        for (int pt = 0; pt < 4; ++pt)
#pragma unroll
            for (int r = 0; r < 4; ++r) zv[hh][pt][r] = P[(size_t)(16 * ib + 4 * kq + r) * NPROJ + PC_Z + (2 * g + hh) * 64 + pt * 16 + fr];
    __syncthreads();
    f32x4 G[4];
#pragma unroll
    for (int jb = 0; jb < 4; ++jb) { G[jb] = (f32x4){0.f, 0.f, 0.f, 0.f};
        if (jb <= ib) {
#pragma unroll
            for (int ks = 0; ks < 4; ++ks) G[jb] = __builtin_amdgcn_mfma_f32_16x16x32_bf16(cf[ks], bfr[jb][ks], G[jb], 0, 0, 0); } }
    const int nks = (ib + 2) >> 1;
    const float* bdp = inp(I_BD) + layer * 4;
    f32x4 yv[2][4]; float sq[4] = {0.f, 0.f, 0.f, 0.f};
#pragma unroll
    for (int hh = 0; hh < 2; ++hh) {
        const int h = 2 * g + hh;
        float ai[4], ea[4];
#pragma unroll
        for (int r = 0; r < 4; ++r) { ai[r] = acs[(16 * ib + 4 * kq + r) * 4 + h]; ea[r] = __expf(ai[r]); }
#pragma unroll
        for (int jb = 0; jb < 4; ++jb) { const int j = 16 * jb + fr; const float aj = acs[j * 4 + h], dj = dtv[j * 4 + h];
#pragma unroll
            for (int r = 0; r < 4; ++r) { const int i = 16 * ib + 4 * kq + r; const float v = (jb <= ib && j <= i) ? G[jb][r] * __expf(ai[r] - aj) * dj : 0.f; scr[(4 * kq + r) * 72 + j] = (bf16)f2bf(v); } }
        asm volatile("s_waitcnt lgkmcnt(0)" ::: "memory");
        bf16x8 gm[2];
#pragma unroll
        for (int ks = 0; ks < 2; ++ks) gm[ks] = *(const LAS bf16x8*)(scr + fr * 72 + 32 * ks + 8 * kq);
        asm volatile("s_waitcnt lgkmcnt(0)" ::: "memory");
        const float dh = bdp[h];
#pragma unroll
        for (int pt = 0; pt < 4; ++pt) {
            f32x4 a1 = {0.f, 0.f, 0.f, 0.f}, a2 = {0.f, 0.f, 0.f, 0.f};
            const LAS bf16* xr = XTl + (h * 64 + pt * 16 + fr) * 72; const LAS bf16* sr = SIN + (h * 64 + pt * 16 + fr) * 136;
#pragma unroll
            for (int ks = 0; ks < 2; ++ks) if (ks < nks) a1 = __builtin_amdgcn_mfma_f32_16x16x32_bf16(gm[ks], *(const LAS bf16x8*)(xr + 32 * ks + 8 * kq), a1, 0, 0, 0);
#pragma unroll
            for (int ks = 0; ks < 4; ++ks) a2 = __builtin_amdgcn_mfma_f32_16x16x32_bf16(cf[ks], *(const LAS bf16x8*)(sr + 32 * ks + 8 * kq), a2, 0, 0, 0);
            const unsigned long long xw = *(const LAS unsigned long long*)(xr + 16 * ib + 4 * kq);
            const float xx[4] = {bf_lo((unsigned)xw), bf_hi((unsigned)xw), bf_lo((unsigned)(xw >> 32)), bf_hi((unsigned)(xw >> 32))};
#pragma unroll
            for (int r = 0; r < 4; ++r) { float y = a1[r] + ea[r] * a2[r] + dh * xx[r]; y *= silu_g(bf1(zv[hh][pt][r])); yv[hh][pt][r] = y; sq[r] += y * y; }
        }
    }
#pragma unroll
    for (int r = 0; r < 4; ++r) { const float q = sum16_l(lane_, sq[r]); if (fr == 0) ss[(16 * ib + 4 * kq + r) * 2 + g] = q; }
    __syncthreads();
    const float* nw = inp(I_BNRM) + (size_t)layer * 256 + 128 * g;
#pragma unroll
    for (int r = 0; r < 4; ++r) { const int i = 16 * ib + 4 * kq + r; const float rstd = rsq_f((ss[i * 2] + ss[i * 2 + 1]) * (1.0f / 256.0f) + EPS); bf16* o = F_XN + (size_t)(row0 + i) * D + 256 + 128 * g + fr;
#pragma unroll
        for (int hh = 0; hh < 2; ++hh)
#pragma unroll
            for (int pt = 0; pt < 4; ++pt) o[hh * 64 + pt * 16] = (bf16)f2bf(yv[hh][pt][r] * rstd * nw[hh * 64 + pt * 16 + fr]); }
    __syncthreads();
}
constexpr int HP_KT = 0, HP_VT = 256 * 72 * 2, HP_HT = 2 * 256 * 72 * 2, HP_END = HP_HT + 4 * 256 * 4;
static_assert(HP_END <= MISC_OFF, "hgrn_prep LDS map");
__device__ __forceinline__ void hgrn_prep_item(Frame& F, int layer, int ci) {
    ITEM_IDS();
    const Chunk c = chunk_of(ci);
    LAS bf16* KTl = (LAS bf16*)(F.lds + HP_KT); LAS bf16* VTl = (LAS bf16*)(F.lds + HP_VT);
    lf32* ht = (lf32*)(F.lds + HP_HT);
    const int cp = tid_ & 127, qt = tid_ >> 7;
    float lb0 = 0.f, lb1 = 0.f; if (layer != 0) { const float* lbp = inp(I_LB) + 2 * cp; lb0 = rcp_f(1.0f + __expf(lbp[0] - lbp[256])); lb1 = rcp_f(1.0f + __expf(lbp[1] - lbp[257])); }
    bf16* pq = F_PROJ + (size_t)(c.row0 + 16 * qt) * NPROJ + PC_CQ + 2 * cp;
    const bool act = 16 * qt < c.nrows;
    unsigned rq[16], rf[16], rv[16];
#pragma unroll
    for (int i = 0; i < 16; ++i) { rq[i] = 0u; rf[i] = 0u; rv[i] = 0u; if (act) { const unsigned* p = (const unsigned*)(pq + (size_t)i * NPROJ); rq[i] = p[0]; rf[i] = p[128]; rv[i] = p[256]; } }
    float b0[16], b1[16], k0[16], k1[16];
    float run0 = 0.f, run1 = 0.f;
#pragma unroll
    for (int i = 0; i < 16; ++i) { float g0 = 0.f, g1 = 0.f; k0[i] = 0.f; k1[i] = 0.f;
        if (act) { const float e0 = __expf(-bf_lo(rf[i])), e1 = __expf(-bf_hi(rf[i])); const float d0 = rcp_f(1.0f + e0), d1 = rcp_f(1.0f + e1);
            g0 = __logf(lb0 + (1.0f - lb0) * d0); g1 = __logf(lb1 + (1.0f - lb1) * d1); k0[i] = (1.0f - lb0) * e0 * d0; k1[i] = (1.0f - lb1) * e1 * d1; }
        run0 += g0; run1 += g1; b0[i] = run0; b1[i] = run1; }
    *(LAS f32x2*)(ht + qt * 256 + 2 * cp) = (f32x2){run0, run1};
    __syncthreads();
    float pre0 = 0.f, pre1 = 0.f, last0 = 0.f, last1 = 0.f;
#pragma unroll
    for (int q = 0; q < 4; ++q) { const f32x2 t = *(const LAS f32x2*)(ht + q * 256 + 2 * cp); if (q < qt) { pre0 += t.x; pre1 += t.y; } last0 += t.x; last1 += t.y; }
    { float* Rg = F_RH + (size_t)ci * 1280 + 2 * cp; *(f32x2*)(Rg + qt * 256) = (f32x2){pre0, pre1};
      if (qt == 3) { *(f32x2*)(Rg + 1024) = (f32x2){last0, last1}; *(f32x2*)(F_DECC + (size_t)ci * 256 + 2 * cp) = (f32x2){__expf(last0), __expf(last1)}; } }
    const float e0 = run0, e1 = run1;
#pragma unroll
    for (int i = 0; i < 16; i += 2) {
        unsigned kt0, kt1;
#pragma unroll
        for (int q = 0; q < 2; ++q) { const int ii = i + q;
            const float qe0 = bf_lo(rq[ii]) * __expf(b0[ii]), qe1 = bf_hi(rq[ii]) * __expf(b1[ii]);
            const float ke0 = k0[ii] * __expf(e0 - b0[ii]), ke1 = k1[ii] * __expf(e1 - b1[ii]);
            const float kd0 = k0[ii] * __expf(fminf(-b0[ii], 80.f)), kd1 = k1[ii] * __expf(fminf(-b1[ii], 80.f));
            if (act && 16 * qt + ii < c.nrows) { unsigned* p = (unsigned*)(pq + (size_t)ii * NPROJ); p[0] = pk2(qe0, qe1); p[128] = pk2(ke0, ke1); p[256] = pk2(kd0, kd1); }
            const float t0 = k0[ii] * __expf(last0 - pre0 - b0[ii]), t1 = k1[ii] * __expf(last1 - pre1 - b1[ii]);
            if (q == 0) { kt0 = f2bf(t0); kt1 = f2bf(t1); } else { kt0 |= f2bf(t0) << 16; kt1 |= f2bf(t1) << 16; } }
        const int j = 16 * qt + i;
        *(LAS unsigned*)(KTl + (2 * cp) * 72 + j) = kt0; *(LAS unsigned*)(KTl + (2 * cp + 1) * 72 + j) = kt1;
        *(LAS unsigned*)(VTl + (2 * cp) * 72 + j) = (rv[i] & 0xffffu) | (rv[i + 1] << 16); *(LAS unsigned*)(VTl + (2 * cp + 1) * 72 + j) = (rv[i] >> 16) | (rv[i + 1] & 0xffff0000u);
    }
    __syncthreads();
    { const int c2 = tid_ >> 1, hf = tid_ & 1; bf16* dst = F_VT + ((size_t)ci * 256 + c2) * 64 + 32 * hf; const LAS bf16* src = VTl + c2 * 72 + 32 * hf;
#pragma unroll
      for (int q = 0; q < 4; ++q) *(v4u*)(dst + 8 * q) = *(const LAS v4u*)(src + 8 * q); }
    const int kq = lane_ >> 4, fr = lane_ & 15, h = wave_ >> 1;
#pragma unroll
    for (int vi = 0; vi < 2; ++vi) {
        const int vb = 2 * (wave_ & 1) + vi;
        bf16x8 af[2];
#pragma unroll
        for (int ks = 0; ks < 2; ++ks) af[ks] = *(const LAS bf16x8*)(VTl + (h * 64 + vb * 16 + fr) * 72 + 32 * ks + 8 * kq);
        bf16* dst = F_STC + ((size_t)(ci * 4 + h) * 64 + vb * 16 + 4 * kq) * 64 + fr;
#pragma unroll
        for (int kb = 0; kb < 4; ++kb) {
            f32x4 acc = {0.f, 0.f, 0.f, 0.f};
#pragma unroll
            for (int ks = 0; ks < 2; ++ks) { const bf16x8 bfr = *(const LAS bf16x8*)(KTl + (h * 64 + kb * 16 + fr) * 72 + 32 * ks + 8 * kq); acc = __builtin_amdgcn_mfma_f32_16x16x32_bf16(af[ks], bfr, acc, 0, 0, 0); }
#pragma unroll
            for (int r = 0; r < 4; ++r) dst[r * 64 + kb * 16] = (bf16)f2bf(acc[r]);
        }
    }
    __syncthreads();
}

__device__ __forceinline__ void hgrn_out_witem(Frame& F, int layer, int ci, int h, int ib, int wave_, int lane_) {
    const Chunk c = chunk_of(ci);
    const int kq = lane_ >> 4, fr = lane_ & 15;
    LAS bf16* scr = (LAS bf16*)(F.lds + wave_ * (2560 + 16384));
    const bf16* P = F_PROJ + (size_t)c.row0 * NPROJ + h * 64;
    const float* Rg = F_RH + (size_t)ci * 1280 + h * 64;
    bf16x8 qf[2]; float qv[2][8], rI[2][8];
#pragma unroll
    for (int ks = 0; ks < 2; ++ks) { qf[ks] = *(const bf16x8*)(P + (size_t)(16 * ib + fr) * NPROJ + PC_CQ + 32 * ks + 8 * kq); unpack8(__builtin_bit_cast(v4u, qf[ks]), qv[ks]);
        const float* rp = Rg + ib * 256 + 32 * ks + 8 * kq; const f32x4 a = *(const f32x4*)rp, b2 = *(const f32x4*)(rp + 4);
        rI[ks][0] = a.x; rI[ks][1] = a.y; rI[ks][2] = a.z; rI[ks][3] = a.w; rI[ks][4] = b2.x; rI[ks][5] = b2.y; rI[ks][6] = b2.z; rI[ks][7] = b2.w; }
#pragma unroll
    for (int J = 0; J < 4; ++J) {
        f32x4 acc = {0.f, 0.f, 0.f, 0.f};
        if (J <= ib) {
#pragma unroll
            for (int ks = 0; ks < 2; ++ks) {
                bf16x8 a = qf[ks];
                if (J < ib) { const float* rp = Rg + (J + 1) * 256 + 32 * ks + 8 * kq; const f32x4 u0 = *(const f32x4*)rp, u1 = *(const f32x4*)(rp + 4); const float rj[8] = {u0.x, u0.y, u0.z, u0.w, u1.x, u1.y, u1.z, u1.w};
                    float v[8];
#pragma unroll
                    for (int e = 0; e < 8; ++e) v[e] = qv[ks][e] * __expf(rI[ks][e] - rj[e]);
                    a = __builtin_bit_cast(bf16x8, pack8(v)); }
                const bf16x8 bfr = *(const bf16x8*)(P + (size_t)(16 * J + fr) * NPROJ + (J < ib ? PC_CF : PC_CI) + 32 * ks + 8 * kq);
                acc = __builtin_amdgcn_mfma_f32_16x16x32_bf16(a, bfr, acc, 0, 0, 0);
            }
        }
#pragma unroll
        for (int r = 0; r < 4; ++r) { const int i = 4 * kq + r, j = fr; const float v = (J < ib || (J == ib && j <= i)) ? acc[r] : 0.f; scr[(4 * kq + r) * 72 + 16 * J + fr] = (bf16)f2bf(v); }
    }
    asm volatile("s_waitcnt lgkmcnt(0)" ::: "memory");
    bf16x8 ga[2];
#pragma unroll
    for (int ks = 0; ks < 2; ++ks) ga[ks] = *(const LAS bf16x8*)(scr + fr * 72 + 32 * ks + 8 * kq);
    asm volatile("s_waitcnt lgkmcnt(0)" ::: "memory");
    bf16x8 qs[2];
#pragma unroll
    for (int ks = 0; ks < 2; ++ks) { float v[8];
#pragma unroll
        for (int e = 0; e < 8; ++e) v[e] = qv[ks][e] * __expf(rI[ks][e]);
        qs[ks] = __builtin_bit_cast(bf16x8, pack8(v)); }
    const int nks = (ib + 2) >> 1;
    const bf16* vt = F_VT + ((size_t)ci * 256 + h * 64) * 64;
    const bf16* sin_b = F_STC + (size_t)(ci * 4 + h) * 4096; const float* sin_f = inp(I_SHGRN) + (size_t)((layer * NSB + (c.b < 0 ? 0 : c.b)) * 4 + h) * 4096;
    f32x4 o[4]; float sq[4] = {0.f, 0.f, 0.f, 0.f};
#pragma unroll
    for (int t = 0; t < 4; ++t) {
        o[t] = (f32x4){0.f, 0.f, 0.f, 0.f};
#pragma unroll
        for (int ks = 0; ks < 2; ++ks) if (ks < nks) { const bf16x8 bfr = *(const bf16x8*)(vt + (size_t)(t * 16 + fr) * 64 + 32 * ks + 8 * kq); o[t] = __builtin_amdgcn_mfma_f32_16x16x32_bf16(ga[ks], bfr, o[t], 0, 0, 0); }
#pragma unroll
        for (int ks = 0; ks < 2; ++ks) { bf16x8 bfr;
            if (c.b < 0) bfr = *(const bf16x8*)(sin_b + (size_t)(t * 16 + fr) * 64 + 32 * ks + 8 * kq);
            else { float v[8];
#pragma unroll
                for (int e = 0; e < 8; ++e) v[e] = sin_f[(size_t)(32 * ks + 8 * kq + e) * 64 + t * 16 + fr];
                bfr = __builtin_bit_cast(bf16x8, pack8(v)); }
            o[t] = __builtin_amdgcn_mfma_f32_16x16x32_bf16(qs[ks], bfr, o[t], 0, 0, 0); }
#pragma unroll
        for (int r = 0; r < 4; ++r) sq[r] += o[t][r] * o[t][r];
    }
    const float* nw = inp(I_CNRM) + (size_t)layer * 256 + h * 64;
#pragma unroll
    for (int r = 0; r < 4; ++r) { const float rstd = rsq_f(sum16_l(lane_, sq[r]) * (1.0f / 64.0f) + EPS); const size_t row = (size_t)(16 * ib + 4 * kq + r);
#pragma unroll
        for (int t = 0; t < 4; ++t) { const int v = t * 16 + fr; const float cg = bf1(P[row * NPROJ + PC_CG + v]);
            F_XN[(size_t)(c.row0 + row) * D + 512 + h * 64 + v] = (bf16)f2bf(o[t][r] * rstd * nw[v] * silu_g(cg)); } }
}

constexpr int HO_KE = 0, HO_VT = 64 * 264 * 2, HO_SIN = HO_VT + 256 * 72 * 2, HO_R = HO_SIN + 256 * 72 * 2, HO_SCR = HO_R + 1280 * 4, HO_END = HO_SCR + 8 * 2304;
static_assert(HO_END <= MISC_OFF, "hgrn_out_block LDS map");
__device__ __forceinline__ void hgrn_out_block(Frame& F, int layer, int ci) {
    ITEM_IDS();
    const int row0 = 64 * ci;
    LAS bf16* KEl = (LAS bf16*)(F.lds + HO_KE); LAS bf16* VTl = (LAS bf16*)(F.lds + HO_VT); LAS bf16* SIN = (LAS bf16*)(F.lds + HO_SIN); lf32* Rl = (lf32*)(F.lds + HO_R);
    LAS bf16* scr = (LAS bf16*)(F.lds + HO_SCR + wave_ * 2304);
    const int kq = lane_ >> 4, fr = lane_ & 15, h = wave_ >> 1, ib0 = 2 * (wave_ & 1);
    const bf16* P = F_PROJ + (size_t)row0 * NPROJ;
    v4u st[13];
    { const bf16* kg = P + PC_CF; const bf16* vg = F_VT + (size_t)ci * 16384; const bf16* sg = F_STC + (size_t)ci * 16384; const float* rg = F_RH + (size_t)ci * 1280;
#pragma unroll
      for (int q = 0; q < 4; ++q) { const int it = tid_ + q * NTHR; st[q] = *(const v4u*)(kg + (size_t)(it >> 5) * NPROJ + 8 * (it & 31)); }
#pragma unroll
      for (int q = 0; q < 4; ++q) st[4 + q] = *(const v4u*)(vg + (size_t)(tid_ + q * NTHR) * 8);
#pragma unroll
      for (int q = 0; q < 4; ++q) st[8 + q] = *(const v4u*)(sg + (size_t)(tid_ + q * NTHR) * 8);
      st[12] = (v4u){0u, 0u, 0u, 0u}; if (tid_ < 320) st[12] = *(const v4u*)(rg + 4 * tid_); }
    bf16x8 qf[2][2], kd[2][2];
#pragma unroll
    for (int bi = 0; bi < 2; ++bi)
#pragma unroll
        for (int ks = 0; ks < 2; ++ks) { const bf16* p = P + (size_t)(16 * (ib0 + bi) + fr) * NPROJ + h * 64 + 32 * ks + 8 * kq; qf[bi][ks] = *(const bf16x8*)(p + PC_CQ); kd[bi][ks] = *(const bf16x8*)(p + PC_CI); }
#pragma unroll
    for (int q = 0; q < 4; ++q) { const int it = tid_ + q * NTHR; *(LAS v4u*)(KEl + (it >> 5) * 264 + 8 * (it & 31)) = st[q]; }
#pragma unroll
    for (int q = 0; q < 4; ++q) { const int it = tid_ + q * NTHR; *(LAS v4u*)(VTl + (it >> 3) * 72 + 8 * (it & 7)) = st[4 + q]; *(LAS v4u*)(SIN + (it >> 3) * 72 + 8 * (it & 7)) = st[8 + q]; }
    if (tid_ < 320) *(LAS v4u*)(Rl + 4 * tid_) = st[12];
    bf16 cgv[2][4][4];
#pragma unroll
    for (int bi = 0; bi < 2; ++bi)
#pragma unroll
        for (int t = 0; t < 4; ++t)
#pragma unroll
            for (int r = 0; r < 4; ++r) cgv[bi][t][r] = P[(size_t)(16 * (ib0 + bi) + 4 * kq + r) * NPROJ + PC_CG + h * 64 + t * 16 + fr];
    __syncthreads();
    const float* nw = inp(I_CNRM) + (size_t)layer * 256 + h * 64;
#pragma unroll
    for (int bi = 0; bi < 2; ++bi) {
        const int ib = ib0 + bi;
        float qv[2][8], rI[2][8];
#pragma unroll
        for (int ks = 0; ks < 2; ++ks) { unpack8(__builtin_bit_cast(v4u, qf[bi][ks]), qv[ks]); const lf32* rp = Rl + ib * 256 + h * 64 + 32 * ks + 8 * kq;
#pragma unroll
            for (int e = 0; e < 8; ++e) rI[ks][e] = rp[e]; }
#pragma unroll
        for (int J = 0; J < 4; ++J) {
            f32x4 acc = {0.f, 0.f, 0.f, 0.f};
            if (J <= ib) {
#pragma unroll
                for (int ks = 0; ks < 2; ++ks) {
                    bf16x8 a = qf[bi][ks], bfr = kd[bi][ks];
                    if (J < ib) { const lf32* rp = Rl + (J + 1) * 256 + h * 64 + 32 * ks + 8 * kq; float v[8];
#pragma unroll
                        for (int e = 0; e < 8; ++e) v[e] = qv[ks][e] * __expf(rI[ks][e] - rp[e]);
                        a = __builtin_bit_cast(bf16x8, pack8(v)); bfr = *(const LAS bf16x8*)(KEl + (16 * J + fr) * 264 + h * 64 + 32 * ks + 8 * kq); }
                    acc = __builtin_amdgcn_mfma_f32_16x16x32_bf16(a, bfr, acc, 0, 0, 0);
                }
            }
#pragma unroll
            for (int r = 0; r < 4; ++r) { const int i = 4 * kq + r, j = fr; const float v = (J < ib || (J == ib && j <= i)) ? acc[r] : 0.f; scr[(4 * kq + r) * 72 + 16 * J + fr] = (bf16)f2bf(v); }
        }
        asm volatile("s_waitcnt lgkmcnt(0)" ::: "memory");
        bf16x8 ga[2];
#pragma unroll
        for (int ks = 0; ks < 2; ++ks) ga[ks] = *(const LAS bf16x8*)(scr + fr * 72 + 32 * ks + 8 * kq);
        asm volatile("s_waitcnt lgkmcnt(0)" ::: "memory");
        bf16x8 qs[2];
#pragma unroll
        for (int ks = 0; ks < 2; ++ks) { float v[8];
#pragma unroll
            for (int e = 0; e < 8; ++e) v[e] = qv[ks][e] * __expf(rI[ks][e]);
            qs[ks] = __builtin_bit_cast(bf16x8, pack8(v)); }
        const int nks = (ib + 2) >> 1;
        f32x4 o[4]; float sq[4] = {0.f, 0.f, 0.f, 0.f};
#pragma unroll
        for (int t = 0; t < 4; ++t) {
            o[t] = (f32x4){0.f, 0.f, 0.f, 0.f};
#pragma unroll
            for (int ks = 0; ks < 2; ++ks) if (ks < nks) o[t] = __builtin_amdgcn_mfma_f32_16x16x32_bf16(ga[ks], *(const LAS bf16x8*)(VTl + (h * 64 + t * 16 + fr) * 72 + 32 * ks + 8 * kq), o[t], 0, 0, 0);
#pragma unroll
            for (int ks = 0; ks < 2; ++ks) o[t] = __builtin_amdgcn_mfma_f32_16x16x32_bf16(qs[ks], *(const LAS bf16x8*)(SIN + (h * 64 + t * 16 + fr) * 72 + 32 * ks + 8 * kq), o[t], 0, 0, 0);
#pragma unroll
            for (int r = 0; r < 4; ++r) sq[r] += o[t][r] * o[t][r];
        }
#pragma unroll
        for (int r = 0; r < 4; ++r) { const float rstd = rsq_f(sum16_l(lane_, sq[r]) * (1.0f / 64.0f) + EPS); bf16* op = F_XN + (size_t)(row0 + 16 * ib + 4 * kq + r) * D + 512 + h * 64 + fr;
#pragma unroll
            for (int t = 0; t < 4; ++t) op[t * 16] = (bf16)f2bf(o[t][r] * rstd * nw[t * 16 + fr] * silu_g(bf1(cgv[bi][t][r]))); }
    }
    __syncthreads();
}
template <int MODE>
__device__ __forceinline__ void mini_gemm(Frame& F, const bf16* A, const bf16* Bt, int K, int ncb, bf16* O, int ldo, const float* res, float* C, const float* nw = nullptr, bf16* xo = nullptr, float* rs = nullptr) {
    ITEM_IDS();
    const int kq = lane_ >> 4, fr = lane_ & 15;
    for (int wi = ((int)blockIdx.x) * NWAVES + wave_; wi < 16 * ncb; wi += ((int)gridDim.x) * NWAVES) {
        const int rb = wi & 15, cb = wi >> 4;
        const bf16* ap = A + (size_t)(MP + 16 * rb + fr) * K + 8 * kq;
        const int c = 16 * cb + fr;
        const bf16* bp = Bt + (size_t)(MODE == 2 ? ((c >> 7) * 256 + (c & 127)) : c) * K + 8 * kq;
        f32x4 acc0 = {0.f, 0.f, 0.f, 0.f}, acc1 = {0.f, 0.f, 0.f, 0.f};
#pragma unroll 8
        for (int k0 = 0; k0 < K; k0 += 32) {
            const bf16x8 a = *(const bf16x8*)(ap + k0), b0 = *(const bf16x8*)(bp + k0);
            acc0 = __builtin_amdgcn_mfma_f32_16x16x32_bf16(a, b0, acc0, 0, 0, 0);
            if (MODE == 2) { const bf16x8 b1 = *(const bf16x8*)(bp + (size_t)128 * K + k0); acc1 = __builtin_amdgcn_mfma_f32_16x16x32_bf16(a, b1, acc1, 0, 0, 0); }
        }
#pragma unroll
        for (int r = 0; r < 4; ++r) { const size_t row = (size_t)(MP + 16 * rb + 4 * kq + r);
            if (MODE == 0) { const bf16 ob = (bf16)f2bf(acc0[r]); O[row * ldo + c] = ob; if (c >= PC_V && c < PC_V + 256) F_VTA[(size_t)(c - PC_V) * M + row] = ob; }
            if (MODE == 1) { const float x = res[row * 1024 + c] + acc0[r]; C[row * 1024 + c] = x;
                if (nw) { xo[row * 1024 + c] = (bf16)f2bf(x * nw[c]); const float q = sum16_l(lane_, x * x); if (fr == 0) atomicAdd(rs + row, q); } }
            if (MODE == 2) O[row * ldo + c] = (bf16)f2bf(silu_g(acc0[r]) * acc1[r]); }
    }
}

template <int MODE, int KS>
__device__ __forceinline__ void mini_gemm2(Frame& F, const bf16* A, const bf16* Bt, int K, int ncb32, bf16* O, int ldo, const float* res, float* C, const float* nw = nullptr, bf16* xo = nullptr, float* rs = nullptr, const bf16* rbf = nullptr, const float* rw = nullptr, bf16* Cb = nullptr) {
    ITEM_IDS();
    const int kq = lane_ >> 4, fr = lane_ & 15;
    LAS f32x4* red = (LAS f32x4*)F.lds;
    for (int it = (int)blockIdx.x; it < 8 * ncb32; it += (int)gridDim.x) {
        const int rb = it & 7, cb = it >> 3;
        const bf16* ap = A + (size_t)(MP + 32 * rb + fr) * K + wave_ * (KS * 32) + 8 * kq;
        const bf16* bp = Bt + (size_t)(32 * cb + fr) * K + wave_ * (KS * 32) + 8 * kq;
        f32x4 acc[2][2] = {{(f32x4){0.f, 0.f, 0.f, 0.f}, (f32x4){0.f, 0.f, 0.f, 0.f}}, {(f32x4){0.f, 0.f, 0.f, 0.f}, (f32x4){0.f, 0.f, 0.f, 0.f}}};
#pragma unroll (KS > 6 ? 6 : KS)
        for (int ks = 0; ks < KS; ++ks) {
            bf16x8 a[2], b[2];
#pragma unroll
            for (int i = 0; i < 2; ++i) { a[i] = *(const bf16x8*)(ap + (size_t)(16 * i) * K + 32 * ks); b[i] = *(const bf16x8*)(bp + (size_t)(16 * i) * K + 32 * ks); }
#pragma unroll
            for (int i = 0; i < 2; ++i)
#pragma unroll
                for (int j = 0; j < 2; ++j) acc[i][j] = __builtin_amdgcn_mfma_f32_16x16x32_bf16(a[i], b[j], acc[i][j], 0, 0, 0);
        }
#pragma unroll
        for (int i = 0; i < 2; ++i)
#pragma unroll
            for (int j = 0; j < 2; ++j) red[(wave_ * 4 + 2 * i + j) * 64 + lane_] = acc[i][j];
        __syncthreads();
        if (wave_ < 4) {
            const int qi = wave_ >> 1, qj = wave_ & 1;
            f32x4 s = red[wave_ * 64 + lane_];
#pragma unroll
            for (int w = 1; w < 8; ++w) s += red[(w * 4 + wave_) * 64 + lane_];
            const int c = 32 * cb + 16 * qj + fr;
#pragma unroll
            for (int r = 0; r < 4; ++r) { const size_t row = (size_t)(MP + 32 * rb + 16 * qi + 4 * kq + r);
                if (MODE == 0) { const bf16 ob = (bf16)f2bf(s[r]); O[row * ldo + c] = ob; if (c >= PC_V && c < PC_V + 256) F_VTA[(size_t)(c - PC_V) * M + row] = ob; }
                if (MODE == 1) { const float x = (rbf ? bf1(rbf[row * 1024 + c]) * (rw ? rcp_f(rw[c]) : 1.0f) : res[row * 1024 + c]) + s[r]; if (C) C[row * 1024 + c] = x; if (Cb) Cb[row * 1024 + c] = (bf16)f2bf(x);
                    if (nw) { xo[row * 1024 + c] = (bf16)f2bf(x * nw[c]); const float q = sum16_l(lane_, x * x); if (fr == 0) atomicAdd(rs + row, q); } } }
        }
        __syncthreads();
    }
}
__device__ __forceinline__ void sample_mix_item(Frame& F, int layer, int b) {
    ssd_prep_item(F, layer, NCHP + b);
    hgrn_prep_item(F, layer, NCHP + b);
    asm volatile("s_waitcnt vmcnt(0)" ::: "memory");
    __syncthreads();
    __builtin_amdgcn_fence(__ATOMIC_ACQUIRE, "agent");
    asm volatile("s_waitcnt vmcnt(0)" ::: "memory");
    { ITEM_IDS();
      if (wave_ == 0) ssd_out_witem(F, layer, NCHP + b, 0, wave_, lane_);
      else if (wave_ <= 4) hgrn_out_witem(F, layer, NCHP + b, wave_ - 1, 0, wave_, lane_); }
    __syncthreads();
}
__device__ __forceinline__ void p2_phase(Frame& F, int layer, volatile LAS unsigned* MISC) {
    constexpr int NS = NSB, NA = NCH * 4, NB = NCHP, NC = NCHP, ND = NCH, NE = 64, NW = 432;
    const int NTOT = NS + NA + NB + NC + ND + NE + (layer == 0 ? NW : 0);
    unsigned* head = (unsigned*)(F.ws + WS_CTL) + CW_QUEUE + 64 * layer;
    attn_bias_load(F, layer);
    unsigned nxt = 0u; if (threadIdx.x == 0) nxt = __hip_atomic_fetch_add(head, 1u, __ATOMIC_RELAXED, __HIP_MEMORY_SCOPE_AGENT);
    for (;;) {
        __syncthreads();
        if (threadIdx.x == 0) MISC[12] = nxt;
        __syncthreads();
        int it = (int)MISC[12];
        if (it >= NTOT) break;
        if (threadIdx.x == 0) nxt = __hip_atomic_fetch_add(head, 1u, __ATOMIC_RELAXED, __HIP_MEMORY_SCOPE_AGENT);
        if (it < NS) { sample_mix_item(F, layer, it); continue; } it -= NS;
        if (it < NA) { const int i2 = it - NSB * 4; const int ci = it < NSB * 4 ? NCHP + (it >> 2) : NCHP - 1 - (i2 >> 2); attn_item(F, layer, ci, it & 3); }
        else if (it < NA + NB) ssd_prep_item(F, layer, it - NA);
        else if (it < NA + NB + NC) hgrn_prep_item(F, layer, it - NA - NB);
        else if (it < NA + NB + NC + ND) pool_item(F, layer, it - NA - NB - NC);
        else if (it < NA + NB + NC + ND + NE) copy_cache(F, layer, it - NA - NB - NC - ND, NE);
        else { ITEM_IDS(); p0_weights(F, 1, (it - NA - NB - NC - ND - NE) * NWAVES + wave_, NW * NWAVES, false); }
    }
}
__device__ __forceinline__ void p4_phase(Frame& F, int layer) {
    for (int ci = ((int)blockIdx.x); ci < NCHP; ci += ((int)gridDim.x)) { ssd_out_block(F, layer, ci); hgrn_out_block(F, layer, ci); }
}

__global__ void __launch_bounds__(NTHR, 2) fwd_kernel(Args args) {
    extern __shared__ __attribute__((aligned(16))) unsigned char lds[];
    Frame F;
    F.lds = (LAS unsigned char*)lds;
    F.out = args.out; F.ws = args.ws;
    volatile LAS unsigned* MISC = (volatile LAS unsigned*)(F.lds + MISC_OFF);
    if (threadIdx.x < 64) MISC[threadIdx.x] = 0u;
    __syncthreads();
    (void)xcd_barrier_post((unsigned*)(args.ws + WS_CTL) + CW_BAR, MISC + 8);
#define GRID_BAR() do { XcdBarrier bar_; bar_.bar = (unsigned*)((unsigned char*)inp(N_IN + 1) + WS_CTL) + CW_BAR; bar_.x = xb_xcc_id(); bar_.st = MISC + 8; xcd_barrier(bar_); \
        F.out = (float*)inp(N_IN); F.ws = (unsigned char*)inp(N_IN + 1); } while (0)
#ifdef TPROBE
    const bool stamper = (blockIdx.x == 0 && threadIdx.x == 0); int n_stamp = 0;
#define STAMP() do { if (stamper) MISC[16 + n_stamp] = (unsigned)__builtin_amdgcn_s_memrealtime(); ++n_stamp; } while (0)
#else
#define STAMP() do { } while (0)
#endif
    STAMP();

    { float* rsz = F_RS; for (int i = (int)blockIdx.x * NTHR + (int)threadIdx.x; i < 2 * M; i += (int)gridDim.x * NTHR) rsz[i] = 0.f; }
    {
      const int w_ = __builtin_amdgcn_readfirstlane((int)(threadIdx.x >> 6));
      { const float* wdt = inp(I_WIN); lf32* wl = (lf32*)(F.lds + 135168); for (int k2 = (int)threadIdx.x; k2 < D; k2 += NTHR) *(LAS f32x4*)(wl + 4 * k2) = *(const f32x4*)(wdt + (size_t)k2 * NIN + 1792); }
      { const float* pw = inp(I_PW); for (int i = (int)blockIdx.x * NTHR + (int)threadIdx.x; i < 2 * 4 * 64 * 64; i += (int)gridDim.x * NTHR) { const int c = i & 63, d = (i >> 6) & 63, lg = i >> 12; F_WPT[i] = (bf16)f2bf(pw[(size_t)(lg * 64 + c) * 64 + d]); } }
      __syncthreads();
      if (w_ < 4) p0_weights(F, 0, (int)blockIdx.x * 4 + w_, (int)gridDim.x * 4, false);
      else norm_rows<true, false>(F, inp(I_XP), inp(I_XS) - (size_t)MP * D, inp(I_N1), inp(I_WIN), nullptr, (int)blockIdx.x * 4 + (w_ - 4), (int)gridDim.x * 4); }
    GRID_BAR(); STAMP();
#pragma unroll 1
    for (int layer = 0; layer < 2; ++layer) {
        unsigned char* wl = F.ws + WS_W + (size_t)layer * WL_STRIDE;
        mini_gemm2<0, 4>(F, F_XN, (const bf16*)(wl + WL_IN), D, NPROJ / 32, F_PROJ, NPROJ, nullptr, nullptr);
        { pg8::Gemm g{F_XN, (const bf16*)(wl + WL_IN), MP, NPROJ, D}; pg8::StaticOrder S; S.init(MP, NPROJ, ((int)gridDim.x), ((int)blockIdx.x));
          pg8::EpiBf16 E{F_PROJ, NPROJ, F_HALO, F_VTA, M};
          pg8::gemm_phase<pg8::EpiBf16, pg8::StaticOrder, true, true>(F.lds + RING_OFF, g, S, E); }
        GRID_BAR(); STAMP();
        p2_phase(F, layer, MISC);
        GRID_BAR(); STAMP();
        scan_phase(F, layer);
        GRID_BAR(); STAMP();
        p4_phase(F, layer);
        GRID_BAR(); STAMP();
        mini_gemm2<1, 4>(F, F_XN, (const bf16*)(wl + WL_OUT), D, D / 32, nullptr, 0, inp(I_XS) - (size_t)MP * D, nullptr, inp(I_N2) + (size_t)layer * D, F_XN2, F_RS + (size_t)layer * M, layer == 0 ? nullptr : (const bf16*)F.out, nullptr);
        { pg8::Gemm g{F_XN, (const bf16*)(wl + WL_OUT), MP, D, D}; pg8::StaticOrder S; S.init(MP, D, ((int)gridDim.x), ((int)blockIdx.x));
          pg8::EpiRes E{inp(I_XP), inp(I_XS) - (size_t)MP * D, nullptr, inp(I_N2) + (size_t)layer * D, F_XN2, F_RS + (size_t)layer * M, layer == 0 ? nullptr : (const bf16*)F.out, nullptr, nullptr};
          pg8::gemm_phase<pg8::EpiRes, pg8::StaticOrder, true, true>(F.lds + RING_OFF, g, S, E); }
        GRID_BAR(); STAMP();
        { pg8::Gemm g{F_XN2, (const bf16*)(wl + WL_GU), M, NGU, D}; pg8::StaticOrder S; S.init(M, NGU, ((int)gridDim.x), ((int)blockIdx.x));
          pg8::EpiSwiGLU E{F_ACT, DFF, F_RS + (size_t)layer * M};
          pg8::gemm_phase<pg8::EpiSwiGLU, pg8::StaticOrder, true, true>(F.lds + RING_OFF, g, S, E); }
        GRID_BAR(); STAMP();
        mini_gemm2<1, 11>(F, F_ACT, (const bf16*)(wl + WL_DN), DFF, D / 32, nullptr, 0, nullptr, nullptr, nullptr, nullptr, nullptr, F_XN2, inp(I_N2) + (size_t)layer * D, layer == 0 ? (bf16*)F.out : F_XN);
        { pg8::Gemm g{F_ACT, (const bf16*)(wl + WL_DN), MP, D, DFF}; pg8::StaticOrder S; S.init(MP, D, ((int)gridDim.x), ((int)blockIdx.x));
          pg8::EpiRes E{nullptr, nullptr, nullptr, nullptr, nullptr, nullptr, F_XN2, inp(I_N2) + (size_t)layer * D, layer == 0 ? (bf16*)F.out : F_XN};
          pg8::gemm_phase<pg8::EpiRes, pg8::StaticOrder, true, true>(F.lds + RING_OFF, g, S, E); }
        GRID_BAR(); STAMP();
        if (layer == 0) { norm_rows<true, false>(F, nullptr, nullptr, inp(I_N1) + D, inp(I_WIN) + (size_t)D * NIN, (const bf16*)F.out); GRID_BAR(); STAMP(); }
        else { norm_rows<false, true>(F, nullptr, nullptr, inp(I_NF), nullptr, F_XN); STAMP(); }
    }
#ifdef TPROBE
    if (stamper) {
        unsigned v[10]; v[0] = MISC[17] - MISC[16];
        for (int j = 1; j < 9; ++j) v[j] = (MISC[17 + j] - MISC[16 + j]) + (MISC[25 + j] - MISC[24 + j]);
        v[9] = (MISC[33] - MISC[16]) / 4;
        const unsigned dl = 800000u + 16u * v[TPROBE];
        const unsigned t0 = MISC[16];
        while ((unsigned)((unsigned)__builtin_amdgcn_s_memrealtime() - t0) < dl) __builtin_amdgcn_s_sleep(32);
    }
#endif
}

extern "C" void kernel_launch(void* const* d_in, const int* in_sizes, int n_in, void* d_out, int out_size, void* d_ws, size_t ws_size, hipStream_t stream) {
    static int grid = 0;
    if (grid == 0) {
        if (n_in != N_IN || (size_t)out_size != O_END || ws_size < WS_END) { fprintf(stderr, "kernel_launch: unexpected shapes (n_in %d, out %d, ws %zu)\n", n_in, out_size, ws_size); grid = -1; return; }
        int dev = 0, cus = 0, per_cu = 0;
        if (hipGetDevice(&dev) != hipSuccess || hipDeviceGetAttribute(&cus, hipDeviceAttributeMultiprocessorCount, dev) != hipSuccess) { grid = -1; return; }
        if (hipFuncSetAttribute((const void*)fwd_kernel, hipFuncAttributeMaxDynamicSharedMemorySize, LDS_BYTES) != hipSuccess) { fprintf(stderr, "kernel_launch: hipFuncSetAttribute failed\n"); grid = -1; return; }
        if (hipOccupancyMaxActiveBlocksPerMultiprocessor(&per_cu, (const void*)fwd_kernel, NTHR, LDS_BYTES) != hipSuccess || per_cu < 1) { fprintf(stderr, "kernel_launch: occupancy query says %d blocks per CU\n", per_cu); (void)hipGetLastError(); grid = -1; return; }
        grid = cus;
        if (grid < 64) { fprintf(stderr, "kernel_launch: needs at least 64 CUs (got %d)\n", cus); grid = -1; return; }
    }
    if (grid < 0) return;
    if (hipMemsetAsync((char*)d_ws + WS_CTL, 0, CTL_ZERO_BYTES, stream) != hipSuccess) { fprintf(stderr, "kernel_launch: hipMemsetAsync failed\n"); return; }
    Args a{};
    for (int i = 0; i < N_IN; ++i) a.in[i] = (const float*)d_in[i];
    a.out = (float*)d_out; a.ws = (unsigned char*)d_ws;
    void* kargs[] = {&a};
    hipError_t e = hipLaunchCooperativeKernel((const void*)fwd_kernel, dim3(grid), dim3(NTHR), kargs, LDS_BYTES, stream);
    if (e != hipSuccess) { fprintf(stderr, "kernel_launch: cooperative launch failed: %s (grid %d)\n", hipGetErrorString(e), grid); }
}
```

```cpp
#include <hip/hip_runtime.h>
#include <cstdio>
#include <cstdint>
namespace pg8 {
#define PG8_LAS __attribute__((address_space(3)))
typedef unsigned short bf16_t;
typedef short bf16x8 __attribute__((ext_vector_type(8)));
typedef float f32x4 __attribute__((ext_vector_type(4)));
typedef unsigned u32x4 __attribute__((ext_vector_type(4)));
constexpr int BM = 256, BK = 64, HALF = 128, HTB = HALF * BK * 2  , STAGE_BYTES = 8 * HTB, NXCD = 8, WGM = 8;

__host__ __device__ __forceinline__ int lds_byte(int r, int c) { const int st = (r >> 4) * 2 + (c >> 5), rr = r & 15, cc = c & 31, ob = rr * 64 + cc * 2; return st * 1024 + (ob ^ (((ob >> 9) & 1) << 5)); }
__host__ __device__ __forceinline__ void stage_rc(int b, int& R, int& C) { const int st = b / 1024, sb = b % 1024, swz = sb ^ (((sb >> 9) & 1) << 5); R = (st >> 1) * 16 + swz / 64; C = (st & 1) * 32 + (swz % 64) / 2; }
__host__ __device__ __forceinline__ int perm32(int rho) { const int n = rho >> 4, i = rho & 15; return 8 * (i >> 2) + 4 * n + (i & 3); }

struct Unit { int pm, pn; };
struct Gemm { const bf16_t* A; const bf16_t* Bt; int M, N, K; };

struct StaticOrder {
    int nM, nN, nwg, G, c;
    __host__ __device__ void init(int M, int N, int G_, int c_) { nM = M / BM; nN = N / BM; nwg = nM * nN; G = G_; c = c_; }
    __host__ __device__ bool next(int i, Unit& u) const {
        const long L = (long)i * G + c; if (L >= nwg) return false;
        int wgid = (int)L; { const int q = nwg / NXCD, r = nwg % NXCD, xcd = wgid % NXCD, off = wgid / NXCD; wgid = (xcd < r ? xcd * (q + 1) : r * (q + 1) + (xcd - r) * q) + off; }
        const int nig = WGM * nN, gid = wgid / nig, fm = gid * WGM, gsz = (nM - fm) < WGM ? (nM - fm) : WGM;
        u.pm = fm + ((wgid % nig) % gsz); u.pn = (wgid % nig) / gsz; return true;
    }
    __device__ __forceinline__ void a_ready(const Unit&) const {}
    __device__ __forceinline__ void done(const Unit&) const {}
};

__device__ __forceinline__ unsigned cvt_pk_bf16(float lo, float hi) { unsigned r; asm volatile("v_cvt_pk_bf16_f32 %0, %1, %2" : "=v"(r) : "v"(lo), "v"(hi)); return r; }
__device__ __forceinline__ float silu_f(float x) { return x * __builtin_amdgcn_rcpf(1.0f + __expf(-x)); }
struct EpiBf16 {
    static constexpr bool PERM = true, AFTER_DRAIN = false;
    bf16_t* O; int ldc; bf16_t* halo; bf16_t* vta; int vld;
    __device__ __forceinline__ void operator()(const f32x4 (&acc)[2][2][4][2], const Unit& u, int wr, int wc, int fr, int fq) const {
        const int row0 = u.pm * BM + wr * 64 + fr, col0 = u.pn * BM + wc * 32 + 8 * fq;
        const bool hz = halo != nullptr && u.pn >= 4 && u.pn <= 6;
#pragma unroll
        for (int ai = 0; ai < 2; ++ai)
#pragma unroll
            for (int m = 0; m < 4; ++m) { const int row = row0 + ai * HALF + m * 16; bf16_t* rowp = O + (size_t)row * ldc + col0;
#pragma unroll
                for (int bj = 0; bj < 2; ++bj) { const f32x4 v0 = acc[ai][bj][m][0], v1 = acc[ai][bj][m][1];
                    u32x4 w; w.x = cvt_pk_bf16(v0[0], v0[1]); w.y = cvt_pk_bf16(v0[2], v0[3]); w.z = cvt_pk_bf16(v1[0], v1[1]); w.w = cvt_pk_bf16(v1[2], v1[3]);
                    *(u32x4*)(rowp + bj * HALF) = w;
                    if (hz && (row & 63) >= 61) *(u32x4*)(halo + ((size_t)(row >> 6) * 3 + (row & 63) - 61) * 768 + (col0 - 1024) + bj * HALF) = w;
                    if (vta != nullptr && u.pn == 2) { bf16_t* vp = vta + (size_t)(col0 - 512 + bj * HALF) * vld + row;
                        vp[0] = (bf16_t)(w.x & 0xffffu); vp[(size_t)vld] = (bf16_t)(w.x >> 16); vp[(size_t)2 * vld] = (bf16_t)(w.y & 0xffffu); vp[(size_t)3 * vld] = (bf16_t)(w.y >> 16);
                        vp[(size_t)4 * vld] = (bf16_t)(w.z & 0xffffu); vp[(size_t)5 * vld] = (bf16_t)(w.z >> 16); vp[(size_t)6 * vld] = (bf16_t)(w.w & 0xffffu); vp[(size_t)7 * vld] = (bf16_t)(w.w >> 16); } } }
    }
};
struct EpiRes {
    static constexpr bool PERM = false, AFTER_DRAIN = false;
    const float* rlo; const float* rhi; float* C; const float* nw; bf16_t* xo; float* rs; const bf16_t* rbf; const float* rw; bf16_t* Cb;
    __device__ __forceinline__ void operator()(const f32x4 (&acc)[2][2][4][2], const Unit& u, int wr, int wc, int fr, int fq) const {
        const int row0 = u.pm * BM + wr * 64 + fr, col0 = u.pn * BM + wc * 32 + 4 * fq;
        const float* rb = (u.pm < 64) ? rlo : rhi;
        f32x4 wv[2][2];
        if (nw || rbf) {
#pragma unroll
            for (int bj = 0; bj < 2; ++bj)
#pragma unroll
                for (int n = 0; n < 2; ++n) { if (nw) wv[bj][n] = *(const f32x4*)(nw + col0 + bj * HALF + n * 16);
                    else if (rw) { const f32x4 t = *(const f32x4*)(rw + col0 + bj * HALF + n * 16); wv[bj][n] = (f32x4){__builtin_amdgcn_rcpf(t[0]), __builtin_amdgcn_rcpf(t[1]), __builtin_amdgcn_rcpf(t[2]), __builtin_amdgcn_rcpf(t[3])}; }
                    else wv[bj][n] = (f32x4){1.f, 1.f, 1.f, 1.f}; } }
#pragma unroll
        for (int ai = 0; ai < 2; ++ai)
#pragma unroll
        for (int mh = 0; mh < 2; ++mh) {
            f32x4 rv[2][2][2];
#pragma unroll
            for (int m2 = 0; m2 < 2; ++m2)
#pragma unroll
                for (int bj = 0; bj < 2; ++bj)
#pragma unroll
                    for (int n = 0; n < 2; ++n) { const size_t o = (size_t)(row0 + ai * HALF + (2 * mh + m2) * 16) * 1024 + col0 + bj * HALF + n * 16;
                        if (rbf) { const unsigned long long w = *(const unsigned long long*)(rbf + o); const unsigned lo = (unsigned)w, hi = (unsigned)(w >> 32);
                            rv[m2][bj][n] = (f32x4){__builtin_bit_cast(float, lo << 16), __builtin_bit_cast(float, lo & 0xffff0000u), __builtin_bit_cast(float, hi << 16), __builtin_bit_cast(float, hi & 0xffff0000u)}; if (!nw) rv[m2][bj][n] = rv[m2][bj][n] * wv[bj][n]; }
                        else rv[m2][bj][n] = *(const f32x4*)(rb + o); }
#pragma unroll
            for (int m2 = 0; m2 < 2; ++m2) { const int m = 2 * mh + m2; const int row = row0 + ai * HALF + m * 16; const size_t off = (size_t)row * 1024 + col0; float ss = 0.f;
#pragma unroll
                for (int bj = 0; bj < 2; ++bj)
#pragma unroll
                    for (int n = 0; n < 2; ++n) { const f32x4 x = rv[m2][bj][n] + acc[ai][bj][m][n]; if (C) *(f32x4*)(C + off + bj * HALF + n * 16) = x;
                        if (Cb) *(unsigned long long*)(Cb + off + bj * HALF + n * 16) = (unsigned long long)cvt_pk_bf16(x[0], x[1]) | ((unsigned long long)cvt_pk_bf16(x[2], x[3]) << 32);
                        if (nw) { ss += (x[0] * x[0] + x[1] * x[1]) + (x[2] * x[2] + x[3] * x[3]); const f32x4 y = x * wv[bj][n];
                            *(unsigned long long*)(xo + off + bj * HALF + n * 16) = (unsigned long long)cvt_pk_bf16(y[0], y[1]) | ((unsigned long long)cvt_pk_bf16(y[2], y[3]) << 32); } }
                if (nw) { const int lane = fq * 16 + fr;
                    ss += __builtin_bit_cast(float, __builtin_amdgcn_ds_bpermute((lane ^ 16) << 2, __builtin_bit_cast(int, ss)));
                    ss += __builtin_bit_cast(float, __builtin_amdgcn_ds_bpermute((lane ^ 32) << 2, __builtin_bit_cast(int, ss)));
                    if (fq == 0) atomicAdd(rs + row, ss); } }
            asm volatile("" ::: "memory");
        }
    }
};
struct EpiSwiGLU {
    static constexpr bool PERM = true, AFTER_DRAIN = false;
    bf16_t* O; int ldc; const float* rs;
    __device__ __forceinline__ void operator()(const f32x4 (&acc)[2][2][4][2], const Unit& u, int wr, int wc, int fr, int fq) const {
        const int row0 = u.pm * BM + wr * 64 + fr, col0 = u.pn * HALF + wc * 32 + 8 * fq;
#pragma unroll
        for (int ai = 0; ai < 2; ++ai)
#pragma unroll
            for (int m = 0; m < 4; ++m) { const int row = row0 + ai * HALF + m * 16; bf16_t* rowp = O + (size_t)row * ldc + col0;
                const float rstd = __builtin_amdgcn_rsqf(rs[row] * (1.0f / 1024.0f) + 1e-6f);
                const f32x4 g0 = acc[ai][0][m][0] * rstd, g1 = acc[ai][0][m][1] * rstd, u0 = acc[ai][1][m][0] * rstd, u1 = acc[ai][1][m][1] * rstd;
                u32x4 w; w.x = cvt_pk_bf16(silu_f(g0[0]) * u0[0], silu_f(g0[1]) * u0[1]); w.y = cvt_pk_bf16(silu_f(g0[2]) * u0[2], silu_f(g0[3]) * u0[3]);
                w.z = cvt_pk_bf16(silu_f(g1[0]) * u1[0], silu_f(g1[1]) * u1[1]); w.w = cvt_pk_bf16(silu_f(g1[2]) * u1[2], silu_f(g1[3]) * u1[3]);
                *(u32x4*)rowp = w; }
    }
};
template <class Epi, class Sched, bool ALIGN_EPI = false, bool SP2 = false>
__device__ __forceinline__ void gemm_phase(PG8_LAS unsigned char* lds, const Gemm g, const Sched& S, const Epi& E) {
    int tid0 = threadIdx.x; asm volatile("" : "+v"(tid0));
    const int tid = tid0, wid = __builtin_amdgcn_readfirstlane(tid >> 6), lane = tid & 63, wr = wid >> 2, wc = wid & 3, fr = lane & 15, fq = lane >> 4;
    const int K = g.K, nt = K / BK;
    unsigned voffA[2], voffB[2];
#pragma unroll
    for (int i = 0; i < 2; ++i) { int R, C; stage_rc(tid * 16 + i * 8192, R, C); const int Rb = Epi::PERM ? ((R & ~31) + perm32(R & 31)) : R;
        voffA[i] = (unsigned)(R * K + C) * 2u; voffB[i] = (unsigned)(Rb * K + C) * 2u; }
    const size_t kstep = (size_t)(BK * 2);
    const size_t hstep = (size_t)HALF * K * 2;
    const size_t tstep = 2 * hstep;
    const unsigned ldsw = (unsigned)wid * 1024u;
    const int aoff = lds_byte(wr * 64 + fr, fq * 8), boff = lds_byte(wc * 32 + fr, fq * 8);
#define PG8_SA(b, h) (((b) * 2 + (h)) * HTB)
#define PG8_SB(b, h) ((4 + (b) * 2 + (h)) * HTB)
#define PG8_STAGE(bufoff, gbase, voff) do { _Pragma("unroll") for (int _i = 0; _i < 2; ++_i) \
        __builtin_amdgcn_global_load_lds((const unsigned*)((const char*)(gbase) + (voff)[_i]), (PG8_LAS unsigned*)(lds + (bufoff) + ldsw + _i * 8192), 16, 0, 0); } while (0)
#define PG8_LDA(dst, b, h) do { _Pragma("unroll") for (int m = 0; m < 4; ++m) _Pragma("unroll") for (int k = 0; k < 2; ++k) dst[m][k] = *(const PG8_LAS bf16x8*)(lds + PG8_SA(b, h) + aoff + m * 2048 + k * 1024); } while (0)
#define PG8_LDB(dst, b, h) do { _Pragma("unroll") for (int n = 0; n < 2; ++n) _Pragma("unroll") for (int k = 0; k < 2; ++k) dst[n][k] = *(const PG8_LAS bf16x8*)(lds + PG8_SB(b, h) + boff + n * 2048 + k * 1024); } while (0)
#define PG8_MMA(ai, bj, At, Bt) do { __builtin_amdgcn_s_setprio(1); _Pragma("unroll") for (int m = 0; m < 4; ++m) _Pragma("unroll") for (int n = 0; n < 2; ++n) _Pragma("unroll") for (int k = 0; k < 2; ++k) \
        acc[ai][bj][m][n] = __builtin_amdgcn_mfma_f32_16x16x32_bf16(Bt[n][k], At[m][k], acc[ai][bj][m][n], 0, 0, 0); __builtin_amdgcn_s_setprio(0); } while (0)
#define PG8_WAIT_V(n) asm volatile("s_waitcnt vmcnt(" #n ")" ::: "memory")
#define PG8_WAIT_L(n) asm volatile("s_waitcnt lgkmcnt(" #n ")" ::: "memory")
#define PG8_BAR __builtin_amdgcn_s_barrier()
#define PG8_SCHED __builtin_amdgcn_sched_barrier(0)
    Unit cur, nxt; int ui = 0;
    if (!S.next(0, cur)) return;
    f32x4 acc[2][2][4][2];
#pragma unroll
    for (int a = 0; a < 2; ++a)
#pragma unroll
        for (int b = 0; b < 2; ++b)
#pragma unroll
            for (int m = 0; m < 4; ++m)
#pragma unroll
                for (int n = 0; n < 2; ++n) acc[a][b][m][n] = (f32x4){0.f, 0.f, 0.f, 0.f};
    bf16x8 At[4][2], B0[2][2], B1[2][2];
    const char* cA = (const char*)g.A + (size_t)cur.pm * tstep; const char* cB = (const char*)g.Bt + (size_t)cur.pn * tstep;
    S.a_ready(cur);
    if constexpr (SP2) {
        PG8_STAGE(PG8_SB(0, 0), cB, voffB); PG8_STAGE(PG8_SB(0, 1), cB + hstep, voffB); PG8_STAGE(PG8_SA(0, 0), cA, voffA); PG8_STAGE(PG8_SA(0, 1), cA + hstep, voffA);
        if (wr == 1) PG8_BAR;
        PG8_WAIT_V(2); PG8_BAR;
        PG8_STAGE(PG8_SB(1, 0), cB + kstep, voffB); PG8_STAGE(PG8_SA(1, 0), cA + kstep, voffA); PG8_STAGE(PG8_SB(1, 1), cB + hstep + kstep, voffB);
        PG8_WAIT_V(6); PG8_BAR;
    } else {
        PG8_STAGE(PG8_SB(0, 0), cB, voffB); PG8_STAGE(PG8_SA(0, 0), cA, voffA); PG8_STAGE(PG8_SB(0, 1), cB + hstep, voffB); PG8_STAGE(PG8_SA(0, 1), cA + hstep, voffA);
        if (wr == 1) PG8_BAR;
        PG8_WAIT_V(4); PG8_BAR;
        PG8_STAGE(PG8_SB(1, 0), cB + kstep, voffB); PG8_STAGE(PG8_SA(1, 0), cA + kstep, voffA); PG8_STAGE(PG8_SB(1, 1), cB + hstep + kstep, voffB);
        PG8_WAIT_V(6); PG8_BAR;
    }
    for (;;) {
        const bool has_next = S.next(ui + 1, nxt);
        const char* nA = has_next ? (const char*)g.A + (size_t)nxt.pm * tstep : cA; const char* nB = has_next ? (const char*)g.Bt + (size_t)nxt.pn * tstep : cB;
        for (int t = 0; t < nt; t += 2) {
            const bool last = (t == nt - 2);
            const char* a1 = cA + (size_t)(t + 1) * kstep;
            const char* a2 = last ? nA : cA + (size_t)(t + 2) * kstep; const char* b2 = last ? nB : cB + (size_t)(t + 2) * kstep;
            const char* a3 = a2 + kstep; const char* b3 = b2 + kstep;
            if (last && has_next) S.a_ready(nxt);
            if constexpr (SP2) {
            PG8_LDB(B0, 0, 0); PG8_LDB(B1, 0, 1); PG8_SCHED; PG8_LDA(At, 0, 0); PG8_STAGE(PG8_SA(1, 1), a1 + hstep, voffA);
            PG8_WAIT_V(8); PG8_WAIT_L(0); PG8_BAR; PG8_MMA(0, 0, At, B0); PG8_MMA(0, 1, At, B1); PG8_BAR; PG8_SCHED;
            PG8_LDA(At, 0, 1); PG8_STAGE(PG8_SB(0, 0), b2, voffB); PG8_STAGE(PG8_SB(0, 1), b2 + hstep, voffB); PG8_STAGE(PG8_SA(0, 0), a2, voffA);
            PG8_WAIT_V(8); PG8_WAIT_L(0); PG8_BAR; PG8_MMA(1, 0, At, B0); PG8_MMA(1, 1, At, B1); PG8_BAR; PG8_SCHED;
            PG8_LDB(B0, 1, 0); PG8_LDB(B1, 1, 1); PG8_SCHED; PG8_LDA(At, 1, 0); PG8_STAGE(PG8_SA(0, 1), a2 + hstep, voffA);
            PG8_WAIT_V(8); PG8_WAIT_L(0); PG8_BAR; PG8_MMA(0, 0, At, B0); PG8_MMA(0, 1, At, B1); PG8_BAR; PG8_SCHED;
            PG8_LDA(At, 1, 1); PG8_STAGE(PG8_SB(1, 0), b3, voffB); PG8_STAGE(PG8_SB(1, 1), b3 + hstep, voffB); PG8_STAGE(PG8_SA(1, 0), a3, voffA);
            PG8_WAIT_V(8); PG8_WAIT_L(0); PG8_BAR; PG8_MMA(1, 0, At, B0); PG8_MMA(1, 1, At, B1); PG8_BAR; PG8_SCHED;
            } else {
            PG8_LDB(B0, 0, 0); PG8_SCHED; PG8_LDA(At, 0, 0); PG8_STAGE(PG8_SA(1, 1), a1 + hstep, voffA);
            PG8_WAIT_L(8); PG8_BAR; PG8_WAIT_L(0); PG8_MMA(0, 0, At, B0); PG8_BAR; PG8_SCHED;
            PG8_LDB(B1, 0, 1); PG8_STAGE(PG8_SB(0, 0), b2, voffB);
            PG8_BAR; PG8_WAIT_L(0); PG8_MMA(0, 1, At, B1); PG8_BAR;
            PG8_LDA(At, 0, 1); PG8_STAGE(PG8_SA(0, 0), a2, voffA);
            PG8_BAR; PG8_WAIT_L(0); PG8_MMA(1, 0, At, B0); PG8_BAR; PG8_SCHED;
            PG8_STAGE(PG8_SB(0, 1), b2 + hstep, voffB);
            PG8_WAIT_V(6); PG8_BAR; PG8_MMA(1, 1, At, B1); PG8_BAR;
            PG8_LDB(B0, 1, 0); PG8_SCHED; PG8_LDA(At, 1, 0); PG8_STAGE(PG8_SA(0, 1), a2 + hstep, voffA);
            PG8_WAIT_L(8); PG8_BAR; PG8_WAIT_L(0); PG8_MMA(0, 0, At, B0); PG8_BAR; PG8_SCHED;
            PG8_LDB(B1, 1, 1); PG8_STAGE(PG8_SB(1, 0), b3, voffB);
            PG8_BAR; PG8_WAIT_L(0); PG8_MMA(0, 1, At, B1); PG8_BAR;
            PG8_LDA(At, 1, 1); PG8_STAGE(PG8_SA(1, 0), a3, voffA);
            PG8_BAR; PG8_WAIT_L(0); PG8_MMA(1, 0, At, B0); PG8_BAR; PG8_SCHED;
            PG8_STAGE(PG8_SB(1, 1), b3 + hstep, voffB);
            PG8_WAIT_V(6); PG8_BAR; PG8_MMA(1, 1, At, B1); PG8_BAR;
            }
        }
        if constexpr (ALIGN_EPI) { if (wr == 0) PG8_BAR; }
        if constexpr (!Epi::AFTER_DRAIN) { E(acc, cur, wr, wc, fr, fq); S.done(cur); }
        if (!has_next) break;
#pragma unroll
        for (int a = 0; a < 2; ++a)
#pragma unroll
            for (int b = 0; b < 2; ++b)
#pragma unroll
                for (int m = 0; m < 4; ++m)
#pragma unroll
                    for (int n = 0; n < 2; ++n) acc[a][b][m][n] = (f32x4){0.f, 0.f, 0.f, 0.f};
        cur = nxt; cA = nA; cB = nB; ++ui;
        if constexpr (ALIGN_EPI) { if (wr == 1) PG8_BAR; }
    }
    PG8_WAIT_V(0);
    if constexpr (!ALIGN_EPI) { if (wr == 0) PG8_BAR; }
    PG8_BAR;
    if constexpr (Epi::AFTER_DRAIN) { E.fused(acc, cur, wr, wc, fr, fq, lds, wid, lane); S.done(cur); }
#undef PG8_SA
#undef PG8_SB
#undef PG8_STAGE
#undef PG8_LDA
#undef PG8_LDB
#undef PG8_MMA
#undef PG8_WAIT_V
#undef PG8_WAIT_L
#undef PG8_BAR
#undef PG8_SCHED
}
}
#define GAS __attribute__((address_space(1)))
#define LAS __attribute__((address_space(3)))
typedef unsigned short bf16;
typedef unsigned v4u __attribute__((ext_vector_type(4)));
typedef float f32x4 __attribute__((ext_vector_type(4)));
typedef short bf16x8 __attribute__((ext_vector_type(8)));
typedef GAS unsigned gu32;
typedef GAS unsigned long long gu64;
#define RLX_AGENT __ATOMIC_RELAXED, __HIP_MEMORY_SCOPE_AGENT
#define LDS_WAIT() asm volatile("s_waitcnt lgkmcnt(0)" ::: "memory")
#define VM_WAIT() asm volatile("s_waitcnt vmcnt(0)" ::: "memory")
__device__ __forceinline__ unsigned long long rt() { return __builtin_amdgcn_s_memrealtime(); }
__device__ __forceinline__ unsigned f2bf(float f) { unsigned u = __builtin_bit_cast(unsigned, f); return (u + 0x7fffu + ((u >> 16) & 1u)) >> 16; }
__device__ __forceinline__ unsigned pk2(float lo, float hi) { return f2bf(lo) | (f2bf(hi) << 16); }
#define XB_TMO      128
#define XB_XCNT(j)  (256  + 64 * (j))
#define XB_XSUB(j)  (1280 + 64 * (j))
#define XB_XGEN(j)  (2304 + 64 * (j))
#define XB_TOP      3328
#define XB_TOPGEN   3392
#define XCD_BAR_WORDS 3456
#define XB_SPIN_CAP (1u << 18)

__device__ __forceinline__ unsigned xb_ld(unsigned* p)              { return __hip_atomic_load(p, __ATOMIC_RELAXED, __HIP_MEMORY_SCOPE_AGENT); }
__device__ __forceinline__ unsigned xb_add(unsigned* p, unsigned v) { return __hip_atomic_fetch_add(p, v, __ATOMIC_RELAXED, __HIP_MEMORY_SCOPE_AGENT); }
__device__ __forceinline__ unsigned xb_xcc_id() { return (unsigned)__builtin_amdgcn_s_getreg((3 << 11) | 20) & 0xFu; }
#define XB_SPIN(cond, bar) do { unsigned _sp = 0; while (cond) { __builtin_amdgcn_s_sleep(1); \
    if ((++_sp & 255u) == 0u) { if (xb_ld(&(bar)[XB_TMO])) break; if (_sp > XB_SPIN_CAP) { atomicAdd(&(bar)[XB_TMO], 1u); break; } } } } while (0)

struct XcdBarrier {
    unsigned* bar; unsigned x;
    volatile LAS unsigned* st;
};

__device__ __forceinline__ XcdBarrier xcd_barrier_post(unsigned* bar, volatile LAS unsigned* st) {
    XcdBarrier b; b.bar = bar; b.x = xb_xcc_id(); b.st = st;
    if (threadIdx.x == 0) (void)xb_add(&bar[XB_XCNT(b.x)], 1u);
    return b;
}
__device__ __forceinline__ void xcd_barrier_complete(unsigned* bar, unsigned x, unsigned& nloc, unsigned& nx) {
    const unsigned G = gridDim.x * gridDim.y * gridDim.z;
    unsigned sum, cnt, mine, sp = 0u;
    for (;;) {
        sum = 0u; cnt = 0u; mine = 0u;
#pragma unroll
        for (unsigned j = 0; j < 16; ++j) { const unsigned c = xb_ld(&bar[XB_XCNT(j)]); sum += c; cnt += (c > 0u) ? 1u : 0u; mine = (j == x) ? c : mine; }
        if (sum == G) break;
        __builtin_amdgcn_s_sleep(1);
        if ((++sp & 255u) == 0u) { if (xb_ld(&bar[XB_TMO])) break; if (sp > XB_SPIN_CAP) { atomicAdd(&bar[XB_TMO], 1u); break; } }
    }
    nloc = mine > 0u ? mine : 1u; nx = cnt > 0u ? cnt : 1u;
}

__device__ __forceinline__ void xcd_barrier(const XcdBarrier& b) {
    asm volatile("s_waitcnt vmcnt(0)" ::: "memory");
    __syncthreads();
    if (threadIdx.x == 0) {
        unsigned* bar = b.bar;
        __builtin_amdgcn_s_waitcnt(0);
        unsigned nloc = b.st[0], nx = b.st[1];
        if (nloc == 0u) { xcd_barrier_complete(bar, b.x, nloc, nx); b.st[0] = nloc; b.st[1] = nx; }
        const unsigned old = xb_add(&bar[XB_XSUB(b.x)], 1u);
        const unsigned gen = old / nloc;
        if (old + 1u == (gen + 1u) * nloc) {
            __builtin_amdgcn_fence(__ATOMIC_RELEASE, "agent");
            asm volatile("s_waitcnt vmcnt(0)" ::: "memory");
            const unsigned og = xb_add(&bar[XB_TOP], 1u);
            const unsigned tg = og / nx;
            if (og + 1u == (tg + 1u) * nx) xb_add(&bar[XB_TOPGEN], 1u);
            else XB_SPIN(xb_ld(&bar[XB_TOPGEN]) == tg, bar);
            __builtin_amdgcn_fence(__ATOMIC_ACQUIRE, "agent");
            xb_add(&bar[XB_XGEN(b.x)], 1u);
            asm volatile("s_waitcnt vmcnt(0)" ::: "memory");
        } else {
            XB_SPIN(xb_ld(&bar[XB_XGEN(b.x)]) == gen, bar);
            __builtin_amdgcn_fence(__ATOMIC_ACQUIRE, "agent");
            asm volatile("s_waitcnt vmcnt(0)" ::: "memory");
        }
    }
    __syncthreads();
}
constexpr int NWAVES = 8, NTHR = 512;
constexpr int D = 1024, MP = 16384, NSB = 16, SSEQ = 16, MS = NSB * SSEQ, M = MP + MS;
constexpr int NIN = 3076, NPROJ = 3072, DFF = 2816, NGU = 2 * DFF;
constexpr int NCHP = 256, NCH = NCHP + NSB;
constexpr int PC_Q = 0, PC_K = 256, PC_V = 512, PC_Z = 768, PC_X = 1024, PC_B = 1280, PC_C = 1536, PC_CQ = 1792, PC_CF = 2048, PC_CI = 2304, PC_CG = 2560, PC_DX = 2816;
constexpr float EPS = 1e-6f;
enum { I_XP = 0, I_XS, I_CK, I_CV, I_SCONV, I_SSSM, I_SHGRN, I_SPOOL, I_N1, I_WIN, I_AREL, I_CW, I_CB, I_DTB, I_ALOG, I_BD, I_BNRM, I_LB, I_CNRM, I_PW, I_PS, I_WOUT, I_N2, I_WGU, I_WDN, I_NF, N_IN };
constexpr size_t O_YP = 0, O_YS = O_YP + (size_t)MP * D, O_PK = O_YS + (size_t)MS * D, O_PV = O_PK + 2 * 512 * 256, O_PCONV = O_PV + 2 * 512 * 256, O_PSSM = O_PCONV + 2 * 3 * 768,
                 O_PHGRN = O_PSSM + 2 * 4 * 64 * 128, O_PPOOL = O_PHGRN + 2 * 4 * 64 * 64, O_SK = O_PPOOL + 2 * 15 * 256, O_SV = O_SK + (size_t)2 * 16 * 512 * 256,
                 O_SCONV = O_SV + (size_t)2 * 16 * 512 * 256, O_SSSM = O_SCONV + 2 * 16 * 3 * 768, O_SHGRN = O_SSSM + 2 * 16 * 4 * 64 * 128, O_SPOOL = O_SHGRN + 2 * 16 * 4 * 64 * 64,
                 O_END = O_SPOOL + 2 * 16 * 15 * 256;
constexpr size_t MiB = 1u << 20;
constexpr size_t WS_CTL = 0, CTL_ZERO_BYTES = 64 * 1024;
constexpr size_t WL_IN = 0, WL_OUT = 6 * MiB, WL_GU = 8 * MiB, WL_DN = 19 * MiB, WL_STRIDE = 24 * MiB + MiB / 2;
constexpr size_t WS_W = 1 * MiB;
constexpr size_t WS_XN = 50 * MiB;
constexpr size_t WS_PROJ = 83 * MiB;
constexpr size_t WS_STB = 181 * MiB;
constexpr size_t WS_XT = 198 * MiB;
constexpr size_t WS_HALO = 207 * MiB;
constexpr size_t WS_RH = 208 * MiB + MiB / 2;
constexpr size_t WS_STC = 215 * MiB;
constexpr size_t WS_VT = 223 * MiB + MiB / 2;
constexpr size_t WS_DT = 232 * MiB;
constexpr size_t WS_DECB = 233 * MiB;
constexpr size_t WS_DECC = 233 * MiB + 64 * 1024;
constexpr size_t WS_ACS = 233 * MiB + 384 * 1024, WS_DTV = 233 * MiB + 704 * 1024;
constexpr size_t WS_VTA = 234 * MiB;
constexpr size_t WS_END = 243 * MiB;
static_assert(WS_VTA + (size_t)256 * M * 2 <= WS_END, "ws map 2");
constexpr int CW_QUEUE = 512;
static_assert(WS_XN + (size_t)M * D * 2 <= WS_PROJ && WS_PROJ + (size_t)M * NPROJ * 2 <= WS_STB && WS_STB + (size_t)NCH * 4 * 64 * 128 * 2 <= WS_XT && WS_XT + (size_t)NCH * 256 * 64 * 2 <= WS_HALO && WS_HALO + (size_t)256 * 3 * 768 * 2 <= WS_STC && WS_RH + (size_t)NCH * 1280 * 4 <= WS_STC && WS_STC + (size_t)NCH * 4 * 64 * 64 * 2 <= WS_VT && WS_VT + (size_t)NCH * 256 * 64 * 2 <= WS_DT, "ws map");
static_assert(WL_DN + (size_t)D * DFF * 2 <= WL_STRIDE && WS_W + 2 * WL_STRIDE <= WS_XN, "weight map");
constexpr size_t WS_WPT = 128 * 1024;
constexpr size_t WS_RS = 256 * 1024;
constexpr size_t WS_XN2 = 181 * MiB;
static_assert(WS_XN2 + (size_t)M * D * 2 <= 232 * MiB && WS_RS + 2 * (size_t)M * 4 <= MiB, "ws map 3");
constexpr int CW_BAR = 1024;
constexpr int LDS_BYTES = 163840;
constexpr int MISC_OFF = LDS_BYTES - 256;
constexpr int RING_OFF = 0;
typedef LAS float lf32;
typedef float f32x2 __attribute__((ext_vector_type(2)));
struct Args { const float* in[N_IN]; float* out; unsigned char* ws; };
struct Frame {
    LAS unsigned char* lds;
    float* out; unsigned char* ws;
};
__device__ __forceinline__ float* inp(int i) { asm volatile("" : "+s"(i)); return ((float* const __attribute__((address_space(4)))*)__builtin_amdgcn_kernarg_segment_ptr())[i]; }
__device__ __forceinline__ unsigned char* opq(unsigned char* p) { asm volatile("" : "+s"(p)); return p; }
#define ITEM_IDS() int tid_ = threadIdx.x; asm volatile("" : "+v"(tid_)); const int wave_ = __builtin_amdgcn_readfirstlane(tid_ >> 6); const int lane_ = tid_ & 63; (void)lane_; (void)wave_
#define F_XN ((bf16*)opq(F.ws + WS_XN))
#define F_PROJ ((bf16*)opq(F.ws + WS_PROJ))
#define F_ACT ((bf16*)opq(F.ws + WS_PROJ))
#define F_STB ((bf16*)opq(F.ws + WS_STB))
#define F_XT ((bf16*)opq(F.ws + WS_XT))
#define F_HALO ((bf16*)opq(F.ws + WS_HALO))
#define F_ACS ((float*)opq(F.ws + WS_ACS))
#define F_DTV ((float*)opq(F.ws + WS_DTV))
#define F_STC ((bf16*)opq(F.ws + WS_STC))
#define F_VT ((bf16*)opq(F.ws + WS_VT))
#define F_RH ((float*)opq(F.ws + WS_RH))
#define F_VTA ((bf16*)opq(F.ws + WS_VTA))
#define F_WPT ((bf16*)opq(F.ws + WS_WPT))
#define F_RS ((float*)opq(F.ws + WS_RS))
#define F_XN2 ((bf16*)opq(F.ws + WS_XN2))
#define F_DT ((float*)opq(F.ws + WS_DT))
#define F_DECB ((float*)opq(F.ws + WS_DECB))
#define F_DECC ((float*)opq(F.ws + WS_DECC))
#define F_X    (F.out)
__device__ __forceinline__ float bf_lo(unsigned w) { return __builtin_bit_cast(float, w << 16); }
__device__ __forceinline__ float bf_hi(unsigned w) { return __builtin_bit_cast(float, w & 0xffff0000u); }
__device__ __forceinline__ float bf1(bf16 b) { return __builtin_bit_cast(float, (unsigned)b << 16); }
__device__ __forceinline__ void unpack8(const v4u w, float (&v)[8]) { v[0] = bf_lo(w.x); v[1] = bf_hi(w.x); v[2] = bf_lo(w.y); v[3] = bf_hi(w.y); v[4] = bf_lo(w.z); v[5] = bf_hi(w.z); v[6] = bf_lo(w.w); v[7] = bf_hi(w.w); }
__device__ __forceinline__ v4u pack8(const float (&v)[8]) { v4u o; o.x = pk2(v[0], v[1]); o.y = pk2(v[2], v[3]); o.z = pk2(v[4], v[5]); o.w = pk2(v[6], v[7]); return o; }
__device__ __forceinline__ float shx(int lane, float v, int o) { return __builtin_bit_cast(float, __builtin_amdgcn_ds_bpermute((lane ^ o) << 2, __builtin_bit_cast(int, v))); }
__device__ __forceinline__ float shu(int lane, float v, int o) { return __builtin_bit_cast(float, __builtin_amdgcn_ds_bpermute((lane - o) << 2, __builtin_bit_cast(int, v))); }
__device__ __forceinline__ float shi(float v, int idx) { return __builtin_bit_cast(float, __builtin_amdgcn_ds_bpermute(idx << 2, __builtin_bit_cast(int, v))); }
__device__ __forceinline__ float wave_sum_l(int lane, float v) {
#pragma unroll
    for (int o = 1; o < 64; o <<= 1) v += shx(lane, v, o);
    return v;
}
__device__ __forceinline__ float sum16_l(int lane, float v) {
#pragma unroll
    for (int o = 1; o < 16; o <<= 1) v += shx(lane, v, o);
    return v;
}
__device__ __forceinline__ float max16_l(int lane, float v) {
#pragma unroll
    for (int o = 1; o < 16; o <<= 1) v = fmaxf(v, shx(lane, v, o));
    return v;
}
__device__ __forceinline__ float rcp_f(float x) { return __builtin_amdgcn_rcpf(x); }
__device__ __forceinline__ float rsq_f(float x) { return __builtin_amdgcn_rsqf(x); }
__device__ __forceinline__ float sigmoid_f(float x) { return rcp_f(1.0f + __expf(-x)); }
__device__ __forceinline__ float silu_g(float x) { return x * rcp_f(1.0f + __expf(-x)); }
__device__ __forceinline__ float softplus_f(float x) { const float e = __expf(x); return x > 20.f ? x : (e < 0.01f ? e * (1.0f - e * (0.5f - e * (1.0f / 3.0f))) : __logf(1.0f + e)); }
__device__ __forceinline__ f32x4 mfma4(float a, float b, f32x4 c) { return __builtin_amdgcn_mfma_f32_16x16x4f32(a, b, c, 0, 0, 0); }

struct Chunk { int ci, row0, nrows, b; };
__device__ __forceinline__ Chunk chunk_of(int ci) { Chunk c; c.ci = ci; if (ci < NCHP) { c.row0 = 64 * ci; c.nrows = 64; c.b = -1; } else { c.b = ci - NCHP; c.row0 = MP + SSEQ * c.b; c.nrows = SSEQ; } return c; }

__device__ __forceinline__ void tr_item64(const float* W, int ldw, int K, bf16* WT, int k0, int nd0, int ns0, float scale, lf32* scr, int lane) {
    f32x4 wv_[16];
    const int rq = lane >> 4, c4 = (lane & 15) * 4;
#pragma unroll
    for (int i = 0; i < 16; ++i) wv_[i] = *(const f32x4*)(W + (size_t)(k0 + 4 * i + rq) * ldw + ns0 + c4);
#pragma unroll
    for (int i = 0; i < 16; ++i) { lf32* d = scr + (4 * i + rq) * 65 + c4; d[0] = wv_[i].x; d[1] = wv_[i].y; d[2] = wv_[i].z; d[3] = wv_[i].w; }
    LDS_WAIT(); asm volatile("" ::: "memory");
    const int c = lane & 7;
#pragma unroll
    for (int j = 0; j < 8; ++j) { const int n = (lane >> 3) + 8 * j; const lf32* s = scr + (8 * c) * 65 + n;
        v4u o; o.x = pk2(s[0 * 65] * scale, s[1 * 65] * scale); o.y = pk2(s[2 * 65] * scale, s[3 * 65] * scale); o.z = pk2(s[4 * 65] * scale, s[5 * 65] * scale); o.w = pk2(s[6 * 65] * scale, s[7 * 65] * scale);
        *(GAS v4u*)(WT + (size_t)(nd0 + n) * K + k0 + 8 * c) = o; }
    LDS_WAIT(); asm volatile("" ::: "memory");
}
__device__ __forceinline__ void tr_item(const float* W, int ldw, int K, bf16* WT, int k0, int nd0, int ns0, float scale, lf32* scr, int lane) {
    float wv_[32];
#pragma unroll
    for (int i = 0; i < 32; ++i) wv_[i] = W[(size_t)(k0 + 2 * i + (lane >> 5)) * ldw + ns0 + (lane & 31)];
#pragma unroll
    for (int i = 0; i < 32; ++i) scr[(2 * i + (lane >> 5)) * 33 + (lane & 31)] = wv_[i];
    LDS_WAIT(); asm volatile("" ::: "memory");
    const int c = lane & 7;
#pragma unroll
    for (int j = 0; j < 4; ++j) { const int n = (lane >> 3) + 8 * j; const lf32* s = scr + (8 * c) * 33 + n;
        v4u o; o.x = pk2(s[0 * 33] * scale, s[1 * 33] * scale); o.y = pk2(s[2 * 33] * scale, s[3 * 33] * scale); o.z = pk2(s[4 * 33] * scale, s[5 * 33] * scale); o.w = pk2(s[6 * 33] * scale, s[7 * 33] * scale);
        *(GAS v4u*)(WT + (size_t)(nd0 + n) * K + k0 + 8 * c) = o; }
    LDS_WAIT(); asm volatile("" ::: "memory");
}
__device__ __forceinline__ void p0_weights(Frame& F, int l, int gw, int NGW, bool pool) {
    ITEM_IDS();
    lf32* scr = (lf32*)(F.lds + wave_ * 16896);
    constexpr int I_INA = 16 * 28, I_INB = 16 * 40, I_OUT = 16 * 16, I_GU = 16 * 88, I_DN = 44 * 16, I_L = I_INA + I_INB + I_OUT + I_GU + I_DN;
    unsigned char* wl = F.ws + WS_W + (size_t)l * WL_STRIDE;
    for (int it = gw; it < I_L; it += NGW) {
        int r = it;
        if (r < I_INA) { const int kb = r / 28, nb = r % 28, nd0 = 64 * nb; tr_item64(inp(I_WIN) + (size_t)l * D * NIN, NIN, D, (bf16*)(wl + WL_IN), 64 * kb, nd0, nd0, nd0 < 256 ? 0.125f : 1.0f, scr, lane_); continue; } r -= I_INA;
        if (r < I_INB) { const int kb = r / 40, nb = r % 40, nd0 = 1792 + 32 * nb; tr_item(inp(I_WIN) + (size_t)l * D * NIN, NIN, D, (bf16*)(wl + WL_IN), 64 * kb, nd0, nd0 + 4, 1.0f, scr, lane_); continue; } r -= I_INB;
        if (r < I_OUT) { const int kb = r / 16, nb = r % 16; tr_item64(inp(I_WOUT) + (size_t)l * D * D, D, D, (bf16*)(wl + WL_OUT), 64 * kb, 64 * nb, 64 * nb, 1.0f, scr, lane_); continue; } r -= I_OUT;
        if (r < I_GU) { const int kb = r / 88, nb = r % 88, nd0 = 64 * nb, pn = nd0 >> 8, bj = (nd0 >> 7) & 1, c = nd0 & 127; tr_item64(inp(I_WGU) + (size_t)l * D * NGU, NGU, D, (bf16*)(wl + WL_GU), 64 * kb, nd0, bj * DFF + 128 * pn + c, 1.0f, scr, lane_); continue; } r -= I_GU;
        { const int kb = r / 16, nb = r % 16; tr_item64(inp(I_WDN) + (size_t)l * DFF * D, D, DFF, (bf16*)(wl + WL_DN), 64 * kb, 64 * nb, 64 * nb, 1.0f, scr, lane_); }
    }
    if (pool) { const float* pw = inp(I_PW); for (int i = ((int)blockIdx.x) * NTHR + tid_; i < 2 * 4 * 64 * 64; i += ((int)gridDim.x) * NTHR) { const int c = i & 63, d = (i >> 6) & 63, lg = i >> 12; F_WPT[i] = (bf16)f2bf(pw[(size_t)(lg * 64 + c) * 64 + d]); } }
}
template <bool WITH_DT, bool FINAL>
__device__ __forceinline__ void norm_rows(Frame& F, const float* xlo, const float* xhi, const float* w, const float* wdt  , const bf16* xb = nullptr  , int gw_ = -1, int ngw_ = 0  , bf16* xcopy = nullptr  ) {
    ITEM_IDS();
    lf32* wl = (lf32*)(F.lds + (gw_ >= 0 ? 135168 : 0));
    if (WITH_DT && gw_ < 0) { for (int k = tid_; k < D; k += NTHR) { const f32x4 v = *(const f32x4*)(wdt + (size_t)k * NIN + 1792); *(LAS f32x4*)(wl + 4 * k) = v; } __syncthreads(); }
    const int gw = gw_ >= 0 ? gw_ : ((int)blockIdx.x) * NWAVES + wave_, NGW = gw_ >= 0 ? ngw_ : ((int)gridDim.x) * NWAVES;
    f32x4 wv[4];
#pragma unroll
    for (int j = 0; j < 4; ++j) wv[j] = *(const f32x4*)(w + 256 * j + 4 * lane_);
    for (int m0 = gw; m0 < M; m0 += 4 * NGW) {
        f32x4 v[4][4];
#pragma unroll
        for (int q = 0; q < 4; ++q) { const int m = m0 + q * NGW; if (m < M) {
            if (xb) {
#pragma unroll
                for (int j = 0; j < 4; ++j) { const unsigned long long t = *(const unsigned long long*)(xb + (size_t)m * D + 256 * j + 4 * lane_); v[q][j] = (f32x4){bf_lo((unsigned)t), bf_hi((unsigned)t), bf_lo((unsigned)(t >> 32)), bf_hi((unsigned)(t >> 32))}; }
            } else { const float* xr = (m < MP ? xlo : xhi) + (size_t)m * D;
#pragma unroll
                for (int j = 0; j < 4; ++j) v[q][j] = *(const f32x4*)(xr + 256 * j + 4 * lane_); } } }
#pragma unroll
        for (int q = 0; q < 4; ++q) { const int m = m0 + q * NGW; if (m < M) {
            float s = 0.f;
            if (xcopy) { GAS unsigned long long* c8 = (GAS unsigned long long*)(xcopy + (size_t)m * D) + lane_;
#pragma unroll
                for (int j = 0; j < 4; ++j) c8[64 * j] = (unsigned long long)pk2(v[q][j].x, v[q][j].y) | ((unsigned long long)pk2(v[q][j].z, v[q][j].w) << 32); }
#pragma unroll
            for (int j = 0; j < 4; ++j) s += (v[q][j].x * v[q][j].x + v[q][j].y * v[q][j].y) + (v[q][j].z * v[q][j].z + v[q][j].w * v[q][j].w);
            const float rstd = rsq_f(wave_sum_l(lane_, s) * (1.0f / D) + EPS);
#pragma unroll
            for (int j = 0; j < 4; ++j) v[q][j] = v[q][j] * rstd * wv[j];
            if (FINAL) {
#pragma unroll
                for (int j = 0; j < 4; ++j) *(f32x4*)(F.out + (size_t)m * D + 256 * j + 4 * lane_) = v[q][j];
            } else {
                GAS unsigned long long* o8 = (GAS unsigned long long*)(F_XN + (size_t)m * D) + lane_;
#pragma unroll
                for (int j = 0; j < 4; ++j) o8[64 * j] = (unsigned long long)pk2(v[q][j].x, v[q][j].y) | ((unsigned long long)pk2(v[q][j].z, v[q][j].w) << 32);
            }
            if (WITH_DT) {
                f32x4 a = {0.f, 0.f, 0.f, 0.f};
#pragma unroll
                for (int j = 0; j < 4; ++j) { const LAS f32x4* wp = (const LAS f32x4*)(wl + 4 * (256 * j + 4 * lane_));
                    a += wp[0] * v[q][j].x; a += wp[1] * v[q][j].y; a += wp[2] * v[q][j].z; a += wp[3] * v[q][j].w; }
                a.x = wave_sum_l(lane_, a.x); a.y = wave_sum_l(lane_, a.y); a.z = wave_sum_l(lane_, a.z); a.w = wave_sum_l(lane_, a.w);
                if (lane_ == 0) *(f32x4*)(F_DT + (size_t)m * 4) = a;
            } } }
    }
    if (WITH_DT && gw_ < 0) __syncthreads();
}
constexpr int PL_RAW = 0, PL_PL = 79 * 256 * 4, PL_END = PL_PL + 64 * 264 * 2;
static_assert(PL_END <= MISC_OFF, "pool LDS map");
__device__ __forceinline__ void pool_item(Frame& F, int layer, int ci) {
    ITEM_IDS();
    const Chunk c = chunk_of(ci);
    lf32* raw = (lf32*)(F.lds + PL_RAW);
    LAS bf16* Pl = (LAS bf16*)(F.lds + PL_PL);
    const float* spool = inp(I_SPOOL) + (size_t)(layer * NSB + (c.b < 0 ? 0 : c.b)) * 15 * 256;
    v4u pw[5]; f32x4 pf[5][2];
#pragma unroll
    for (int q = 0; q < 5; ++q) { const int it = tid_ + q * NTHR; pw[q] = (v4u){0u, 0u, 0u, 0u}; pf[q][0] = (f32x4){0.f, 0.f, 0.f, 0.f}; pf[q][1] = pf[q][0];
        if (it < 79 * 32) { const int rr = it >> 5, cg = it & 31, r = rr - 15;
            if (r < c.nrows) { if (r >= 0 || (c.b < 0 && c.row0 + r >= 0)) pw[q] = *(const v4u*)(F_PROJ + (size_t)(c.row0 + r) * NPROJ + PC_DX + 8 * cg);
                               else if (c.b >= 0) { const float* s = spool + (size_t)(15 + r) * 256 + 8 * cg; pf[q][0] = *(const f32x4*)s; pf[q][1] = *(const f32x4*)(s + 4); } } } }
#pragma unroll
    for (int q = 0; q < 5; ++q) { const int it = tid_ + q * NTHR;
        if (it < 79 * 32) { const int rr = it >> 5, cg = it & 31, r = rr - 15; float v[8];
            if (c.b >= 0 && r < 0) { v[0] = pf[q][0].x; v[1] = pf[q][0].y; v[2] = pf[q][0].z; v[3] = pf[q][0].w; v[4] = pf[q][1].x; v[5] = pf[q][1].y; v[6] = pf[q][1].z; v[7] = pf[q][1].w; } else unpack8(pw[q], v);
            *(LAS f32x4*)(raw + rr * 256 + 8 * cg) = (f32x4){v[0], v[1], v[2], v[3]}; *(LAS f32x4*)(raw + rr * 256 + 8 * cg + 4) = (f32x4){v[4], v[5], v[6], v[7]}; } }
    __syncthreads();
    { const int ch = tid_ & 255, half = tid_ >> 8, win = 2 << (ch >> 6); const float inv = 1.0f / (float)win;
      const lf32* rp = raw + (32 * half + 15) * 256 + ch;
      float s = 0.f; for (int q = 1; q < win; ++q) s += rp[-q * 256];
#pragma unroll 8
      for (int r = 0; r < 32; ++r) { const float x = rp[r * 256], xo = rp[(r - win + 1) * 256]; s += x; Pl[(32 * half + r) * 264 + ch] = (bf16)f2bf(s * inv - x); s -= xo; } }
    __syncthreads();
    const int tb = wave_ >> 1, g0 = 2 * (wave_ & 1), kq = lane_ >> 4, fr = lane_ & 15;
    const bf16* wt = F_WPT + (size_t)layer * 4 * 64 * 64; const float* sc = inp(I_PS) + (size_t)layer * 256;
#pragma unroll
    for (int gg = 0; gg < 2; ++gg) {
        const int g = g0 + gg;
        bf16x8 bw[4][2];
#pragma unroll
        for (int t = 0; t < 4; ++t)
#pragma unroll
            for (int ks = 0; ks < 2; ++ks) bw[t][ks] = *(const bf16x8*)(wt + (size_t)(g * 64 + t * 16 + fr) * 64 + 32 * ks + 8 * kq);
        bf16x8 a[2];
#pragma unroll
        for (int ks = 0; ks < 2; ++ks) a[ks] = *(const LAS bf16x8*)(Pl + (tb * 16 + fr) * 264 + g * 64 + 32 * ks + 8 * kq);
#pragma unroll
        for (int t = 0; t < 4; ++t) { f32x4 acc = {0.f, 0.f, 0.f, 0.f};
#pragma unroll
            for (int ks = 0; ks < 2; ++ks) acc = __builtin_amdgcn_mfma_f32_16x16x32_bf16(a[ks], bw[t][ks], acc, 0, 0, 0);
            const float s = sc[g * 64 + t * 16 + fr];
#pragma unroll
            for (int r = 0; r < 4; ++r) { const int row = tb * 16 + 4 * kq + r; if (row < c.nrows) F_XN[(size_t)(c.row0 + row) * D + 768 + g * 64 + t * 16 + fr] = (bf16)f2bf(acc[r] * s); } }
    }
    __syncthreads();
}

__device__ __forceinline__ void copy_cache(Frame& F, int layer, int b0, int nb) {
    ITEM_IDS();
    const int gt = b0 * NTHR + tid_, GT = nb * NTHR;
    float* out = F.out; const float* ckp = inp(I_CK); const float* cvp = inp(I_CV);
    for (int base = gt; base < 32 * 31744; base += 8 * GT) {
        f32x4 v[8];
#pragma unroll
        for (int q = 0; q < 8; ++q) { const int i = base + q * GT; if (i < 32 * 31744) { const int wb = i / 31744, e = i - wb * 31744; const int which = wb >> 4, b = wb & 15;
            v[q] = *(const f32x4*)((which ? cvp : ckp) + ((size_t)(layer * NSB + b) * 512 + 16) * 256 + 4 * (size_t)e); } }
#pragma unroll
        for (int q = 0; q < 8; ++q) { const int i = base + q * GT; if (i < 32 * 31744) { const int wb = i / 31744, e = i - wb * 31744; const int which = wb >> 4, b = wb & 15;
            *(f32x4*)(out + (which ? O_SV : O_SK) + (size_t)(layer * NSB + b) * 512 * 256 + 4 * (size_t)e) = v[q]; } }
    }
}
__device__ __forceinline__ void copy_small(Frame& F, int layer, int b0, int nb) {
    ITEM_IDS();
    const int gt = b0 * NTHR + tid_, GT = nb * NTHR;
    float* out = F.out;
    constexpr int T_P = 2 * 512 * 32, T_S = 2 * 16 * 16 * 32, T_D = 17 * 15 * 32, T_ALL = T_P + T_S + T_D;
    for (int base = gt; base < T_ALL; base += 4 * GT) {
        v4u w[4];
#pragma unroll
        for (int q = 0; q < 4; ++q) { int t = base + q * GT; if (t < T_ALL) { size_t src;
            if (t < T_P) { const int which = t >> 14, j = (t >> 5) & 511, cg = t & 31; src = (size_t)(MP - 512 + j) * NPROJ + (which ? PC_V : PC_K) + 8 * cg; }
            else if (t < T_P + T_S) { t -= T_P; const int which = t >> 13, b = (t >> 9) & 15, j = (t >> 5) & 15, cg = t & 31; src = (size_t)(MP + 16 * b + j) * NPROJ + (which ? PC_V : PC_K) + 8 * cg; }
            else { t -= T_P + T_S; const int b = t / 480, rr = (t / 32) % 15, cg = t & 31; src = (size_t)(b == 0 ? MP - 15 + rr : MP + 16 * (b - 1) + 1 + rr) * NPROJ + PC_DX + 8 * cg; }
            w[q] = *(const v4u*)(F_PROJ + src); } }
#pragma unroll
        for (int q = 0; q < 4; ++q) { int t = base + q * GT; if (t < T_ALL) { size_t dst;
            if (t < T_P) { const int which = t >> 14, j = (t >> 5) & 511, cg = t & 31; dst = (which ? O_PV : O_PK) + (size_t)layer * 512 * 256 + j * 256 + 8 * cg; }
            else if (t < T_P + T_S) { t -= T_P; const int which = t >> 13, b = (t >> 9) & 15, j = (t >> 5) & 15, cg = t & 31; dst = (which ? O_SV : O_SK) + ((size_t)(layer * NSB + b) * 512 + 496 + j) * 256 + 8 * cg; }
            else { t -= T_P + T_S; const int b = t / 480, rr = (t / 32) % 15, cg = t & 31; dst = (b == 0 ? O_PPOOL + (size_t)layer * 3840 : O_SPOOL + (size_t)(layer * NSB + b - 1) * 3840) + rr * 256 + 8 * cg; }
            float v[8]; unpack8(w[q], v); *(f32x4*)(out + dst) = (f32x4){v[0], v[1], v[2], v[3]}; *(f32x4*)(out + dst + 4) = (f32x4){v[4], v[5], v[6], v[7]}; } }
    }
}
constexpr int KS_LD = 72, PS_LD = 584;
constexpr int AT_KS = 0, AT_VT = 576 * KS_LD * 2, AT_ST = AT_VT + 64 * PS_LD * 2, AT_BIAS = AT_ST + 1024;
static_assert(AT_BIAS + 4 * 260 * 4 <= MISC_OFF, "attention LDS map");
__device__ __forceinline__ void attn_bias_load(Frame& F, int layer) { const float* arel = inp(I_AREL) + (size_t)layer * 257 * 4; lf32* b = (lf32*)(F.lds + AT_BIAS); ITEM_IDS(); for (int i = tid_; i < 257 * 4; i += NTHR) b[260 * (i & 3) + (i >> 2)] = arel[i]; }
__device__ __forceinline__ void attn_item(Frame& F, int layer, int ci, int h) {
    ITEM_IDS();
    const Chunk c = chunk_of(ci);
    LAS bf16* Ks = (LAS bf16*)(F.lds + AT_KS); LAS bf16* Ps = Ks; LAS bf16* Vt = (LAS bf16*)(F.lds + AT_VT);
    lf32* mx = (lf32*)(F.lds + AT_ST); lf32* sm = mx + 128; lf32* bias = (lf32*)(F.lds + AT_BIAS) + 260 * h;
    const int jlo = (c.b < 0) ? (ci < 8 ? 64 * (8 - ci) : 0) : 0;
    const int jval = (c.b < 0) ? 576 : 528;
    const float* ckp = inp(I_CK); const float* cvp = inp(I_CV);
    bf16x8 qa0 = {0, 0, 0, 0, 0, 0, 0, 0}, qa1 = qa0;
    if (c.b < 0 || (wave_ >> 1) == 0) { const bf16* qp = F_PROJ + (size_t)(c.row0 + (wave_ >> 1) * 16 + (lane_ & 15)) * NPROJ + PC_Q + 64 * h + 8 * (lane_ >> 4); qa0 = *(const bf16x8*)qp; qa1 = *(const bf16x8*)(qp + 32); }
    if (c.b < 0) {
        const bf16* kg = F_PROJ + (long)(c.row0 - 512) * NPROJ + PC_K + 64 * h;
        const bf16* vg = F_VTA + (long)(64 * h) * M + (long)(c.row0 - 512);
        const int npc = (576 - jlo) >> 3, nk = (576 - jlo) * 8, nv = 64 * npc;
        v4u kr[9], vr[9];
#pragma unroll
        for (int q = 0; q < 9; ++q) { const int it = tid_ + q * NTHR;
            if (it < nk) kr[q] = *(const v4u*)(kg + (long)(jlo + (it >> 3)) * NPROJ + 8 * (it & 7));
            if (it < nv) { const int d = it / npc, pc = it - d * npc; vr[q] = *(const v4u*)(vg + (long)d * M + jlo + 8 * pc); } }
#pragma unroll
        for (int q = 0; q < 9; ++q) { const int it = tid_ + q * NTHR;
            if (it < nk) *(LAS v4u*)(Ks + (jlo + (it >> 3)) * KS_LD + 8 * (it & 7)) = kr[q];
            if (it < nv) { const int d = it / npc, pc = it - d * npc; *(LAS v4u*)(Vt + d * PS_LD + jlo + 8 * pc) = vr[q]; } }
    } else {
    for (int it = tid_; it < (576 - jlo) * 8; it += NTHR) {
        const int j = jlo + (it >> 3), dg = it & 7;
        v4u kw, vw;
        if (j < 512) { const size_t o = (((size_t)(layer * NSB + c.b) * 512 + j) * 4 + h) * 64 + 8 * dg; const float* kp = ckp + o; const float* vp = cvp + o;
            const f32x4 k0 = *(const f32x4*)kp, k1 = *(const f32x4*)(kp + 4), v0 = *(const f32x4*)vp, v1 = *(const f32x4*)(vp + 4);
            kw.x = pk2(k0.x, k0.y); kw.y = pk2(k0.z, k0.w); kw.z = pk2(k1.x, k1.y); kw.w = pk2(k1.z, k1.w); vw.x = pk2(v0.x, v0.y); vw.y = pk2(v0.z, v0.w); vw.z = pk2(v1.x, v1.y); vw.w = pk2(v1.z, v1.w); }
        else if (j < 528) { const size_t row = (size_t)(c.row0 + j - 512); kw = *(const v4u*)(F_PROJ + row * NPROJ + PC_K + 64 * h + 8 * dg); vw = *(const v4u*)(F_PROJ + row * NPROJ + PC_V + 64 * h + 8 * dg); }
        else { kw = (v4u){0u, 0u, 0u, 0u}; vw = kw; }
        *(LAS v4u*)(Ks + j * KS_LD + 8 * dg) = kw;
        LAS bf16* vt = Vt + (8 * dg) * PS_LD + j;
        vt[0 * PS_LD] = (bf16)(vw.x & 0xffffu); vt[1 * PS_LD] = (bf16)(vw.x >> 16); vt[2 * PS_LD] = (bf16)(vw.y & 0xffffu); vt[3 * PS_LD] = (bf16)(vw.y >> 16);
        vt[4 * PS_LD] = (bf16)(vw.z & 0xffffu); vt[5 * PS_LD] = (bf16)(vw.z >> 16); vt[6 * PS_LD] = (bf16)(vw.w & 0xffffu); vt[7 * PS_LD] = (bf16)(vw.w >> 16);
    }
    }
    __syncthreads();
    const int qb = wave_ >> 1, kh = wave_ & 1, kq = lane_ >> 4, fr = lane_ & 15;
    const bool active = (c.b < 0) || (qb == 0);
    const int ntw = (576 - jlo) / 32;
    const int kbase = jlo + kh * ntw * 16;
    f32x4 s[18];
    float mloc = -3.0e38f;
    const int iq = qb * 16 + fr;
    if (active) {
#pragma unroll
        for (int t = 0; t < 18; ++t) {
            s[t] = (f32x4){0.f, 0.f, 0.f, 0.f};
            if (t < ntw) {
                const LAS bf16* kp = Ks + (kbase + t * 16 + fr) * KS_LD + 8 * kq;
                const bf16x8 kb0 = *(const LAS bf16x8*)kp, kb1 = *(const LAS bf16x8*)(kp + 32);
                s[t] = __builtin_amdgcn_mfma_f32_16x16x32_bf16(kb0, qa0, s[t], 0, 0, 0);
                s[t] = __builtin_amdgcn_mfma_f32_16x16x32_bf16(kb1, qa1, s[t], 0, 0, 0);
#pragma unroll
                for (int r = 0; r < 4; ++r) { const int j = kbase + t * 16 + 4 * kq + r; int rel = 512 + iq - j; rel = rel > 128 ? 128 : rel; float v = s[t][r] + bias[rel + 128]; if (j >= jval) v = -1.0e30f; s[t][r] = v; mloc = fmaxf(mloc, v); }
            }
        }
        mloc = fmaxf(mloc, shx(lane_, mloc, 16)); mloc = fmaxf(mloc, shx(lane_, mloc, 32));
        if (kq == 0) mx[iq * 2 + kh] = mloc;
    }
    __syncthreads();
    if (active) {
        mloc = fmaxf(mx[iq * 2], mx[iq * 2 + 1]);
        float lsum = 0.f;
#pragma unroll
        for (int t = 0; t < 18; ++t) if (t < ntw) {
            const float p0 = __expf(s[t][0] - mloc), p1 = __expf(s[t][1] - mloc), p2 = __expf(s[t][2] - mloc), p3 = __expf(s[t][3] - mloc);
            lsum += (p0 + p1) + (p2 + p3);
            *(LAS f32x2*)(Ps + iq * PS_LD + kbase + t * 16 + 4 * kq) = __builtin_bit_cast(f32x2, (unsigned long long)pk2(p0, p1) | ((unsigned long long)pk2(p2, p3) << 32));
        }
        lsum += shx(lane_, lsum, 16); lsum += shx(lane_, lsum, 32);
        if (kq == 0) sm[iq * 2 + kh] = lsum;
    }
    __syncthreads();
    if (active) {
        f32x4 o[2] = {(f32x4){0.f, 0.f, 0.f, 0.f}, (f32x4){0.f, 0.f, 0.f, 0.f}};
        const int nks = (576 - jlo) / 32;
#pragma unroll 2
        for (int ks = 0; ks < nks; ++ks) {
            const int j0 = jlo + 32 * ks + 8 * kq;
            const bf16x8 pa = *(const LAS bf16x8*)(Ps + iq * PS_LD + j0);
#pragma unroll
            for (int t = 0; t < 2; ++t) { const bf16x8 vb = *(const LAS bf16x8*)(Vt + (kh * 32 + t * 16 + fr) * PS_LD + j0); o[t] = __builtin_amdgcn_mfma_f32_16x16x32_bf16(vb, pa, o[t], 0, 0, 0); }
        }
        const float inv = rcp_f(sm[iq * 2] + sm[iq * 2 + 1]);
#pragma unroll
        for (int t = 0; t < 2; ++t) *(f32x2*)(F_XN + (size_t)(c.row0 + iq) * D + 64 * h + kh * 32 + t * 16 + 4 * kq) =
            __builtin_bit_cast(f32x2, (unsigned long long)pk2(o[t][0] * inv, o[t][1] * inv) | ((unsigned long long)pk2(o[t][2] * inv, o[t][3] * inv) << 32));
    }
    __syncthreads();
}
__device__ __forceinline__ void scan_phase(Frame& F, int layer) {
    ITEM_IDS();
    lf32* db = (lf32*)F.lds; lf32* dcl = db + NCHP * 4;
    for (int i = tid_; i < NCHP * 4; i += NTHR) db[i] = F_DECB[i];
    if (((int)blockIdx.x) >= 32 && ((int)blockIdx.x) < 48) { const int hh = (((int)blockIdx.x) - 32) >> 2; const float* dg = F_DECC + hh * 64;
        for (int i = tid_; i < NCHP * 16; i += NTHR) *(LAS f32x4*)(dcl + (i >> 4) * 64 + 4 * (i & 15)) = *(const f32x4*)(dg + (size_t)(i >> 4) * 256 + 4 * (i & 15)); }
    __syncthreads();
    constexpr int NSCAN = 48;
    if (((int)blockIdx.x) < NSCAN) {
        const int u = ((int)blockIdx.x) * NTHR + tid_;
        if (u < 16384) {
            unsigned* st = (unsigned*)F_STB + u; const int hb = u >> 12;
            float r0 = 0.f, r1 = 0.f;
            for (int c0 = 0; c0 < NCHP; c0 += 64) {
                unsigned sl[64];
#pragma unroll
                for (int i = 0; i < 64; ++i) sl[i] = st[(size_t)(c0 + i) * 16384];
#pragma unroll
                for (int i = 0; i < 64; ++i) { const float d0 = db[(c0 + i) * 4 + hb]; st[(size_t)(c0 + i) * 16384] = pk2(r0, r1); r0 = d0 * r0 + bf_lo(sl[i]); r1 = d0 * r1 + bf_hi(sl[i]); }
            }
            *(f32x2*)(F.out + O_PSSM + (size_t)layer * 32768 + 2 * u) = (f32x2){r0, r1};
        } else {
            const int u2 = u - 16384;
            unsigned* st = (unsigned*)F_STC + u2; const int hk = (u2 >> 11) * 64 + 2 * (u2 & 31);
            float r0 = 0.f, r1 = 0.f;
            for (int c0 = 0; c0 < NCHP; c0 += 64) {
                unsigned sl[64];
#pragma unroll
                for (int i = 0; i < 64; ++i) sl[i] = st[(size_t)(c0 + i) * 8192];
#pragma unroll
                for (int i = 0; i < 64; ++i) { const f32x2 dd = *(const LAS f32x2*)(dcl + (c0 + i) * 64 + 2 * (u2 & 31)); st[(size_t)(c0 + i) * 8192] = pk2(r0, r1); r0 = dd.x * r0 + bf_lo(sl[i]); r1 = dd.y * r1 + bf_hi(sl[i]); }
            }
            const int v = (u2 >> 5) & 63; float* o = F.out + O_PHGRN + (size_t)layer * 16384 + (size_t)hk * 64 + v; o[0] = r0; o[64] = r1;
        }
    }
    else {
        const int nb = ((int)gridDim.x) - NSCAN, b0 = ((int)blockIdx.x) - NSCAN;
        copy_small(F, layer, b0, nb);
        const float* sssm = inp(I_SSSM) + (size_t)layer * NSB * 32768; const float* shgrn = inp(I_SHGRN) + (size_t)layer * NSB * 16384;
        float* osb = F.out + O_SSSM + (size_t)layer * NSB * 32768; float* osc = F.out + O_SHGRN + (size_t)layer * NSB * 16384;
        for (int t = b0 * NTHR + tid_; t < NSB * 8192; t += nb * NTHR) {
            const int b = t >> 13, e = (t & 8191) * 4; const f32x4 s0 = *(const f32x4*)(sssm + (size_t)b * 32768 + e); const unsigned long long w = *(const unsigned long long*)(F_STB + (size_t)(NCHP + b) * 32768 + e);
            const float d = F_DECB[(NCHP + b) * 4 + (e >> 13)];
            *(f32x4*)(osb + (size_t)b * 32768 + e) = (f32x4){d * s0.x + bf_lo((unsigned)w), d * s0.y + bf_hi((unsigned)w), d * s0.z + bf_lo((unsigned)(w >> 32)), d * s0.w + bf_hi((unsigned)(w >> 32))}; }
        for (int t = b0 * NTHR + tid_; t < NSB * 4096; t += nb * NTHR) {
            const int b = t >> 12, e2 = (t & 4095) * 4, hk = e2 >> 6, v = e2 & 63; const f32x4 s0 = *(const f32x4*)(shgrn + (size_t)b * 16384 + e2);
            const bf16* sp = F_STC + (size_t)(NCHP + b) * 16384 + (size_t)((hk >> 6) * 64 + v) * 64 + (hk & 63); const float d = F_DECC[(size_t)(NCHP + b) * 256 + hk];
            *(f32x4*)(osc + (size_t)b * 16384 + e2) = (f32x4){d * s0.x + bf1(sp[0]), d * s0.y + bf1(sp[64]), d * s0.z + bf1(sp[128]), d * s0.w + bf1(sp[192])}; }
    }
}
constexpr int SP_XT = 0, SP_BT = 256 * 72 * 2, SP_ACS = 2 * 256 * 72 * 2, SP_DTV = SP_ACS + 1024, SP_SJ = SP_DTV + 1024, SP_END = SP_SJ + 1024;
static_assert(SP_END <= MISC_OFF, "ssd_prep LDS map");
__device__ __forceinline__ void ssd_prep_item(Frame& F, int layer, int ci) {
    ITEM_IDS();
    const Chunk c = chunk_of(ci);
    LAS bf16* XTl = (LAS bf16*)(F.lds + SP_XT); LAS bf16* BTl = (LAS bf16*)(F.lds + SP_BT);
    lf32* acs = (lf32*)(F.lds + SP_ACS); lf32* dtv = (lf32*)(F.lds + SP_DTV); lf32* sj = (lf32*)(F.lds + SP_SJ);
    const int cg = tid_ % 96, seg = tid_ / 96, col = 8 * cg;
    const bool act = seg < 4 && 16 * seg < c.nrows;
    bf16* prow = F_PROJ + (size_t)c.row0 * NPROJ + PC_X + col;
    v4u raw[19];
    if (act) {
#pragma unroll
        for (int q = 0; q < 19; ++q) { const int r = 16 * seg - 3 + q;
            if (r >= 0) raw[q] = *(const v4u*)(prow + (size_t)r * NPROJ);
            else if (c.b < 0) { if (ci > 0) raw[q] = *(const v4u*)(F_HALO + ((size_t)(ci - 1) * 3 + (3 + r)) * 768 + col); else raw[q] = (v4u){0u, 0u, 0u, 0u}; }
            else { const float* s = inp(I_SCONV) + ((size_t)(layer * NSB + c.b) * 3 + (3 + r)) * 768 + col; const f32x4 a = *(const f32x4*)s, b2 = *(const f32x4*)(s + 4);
                raw[q].x = pk2(a.x, a.y); raw[q].y = pk2(a.z, a.w); raw[q].z = pk2(b2.x, b2.y); raw[q].w = pk2(b2.z, b2.w); } }
    }
    if (wave_ == 6) { const int r = lane_; const float* dtb = inp(I_DTB) + layer * 4; const float* alg = inp(I_ALOG) + layer * 4;
        f32x4 raw4 = {0.f, 0.f, 0.f, 0.f}; if (r < c.nrows) raw4 = *(const f32x4*)(F_DT + (size_t)(c.row0 + r) * 4);
        f32x4 dt4, ac4;
#pragma unroll
        for (int h = 0; h < 4; ++h) { float dt = 0.f; if (r < c.nrows) dt = softplus_f(raw4[h] + dtb[h]); float v = -__expf(alg[h]) * dt;
#pragma unroll
            for (int o = 1; o < 64; o <<= 1) { const float t = shu(lane_, v, o); if (lane_ >= o) v += t; }
            const float last = shi(v, 63);
            dt4[h] = dt; ac4[h] = v; acs[r * 4 + h] = v; dtv[r * 4 + h] = dt; sj[h * 64 + r] = dt * __expf(last - v);
            if (r == 63) F_DECB[ci * 4 + h] = __expf(last); }
        if (r < c.nrows) { *(f32x4*)(F_DTV + (size_t)(c.row0 + r) * 4) = dt4; *(f32x4*)(F_ACS + (size_t)(c.row0 + r) * 4) = ac4; } }
    if (c.nrows < 64) { for (int i = tid_; i < 2 * 256 * 72 / 2; i += NTHR) ((LAS unsigned*)XTl)[i] = 0u; }
    asm volatile("s_waitcnt vmcnt(0)" ::: "memory");
    __syncthreads();
    if (act) {
        if (ci == NCHP - 1 && seg == 3) {
#pragma unroll
            for (int q = 0; q < 3; ++q) { float v[8]; unpack8(raw[16 + q], v); float* o = F.out + O_PCONV + (size_t)layer * 2304 + q * 768 + col;
                *(f32x4*)o = (f32x4){v[0], v[1], v[2], v[3]}; *(f32x4*)(o + 4) = (f32x4){v[4], v[5], v[6], v[7]}; } }
        if (c.b >= 0) {
#pragma unroll
            for (int q = 0; q < 3; ++q) { float v[8]; unpack8(raw[16 + q], v); float* o = F.out + O_SCONV + ((size_t)(layer * NSB + c.b) * 3 + q) * 768 + col;
                *(f32x4*)o = (f32x4){v[0], v[1], v[2], v[3]}; *(f32x4*)(o + 4) = (f32x4){v[4], v[5], v[6], v[7]}; } }
        const float* cw = inp(I_CW) + (size_t)layer * 4 * 768 + col; const float* cb = inp(I_CB) + (size_t)layer * 768 + col;
        LAS bf16* tl = (cg < 32) ? XTl + col * 72 : BTl + (col - 256) * 72;
#pragma unroll
        for (int hc = 0; hc < 2; ++hc) {
            float w0[4], w1[4], w2[4], w3[4], bb[4];
#pragma unroll
            for (int e = 0; e < 4; ++e) { bb[e] = cb[4 * hc + e]; w0[e] = cw[4 * hc + e]; w1[e] = cw[768 + 4 * hc + e]; w2[e] = cw[2 * 768 + 4 * hc + e]; w3[e] = cw[3 * 768 + 4 * hc + e]; }
#pragma unroll
            for (int i = 0; i < 16; i += 2) {
                float x[5][4];
#pragma unroll
                for (int q = 0; q < 5; ++q) { const unsigned ua = hc ? raw[i + q].z : raw[i + q].x, ub = hc ? raw[i + q].w : raw[i + q].y; x[q][0] = bf_lo(ua); x[q][1] = bf_hi(ua); x[q][2] = bf_lo(ub); x[q][3] = bf_hi(ub); }
                float ya[4], yb[4];
#pragma unroll
                for (int e = 0; e < 4; ++e) { ya[e] = silu_g(bb[e] + w0[e] * x[0][e] + w1[e] * x[1][e] + w2[e] * x[2][e] + w3[e] * x[3][e]); yb[e] = silu_g(bb[e] + w0[e] * x[1][e] + w1[e] * x[2][e] + w2[e] * x[3][e] + w3[e] * x[4][e]); }
                const int r = 16 * seg + i;
                *(unsigned long long*)(prow + (size_t)r * NPROJ + 4 * hc) = (unsigned long long)pk2(ya[0], ya[1]) | ((unsigned long long)pk2(ya[2], ya[3]) << 32);
                *(unsigned long long*)(prow + (size_t)(r + 1) * NPROJ + 4 * hc) = (unsigned long long)pk2(yb[0], yb[1]) | ((unsigned long long)pk2(yb[2], yb[3]) << 32);
                if (cg < 64) {
#pragma unroll
                    for (int e = 0; e < 4; ++e) *(LAS unsigned*)(tl + (4 * hc + e) * 72 + r) = pk2(ya[e], yb[e]); }
            }
        }
    }
    __syncthreads();
    { const int ch = tid_ >> 1, hf = tid_ & 1; bf16* dst = F_XT + ((size_t)ci * 256 + ch) * 64 + 32 * hf; const LAS bf16* src = XTl + ch * 72 + 32 * hf;
#pragma unroll
      for (int q = 0; q < 4; ++q) *(v4u*)(dst + 8 * q) = *(const LAS v4u*)(src + 8 * q); }
    const int kq = lane_ >> 4, fr = lane_ & 15, h = wave_ >> 1, g = h >> 1;
#pragma unroll
    for (int pi = 0; pi < 2; ++pi) {
        const int pb = 2 * (wave_ & 1) + pi;
        bf16x8 af[2];
#pragma unroll
        for (int ks = 0; ks < 2; ++ks) { float v[8]; unpack8(*(const LAS v4u*)(XTl + (h * 64 + pb * 16 + fr) * 72 + 32 * ks + 8 * kq), v);
#pragma unroll
            for (int e = 0; e < 8; ++e) v[e] *= sj[h * 64 + 32 * ks + 8 * kq + e];
            af[ks] = __builtin_bit_cast(bf16x8, pack8(v)); }
        bf16* dst = F_STB + ((size_t)(ci * 4 + h) * 64 + pb * 16 + 4 * kq) * 128 + fr;
#pragma unroll
        for (int nt = 0; nt < 8; ++nt) {
            f32x4 acc = {0.f, 0.f, 0.f, 0.f};
#pragma unroll
            for (int ks = 0; ks < 2; ++ks) { const bf16x8 bfr = *(const LAS bf16x8*)(BTl + (g * 128 + nt * 16 + fr) * 72 + 32 * ks + 8 * kq); acc = __builtin_amdgcn_mfma_f32_16x16x32_bf16(af[ks], bfr, acc, 0, 0, 0); }
#pragma unroll
            for (int r = 0; r < 4; ++r) dst[r * 128 + nt * 16] = (bf16)f2bf(acc[r]);
        }
    }
    __syncthreads();
}

__device__ __forceinline__ void ssd_out_witem(Frame& F, int layer, int ci, int ib, int wave_, int lane_) {
    const Chunk c = chunk_of(ci);
    const int kq = lane_ >> 4, fr = lane_ & 15;
    constexpr int WSTRIDE = 2560 + 16384; static_assert(8 * WSTRIDE <= MISC_OFF, "per-wave LDS");
    LAS bf16* scr = (LAS bf16*)(F.lds + wave_ * WSTRIDE);
    lf32* ysc = (lf32*)(F.lds + wave_ * WSTRIDE + 2560) + lane_;
    const bf16* P = F_PROJ + (size_t)c.row0 * NPROJ;
    const float* acsg = F_ACS + (size_t)c.row0 * 4; const float* dtg = F_DTV + (size_t)c.row0 * 4;
    const int nks = (ib + 2) >> 1;
    float sq[4] = {0.f, 0.f, 0.f, 0.f};
    const float* bdp = inp(I_BD) + layer * 4;
#pragma unroll
    for (int g = 0; g < 2; ++g) {
        bf16x8 cf[4];
#pragma unroll
        for (int ks = 0; ks < 4; ++ks) cf[ks] = *(const bf16x8*)(P + (size_t)(16 * ib + fr) * NPROJ + PC_C + 128 * g + 32 * ks + 8 * kq);
        f32x4 G[4];
#pragma unroll
        for (int jb = 0; jb < 4; ++jb) { G[jb] = (f32x4){0.f, 0.f, 0.f, 0.f};
            if (jb <= ib) {
#pragma unroll
                for (int ks = 0; ks < 4; ++ks) { const bf16x8 bfr = *(const bf16x8*)(P + (size_t)(16 * jb + fr) * NPROJ + PC_B + 128 * g + 32 * ks + 8 * kq); G[jb] = __builtin_amdgcn_mfma_f32_16x16x32_bf16(cf[ks], bfr, G[jb], 0, 0, 0); } } }
#pragma unroll
        for (int hh = 0; hh < 2; ++hh) {
            const int h = 2 * g + hh;
            float ai[4], ea[4];
#pragma unroll
            for (int r = 0; r < 4; ++r) { ai[r] = acsg[(16 * ib + 4 * kq + r) * 4 + h]; ea[r] = __expf(ai[r]); }
#pragma unroll
            for (int jb = 0; jb < 4; ++jb) { const int j = 16 * jb + fr; float aj = 0.f, dj = 0.f; if (jb <= ib) { aj = acsg[j * 4 + h]; dj = dtg[j * 4 + h]; }
#pragma unroll
                for (int r = 0; r < 4; ++r) { const int i = 16 * ib + 4 * kq + r; const float v = (jb <= ib && j <= i) ? G[jb][r] * __expf(ai[r] - aj) * dj : 0.f; scr[(4 * kq + r) * 72 + j] = (bf16)f2bf(v); } }
            asm volatile("s_waitcnt lgkmcnt(0)" ::: "memory");
            bf16x8 gm[2];
#pragma unroll
            for (int ks = 0; ks < 2; ++ks) gm[ks] = *(const LAS bf16x8*)(scr + fr * 72 + 32 * ks + 8 * kq);
            asm volatile("s_waitcnt lgkmcnt(0)" ::: "memory");
            const bf16* xt = F_XT + ((size_t)ci * 256 + h * 64) * 64;
            const bf16* sin_b = F_STB + (size_t)(ci * 4 + h) * 8192; const float* sin_f = inp(I_SSSM) + (size_t)((layer * NSB + (c.b < 0 ? 0 : c.b)) * 4 + h) * 8192;
#pragma unroll 2
            for (int pt = 0; pt < 4; ++pt) {
                f32x4 a1 = {0.f, 0.f, 0.f, 0.f}, a2 = {0.f, 0.f, 0.f, 0.f};
#pragma unroll
                for (int ks = 0; ks < 2; ++ks) if (ks < nks) { const bf16x8 bfr = *(const bf16x8*)(xt + (size_t)(pt * 16 + fr) * 64 + 32 * ks + 8 * kq); a1 = __builtin_amdgcn_mfma_f32_16x16x32_bf16(gm[ks], bfr, a1, 0, 0, 0); }
#pragma unroll
                for (int ks = 0; ks < 4; ++ks) { bf16x8 bfr;
                    if (c.b < 0) bfr = *(const bf16x8*)(sin_b + (size_t)(pt * 16 + fr) * 128 + 32 * ks + 8 * kq);
                    else { const float* s = sin_f + (size_t)(pt * 16 + fr) * 128 + 32 * ks + 8 * kq; const f32x4 u0 = *(const f32x4*)s, u1 = *(const f32x4*)(s + 4); v4u w; w.x = pk2(u0.x, u0.y); w.y = pk2(u0.z, u0.w); w.z = pk2(u1.x, u1.y); w.w = pk2(u1.z, u1.w); bfr = __builtin_bit_cast(bf16x8, w); }
                    a2 = __builtin_amdgcn_mfma_f32_16x16x32_bf16(cf[ks], bfr, a2, 0, 0, 0); }
                const float dh = bdp[h];
#pragma unroll
                for (int r = 0; r < 4; ++r) { const size_t ro = (size_t)(16 * ib + 4 * kq + r) * NPROJ; const int p = h * 64 + pt * 16 + fr;
                    float y = a1[r] + ea[r] * a2[r] + dh * bf1(P[ro + PC_X + p]);
                    y *= silu_g(bf1(P[ro + PC_Z + p])); ysc[((h * 4 + pt) * 4 + r) * 64] = y; sq[r] += y * y; }
            }
        }
    }
    const float* nw = inp(I_BNRM) + (size_t)layer * 256;
#pragma unroll
    for (int r = 0; r < 4; ++r) { const float rstd = rsq_f(sum16_l(lane_, sq[r]) * (1.0f / 256.0f) + EPS); bf16* o = F_XN + (size_t)(c.row0 + 16 * ib + 4 * kq + r) * D + 256 + fr;
#pragma unroll 4
        for (int q = 0; q < 16; ++q) o[q * 16] = (bf16)f2bf(ysc[(q * 4 + r) * 64] * rstd * nw[q * 16 + fr]); }
}

constexpr int SO_SIN = 0, SO_XT = 4 * 64 * 136 * 2, SO_ACS = SO_XT + 256 * 72 * 2, SO_DTV = SO_ACS + 1024, SO_SS = SO_DTV + 1024, SO_SCR = SO_SS + 512, SO_END = SO_SCR + 8 * 2560;
static_assert(SO_END <= MISC_OFF, "ssd_out_block LDS map");
__device__ __forceinline__ void ssd_out_block(Frame& F, int layer, int ci) {
    ITEM_IDS();
    const int row0 = 64 * ci;
    LAS bf16* SIN = (LAS bf16*)(F.lds + SO_SIN); LAS bf16* XTl = (LAS bf16*)(F.lds + SO_XT);
    lf32* acs = (lf32*)(F.lds + SO_ACS); lf32* dtv = (lf32*)(F.lds + SO_DTV); lf32* ss = (lf32*)(F.lds + SO_SS);
    LAS bf16* scr = (LAS bf16*)(F.lds + SO_SCR + wave_ * 2560);
    const int kq = lane_ >> 4, fr = lane_ & 15, ib = wave_ >> 1, g = wave_ & 1;
    const bf16* P = F_PROJ + (size_t)row0 * NPROJ;
    v4u st[12];
    { const bf16* sg = F_STB + (size_t)ci * 32768; const bf16* xg = F_XT + (size_t)ci * 16384;
#pragma unroll
      for (int q = 0; q < 8; ++q) st[q] = *(const v4u*)(sg + (size_t)(tid_ + q * NTHR) * 8);
#pragma unroll
      for (int q = 0; q < 4; ++q) st[8 + q] = *(const v4u*)(xg + (size_t)(tid_ + q * NTHR) * 8); }
    float a4 = 0.f, d4 = 0.f; if (tid_ < 256) { a4 = F_ACS[(size_t)row0 * 4 + tid_]; d4 = F_DTV[(size_t)row0 * 4 + tid_]; }
    bf16x8 cf[4], bfr[4][4];
#pragma unroll
    for (int ks = 0; ks < 4; ++ks) cf[ks] = *(const bf16x8*)(P + (size_t)(16 * ib + fr) * NPROJ + PC_C + 128 * g + 32 * ks + 8 * kq);
#pragma unroll
    for (int jb = 0; jb < 4; ++jb)
#pragma unroll
        for (int ks = 0; ks < 4; ++ks) { bfr[jb][ks] = (bf16x8){0, 0, 0, 0, 0, 0, 0, 0}; if (jb <= ib) bfr[jb][ks] = *(const bf16x8*)(P + (size_t)(16 * jb + fr) * NPROJ + PC_B + 128 * g + 32 * ks + 8 * kq); }
#pragma unroll
    for (int q = 0; q < 8; ++q) { const int it = tid_ + q * NTHR; *(LAS v4u*)(SIN + (it >> 4) * 136 + 8 * (it & 15)) = st[q]; }
#pragma unroll
    for (int q = 0; q < 4; ++q) { const int it = tid_ + q * NTHR; *(LAS v4u*)(XTl + (it >> 3) * 72 + 8 * (it & 7)) = st[8 + q]; }
    if (tid_ < 256) { acs[tid_] = a4; dtv[tid_] = d4; }
    bf16 zv[2][4][4];
#pragma unroll
    for (int hh = 0; hh < 2; ++hh)
#pragma unroll
        for (int pt = 0; pt < 4; ++pt)
#pragma unroll
            for (int r = 0; r < 4; ++r) zv[hh][pt][r] = P[(size_t)(16 * ib + 4 * kq + r) * NPROJ + PC_Z + (2 * g + hh) * 64 + pt * 16 + fr];
    __syncthreads();
    f32x4 G[4];
#pragma unroll
    for (int jb = 0; jb < 4; ++jb) { G[jb] = (f32x4){0.f, 0.f, 0.f, 0.f};
        if (jb <= ib) {
#pragma unroll
            for (int ks = 0; ks < 4; ++ks) G[jb] = __builtin_amdgcn_mfma_f32_16x16x32_bf16(cf[ks], bfr[jb][ks], G[jb], 0, 0, 0); } }
    const int nks = (ib + 2) >> 1;
    const float* bdp = inp(I_BD) + layer * 4;
    f32x4 yv[2][4]; float sq[4] = {0.f, 0.f, 0.f, 0.f};
#pragma unroll
    for (int hh = 0; hh < 2; ++hh) {
        const int h = 2 * g + hh;
        float ai[4], ea[4];
#pragma unroll
        for (int r = 0; r < 4; ++r) { ai[r] = acs[(16 * ib + 4 * kq + r) * 4 + h]; ea[r] = __expf(ai[r]); }
#pragma unroll
        for (int jb = 0; jb < 4; ++jb) { const int j = 16 * jb + fr; const float aj = acs[j * 4 + h], dj = dtv[j * 4 + h];
#pragma unroll
            for (int r = 0; r < 4; ++r) { const int i = 16 * ib + 4 * kq + r; const float v = (jb <= ib && j <= i) ? G[jb][r] * __expf(ai[r] - aj) * dj : 0.f; scr[(4 * kq + r) * 72 + j] = (bf16)f2bf(v); } }
        asm volatile("s_waitcnt lgkmcnt(0)" ::: "memory");
        bf16x8 gm[2];
#pragma unroll
        for (int ks = 0; ks < 2; ++ks) gm[ks] = *(const LAS bf16x8*)(scr + fr * 72 + 32 * ks + 8 * kq);
        asm volatile("s_waitcnt lgkmcnt(0)" ::: "memory");
        const float dh = bdp[h];
#pragma unroll
        for (int pt = 0; pt < 4; ++pt) {
            f32x4 a1 = {0.f, 0.f, 0.f, 0.f}, a2 = {0.f, 0.f, 0.f, 0.f};
            const LAS bf16* xr = XTl + (h * 64 + pt * 16 + fr) * 72; const LAS bf16* sr = SIN + (h * 64 + pt * 16 + fr) * 136;
#pragma unroll
            for (int ks = 0; ks < 2; ++ks) if (ks < nks) a1 = __builtin_amdgcn_mfma_f32_16x16x32_bf16(gm[ks], *(const LAS bf16x8*)(xr + 32 * ks + 8 * kq), a1, 0, 0, 0);
#pragma unroll
            for (int ks = 0; ks < 4; ++ks) a2 = __builtin_amdgcn_mfma_f32_16x16x32_bf16(cf[ks], *(const LAS bf16x8*)(sr + 32 * ks + 8 * kq), a2, 0, 0, 0);
            const unsigned long long xw = *(const LAS unsigned long long*)(xr + 16 * ib + 4 * kq);
            const float xx[4] = {bf_lo((unsigned)xw), bf_hi((unsigned)xw), bf_lo((unsigned)(xw >> 32)), bf_hi((unsigned)(xw >> 32))};
#pragma unroll
            for (int r = 0; r < 4; ++r) { float y = a1[r] + ea[r] * a2[r] + dh * xx[r]; y *= silu_g(bf1(zv[hh][pt][r])); yv[hh][pt][r] = y; sq[r] += y * y; }
        }
    }
#pragma unroll
    for (int r = 0; r < 4; ++r) { const float q = sum16_l(lane_, sq[r]); if (fr == 0) ss[(16 * ib + 4 * kq + r) * 2 + g] = q; }
    __syncthreads();
    const float* nw = inp(I_BNRM) + (size_t)layer * 256 + 128 * g;
#pragma unroll
    for (int r = 0; r < 4; ++r) { const int i = 16 * ib + 4 * kq + r; const float rstd = rsq_f((ss[i * 2] + ss[i * 2 + 1]) * (1.0f / 256.0f) + EPS); bf16* o = F_XN + (size_t)(row0 + i) * D + 256 + 128 * g + fr;
#pragma unroll
        for (int hh = 0; hh < 2; ++hh)
#pragma unroll
            for (int pt = 0; pt < 4; ++pt) o[hh * 64 + pt * 16] = (bf16)f2bf(yv[hh][pt][r] * rstd * nw[hh * 64 + pt * 16 + fr]); }
    __syncthreads();
}
constexpr int HP_KT = 0, HP_VT = 256 * 72 * 2, HP_HT = 2 * 256 * 72 * 2, HP_END = HP_HT + 4 * 256 * 4;
static_assert(HP_END <= MISC_OFF, "hgrn_prep LDS map");
__device__ __forceinline__ void hgrn_prep_item(Frame& F, int layer, int ci) {
    ITEM_IDS();
    const Chunk c = chunk_of(ci);
    LAS bf16* KTl = (LAS bf16*)(F.lds + HP_KT); LAS bf16* VTl = (LAS bf16*)(F.lds + HP_VT);
    lf32* ht = (lf32*)(F.lds + HP_HT);
    const int cp = tid_ & 127, qt = tid_ >> 7;
    float lb0 = 0.f, lb1 = 0.f; if (layer != 0) { const float* lbp = inp(I_LB) + 2 * cp; lb0 = rcp_f(1.0f + __expf(lbp[0] - lbp[256])); lb1 = rcp_f(1.0f + __expf(lbp[1] - lbp[257])); }
    bf16* pq = F_PROJ + (size_t)(c.row0 + 16 * qt) * NPROJ + PC_CQ + 2 * cp;
    const bool act = 16 * qt < c.nrows;
    unsigned rq[16], rf[16], rv[16];
#pragma unroll
    for (int i = 0; i < 16; ++i) { rq[i] = 0u; rf[i] = 0u; rv[i] = 0u; if (act) { const unsigned* p = (const unsigned*)(pq + (size_t)i * NPROJ); rq[i] = p[0]; rf[i] = p[128]; rv[i] = p[256]; } }
    float b0[16], b1[16], k0[16], k1[16];
    float run0 = 0.f, run1 = 0.f;
#pragma unroll
    for (int i = 0; i < 16; ++i) { float g0 = 0.f, g1 = 0.f; k0[i] = 0.f; k1[i] = 0.f;
        if (act) { const float e0 = __expf(-bf_lo(rf[i])), e1 = __expf(-bf_hi(rf[i])); const float d0 = rcp_f(1.0f + e0), d1 = rcp_f(1.0f + e1);
            g0 = __logf(lb0 + (1.0f - lb0) * d0); g1 = __logf(lb1 + (1.0f - lb1) * d1); k0[i] = (1.0f - lb0) * e0 * d0; k1[i] = (1.0f - lb1) * e1 * d1; }
        run0 += g0; run1 += g1; b0[i] = run0; b1[i] = run1; }
    *(LAS f32x2*)(ht + qt * 256 + 2 * cp) = (f32x2){run0, run1};
    __syncthreads();
    float pre0 = 0.f, pre1 = 0.f, last0 = 0.f, last1 = 0.f;
#pragma unroll
    for (int q = 0; q < 4; ++q) { const f32x2 t = *(const LAS f32x2*)(ht + q * 256 + 2 * cp); if (q < qt) { pre0 += t.x; pre1 += t.y; } last0 += t.x; last1 += t.y; }
    { float* Rg = F_RH + (size_t)ci * 1280 + 2 * cp; *(f32x2*)(Rg + qt * 256) = (f32x2){pre0, pre1};
      if (qt == 3) { *(f32x2*)(Rg + 1024) = (f32x2){last0, last1}; *(f32x2*)(F_DECC + (size_t)ci * 256 + 2 * cp) = (f32x2){__expf(last0), __expf(last1)}; } }
    const float e0 = run0, e1 = run1;
#pragma unroll
    for (int i = 0; i < 16; i += 2) {
        unsigned kt0, kt1;
#pragma unroll
        for (int q = 0; q < 2; ++q) { const int ii = i + q;
            const float qe0 = bf_lo(rq[ii]) * __expf(b0[ii]), qe1 = bf_hi(rq[ii]) * __expf(b1[ii]);
            const float ke0 = k0[ii] * __expf(e0 - b0[ii]), ke1 = k1[ii] * __expf(e1 - b1[ii]);
            const float kd0 = k0[ii] * __expf(fminf(-b0[ii], 80.f)), kd1 = k1[ii] * __expf(fminf(-b1[ii], 80.f));
            if (act && 16 * qt + ii < c.nrows) { unsigned* p = (unsigned*)(pq + (size_t)ii * NPROJ); p[0] = pk2(qe0, qe1); p[128] = pk2(ke0, ke1); p[256] = pk2(kd0, kd1); }
            const float t0 = k0[ii] * __expf(last0 - pre0 - b0[ii]), t1 = k1[ii] * __expf(last1 - pre1 - b1[ii]);
            if (q == 0) { kt0 = f2bf(t0); kt1 = f2bf(t1); } else { kt0 |= f2bf(t0) << 16; kt1 |= f2bf(t1) << 16; } }
        const int j = 16 * qt + i;
        *(LAS unsigned*)(KTl + (2 * cp) * 72 + j) = kt0; *(LAS unsigned*)(KTl + (2 * cp + 1) * 72 + j) = kt1;
        *(LAS unsigned*)(VTl + (2 * cp) * 72 + j) = (rv[i] & 0xffffu) | (rv[i + 1] << 16); *(LAS unsigned*)(VTl + (2 * cp + 1) * 72 + j) = (rv[i] >> 16) | (rv[i + 1] & 0xffff0000u);
    }
    __syncthreads();
    { const int c2 = tid_ >> 1, hf = tid_ & 1; bf16* dst = F_VT + ((size_t)ci * 256 + c2) * 64 + 32 * hf; const LAS bf16* src = VTl + c2 * 72 + 32 * hf;
#pragma unroll
      for (int q = 0; q < 4; ++q) *(v4u*)(dst + 8 * q) = *(const LAS v4u*)(src + 8 * q); }
    const int kq = lane_ >> 4, fr = lane_ & 15, h = wave_ >> 1;
#pragma unroll
    for (int vi = 0; vi < 2; ++vi) {
        const int vb = 2 * (wave_ & 1) + vi;
        bf16x8 af[2];
#pragma unroll
        for (int ks = 0; ks < 2; ++ks) af[ks] = *(const LAS bf16x8*)(VTl + (h * 64 + vb * 16 + fr) * 72 + 32 * ks + 8 * kq);
        bf16* dst = F_STC + ((size_t)(ci * 4 + h) * 64 + vb * 16 + 4 * kq) * 64 + fr;
#pragma unroll
        for (int kb = 0; kb < 4; ++kb) {
            f32x4 acc = {0.f, 0.f, 0.f, 0.f};
#pragma unroll
            for (int ks = 0; ks < 2; ++ks) { const bf16x8 bfr = *(const LAS bf16x8*)(KTl + (h * 64 + kb * 16 + fr) * 72 + 32 * ks + 8 * kq); acc = __builtin_amdgcn_mfma_f32_16x16x32_bf16(af[ks], bfr, acc, 0, 0, 0); }
#pragma unroll
            for (int r = 0; r < 4; ++r) dst[r * 64 + kb * 16] = (bf16)f2bf(acc[r]);
        }
    }
    __syncthreads();
}

__device__ __forceinline__ void hgrn_out_witem(Frame& F, int layer, int ci, int h, int ib, int wave_, int lane_) {
    const Chunk c = chunk_of(ci);
    const int kq = lane_ >> 4, fr = lane_ & 15;
    LAS bf16* scr = (LAS bf16*)(F.lds + wave_ * (2560 + 16384));
    const bf16* P = F_PROJ + (size_t)c.row0 * NPROJ + h * 64;
    const float* Rg = F_RH + (size_t)ci * 1280 + h * 64;
    bf16x8 qf[2]; float qv[2][8], rI[2][8];
#pragma unroll
    for (int ks = 0; ks < 2; ++ks) { qf[ks] = *(const bf16x8*)(P + (size_t)(16 * ib + fr) * NPROJ + PC_CQ + 32 * ks + 8 * kq); unpack8(__builtin_bit_cast(v4u, qf[ks]), qv[ks]);
        const float* rp = Rg + ib * 256 + 32 * ks + 8 * kq; const f32x4 a = *(const f32x4*)rp, b2 = *(const f32x4*)(rp + 4);
        rI[ks][0] = a.x; rI[ks][1] = a.y; rI[ks][2] = a.z; rI[ks][3] = a.w; rI[ks][4] = b2.x; rI[ks][5] = b2.y; rI[ks][6] = b2.z; rI[ks][7] = b2.w; }
#pragma unroll
    for (int J = 0; J < 4; ++J) {
        f32x4 acc = {0.f, 0.f, 0.f, 0.f};
        if (J <= ib) {
#pragma unroll
            for (int ks = 0; ks < 2; ++ks) {
                bf16x8 a = qf[ks];
                if (J < ib) { const float* rp = Rg + (J + 1) * 256 + 32 * ks + 8 * kq; const f32x4 u0 = *(const f32x4*)rp, u1 = *(const f32x4*)(rp + 4); const float rj[8] = {u0.x, u0.y, u0.z, u0.w, u1.x, u1.y, u1.z, u1.w};
                    float v[8];
#pragma unroll
                    for (int e = 0; e < 8; ++e) v[e] = qv[ks][e] * __expf(rI[ks][e] - rj[e]);
                    a = __builtin_bit_cast(bf16x8, pack8(v)); }
                const bf16x8 bfr = *(const bf16x8*)(P + (size_t)(16 * J + fr) * NPROJ + (J < ib ? PC_CF : PC_CI) + 32 * ks + 8 * kq);
                acc = __builtin_amdgcn_mfma_f32_16x16x32_bf16(a, bfr, acc, 0, 0, 0);
            }
        }
#pragma unroll
        for (int r = 0; r < 4; ++r) { const int i = 4 * kq + r, j = fr; const float v = (J < ib || (J == ib && j <= i)) ? acc[r] : 0.f; scr[(4 * kq + r) * 72 + 16 * J + fr] = (bf16)f2bf(v); }
    }
    asm volatile("s_waitcnt lgkmcnt(0)" ::: "memory");
    bf16x8 ga[2];
#pragma unroll
    for (int ks = 0; ks < 2; ++ks) ga[ks] = *(const LAS bf16x8*)(scr + fr * 72 + 32 * ks + 8 * kq);
    asm volatile("s_waitcnt lgkmcnt(0)" ::: "memory");
    bf16x8 qs[2];
#pragma unroll
    for (int ks = 0; ks < 2; ++ks) { float v[8];
#pragma unroll
        for (int e = 0; e < 8; ++e) v[e] = qv[ks][e] * __expf(rI[ks][e]);
        qs[ks] = __builtin_bit_cast(bf16x8, pack8(v)); }
    const int nks = (ib + 2) >> 1;
    const bf16* vt = F_VT + ((size_t)ci * 256 + h * 64) * 64;
    const bf16* sin_b = F_STC + (size_t)(ci * 4 + h) * 4096; const float* sin_f = inp(I_SHGRN) + (size_t)((layer * NSB + (c.b < 0 ? 0 : c.b)) * 4 + h) * 4096;
    f32x4 o[4]; float sq[4] = {0.f, 0.f, 0.f, 0.f};
#pragma unroll
    for (int t = 0; t < 4; ++t) {
        o[t] = (f32x4){0.f, 0.f, 0.f, 0.f};
#pragma unroll
        for (int ks = 0; ks < 2; ++ks) if (ks < nks) { const bf16x8 bfr = *(const bf16x8*)(vt + (size_t)(t * 16 + fr) * 64 + 32 * ks + 8 * kq); o[t] = __builtin_amdgcn_mfma_f32_16x16x32_bf16(ga[ks], bfr, o[t], 0, 0, 0); }
#pragma unroll
        for (int ks = 0; ks < 2; ++ks) { bf16x8 bfr;
            if (c.b < 0) bfr = *(const bf16x8*)(sin_b + (size_t)(t * 16 + fr) * 64 + 32 * ks + 8 * kq);
            else { float v[8];
#pragma unroll
                for (int e = 0; e < 8; ++e) v[e] = sin_f[(size_t)(32 * ks + 8 * kq + e) * 64 + t * 16 + fr];
                bfr = __builtin_bit_cast(bf16x8, pack8(v)); }
            o[t] = __builtin_amdgcn_mfma_f32_16x16x32_bf16(qs[ks], bfr, o[t], 0, 0, 0); }
#pragma unroll
        for (int r = 0; r < 4; ++r) sq[r] += o[t][r] * o[t][r];
    }
    const float* nw = inp(I_CNRM) + (size_t)layer * 256 + h * 64;
#pragma unroll
    for (int r = 0; r < 4; ++r) { const float rstd = rsq_f(sum16_l(lane_, sq[r]) * (1.0f / 64.0f) + EPS); const size_t row = (size_t)(16 * ib + 4 * kq + r);
#pragma unroll
        for (int t = 0; t < 4; ++t) { const int v = t * 16 + fr; const float cg = bf1(P[row * NPROJ + PC_CG + v]);
            F_XN[(size_t)(c.row0 + row) * D + 512 + h * 64 + v] = (bf16)f2bf(o[t][r] * rstd * nw[v] * silu_g(cg)); } }
}

constexpr int HO_KE = 0, HO_VT = 64 * 264 * 2, HO_SIN = HO_VT + 256 * 72 * 2, HO_R = HO_SIN + 256 * 72 * 2, HO_SCR = HO_R + 1280 * 4, HO_END = HO_SCR + 8 * 2304;
static_assert(HO_END <= MISC_OFF, "hgrn_out_block LDS map");
__device__ __forceinline__ void hgrn_out_block(Frame& F, int layer, int ci) {
    ITEM_IDS();
    const int row0 = 64 * ci;
    LAS bf16* KEl = (LAS bf16*)(F.lds + HO_KE); LAS bf16* VTl = (LAS bf16*)(F.lds + HO_VT); LAS bf16* SIN = (LAS bf16*)(F.lds + HO_SIN); lf32* Rl = (lf32*)(F.lds + HO_R);
    LAS bf16* scr = (LAS bf16*)(F.lds + HO_SCR + wave_ * 2304);
    const int kq = lane_ >> 4, fr = lane_ & 15, h = wave_ >> 1, wp = wave_ & 1;
    const bf16* P = F_PROJ + (size_t)row0 * NPROJ;
    v4u st[13];
    { const bf16* kg = P + PC_CF; const bf16* vg = F_VT + (size_t)ci * 16384; const bf16* sg = F_STC + (size_t)ci * 16384; const float* rg = F_RH + (size_t)ci * 1280;
#pragma unroll
      for (int q = 0; q < 4; ++q) { const int it = tid_ + q * NTHR; st[q] = *(const v4u*)(kg + (size_t)(it >> 5) * NPROJ + 8 * (it & 31)); }
#pragma unroll
      for (int q = 0; q < 4; ++q) st[4 + q] = *(const v4u*)(vg + (size_t)(tid_ + q * NTHR) * 8);
#pragma unroll
      for (int q = 0; q < 4; ++q) st[8 + q] = *(const v4u*)(sg + (size_t)(tid_ + q * NTHR) * 8);
      st[12] = (v4u){0u, 0u, 0u, 0u}; if (tid_ < 320) st[12] = *(const v4u*)(rg + 4 * tid_); }
    bf16x8 qf[2][2], kd[2][2];
#pragma unroll
    for (int bi = 0; bi < 2; ++bi)
#pragma unroll
        for (int ks = 0; ks < 2; ++ks) { const bf16* p = P + (size_t)(16 * (bi == 0 ? wp : 3 - wp) + fr) * NPROJ + h * 64 + 32 * ks + 8 * kq; qf[bi][ks] = *(const bf16x8*)(p + PC_CQ); kd[bi][ks] = *(const bf16x8*)(p + PC_CI); }
#pragma unroll
    for (int q = 0; q < 4; ++q) { const int it = tid_ + q * NTHR; *(LAS v4u*)(KEl + (it >> 5) * 264 + 8 * (it & 31)) = st[q]; }
#pragma unroll
    for (int q = 0; q < 4; ++q) { const int it = tid_ + q * NTHR; *(LAS v4u*)(VTl + (it >> 3) * 72 + 8 * (it & 7)) = st[4 + q]; *(LAS v4u*)(SIN + (it >> 3) * 72 + 8 * (it & 7)) = st[8 + q]; }
    if (tid_ < 320) *(LAS v4u*)(Rl + 4 * tid_) = st[12];
    bf16 cgv[2][4][4];
#pragma unroll
    for (int bi = 0; bi < 2; ++bi)
#pragma unroll
        for (int t = 0; t < 4; ++t)
#pragma unroll
            for (int r = 0; r < 4; ++r) cgv[bi][t][r] = P[(size_t)(16 * (bi == 0 ? wp : 3 - wp) + 4 * kq + r) * NPROJ + PC_CG + h * 64 + t * 16 + fr];
    __syncthreads();
    const float* nw = inp(I_CNRM) + (size_t)layer * 256 + h * 64;
#pragma unroll
    for (int bi = 0; bi < 2; ++bi) {
        const int ib = bi == 0 ? wp : 3 - wp;
        float qv[2][8], rI[2][8];
#pragma unroll
        for (int ks = 0; ks < 2; ++ks) { unpack8(__builtin_bit_cast(v4u, qf[bi][ks]), qv[ks]); const lf32* rp = Rl + ib * 256 + h * 64 + 32 * ks + 8 * kq;
#pragma unroll
            for (int e = 0; e < 8; ++e) rI[ks][e] = rp[e]; }
#pragma unroll
        for (int J = 0; J < 4; ++J) {
            f32x4 acc = {0.f, 0.f, 0.f, 0.f};
            if (J <= ib) {
#pragma unroll
                for (int ks = 0; ks < 2; ++ks) {
                    bf16x8 a = qf[bi][ks], bfr = kd[bi][ks];
                    if (J < ib) { const lf32* rp = Rl + (J + 1) * 256 + h * 64 + 32 * ks + 8 * kq; float v[8];
#pragma unroll
                        for (int e = 0; e < 8; ++e) v[e] = qv[ks][e] * __expf(rI[ks][e] - rp[e]);
                        a = __builtin_bit_cast(bf16x8, pack8(v)); bfr = *(const LAS bf16x8*)(KEl + (16 * J + fr) * 264 + h * 64 + 32 * ks + 8 * kq); }
                    acc = __builtin_amdgcn_mfma_f32_16x16x32_bf16(a, bfr, acc, 0, 0, 0);
                }
            }
#pragma unroll
            for (int r = 0; r < 4; ++r) { const int i = 4 * kq + r, j = fr; const float v = (J < ib || (J == ib && j <= i)) ? acc[r] : 0.f; scr[(4 * kq + r) * 72 + 16 * J + fr] = (bf16)f2bf(v); }
        }
        asm volatile("s_waitcnt lgkmcnt(0)" ::: "memory");
        bf16x8 ga[2];
#pragma unroll
        for (int ks = 0; ks < 2; ++ks) ga[ks] = *(const LAS bf16x8*)(scr + fr * 72 + 32 * ks + 8 * kq);
        asm volatile("s_waitcnt lgkmcnt(0)" ::: "memory");
        bf16x8 qs[2];
#pragma unroll
        for (int ks = 0; ks < 2; ++ks) { float v[8];
#pragma unroll
            for (int e = 0; e < 8; ++e) v[e] = qv[ks][e] * __expf(rI[ks][e]);
            qs[ks] = __builtin_bit_cast(bf16x8, pack8(v)); }
        const int nks = (ib + 2) >> 1;
        f32x4 o[4]; float sq[4] = {0.f, 0.f, 0.f, 0.f};
#pragma unroll
        for (int t = 0; t < 4; ++t) {
            o[t] = (f32x4){0.f, 0.f, 0.f, 0.f};
#pragma unroll
            for (int ks = 0; ks < 2; ++ks) if (ks < nks) o[t] = __builtin_amdgcn_mfma_f32_16x16x32_bf16(ga[ks], *(const LAS bf16x8*)(VTl + (h * 64 + t * 16 + fr) * 72 + 32 * ks + 8 * kq), o[t], 0, 0, 0);
#pragma unroll
            for (int ks = 0; ks < 2; ++ks) o[t] = __builtin_amdgcn_mfma_f32_16x16x32_bf16(qs[ks], *(const LAS bf16x8*)(SIN + (h * 64 + t * 16 + fr) * 72 + 32 * ks + 8 * kq), o[t], 0, 0, 0);
#pragma unroll
            for (int r = 0; r < 4; ++r) sq[r] += o[t][r] * o[t][r];
        }
#pragma unroll
        for (int r = 0; r < 4; ++r) { const float rstd = rsq_f(sum16_l(lane_, sq[r]) * (1.0f / 64.0f) + EPS); bf16* op = F_XN + (size_t)(row0 + 16 * ib + 4 * kq + r) * D + 512 + h * 64 + fr;
#pragma unroll
            for (int t = 0; t < 4; ++t) op[t * 16] = (bf16)f2bf(o[t][r] * rstd * nw[t * 16 + fr] * silu_g(bf1(cgv[bi][t][r]))); }
    }
    __syncthreads();
}
template <int MODE>
__device__ __forceinline__ void mini_gemm(Frame& F, const bf16* A, const bf16* Bt, int K, int ncb, bf16* O, int ldo, const float* res, float* C, const float* nw = nullptr, bf16* xo = nullptr, float* rs = nullptr) {
    ITEM_IDS();
    const int kq = lane_ >> 4, fr = lane_ & 15;
    for (int wi = ((int)blockIdx.x) * NWAVES + wave_; wi < 16 * ncb; wi += ((int)gridDim.x) * NWAVES) {
        const int rb = wi & 15, cb = wi >> 4;
        const bf16* ap = A + (size_t)(MP + 16 * rb + fr) * K + 8 * kq;
        const int c = 16 * cb + fr;
        const bf16* bp = Bt + (size_t)(MODE == 2 ? ((c >> 7) * 256 + (c & 127)) : c) * K + 8 * kq;
        f32x4 acc0 = {0.f, 0.f, 0.f, 0.f}, acc1 = {0.f, 0.f, 0.f, 0.f};
#pragma unroll 8
        for (int k0 = 0; k0 < K; k0 += 32) {
            const bf16x8 a = *(const bf16x8*)(ap + k0), b0 = *(const bf16x8*)(bp + k0);
            acc0 = __builtin_amdgcn_mfma_f32_16x16x32_bf16(a, b0, acc0, 0, 0, 0);
            if (MODE == 2) { const bf16x8 b1 = *(const bf16x8*)(bp + (size_t)128 * K + k0); acc1 = __builtin_amdgcn_mfma_f32_16x16x32_bf16(a, b1, acc1, 0, 0, 0); }
        }
#pragma unroll
        for (int r = 0; r < 4; ++r) { const size_t row = (size_t)(MP + 16 * rb + 4 * kq + r);
            if (MODE == 0) { const bf16 ob = (bf16)f2bf(acc0[r]); O[row * ldo + c] = ob; if (c >= PC_V && c < PC_V + 256) F_VTA[(size_t)(c - PC_V) * M + row] = ob; }
            if (MODE == 1) { const float x = res[row * 1024 + c] + acc0[r]; C[row * 1024 + c] = x;
                if (nw) { xo[row * 1024 + c] = (bf16)f2bf(x * nw[c]); const float q = sum16_l(lane_, x * x); if (fr == 0) atomicAdd(rs + row, q); } }
            if (MODE == 2) O[row * ldo + c] = (bf16)f2bf(silu_g(acc0[r]) * acc1[r]); }
    }
}

template <int MODE, int KS>
__device__ __forceinline__ void mini_gemm2(Frame& F, const bf16* A, const bf16* Bt, int K, int ncb32, bf16* O, int ldo, const float* res, float* C, const float* nw = nullptr, bf16* xo = nullptr, float* rs = nullptr, const bf16* rbf = nullptr, const float* rw = nullptr, bf16* Cb = nullptr) {
    ITEM_IDS();
    const int kq = lane_ >> 4, fr = lane_ & 15;
    LAS f32x4* red = (LAS f32x4*)F.lds;
    for (int it = (int)blockIdx.x; it < 8 * ncb32; it += (int)gridDim.x) {
        const int rb = it & 7, cb = it >> 3;
        const bf16* ap = A + (size_t)(MP + 32 * rb + fr) * K + wave_ * (KS * 32) + 8 * kq;
        const bf16* bp = Bt + (size_t)(32 * cb + fr) * K + wave_ * (KS * 32) + 8 * kq;
        f32x4 acc[2][2] = {{(f32x4){0.f, 0.f, 0.f, 0.f}, (f32x4){0.f, 0.f, 0.f, 0.f}}, {(f32x4){0.f, 0.f, 0.f, 0.f}, (f32x4){0.f, 0.f, 0.f, 0.f}}};
#pragma unroll (KS > 6 ? 6 : KS)
        for (int ks = 0; ks < KS; ++ks) {
            bf16x8 a[2], b[2];
#pragma unroll
            for (int i = 0; i < 2; ++i) { a[i] = *(const bf16x8*)(ap + (size_t)(16 * i) * K + 32 * ks); b[i] = *(const bf16x8*)(bp + (size_t)(16 * i) * K + 32 * ks); }
#pragma unroll
            for (int i = 0; i < 2; ++i)
#pragma unroll
                for (int j = 0; j < 2; ++j) acc[i][j] = __builtin_amdgcn_mfma_f32_16x16x32_bf16(a[i], b[j], acc[i][j], 0, 0, 0);
        }
#pragma unroll
        for (int i = 0; i < 2; ++i)
#pragma unroll
            for (int j = 0; j < 2; ++j) red[(wave_ * 4 + 2 * i + j) * 64 + lane_] = acc[i][j];
        __syncthreads();
        if (wave_ < 4) {
            const int qi = wave_ >> 1, qj = wave_ & 1;
            f32x4 s = red[wave_ * 64 + lane_];
#pragma unroll
            for (int w = 1; w < 8; ++w) s += red[(w * 4 + wave_) * 64 + lane_];
            const int c = 32 * cb + 16 * qj + fr;
#pragma unroll
            for (int r = 0; r < 4; ++r) { const size_t row = (size_t)(MP + 32 * rb + 16 * qi + 4 * kq + r);
                if (MODE == 0) { const bf16 ob = (bf16)f2bf(s[r]); O[row * ldo + c] = ob; if (c >= PC_V && c < PC_V + 256) F_VTA[(size_t)(c - PC_V) * M + row] = ob; }
                if (MODE == 1) { const float x = (rbf ? bf1(rbf[row * 1024 + c]) * (rw ? rcp_f(rw[c]) : 1.0f) : res[row * 1024 + c]) + s[r]; if (C) C[row * 1024 + c] = x; if (Cb) Cb[row * 1024 + c] = (bf16)f2bf(x);
                    if (nw) { xo[row * 1024 + c] = (bf16)f2bf(x * nw[c]); const float q = sum16_l(lane_, x * x); if (fr == 0) atomicAdd(rs + row, q); } } }
        }
        __syncthreads();
    }
}

__device__ __forceinline__ void mini_gemm_proj(Frame& F, const bf16* A, const bf16* Bt, bf16* O) {
    ITEM_IDS();
    const int kq = lane_ >> 4, fr = lane_ & 15;
    LAS f32x4* red = (LAS f32x4*)F.lds;
    for (int it = (int)blockIdx.x; it < 4 * (NPROJ / 64); it += (int)gridDim.x) {
        const int rb = it & 3, cb = it >> 2;
        const bf16* ap = A + (size_t)(MP + 64 * rb + fr) * D + wave_ * 128 + 8 * kq;
        const bf16* bp = Bt + (size_t)(64 * cb + fr) * D + wave_ * 128 + 8 * kq;
        f32x4 acc[4][4];
#pragma unroll
        for (int i = 0; i < 4; ++i)
#pragma unroll
            for (int j = 0; j < 4; ++j) acc[i][j] = (f32x4){0.f, 0.f, 0.f, 0.f};
        bf16x8 a[4][4], b[4][4];
#pragma unroll
        for (int ks = 0; ks < 4; ++ks)
#pragma unroll
            for (int i = 0; i < 4; ++i) { a[ks][i] = *(const bf16x8*)(ap + (size_t)(16 * i) * D + 32 * ks); b[ks][i] = *(const bf16x8*)(bp + (size_t)(16 * i) * D + 32 * ks); }
#pragma unroll
        for (int ks = 0; ks < 4; ++ks)
#pragma unroll
            for (int i = 0; i < 4; ++i)
#pragma unroll
                for (int j = 0; j < 4; ++j) acc[i][j] = __builtin_amdgcn_mfma_f32_16x16x32_bf16(a[ks][i], b[ks][j], acc[i][j], 0, 0, 0);
#pragma unroll
        for (int i = 0; i < 4; ++i)
#pragma unroll
            for (int j = 0; j < 4; ++j) red[(wave_ * 16 + 4 * i + j) * 64 + lane_] = acc[i][j];
        __syncthreads();
#pragma unroll
        for (int u = 0; u < 2; ++u) { const int q = 2 * wave_ + u, qi = q >> 2, qj = q & 3;
            f32x4 s = red[q * 64 + lane_];
#pragma unroll
            for (int w = 1; w < 8; ++w) s += red[(w * 16 + q) * 64 + lane_];
            const int c = 64 * cb + 16 * qj + fr;
#pragma unroll
            for (int r = 0; r < 4; ++r) { const size_t row = (size_t)(MP + 64 * rb + 16 * qi + 4 * kq + r); const bf16 ob = (bf16)f2bf(s[r]); O[row * NPROJ + c] = ob; if (c >= PC_V && c < PC_V + 256) F_VTA[(size_t)(c - PC_V) * M + row] = ob; } }
        __syncthreads();
    }
}
__device__ __forceinline__ void sample_mix_item(Frame& F, int layer, int b) {
    ssd_prep_item(F, layer, NCHP + b);
    hgrn_prep_item(F, layer, NCHP + b);
    asm volatile("s_waitcnt vmcnt(0)" ::: "memory");
    __syncthreads();
    __builtin_amdgcn_fence(__ATOMIC_ACQUIRE, "agent");
    asm volatile("s_waitcnt vmcnt(0)" ::: "memory");
    { ITEM_IDS();
      if (wave_ == 0) ssd_out_witem(F, layer, NCHP + b, 0, wave_, lane_);
      else if (wave_ <= 4) hgrn_out_witem(F, layer, NCHP + b, wave_ - 1, 0, wave_, lane_); }
    __syncthreads();
}
__device__ __forceinline__ void p2_phase(Frame& F, int layer, volatile LAS unsigned* MISC) {
    constexpr int NS = NSB, NA = NCH * 4, NB = NCHP, NC = NCHP, ND = NCH, NE = 64, NW = 432;
    const int NTOT = NS + NA + NB + NC + ND + NE + (layer == 0 ? NW : 0);
    unsigned* head = (unsigned*)(F.ws + WS_CTL) + CW_QUEUE + 64 * layer;
    attn_bias_load(F, layer);
    unsigned nxt = 0u; if (threadIdx.x == 0) nxt = __hip_atomic_fetch_add(head, 1u, __ATOMIC_RELAXED, __HIP_MEMORY_SCOPE_AGENT);
    for (;;) {
        __syncthreads();
        if (threadIdx.x == 0) MISC[12] = nxt;
        __syncthreads();
        int it = (int)MISC[12];
        if (it >= NTOT) break;
        if (threadIdx.x == 0) nxt = __hip_atomic_fetch_add(head, 1u, __ATOMIC_RELAXED, __HIP_MEMORY_SCOPE_AGENT);
        if (it < NS) { sample_mix_item(F, layer, it); continue; } it -= NS;
        if (it < NA) { const int i2 = it - NSB * 4; const int ci = it < NSB * 4 ? NCHP + (it >> 2) : NCHP - 1 - (i2 >> 2); attn_item(F, layer, ci, it & 3); }
        else if (it < NA + NB) ssd_prep_item(F, layer, it - NA);
        else if (it < NA + NB + NC) hgrn_prep_item(F, layer, it - NA - NB);
        else if (it < NA + NB + NC + ND) pool_item(F, layer, it - NA - NB - NC);
        else if (it < NA + NB + NC + ND + NE) copy_cache(F, layer, it - NA - NB - NC - ND, NE);
        else { ITEM_IDS(); p0_weights(F, 1, (it - NA - NB - NC - ND - NE) * NWAVES + wave_, NW * NWAVES, false); }
    }
}
__device__ __forceinline__ void p4_phase(Frame& F, int layer) {
    for (int ci = ((int)blockIdx.x); ci < NCHP; ci += ((int)gridDim.x)) { ssd_out_block(F, layer, ci); hgrn_out_block(F, layer, ci); }
}

__global__ void __launch_bounds__(NTHR, 2) fwd_kernel(Args args) {
    extern __shared__ __attribute__((aligned(16))) unsigned char lds[];
    Frame F;
    F.lds = (LAS unsigned char*)lds;
    F.out = args.out; F.ws = args.ws;
    volatile LAS unsigned* MISC = (volatile LAS unsigned*)(F.lds + MISC_OFF);
    if (threadIdx.x < 64) MISC[threadIdx.x] = 0u;
    __syncthreads();
    (void)xcd_barrier_post((unsigned*)(args.ws + WS_CTL) + CW_BAR, MISC + 8);
#define GRID_BAR() do { XcdBarrier bar_; bar_.bar = (unsigned*)((unsigned char*)inp(N_IN + 1) + WS_CTL) + CW_BAR; bar_.x = xb_xcc_id(); bar_.st = MISC + 8; xcd_barrier(bar_); \
        F.out = (float*)inp(N_IN); F.ws = (unsigned char*)inp(N_IN + 1); } while (0)
#ifdef TPROBE
    const bool stamper = (blockIdx.x == 0 && threadIdx.x == 0); int n_stamp = 0;
#define STAMP() do { if (stamper) MISC[16 + n_stamp] = (unsigned)__builtin_amdgcn_s_memrealtime(); ++n_stamp; } while (0)
#else
#define STAMP() do { } while (0)
#endif
    STAMP();

    { float* rsz = F_RS; for (int i = (int)blockIdx.x * NTHR + (int)threadIdx.x; i < 2 * M; i += (int)gridDim.x * NTHR) rsz[i] = 0.f; }
    {
      const int w_ = __builtin_amdgcn_readfirstlane((int)(threadIdx.x >> 6));
      { const float* wdt = inp(I_WIN); lf32* wl = (lf32*)(F.lds + 135168); for (int k2 = (int)threadIdx.x; k2 < D; k2 += NTHR) *(LAS f32x4*)(wl + 4 * k2) = *(const f32x4*)(wdt + (size_t)k2 * NIN + 1792); }
      { const float* pw = inp(I_PW); for (int i = (int)blockIdx.x * NTHR + (int)threadIdx.x; i < 2 * 4 * 64 * 64; i += (int)gridDim.x * NTHR) { const int c = i & 63, d = (i >> 6) & 63, lg = i >> 12; F_WPT[i] = (bf16)f2bf(pw[(size_t)(lg * 64 + c) * 64 + d]); } }
      __syncthreads();
      if (w_ < 4) p0_weights(F, 0, (int)blockIdx.x * 4 + w_, (int)gridDim.x * 4, false);
      else norm_rows<true, false>(F, inp(I_XP), inp(I_XS) - (size_t)MP * D, inp(I_N1), inp(I_WIN), nullptr, (int)blockIdx.x * 4 + (w_ - 4), (int)gridDim.x * 4); }
    GRID_BAR(); STAMP();
#pragma unroll 1
    for (int layer = 0; layer < 2; ++layer) {
        unsigned char* wl = F.ws + WS_W + (size_t)layer * WL_STRIDE;
        mini_gemm_proj(F, F_XN, (const bf16*)(wl + WL_IN), F_PROJ);
        { pg8::Gemm g{F_XN, (const bf16*)(wl + WL_IN), MP, NPROJ, D}; pg8::StaticOrder S; S.init(MP, NPROJ, ((int)gridDim.x), ((int)blockIdx.x));
          pg8::EpiBf16 E{F_PROJ, NPROJ, F_HALO, F_VTA, M};
          pg8::gemm_phase<pg8::EpiBf16, pg8::StaticOrder, true, true>(F.lds + RING_OFF, g, S, E); }
        GRID_BAR(); STAMP();
        p2_phase(F, layer, MISC);
        GRID_BAR(); STAMP();
        scan_phase(F, layer);
        GRID_BAR(); STAMP();
        p4_phase(F, layer);
        GRID_BAR(); STAMP();
        mini_gemm2<1, 4>(F, F_XN, (const bf16*)(wl + WL_OUT), D, D / 32, nullptr, 0, inp(I_XS) - (size_t)MP * D, nullptr, inp(I_N2) + (size_t)layer * D, F_XN2, F_RS + (size_t)layer * M, layer == 0 ? nullptr : (const bf16*)F.out, nullptr);
        { pg8::Gemm g{F_XN, (const bf16*)(wl + WL_OUT), MP, D, D}; pg8::StaticOrder S; S.init(MP, D, ((int)gridDim.x), ((int)blockIdx.x));
          pg8::EpiRes E{inp(I_XP), inp(I_XS) - (size_t)MP * D, nullptr, inp(I_N2) + (size_t)layer * D, F_XN2, F_RS + (size_t)layer * M, layer == 0 ? nullptr : (const bf16*)F.out, nullptr, nullptr};
          pg8::gemm_phase<pg8::EpiRes, pg8::StaticOrder, true, true>(F.lds + RING_OFF, g, S, E); }
        GRID_BAR(); STAMP();
        { pg8::Gemm g{F_XN2, (const bf16*)(wl + WL_GU), M, NGU, D}; pg8::StaticOrder S; S.init(M, NGU, ((int)gridDim.x), ((int)blockIdx.x));
          pg8::EpiSwiGLU E{F_ACT, DFF, F_RS + (size_t)layer * M};
          pg8::gemm_phase<pg8::EpiSwiGLU, pg8::StaticOrder, true, true>(F.lds + RING_OFF, g, S, E); }
        GRID_BAR(); STAMP();
        mini_gemm2<1, 11>(F, F_ACT, (const bf16*)(wl + WL_DN), DFF, D / 32, nullptr, 0, nullptr, nullptr, nullptr, nullptr, nullptr, F_XN2, inp(I_N2) + (size_t)layer * D, layer == 0 ? (bf16*)F.out : F_XN);
        { pg8::Gemm g{F_ACT, (const bf16*)(wl + WL_DN), MP, D, DFF}; pg8::StaticOrder S; S.init(MP, D, ((int)gridDim.x), ((int)blockIdx.x));
          pg8::EpiRes E{nullptr, nullptr, nullptr, nullptr, nullptr, nullptr, F_XN2, inp(I_N2) + (size_t)layer * D, layer == 0 ? (bf16*)F.out : F_XN};
          pg8::gemm_phase<pg8::EpiRes, pg8::StaticOrder, true, true>(F.lds + RING_OFF, g, S, E); }
        GRID_BAR(); STAMP();
        if (layer == 0) { norm_rows<true, false>(F, nullptr, nullptr, inp(I_N1) + D, inp(I_WIN) + (size_t)D * NIN, (const bf16*)F.out); GRID_BAR(); STAMP(); }
        else { norm_rows<false, true>(F, nullptr, nullptr, inp(I_NF), nullptr, F_XN); STAMP(); }
    }
#ifdef TPROBE
    if (stamper) {
        unsigned v[10]; v[0] = MISC[17] - MISC[16];
        for (int j = 1; j < 9; ++j) v[j] = (MISC[17 + j] - MISC[16 + j]) + (MISC[25 + j] - MISC[24 + j]);
        v[9] = (MISC[33] - MISC[16]) / 4;
        const unsigned dl = 800000u + 16u * v[TPROBE];
        const unsigned t0 = MISC[16];
        while ((unsigned)((unsigned)__builtin_amdgcn_s_memrealtime() - t0) < dl) __builtin_amdgcn_s_sleep(32);
    }
#endif
}

extern "C" void kernel_launch(void* const* d_in, const int* in_sizes, int n_in, void* d_out, int out_size, void* d_ws, size_t ws_size, hipStream_t stream) {
    static int grid = 0;
    if (grid == 0) {
        if (n_in != N_IN || (size_t)out_size != O_END || ws_size < WS_END) { fprintf(stderr, "kernel_launch: unexpected shapes (n_in %d, out %d, ws %zu)\n", n_in, out_size, ws_size); grid = -1; return; }
        int dev = 0, cus = 0, per_cu = 0;
        if (hipGetDevice(&dev) != hipSuccess || hipDeviceGetAttribute(&cus, hipDeviceAttributeMultiprocessorCount, dev) != hipSuccess) { grid = -1; return; }
        if (hipFuncSetAttribute((const void*)fwd_kernel, hipFuncAttributeMaxDynamicSharedMemorySize, LDS_BYTES) != hipSuccess) { fprintf(stderr, "kernel_launch: hipFuncSetAttribute failed\n"); grid = -1; return; }
        if (hipOccupancyMaxActiveBlocksPerMultiprocessor(&per_cu, (const void*)fwd_kernel, NTHR, LDS_BYTES) != hipSuccess || per_cu < 1) { fprintf(stderr, "kernel_launch: occupancy query says %d blocks per CU\n", per_cu); (void)hipGetLastError(); grid = -1; return; }
        grid = cus;
        if (grid < 64) { fprintf(stderr, "kernel_launch: needs at least 64 CUs (got %d)\n", cus); grid = -1; return; }
    }
    if (grid < 0) return;
    if (hipMemsetAsync((char*)d_ws + WS_CTL, 0, CTL_ZERO_BYTES, stream) != hipSuccess) { fprintf(stderr, "kernel_launch: hipMemsetAsync failed\n"); return; }
    Args a{};
    for (int i = 0; i < N_IN; ++i) a.in[i] = (const float*)d_in[i];
    a.out = (float*)d_out; a.ws = (unsigned char*)d_ws;
    void* kargs[] = {&a};
    hipError_t e = hipLaunchCooperativeKernel((const void*)fwd_kernel, dim3(grid), dim3(NTHR), kargs, LDS_BYTES, stream);
    if (e != hipSuccess) { fprintf(stderr, "kernel_launch: cooperative launch failed: %s (grid %d)\n", hipGetErrorString(e), grid); }
}
```

```cpp
#include <hip/hip_runtime.h>
#include <cstdio>
#include <cstdint>
namespace pg8 {
#define PG8_LAS __attribute__((address_space(3)))
typedef unsigned short bf16_t;
typedef short bf16x8 __attribute__((ext_vector_type(8)));
typedef float f32x4 __attribute__((ext_vector_type(4)));
typedef unsigned u32x4 __attribute__((ext_vector_type(4)));
constexpr int BM = 256, BK = 64, HALF = 128, HTB = HALF * BK * 2  , STAGE_BYTES = 8 * HTB, NXCD = 8, WGM = 8;

__host__ __device__ __forceinline__ int lds_byte(int r, int c) { const int st = (r >> 4) * 2 + (c >> 5), rr = r & 15, cc = c & 31, ob = rr * 64 + cc * 2; return st * 1024 + (ob ^ (((ob >> 9) & 1) << 5)); }
__host__ __device__ __forceinline__ void stage_rc(int b, int& R, int& C) { const int st = b / 1024, sb = b % 1024, swz = sb ^ (((sb >> 9) & 1) << 5); R = (st >> 1) * 16 + swz / 64; C = (st & 1) * 32 + (swz % 64) / 2; }
__host__ __device__ __forceinline__ int perm32(int rho) { const int n = rho >> 4, i = rho & 15; return 8 * (i >> 2) + 4 * n + (i & 3); }

struct Unit { int pm, pn; };
struct Gemm { const bf16_t* A; const bf16_t* Bt; int M, N, K; };

struct StaticOrder {
    int nM, nN, nwg, G, c;
    __host__ __device__ void init(int M, int N, int G_, int c_) { nM = M / BM; nN = N / BM; nwg = nM * nN; G = G_; c = c_; }
    __host__ __device__ bool next(int i, Unit& u) const {
        const long L = (long)i * G + c; if (L >= nwg) return false;
        int wgid = (int)L; { const int q = nwg / NXCD, r = nwg % NXCD, xcd = wgid % NXCD, off = wgid / NXCD; wgid = (xcd < r ? xcd * (q + 1) : r * (q + 1) + (xcd - r) * q) + off; }
        const int nig = WGM * nN, gid = wgid / nig, fm = gid * WGM, gsz = (nM - fm) < WGM ? (nM - fm) : WGM;
        u.pm = fm + ((wgid % nig) % gsz); u.pn = (wgid % nig) / gsz; return true;
    }
    __device__ __forceinline__ void a_ready(const Unit&) const {}
    __device__ __forceinline__ void done(const Unit&) const {}
};

__device__ __forceinline__ unsigned cvt_pk_bf16(float lo, float hi) { unsigned r; asm volatile("v_cvt_pk_bf16_f32 %0, %1, %2" : "=v"(r) : "v"(lo), "v"(hi)); return r; }
__device__ __forceinline__ float silu_f(float x) { return x * __builtin_amdgcn_rcpf(1.0f + __expf(-x)); }
struct EpiBf16 {
    static constexpr bool PERM = true, AFTER_DRAIN = false;
    bf16_t* O; int ldc; bf16_t* halo; bf16_t* vta; int vld; const float* rs;
    __device__ __forceinline__ void operator()(const f32x4 (&acc)[2][2][4][2], const Unit& u, int wr, int wc, int fr, int fq) const {
        const int row0 = u.pm * BM + wr * 64 + fr, col0 = u.pn * BM + wc * 32 + 8 * fq;
        const bool hz = halo != nullptr && u.pn >= 4 && u.pn <= 6;
#pragma unroll
        for (int ai = 0; ai < 2; ++ai)
#pragma unroll
            for (int m = 0; m < 4; ++m) { const int row = row0 + ai * HALF + m * 16; bf16_t* rowp = O + (size_t)row * ldc + col0;
                const float rstd = rs ? __builtin_amdgcn_rsqf(rs[row] * (1.0f / 1024.0f) + 1e-6f) : 1.0f;
#pragma unroll
                for (int bj = 0; bj < 2; ++bj) { const f32x4 v0 = acc[ai][bj][m][0] * rstd, v1 = acc[ai][bj][m][1] * rstd;
                    u32x4 w; w.x = cvt_pk_bf16(v0[0], v0[1]); w.y = cvt_pk_bf16(v0[2], v0[3]); w.z = cvt_pk_bf16(v1[0], v1[1]); w.w = cvt_pk_bf16(v1[2], v1[3]);
                    *(u32x4*)(rowp + bj * HALF) = w;
                    if (hz && (row & 63) >= 61) *(u32x4*)(halo + ((size_t)(row >> 6) * 3 + (row & 63) - 61) * 768 + (col0 - 1024) + bj * HALF) = w;
                    if (vta != nullptr && u.pn == 2) { bf16_t* vp = vta + (size_t)(col0 - 512 + bj * HALF) * vld + row;
                        vp[0] = (bf16_t)(w.x & 0xffffu); vp[(size_t)vld] = (bf16_t)(w.x >> 16); vp[(size_t)2 * vld] = (bf16_t)(w.y & 0xffffu); vp[(size_t)3 * vld] = (bf16_t)(w.y >> 16);
                        vp[(size_t)4 * vld] = (bf16_t)(w.z & 0xffffu); vp[(size_t)5 * vld] = (bf16_t)(w.z >> 16); vp[(size_t)6 * vld] = (bf16_t)(w.w & 0xffffu); vp[(size_t)7 * vld] = (bf16_t)(w.w >> 16); } } }
    }
};
struct EpiRes {
    static constexpr bool PERM = false, AFTER_DRAIN = false;
    const float* rlo; const float* rhi; float* C; const float* nw; bf16_t* xo; float* rs; const bf16_t* rbf; const float* rw; bf16_t* Cb;
    __device__ __forceinline__ void operator()(const f32x4 (&acc)[2][2][4][2], const Unit& u, int wr, int wc, int fr, int fq) const {
        const int row0 = u.pm * BM + wr * 64 + fr, col0 = u.pn * BM + wc * 32 + 4 * fq;
        const float* rb = (u.pm < 64) ? rlo : rhi;
        f32x4 wv[2][2], wq[2][2];
#pragma unroll
        for (int bj = 0; bj < 2; ++bj)
#pragma unroll
            for (int n = 0; n < 2; ++n) { wv[bj][n] = nw ? *(const f32x4*)(nw + col0 + bj * HALF + n * 16) : (f32x4){1.f, 1.f, 1.f, 1.f};
                if (rbf && rw) { const f32x4 t = *(const f32x4*)(rw + col0 + bj * HALF + n * 16); wq[bj][n] = (f32x4){__builtin_amdgcn_rcpf(t[0]), __builtin_amdgcn_rcpf(t[1]), __builtin_amdgcn_rcpf(t[2]), __builtin_amdgcn_rcpf(t[3])}; }
                else wq[bj][n] = (f32x4){1.f, 1.f, 1.f, 1.f}; }
#pragma unroll
        for (int ai = 0; ai < 2; ++ai)
#pragma unroll
        for (int mh = 0; mh < 2; ++mh) {
            f32x4 rv[2][2][2];
#pragma unroll
            for (int m2 = 0; m2 < 2; ++m2)
#pragma unroll
                for (int bj = 0; bj < 2; ++bj)
#pragma unroll
                    for (int n = 0; n < 2; ++n) { const size_t o = (size_t)(row0 + ai * HALF + (2 * mh + m2) * 16) * 1024 + col0 + bj * HALF + n * 16;
                        if (rbf) { const unsigned long long w = *(const unsigned long long*)(rbf + o); const unsigned lo = (unsigned)w, hi = (unsigned)(w >> 32);
                            rv[m2][bj][n] = (f32x4){__builtin_bit_cast(float, lo << 16), __builtin_bit_cast(float, lo & 0xffff0000u), __builtin_bit_cast(float, hi << 16), __builtin_bit_cast(float, hi & 0xffff0000u)} * wq[bj][n]; }
                        else rv[m2][bj][n] = *(const f32x4*)(rb + o); }
#pragma unroll
            for (int m2 = 0; m2 < 2; ++m2) { const int m = 2 * mh + m2; const int row = row0 + ai * HALF + m * 16; const size_t off = (size_t)row * 1024 + col0; float ss = 0.f;
#pragma unroll
                for (int bj = 0; bj < 2; ++bj)
#pragma unroll
                    for (int n = 0; n < 2; ++n) { const f32x4 x = rv[m2][bj][n] + acc[ai][bj][m][n]; if (C) *(f32x4*)(C + off + bj * HALF + n * 16) = x;
                        if (Cb) *(unsigned long long*)(Cb + off + bj * HALF + n * 16) = (unsigned long long)cvt_pk_bf16(x[0], x[1]) | ((unsigned long long)cvt_pk_bf16(x[2], x[3]) << 32);
                        if (nw) { ss += (x[0] * x[0] + x[1] * x[1]) + (x[2] * x[2] + x[3] * x[3]); const f32x4 y = x * wv[bj][n];
                            *(unsigned long long*)(xo + off + bj * HALF + n * 16) = (unsigned long long)cvt_pk_bf16(y[0], y[1]) | ((unsigned long long)cvt_pk_bf16(y[2], y[3]) << 32); } }
                if (nw) { const int lane = fq * 16 + fr;
                    ss += __builtin_bit_cast(float, __builtin_amdgcn_ds_bpermute((lane ^ 16) << 2, __builtin_bit_cast(int, ss)));
                    ss += __builtin_bit_cast(float, __builtin_amdgcn_ds_bpermute((lane ^ 32) << 2, __builtin_bit_cast(int, ss)));
                    if (fq == 0) atomicAdd(rs + row, ss); } }
            asm volatile("" ::: "memory");
        }
    }
};
struct EpiSwiGLU {
    static constexpr bool PERM = true, AFTER_DRAIN = false;
    bf16_t* O; int ldc; const float* rs;
    __device__ __forceinline__ void operator()(const f32x4 (&acc)[2][2][4][2], const Unit& u, int wr, int wc, int fr, int fq) const {
        const int row0 = u.pm * BM + wr * 64 + fr, col0 = u.pn * HALF + wc * 32 + 8 * fq;
#pragma unroll
        for (int ai = 0; ai < 2; ++ai)
#pragma unroll
            for (int m = 0; m < 4; ++m) { const int row = row0 + ai * HALF + m * 16; bf16_t* rowp = O + (size_t)row * ldc + col0;
                const float rstd = __builtin_amdgcn_rsqf(rs[row] * (1.0f / 1024.0f) + 1e-6f);
                const f32x4 g0 = acc[ai][0][m][0] * rstd, g1 = acc[ai][0][m][1] * rstd, u0 = acc[ai][1][m][0] * rstd, u1 = acc[ai][1][m][1] * rstd;
                u32x4 w; w.x = cvt_pk_bf16(silu_f(g0[0]) * u0[0], silu_f(g0[1]) * u0[1]); w.y = cvt_pk_bf16(silu_f(g0[2]) * u0[2], silu_f(g0[3]) * u0[3]);
                w.z = cvt_pk_bf16(silu_f(g1[0]) * u1[0], silu_f(g1[1]) * u1[1]); w.w = cvt_pk_bf16(silu_f(g1[2]) * u1[2], silu_f(g1[3]) * u1[3]);
                *(u32x4*)rowp = w; }
    }
};
template <class Epi, class Sched, bool ALIGN_EPI = false, bool SP2 = false>
__device__ __forceinline__ void gemm_phase(PG8_LAS unsigned char* lds, const Gemm g, const Sched& S, const Epi& E) {
    int tid0 = threadIdx.x; asm volatile("" : "+v"(tid0));
    const int tid = tid0, wid = __builtin_amdgcn_readfirstlane(tid >> 6), lane = tid & 63, wr = wid >> 2, wc = wid & 3, fr = lane & 15, fq = lane >> 4;
    const int K = g.K, nt = K / BK;
    unsigned voffA[2], voffB[2];
#pragma unroll
    for (int i = 0; i < 2; ++i) { int R, C; stage_rc(tid * 16 + i * 8192, R, C); const int Rb = Epi::PERM ? ((R & ~31) + perm32(R & 31)) : R;
        voffA[i] = (unsigned)(R * K + C) * 2u; voffB[i] = (unsigned)(Rb * K + C) * 2u; }
    const size_t kstep = (size_t)(BK * 2);
    const size_t hstep = (size_t)HALF * K * 2;
    const size_t tstep = 2 * hstep;
    const unsigned ldsw = (unsigned)wid * 1024u;
    const int aoff = lds_byte(wr * 64 + fr, fq * 8), boff = lds_byte(wc * 32 + fr, fq * 8);
#define PG8_SA(b, h) (((b) * 2 + (h)) * HTB)
#define PG8_SB(b, h) ((4 + (b) * 2 + (h)) * HTB)
#define PG8_STAGE(bufoff, gbase, voff) do { _Pragma("unroll") for (int _i = 0; _i < 2; ++_i) \
        __builtin_amdgcn_global_load_lds((const unsigned*)((const char*)(gbase) + (voff)[_i]), (PG8_LAS unsigned*)(lds + (bufoff) + ldsw + _i * 8192), 16, 0, 0); } while (0)
#define PG8_LDA(dst, b, h) do { _Pragma("unroll") for (int m = 0; m < 4; ++m) _Pragma("unroll") for (int k = 0; k < 2; ++k) dst[m][k] = *(const PG8_LAS bf16x8*)(lds + PG8_SA(b, h) + aoff + m * 2048 + k * 1024); } while (0)
#define PG8_LDB(dst, b, h) do { _Pragma("unroll") for (int n = 0; n < 2; ++n) _Pragma("unroll") for (int k = 0; k < 2; ++k) dst[n][k] = *(const PG8_LAS bf16x8*)(lds + PG8_SB(b, h) + boff + n * 2048 + k * 1024); } while (0)
#define PG8_MMA(ai, bj, At, Bt) do { __builtin_amdgcn_s_setprio(1); _Pragma("unroll") for (int m = 0; m < 4; ++m) _Pragma("unroll") for (int n = 0; n < 2; ++n) _Pragma("unroll") for (int k = 0; k < 2; ++k) \
        acc[ai][bj][m][n] = __builtin_amdgcn_mfma_f32_16x16x32_bf16(Bt[n][k], At[m][k], acc[ai][bj][m][n], 0, 0, 0); __builtin_amdgcn_s_setprio(0); } while (0)
#define PG8_WAIT_V(n) asm volatile("s_waitcnt vmcnt(" #n ")" ::: "memory")
#define PG8_WAIT_L(n) asm volatile("s_waitcnt lgkmcnt(" #n ")" ::: "memory")
#define PG8_BAR __builtin_amdgcn_s_barrier()
#define PG8_SCHED __builtin_amdgcn_sched_barrier(0)
    Unit cur, nxt; int ui = 0;
    if (!S.next(0, cur)) return;
    f32x4 acc[2][2][4][2];
#pragma unroll
    for (int a = 0; a < 2; ++a)
#pragma unroll
        for (int b = 0; b < 2; ++b)
#pragma unroll
            for (int m = 0; m < 4; ++m)
#pragma unroll
                for (int n = 0; n < 2; ++n) acc[a][b][m][n] = (f32x4){0.f, 0.f, 0.f, 0.f};
    bf16x8 At[4][2], B0[2][2], B1[2][2];
    const char* cA = (const char*)g.A + (size_t)cur.pm * tstep; const char* cB = (const char*)g.Bt + (size_t)cur.pn * tstep;
    S.a_ready(cur);
    if constexpr (SP2) {
        PG8_STAGE(PG8_SB(0, 0), cB, voffB); PG8_STAGE(PG8_SB(0, 1), cB + hstep, voffB); PG8_STAGE(PG8_SA(0, 0), cA, voffA); PG8_STAGE(PG8_SA(0, 1), cA + hstep, voffA);
        if (wr == 1) PG8_BAR;
        PG8_WAIT_V(2); PG8_BAR;
        PG8_STAGE(PG8_SB(1, 0), cB + kstep, voffB); PG8_STAGE(PG8_SA(1, 0), cA + kstep, voffA); PG8_STAGE(PG8_SB(1, 1), cB + hstep + kstep, voffB);
        PG8_WAIT_V(6); PG8_BAR;
    } else {
        PG8_STAGE(PG8_SB(0, 0), cB, voffB); PG8_STAGE(PG8_SA(0, 0), cA, voffA); PG8_STAGE(PG8_SB(0, 1), cB + hstep, voffB); PG8_STAGE(PG8_SA(0, 1), cA + hstep, voffA);
        if (wr == 1) PG8_BAR;
        PG8_WAIT_V(4); PG8_BAR;
        PG8_STAGE(PG8_SB(1, 0), cB + kstep, voffB); PG8_STAGE(PG8_SA(1, 0), cA + kstep, voffA); PG8_STAGE(PG8_SB(1, 1), cB + hstep + kstep, voffB);
        PG8_WAIT_V(6); PG8_BAR;
    }
    for (;;) {
        const bool has_next = S.next(ui + 1, nxt);
        const char* nA = has_next ? (const char*)g.A + (size_t)nxt.pm * tstep : cA; const char* nB = has_next ? (const char*)g.Bt + (size_t)nxt.pn * tstep : cB;
        for (int t = 0; t < nt; t += 2) {
            const bool last = (t == nt - 2);
            const char* a1 = cA + (size_t)(t + 1) * kstep;
            const char* a2 = last ? nA : cA + (size_t)(t + 2) * kstep; const char* b2 = last ? nB : cB + (size_t)(t + 2) * kstep;
            const char* a3 = a2 + kstep; const char* b3 = b2 + kstep;
            if (last && has_next) S.a_ready(nxt);
            if constexpr (SP2) {
            PG8_LDB(B0, 0, 0); PG8_LDB(B1, 0, 1); PG8_SCHED; PG8_LDA(At, 0, 0); PG8_STAGE(PG8_SA(1, 1), a1 + hstep, voffA);
            PG8_WAIT_V(8); PG8_WAIT_L(0); PG8_BAR; PG8_MMA(0, 0, At, B0); PG8_MMA(0, 1, At, B1); PG8_BAR; PG8_SCHED;
            PG8_LDA(At, 0, 1); PG8_STAGE(PG8_SB(0, 0), b2, voffB); PG8_STAGE(PG8_SB(0, 1), b2 + hstep, voffB); PG8_STAGE(PG8_SA(0, 0), a2, voffA);
            PG8_WAIT_V(8); PG8_WAIT_L(0); PG8_BAR; PG8_MMA(1, 0, At, B0); PG8_MMA(1, 1, At, B1); PG8_BAR; PG8_SCHED;
            PG8_LDB(B0, 1, 0); PG8_LDB(B1, 1, 1); PG8_SCHED; PG8_LDA(At, 1, 0); PG8_STAGE(PG8_SA(0, 1), a2 + hstep, voffA);
            PG8_WAIT_V(8); PG8_WAIT_L(0); PG8_BAR; PG8_MMA(0, 0, At, B0); PG8_MMA(0, 1, At, B1); PG8_BAR; PG8_SCHED;
            PG8_LDA(At, 1, 1); PG8_STAGE(PG8_SB(1, 0), b3, voffB); PG8_STAGE(PG8_SB(1, 1), b3 + hstep, voffB); PG8_STAGE(PG8_SA(1, 0), a3, voffA);
            PG8_WAIT_V(8); PG8_WAIT_L(0); PG8_BAR; PG8_MMA(1, 0, At, B0); PG8_MMA(1, 1, At, B1); PG8_BAR; PG8_SCHED;
            } else {
            PG8_LDB(B0, 0, 0); PG8_SCHED; PG8_LDA(At, 0, 0); PG8_STAGE(PG8_SA(1, 1), a1 + hstep, voffA);
            PG8_WAIT_L(8); PG8_BAR; PG8_WAIT_L(0); PG8_MMA(0, 0, At, B0); PG8_BAR; PG8_SCHED;
            PG8_LDB(B1, 0, 1); PG8_STAGE(PG8_SB(0, 0), b2, voffB);
            PG8_BAR; PG8_WAIT_L(0); PG8_MMA(0, 1, At, B1); PG8_BAR;
            PG8_LDA(At, 0, 1); PG8_STAGE(PG8_SA(0, 0), a2, voffA);
            PG8_BAR; PG8_WAIT_L(0); PG8_MMA(1, 0, At, B0); PG8_BAR; PG8_SCHED;
            PG8_STAGE(PG8_SB(0, 1), b2 + hstep, voffB);
            PG8_WAIT_V(6); PG8_BAR; PG8_MMA(1, 1, At, B1); PG8_BAR;
            PG8_LDB(B0, 1, 0); PG8_SCHED; PG8_LDA(At, 1, 0); PG8_STAGE(PG8_SA(0, 1), a2 + hstep, voffA);
            PG8_WAIT_L(8); PG8_BAR; PG8_WAIT_L(0); PG8_MMA(0, 0, At, B0); PG8_BAR; PG8_SCHED;
            PG8_LDB(B1, 1, 1); PG8_STAGE(PG8_SB(1, 0), b3, voffB);
            PG8_BAR; PG8_WAIT_L(0); PG8_MMA(0, 1, At, B1); PG8_BAR;
            PG8_LDA(At, 1, 1); PG8_STAGE(PG8_SA(1, 0), a3, voffA);
            PG8_BAR; PG8_WAIT_L(0); PG8_MMA(1, 0, At, B0); PG8_BAR; PG8_SCHED;
            PG8_STAGE(PG8_SB(1, 1), b3 + hstep, voffB);
            PG8_WAIT_V(6); PG8_BAR; PG8_MMA(1, 1, At, B1); PG8_BAR;
            }
        }
        if constexpr (ALIGN_EPI) { if (wr == 0) PG8_BAR; }
        if constexpr (!Epi::AFTER_DRAIN) { E(acc, cur, wr, wc, fr, fq); S.done(cur); }
        if (!has_next) break;
#pragma unroll
        for (int a = 0; a < 2; ++a)
#pragma unroll
            for (int b = 0; b < 2; ++b)
#pragma unroll
                for (int m = 0; m < 4; ++m)
#pragma unroll
                    for (int n = 0; n < 2; ++n) acc[a][b][m][n] = (f32x4){0.f, 0.f, 0.f, 0.f};
        cur = nxt; cA = nA; cB = nB; ++ui;
        if constexpr (ALIGN_EPI) { if (wr == 1) PG8_BAR; }
    }
    PG8_WAIT_V(0);
    if constexpr (!ALIGN_EPI) { if (wr == 0) PG8_BAR; }
    PG8_BAR;
    if constexpr (Epi::AFTER_DRAIN) { E.fused(acc, cur, wr, wc, fr, fq, lds, wid, lane); S.done(cur); }
#undef PG8_SA
#undef PG8_SB
#undef PG8_STAGE
#undef PG8_LDA
#undef PG8_LDB
#undef PG8_MMA
#undef PG8_WAIT_V
#undef PG8_WAIT_L
#undef PG8_BAR
#undef PG8_SCHED
}
}
#define GAS __attribute__((address_space(1)))
#define LAS __attribute__((address_space(3)))
typedef unsigned short bf16;
typedef unsigned v4u __attribute__((ext_vector_type(4)));
typedef float f32x4 __attribute__((ext_vector_type(4)));
typedef short bf16x8 __attribute__((ext_vector_type(8)));
typedef GAS unsigned gu32;
typedef GAS unsigned long long gu64;
#define RLX_AGENT __ATOMIC_RELAXED, __HIP_MEMORY_SCOPE_AGENT
#define LDS_WAIT() asm volatile("s_waitcnt lgkmcnt(0)" ::: "memory")
#define VM_WAIT() asm volatile("s_waitcnt vmcnt(0)" ::: "memory")
__device__ __forceinline__ unsigned long long rt() { return __builtin_amdgcn_s_memrealtime(); }
__device__ __forceinline__ unsigned f2bf(float f) { unsigned u = __builtin_bit_cast(unsigned, f); return (u + 0x7fffu + ((u >> 16) & 1u)) >> 16; }
__device__ __forceinline__ unsigned pk2(float lo, float hi) { return f2bf(lo) | (f2bf(hi) << 16); }
#define XB_TMO      128
#define XB_XCNT(j)  (256  + 64 * (j))
#define XB_XSUB(j)  (1280 + 64 * (j))
#define XB_XGEN(j)  (2304 + 64 * (j))
#define XB_TOP      3328
#define XB_TOPGEN   3392
#define XCD_BAR_WORDS 3456
#define XB_SPIN_CAP (1u << 18)

__device__ __forceinline__ unsigned xb_ld(unsigned* p)              { return __hip_atomic_load(p, __ATOMIC_RELAXED, __HIP_MEMORY_SCOPE_AGENT); }
__device__ __forceinline__ unsigned xb_add(unsigned* p, unsigned v) { return __hip_atomic_fetch_add(p, v, __ATOMIC_RELAXED, __HIP_MEMORY_SCOPE_AGENT); }
__device__ __forceinline__ unsigned xb_xcc_id() { return (unsigned)__builtin_amdgcn_s_getreg((3 << 11) | 20) & 0xFu; }
#define XB_SPIN(cond, bar) do { unsigned _sp = 0; while (cond) { __builtin_amdgcn_s_sleep(1); \
    if ((++_sp & 255u) == 0u) { if (xb_ld(&(bar)[XB_TMO])) break; if (_sp > XB_SPIN_CAP) { atomicAdd(&(bar)[XB_TMO], 1u); break; } } } } while (0)

struct XcdBarrier {
    unsigned* bar; unsigned x;
    volatile LAS unsigned* st;
};

__device__ __forceinline__ XcdBarrier xcd_barrier_post(unsigned* bar, volatile LAS unsigned* st) {
    XcdBarrier b; b.bar = bar; b.x = xb_xcc_id(); b.st = st;
    if (threadIdx.x == 0) (void)xb_add(&bar[XB_XCNT(b.x)], 1u);
    return b;
}
__device__ __forceinline__ void xcd_barrier_complete(unsigned* bar, unsigned x, unsigned& nloc, unsigned& nx) {
    const unsigned G = gridDim.x * gridDim.y * gridDim.z;
    unsigned sum, cnt, mine, sp = 0u;
    for (;;) {
        sum = 0u; cnt = 0u; mine = 0u;
#pragma unroll
        for (unsigned j = 0; j < 16; ++j) { const unsigned c = xb_ld(&bar[XB_XCNT(j)]); sum += c; cnt += (c > 0u) ? 1u : 0u; mine = (j == x) ? c : mine; }
        if (sum == G) break;
        __builtin_amdgcn_s_sleep(1);
        if ((++sp & 255u) == 0u) { if (xb_ld(&bar[XB_TMO])) break; if (sp > XB_SPIN_CAP) { atomicAdd(&bar[XB_TMO], 1u); break; } }
    }
    nloc = mine > 0u ? mine : 1u; nx = cnt > 0u ? cnt : 1u;
}

__device__ __forceinline__ void xcd_barrier(const XcdBarrier& b) {
    asm volatile("s_waitcnt vmcnt(0)" ::: "memory");
    __syncthreads();
    if (threadIdx.x == 0) {
        unsigned* bar = b.bar;
        __builtin_amdgcn_s_waitcnt(0);
        unsigned nloc = b.st[0], nx = b.st[1];
        if (nloc == 0u) { xcd_barrier_complete(bar, b.x, nloc, nx); b.st[0] = nloc; b.st[1] = nx; }
        const unsigned old = xb_add(&bar[XB_XSUB(b.x)], 1u);
        const unsigned gen = old / nloc;
        if (old + 1u == (gen + 1u) * nloc) {
            __builtin_amdgcn_fence(__ATOMIC_RELEASE, "agent");
            asm volatile("s_waitcnt vmcnt(0)" ::: "memory");
            const unsigned og = xb_add(&bar[XB_TOP], 1u);
            const unsigned tg = og / nx;
            if (og + 1u == (tg + 1u) * nx) xb_add(&bar[XB_TOPGEN], 1u);
            else XB_SPIN(xb_ld(&bar[XB_TOPGEN]) == tg, bar);
            __builtin_amdgcn_fence(__ATOMIC_ACQUIRE, "agent");
            xb_add(&bar[XB_XGEN(b.x)], 1u);
            asm volatile("s_waitcnt vmcnt(0)" ::: "memory");
        } else {
            XB_SPIN(xb_ld(&bar[XB_XGEN(b.x)]) == gen, bar);
            __builtin_amdgcn_fence(__ATOMIC_ACQUIRE, "agent");
            asm volatile("s_waitcnt vmcnt(0)" ::: "memory");
        }
    }
    __syncthreads();
}
constexpr int NWAVES = 8, NTHR = 512;
constexpr int D = 1024, MP = 16384, NSB = 16, SSEQ = 16, MS = NSB * SSEQ, M = MP + MS;
constexpr int NIN = 3076, NPROJ = 3072, DFF = 2816, NGU = 2 * DFF;
constexpr int NCHP = 256, NCH = NCHP + NSB;
constexpr int PC_Q = 0, PC_K = 256, PC_V = 512, PC_Z = 768, PC_X = 1024, PC_B = 1280, PC_C = 1536, PC_CQ = 1792, PC_CF = 2048, PC_CI = 2304, PC_CG = 2560, PC_DX = 2816;
constexpr float EPS = 1e-6f;
enum { I_XP = 0, I_XS, I_CK, I_CV, I_SCONV, I_SSSM, I_SHGRN, I_SPOOL, I_N1, I_WIN, I_AREL, I_CW, I_CB, I_DTB, I_ALOG, I_BD, I_BNRM, I_LB, I_CNRM, I_PW, I_PS, I_WOUT, I_N2, I_WGU, I_WDN, I_NF, N_IN };
constexpr size_t O_YP = 0, O_YS = O_YP + (size_t)MP * D, O_PK = O_YS + (size_t)MS * D, O_PV = O_PK + 2 * 512 * 256, O_PCONV = O_PV + 2 * 512 * 256, O_PSSM = O_PCONV + 2 * 3 * 768,
                 O_PHGRN = O_PSSM + 2 * 4 * 64 * 128, O_PPOOL = O_PHGRN + 2 * 4 * 64 * 64, O_SK = O_PPOOL + 2 * 15 * 256, O_SV = O_SK + (size_t)2 * 16 * 512 * 256,
                 O_SCONV = O_SV + (size_t)2 * 16 * 512 * 256, O_SSSM = O_SCONV + 2 * 16 * 3 * 768, O_SHGRN = O_SSSM + 2 * 16 * 4 * 64 * 128, O_SPOOL = O_SHGRN + 2 * 16 * 4 * 64 * 64,
                 O_END = O_SPOOL + 2 * 16 * 15 * 256;
constexpr size_t MiB = 1u << 20;
constexpr size_t WS_CTL = 0, CTL_ZERO_BYTES = 64 * 1024;
constexpr size_t WL_IN = 0, WL_OUT = 6 * MiB, WL_GU = 8 * MiB, WL_DN = 19 * MiB, WL_STRIDE = 24 * MiB + MiB / 2;
constexpr size_t WS_W = 1 * MiB;
constexpr size_t WS_XN = 50 * MiB;
constexpr size_t WS_PROJ = 83 * MiB;
constexpr size_t WS_STB = 181 * MiB;
constexpr size_t WS_XT = 198 * MiB;
constexpr size_t WS_HALO = 207 * MiB;
constexpr size_t WS_RH = 208 * MiB + MiB / 2;
constexpr size_t WS_STC = 215 * MiB;
constexpr size_t WS_VT = 223 * MiB + MiB / 2;
constexpr size_t WS_DT = 232 * MiB;
constexpr size_t WS_DECB = 233 * MiB;
constexpr size_t WS_DECC = 233 * MiB + 64 * 1024;
constexpr size_t WS_ACS = 233 * MiB + 384 * 1024, WS_DTV = 233 * MiB + 704 * 1024;
constexpr size_t WS_VTA = 234 * MiB;
constexpr size_t WS_END = 243 * MiB;
static_assert(WS_VTA + (size_t)256 * M * 2 <= WS_END, "ws map 2");
constexpr int CW_QUEUE = 512;
static_assert(WS_XN + (size_t)M * D * 2 <= WS_PROJ && WS_PROJ + (size_t)M * NPROJ * 2 <= WS_STB && WS_STB + (size_t)NCH * 4 * 64 * 128 * 2 <= WS_XT && WS_XT + (size_t)NCH * 256 * 64 * 2 <= WS_HALO && WS_HALO + (size_t)256 * 3 * 768 * 2 <= WS_STC && WS_RH + (size_t)NCH * 1280 * 4 <= WS_STC && WS_STC + (size_t)NCH * 4 * 64 * 64 * 2 <= WS_VT && WS_VT + (size_t)NCH * 256 * 64 * 2 <= WS_DT, "ws map");
static_assert(WL_DN + (size_t)D * DFF * 2 <= WL_STRIDE && WS_W + 2 * WL_STRIDE <= WS_XN, "weight map");
constexpr size_t WS_WPT = 128 * 1024;
constexpr size_t WS_WDT = 192 * 1024;
constexpr size_t WS_RS = 256 * 1024;
constexpr size_t WS_XN2 = 181 * MiB;
static_assert(WS_XN2 + (size_t)M * D * 2 <= 232 * MiB && WS_RS + 3 * (size_t)M * 4 <= MiB, "ws map 3");
constexpr int CW_BAR = 1024;
constexpr int LDS_BYTES = 163840;
constexpr int MISC_OFF = LDS_BYTES - 256;
constexpr int RING_OFF = 0;
typedef LAS float lf32;
typedef float f32x2 __attribute__((ext_vector_type(2)));
struct Args { const float* in[N_IN]; float* out; unsigned char* ws; };
struct Frame {
    LAS unsigned char* lds;
    float* out; unsigned char* ws;
};
__device__ __forceinline__ float* inp(int i) { asm volatile("" : "+s"(i)); return ((float* const __attribute__((address_space(4)))*)__builtin_amdgcn_kernarg_segment_ptr())[i]; }
__device__ __forceinline__ unsigned char* opq(unsigned char* p) { asm volatile("" : "+s"(p)); return p; }
#define ITEM_IDS() int tid_ = threadIdx.x; asm volatile("" : "+v"(tid_)); const int wave_ = __builtin_amdgcn_readfirstlane(tid_ >> 6); const int lane_ = tid_ & 63; (void)lane_; (void)wave_
#define F_XN ((bf16*)opq(F.ws + WS_XN))
#define F_PROJ ((bf16*)opq(F.ws + WS_PROJ))
#define F_ACT ((bf16*)opq(F.ws + WS_PROJ))
#define F_STB ((bf16*)opq(F.ws + WS_STB))
#define F_XT ((bf16*)opq(F.ws + WS_XT))
#define F_HALO ((bf16*)opq(F.ws + WS_HALO))
#define F_ACS ((float*)opq(F.ws + WS_ACS))
#define F_DTV ((float*)opq(F.ws + WS_DTV))
#define F_STC ((bf16*)opq(F.ws + WS_STC))
#define F_VT ((bf16*)opq(F.ws + WS_VT))
#define F_RH ((float*)opq(F.ws + WS_RH))
#define F_VTA ((bf16*)opq(F.ws + WS_VTA))
#define F_WPT ((bf16*)opq(F.ws + WS_WPT))
#define F_RS ((float*)opq(F.ws + WS_RS))
#define F_WDT ((bf16*)opq(F.ws + WS_WDT))
#define F_XN2 ((bf16*)opq(F.ws + WS_XN2))
#define F_DT ((float*)opq(F.ws + WS_DT))
#define F_DECB ((float*)opq(F.ws + WS_DECB))
#define F_DECC ((float*)opq(F.ws + WS_DECC))
#define F_X    (F.out)
__device__ __forceinline__ float bf_lo(unsigned w) { return __builtin_bit_cast(float, w << 16); }
__device__ __forceinline__ float bf_hi(unsigned w) { return __builtin_bit_cast(float, w & 0xffff0000u); }
__device__ __forceinline__ float bf1(bf16 b) { return __builtin_bit_cast(float, (unsigned)b << 16); }
__device__ __forceinline__ void unpack8(const v4u w, float (&v)[8]) { v[0] = bf_lo(w.x); v[1] = bf_hi(w.x); v[2] = bf_lo(w.y); v[3] = bf_hi(w.y); v[4] = bf_lo(w.z); v[5] = bf_hi(w.z); v[6] = bf_lo(w.w); v[7] = bf_hi(w.w); }
__device__ __forceinline__ v4u pack8(const float (&v)[8]) { v4u o; o.x = pk2(v[0], v[1]); o.y = pk2(v[2], v[3]); o.z = pk2(v[4], v[5]); o.w = pk2(v[6], v[7]); return o; }
__device__ __forceinline__ float shx(int lane, float v, int o) { return __builtin_bit_cast(float, __builtin_amdgcn_ds_bpermute((lane ^ o) << 2, __builtin_bit_cast(int, v))); }
__device__ __forceinline__ float shu(int lane, float v, int o) { return __builtin_bit_cast(float, __builtin_amdgcn_ds_bpermute((lane - o) << 2, __builtin_bit_cast(int, v))); }
__device__ __forceinline__ float shi(float v, int idx) { return __builtin_bit_cast(float, __builtin_amdgcn_ds_bpermute(idx << 2, __builtin_bit_cast(int, v))); }
__device__ __forceinline__ float wave_sum_l(int lane, float v) {
#pragma unroll
    for (int o = 1; o < 64; o <<= 1) v += shx(lane, v, o);
    return v;
}
__device__ __forceinline__ float sum16_l(int lane, float v) {
#pragma unroll
    for (int o = 1; o < 16; o <<= 1) v += shx(lane, v, o);
    return v;
}
__device__ __forceinline__ float max16_l(int lane, float v) {
#pragma unroll
    for (int o = 1; o < 16; o <<= 1) v = fmaxf(v, shx(lane, v, o));
    return v;
}
__device__ __forceinline__ float rcp_f(float x) { return __builtin_amdgcn_rcpf(x); }
__device__ __forceinline__ float rsq_f(float x) { return __builtin_amdgcn_rsqf(x); }
__device__ __forceinline__ float sigmoid_f(float x) { return rcp_f(1.0f + __expf(-x)); }
__device__ __forceinline__ float silu_g(float x) { return x * rcp_f(1.0f + __expf(-x)); }
__device__ __forceinline__ float softplus_f(float x) { const float e = __expf(x); return x > 20.f ? x : (e < 0.01f ? e * (1.0f - e * (0.5f - e * (1.0f / 3.0f))) : __logf(1.0f + e)); }
__device__ __forceinline__ f32x4 mfma4(float a, float b, f32x4 c) { return __builtin_amdgcn_mfma_f32_16x16x4f32(a, b, c, 0, 0, 0); }

struct Chunk { int ci, row0, nrows, b; };
__device__ __forceinline__ Chunk chunk_of(int ci) { Chunk c; c.ci = ci; if (ci < NCHP) { c.row0 = 64 * ci; c.nrows = 64; c.b = -1; } else { c.b = ci - NCHP; c.row0 = MP + SSEQ * c.b; c.nrows = SSEQ; } return c; }

__device__ __forceinline__ void tr_item64(const float* W, int ldw, int K, bf16* WT, int k0, int nd0, int ns0, float scale, lf32* scr, int lane) {
    f32x4 wv_[16];
    const int rq = lane >> 4, c4 = (lane & 15) * 4;
#pragma unroll
    for (int i = 0; i < 16; ++i) wv_[i] = *(const f32x4*)(W + (size_t)(k0 + 4 * i + rq) * ldw + ns0 + c4);
#pragma unroll
    for (int i = 0; i < 16; ++i) { lf32* d = scr + (4 * i + rq) * 65 + c4; d[0] = wv_[i].x; d[1] = wv_[i].y; d[2] = wv_[i].z; d[3] = wv_[i].w; }
    LDS_WAIT(); asm volatile("" ::: "memory");
    const int c = lane & 7;
#pragma unroll
    for (int j = 0; j < 8; ++j) { const int n = (lane >> 3) + 8 * j; const lf32* s = scr + (8 * c) * 65 + n;
        v4u o; o.x = pk2(s[0 * 65] * scale, s[1 * 65] * scale); o.y = pk2(s[2 * 65] * scale, s[3 * 65] * scale); o.z = pk2(s[4 * 65] * scale, s[5 * 65] * scale); o.w = pk2(s[6 * 65] * scale, s[7 * 65] * scale);
        *(GAS v4u*)(WT + (size_t)(nd0 + n) * K + k0 + 8 * c) = o; }
    LDS_WAIT(); asm volatile("" ::: "memory");
}
__device__ __forceinline__ void tr_item(const float* W, int ldw, int K, bf16* WT, int k0, int nd0, int ns0, float scale, lf32* scr, int lane) {
    float wv_[32];
#pragma unroll
    for (int i = 0; i < 32; ++i) wv_[i] = W[(size_t)(k0 + 2 * i + (lane >> 5)) * ldw + ns0 + (lane & 31)];
#pragma unroll
    for (int i = 0; i < 32; ++i) scr[(2 * i + (lane >> 5)) * 33 + (lane & 31)] = wv_[i];
    LDS_WAIT(); asm volatile("" ::: "memory");
    const int c = lane & 7;
#pragma unroll
    for (int j = 0; j < 4; ++j) { const int n = (lane >> 3) + 8 * j; const lf32* s = scr + (8 * c) * 33 + n;
        v4u o; o.x = pk2(s[0 * 33] * scale, s[1 * 33] * scale); o.y = pk2(s[2 * 33] * scale, s[3 * 33] * scale); o.z = pk2(s[4 * 33] * scale, s[5 * 33] * scale); o.w = pk2(s[6 * 33] * scale, s[7 * 33] * scale);
        *(GAS v4u*)(WT + (size_t)(nd0 + n) * K + k0 + 8 * c) = o; }
    LDS_WAIT(); asm volatile("" ::: "memory");
}
__device__ __forceinline__ void p0_weights(Frame& F, int l, int gw, int NGW, bool pool, int part = 2  ) {
    ITEM_IDS();
    lf32* scr = (lf32*)(F.lds + wave_ * 16896);
    constexpr int I_INA = 16 * 28, I_INB = 16 * 40, I_OUT = 16 * 16, I_GU = 16 * 88, I_DN = 44 * 16, I_L = I_INA + I_INB + I_OUT + I_GU + I_DN;
    unsigned char* wl = F.ws + WS_W + (size_t)l * WL_STRIDE;
    const int i_lo = part == 1 ? I_INA + I_INB : 0, i_hi = part == 0 ? I_INA + I_INB : I_L;
    for (int it = i_lo + gw; it < i_hi; it += NGW) {
        int r = it;
        if (r < I_INA) { const int kb = r / 28, nb = r % 28, nd0 = 64 * nb; tr_item64(inp(I_WIN) + (size_t)l * D * NIN, NIN, D, (bf16*)(wl + WL_IN), 64 * kb, nd0, nd0, nd0 < 256 ? 0.125f : 1.0f, scr, lane_); continue; } r -= I_INA;
        if (r < I_INB) { const int kb = r / 40, nb = r % 40, nd0 = 1792 + 32 * nb; tr_item(inp(I_WIN) + (size_t)l * D * NIN, NIN, D, (bf16*)(wl + WL_IN), 64 * kb, nd0, nd0 + 4, 1.0f, scr, lane_); continue; } r -= I_INB;
        if (r < I_OUT) { const int kb = r / 16, nb = r % 16; tr_item64(inp(I_WOUT) + (size_t)l * D * D, D, D, (bf16*)(wl + WL_OUT), 64 * kb, 64 * nb, 64 * nb, 1.0f, scr, lane_); continue; } r -= I_OUT;
        if (r < I_GU) { const int kb = r / 88, nb = r % 88, nd0 = 64 * nb, pn = nd0 >> 8, bj = (nd0 >> 7) & 1, c = nd0 & 127; tr_item64(inp(I_WGU) + (size_t)l * D * NGU, NGU, D, (bf16*)(wl + WL_GU), 64 * kb, nd0, bj * DFF + 128 * pn + c, 1.0f, scr, lane_); continue; } r -= I_GU;
        { const int kb = r / 16, nb = r % 16; tr_item64(inp(I_WDN) + (size_t)l * DFF * D, D, DFF, (bf16*)(wl + WL_DN), 64 * kb, 64 * nb, 64 * nb, 1.0f, scr, lane_); }
    }
    if (pool) { const float* pw = inp(I_PW); for (int i = ((int)blockIdx.x) * NTHR + tid_; i < 2 * 4 * 64 * 64; i += ((int)gridDim.x) * NTHR) { const int c = i & 63, d = (i >> 6) & 63, lg = i >> 12; F_WPT[i] = (bf16)f2bf(pw[(size_t)(lg * 64 + c) * 64 + d]); } }
}
template <bool WITH_DT, bool FINAL>
__device__ __forceinline__ void norm_rows(Frame& F, const float* xlo, const float* xhi, const float* w, const float* wdt  , const bf16* xb = nullptr  , int gw_ = -1, int ngw_ = 0  , bf16* xcopy = nullptr  ) {
    ITEM_IDS();
    lf32* wl = (lf32*)(F.lds + (gw_ >= 0 ? 135168 : 0));
    if (WITH_DT && gw_ < 0) { for (int k = tid_; k < D; k += NTHR) { const f32x4 v = *(const f32x4*)(wdt + (size_t)k * NIN + 1792); *(LAS f32x4*)(wl + 4 * k) = v; } __syncthreads(); }
    const int gw = gw_ >= 0 ? gw_ : ((int)blockIdx.x) * NWAVES + wave_, NGW = gw_ >= 0 ? ngw_ : ((int)gridDim.x) * NWAVES;
    f32x4 wv[4];
#pragma unroll
    for (int j = 0; j < 4; ++j) wv[j] = *(const f32x4*)(w + 256 * j + 4 * lane_);
    for (int m0 = gw; m0 < M; m0 += 4 * NGW) {
        f32x4 v[4][4];
#pragma unroll
        for (int q = 0; q < 4; ++q) { const int m = m0 + q * NGW; if (m < M) {
            if (xb) {
#pragma unroll
                for (int j = 0; j < 4; ++j) { const unsigned long long t = *(const unsigned long long*)(xb + (size_t)m * D + 256 * j + 4 * lane_); v[q][j] = (f32x4){bf_lo((unsigned)t), bf_hi((unsigned)t), bf_lo((unsigned)(t >> 32)), bf_hi((unsigned)(t >> 32))}; }
            } else { const float* xr = (m < MP ? xlo : xhi) + (size_t)m * D;
#pragma unroll
                for (int j = 0; j < 4; ++j) v[q][j] = *(const f32x4*)(xr + 256 * j + 4 * lane_); } } }
#pragma unroll
        for (int q = 0; q < 4; ++q) { const int m = m0 + q * NGW; if (m < M) {
            float s = 0.f;
            if (xcopy) { GAS unsigned long long* c8 = (GAS unsigned long long*)(xcopy + (size_t)m * D) + lane_;
#pragma unroll
                for (int j = 0; j < 4; ++j) c8[64 * j] = (unsigned long long)pk2(v[q][j].x, v[q][j].y) | ((unsigned long long)pk2(v[q][j].z, v[q][j].w) << 32); }
#pragma unroll
            for (int j = 0; j < 4; ++j) s += (v[q][j].x * v[q][j].x + v[q][j].y * v[q][j].y) + (v[q][j].z * v[q][j].z + v[q][j].w * v[q][j].w);
            const float rstd = rsq_f(wave_sum_l(lane_, s) * (1.0f / D) + EPS);
#pragma unroll
            for (int j = 0; j < 4; ++j) v[q][j] = v[q][j] * rstd * wv[j];
            if (FINAL) {
#pragma unroll
                for (int j = 0; j < 4; ++j) *(f32x4*)(F.out + (size_t)m * D + 256 * j + 4 * lane_) = v[q][j];
            } else {
                GAS unsigned long long* o8 = (GAS unsigned long long*)(F_XN + (size_t)m * D) + lane_;
#pragma unroll
                for (int j = 0; j < 4; ++j) o8[64 * j] = (unsigned long long)pk2(v[q][j].x, v[q][j].y) | ((unsigned long long)pk2(v[q][j].z, v[q][j].w) << 32);
            }
            if (WITH_DT) {
                f32x4 a = {0.f, 0.f, 0.f, 0.f};
#pragma unroll
                for (int j = 0; j < 4; ++j) { const LAS f32x4* wp = (const LAS f32x4*)(wl + 4 * (256 * j + 4 * lane_));
                    a += wp[0] * v[q][j].x; a += wp[1] * v[q][j].y; a += wp[2] * v[q][j].z; a += wp[3] * v[q][j].w; }
                a.x = wave_sum_l(lane_, a.x); a.y = wave_sum_l(lane_, a.y); a.z = wave_sum_l(lane_, a.z); a.w = wave_sum_l(lane_, a.w);
                if (lane_ == 0) *(f32x4*)(F_DT + (size_t)m * 4) = a;
            } } }
    }
    if (WITH_DT && gw_ < 0) __syncthreads();
}
constexpr int PL_RAW = 0, PL_PL = 79 * 256 * 4, PL_END = PL_PL + 64 * 264 * 2;
static_assert(PL_END <= MISC_OFF, "pool LDS map");
__device__ __forceinline__ void pool_item(Frame& F, int layer, int ci) {
    ITEM_IDS();
    const Chunk c = chunk_of(ci);
    lf32* raw = (lf32*)(F.lds + PL_RAW);
    LAS bf16* Pl = (LAS bf16*)(F.lds + PL_PL);
    const float* spool = inp(I_SPOOL) + (size_t)(layer * NSB + (c.b < 0 ? 0 : c.b)) * 15 * 256;
    v4u pw[5]; f32x4 pf[5][2];
#pragma unroll
    for (int q = 0; q < 5; ++q) { const int it = tid_ + q * NTHR; pw[q] = (v4u){0u, 0u, 0u, 0u}; pf[q][0] = (f32x4){0.f, 0.f, 0.f, 0.f}; pf[q][1] = pf[q][0];
        if (it < 79 * 32) { const int rr = it >> 5, cg = it & 31, r = rr - 15;
            if (r < c.nrows) { if (r >= 0 || (c.b < 0 && c.row0 + r >= 0)) pw[q] = *(const v4u*)(F_PROJ + (size_t)(c.row0 + r) * NPROJ + PC_DX + 8 * cg);
                               else if (c.b >= 0) { const float* s = spool + (size_t)(15 + r) * 256 + 8 * cg; pf[q][0] = *(const f32x4*)s; pf[q][1] = *(const f32x4*)(s + 4); } } } }
#pragma unroll
    for (int q = 0; q < 5; ++q) { const int it = tid_ + q * NTHR;
        if (it < 79 * 32) { const int rr = it >> 5, cg = it & 31, r = rr - 15; float v[8];
            if (c.b >= 0 && r < 0) { v[0] = pf[q][0].x; v[1] = pf[q][0].y; v[2] = pf[q][0].z; v[3] = pf[q][0].w; v[4] = pf[q][1].x; v[5] = pf[q][1].y; v[6] = pf[q][1].z; v[7] = pf[q][1].w; } else unpack8(pw[q], v);
            *(LAS f32x4*)(raw + rr * 256 + 8 * cg) = (f32x4){v[0], v[1], v[2], v[3]}; *(LAS f32x4*)(raw + rr * 256 + 8 * cg + 4) = (f32x4){v[4], v[5], v[6], v[7]}; } }
    __syncthreads();
    { const int ch = tid_ & 255, half = tid_ >> 8, win = 2 << (ch >> 6); const float inv = 1.0f / (float)win;
      const lf32* rp = raw + (32 * half + 15) * 256 + ch;
      float s = 0.f; for (int q = 1; q < win; ++q) s += rp[-q * 256];
#pragma unroll 8
      for (int r = 0; r < 32; ++r) { const float x = rp[r * 256], xo = rp[(r - win + 1) * 256]; s += x; Pl[(32 * half + r) * 264 + ch] = (bf16)f2bf(s * inv - x); s -= xo; } }
    __syncthreads();
    const int tb = wave_ >> 1, g0 = 2 * (wave_ & 1), kq = lane_ >> 4, fr = lane_ & 15;
    const bf16* wt = F_WPT + (size_t)layer * 4 * 64 * 64; const float* sc = inp(I_PS) + (size_t)layer * 256;
#pragma unroll
    for (int gg = 0; gg < 2; ++gg) {
        const int g = g0 + gg;
        bf16x8 bw[4][2];
#pragma unroll
        for (int t = 0; t < 4; ++t)
#pragma unroll
            for (int ks = 0; ks < 2; ++ks) bw[t][ks] = *(const bf16x8*)(wt + (size_t)(g * 64 + t * 16 + fr) * 64 + 32 * ks + 8 * kq);
        bf16x8 a[2];
#pragma unroll
        for (int ks = 0; ks < 2; ++ks) a[ks] = *(const LAS bf16x8*)(Pl + (tb * 16 + fr) * 264 + g * 64 + 32 * ks + 8 * kq);
#pragma unroll
        for (int t = 0; t < 4; ++t) { f32x4 acc = {0.f, 0.f, 0.f, 0.f};
#pragma unroll
            for (int ks = 0; ks < 2; ++ks) acc = __builtin_amdgcn_mfma_f32_16x16x32_bf16(a[ks], bw[t][ks], acc, 0, 0, 0);
            const float s = sc[g * 64 + t * 16 + fr];
#pragma unroll
            for (int r = 0; r < 4; ++r) { const int row = tb * 16 + 4 * kq + r; if (row < c.nrows) F_XN[(size_t)(c.row0 + row) * D + 768 + g * 64 + t * 16 + fr] = (bf16)f2bf(acc[r] * s); } }
    }
    __syncthreads();
}

__device__ __forceinline__ void copy_cache(Frame& F, int layer, int b0, int nb) {
    ITEM_IDS();
    const int gt = b0 * NTHR + tid_, GT = nb * NTHR;
    float* out = F.out; const float* ckp = inp(I_CK); const float* cvp = inp(I_CV);
    for (int base = gt; base < 32 * 31744; base += 8 * GT) {
        f32x4 v[8];
#pragma unroll
        for (int q = 0; q < 8; ++q) { const int i = base + q * GT; if (i < 32 * 31744) { const int wb = i / 31744, e = i - wb * 31744; const int which = wb >> 4, b = wb & 15;
            v[q] = *(const f32x4*)((which ? cvp : ckp) + ((size_t)(layer * NSB + b) * 512 + 16) * 256 + 4 * (size_t)e); } }
#pragma unroll
        for (int q = 0; q < 8; ++q) { const int i = base + q * GT; if (i < 32 * 31744) { const int wb = i / 31744, e = i - wb * 31744; const int which = wb >> 4, b = wb & 15;
            *(f32x4*)(out + (which ? O_SV : O_SK) + (size_t)(layer * NSB + b) * 512 * 256 + 4 * (size_t)e) = v[q]; } }
    }
}
__device__ __forceinline__ void copy_small(Frame& F, int layer, int b0, int nb) {
    ITEM_IDS();
    const int gt = b0 * NTHR + tid_, GT = nb * NTHR;
    float* out = F.out;
    constexpr int T_P = 2 * 512 * 32, T_S = 2 * 16 * 16 * 32, T_D = 17 * 15 * 32, T_ALL = T_P + T_S + T_D;
    for (int base = gt; base < T_ALL; base += 4 * GT) {
        v4u w[4];
#pragma unroll
        for (int q = 0; q < 4; ++q) { int t = base + q * GT; if (t < T_ALL) { size_t src;
            if (t < T_P) { const int which = t >> 14, j = (t >> 5) & 511, cg = t & 31; src = (size_t)(MP - 512 + j) * NPROJ + (which ? PC_V : PC_K) + 8 * cg; }
            else if (t < T_P + T_S) { t -= T_P; const int which = t >> 13, b = (t >> 9) & 15, j = (t >> 5) & 15, cg = t & 31; src = (size_t)(MP + 16 * b + j) * NPROJ + (which ? PC_V : PC_K) + 8 * cg; }
            else { t -= T_P + T_S; const int b = t / 480, rr = (t / 32) % 15, cg = t & 31; src = (size_t)(b == 0 ? MP - 15 + rr : MP + 16 * (b - 1) + 1 + rr) * NPROJ + PC_DX + 8 * cg; }
            w[q] = *(const v4u*)(F_PROJ + src); } }
#pragma unroll
        for (int q = 0; q < 4; ++q) { int t = base + q * GT; if (t < T_ALL) { size_t dst;
            if (t < T_P) { const int which = t >> 14, j = (t >> 5) & 511, cg = t & 31; dst = (which ? O_PV : O_PK) + (size_t)layer * 512 * 256 + j * 256 + 8 * cg; }
            else if (t < T_P + T_S) { t -= T_P; const int which = t >> 13, b = (t >> 9) & 15, j = (t >> 5) & 15, cg = t & 31; dst = (which ? O_SV : O_SK) + ((size_t)(layer * NSB + b) * 512 + 496 + j) * 256 + 8 * cg; }
            else { t -= T_P + T_S; const int b = t / 480, rr = (t / 32) % 15, cg = t & 31; dst = (b == 0 ? O_PPOOL + (size_t)layer * 3840 : O_SPOOL + (size_t)(layer * NSB + b - 1) * 3840) + rr * 256 + 8 * cg; }
            float v[8]; unpack8(w[q], v); *(f32x4*)(out + dst) = (f32x4){v[0], v[1], v[2], v[3]}; *(f32x4*)(out + dst + 4) = (f32x4){v[4], v[5], v[6], v[7]}; } }
    }
}
constexpr int KS_LD = 72, PS_LD = 584;
constexpr int AT_KS = 0, AT_VT = 576 * KS_LD * 2, AT_ST = AT_VT + 64 * PS_LD * 2, AT_BIAS = AT_ST + 1024;
static_assert(AT_BIAS + 4 * 260 * 4 <= MISC_OFF, "attention LDS map");
__device__ __forceinline__ void attn_bias_load(Frame& F, int layer) { const float* arel = inp(I_AREL) + (size_t)layer * 257 * 4; lf32* b = (lf32*)(F.lds + AT_BIAS); ITEM_IDS(); for (int i = tid_; i < 257 * 4; i += NTHR) b[260 * (i & 3) + (i >> 2)] = arel[i]; }
__device__ __forceinline__ void attn_item(Frame& F, int layer, int ci, int h) {
    ITEM_IDS();
    const Chunk c = chunk_of(ci);
    LAS bf16* Ks = (LAS bf16*)(F.lds + AT_KS); LAS bf16* Ps = Ks; LAS bf16* Vt = (LAS bf16*)(F.lds + AT_VT);
    lf32* mx = (lf32*)(F.lds + AT_ST); lf32* sm = mx + 128; lf32* bias = (lf32*)(F.lds + AT_BIAS) + 260 * h;
    const int jlo = (c.b < 0) ? (ci < 8 ? 64 * (8 - ci) : 0) : 0;
    const int jval = (c.b < 0) ? 576 : 528;
    const float* ckp = inp(I_CK); const float* cvp = inp(I_CV);
    bf16x8 qa0 = {0, 0, 0, 0, 0, 0, 0, 0}, qa1 = qa0;
    if (c.b < 0 || (wave_ >> 1) == 0) { const bf16* qp = F_PROJ + (size_t)(c.row0 + (wave_ >> 1) * 16 + (lane_ & 15)) * NPROJ + PC_Q + 64 * h + 8 * (lane_ >> 4); qa0 = *(const bf16x8*)qp; qa1 = *(const bf16x8*)(qp + 32); }
    if (c.b < 0) {
        const bf16* kg = F_PROJ + (long)(c.row0 - 512) * NPROJ + PC_K + 64 * h;
        const bf16* vg = F_VTA + (long)(64 * h) * M + (long)(c.row0 - 512);
        const int npc = (576 - jlo) >> 3, nk = (576 - jlo) * 8, nv = 64 * npc;
        v4u kr[9], vr[9];
#pragma unroll
        for (int q = 0; q < 9; ++q) { const int it = tid_ + q * NTHR;
            if (it < nk) kr[q] = *(const v4u*)(kg + (long)(jlo + (it >> 3)) * NPROJ + 8 * (it & 7));
            if (it < nv) { const int d = it / npc, pc = it - d * npc; vr[q] = *(const v4u*)(vg + (long)d * M + jlo + 8 * pc); } }
#pragma unroll
        for (int q = 0; q < 9; ++q) { const int it = tid_ + q * NTHR;
            if (it < nk) *(LAS v4u*)(Ks + (jlo + (it >> 3)) * KS_LD + 8 * (it & 7)) = kr[q];
            if (it < nv) { const int d = it / npc, pc = it - d * npc; *(LAS v4u*)(Vt + d * PS_LD + jlo + 8 * pc) = vr[q]; } }
    } else {
    for (int it = tid_; it < (576 - jlo) * 8; it += NTHR) {
        const int j = jlo + (it >> 3), dg = it & 7;
        v4u kw, vw;
        if (j < 512) { const size_t o = (((size_t)(layer * NSB + c.b) * 512 + j) * 4 + h) * 64 + 8 * dg; const float* kp = ckp + o; const float* vp = cvp + o;
            const f32x4 k0 = *(const f32x4*)kp, k1 = *(const f32x4*)(kp + 4), v0 = *(const f32x4*)vp, v1 = *(const f32x4*)(vp + 4);
            kw.x = pk2(k0.x, k0.y); kw.y = pk2(k0.z, k0.w); kw.z = pk2(k1.x, k1.y); kw.w = pk2(k1.z, k1.w); vw.x = pk2(v0.x, v0.y); vw.y = pk2(v0.z, v0.w); vw.z = pk2(v1.x, v1.y); vw.w = pk2(v1.z, v1.w); }
        else if (j < 528) { const size_t row = (size_t)(c.row0 + j - 512); kw = *(const v4u*)(F_PROJ + row * NPROJ + PC_K + 64 * h + 8 * dg); vw = *(const v4u*)(F_PROJ + row * NPROJ + PC_V + 64 * h + 8 * dg); }
        else { kw = (v4u){0u, 0u, 0u, 0u}; vw = kw; }
        *(LAS v4u*)(Ks + j * KS_LD + 8 * dg) = kw;
        LAS bf16* vt = Vt + (8 * dg) * PS_LD + j;
        vt[0 * PS_LD] = (bf16)(vw.x & 0xffffu); vt[1 * PS_LD] = (bf16)(vw.x >> 16); vt[2 * PS_LD] = (bf16)(vw.y & 0xffffu); vt[3 * PS_LD] = (bf16)(vw.y >> 16);
        vt[4 * PS_LD] = (bf16)(vw.z & 0xffffu); vt[5 * PS_LD] = (bf16)(vw.z >> 16); vt[6 * PS_LD] = (bf16)(vw.w & 0xffffu); vt[7 * PS_LD] = (bf16)(vw.w >> 16);
    }
    }
    __syncthreads();
    const int qb = wave_ >> 1, kh = wave_ & 1, kq = lane_ >> 4, fr = lane_ & 15;
    const bool active = (c.b < 0) || (qb == 0);
    const int ntw = (576 - jlo) / 32;
    const int kbase = jlo + kh * ntw * 16;
    f32x4 s[18];
    float mloc = -3.0e38f;
    const int iq = qb * 16 + fr;
    if (active) {
#pragma unroll
        for (int t = 0; t < 18; ++t) {
            s[t] = (f32x4){0.f, 0.f, 0.f, 0.f};
            if (t < ntw) {
                const LAS bf16* kp = Ks + (kbase + t * 16 + fr) * KS_LD + 8 * kq;
                const bf16x8 kb0 = *(const LAS bf16x8*)kp, kb1 = *(const LAS bf16x8*)(kp + 32);
                s[t] = __builtin_amdgcn_mfma_f32_16x16x32_bf16(kb0, qa0, s[t], 0, 0, 0);
                s[t] = __builtin_amdgcn_mfma_f32_16x16x32_bf16(kb1, qa1, s[t], 0, 0, 0);
#pragma unroll
                for (int r = 0; r < 4; ++r) { const int j = kbase + t * 16 + 4 * kq + r; int rel = 512 + iq - j; rel = rel > 128 ? 128 : rel; float v = s[t][r] + bias[rel + 128]; if (j >= jval) v = -1.0e30f; s[t][r] = v; mloc = fmaxf(mloc, v); }
            }
        }
        mloc = fmaxf(mloc, shx(lane_, mloc, 16)); mloc = fmaxf(mloc, shx(lane_, mloc, 32));
        if (kq == 0) mx[iq * 2 + kh] = mloc;
    }
    __syncthreads();
    if (active) {
        mloc = fmaxf(mx[iq * 2], mx[iq * 2 + 1]);
        float lsum = 0.f;
#pragma unroll
        for (int t = 0; t < 18; ++t) if (t < ntw) {
            const float p0 = __expf(s[t][0] - mloc), p1 = __expf(s[t][1] - mloc), p2 = __expf(s[t][2] - mloc), p3 = __expf(s[t][3] - mloc);
            lsum += (p0 + p1) + (p2 + p3);
            *(LAS f32x2*)(Ps + iq * PS_LD + kbase + t * 16 + 4 * kq) = __builtin_bit_cast(f32x2, (unsigned long long)pk2(p0, p1) | ((unsigned long long)pk2(p2, p3) << 32));
        }
        lsum += shx(lane_, lsum, 16); lsum += shx(lane_, lsum, 32);
        if (kq == 0) sm[iq * 2 + kh] = lsum;
    }
    __syncthreads();
    if (active) {
        f32x4 o[2] = {(f32x4){0.f, 0.f, 0.f, 0.f}, (f32x4){0.f, 0.f, 0.f, 0.f}};
        const int nks = (576 - jlo) / 32;
#pragma unroll 2
        for (int ks = 0; ks < nks; ++ks) {
            const int j0 = jlo + 32 * ks + 8 * kq;
            const bf16x8 pa = *(const LAS bf16x8*)(Ps + iq * PS_LD + j0);
#pragma unroll
            for (int t = 0; t < 2; ++t) { const bf16x8 vb = *(const LAS bf16x8*)(Vt + (kh * 32 + t * 16 + fr) * PS_LD + j0); o[t] = __builtin_amdgcn_mfma_f32_16x16x32_bf16(vb, pa, o[t], 0, 0, 0); }
        }
        const float inv = rcp_f(sm[iq * 2] + sm[iq * 2 + 1]);
#pragma unroll
        for (int t = 0; t < 2; ++t) *(f32x2*)(F_XN + (size_t)(c.row0 + iq) * D + 64 * h + kh * 32 + t * 16 + 4 * kq) =
            __builtin_bit_cast(f32x2, (unsigned long long)pk2(o[t][0] * inv, o[t][1] * inv) | ((unsigned long long)pk2(o[t][2] * inv, o[t][3] * inv) << 32));
    }
    __syncthreads();
}
__device__ __forceinline__ void scan_phase(Frame& F, int layer) {
    ITEM_IDS();
    lf32* db = (lf32*)F.lds; lf32* dcl = db + NCHP * 4;
    for (int i = tid_; i < NCHP * 4; i += NTHR) db[i] = F_DECB[i];
    if (((int)blockIdx.x) >= 32 && ((int)blockIdx.x) < 48) { const int hh = (((int)blockIdx.x) - 32) >> 2; const float* dg = F_DECC + hh * 64;
        for (int i = tid_; i < NCHP * 16; i += NTHR) *(LAS f32x4*)(dcl + (i >> 4) * 64 + 4 * (i & 15)) = *(const f32x4*)(dg + (size_t)(i >> 4) * 256 + 4 * (i & 15)); }
    __syncthreads();
    constexpr int NSCAN = 48;
    if (((int)blockIdx.x) < NSCAN) {
        const int u = ((int)blockIdx.x) * NTHR + tid_;
        if (u < 16384) {
            unsigned* st = (unsigned*)F_STB + u; const int hb = u >> 12;
            float r0 = 0.f, r1 = 0.f;
            for (int c0 = 0; c0 < NCHP; c0 += 64) {
                unsigned sl[64];
#pragma unroll
                for (int i = 0; i < 64; ++i) sl[i] = st[(size_t)(c0 + i) * 16384];
#pragma unroll
                for (int i = 0; i < 64; ++i) { const float d0 = db[(c0 + i) * 4 + hb]; st[(size_t)(c0 + i) * 16384] = pk2(r0, r1); r0 = d0 * r0 + bf_lo(sl[i]); r1 = d0 * r1 + bf_hi(sl[i]); }
            }
            *(f32x2*)(F.out + O_PSSM + (size_t)layer * 32768 + 2 * u) = (f32x2){r0, r1};
        } else {
            const int u2 = u - 16384;
            unsigned* st = (unsigned*)F_STC + u2; const int hk = (u2 >> 11) * 64 + 2 * (u2 & 31);
            float r0 = 0.f, r1 = 0.f;
            for (int c0 = 0; c0 < NCHP; c0 += 64) {
                unsigned sl[64];
#pragma unroll
                for (int i = 0; i < 64; ++i) sl[i] = st[(size_t)(c0 + i) * 8192];
#pragma unroll
                for (int i = 0; i < 64; ++i) { const f32x2 dd = *(const LAS f32x2*)(dcl + (c0 + i) * 64 + 2 * (u2 & 31)); st[(size_t)(c0 + i) * 8192] = pk2(r0, r1); r0 = dd.x * r0 + bf_lo(sl[i]); r1 = dd.y * r1 + bf_hi(sl[i]); }
            }
            const int v = (u2 >> 5) & 63; float* o = F.out + O_PHGRN + (size_t)layer * 16384 + (size_t)hk * 64 + v; o[0] = r0; o[64] = r1;
        }
    }
    else {
        const int nb = ((int)gridDim.x) - NSCAN, b0 = ((int)blockIdx.x) - NSCAN;
        copy_small(F, layer, b0, nb);
        const float* sssm = inp(I_SSSM) + (size_t)layer * NSB * 32768; const float* shgrn = inp(I_SHGRN) + (size_t)layer * NSB * 16384;
        float* osb = F.out + O_SSSM + (size_t)layer * NSB * 32768; float* osc = F.out + O_SHGRN + (size_t)layer * NSB * 16384;
        for (int t = b0 * NTHR + tid_; t < NSB * 8192; t += nb * NTHR) {
            const int b = t >> 13, e = (t & 8191) * 4; const f32x4 s0 = *(const f32x4*)(sssm + (size_t)b * 32768 + e); const unsigned long long w = *(const unsigned long long*)(F_STB + (size_t)(NCHP + b) * 32768 + e);
            const float d = F_DECB[(NCHP + b) * 4 + (e >> 13)];
            *(f32x4*)(osb + (size_t)b * 32768 + e) = (f32x4){d * s0.x + bf_lo((unsigned)w), d * s0.y + bf_hi((unsigned)w), d * s0.z + bf_lo((unsigned)(w >> 32)), d * s0.w + bf_hi((unsigned)(w >> 32))}; }
        for (int t = b0 * NTHR + tid_; t < NSB * 4096; t += nb * NTHR) {
            const int b = t >> 12, e2 = (t & 4095) * 4, hk = e2 >> 6, v = e2 & 63; const f32x4 s0 = *(const f32x4*)(shgrn + (size_t)b * 16384 + e2);
            const bf16* sp = F_STC + (size_t)(NCHP + b) * 16384 + (size_t)((hk >> 6) * 64 + v) * 64 + (hk & 63); const float d = F_DECC[(size_t)(NCHP + b) * 256 + hk];
            *(f32x4*)(osc + (size_t)b * 16384 + e2) = (f32x4){d * s0.x + bf1(sp[0]), d * s0.y + bf1(sp[64]), d * s0.z + bf1(sp[128]), d * s0.w + bf1(sp[192])}; }
    }
}
constexpr int SP_XT = 0, SP_BT = 256 * 72 * 2, SP_ACS = 2 * 256 * 72 * 2, SP_DTV = SP_ACS + 1024, SP_SJ = SP_DTV + 1024, SP_END = SP_SJ + 1024;
static_assert(SP_END <= MISC_OFF, "ssd_prep LDS map");
__device__ __forceinline__ void ssd_prep_item(Frame& F, int layer, int ci) {
    ITEM_IDS();
    const Chunk c = chunk_of(ci);
    LAS bf16* XTl = (LAS bf16*)(F.lds + SP_XT); LAS bf16* BTl = (LAS bf16*)(F.lds + SP_BT);
    lf32* acs = (lf32*)(F.lds + SP_ACS); lf32* dtv = (lf32*)(F.lds + SP_DTV); lf32* sj = (lf32*)(F.lds + SP_SJ);
    const int cg = tid_ % 96, seg = tid_ / 96, col = 8 * cg;
    const bool act = seg < 4 && 16 * seg < c.nrows;
    bf16* prow = F_PROJ + (size_t)c.row0 * NPROJ + PC_X + col;
    v4u raw[19];
    if (act) {
#pragma unroll
        for (int q = 0; q < 19; ++q) { const int r = 16 * seg - 3 + q;
            if (r >= 0) raw[q] = *(const v4u*)(prow + (size_t)r * NPROJ);
            else if (c.b < 0) { if (ci > 0) raw[q] = *(const v4u*)(F_HALO + ((size_t)(ci - 1) * 3 + (3 + r)) * 768 + col); else raw[q] = (v4u){0u, 0u, 0u, 0u}; }
            else { const float* s = inp(I_SCONV) + ((size_t)(layer * NSB + c.b) * 3 + (3 + r)) * 768 + col; const f32x4 a = *(const f32x4*)s, b2 = *(const f32x4*)(s + 4);
                raw[q].x = pk2(a.x, a.y); raw[q].y = pk2(a.z, a.w); raw[q].z = pk2(b2.x, b2.y); raw[q].w = pk2(b2.z, b2.w); } }
    }
    if (wave_ == 6) { const int r = lane_; const float* dtb = inp(I_DTB) + layer * 4; const float* alg = inp(I_ALOG) + layer * 4;
        f32x4 raw4 = {0.f, 0.f, 0.f, 0.f}; if (r < c.nrows) raw4 = *(const f32x4*)(F_DT + (size_t)(c.row0 + r) * 4);
        f32x4 dt4, ac4;
#pragma unroll
        for (int h = 0; h < 4; ++h) { float dt = 0.f; if (r < c.nrows) dt = softplus_f(raw4[h] + dtb[h]); float v = -__expf(alg[h]) * dt;
#pragma unroll
            for (int o = 1; o < 64; o <<= 1) { const float t = shu(lane_, v, o); if (lane_ >= o) v += t; }
            const float last = shi(v, 63);
            dt4[h] = dt; ac4[h] = v; acs[r * 4 + h] = v; dtv[r * 4 + h] = dt; sj[h * 64 + r] = dt * __expf(last - v);
            if (r == 63) F_DECB[ci * 4 + h] = __expf(last); }
        if (r < c.nrows) { *(f32x4*)(F_DTV + (size_t)(c.row0 + r) * 4) = dt4; *(f32x4*)(F_ACS + (size_t)(c.row0 + r) * 4) = ac4; } }
    if (c.nrows < 64) { for (int i = tid_; i < 2 * 256 * 72 / 2; i += NTHR) ((LAS unsigned*)XTl)[i] = 0u; }
    asm volatile("s_waitcnt vmcnt(0)" ::: "memory");
    __syncthreads();
    if (act) {
        if (ci == NCHP - 1 && seg == 3) {
#pragma unroll
            for (int q = 0; q < 3; ++q) { float v[8]; unpack8(raw[16 + q], v); float* o = F.out + O_PCONV + (size_t)layer * 2304 + q * 768 + col;
                *(f32x4*)o = (f32x4){v[0], v[1], v[2], v[3]}; *(f32x4*)(o + 4) = (f32x4){v[4], v[5], v[6], v[7]}; } }
        if (c.b >= 0) {
#pragma unroll
            for (int q = 0; q < 3; ++q) { float v[8]; unpack8(raw[16 + q], v); float* o = F.out + O_SCONV + ((size_t)(layer * NSB + c.b) * 3 + q) * 768 + col;
                *(f32x4*)o = (f32x4){v[0], v[1], v[2], v[3]}; *(f32x4*)(o + 4) = (f32x4){v[4], v[5], v[6], v[7]}; } }
        const float* cw = inp(I_CW) + (size_t)layer * 4 * 768 + col; const float* cb = inp(I_CB) + (size_t)layer * 768 + col;
        LAS bf16* tl = (cg < 32) ? XTl + col * 72 : BTl + (col - 256) * 72;
#pragma unroll
        for (int hc = 0; hc < 2; ++hc) {
            float w0[4], w1[4], w2[4], w3[4], bb[4];
#pragma unroll
            for (int e = 0; e < 4; ++e) { bb[e] = cb[4 * hc + e]; w0[e] = cw[4 * hc + e]; w1[e] = cw[768 + 4 * hc + e]; w2[e] = cw[2 * 768 + 4 * hc + e]; w3[e] = cw[3 * 768 + 4 * hc + e]; }
#pragma unroll
            for (int i = 0; i < 16; i += 2) {
                float x[5][4];
#pragma unroll
                for (int q = 0; q < 5; ++q) { const unsigned ua = hc ? raw[i + q].z : raw[i + q].x, ub = hc ? raw[i + q].w : raw[i + q].y; x[q][0] = bf_lo(ua); x[q][1] = bf_hi(ua); x[q][2] = bf_lo(ub); x[q][3] = bf_hi(ub); }
                float ya[4], yb[4];
#pragma unroll
                for (int e = 0; e < 4; ++e) { ya[e] = silu_g(bb[e] + w0[e] * x[0][e] + w1[e] * x[1][e] + w2[e] * x[2][e] + w3[e] * x[3][e]); yb[e] = silu_g(bb[e] + w0[e] * x[1][e] + w1[e] * x[2][e] + w2[e] * x[3][e] + w3[e] * x[4][e]); }
                const int r = 16 * seg + i;
                *(unsigned long long*)(prow + (size_t)r * NPROJ + 4 * hc) = (unsigned long long)pk2(ya[0], ya[1]) | ((unsigned long long)pk2(ya[2], ya[3]) << 32);
                *(unsigned long long*)(prow + (size_t)(r + 1) * NPROJ + 4 * hc) = (unsigned long long)pk2(yb[0], yb[1]) | ((unsigned long long)pk2(yb[2], yb[3]) << 32);
                if (cg < 64) {
#pragma unroll
                    for (int e = 0; e < 4; ++e) *(LAS unsigned*)(tl + (4 * hc + e) * 72 + r) = pk2(ya[e], yb[e]); }
            }
        }
    }
    __syncthreads();
    { const int ch = tid_ >> 1, hf = tid_ & 1; bf16* dst = F_XT + ((size_t)ci * 256 + ch) * 64 + 32 * hf; const LAS bf16* src = XTl + ch * 72 + 32 * hf;
#pragma unroll
      for (int q = 0; q < 4; ++q) *(v4u*)(dst + 8 * q) = *(const LAS v4u*)(src + 8 * q); }
    const int kq = lane_ >> 4, fr = lane_ & 15, h = wave_ >> 1, g = h >> 1;
#pragma unroll
    for (int pi = 0; pi < 2; ++pi) {
        const int pb = 2 * (wave_ & 1) + pi;
        bf16x8 af[2];
#pragma unroll
        for (int ks = 0; ks < 2; ++ks) { float v[8]; unpack8(*(const LAS v4u*)(XTl + (h * 64 + pb * 16 + fr) * 72 + 32 * ks + 8 * kq), v);
#pragma unroll
            for (int e = 0; e < 8; ++e) v[e] *= sj[h * 64 + 32 * ks + 8 * kq + e];
            af[ks] = __builtin_bit_cast(bf16x8, pack8(v)); }
        bf16* dst = F_STB + ((size_t)(ci * 4 + h) * 64 + pb * 16 + 4 * kq) * 128 + fr;
#pragma unroll
        for (int nt = 0; nt < 8; ++nt) {
            f32x4 acc = {0.f, 0.f, 0.f, 0.f};
#pragma unroll
            for (int ks = 0; ks < 2; ++ks) { const bf16x8 bfr = *(const LAS bf16x8*)(BTl + (g * 128 + nt * 16 + fr) * 72 + 32 * ks + 8 * kq); acc = __builtin_amdgcn_mfma_f32_16x16x32_bf16(af[ks], bfr, acc, 0, 0, 0); }
#pragma unroll
            for (int r = 0; r < 4; ++r) dst[r * 128 + nt * 16] = (bf16)f2bf(acc[r]);
        }
    }
    __syncthreads();
}

__device__ __forceinline__ void ssd_out_witem(Frame& F, int layer, int ci, int ib, int wave_, int lane_) {
    const Chunk c = chunk_of(ci);
    const int kq = lane_ >> 4, fr = lane_ & 15;
    constexpr int WSTRIDE = 2560 + 16384; static_assert(8 * WSTRIDE <= MISC_OFF, "per-wave LDS");
    LAS bf16* scr = (LAS bf16*)(F.lds + wave_ * WSTRIDE);
    lf32* ysc = (lf32*)(F.lds + wave_ * WSTRIDE + 2560) + lane_;
    const bf16* P = F_PROJ + (size_t)c.row0 * NPROJ;
    const float* acsg = F_ACS + (size_t)c.row0 * 4; const float* dtg = F_DTV + (size_t)c.row0 * 4;
    const int nks = (ib + 2) >> 1;
    float sq[4] = {0.f, 0.f, 0.f, 0.f};
    const float* bdp = inp(I_BD) + layer * 4;
#pragma unroll
    for (int g = 0; g < 2; ++g) {
        bf16x8 cf[4];
#pragma unroll
        for (int ks = 0; ks < 4; ++ks) cf[ks] = *(const bf16x8*)(P + (size_t)(16 * ib + fr) * NPROJ + PC_C + 128 * g + 32 * ks + 8 * kq);
        f32x4 G[4];
#pragma unroll
        for (int jb = 0; jb < 4; ++jb) { G[jb] = (f32x4){0.f, 0.f, 0.f, 0.f};
            if (jb <= ib) {
#pragma unroll
                for (int ks = 0; ks < 4; ++ks) { const bf16x8 bfr = *(const bf16x8*)(P + (size_t)(16 * jb + fr) * NPROJ + PC_B + 128 * g + 32 * ks + 8 * kq); G[jb] = __builtin_amdgcn_mfma_f32_16x16x32_bf16(cf[ks], bfr, G[jb], 0, 0, 0); } } }
#pragma unroll
        for (int hh = 0; hh < 2; ++hh) {
            const int h = 2 * g + hh;
            float ai[4], ea[4];
#pragma unroll
            for (int r = 0; r < 4; ++r) { ai[r] = acsg[(16 * ib + 4 * kq + r) * 4 + h]; ea[r] = __expf(ai[r]); }
#pragma unroll
            for (int jb = 0; jb < 4; ++jb) { const int j = 16 * jb + fr; float aj = 0.f, dj = 0.f; if (jb <= ib) { aj = acsg[j * 4 + h]; dj = dtg[j * 4 + h]; }
#pragma unroll
                for (int r = 0; r < 4; ++r) { const int i = 16 * ib + 4 * kq + r; const float v = (jb <= ib && j <= i) ? G[jb][r] * __expf(ai[r] - aj) * dj : 0.f; scr[(4 * kq + r) * 72 + j] = (bf16)f2bf(v); } }
            asm volatile("s_waitcnt lgkmcnt(0)" ::: "memory");
            bf16x8 gm[2];
#pragma unroll
            for (int ks = 0; ks < 2; ++ks) gm[ks] = *(const LAS bf16x8*)(scr + fr * 72 + 32 * ks + 8 * kq);
            asm volatile("s_waitcnt lgkmcnt(0)" ::: "memory");
            const bf16* xt = F_XT + ((size_t)ci * 256 + h * 64) * 64;
            const bf16* sin_b = F_STB + (size_t)(ci * 4 + h) * 8192; const float* sin_f = inp(I_SSSM) + (size_t)((layer * NSB + (c.b < 0 ? 0 : c.b)) * 4 + h) * 8192;
#pragma unroll 2
            for (int pt = 0; pt < 4; ++pt) {
                f32x4 a1 = {0.f, 0.f, 0.f, 0.f}, a2 = {0.f, 0.f, 0.f, 0.f};
#pragma unroll
                for (int ks = 0; ks < 2; ++ks) if (ks < nks) { const bf16x8 bfr = *(const bf16x8*)(xt + (size_t)(pt * 16 + fr) * 64 + 32 * ks + 8 * kq); a1 = __builtin_amdgcn_mfma_f32_16x16x32_bf16(gm[ks], bfr, a1, 0, 0, 0); }
#pragma unroll
                for (int ks = 0; ks < 4; ++ks) { bf16x8 bfr;
                    if (c.b < 0) bfr = *(const bf16x8*)(sin_b + (size_t)(pt * 16 + fr) * 128 + 32 * ks + 8 * kq);
                    else { const float* s = sin_f + (size_t)(pt * 16 + fr) * 128 + 32 * ks + 8 * kq; const f32x4 u0 = *(const f32x4*)s, u1 = *(const f32x4*)(s + 4); v4u w; w.x = pk2(u0.x, u0.y); w.y = pk2(u0.z, u0.w); w.z = pk2(u1.x, u1.y); w.w = pk2(u1.z, u1.w); bfr = __builtin_bit_cast(bf16x8, w); }
                    a2 = __builtin_amdgcn_mfma_f32_16x16x32_bf16(cf[ks], bfr, a2, 0, 0, 0); }
                const float dh = bdp[h];
#pragma unroll
                for (int r = 0; r < 4; ++r) { const size_t ro = (size_t)(16 * ib + 4 * kq + r) * NPROJ; const int p = h * 64 + pt * 16 + fr;
                    float y = a1[r] + ea[r] * a2[r] + dh * bf1(P[ro + PC_X + p]);
                    y *= silu_g(bf1(P[ro + PC_Z + p])); ysc[((h * 4 + pt) * 4 + r) * 64] = y; sq[r] += y * y; }
            }
        }
    }
    const float* nw = inp(I_BNRM) + (size_t)layer * 256;
#pragma unroll
    for (int r = 0; r < 4; ++r) { const float rstd = rsq_f(sum16_l(lane_, sq[r]) * (1.0f / 256.0f) + EPS); bf16* o = F_XN + (size_t)(c.row0 + 16 * ib + 4 * kq + r) * D + 256 + fr;
#pragma unroll 4
        for (int q = 0; q < 16; ++q) o[q * 16] = (bf16)f2bf(ysc[(q * 4 + r) * 64] * rstd * nw[q * 16 + fr]); }
}

constexpr int SO_SIN = 0, SO_XT = 4 * 64 * 136 * 2, SO_ACS = SO_XT + 256 * 72 * 2, SO_DTV = SO_ACS + 1024, SO_SS = SO_DTV + 1024, SO_SCR = SO_SS + 512, SO_END = SO_SCR + 8 * 2560;
static_assert(SO_END <= MISC_OFF, "ssd_out_block LDS map");
__device__ __forceinline__ void ssd_out_block(Frame& F, int layer, int ci) {
    ITEM_IDS();
    const int row0 = 64 * ci;
    LAS bf16* SIN = (LAS bf16*)(F.lds + SO_SIN); LAS bf16* XTl = (LAS bf16*)(F.lds + SO_XT);
    lf32* acs = (lf32*)(F.lds + SO_ACS); lf32* dtv = (lf32*)(F.lds + SO_DTV); lf32* ss = (lf32*)(F.lds + SO_SS);
    LAS bf16* scr = (LAS bf16*)(F.lds + SO_SCR + wave_ * 2560);
    const int kq = lane_ >> 4, fr = lane_ & 15, ib = wave_ >> 1, g = wave_ & 1;
    const bf16* P = F_PROJ + (size_t)row0 * NPROJ;
    v4u st[12];
    { const bf16* sg = F_STB + (size_t)ci * 32768; const bf16* xg = F_XT + (size_t)ci * 16384;
#pragma unroll
      for (int q = 0; q < 8; ++q) st[q] = *(const v4u*)(sg + (size_t)(tid_ + q * NTHR) * 8);
#pragma unroll
      for (int q = 0; q < 4; ++q) st[8 + q] = *(const v4u*)(xg + (size_t)(tid_ + q * NTHR) * 8); }
    float a4 = 0.f, d4 = 0.f; if (tid_ < 256) { a4 = F_ACS[(size_t)row0 * 4 + tid_]; d4 = F_DTV[(size_t)row0 * 4 + tid_]; }
    bf16x8 cf[4], bfr[4][4];
#pragma unroll
    for (int ks = 0; ks < 4; ++ks) cf[ks] = *(const bf16x8*)(P + (size_t)(16 * ib + fr) * NPROJ + PC_C + 128 * g + 32 * ks + 8 * kq);
#pragma unroll
    for (int jb = 0; jb < 4; ++jb)
#pragma unroll
        for (int ks = 0; ks < 4; ++ks) { bfr[jb][ks] = (bf16x8){0, 0, 0, 0, 0, 0, 0, 0}; if (jb <= ib) bfr[jb][ks] = *(const bf16x8*)(P + (size_t)(16 * jb + fr) * NPROJ + PC_B + 128 * g + 32 * ks + 8 * kq); }
#pragma unroll
    for (int q = 0; q < 8; ++q) { const int it = tid_ + q * NTHR; *(LAS v4u*)(SIN + (it >> 4) * 136 + 8 * (it & 15)) = st[q]; }
#pragma unroll
    for (int q = 0; q < 4; ++q) { const int it = tid_ + q * NTHR; *(LAS v4u*)(XTl + (it >> 3) * 72 + 8 * (it & 7)) = st[8 + q]; }
    if (tid_ < 256) { acs[tid_] = a4; dtv[tid_] = d4; }
    bf16 zv[2][4][4];
#pragma unroll
    for (int hh = 0; hh < 2; ++hh)
#pragma unroll
        for (int pt = 0; pt < 4; ++pt)
#pragma unroll
            for (int r = 0; r < 4; ++r) zv[hh][pt][r] = P[(size_t)(16 * ib + 4 * kq + r) * NPROJ + PC_Z + (2 * g + hh) * 64 + pt * 16 + fr];
    __syncthreads();
    f32x4 G[4];
#pragma unroll
    for (int jb = 0; jb < 4; ++jb) { G[jb] = (f32x4){0.f, 0.f, 0.f, 0.f};
        if (jb <= ib) {
#pragma unroll
            for (int ks = 0; ks < 4; ++ks) G[jb] = __builtin_amdgcn_mfma_f32_16x16x32_bf16(cf[ks], bfr[jb][ks], G[jb], 0, 0, 0); } }
    const int nks = (ib + 2) >> 1;
    const float* bdp = inp(I_BD) + layer * 4;
    f32x4 yv[2][4]; float sq[4] = {0.f, 0.f, 0.f, 0.f};
#pragma unroll
    for (int hh = 0; hh < 2; ++hh) {
        const int h = 2 * g + hh;
        float ai[4], ea[4];
#pragma unroll
        for (int r = 0; r < 4; ++r) { ai[r] = acs[(16 * ib + 4 * kq + r) * 4 + h]; ea[r] = __expf(ai[r]); }
#pragma unroll
        for (int jb = 0; jb < 4; ++jb) { const int j = 16 * jb + fr; const float aj = acs[j * 4 + h], dj = dtv[j * 4 + h];
#pragma unroll
            for (int r = 0; r < 4; ++r) { const int i = 16 * ib + 4 * kq + r; const float v = (jb <= ib && j <= i) ? G[jb][r] * __expf(ai[r] - aj) * dj : 0.f; scr[(4 * kq + r) * 72 + j] = (bf16)f2bf(v); } }
        asm volatile("s_waitcnt lgkmcnt(0)" ::: "memory");
        bf16x8 gm[2];
#pragma unroll
        for (int ks = 0; ks < 2; ++ks) gm[ks] = *(const LAS bf16x8*)(scr + fr * 72 + 32 * ks + 8 * kq);
        asm volatile("s_waitcnt lgkmcnt(0)" ::: "memory");
        const float dh = bdp[h];
#pragma unroll
        for (int pt = 0; pt < 4; ++pt) {
            f32x4 a1 = {0.f, 0.f, 0.f, 0.f}, a2 = {0.f, 0.f, 0.f, 0.f};
            const LAS bf16* xr = XTl + (h * 64 + pt * 16 + fr) * 72; const LAS bf16* sr = SIN + (h * 64 + pt * 16 + fr) * 136;
#pragma unroll
            for (int ks = 0; ks < 2; ++ks) if (ks < nks) a1 = __builtin_amdgcn_mfma_f32_16x16x32_bf16(gm[ks], *(const LAS bf16x8*)(xr + 32 * ks + 8 * kq), a1, 0, 0, 0);
#pragma unroll
            for (int ks = 0; ks < 4; ++ks) a2 = __builtin_amdgcn_mfma_f32_16x16x32_bf16(cf[ks], *(const LAS bf16x8*)(sr + 32 * ks + 8 * kq), a2, 0, 0, 0);
            const unsigned long long xw = *(const LAS unsigned long long*)(xr + 16 * ib + 4 * kq);
            const float xx[4] = {bf_lo((unsigned)xw), bf_hi((unsigned)xw), bf_lo((unsigned)(xw >> 32)), bf_hi((unsigned)(xw >> 32))};
#pragma unroll
            for (int r = 0; r < 4; ++r) { float y = a1[r] + ea[r] * a2[r] + dh * xx[r]; y *= silu_g(bf1(zv[hh][pt][r])); yv[hh][pt][r] = y; sq[r] += y * y; }
        }
    }
#pragma unroll
    for (int r = 0; r < 4; ++r) { const float q = sum16_l(lane_, sq[r]); if (fr == 0) ss[(16 * ib + 4 * kq + r) * 2 + g] = q; }
    __syncthreads();
    const float* nw = inp(I_BNRM) + (size_t)layer * 256 + 128 * g;
#pragma unroll
    for (int r = 0; r < 4; ++r) { const int i = 16 * ib + 4 * kq + r; const float rstd = rsq_f((ss[i * 2] + ss[i * 2 + 1]) * (1.0f / 256.0f) + EPS); bf16* o = F_XN + (size_t)(row0 + i) * D + 256 + 128 * g + fr;
#pragma unroll
        for (int hh = 0; hh < 2; ++hh)
#pragma unroll
            for (int pt = 0; pt < 4; ++pt) o[hh * 64 + pt * 16] = (bf16)f2bf(yv[hh][pt][r] * rstd * nw[hh * 64 + pt * 16 + fr]); }
    __syncthreads();
}
constexpr int HP_KT = 0, HP_VT = 256 * 72 * 2, HP_HT = 2 * 256 * 72 * 2, HP_END = HP_HT + 4 * 256 * 4;
static_assert(HP_END <= MISC_OFF, "hgrn_prep LDS map");
__device__ __forceinline__ void hgrn_prep_item(Frame& F, int layer, int ci) {
    ITEM_IDS();
    const Chunk c = chunk_of(ci);
    LAS bf16* KTl = (LAS bf16*)(F.lds + HP_KT); LAS bf16* VTl = (LAS bf16*)(F.lds + HP_VT);
    lf32* ht = (lf32*)(F.lds + HP_HT);
    const int cp = tid_ & 127, qt = tid_ >> 7;
    float lb0 = 0.f, lb1 = 0.f; if (layer != 0) { const float* lbp = inp(I_LB) + 2 * cp; lb0 = rcp_f(1.0f + __expf(lbp[0] - lbp[256])); lb1 = rcp_f(1.0f + __expf(lbp[1] - lbp[257])); }
    bf16* pq = F_PROJ + (size_t)(c.row0 + 16 * qt) * NPROJ + PC_CQ + 2 * cp;
    const bool act = 16 * qt < c.nrows;
    unsigned rq[16], rf[16], rv[16];
#pragma unroll
    for (int i = 0; i < 16; ++i) { rq[i] = 0u; rf[i] = 0u; rv[i] = 0u; if (act) { const unsigned* p = (const unsigned*)(pq + (size_t)i * NPROJ); rq[i] = p[0]; rf[i] = p[128]; rv[i] = p[256]; } }
    float b0[16], b1[16], k0[16], k1[16];
    float run0 = 0.f, run1 = 0.f;
#pragma unroll
    for (int i = 0; i < 16; ++i) { float g0 = 0.f, g1 = 0.f; k0[i] = 0.f; k1[i] = 0.f;
        if (act) { const float e0 = __expf(-bf_lo(rf[i])), e1 = __expf(-bf_hi(rf[i])); const float d0 = rcp_f(1.0f + e0), d1 = rcp_f(1.0f + e1);
            g0 = __logf(lb0 + (1.0f - lb0) * d0); g1 = __logf(lb1 + (1.0f - lb1) * d1); k0[i] = (1.0f - lb0) * e0 * d0; k1[i] = (1.0f - lb1) * e1 * d1; }
        run0 += g0; run1 += g1; b0[i] = run0; b1[i] = run1; }
    *(LAS f32x2*)(ht + qt * 256 + 2 * cp) = (f32x2){run0, run1};
    __syncthreads();
    float pre0 = 0.f, pre1 = 0.f, last0 = 0.f, last1 = 0.f;
#pragma unroll
    for (int q = 0; q < 4; ++q) { const f32x2 t = *(const LAS f32x2*)(ht + q * 256 + 2 * cp); if (q < qt) { pre0 += t.x; pre1 += t.y; } last0 += t.x; last1 += t.y; }
    { float* Rg = F_RH + (size_t)ci * 1280 + 2 * cp; *(f32x2*)(Rg + qt * 256) = (f32x2){pre0, pre1};
      if (qt == 3) { *(f32x2*)(Rg + 1024) = (f32x2){last0, last1}; *(f32x2*)(F_DECC + (size_t)ci * 256 + 2 * cp) = (f32x2){__expf(last0), __expf(last1)}; } }
    const float e0 = run0, e1 = run1;
#pragma unroll
    for (int i = 0; i < 16; i += 2) {
        unsigned kt0, kt1;
#pragma unroll
        for (int q = 0; q < 2; ++q) { const int ii = i + q;
            const float qe0 = bf_lo(rq[ii]) * __expf(b0[ii]), qe1 = bf_hi(rq[ii]) * __expf(b1[ii]);
            const float ke0 = k0[ii] * __expf(e0 - b0[ii]), ke1 = k1[ii] * __expf(e1 - b1[ii]);
            const float kd0 = k0[ii] * __expf(fminf(-b0[ii], 80.f)), kd1 = k1[ii] * __expf(fminf(-b1[ii], 80.f));
            if (act && 16 * qt + ii < c.nrows) { unsigned* p = (unsigned*)(pq + (size_t)ii * NPROJ); p[0] = pk2(qe0, qe1); p[128] = pk2(ke0, ke1); p[256] = pk2(kd0, kd1); }
            const float t0 = k0[ii] * __expf(last0 - pre0 - b0[ii]), t1 = k1[ii] * __expf(last1 - pre1 - b1[ii]);
            if (q == 0) { kt0 = f2bf(t0); kt1 = f2bf(t1); } else { kt0 |= f2bf(t0) << 16; kt1 |= f2bf(t1) << 16; } }
        const int j = 16 * qt + i;
        *(LAS unsigned*)(KTl + (2 * cp) * 72 + j) = kt0; *(LAS unsigned*)(KTl + (2 * cp + 1) * 72 + j) = kt1;
        *(LAS unsigned*)(VTl + (2 * cp) * 72 + j) = (rv[i] & 0xffffu) | (rv[i + 1] << 16); *(LAS unsigned*)(VTl + (2 * cp + 1) * 72 + j) = (rv[i] >> 16) | (rv[i + 1] & 0xffff0000u);
    }
    __syncthreads();
    { const int c2 = tid_ >> 1, hf = tid_ & 1; bf16* dst = F_VT + ((size_t)ci * 256 + c2) * 64 + 32 * hf; const LAS bf16* src = VTl + c2 * 72 + 32 * hf;
#pragma unroll
      for (int q = 0; q < 4; ++q) *(v4u*)(dst + 8 * q) = *(const LAS v4u*)(src + 8 * q); }
    const int kq = lane_ >> 4, fr = lane_ & 15, h = wave_ >> 1;
#pragma unroll
    for (int vi = 0; vi < 2; ++vi) {
        const int vb = 2 * (wave_ & 1) + vi;
        bf16x8 af[2];
#pragma unroll
        for (int ks = 0; ks < 2; ++ks) af[ks] = *(const LAS bf16x8*)(VTl + (h * 64 + vb * 16 + fr) * 72 + 32 * ks + 8 * kq);
        bf16* dst = F_STC + ((size_t)(ci * 4 + h) * 64 + vb * 16 + 4 * kq) * 64 + fr;
#pragma unroll
        for (int kb = 0; kb < 4; ++kb) {
            f32x4 acc = {0.f, 0.f, 0.f, 0.f};
#pragma unroll
            for (int ks = 0; ks < 2; ++ks) { const bf16x8 bfr = *(const LAS bf16x8*)(KTl + (h * 64 + kb * 16 + fr) * 72 + 32 * ks + 8 * kq); acc = __builtin_amdgcn_mfma_f32_16x16x32_bf16(af[ks], bfr, acc, 0, 0, 0); }
#pragma unroll
            for (int r = 0; r < 4; ++r) dst[r * 64 + kb * 16] = (bf16)f2bf(acc[r]);
        }
    }
    __syncthreads();
}

__device__ __forceinline__ void hgrn_out_witem(Frame& F, int layer, int ci, int h, int ib, int wave_, int lane_) {
    const Chunk c = chunk_of(ci);
    const int kq = lane_ >> 4, fr = lane_ & 15;
    LAS bf16* scr = (LAS bf16*)(F.lds + wave_ * (2560 + 16384));
    const bf16* P = F_PROJ + (size_t)c.row0 * NPROJ + h * 64;
    const float* Rg = F_RH + (size_t)ci * 1280 + h * 64;
    bf16x8 qf[2]; float qv[2][8], rI[2][8];
#pragma unroll
    for (int ks = 0; ks < 2; ++ks) { qf[ks] = *(const bf16x8*)(P + (size_t)(16 * ib + fr) * NPROJ + PC_CQ + 32 * ks + 8 * kq); unpack8(__builtin_bit_cast(v4u, qf[ks]), qv[ks]);
        const float* rp = Rg + ib * 256 + 32 * ks + 8 * kq; const f32x4 a = *(const f32x4*)rp, b2 = *(const f32x4*)(rp + 4);
        rI[ks][0] = a.x; rI[ks][1] = a.y; rI[ks][2] = a.z; rI[ks][3] = a.w; rI[ks][4] = b2.x; rI[ks][5] = b2.y; rI[ks][6] = b2.z; rI[ks][7] = b2.w; }
#pragma unroll
    for (int J = 0; J < 4; ++J) {
        f32x4 acc = {0.f, 0.f, 0.f, 0.f};
        if (J <= ib) {
#pragma unroll
            for (int ks = 0; ks < 2; ++ks) {
                bf16x8 a = qf[ks];
                if (J < ib) { const float* rp = Rg + (J + 1) * 256 + 32 * ks + 8 * kq; const f32x4 u0 = *(const f32x4*)rp, u1 = *(const f32x4*)(rp + 4); const float rj[8] = {u0.x, u0.y, u0.z, u0.w, u1.x, u1.y, u1.z, u1.w};
                    float v[8];
#pragma unroll
                    for (int e = 0; e < 8; ++e) v[e] = qv[ks][e] * __expf(rI[ks][e] - rj[e]);
                    a = __builtin_bit_cast(bf16x8, pack8(v)); }
                const bf16x8 bfr = *(const bf16x8*)(P + (size_t)(16 * J + fr) * NPROJ + (J < ib ? PC_CF : PC_CI) + 32 * ks + 8 * kq);
                acc = __builtin_amdgcn_mfma_f32_16x16x32_bf16(a, bfr, acc, 0, 0, 0);
            }
        }
#pragma unroll
        for (int r = 0; r < 4; ++r) { const int i = 4 * kq + r, j = fr; const float v = (J < ib || (J == ib && j <= i)) ? acc[r] : 0.f; scr[(4 * kq + r) * 72 + 16 * J + fr] = (bf16)f2bf(v); }
    }
    asm volatile("s_waitcnt lgkmcnt(0)" ::: "memory");
    bf16x8 ga[2];
#pragma unroll
    for (int ks = 0; ks < 2; ++ks) ga[ks] = *(const LAS bf16x8*)(scr + fr * 72 + 32 * ks + 8 * kq);
    asm volatile("s_waitcnt lgkmcnt(0)" ::: "memory");
    bf16x8 qs[2];
#pragma unroll
    for (int ks = 0; ks < 2; ++ks) { float v[8];
#pragma unroll
        for (int e = 0; e < 8; ++e) v[e] = qv[ks][e] * __expf(rI[ks][e]);
        qs[ks] = __builtin_bit_cast(bf16x8, pack8(v)); }
    const int nks = (ib + 2) >> 1;
    const bf16* vt = F_VT + ((size_t)ci * 256 + h * 64) * 64;
    const bf16* sin_b = F_STC + (size_t)(ci * 4 + h) * 4096; const float* sin_f = inp(I_SHGRN) + (size_t)((layer * NSB + (c.b < 0 ? 0 : c.b)) * 4 + h) * 4096;
    f32x4 o[4]; float sq[4] = {0.f, 0.f, 0.f, 0.f};
#pragma unroll
    for (int t = 0; t < 4; ++t) {
        o[t] = (f32x4){0.f, 0.f, 0.f, 0.f};
#pragma unroll
        for (int ks = 0; ks < 2; ++ks) if (ks < nks) { const bf16x8 bfr = *(const bf16x8*)(vt + (size_t)(t * 16 + fr) * 64 + 32 * ks + 8 * kq); o[t] = __builtin_amdgcn_mfma_f32_16x16x32_bf16(ga[ks], bfr, o[t], 0, 0, 0); }
#pragma unroll
        for (int ks = 0; ks < 2; ++ks) { bf16x8 bfr;
            if (c.b < 0) bfr = *(const bf16x8*)(sin_b + (size_t)(t * 16 + fr) * 64 + 32 * ks + 8 * kq);
            else { float v[8];
#pragma unroll
                for (int e = 0; e < 8; ++e) v[e] = sin_f[(size_t)(32 * ks + 8 * kq + e) * 64 + t * 16 + fr];
                bfr = __builtin_bit_cast(bf16x8, pack8(v)); }
            o[t] = __builtin_amdgcn_mfma_f32_16x16x32_bf16(qs[ks], bfr, o[t], 0, 0, 0); }
#pragma unroll
        for (int r = 0; r < 4; ++r) sq[r] += o[t][r] * o[t][r];
    }
    const float* nw = inp(I_CNRM) + (size_t)layer * 256 + h * 64;
#pragma unroll
    for (int r = 0; r < 4; ++r) { const float rstd = rsq_f(sum16_l(lane_, sq[r]) * (1.0f / 64.0f) + EPS); const size_t row = (size_t)(16 * ib + 4 * kq + r);
#pragma unroll
        for (int t = 0; t < 4; ++t) { const int v = t * 16 + fr; const float cg = bf1(P[row * NPROJ + PC_CG + v]);
            F_XN[(size_t)(c.row0 + row) * D + 512 + h * 64 + v] = (bf16)f2bf(o[t][r] * rstd * nw[v] * silu_g(cg)); } }
}

constexpr int HO_KE = 0, HO_VT = 64 * 264 * 2, HO_SIN = HO_VT + 256 * 72 * 2, HO_R = HO_SIN + 256 * 72 * 2, HO_SCR = HO_R + 1280 * 4, HO_END = HO_SCR + 8 * 2304;
static_assert(HO_END <= MISC_OFF, "hgrn_out_block LDS map");
__device__ __forceinline__ void hgrn_out_block(Frame& F, int layer, int ci) {
    ITEM_IDS();
    const int row0 = 64 * ci;
    LAS bf16* KEl = (LAS bf16*)(F.lds + HO_KE); LAS bf16* VTl = (LAS bf16*)(F.lds + HO_VT); LAS bf16* SIN = (LAS bf16*)(F.lds + HO_SIN); lf32* Rl = (lf32*)(F.lds + HO_R);
    LAS bf16* scr = (LAS bf16*)(F.lds + HO_SCR + wave_ * 2304);
    const int kq = lane_ >> 4, fr = lane_ & 15, h = wave_ >> 1, wp = wave_ & 1;
    const bf16* P = F_PROJ + (size_t)row0 * NPROJ;
    v4u st[13];
    { const bf16* kg = P + PC_CF; const bf16* vg = F_VT + (size_t)ci * 16384; const bf16* sg = F_STC + (size_t)ci * 16384; const float* rg = F_RH + (size_t)ci * 1280;
#pragma unroll
      for (int q = 0; q < 4; ++q) { const int it = tid_ + q * NTHR; st[q] = *(const v4u*)(kg + (size_t)(it >> 5) * NPROJ + 8 * (it & 31)); }
#pragma unroll
      for (int q = 0; q < 4; ++q) st[4 + q] = *(const v4u*)(vg + (size_t)(tid_ + q * NTHR) * 8);
#pragma unroll
      for (int q = 0; q < 4; ++q) st[8 + q] = *(const v4u*)(sg + (size_t)(tid_ + q * NTHR) * 8);
      st[12] = (v4u){0u, 0u, 0u, 0u}; if (tid_ < 320) st[12] = *(const v4u*)(rg + 4 * tid_); }
    bf16x8 qf[2][2], kd[2][2];
#pragma unroll
    for (int bi = 0; bi < 2; ++bi)
#pragma unroll
        for (int ks = 0; ks < 2; ++ks) { const bf16* p = P + (size_t)(16 * (bi == 0 ? wp : 3 - wp) + fr) * NPROJ + h * 64 + 32 * ks + 8 * kq; qf[bi][ks] = *(const bf16x8*)(p + PC_CQ); kd[bi][ks] = *(const bf16x8*)(p + PC_CI); }
#pragma unroll
    for (int q = 0; q < 4; ++q) { const int it = tid_ + q * NTHR; *(LAS v4u*)(KEl + (it >> 5) * 264 + 8 * (it & 31)) = st[q]; }
#pragma unroll
    for (int q = 0; q < 4; ++q) { const int it = tid_ + q * NTHR; *(LAS v4u*)(VTl + (it >> 3) * 72 + 8 * (it & 7)) = st[4 + q]; *(LAS v4u*)(SIN + (it >> 3) * 72 + 8 * (it & 7)) = st[8 + q]; }
    if (tid_ < 320) *(LAS v4u*)(Rl + 4 * tid_) = st[12];
    bf16 cgv[2][4][4];
#pragma unroll
    for (int bi = 0; bi < 2; ++bi)
#pragma unroll
        for (int t = 0; t < 4; ++t)
#pragma unroll
            for (int r = 0; r < 4; ++r) cgv[bi][t][r] = P[(size_t)(16 * (bi == 0 ? wp : 3 - wp) + 4 * kq + r) * NPROJ + PC_CG + h * 64 + t * 16 + fr];
    __syncthreads();
    const float* nw = inp(I_CNRM) + (size_t)layer * 256 + h * 64;
#pragma unroll
    for (int bi = 0; bi < 2; ++bi) {
        const int ib = bi == 0 ? wp : 3 - wp;
        float qv[2][8], rI[2][8];
#pragma unroll
        for (int ks = 0; ks < 2; ++ks) { unpack8(__builtin_bit_cast(v4u, qf[bi][ks]), qv[ks]); const lf32* rp = Rl + ib * 256 + h * 64 + 32 * ks + 8 * kq;
#pragma unroll
            for (int e = 0; e < 8; ++e) rI[ks][e] = rp[e]; }
#pragma unroll
        for (int J = 0; J < 4; ++J) {
            f32x4 acc = {0.f, 0.f, 0.f, 0.f};
            if (J <= ib) {
#pragma unroll
                for (int ks = 0; ks < 2; ++ks) {
                    bf16x8 a = qf[bi][ks], bfr = kd[bi][ks];
                    if (J < ib) { const lf32* rp = Rl + (J + 1) * 256 + h * 64 + 32 * ks + 8 * kq; float v[8];
#pragma unroll
                        for (int e = 0; e < 8; ++e) v[e] = qv[ks][e] * __expf(rI[ks][e] - rp[e]);
                        a = __builtin_bit_cast(bf16x8, pack8(v)); bfr = *(const LAS bf16x8*)(KEl + (16 * J + fr) * 264 + h * 64 + 32 * ks + 8 * kq); }
                    acc = __builtin_amdgcn_mfma_f32_16x16x32_bf16(a, bfr, acc, 0, 0, 0);
                }
            }
#pragma unroll
            for (int r = 0; r < 4; ++r) { const int i = 4 * kq + r, j = fr; const float v = (J < ib || (J == ib && j <= i)) ? acc[r] : 0.f; scr[(4 * kq + r) * 72 + 16 * J + fr] = (bf16)f2bf(v); }
        }
        asm volatile("s_waitcnt lgkmcnt(0)" ::: "memory");
        bf16x8 ga[2];
#pragma unroll
        for (int ks = 0; ks < 2; ++ks) ga[ks] = *(const LAS bf16x8*)(scr + fr * 72 + 32 * ks + 8 * kq);
        asm volatile("s_waitcnt lgkmcnt(0)" ::: "memory");
        bf16x8 qs[2];
#pragma unroll
        for (int ks = 0; ks < 2; ++ks) { float v[8];
#pragma unroll
            for (int e = 0; e < 8; ++e) v[e] = qv[ks][e] * __expf(rI[ks][e]);
            qs[ks] = __builtin_bit_cast(bf16x8, pack8(v)); }
        const int nks = (ib + 2) >> 1;
        f32x4 o[4]; float sq[4] = {0.f, 0.f, 0.f, 0.f};
#pragma unroll
        for (int t = 0; t < 4; ++t) {
            o[t] = (f32x4){0.f, 0.f, 0.f, 0.f};
#pragma unroll
            for (int ks = 0; ks < 2; ++ks) if (ks < nks) o[t] = __builtin_amdgcn_mfma_f32_16x16x32_bf16(ga[ks], *(const LAS bf16x8*)(VTl + (h * 64 + t * 16 + fr) * 72 + 32 * ks + 8 * kq), o[t], 0, 0, 0);
#pragma unroll
            for (int ks = 0; ks < 2; ++ks) o[t] = __builtin_amdgcn_mfma_f32_16x16x32_bf16(qs[ks], *(const LAS bf16x8*)(SIN + (h * 64 + t * 16 + fr) * 72 + 32 * ks + 8 * kq), o[t], 0, 0, 0);
#pragma unroll
            for (int r = 0; r < 4; ++r) sq[r] += o[t][r] * o[t][r];
        }
#pragma unroll
        for (int r = 0; r < 4; ++r) { const float rstd = rsq_f(sum16_l(lane_, sq[r]) * (1.0f / 64.0f) + EPS); bf16* op = F_XN + (size_t)(row0 + 16 * ib + 4 * kq + r) * D + 512 + h * 64 + fr;
#pragma unroll
            for (int t = 0; t < 4; ++t) op[t * 16] = (bf16)f2bf(o[t][r] * rstd * nw[t * 16 + fr] * silu_g(bf1(cgv[bi][t][r]))); }
    }
    __syncthreads();
}
template <int MODE>
__device__ __forceinline__ void mini_gemm(Frame& F, const bf16* A, const bf16* Bt, int K, int ncb, bf16* O, int ldo, const float* res, float* C, const float* nw = nullptr, bf16* xo = nullptr, float* rs = nullptr) {
    ITEM_IDS();
    const int kq = lane_ >> 4, fr = lane_ & 15;
    for (int wi = ((int)blockIdx.x) * NWAVES + wave_; wi < 16 * ncb; wi += ((int)gridDim.x) * NWAVES) {
        const int rb = wi & 15, cb = wi >> 4;
        const bf16* ap = A + (size_t)(MP + 16 * rb + fr) * K + 8 * kq;
        const int c = 16 * cb + fr;
        const bf16* bp = Bt + (size_t)(MODE == 2 ? ((c >> 7) * 256 + (c & 127)) : c) * K + 8 * kq;
        f32x4 acc0 = {0.f, 0.f, 0.f, 0.f}, acc1 = {0.f, 0.f, 0.f, 0.f};
#pragma unroll 8
        for (int k0 = 0; k0 < K; k0 += 32) {
            const bf16x8 a = *(const bf16x8*)(ap + k0), b0 = *(const bf16x8*)(bp + k0);
            acc0 = __builtin_amdgcn_mfma_f32_16x16x32_bf16(a, b0, acc0, 0, 0, 0);
            if (MODE == 2) { const bf16x8 b1 = *(const bf16x8*)(bp + (size_t)128 * K + k0); acc1 = __builtin_amdgcn_mfma_f32_16x16x32_bf16(a, b1, acc1, 0, 0, 0); }
        }
#pragma unroll
        for (int r = 0; r < 4; ++r) { const size_t row = (size_t)(MP + 16 * rb + 4 * kq + r);
            if (MODE == 0) { const bf16 ob = (bf16)f2bf(acc0[r]); O[row * ldo + c] = ob; if (c >= PC_V && c < PC_V + 256) F_VTA[(size_t)(c - PC_V) * M + row] = ob; }
            if (MODE == 1) { const float x = res[row * 1024 + c] + acc0[r]; C[row * 1024 + c] = x;
                if (nw) { xo[row * 1024 + c] = (bf16)f2bf(x * nw[c]); const float q = sum16_l(lane_, x * x); if (fr == 0) atomicAdd(rs + row, q); } }
            if (MODE == 2) O[row * ldo + c] = (bf16)f2bf(silu_g(acc0[r]) * acc1[r]); }
    }
}

template <int MODE, int KS>
__device__ __forceinline__ void mini_gemm2(Frame& F, const bf16* A, const bf16* Bt, int K, int ncb32, bf16* O, int ldo, const float* res, float* C, const float* nw = nullptr, bf16* xo = nullptr, float* rs = nullptr, const bf16* rbf = nullptr, const float* rw = nullptr, bf16* Cb = nullptr) {
    ITEM_IDS();
    const int kq = lane_ >> 4, fr = lane_ & 15;
    LAS f32x4* red = (LAS f32x4*)F.lds;
    for (int it = (int)blockIdx.x; it < 8 * ncb32; it += (int)gridDim.x) {
        const int rb = it & 7, cb = it >> 3;
        const bf16* ap = A + (size_t)(MP + 32 * rb + fr) * K + wave_ * (KS * 32) + 8 * kq;
        const bf16* bp = Bt + (size_t)(32 * cb + fr) * K + wave_ * (KS * 32) + 8 * kq;
        f32x4 acc[2][2] = {{(f32x4){0.f, 0.f, 0.f, 0.f}, (f32x4){0.f, 0.f, 0.f, 0.f}}, {(f32x4){0.f, 0.f, 0.f, 0.f}, (f32x4){0.f, 0.f, 0.f, 0.f}}};
#pragma unroll (KS > 6 ? 6 : KS)
        for (int ks = 0; ks < KS; ++ks) {
            bf16x8 a[2], b[2];
#pragma unroll
            for (int i = 0; i < 2; ++i) { a[i] = *(const bf16x8*)(ap + (size_t)(16 * i) * K + 32 * ks); b[i] = *(const bf16x8*)(bp + (size_t)(16 * i) * K + 32 * ks); }
#pragma unroll
            for (int i = 0; i < 2; ++i)
#pragma unroll
                for (int j = 0; j < 2; ++j) acc[i][j] = __builtin_amdgcn_mfma_f32_16x16x32_bf16(a[i], b[j], acc[i][j], 0, 0, 0);
        }
#pragma unroll
        for (int i = 0; i < 2; ++i)
#pragma unroll
            for (int j = 0; j < 2; ++j) red[(wave_ * 4 + 2 * i + j) * 64 + lane_] = acc[i][j];
        __syncthreads();
        if (wave_ < 4) {
            const int qi = wave_ >> 1, qj = wave_ & 1;
            f32x4 s = red[wave_ * 64 + lane_];
#pragma unroll
            for (int w = 1; w < 8; ++w) s += red[(w * 4 + wave_) * 64 + lane_];
            const int c = 32 * cb + 16 * qj + fr;
#pragma unroll
            for (int r = 0; r < 4; ++r) { const size_t row = (size_t)(MP + 32 * rb + 16 * qi + 4 * kq + r);
                if (MODE == 0) { const bf16 ob = (bf16)f2bf(s[r]); O[row * ldo + c] = ob; if (c >= PC_V && c < PC_V + 256) F_VTA[(size_t)(c - PC_V) * M + row] = ob; }
                if (MODE == 1) { const float x = (rbf ? bf1(rbf[row * 1024 + c]) * (rw ? rcp_f(rw[c]) : 1.0f) : res[row * 1024 + c]) + s[r]; if (C) C[row * 1024 + c] = x; if (Cb) Cb[row * 1024 + c] = (bf16)f2bf(x);
                    if (nw) { xo[row * 1024 + c] = (bf16)f2bf(x * nw[c]); const float q = sum16_l(lane_, x * x); if (fr == 0) atomicAdd(rs + row, q); } } }
        }
        __syncthreads();
    }
}

__device__ __forceinline__ void mini_gemm_proj(Frame& F, const bf16* A, const bf16* Bt, bf16* O, const float* rs) {
    ITEM_IDS();
    const int kq = lane_ >> 4, fr = lane_ & 15;
    LAS f32x4* red = (LAS f32x4*)F.lds;
    for (int it = (int)blockIdx.x; it < 4 * (NPROJ / 64); it += (int)gridDim.x) {
        const int rb = it & 3, cb = it >> 2;
        const bf16* ap = A + (size_t)(MP + 64 * rb + fr) * D + wave_ * 128 + 8 * kq;
        const bf16* bp = Bt + (size_t)(64 * cb + fr) * D + wave_ * 128 + 8 * kq;
        f32x4 acc[4][4];
#pragma unroll
        for (int i = 0; i < 4; ++i)
#pragma unroll
            for (int j = 0; j < 4; ++j) acc[i][j] = (f32x4){0.f, 0.f, 0.f, 0.f};
        bf16x8 a[4][4], b[4][4];
#pragma unroll
        for (int ks = 0; ks < 4; ++ks)
#pragma unroll
            for (int i = 0; i < 4; ++i) { a[ks][i] = *(const bf16x8*)(ap + (size_t)(16 * i) * D + 32 * ks); b[ks][i] = *(const bf16x8*)(bp + (size_t)(16 * i) * D + 32 * ks); }
#pragma unroll
        for (int ks = 0; ks < 4; ++ks)
#pragma unroll
            for (int i = 0; i < 4; ++i)
#pragma unroll
                for (int j = 0; j < 4; ++j) acc[i][j] = __builtin_amdgcn_mfma_f32_16x16x32_bf16(a[ks][i], b[ks][j], acc[i][j], 0, 0, 0);
#pragma unroll
        for (int i = 0; i < 4; ++i)
#pragma unroll
            for (int j = 0; j < 4; ++j) red[(wave_ * 16 + 4 * i + j) * 64 + lane_] = acc[i][j];
        __syncthreads();
#pragma unroll
        for (int u = 0; u < 2; ++u) { const int q = 2 * wave_ + u, qi = q >> 2, qj = q & 3;
            f32x4 s = red[q * 64 + lane_];
#pragma unroll
            for (int w = 1; w < 8; ++w) s += red[(w * 16 + q) * 64 + lane_];
            const int c = 64 * cb + 16 * qj + fr;
#pragma unroll
            for (int r = 0; r < 4; ++r) { const size_t row = (size_t)(MP + 64 * rb + 16 * qi + 4 * kq + r); const bf16 ob = (bf16)f2bf(rs ? s[r] * rsq_f(rs[row] * (1.0f / 1024.0f) + EPS) : s[r]); O[row * NPROJ + c] = ob; if (c >= PC_V && c < PC_V + 256) F_VTA[(size_t)(c - PC_V) * M + row] = ob; } }
        __syncthreads();
    }
}

__device__ __forceinline__ void mini_dt(Frame& F, const bf16* A, const bf16* Wd, const float* rs, float* DTo) {
    ITEM_IDS();
    const int kq = lane_ >> 4, fr = lane_ & 15;
    for (int wi = (int)blockIdx.x * NWAVES + wave_; wi < M / 16; wi += (int)gridDim.x * NWAVES) {
        const bf16* ap = A + (size_t)(16 * wi + fr) * D + 8 * kq; const bf16* bp = Wd + (size_t)fr * D + 8 * kq;
        f32x4 acc = {0.f, 0.f, 0.f, 0.f};
#pragma unroll 16
        for (int k0 = 0; k0 < D; k0 += 32) acc = __builtin_amdgcn_mfma_f32_16x16x32_bf16(*(const bf16x8*)(ap + k0), *(const bf16x8*)(bp + k0), acc, 0, 0, 0);
        if (fr < 4) {
#pragma unroll
            for (int r = 0; r < 4; ++r) { const int row = 16 * wi + 4 * kq + r; DTo[(size_t)row * 4 + fr] = acc[r] * rsq_f(rs[row] * (1.0f / 1024.0f) + EPS); } }
    }
}
__device__ __forceinline__ void sample_mix_item(Frame& F, int layer, int b) {
    ssd_prep_item(F, layer, NCHP + b);
    hgrn_prep_item(F, layer, NCHP + b);
    asm volatile("s_waitcnt vmcnt(0)" ::: "memory");
    __syncthreads();
    __builtin_amdgcn_fence(__ATOMIC_ACQUIRE, "agent");
    asm volatile("s_waitcnt vmcnt(0)" ::: "memory");
    { ITEM_IDS();
      if (wave_ == 0) ssd_out_witem(F, layer, NCHP + b, 0, wave_, lane_);
      else if (wave_ <= 4) hgrn_out_witem(F, layer, NCHP + b, wave_ - 1, 0, wave_, lane_); }
    __syncthreads();
}
__device__ __forceinline__ void p2_phase(Frame& F, int layer, volatile LAS unsigned* MISC) {
    constexpr int NS = NSB, NA = NCH * 4, NB = NCHP, NC = NCHP, ND = NCH, NE = 64, NW0 = 296, NW = 432;
    const int NTOT = NS + NA + NB + NC + ND + NE + (layer == 0 ? NW0 + NW : 0);
    unsigned* head = (unsigned*)(F.ws + WS_CTL) + CW_QUEUE + 64 * layer;
    attn_bias_load(F, layer);
    unsigned nxt = 0u; if (threadIdx.x == 0) nxt = __hip_atomic_fetch_add(head, 1u, __ATOMIC_RELAXED, __HIP_MEMORY_SCOPE_AGENT);
    for (;;) {
        __syncthreads();
        if (threadIdx.x == 0) MISC[12] = nxt;
        __syncthreads();
        int it = (int)MISC[12];
        if (it >= NTOT) break;
        if (threadIdx.x == 0) nxt = __hip_atomic_fetch_add(head, 1u, __ATOMIC_RELAXED, __HIP_MEMORY_SCOPE_AGENT);
        if (it < NS) { sample_mix_item(F, layer, it); continue; } it -= NS;
        if (it < NA) { const int i2 = it - NSB * 4; const int ci = it < NSB * 4 ? NCHP + (it >> 2) : NCHP - 1 - (i2 >> 2); attn_item(F, layer, ci, it & 3); }
        else if (it < NA + NB) ssd_prep_item(F, layer, it - NA);
        else if (it < NA + NB + NC) hgrn_prep_item(F, layer, it - NA - NB);
        else if (it < NA + NB + NC + ND) pool_item(F, layer, it - NA - NB - NC);
        else if (it < NA + NB + NC + ND + NE) copy_cache(F, layer, it - NA - NB - NC - ND, NE);
        else { ITEM_IDS(); const int iw = it - NA - NB - NC - ND - NE;
            if (iw < NW0) p0_weights(F, 0, iw * NWAVES + wave_, NW0 * NWAVES, false, 1); else p0_weights(F, 1, (iw - NW0) * NWAVES + wave_, NW * NWAVES, false); }
    }
}
__device__ __forceinline__ void p4_phase(Frame& F, int layer) {
    for (int ci = ((int)blockIdx.x); ci < NCHP; ci += ((int)gridDim.x)) { ssd_out_block(F, layer, ci); hgrn_out_block(F, layer, ci); }
}

__global__ void __launch_bounds__(NTHR, 2) fwd_kernel(Args args) {
    extern __shared__ __attribute__((aligned(16))) unsigned char lds[];
    Frame F;
    F.lds = (LAS unsigned char*)lds;
    F.out = args.out; F.ws = args.ws;
    volatile LAS unsigned* MISC = (volatile LAS unsigned*)(F.lds + MISC_OFF);
    if (threadIdx.x < 64) MISC[threadIdx.x] = 0u;
    __syncthreads();
    (void)xcd_barrier_post((unsigned*)(args.ws + WS_CTL) + CW_BAR, MISC + 8);
#define GRID_BAR() do { XcdBarrier bar_; bar_.bar = (unsigned*)((unsigned char*)inp(N_IN + 1) + WS_CTL) + CW_BAR; bar_.x = xb_xcc_id(); bar_.st = MISC + 8; xcd_barrier(bar_); \
        F.out = (float*)inp(N_IN); F.ws = (unsigned char*)inp(N_IN + 1); } while (0)
#ifdef TPROBE
    const bool stamper = (blockIdx.x == 0 && threadIdx.x == 0); int n_stamp = 0;
#define STAMP() do { if (stamper) MISC[16 + n_stamp] = (unsigned)__builtin_amdgcn_s_memrealtime(); ++n_stamp; } while (0)
#else
#define STAMP() do { } while (0)
#endif
    STAMP();

    { float* rsz = F_RS; for (int i = (int)blockIdx.x * NTHR + (int)threadIdx.x; i < 3 * M; i += (int)gridDim.x * NTHR) rsz[i] = 0.f;
      const float* w1 = inp(I_WIN) + (size_t)D * NIN; bf16* wd = F_WDT; for (int i = (int)blockIdx.x * NTHR + (int)threadIdx.x; i < 16 * D; i += (int)gridDim.x * NTHR) { const int hh = i >> 10, kk = i & 1023; wd[i] = hh < 4 ? (bf16)f2bf(w1[(size_t)kk * NIN + 1792 + hh]) : (bf16)0; } }
    {
      const int w_ = __builtin_amdgcn_readfirstlane((int)(threadIdx.x >> 6));
      { const float* wdt = inp(I_WIN); lf32* wl = (lf32*)(F.lds + 135168); for (int k2 = (int)threadIdx.x; k2 < D; k2 += NTHR) *(LAS f32x4*)(wl + 4 * k2) = *(const f32x4*)(wdt + (size_t)k2 * NIN + 1792); }
      { const float* pw = inp(I_PW); for (int i = (int)blockIdx.x * NTHR + (int)threadIdx.x; i < 2 * 4 * 64 * 64; i += (int)gridDim.x * NTHR) { const int c = i & 63, d = (i >> 6) & 63, lg = i >> 12; F_WPT[i] = (bf16)f2bf(pw[(size_t)(lg * 64 + c) * 64 + d]); } }
      __syncthreads();
      if (w_ < 2) p0_weights(F, 0, (int)blockIdx.x * 2 + w_, (int)gridDim.x * 2, false, 0);
      else norm_rows<true, false>(F, inp(I_XP), inp(I_XS) - (size_t)MP * D, inp(I_N1), inp(I_WIN), nullptr, (int)blockIdx.x * 6 + (w_ - 2), (int)gridDim.x * 6); }
    GRID_BAR(); STAMP();
#pragma unroll 1
    for (int layer = 0; layer < 2; ++layer) {
        unsigned char* wl = F.ws + WS_W + (size_t)layer * WL_STRIDE;
        const bf16* a1 = layer == 0 ? F_XN : (const bf16*)F.out; const float* rs1 = layer == 0 ? nullptr : F_RS + 2 * (size_t)M;
        if (layer == 1) mini_dt(F, a1, F_WDT, rs1, F_DT);
        mini_gemm_proj(F, a1, (const bf16*)(wl + WL_IN), F_PROJ, rs1);
        { pg8::Gemm g{a1, (const bf16*)(wl + WL_IN), MP, NPROJ, D}; pg8::StaticOrder S; S.init(MP, NPROJ, ((int)gridDim.x), ((int)blockIdx.x));
          pg8::EpiBf16 E{F_PROJ, NPROJ, F_HALO, F_VTA, M, rs1};
          pg8::gemm_phase<pg8::EpiBf16, pg8::StaticOrder, true, true>(F.lds + RING_OFF, g, S, E); }
        GRID_BAR(); STAMP();
        p2_phase(F, layer, MISC);
        GRID_BAR(); STAMP();
        scan_phase(F, layer);
        GRID_BAR(); STAMP();
        p4_phase(F, layer);
        GRID_BAR(); STAMP();
        mini_gemm2<1, 4>(F, F_XN, (const bf16*)(wl + WL_OUT), D, D / 32, nullptr, 0, inp(I_XS) - (size_t)MP * D, nullptr, inp(I_N2) + (size_t)layer * D, F_XN2, F_RS + (size_t)layer * M, layer == 0 ? nullptr : (const bf16*)F.out, layer == 0 ? nullptr : inp(I_N1) + D);
        { pg8::Gemm g{F_XN, (const bf16*)(wl + WL_OUT), MP, D, D}; pg8::StaticOrder S; S.init(MP, D, ((int)gridDim.x), ((int)blockIdx.x));
          pg8::EpiRes E{inp(I_XP), inp(I_XS) - (size_t)MP * D, nullptr, inp(I_N2) + (size_t)layer * D, F_XN2, F_RS + (size_t)layer * M, layer == 0 ? nullptr : (const bf16*)F.out, layer == 0 ? nullptr : inp(I_N1) + D, nullptr};
          pg8::gemm_phase<pg8::EpiRes, pg8::StaticOrder, true, true>(F.lds + RING_OFF, g, S, E); }
        GRID_BAR(); STAMP();
        { pg8::Gemm g{F_XN2, (const bf16*)(wl + WL_GU), M, NGU, D}; pg8::StaticOrder S; S.init(M, NGU, ((int)gridDim.x), ((int)blockIdx.x));
          pg8::EpiSwiGLU E{F_ACT, DFF, F_RS + (size_t)layer * M};
          pg8::gemm_phase<pg8::EpiSwiGLU, pg8::StaticOrder, true, true>(F.lds + RING_OFF, g, S, E); }
        GRID_BAR(); STAMP();
        mini_gemm2<1, 11>(F, F_ACT, (const bf16*)(wl + WL_DN), DFF, D / 32, nullptr, 0, nullptr, nullptr, layer == 0 ? inp(I_N1) + D : nullptr, (bf16*)F.out, F_RS + 2 * (size_t)M, F_XN2, inp(I_N2) + (size_t)layer * D, layer == 0 ? nullptr : F_XN);
        { pg8::Gemm g{F_ACT, (const bf16*)(wl + WL_DN), MP, D, DFF}; pg8::StaticOrder S; S.init(MP, D, ((int)gridDim.x), ((int)blockIdx.x));
          pg8::EpiRes E{nullptr, nullptr, nullptr, layer == 0 ? inp(I_N1) + D : nullptr, (bf16*)F.out, F_RS + 2 * (size_t)M, F_XN2, inp(I_N2) + (size_t)layer * D, layer == 0 ? nullptr : F_XN};
          pg8::gemm_phase<pg8::EpiRes, pg8::StaticOrder, true, true>(F.lds + RING_OFF, g, S, E); }
        GRID_BAR(); STAMP();
        if (layer == 1) { norm_rows<false, true>(F, nullptr, nullptr, inp(I_NF), nullptr, F_XN); STAMP(); }
    }
#ifdef TPROBE
    if (stamper) {
        unsigned v[10]; v[0] = MISC[17] - MISC[16];
        for (int j = 1; j < 9; ++j) v[j] = (MISC[17 + j] - MISC[16 + j]) + (MISC[25 + j] - MISC[24 + j]);
        v[9] = (MISC[33] - MISC[16]) / 4;
        const unsigned dl = 800000u + 16u * v[TPROBE];
        const unsigned t0 = MISC[16];
        while ((unsigned)((unsigned)__builtin_amdgcn_s_memrealtime() - t0) < dl) __builtin_amdgcn_s_sleep(32);
    }
#endif
}

extern "C" void kernel_launch(void* const* d_in, const int* in_sizes, int n_in, void* d_out, int out_size, void* d_ws, size_t ws_size, hipStream_t stream) {
    static int grid = 0;
    if (grid == 0) {
        if (n_in != N_IN || (size_t)out_size != O_END || ws_size < WS_END) { fprintf(stderr, "kernel_launch: unexpected shapes (n_in %d, out %d, ws %zu)\n", n_in, out_size, ws_size); grid = -1; return; }
        int dev = 0, cus = 0, per_cu = 0;
        if (hipGetDevice(&dev) != hipSuccess || hipDeviceGetAttribute(&cus, hipDeviceAttributeMultiprocessorCount, dev) != hipSuccess) { grid = -1; return; }
        if (hipFuncSetAttribute((const void*)fwd_kernel, hipFuncAttributeMaxDynamicSharedMemorySize, LDS_BYTES) != hipSuccess) { fprintf(stderr, "kernel_launch: hipFuncSetAttribute failed\n"); grid = -1; return; }
        if (hipOccupancyMaxActiveBlocksPerMultiprocessor(&per_cu, (const void*)fwd_kernel, NTHR, LDS_BYTES) != hipSuccess || per_cu < 1) { fprintf(stderr, "kernel_launch: occupancy query says %d blocks per CU\n", per_cu); (void)hipGetLastError(); grid = -1; return; }
        grid = cus;
        if (grid < 64) { fprintf(stderr, "kernel_launch: needs at least 64 CUs (got %d)\n", cus); grid = -1; return; }
    }
    if (grid < 0) return;
    if (hipMemsetAsync((char*)d_ws + WS_CTL, 0, CTL_ZERO_BYTES, stream) != hipSuccess) { fprintf(stderr, "kernel_launch: hipMemsetAsync failed\n"); return; }
    Args a{};
    for (int i = 0; i < N_IN; ++i) a.in[i] = (const float*)d_in[i];
    a.out = (float*)d_out; a.ws = (unsigned char*)d_ws;
    void* kargs[] = {&a};
    hipError_t e = hipLaunchCooperativeKernel((const void*)fwd_kernel, dim3(grid), dim3(NTHR), kargs, LDS_BYTES, stream);
    if (e != hipSuccess) { fprintf(stderr, "kernel_launch: cooperative launch failed: %s (grid %d)\n", hipGetErrorString(e), grid); }
}
```

```cpp
#include <hip/hip_runtime.h>
#include <cstdio>
#include <cstdint>
namespace pg8 {
#define PG8_LAS __attribute__((address_space(3)))
typedef unsigned short bf16_t;
typedef short bf16x8 __attribute__((ext_vector_type(8)));
typedef float f32x4 __attribute__((ext_vector_type(4)));
typedef unsigned u32x4 __attribute__((ext_vector_type(4)));
constexpr int BM = 256, BK = 64, HALF = 128, HTB = HALF * BK * 2  , STAGE_BYTES = 8 * HTB, NXCD = 8, WGM = 8;

__host__ __device__ __forceinline__ int lds_byte(int r, int c) { const int st = (r >> 4) * 2 + (c >> 5), rr = r & 15, cc = c & 31, ob = rr * 64 + cc * 2; return st * 1024 + (ob ^ (((ob >> 9) & 1) << 5)); }
__host__ __device__ __forceinline__ void stage_rc(int b, int& R, int& C) { const int st = b / 1024, sb = b % 1024, swz = sb ^ (((sb >> 9) & 1) << 5); R = (st >> 1) * 16 + swz / 64; C = (st & 1) * 32 + (swz % 64) / 2; }
__host__ __device__ __forceinline__ int perm32(int rho) { const int n = rho >> 4, i = rho & 15; return 8 * (i >> 2) + 4 * n + (i & 3); }

struct Unit { int pm, pn; };
struct Gemm { const bf16_t* A; const bf16_t* Bt; int M, N, K; };

struct StaticOrder {
    int nM, nN, nwg, G, c;
    __host__ __device__ void init(int M, int N, int G_, int c_) { nM = M / BM; nN = N / BM; nwg = nM * nN; G = G_; c = c_; }
    __host__ __device__ bool next(int i, Unit& u) const {
        const long L = (long)i * G + c; if (L >= nwg) return false;
        int wgid = (int)L; { const int q = nwg / NXCD, r = nwg % NXCD, xcd = wgid % NXCD, off = wgid / NXCD; wgid = (xcd < r ? xcd * (q + 1) : r * (q + 1) + (xcd - r) * q) + off; }
        const int nig = WGM * nN, gid = wgid / nig, fm = gid * WGM, gsz = (nM - fm) < WGM ? (nM - fm) : WGM;
        u.pm = fm + ((wgid % nig) % gsz); u.pn = (wgid % nig) / gsz; return true;
    }
    __device__ __forceinline__ void a_ready(const Unit&) const {}
    __device__ __forceinline__ void done(const Unit&) const {}
};

__device__ __forceinline__ unsigned cvt_pk_bf16(float lo, float hi) { unsigned r; asm volatile("v_cvt_pk_bf16_f32 %0, %1, %2" : "=v"(r) : "v"(lo), "v"(hi)); return r; }
__device__ __forceinline__ float silu_f(float x) { return x * __builtin_amdgcn_rcpf(1.0f + __expf(-x)); }
struct EpiBf16 {
    static constexpr bool PERM = true, AFTER_DRAIN = false;
    bf16_t* O; int ldc; bf16_t* halo; bf16_t* vta; int vld; const float* rs;
    __device__ __forceinline__ void operator()(const f32x4 (&acc)[2][2][4][2], const Unit& u, int wr, int wc, int fr, int fq) const {
        const int row0 = u.pm * BM + wr * 64 + fr, col0 = u.pn * BM + wc * 32 + 8 * fq;
        const bool hz = halo != nullptr && u.pn >= 4 && u.pn <= 6;
#pragma unroll
        for (int ai = 0; ai < 2; ++ai)
#pragma unroll
            for (int m = 0; m < 4; ++m) { const int row = row0 + ai * HALF + m * 16; bf16_t* rowp = O + (size_t)row * ldc + col0;
                const float rstd = rs ? __builtin_amdgcn_rsqf(rs[row] * (1.0f / 1024.0f) + 1e-6f) : 1.0f;
#pragma unroll
                for (int bj = 0; bj < 2; ++bj) { const f32x4 v0 = acc[ai][bj][m][0] * rstd, v1 = acc[ai][bj][m][1] * rstd;
                    u32x4 w; w.x = cvt_pk_bf16(v0[0], v0[1]); w.y = cvt_pk_bf16(v0[2], v0[3]); w.z = cvt_pk_bf16(v1[0], v1[1]); w.w = cvt_pk_bf16(v1[2], v1[3]);
                    *(u32x4*)(rowp + bj * HALF) = w;
                    if (hz && (row & 63) >= 61) *(u32x4*)(halo + ((size_t)(row >> 6) * 3 + (row & 63) - 61) * 768 + (col0 - 1024) + bj * HALF) = w;
                    if (vta != nullptr && u.pn == 2) { bf16_t* vp = vta + (size_t)(col0 - 512 + bj * HALF) * vld + row;
                        vp[0] = (bf16_t)(w.x & 0xffffu); vp[(size_t)vld] = (bf16_t)(w.x >> 16); vp[(size_t)2 * vld] = (bf16_t)(w.y & 0xffffu); vp[(size_t)3 * vld] = (bf16_t)(w.y >> 16);
                        vp[(size_t)4 * vld] = (bf16_t)(w.z & 0xffffu); vp[(size_t)5 * vld] = (bf16_t)(w.z >> 16); vp[(size_t)6 * vld] = (bf16_t)(w.w & 0xffffu); vp[(size_t)7 * vld] = (bf16_t)(w.w >> 16); } } }
    }
};
struct EpiRes {
    static constexpr bool PERM = false, AFTER_DRAIN = false;
    const float* rlo; const float* rhi; float* C; const float* nw; bf16_t* xo; float* rs; const bf16_t* rbf; const float* rw; bf16_t* Cb;
    __device__ __forceinline__ void operator()(const f32x4 (&acc)[2][2][4][2], const Unit& u, int wr, int wc, int fr, int fq) const {
        const int row0 = u.pm * BM + wr * 64 + fr, col0 = u.pn * BM + wc * 32 + 4 * fq;
        const float* rb = (u.pm < 64) ? rlo : rhi;
        f32x4 wv[2][2], wq[2][2];
#pragma unroll
        for (int bj = 0; bj < 2; ++bj)
#pragma unroll
            for (int n = 0; n < 2; ++n) { wv[bj][n] = nw ? *(const f32x4*)(nw + col0 + bj * HALF + n * 16) : (f32x4){1.f, 1.f, 1.f, 1.f};
                if (rbf && rw) { const f32x4 t = *(const f32x4*)(rw + col0 + bj * HALF + n * 16); wq[bj][n] = (f32x4){__builtin_amdgcn_rcpf(t[0]), __builtin_amdgcn_rcpf(t[1]), __builtin_amdgcn_rcpf(t[2]), __builtin_amdgcn_rcpf(t[3])}; }
                else wq[bj][n] = (f32x4){1.f, 1.f, 1.f, 1.f}; }
#pragma unroll
        for (int ai = 0; ai < 2; ++ai)
#pragma unroll
        for (int mh = 0; mh < 2; ++mh) {
            f32x4 rv[2][2][2];
#pragma unroll
            for (int m2 = 0; m2 < 2; ++m2)
#pragma unroll
                for (int bj = 0; bj < 2; ++bj)
#pragma unroll
                    for (int n = 0; n < 2; ++n) { const size_t o = (size_t)(row0 + ai * HALF + (2 * mh + m2) * 16) * 1024 + col0 + bj * HALF + n * 16;
                        if (rbf) { const unsigned long long w = *(const unsigned long long*)(rbf + o); const unsigned lo = (unsigned)w, hi = (unsigned)(w >> 32);
                            rv[m2][bj][n] = (f32x4){__builtin_bit_cast(float, lo << 16), __builtin_bit_cast(float, lo & 0xffff0000u), __builtin_bit_cast(float, hi << 16), __builtin_bit_cast(float, hi & 0xffff0000u)} * wq[bj][n]; }
                        else rv[m2][bj][n] = *(const f32x4*)(rb + o); }
#pragma unroll
            for (int m2 = 0; m2 < 2; ++m2) { const int m = 2 * mh + m2; const int row = row0 + ai * HALF + m * 16; const size_t off = (size_t)row * 1024 + col0; float ss = 0.f;
#pragma unroll
                for (int bj = 0; bj < 2; ++bj)
#pragma unroll
                    for (int n = 0; n < 2; ++n) { const f32x4 x = rv[m2][bj][n] + acc[ai][bj][m][n]; if (C) *(f32x4*)(C + off + bj * HALF + n * 16) = x;
                        if (Cb) *(unsigned long long*)(Cb + off + bj * HALF + n * 16) = (unsigned long long)cvt_pk_bf16(x[0], x[1]) | ((unsigned long long)cvt_pk_bf16(x[2], x[3]) << 32);
                        if (nw) { ss += (x[0] * x[0] + x[1] * x[1]) + (x[2] * x[2] + x[3] * x[3]); const f32x4 y = x * wv[bj][n];
                            *(unsigned long long*)(xo + off + bj * HALF + n * 16) = (unsigned long long)cvt_pk_bf16(y[0], y[1]) | ((unsigned long long)cvt_pk_bf16(y[2], y[3]) << 32); } }
                if (nw) { const int lane = fq * 16 + fr;
                    ss += __builtin_bit_cast(float, __builtin_amdgcn_ds_bpermute((lane ^ 16) << 2, __builtin_bit_cast(int, ss)));
                    ss += __builtin_bit_cast(float, __builtin_amdgcn_ds_bpermute((lane ^ 32) << 2, __builtin_bit_cast(int, ss)));
                    if (fq == 0) atomicAdd(rs + row, ss); } }
            asm volatile("" ::: "memory");
        }
    }
};
struct EpiSwiGLU {
    static constexpr bool PERM = true, AFTER_DRAIN = false;
    bf16_t* O; int ldc; const float* rs;
    __device__ __forceinline__ void operator()(const f32x4 (&acc)[2][2][4][2], const Unit& u, int wr, int wc, int fr, int fq) const {
        const int row0 = u.pm * BM + wr * 64 + fr, col0 = u.pn * HALF + wc * 32 + 8 * fq;
#pragma unroll
        for (int ai = 0; ai < 2; ++ai)
#pragma unroll
            for (int m = 0; m < 4; ++m) { const int row = row0 + ai * HALF + m * 16; bf16_t* rowp = O + (size_t)row * ldc + col0;
                const float rstd = __builtin_amdgcn_rsqf(rs[row] * (1.0f / 1024.0f) + 1e-6f);
                const f32x4 g0 = acc[ai][0][m][0] * rstd, g1 = acc[ai][0][m][1] * rstd, u0 = acc[ai][1][m][0] * rstd, u1 = acc[ai][1][m][1] * rstd;
                u32x4 w; w.x = cvt_pk_bf16(silu_f(g0[0]) * u0[0], silu_f(g0[1]) * u0[1]); w.y = cvt_pk_bf16(silu_f(g0[2]) * u0[2], silu_f(g0[3]) * u0[3]);
                w.z = cvt_pk_bf16(silu_f(g1[0]) * u1[0], silu_f(g1[1]) * u1[1]); w.w = cvt_pk_bf16(silu_f(g1[2]) * u1[2], silu_f(g1[3]) * u1[3]);
                *(u32x4*)rowp = w; }
    }
};
template <class Epi, class Sched, bool ALIGN_EPI = false, bool SP2 = false>
__device__ __forceinline__ void gemm_phase(PG8_LAS unsigned char* lds, const Gemm g, const Sched& S, const Epi& E) {
    int tid0 = threadIdx.x; asm volatile("" : "+v"(tid0));
    const int tid = tid0, wid = __builtin_amdgcn_readfirstlane(tid >> 6), lane = tid & 63, wr = wid >> 2, wc = wid & 3, fr = lane & 15, fq = lane >> 4;
    const int K = g.K, nt = K / BK;
    unsigned voffA[2], voffB[2];
#pragma unroll
    for (int i = 0; i < 2; ++i) { int R, C; stage_rc(tid * 16 + i * 8192, R, C); const int Rb = Epi::PERM ? ((R & ~31) + perm32(R & 31)) : R;
        voffA[i] = (unsigned)(R * K + C) * 2u; voffB[i] = (unsigned)(Rb * K + C) * 2u; }
    const size_t kstep = (size_t)(BK * 2);
    const size_t hstep = (size_t)HALF * K * 2;
    const size_t tstep = 2 * hstep;
    const unsigned ldsw = (unsigned)wid * 1024u;
    const int aoff = lds_byte(wr * 64 + fr, fq * 8), boff = lds_byte(wc * 32 + fr, fq * 8);
#define PG8_SA(b, h) (((b) * 2 + (h)) * HTB)
#define PG8_SB(b, h) ((4 + (b) * 2 + (h)) * HTB)
#define PG8_STAGE(bufoff, gbase, voff) do { _Pragma("unroll") for (int _i = 0; _i < 2; ++_i) \
        __builtin_amdgcn_global_load_lds((const unsigned*)((const char*)(gbase) + (voff)[_i]), (PG8_LAS unsigned*)(lds + (bufoff) + ldsw + _i * 8192), 16, 0, 0); } while (0)
#define PG8_LDA(dst, b, h) do { _Pragma("unroll") for (int m = 0; m < 4; ++m) _Pragma("unroll") for (int k = 0; k < 2; ++k) dst[m][k] = *(const PG8_LAS bf16x8*)(lds + PG8_SA(b, h) + aoff + m * 2048 + k * 1024); } while (0)
#define PG8_LDB(dst, b, h) do { _Pragma("unroll") for (int n = 0; n < 2; ++n) _Pragma("unroll") for (int k = 0; k < 2; ++k) dst[n][k] = *(const PG8_LAS bf16x8*)(lds + PG8_SB(b, h) + boff + n * 2048 + k * 1024); } while (0)
#define PG8_MMA(ai, bj, At, Bt) do { __builtin_amdgcn_s_setprio(1); _Pragma("unroll") for (int m = 0; m < 4; ++m) _Pragma("unroll") for (int n = 0; n < 2; ++n) _Pragma("unroll") for (int k = 0; k < 2; ++k) \
        acc[ai][bj][m][n] = __builtin_amdgcn_mfma_f32_16x16x32_bf16(Bt[n][k], At[m][k], acc[ai][bj][m][n], 0, 0, 0); __builtin_amdgcn_s_setprio(0); } while (0)
#define PG8_WAIT_V(n) asm volatile("s_waitcnt vmcnt(" #n ")" ::: "memory")
#define PG8_WAIT_L(n) asm volatile("s_waitcnt lgkmcnt(" #n ")" ::: "memory")
#define PG8_BAR __builtin_amdgcn_s_barrier()
#define PG8_SCHED __builtin_amdgcn_sched_barrier(0)
    Unit cur, nxt; int ui = 0;
    if (!S.next(0, cur)) return;
    f32x4 acc[2][2][4][2];
#pragma unroll
    for (int a = 0; a < 2; ++a)
#pragma unroll
        for (int b = 0; b < 2; ++b)
#pragma unroll
            for (int m = 0; m < 4; ++m)
#pragma unroll
                for (int n = 0; n < 2; ++n) acc[a][b][m][n] = (f32x4){0.f, 0.f, 0.f, 0.f};
    bf16x8 At[4][2], B0[2][2], B1[2][2];
    const char* cA = (const char*)g.A + (size_t)cur.pm * tstep; const char* cB = (const char*)g.Bt + (size_t)cur.pn * tstep;
    S.a_ready(cur);
    if constexpr (SP2) {
        PG8_STAGE(PG8_SB(0, 0), cB, voffB); PG8_STAGE(PG8_SB(0, 1), cB + hstep, voffB); PG8_STAGE(PG8_SA(0, 0), cA, voffA); PG8_STAGE(PG8_SA(0, 1), cA + hstep, voffA);
        if (wr == 1) PG8_BAR;
        PG8_WAIT_V(2); PG8_BAR;
        PG8_STAGE(PG8_SB(1, 0), cB + kstep, voffB); PG8_STAGE(PG8_SA(1, 0), cA + kstep, voffA); PG8_STAGE(PG8_SB(1, 1), cB + hstep + kstep, voffB);
        PG8_WAIT_V(6); PG8_BAR;
    } else {
        PG8_STAGE(PG8_SB(0, 0), cB, voffB); PG8_STAGE(PG8_SA(0, 0), cA, voffA); PG8_STAGE(PG8_SB(0, 1), cB + hstep, voffB); PG8_STAGE(PG8_SA(0, 1), cA + hstep, voffA);
        if (wr == 1) PG8_BAR;
        PG8_WAIT_V(4); PG8_BAR;
        PG8_STAGE(PG8_SB(1, 0), cB + kstep, voffB); PG8_STAGE(PG8_SA(1, 0), cA + kstep, voffA); PG8_STAGE(PG8_SB(1, 1), cB + hstep + kstep, voffB);
        PG8_WAIT_V(6); PG8_BAR;
    }
    for (;;) {
        const bool has_next = S.next(ui + 1, nxt);
        const char* nA = has_next ? (const char*)g.A + (size_t)nxt.pm * tstep : cA; const char* nB = has_next ? (const char*)g.Bt + (size_t)nxt.pn * tstep : cB;
        for (int t = 0; t < nt; t += 2) {
            const bool last = (t == nt - 2);
            const char* a1 = cA + (size_t)(t + 1) * kstep;
            const char* a2 = last ? nA : cA + (size_t)(t + 2) * kstep; const char* b2 = last ? nB : cB + (size_t)(t + 2) * kstep;
            const char* a3 = a2 + kstep; const char* b3 = b2 + kstep;
            if (last && has_next) S.a_ready(nxt);
            if constexpr (SP2) {
            PG8_LDB(B0, 0, 0); PG8_LDB(B1, 0, 1); PG8_SCHED; PG8_LDA(At, 0, 0); PG8_STAGE(PG8_SA(1, 1), a1 + hstep, voffA);
            PG8_WAIT_V(8); PG8_WAIT_L(0); PG8_BAR; PG8_MMA(0, 0, At, B0); PG8_MMA(0, 1, At, B1); PG8_BAR; PG8_SCHED;
            PG8_LDA(At, 0, 1); PG8_STAGE(PG8_SB(0, 0), b2, voffB); PG8_STAGE(PG8_SB(0, 1), b2 + hstep, voffB); PG8_STAGE(PG8_SA(0, 0), a2, voffA);
            PG8_WAIT_V(8); PG8_WAIT_L(0); PG8_BAR; PG8_MMA(1, 0, At, B0); PG8_MMA(1, 1, At, B1); PG8_BAR; PG8_SCHED;
            PG8_LDB(B0, 1, 0); PG8_LDB(B1, 1, 1); PG8_SCHED; PG8_LDA(At, 1, 0); PG8_STAGE(PG8_SA(0, 1), a2 + hstep, voffA);
            PG8_WAIT_V(8); PG8_WAIT_L(0); PG8_BAR; PG8_MMA(0, 0, At, B0); PG8_MMA(0, 1, At, B1); PG8_BAR; PG8_SCHED;
            PG8_LDA(At, 1, 1); PG8_STAGE(PG8_SB(1, 0), b3, voffB); PG8_STAGE(PG8_SB(1, 1), b3 + hstep, voffB); PG8_STAGE(PG8_SA(1, 0), a3, voffA);
            PG8_WAIT_V(8); PG8_WAIT_L(0); PG8_BAR; PG8_MMA(1, 0, At, B0); PG8_MMA(1, 1, At, B1); PG8_BAR; PG8_SCHED;
            } else {
            PG8_LDB(B0, 0, 0); PG8_SCHED; PG8_LDA(At, 0, 0); PG8_STAGE(PG8_SA(1, 1), a1 + hstep, voffA);
            PG8_WAIT_L(8); PG8_BAR; PG8_WAIT_L(0); PG8_MMA(0, 0, At, B0); PG8_BAR; PG8_SCHED;
            PG8_LDB(B1, 0, 1); PG8_STAGE(PG8_SB(0, 0), b2, voffB);
            PG8_BAR; PG8_WAIT_L(0); PG8_MMA(0, 1, At, B1); PG8_BAR;
            PG8_LDA(At, 0, 1); PG8_STAGE(PG8_SA(0, 0), a2, voffA);
            PG8_BAR; PG8_WAIT_L(0); PG8_MMA(1, 0, At, B0); PG8_BAR; PG8_SCHED;
            PG8_STAGE(PG8_SB(0, 1), b2 + hstep, voffB);
            PG8_WAIT_V(6); PG8_BAR; PG8_MMA(1, 1, At, B1); PG8_BAR;
            PG8_LDB(B0, 1, 0); PG8_SCHED; PG8_LDA(At, 1, 0); PG8_STAGE(PG8_SA(0, 1), a2 + hstep, voffA);
            PG8_WAIT_L(8); PG8_BAR; PG8_WAIT_L(0); PG8_MMA(0, 0, At, B0); PG8_BAR; PG8_SCHED;
            PG8_LDB(B1, 1, 1); PG8_STAGE(PG8_SB(1, 0), b3, voffB);
            PG8_BAR; PG8_WAIT_L(0); PG8_MMA(0, 1, At, B1); PG8_BAR;
            PG8_LDA(At, 1, 1); PG8_STAGE(PG8_SA(1, 0), a3, voffA);
            PG8_BAR; PG8_WAIT_L(0); PG8_MMA(1, 0, At, B0); PG8_BAR; PG8_SCHED;
            PG8_STAGE(PG8_SB(1, 1), b3 + hstep, voffB);
            PG8_WAIT_V(6); PG8_BAR; PG8_MMA(1, 1, At, B1); PG8_BAR;
            }
        }
        if constexpr (ALIGN_EPI) { if (wr == 0) PG8_BAR; }
        if constexpr (!Epi::AFTER_DRAIN) { E(acc, cur, wr, wc, fr, fq); S.done(cur); }
        if (!has_next) break;
#pragma unroll
        for (int a = 0; a < 2; ++a)
#pragma unroll
            for (int b = 0; b < 2; ++b)
#pragma unroll
                for (int m = 0; m < 4; ++m)
#pragma unroll
                    for (int n = 0; n < 2; ++n) acc[a][b][m][n] = (f32x4){0.f, 0.f, 0.f, 0.f};
        cur = nxt; cA = nA; cB = nB; ++ui;
        if constexpr (ALIGN_EPI) { if (wr == 1) PG8_BAR; }
    }
    PG8_WAIT_V(0);
    if constexpr (!ALIGN_EPI) { if (wr == 0) PG8_BAR; }
    PG8_BAR;
    if constexpr (Epi::AFTER_DRAIN) { E.fused(acc, cur, wr, wc, fr, fq, lds, wid, lane); S.done(cur); }
#undef PG8_SA
#undef PG8_SB
#undef PG8_STAGE
#undef PG8_LDA
#undef PG8_LDB
#undef PG8_MMA
#undef PG8_WAIT_V
#undef PG8_WAIT_L
#undef PG8_BAR
#undef PG8_SCHED
}
}
#define GAS __attribute__((address_space(1)))
#define LAS __attribute__((address_space(3)))
typedef unsigned short bf16;
typedef unsigned v4u __attribute__((ext_vector_type(4)));
typedef float f32x4 __attribute__((ext_vector_type(4)));
typedef short bf16x8 __attribute__((ext_vector_type(8)));
typedef GAS unsigned gu32;
typedef GAS unsigned long long gu64;
#define RLX_AGENT __ATOMIC_RELAXED, __HIP_MEMORY_SCOPE_AGENT
#define LDS_WAIT() asm volatile("s_waitcnt lgkmcnt(0)" ::: "memory")
#define VM_WAIT() asm volatile("s_waitcnt vmcnt(0)" ::: "memory")
__device__ __forceinline__ unsigned long long rt() { return __builtin_amdgcn_s_memrealtime(); }
__device__ __forceinline__ unsigned f2bf(float f) { unsigned u = __builtin_bit_cast(unsigned, f); return (u + 0x7fffu + ((u >> 16) & 1u)) >> 16; }
__device__ __forceinline__ unsigned pk2(float lo, float hi) { return f2bf(lo) | (f2bf(hi) << 16); }
#define XB_TMO      128
#define XB_XCNT(j)  (256  + 64 * (j))
#define XB_XSUB(j)  (1280 + 64 * (j))
#define XB_XGEN(j)  (2304 + 64 * (j))
#define XB_TOP      3328
#define XB_TOPGEN   3392
#define XCD_BAR_WORDS 3456
#define XB_SPIN_CAP (1u << 18)

__device__ __forceinline__ unsigned xb_ld(unsigned* p)              { return __hip_atomic_load(p, __ATOMIC_RELAXED, __HIP_MEMORY_SCOPE_AGENT); }
__device__ __forceinline__ unsigned xb_add(unsigned* p, unsigned v) { return __hip_atomic_fetch_add(p, v, __ATOMIC_RELAXED, __HIP_MEMORY_SCOPE_AGENT); }
__device__ __forceinline__ unsigned xb_xcc_id() { return (unsigned)__builtin_amdgcn_s_getreg((3 << 11) | 20) & 0xFu; }
#define XB_SPIN(cond, bar) do { unsigned _sp = 0; while (cond) { __builtin_amdgcn_s_sleep(1); \
    if ((++_sp & 255u) == 0u) { if (xb_ld(&(bar)[XB_TMO])) break; if (_sp > XB_SPIN_CAP) { atomicAdd(&(bar)[XB_TMO], 1u); break; } } } } while (0)

struct XcdBarrier {
    unsigned* bar; unsigned x;
    volatile LAS unsigned* st;
};

__device__ __forceinline__ XcdBarrier xcd_barrier_post(unsigned* bar, volatile LAS unsigned* st) {
    XcdBarrier b; b.bar = bar; b.x = xb_xcc_id(); b.st = st;
    if (threadIdx.x == 0) (void)xb_add(&bar[XB_XCNT(b.x)], 1u);
    return b;
}
__device__ __forceinline__ void xcd_barrier_complete(unsigned* bar, unsigned x, unsigned& nloc, unsigned& nx) {
    const unsigned G = gridDim.x * gridDim.y * gridDim.z;
    unsigned sum, cnt, mine, sp = 0u;
    for (;;) {
        sum = 0u; cnt = 0u; mine = 0u;
#pragma unroll
        for (unsigned j = 0; j < 16; ++j) { const unsigned c = xb_ld(&bar[XB_XCNT(j)]); sum += c; cnt += (c > 0u) ? 1u : 0u; mine = (j == x) ? c : mine; }
        if (sum == G) break;
        __builtin_amdgcn_s_sleep(1);
        if ((++sp & 255u) == 0u) { if (xb_ld(&bar[XB_TMO])) break; if (sp > XB_SPIN_CAP) { atomicAdd(&bar[XB_TMO], 1u); break; } }
    }
    nloc = mine > 0u ? mine : 1u; nx = cnt > 0u ? cnt : 1u;
}

__device__ __forceinline__ void xcd_barrier(const XcdBarrier& b) {
    asm volatile("s_waitcnt vmcnt(0)" ::: "memory");
    __syncthreads();
    if (threadIdx.x == 0) {
        unsigned* bar = b.bar;
        __builtin_amdgcn_s_waitcnt(0);
        unsigned nloc = b.st[0], nx = b.st[1];
        if (nloc == 0u) { xcd_barrier_complete(bar, b.x, nloc, nx); b.st[0] = nloc; b.st[1] = nx; }
        const unsigned old = xb_add(&bar[XB_XSUB(b.x)], 1u);
        const unsigned gen = old / nloc;
        if (old + 1u == (gen + 1u) * nloc) {
            __builtin_amdgcn_fence(__ATOMIC_RELEASE, "agent");
            asm volatile("s_waitcnt vmcnt(0)" ::: "memory");
            const unsigned og = xb_add(&bar[XB_TOP], 1u);
            const unsigned tg = og / nx;
            if (og + 1u == (tg + 1u) * nx) xb_add(&bar[XB_TOPGEN], 1u);
            else XB_SPIN(xb_ld(&bar[XB_TOPGEN]) == tg, bar);
            __builtin_amdgcn_fence(__ATOMIC_ACQUIRE, "agent");
            xb_add(&bar[XB_XGEN(b.x)], 1u);
            asm volatile("s_waitcnt vmcnt(0)" ::: "memory");
        } else {
            XB_SPIN(xb_ld(&bar[XB_XGEN(b.x)]) == gen, bar);
            __builtin_amdgcn_fence(__ATOMIC_ACQUIRE, "agent");
            asm volatile("s_waitcnt vmcnt(0)" ::: "memory");
        }
    }
    __syncthreads();
}
constexpr int NWAVES = 8, NTHR = 512;
constexpr int D = 1024, MP = 16384, NSB = 16, SSEQ = 16, MS = NSB * SSEQ, M = MP + MS;
constexpr int NIN = 3076, NPROJ = 3072, DFF = 2816, NGU = 2 * DFF;
constexpr int NCHP = 256, NCH = NCHP + NSB;
constexpr int PC_Q = 0, PC_K = 256, PC_V = 512, PC_Z = 768, PC_X = 1024, PC_B = 1280, PC_C = 1536, PC_CQ = 1792, PC_CF = 2048, PC_CI = 2304, PC_CG = 2560, PC_DX = 2816;
constexpr float EPS = 1e-6f;
enum { I_XP = 0, I_XS, I_CK, I_CV, I_SCONV, I_SSSM, I_SHGRN, I_SPOOL, I_N1, I_WIN, I_AREL, I_CW, I_CB, I_DTB, I_ALOG, I_BD, I_BNRM, I_LB, I_CNRM, I_PW, I_PS, I_WOUT, I_N2, I_WGU, I_WDN, I_NF, N_IN };
constexpr size_t O_YP = 0, O_YS = O_YP + (size_t)MP * D, O_PK = O_YS + (size_t)MS * D, O_PV = O_PK + 2 * 512 * 256, O_PCONV = O_PV + 2 * 512 * 256, O_PSSM = O_PCONV + 2 * 3 * 768,
                 O_PHGRN = O_PSSM + 2 * 4 * 64 * 128, O_PPOOL = O_PHGRN + 2 * 4 * 64 * 64, O_SK = O_PPOOL + 2 * 15 * 256, O_SV = O_SK + (size_t)2 * 16 * 512 * 256,
                 O_SCONV = O_SV + (size_t)2 * 16 * 512 * 256, O_SSSM = O_SCONV + 2 * 16 * 3 * 768, O_SHGRN = O_SSSM + 2 * 16 * 4 * 64 * 128, O_SPOOL = O_SHGRN + 2 * 16 * 4 * 64 * 64,
                 O_END = O_SPOOL + 2 * 16 * 15 * 256;
constexpr size_t MiB = 1u << 20;
constexpr size_t WS_CTL = 0, CTL_ZERO_BYTES = 64 * 1024;
constexpr size_t WL_IN = 0, WL_OUT = 6 * MiB, WL_GU = 8 * MiB, WL_DN = 19 * MiB, WL_STRIDE = 24 * MiB + MiB / 2;
constexpr size_t WS_W = 1 * MiB;
constexpr size_t WS_XN = 50 * MiB;
constexpr size_t WS_PROJ = 83 * MiB;
constexpr size_t WS_STB = 181 * MiB;
constexpr size_t WS_XT = 198 * MiB;
constexpr size_t WS_HALO = 207 * MiB;
constexpr size_t WS_RH = 208 * MiB + MiB / 2;
constexpr size_t WS_STC = 215 * MiB;
constexpr size_t WS_VT = 223 * MiB + MiB / 2;
constexpr size_t WS_DT = 232 * MiB;
constexpr size_t WS_DECB = 233 * MiB;
constexpr size_t WS_DECC = 233 * MiB + 64 * 1024;
constexpr size_t WS_ACS = 233 * MiB + 384 * 1024, WS_DTV = 233 * MiB + 704 * 1024;
constexpr size_t WS_VTA = 234 * MiB;
constexpr size_t WS_CAR = 243 * MiB;
constexpr size_t WS_END = 245 * MiB;
static_assert(WS_VTA + (size_t)256 * M * 2 <= WS_END, "ws map 2");
constexpr int CW_QUEUE = 512;
static_assert(WS_XN + (size_t)M * D * 2 <= WS_PROJ && WS_PROJ + (size_t)M * NPROJ * 2 <= WS_STB && WS_STB + (size_t)NCH * 4 * 64 * 128 * 2 <= WS_XT && WS_XT + (size_t)NCH * 256 * 64 * 2 <= WS_HALO && WS_HALO + (size_t)256 * 3 * 768 * 2 <= WS_STC && WS_RH + (size_t)NCH * 1280 * 4 <= WS_STC && WS_STC + (size_t)NCH * 4 * 64 * 64 * 2 <= WS_VT && WS_VT + (size_t)NCH * 256 * 64 * 2 <= WS_DT, "ws map");
static_assert(WL_DN + (size_t)D * DFF * 2 <= WL_STRIDE && WS_W + 2 * WL_STRIDE <= WS_XN, "weight map");
constexpr size_t WS_WPT = 128 * 1024;
constexpr size_t WS_WDT = 192 * 1024;
constexpr size_t WS_RS = 256 * 1024;
constexpr size_t WS_XN2 = 181 * MiB;
static_assert(WS_XN2 + (size_t)M * D * 2 <= 232 * MiB && WS_RS + 3 * (size_t)M * 4 <= MiB, "ws map 3");
constexpr int CW_SCAN = 8192;
constexpr int CW_BAR = 1024;
constexpr int LDS_BYTES = 163840;
constexpr int MISC_OFF = LDS_BYTES - 256;
constexpr int RING_OFF = 0;
typedef LAS float lf32;
typedef float f32x2 __attribute__((ext_vector_type(2)));
struct Args { const float* in[N_IN]; float* out; unsigned char* ws; };
struct Frame {
    LAS unsigned char* lds;
    float* out; unsigned char* ws;
};
__device__ __forceinline__ float* inp(int i) { asm volatile("" : "+s"(i)); return ((float* const __attribute__((address_space(4)))*)__builtin_amdgcn_kernarg_segment_ptr())[i]; }
__device__ __forceinline__ unsigned char* opq(unsigned char* p) { asm volatile("" : "+s"(p)); return p; }
#define ITEM_IDS() int tid_ = threadIdx.x; asm volatile("" : "+v"(tid_)); const int wave_ = __builtin_amdgcn_readfirstlane(tid_ >> 6); const int lane_ = tid_ & 63; (void)lane_; (void)wave_
#define F_XN ((bf16*)opq(F.ws + WS_XN))
#define F_PROJ ((bf16*)opq(F.ws + WS_PROJ))
#define F_ACT ((bf16*)opq(F.ws + WS_PROJ))
#define F_STB ((bf16*)opq(F.ws + WS_STB))
#define F_XT ((bf16*)opq(F.ws + WS_XT))
#define F_HALO ((bf16*)opq(F.ws + WS_HALO))
#define F_ACS ((float*)opq(F.ws + WS_ACS))
#define F_DTV ((float*)opq(F.ws + WS_DTV))
#define F_STC ((bf16*)opq(F.ws + WS_STC))
#define F_VT ((bf16*)opq(F.ws + WS_VT))
#define F_RH ((float*)opq(F.ws + WS_RH))
#define F_VTA ((bf16*)opq(F.ws + WS_VTA))
#define F_WPT ((bf16*)opq(F.ws + WS_WPT))
#define F_RS ((float*)opq(F.ws + WS_RS))
#define F_WDT ((bf16*)opq(F.ws + WS_WDT))
#define F_XN2 ((bf16*)opq(F.ws + WS_XN2))
#define F_DT ((float*)opq(F.ws + WS_DT))
#define F_DECB ((float*)opq(F.ws + WS_DECB))
#define F_DECC ((float*)opq(F.ws + WS_DECC))
#define F_X    (F.out)
__device__ __forceinline__ float bf_lo(unsigned w) { return __builtin_bit_cast(float, w << 16); }
__device__ __forceinline__ float bf_hi(unsigned w) { return __builtin_bit_cast(float, w & 0xffff0000u); }
__device__ __forceinline__ float bf1(bf16 b) { return __builtin_bit_cast(float, (unsigned)b << 16); }
__device__ __forceinline__ void unpack8(const v4u w, float (&v)[8]) { v[0] = bf_lo(w.x); v[1] = bf_hi(w.x); v[2] = bf_lo(w.y); v[3] = bf_hi(w.y); v[4] = bf_lo(w.z); v[5] = bf_hi(w.z); v[6] = bf_lo(w.w); v[7] = bf_hi(w.w); }
__device__ __forceinline__ v4u pack8(const float (&v)[8]) { v4u o; o.x = pk2(v[0], v[1]); o.y = pk2(v[2], v[3]); o.z = pk2(v[4], v[5]); o.w = pk2(v[6], v[7]); return o; }
__device__ __forceinline__ float shx(int lane, float v, int o) { return __builtin_bit_cast(float, __builtin_amdgcn_ds_bpermute((lane ^ o) << 2, __builtin_bit_cast(int, v))); }
__device__ __forceinline__ float shu(int lane, float v, int o) { return __builtin_bit_cast(float, __builtin_amdgcn_ds_bpermute((lane - o) << 2, __builtin_bit_cast(int, v))); }
__device__ __forceinline__ float shi(float v, int idx) { return __builtin_bit_cast(float, __builtin_amdgcn_ds_bpermute(idx << 2, __builtin_bit_cast(int, v))); }
__device__ __forceinline__ float wave_sum_l(int lane, float v) {
#pragma unroll
    for (int o = 1; o < 64; o <<= 1) v += shx(lane, v, o);
    return v;
}
__device__ __forceinline__ float sum16_l(int lane, float v) {
#pragma unroll
    for (int o = 1; o < 16; o <<= 1) v += shx(lane, v, o);
    return v;
}
__device__ __forceinline__ float max16_l(int lane, float v) {
#pragma unroll
    for (int o = 1; o < 16; o <<= 1) v = fmaxf(v, shx(lane, v, o));
    return v;
}
__device__ __forceinline__ float rcp_f(float x) { return __builtin_amdgcn_rcpf(x); }
__device__ __forceinline__ float rsq_f(float x) { return __builtin_amdgcn_rsqf(x); }
__device__ __forceinline__ float sigmoid_f(float x) { return rcp_f(1.0f + __expf(-x)); }
__device__ __forceinline__ float silu_g(float x) { return x * rcp_f(1.0f + __expf(-x)); }
__device__ __forceinline__ float softplus_f(float x) { const float e = __expf(x); return x > 20.f ? x : (e < 0.01f ? e * (1.0f - e * (0.5f - e * (1.0f / 3.0f))) : __logf(1.0f + e)); }
__device__ __forceinline__ f32x4 mfma4(float a, float b, f32x4 c) { return __builtin_amdgcn_mfma_f32_16x16x4f32(a, b, c, 0, 0, 0); }

struct Chunk { int ci, row0, nrows, b; };
__device__ __forceinline__ Chunk chunk_of(int ci) { Chunk c; c.ci = ci; if (ci < NCHP) { c.row0 = 64 * ci; c.nrows = 64; c.b = -1; } else { c.b = ci - NCHP; c.row0 = MP + SSEQ * c.b; c.nrows = SSEQ; } return c; }

__device__ __forceinline__ void tr_item64(const float* W, int ldw, int K, bf16* WT, int k0, int nd0, int ns0, float scale, lf32* scr, int lane) {
    f32x4 wv_[16];
    const int rq = lane >> 4, c4 = (lane & 15) * 4;
#pragma unroll
    for (int i = 0; i < 16; ++i) wv_[i] = *(const f32x4*)(W + (size_t)(k0 + 4 * i + rq) * ldw + ns0 + c4);
#pragma unroll
    for (int i = 0; i < 16; ++i) { lf32* d = scr + (4 * i + rq) * 65 + c4; d[0] = wv_[i].x; d[1] = wv_[i].y; d[2] = wv_[i].z; d[3] = wv_[i].w; }
    LDS_WAIT(); asm volatile("" ::: "memory");
    const int c = lane & 7;
#pragma unroll
    for (int j = 0; j < 8; ++j) { const int n = (lane >> 3) + 8 * j; const lf32* s = scr + (8 * c) * 65 + n;
        v4u o; o.x = pk2(s[0 * 65] * scale, s[1 * 65] * scale); o.y = pk2(s[2 * 65] * scale, s[3 * 65] * scale); o.z = pk2(s[4 * 65] * scale, s[5 * 65] * scale); o.w = pk2(s[6 * 65] * scale, s[7 * 65] * scale);
        *(GAS v4u*)(WT + (size_t)(nd0 + n) * K + k0 + 8 * c) = o; }
    LDS_WAIT(); asm volatile("" ::: "memory");
}
__device__ __forceinline__ void tr_item(const float* W, int ldw, int K, bf16* WT, int k0, int nd0, int ns0, float scale, lf32* scr, int lane) {
    float wv_[32];
#pragma unroll
    for (int i = 0; i < 32; ++i) wv_[i] = W[(size_t)(k0 + 2 * i + (lane >> 5)) * ldw + ns0 + (lane & 31)];
#pragma unroll
    for (int i = 0; i < 32; ++i) scr[(2 * i + (lane >> 5)) * 33 + (lane & 31)] = wv_[i];
    LDS_WAIT(); asm volatile("" ::: "memory");
    const int c = lane & 7;
#pragma unroll
    for (int j = 0; j < 4; ++j) { const int n = (lane >> 3) + 8 * j; const lf32* s = scr + (8 * c) * 33 + n;
        v4u o; o.x = pk2(s[0 * 33] * scale, s[1 * 33] * scale); o.y = pk2(s[2 * 33] * scale, s[3 * 33] * scale); o.z = pk2(s[4 * 33] * scale, s[5 * 33] * scale); o.w = pk2(s[6 * 33] * scale, s[7 * 33] * scale);
        *(GAS v4u*)(WT + (size_t)(nd0 + n) * K + k0 + 8 * c) = o; }
    LDS_WAIT(); asm volatile("" ::: "memory");
}
__device__ __forceinline__ void p0_weights(Frame& F, int l, int gw, int NGW, bool pool, int part = 2  ) {
    ITEM_IDS();
    lf32* scr = (lf32*)(F.lds + wave_ * 16896);
    constexpr int I_INA = 16 * 28, I_INB = 16 * 40, I_OUT = 16 * 16, I_GU = 16 * 88, I_DN = 44 * 16, I_L = I_INA + I_INB + I_OUT + I_GU + I_DN;
    unsigned char* wl = F.ws + WS_W + (size_t)l * WL_STRIDE;
    const int i_lo = part == 1 ? I_INA + I_INB : 0, i_hi = part == 0 ? I_INA + I_INB : I_L;
    for (int it = i_lo + gw; it < i_hi; it += NGW) {
        int r = it;
        if (r < I_INA) { const int kb = r / 28, nb = r % 28, nd0 = 64 * nb; tr_item64(inp(I_WIN) + (size_t)l * D * NIN, NIN, D, (bf16*)(wl + WL_IN), 64 * kb, nd0, nd0, nd0 < 256 ? 0.125f : 1.0f, scr, lane_); continue; } r -= I_INA;
        if (r < I_INB) { const int kb = r / 40, nb = r % 40, nd0 = 1792 + 32 * nb; tr_item(inp(I_WIN) + (size_t)l * D * NIN, NIN, D, (bf16*)(wl + WL_IN), 64 * kb, nd0, nd0 + 4, 1.0f, scr, lane_); continue; } r -= I_INB;
        if (r < I_OUT) { const int kb = r / 16, nb = r % 16; tr_item64(inp(I_WOUT) + (size_t)l * D * D, D, D, (bf16*)(wl + WL_OUT), 64 * kb, 64 * nb, 64 * nb, 1.0f, scr, lane_); continue; } r -= I_OUT;
        if (r < I_GU) { const int kb = r / 88, nb = r % 88, nd0 = 64 * nb, pn = nd0 >> 8, bj = (nd0 >> 7) & 1, c = nd0 & 127; tr_item64(inp(I_WGU) + (size_t)l * D * NGU, NGU, D, (bf16*)(wl + WL_GU), 64 * kb, nd0, bj * DFF + 128 * pn + c, 1.0f, scr, lane_); continue; } r -= I_GU;
        { const int kb = r / 16, nb = r % 16; tr_item64(inp(I_WDN) + (size_t)l * DFF * D, D, DFF, (bf16*)(wl + WL_DN), 64 * kb, 64 * nb, 64 * nb, 1.0f, scr, lane_); }
    }
    if (pool) { const float* pw = inp(I_PW); for (int i = ((int)blockIdx.x) * NTHR + tid_; i < 2 * 4 * 64 * 64; i += ((int)gridDim.x) * NTHR) { const int c = i & 63, d = (i >> 6) & 63, lg = i >> 12; F_WPT[i] = (bf16)f2bf(pw[(size_t)(lg * 64 + c) * 64 + d]); } }
}
template <bool WITH_DT, bool FINAL>
__device__ __forceinline__ void norm_rows(Frame& F, const float* xlo, const float* xhi, const float* w, const float* wdt  , const bf16* xb = nullptr  , int gw_ = -1, int ngw_ = 0  , bf16* xcopy = nullptr  ) {
    ITEM_IDS();
    lf32* wl = (lf32*)(F.lds + (gw_ >= 0 ? 135168 : 0));
    if (WITH_DT && gw_ < 0) { for (int k = tid_; k < D; k += NTHR) { const f32x4 v = *(const f32x4*)(wdt + (size_t)k * NIN + 1792); *(LAS f32x4*)(wl + 4 * k) = v; } __syncthreads(); }
    const int gw = gw_ >= 0 ? gw_ : ((int)blockIdx.x) * NWAVES + wave_, NGW = gw_ >= 0 ? ngw_ : ((int)gridDim.x) * NWAVES;
    f32x4 wv[4];
#pragma unroll
    for (int j = 0; j < 4; ++j) wv[j] = *(const f32x4*)(w + 256 * j + 4 * lane_);
    for (int m0 = gw; m0 < M; m0 += 4 * NGW) {
        f32x4 v[4][4];
#pragma unroll
        for (int q = 0; q < 4; ++q) { const int m = m0 + q * NGW; if (m < M) {
            if (xb) {
#pragma unroll
                for (int j = 0; j < 4; ++j) { const unsigned long long t = *(const unsigned long long*)(xb + (size_t)m * D + 256 * j + 4 * lane_); v[q][j] = (f32x4){bf_lo((unsigned)t), bf_hi((unsigned)t), bf_lo((unsigned)(t >> 32)), bf_hi((unsigned)(t >> 32))}; }
            } else { const float* xr = (m < MP ? xlo : xhi) + (size_t)m * D;
#pragma unroll
                for (int j = 0; j < 4; ++j) v[q][j] = *(const f32x4*)(xr + 256 * j + 4 * lane_); } } }
#pragma unroll
        for (int q = 0; q < 4; ++q) { const int m = m0 + q * NGW; if (m < M) {
            float s = 0.f;
            if (xcopy) { GAS unsigned long long* c8 = (GAS unsigned long long*)(xcopy + (size_t)m * D) + lane_;
#pragma unroll
                for (int j = 0; j < 4; ++j) c8[64 * j] = (unsigned long long)pk2(v[q][j].x, v[q][j].y) | ((unsigned long long)pk2(v[q][j].z, v[q][j].w) << 32); }
#pragma unroll
            for (int j = 0; j < 4; ++j) s += (v[q][j].x * v[q][j].x + v[q][j].y * v[q][j].y) + (v[q][j].z * v[q][j].z + v[q][j].w * v[q][j].w);
            const float rstd = rsq_f(wave_sum_l(lane_, s) * (1.0f / D) + EPS);
#pragma unroll
            for (int j = 0; j < 4; ++j) v[q][j] = v[q][j] * rstd * wv[j];
            if (FINAL) {
#pragma unroll
                for (int j = 0; j < 4; ++j) *(f32x4*)(F.out + (size_t)m * D + 256 * j + 4 * lane_) = v[q][j];
            } else {
                GAS unsigned long long* o8 = (GAS unsigned long long*)(F_XN + (size_t)m * D) + lane_;
#pragma unroll
                for (int j = 0; j < 4; ++j) o8[64 * j] = (unsigned long long)pk2(v[q][j].x, v[q][j].y) | ((unsigned long long)pk2(v[q][j].z, v[q][j].w) << 32);
            }
            if (WITH_DT) {
                f32x4 a = {0.f, 0.f, 0.f, 0.f};
#pragma unroll
                for (int j = 0; j < 4; ++j) { const LAS f32x4* wp = (const LAS f32x4*)(wl + 4 * (256 * j + 4 * lane_));
                    a += wp[0] * v[q][j].x; a += wp[1] * v[q][j].y; a += wp[2] * v[q][j].z; a += wp[3] * v[q][j].w; }
                a.x = wave_sum_l(lane_, a.x); a.y = wave_sum_l(lane_, a.y); a.z = wave_sum_l(lane_, a.z); a.w = wave_sum_l(lane_, a.w);
                if (lane_ == 0) *(f32x4*)(F_DT + (size_t)m * 4) = a;
            } } }
    }
    if (WITH_DT && gw_ < 0) __syncthreads();
}
constexpr int PL_RAW = 0, PL_PL = 79 * 256 * 4, PL_END = PL_PL + 64 * 264 * 2;
static_assert(PL_END <= MISC_OFF, "pool LDS map");
__device__ __forceinline__ void pool_item(Frame& F, int layer, int ci) {
    ITEM_IDS();
    const Chunk c = chunk_of(ci);
    lf32* raw = (lf32*)(F.lds + PL_RAW);
    LAS bf16* Pl = (LAS bf16*)(F.lds + PL_PL);
    const float* spool = inp(I_SPOOL) + (size_t)(layer * NSB + (c.b < 0 ? 0 : c.b)) * 15 * 256;
    v4u pw[5]; f32x4 pf[5][2];
#pragma unroll
    for (int q = 0; q < 5; ++q) { const int it = tid_ + q * NTHR; pw[q] = (v4u){0u, 0u, 0u, 0u}; pf[q][0] = (f32x4){0.f, 0.f, 0.f, 0.f}; pf[q][1] = pf[q][0];
        if (it < 79 * 32) { const int rr = it >> 5, cg = it & 31, r = rr - 15;
            if (r < c.nrows) { if (r >= 0 || (c.b < 0 && c.row0 + r >= 0)) pw[q] = *(const v4u*)(F_PROJ + (size_t)(c.row0 + r) * NPROJ + PC_DX + 8 * cg);
                               else if (c.b >= 0) { const float* s = spool + (size_t)(15 + r) * 256 + 8 * cg; pf[q][0] = *(const f32x4*)s; pf[q][1] = *(const f32x4*)(s + 4); } } } }
#pragma unroll
    for (int q = 0; q < 5; ++q) { const int it = tid_ + q * NTHR;
        if (it < 79 * 32) { const int rr = it >> 5, cg = it & 31, r = rr - 15; float v[8];
            if (c.b >= 0 && r < 0) { v[0] = pf[q][0].x; v[1] = pf[q][0].y; v[2] = pf[q][0].z; v[3] = pf[q][0].w; v[4] = pf[q][1].x; v[5] = pf[q][1].y; v[6] = pf[q][1].z; v[7] = pf[q][1].w; } else unpack8(pw[q], v);
            *(LAS f32x4*)(raw + rr * 256 + 8 * cg) = (f32x4){v[0], v[1], v[2], v[3]}; *(LAS f32x4*)(raw + rr * 256 + 8 * cg + 4) = (f32x4){v[4], v[5], v[6], v[7]}; } }
    __syncthreads();
    { const int ch = tid_ & 255, half = tid_ >> 8, win = 2 << (ch >> 6); const float inv = 1.0f / (float)win;
      const lf32* rp = raw + (32 * half + 15) * 256 + ch;
      float s = 0.f; for (int q = 1; q < win; ++q) s += rp[-q * 256];
#pragma unroll 8
      for (int r = 0; r < 32; ++r) { const float x = rp[r * 256], xo = rp[(r - win + 1) * 256]; s += x; Pl[(32 * half + r) * 264 + ch] = (bf16)f2bf(s * inv - x); s -= xo; } }
    __syncthreads();
    const int tb = wave_ >> 1, g0 = 2 * (wave_ & 1), kq = lane_ >> 4, fr = lane_ & 15;
    const bf16* wt = F_WPT + (size_t)layer * 4 * 64 * 64; const float* sc = inp(I_PS) + (size_t)layer * 256;
#pragma unroll
    for (int gg = 0; gg < 2; ++gg) {
        const int g = g0 + gg;
        bf16x8 bw[4][2];
#pragma unroll
        for (int t = 0; t < 4; ++t)
#pragma unroll
            for (int ks = 0; ks < 2; ++ks) bw[t][ks] = *(const bf16x8*)(wt + (size_t)(g * 64 + t * 16 + fr) * 64 + 32 * ks + 8 * kq);
        bf16x8 a[2];
#pragma unroll
        for (int ks = 0; ks < 2; ++ks) a[ks] = *(const LAS bf16x8*)(Pl + (tb * 16 + fr) * 264 + g * 64 + 32 * ks + 8 * kq);
#pragma unroll
        for (int t = 0; t < 4; ++t) { f32x4 acc = {0.f, 0.f, 0.f, 0.f};
#pragma unroll
            for (int ks = 0; ks < 2; ++ks) acc = __builtin_amdgcn_mfma_f32_16x16x32_bf16(a[ks], bw[t][ks], acc, 0, 0, 0);
            const float s = sc[g * 64 + t * 16 + fr];
#pragma unroll
            for (int r = 0; r < 4; ++r) { const int row = tb * 16 + 4 * kq + r; if (row < c.nrows) F_XN[(size_t)(c.row0 + row) * D + 768 + g * 64 + t * 16 + fr] = (bf16)f2bf(acc[r] * s); } }
    }
    __syncthreads();
}

__device__ __forceinline__ void copy_cache(Frame& F, int layer, int b0, int nb) {
    ITEM_IDS();
    const int gt = b0 * NTHR + tid_, GT = nb * NTHR;
    float* out = F.out; const float* ckp = inp(I_CK); const float* cvp = inp(I_CV);
    for (int base = gt; base < 32 * 31744; base += 8 * GT) {
        f32x4 v[8];
#pragma unroll
        for (int q = 0; q < 8; ++q) { const int i = base + q * GT; if (i < 32 * 31744) { const int wb = i / 31744, e = i - wb * 31744; const int which = wb >> 4, b = wb & 15;
            v[q] = *(const f32x4*)((which ? cvp : ckp) + ((size_t)(layer * NSB + b) * 512 + 16) * 256 + 4 * (size_t)e); } }
#pragma unroll
        for (int q = 0; q < 8; ++q) { const int i = base + q * GT; if (i < 32 * 31744) { const int wb = i / 31744, e = i - wb * 31744; const int which = wb >> 4, b = wb & 15;
            *(f32x4*)(out + (which ? O_SV : O_SK) + (size_t)(layer * NSB + b) * 512 * 256 + 4 * (size_t)e) = v[q]; } }
    }
}
__device__ __forceinline__ void copy_small(Frame& F, int layer, int b0, int nb) {
    ITEM_IDS();
    const int gt = b0 * NTHR + tid_, GT = nb * NTHR;
    float* out = F.out;
    constexpr int T_P = 2 * 512 * 32, T_S = 2 * 16 * 16 * 32, T_D = 17 * 15 * 32, T_ALL = T_P + T_S + T_D;
    for (int base = gt; base < T_ALL; base += 4 * GT) {
        v4u w[4];
#pragma unroll
        for (int q = 0; q < 4; ++q) { int t = base + q * GT; if (t < T_ALL) { size_t src;
            if (t < T_P) { const int which = t >> 14, j = (t >> 5) & 511, cg = t & 31; src = (size_t)(MP - 512 + j) * NPROJ + (which ? PC_V : PC_K) + 8 * cg; }
            else if (t < T_P + T_S) { t -= T_P; const int which = t >> 13, b = (t >> 9) & 15, j = (t >> 5) & 15, cg = t & 31; src = (size_t)(MP + 16 * b + j) * NPROJ + (which ? PC_V : PC_K) + 8 * cg; }
            else { t -= T_P + T_S; const int b = t / 480, rr = (t / 32) % 15, cg = t & 31; src = (size_t)(b == 0 ? MP - 15 + rr : MP + 16 * (b - 1) + 1 + rr) * NPROJ + PC_DX + 8 * cg; }
            w[q] = *(const v4u*)(F_PROJ + src); } }
#pragma unroll
        for (int q = 0; q < 4; ++q) { int t = base + q * GT; if (t < T_ALL) { size_t dst;
            if (t < T_P) { const int which = t >> 14, j = (t >> 5) & 511, cg = t & 31; dst = (which ? O_PV : O_PK) + (size_t)layer * 512 * 256 + j * 256 + 8 * cg; }
            else if (t < T_P + T_S) { t -= T_P; const int which = t >> 13, b = (t >> 9) & 15, j = (t >> 5) & 15, cg = t & 31; dst = (which ? O_SV : O_SK) + ((size_t)(layer * NSB + b) * 512 + 496 + j) * 256 + 8 * cg; }
            else { t -= T_P + T_S; const int b = t / 480, rr = (t / 32) % 15, cg = t & 31; dst = (b == 0 ? O_PPOOL + (size_t)layer * 3840 : O_SPOOL + (size_t)(layer * NSB + b - 1) * 3840) + rr * 256 + 8 * cg; }
            float v[8]; unpack8(w[q], v); *(f32x4*)(out + dst) = (f32x4){v[0], v[1], v[2], v[3]}; *(f32x4*)(out + dst + 4) = (f32x4){v[4], v[5], v[6], v[7]}; } }
    }
}
constexpr int KS_LD = 72, PS_LD = 584;
constexpr int AT_KS = 0, AT_VT = 576 * KS_LD * 2, AT_ST = AT_VT + 64 * PS_LD * 2, AT_BIAS = AT_ST + 1024;
static_assert(AT_BIAS + 4 * 260 * 4 <= MISC_OFF, "attention LDS map");
__device__ __forceinline__ void attn_bias_load(Frame& F, int layer) { const float* arel = inp(I_AREL) + (size_t)layer * 257 * 4; lf32* b = (lf32*)(F.lds + AT_BIAS); ITEM_IDS(); for (int i = tid_; i < 257 * 4; i += NTHR) b[260 * (i & 3) + (i >> 2)] = arel[i]; }
__device__ __forceinline__ void attn_item(Frame& F, int layer, int ci, int h) {
    ITEM_IDS();
    const Chunk c = chunk_of(ci);
    LAS bf16* Ks = (LAS bf16*)(F.lds + AT_KS); LAS bf16* Ps = Ks; LAS bf16* Vt = (LAS bf16*)(F.lds + AT_VT);
    lf32* mx = (lf32*)(F.lds + AT_ST); lf32* sm = mx + 128; lf32* bias = (lf32*)(F.lds + AT_BIAS) + 260 * h;
    const int jlo = (c.b < 0) ? (ci < 8 ? 64 * (8 - ci) : 0) : 0;
    const int jval = (c.b < 0) ? 576 : 528;
    const float* ckp = inp(I_CK); const float* cvp = inp(I_CV);
    bf16x8 qa0 = {0, 0, 0, 0, 0, 0, 0, 0}, qa1 = qa0;
    if (c.b < 0 || (wave_ >> 1) == 0) { const bf16* qp = F_PROJ + (size_t)(c.row0 + (wave_ >> 1) * 16 + (lane_ & 15)) * NPROJ + PC_Q + 64 * h + 8 * (lane_ >> 4); qa0 = *(const bf16x8*)qp; qa1 = *(const bf16x8*)(qp + 32); }
    if (c.b < 0) {
        const bf16* kg = F_PROJ + (long)(c.row0 - 512) * NPROJ + PC_K + 64 * h;
        const bf16* vg = F_VTA + (long)(64 * h) * M + (long)(c.row0 - 512);
        const int npc = (576 - jlo) >> 3, nk = (576 - jlo) * 8, nv = 64 * npc;
        v4u kr[9], vr[9];
#pragma unroll
        for (int q = 0; q < 9; ++q) { const int it = tid_ + q * NTHR;
            if (it < nk) kr[q] = *(const v4u*)(kg + (long)(jlo + (it >> 3)) * NPROJ + 8 * (it & 7));
            if (it < nv) { const int d = it / npc, pc = it - d * npc; vr[q] = *(const v4u*)(vg + (long)d * M + jlo + 8 * pc); } }
#pragma unroll
        for (int q = 0; q < 9; ++q) { const int it = tid_ + q * NTHR;
            if (it < nk) *(LAS v4u*)(Ks + (jlo + (it >> 3)) * KS_LD + 8 * (it & 7)) = kr[q];
            if (it < nv) { const int d = it / npc, pc = it - d * npc; *(LAS v4u*)(Vt + d * PS_LD + jlo + 8 * pc) = vr[q]; } }
    } else {
    for (int it = tid_; it < (576 - jlo) * 8; it += NTHR) {
        const int j = jlo + (it >> 3), dg = it & 7;
        v4u kw, vw;
        if (j < 512) { const size_t o = (((size_t)(layer * NSB + c.b) * 512 + j) * 4 + h) * 64 + 8 * dg; const float* kp = ckp + o; const float* vp = cvp + o;
            const f32x4 k0 = *(const f32x4*)kp, k1 = *(const f32x4*)(kp + 4), v0 = *(const f32x4*)vp, v1 = *(const f32x4*)(vp + 4);
            kw.x = pk2(k0.x, k0.y); kw.y = pk2(k0.z, k0.w); kw.z = pk2(k1.x, k1.y); kw.w = pk2(k1.z, k1.w); vw.x = pk2(v0.x, v0.y); vw.y = pk2(v0.z, v0.w); vw.z = pk2(v1.x, v1.y); vw.w = pk2(v1.z, v1.w); }
        else if (j < 528) { const size_t row = (size_t)(c.row0 + j - 512); kw = *(const v4u*)(F_PROJ + row * NPROJ + PC_K + 64 * h + 8 * dg); vw = *(const v4u*)(F_PROJ + row * NPROJ + PC_V + 64 * h + 8 * dg); }
        else { kw = (v4u){0u, 0u, 0u, 0u}; vw = kw; }
        *(LAS v4u*)(Ks + j * KS_LD + 8 * dg) = kw;
        LAS bf16* vt = Vt + (8 * dg) * PS_LD + j;
        vt[0 * PS_LD] = (bf16)(vw.x & 0xffffu); vt[1 * PS_LD] = (bf16)(vw.x >> 16); vt[2 * PS_LD] = (bf16)(vw.y & 0xffffu); vt[3 * PS_LD] = (bf16)(vw.y >> 16);
        vt[4 * PS_LD] = (bf16)(vw.z & 0xffffu); vt[5 * PS_LD] = (bf16)(vw.z >> 16); vt[6 * PS_LD] = (bf16)(vw.w & 0xffffu); vt[7 * PS_LD] = (bf16)(vw.w >> 16);
    }
    }
    __syncthreads();
    const int qb = wave_ >> 1, kh = wave_ & 1, kq = lane_ >> 4, fr = lane_ & 15;
    const bool active = (c.b < 0) || (qb == 0);
    const int ntw = (576 - jlo) / 32;
    const int kbase = jlo + kh * ntw * 16;
    f32x4 s[18];
    float mloc = -3.0e38f;
    const int iq = qb * 16 + fr;
    if (active) {
#pragma unroll
        for (int t = 0; t < 18; ++t) {
            s[t] = (f32x4){0.f, 0.f, 0.f, 0.f};
            if (t < ntw) {
                const LAS bf16* kp = Ks + (kbase + t * 16 + fr) * KS_LD + 8 * kq;
                const bf16x8 kb0 = *(const LAS bf16x8*)kp, kb1 = *(const LAS bf16x8*)(kp + 32);
                s[t] = __builtin_amdgcn_mfma_f32_16x16x32_bf16(kb0, qa0, s[t], 0, 0, 0);
                s[t] = __builtin_amdgcn_mfma_f32_16x16x32_bf16(kb1, qa1, s[t], 0, 0, 0);
#pragma unroll
                for (int r = 0; r < 4; ++r) { const int j = kbase + t * 16 + 4 * kq + r; int rel = 512 + iq - j; rel = rel > 128 ? 128 : rel; float v = s[t][r] + bias[rel + 128]; if (j >= jval) v = -1.0e30f; s[t][r] = v; mloc = fmaxf(mloc, v); }
            }
        }
        mloc = fmaxf(mloc, shx(lane_, mloc, 16)); mloc = fmaxf(mloc, shx(lane_, mloc, 32));
        if (kq == 0) mx[iq * 2 + kh] = mloc;
    }
    __syncthreads();
    if (active) {
        mloc = fmaxf(mx[iq * 2], mx[iq * 2 + 1]);
        float lsum = 0.f;
#pragma unroll
        for (int t = 0; t < 18; ++t) if (t < ntw) {
            const float p0 = __expf(s[t][0] - mloc), p1 = __expf(s[t][1] - mloc), p2 = __expf(s[t][2] - mloc), p3 = __expf(s[t][3] - mloc);
            lsum += (p0 + p1) + (p2 + p3);
            *(LAS f32x2*)(Ps + iq * PS_LD + kbase + t * 16 + 4 * kq) = __builtin_bit_cast(f32x2, (unsigned long long)pk2(p0, p1) | ((unsigned long long)pk2(p2, p3) << 32));
        }
        lsum += shx(lane_, lsum, 16); lsum += shx(lane_, lsum, 32);
        if (kq == 0) sm[iq * 2 + kh] = lsum;
    }
    __syncthreads();
    if (active) {
        f32x4 o[2] = {(f32x4){0.f, 0.f, 0.f, 0.f}, (f32x4){0.f, 0.f, 0.f, 0.f}};
        const int nks = (576 - jlo) / 32;
#pragma unroll 2
        for (int ks = 0; ks < nks; ++ks) {
            const int j0 = jlo + 32 * ks + 8 * kq;
            const bf16x8 pa = *(const LAS bf16x8*)(Ps + iq * PS_LD + j0);
#pragma unroll
            for (int t = 0; t < 2; ++t) { const bf16x8 vb = *(const LAS bf16x8*)(Vt + (kh * 32 + t * 16 + fr) * PS_LD + j0); o[t] = __builtin_amdgcn_mfma_f32_16x16x32_bf16(vb, pa, o[t], 0, 0, 0); }
        }
        const float inv = rcp_f(sm[iq * 2] + sm[iq * 2 + 1]);
#pragma unroll
        for (int t = 0; t < 2; ++t) *(f32x2*)(F_XN + (size_t)(c.row0 + iq) * D + 64 * h + kh * 32 + t * 16 + 4 * kq) =
            __builtin_bit_cast(f32x2, (unsigned long long)pk2(o[t][0] * inv, o[t][1] * inv) | ((unsigned long long)pk2(o[t][2] * inv, o[t][3] * inv) << 32));
    }
    __syncthreads();
}
__device__ __forceinline__ void scan_phase(Frame& F, int layer) {
    ITEM_IDS();
    constexpr int NSCAN = 192;
    if (((int)blockIdx.x) < NSCAN) {
        const int part = ((int)blockIdx.x) >> 2, seg = ((int)blockIdx.x) & 3, c0 = seg * 64;
        lf32* dl = (lf32*)F.lds;
        const bool ssd = part < 32;
        unsigned* ub; unsigned cstride; int hk = 0;
        f32x4 dq0 = {0.f, 0.f, 0.f, 0.f}, dq1 = dq0; float dq = 0.f;
        if (ssd) { cstride = 512u; ub = (unsigned*)F_STB + (size_t)part * (NCHP * 512) + (size_t)c0 * 512; if (tid_ < 64) dq = F_DECB[(c0 + tid_) * 4 + (part >> 3)]; }
        else { const int u2 = (part - 32) * NTHR + tid_; cstride = 512u; ub = (unsigned*)F_STC + (size_t)(part - 32) * (NCHP * 512) + (size_t)c0 * 512; hk = (u2 >> 11) * 64 + 2 * (u2 & 31);
               const float* dg = F_DECC + (size_t)c0 * 256 + ((part - 32) >> 2) * 64; dq0 = *(const f32x4*)(dg + (size_t)(tid_ >> 4) * 256 + 4 * (tid_ & 15)); dq1 = *(const f32x4*)(dg + (size_t)(32 + (tid_ >> 4)) * 256 + 4 * (tid_ & 15)); }
        const __amdgpu_buffer_rsrc_t srd = __builtin_amdgcn_make_buffer_rsrc(ub, (short)0, 64 * (int)cstride * 4, 0x00020000);
#if defined(TPROBE) && TPROBE >= 20
        unsigned tq0 = 0, tq1 = 0, tq2 = 0, tq3 = 0, tq4 = 0; tq0 = (unsigned)__builtin_amdgcn_s_memrealtime();
#define SUBSTAMP(v) do { asm volatile("s_waitcnt vmcnt(0)" ::: "memory"); v = (unsigned)__builtin_amdgcn_s_memrealtime(); } while (0)
#else
#define SUBSTAMP(v) do { } while (0)
#endif
        unsigned sl[64];
#pragma unroll
        for (int i = 0; i < 64; ++i) sl[i] = __builtin_amdgcn_raw_buffer_load_b32(srd, tid_ * 4, i * (int)cstride * 4, 0);
        if (ssd) { if (tid_ < 64) *(LAS f32x2*)(dl + tid_ * 64) = (f32x2){dq, dq}; }
        else { *(LAS f32x4*)(dl + (tid_ >> 4) * 64 + 4 * (tid_ & 15)) = dq0; *(LAS f32x4*)(dl + (32 + (tid_ >> 4)) * 64 + 4 * (tid_ & 15)) = dq1; }
        SUBSTAMP(tq1);
        __syncthreads();
        const lf32* dp = dl + (ssd ? 0 : 2 * (tid_ & 31));
        float r0 = 0.f, r1 = 0.f;
        gu32* flg = (gu32*)((unsigned*)(F.ws + WS_CTL) + CW_SCAN) + ((layer * 48 + part) * 3) * 16;
        gu64* car = (gu64*)(F.ws + WS_CAR) + 2 * (size_t)(part * NTHR + tid_);
        if (seg < 3) {
            float e0 = 0.f, e1 = 0.f, p0 = 1.f, p1 = 1.f;
#pragma unroll
            for (int i = 0; i < 64; ++i) { const f32x2 dd = *(const LAS f32x2*)(dp + i * 64); e0 = dd.x * e0 + bf_lo(sl[i]); e1 = dd.y * e1 + bf_hi(sl[i]); p0 *= dd.x; p1 *= dd.y; }
            gu64* cs = car + (size_t)seg * 2 * 24576;
            __hip_atomic_store(cs, (unsigned long long)__builtin_bit_cast(unsigned, e0) | ((unsigned long long)__builtin_bit_cast(unsigned, e1) << 32), __ATOMIC_RELAXED, __HIP_MEMORY_SCOPE_AGENT);
            __hip_atomic_store(cs + 1, (unsigned long long)__builtin_bit_cast(unsigned, p0) | ((unsigned long long)__builtin_bit_cast(unsigned, p1) << 32), __ATOMIC_RELAXED, __HIP_MEMORY_SCOPE_AGENT);
            asm volatile("s_waitcnt vmcnt(0)" ::: "memory");
            __syncthreads();
            if (tid_ == 0) __hip_atomic_store(flg + seg * 16, 1u, __ATOMIC_RELAXED, __HIP_MEMORY_SCOPE_AGENT);
        }
        SUBSTAMP(tq2);
        if (seg > 0) {
            if (tid_ == 0) { for (int j = 0; j < seg; ++j) { unsigned sp = 0; while (__hip_atomic_load(flg + j * 16, __ATOMIC_RELAXED, __HIP_MEMORY_SCOPE_AGENT) == 0u) { __builtin_amdgcn_s_sleep(1); if (++sp > (1u << 22)) break; } }
                __builtin_amdgcn_fence(__ATOMIC_ACQUIRE, "agent");
                asm volatile("s_waitcnt vmcnt(0)" ::: "memory"); }
            __syncthreads();
            unsigned long long ce[3], cd[3];
#pragma unroll
            for (int j = 0; j < 3; ++j) if (j < seg) { ce[j] = __hip_atomic_load(car + (size_t)j * 2 * 24576, __ATOMIC_RELAXED, __HIP_MEMORY_SCOPE_AGENT); cd[j] = __hip_atomic_load(car + (size_t)j * 2 * 24576 + 1, __ATOMIC_RELAXED, __HIP_MEMORY_SCOPE_AGENT); }
#pragma unroll
            for (int j = 0; j < 3; ++j) if (j < seg) { r0 = __builtin_bit_cast(float, (unsigned)cd[j]) * r0 + __builtin_bit_cast(float, (unsigned)ce[j]); r1 = __builtin_bit_cast(float, (unsigned)(cd[j] >> 32)) * r1 + __builtin_bit_cast(float, (unsigned)(ce[j] >> 32)); }
        }
        SUBSTAMP(tq3);
#pragma unroll
        for (int i = 0; i < 64; ++i) { const f32x2 dd = *(const LAS f32x2*)(dp + i * 64); __builtin_amdgcn_raw_buffer_store_b32(pk2(r0, r1), srd, tid_ * 4, i * (int)cstride * 4, 0); r0 = dd.x * r0 + bf_lo(sl[i]); r1 = dd.y * r1 + bf_hi(sl[i]); }
        SUBSTAMP(tq4);
#if defined(TPROBE) && TPROBE >= 20
        if (layer == 1 && tid_ == 0) { gu32* pw = (gu32*)((unsigned*)(F.ws + WS_CTL) + CW_SCAN - 64); __hip_atomic_fetch_max(pw, tq1 - tq0, __ATOMIC_RELAXED, __HIP_MEMORY_SCOPE_AGENT); __hip_atomic_fetch_max(pw + 1, tq2 - tq0, __ATOMIC_RELAXED, __HIP_MEMORY_SCOPE_AGENT);
            __hip_atomic_fetch_max(pw + 4, tq0, __ATOMIC_RELAXED, __HIP_MEMORY_SCOPE_AGENT); __hip_atomic_fetch_max(pw + 5, 0xFFFFFFFFu - tq0, __ATOMIC_RELAXED, __HIP_MEMORY_SCOPE_AGENT); __hip_atomic_fetch_max(pw + 6, tq4, __ATOMIC_RELAXED, __HIP_MEMORY_SCOPE_AGENT);
            __hip_atomic_fetch_max(pw + 2, tq3 - tq0, __ATOMIC_RELAXED, __HIP_MEMORY_SCOPE_AGENT); __hip_atomic_fetch_max(pw + 3, tq4 - tq0, __ATOMIC_RELAXED, __HIP_MEMORY_SCOPE_AGENT); }
#endif
        if (seg == 3) {
            if (ssd) *(f32x2*)(F.out + O_PSSM + (size_t)layer * 32768 + 2 * (part * NTHR + tid_)) = (f32x2){r0, r1};
            else { const int u2 = (part - 32) * NTHR + tid_; const int v = (u2 >> 5) & 63; float* o = F.out + O_PHGRN + (size_t)layer * 16384 + (size_t)hk * 64 + v; o[0] = r0; o[64] = r1; }
        }
    }
}
__device__ __forceinline__ void state_misc(Frame& F, int layer, int b0, int nb) {
    ITEM_IDS();
    {
        copy_small(F, layer, b0, nb);
        const float* sssm = inp(I_SSSM) + (size_t)layer * NSB * 32768; const float* shgrn = inp(I_SHGRN) + (size_t)layer * NSB * 16384;
        float* osb = F.out + O_SSSM + (size_t)layer * NSB * 32768; float* osc = F.out + O_SHGRN + (size_t)layer * NSB * 16384;
        const int GT = nb * NTHR;
        for (int base = b0 * NTHR + tid_; base < NSB * 8192; base += 4 * GT) {
            f32x4 s0[4]; unsigned long long w[4]; float d[4];
#pragma unroll
            for (int q = 0; q < 4; ++q) { const int t = base + q * GT; if (t < NSB * 8192) { const int b = t >> 13, e = (t & 8191) * 4; s0[q] = *(const f32x4*)(sssm + (size_t)b * 32768 + e); w[q] = *(const unsigned long long*)(F_STB + (size_t)(NCHP + b) * 32768 + e); d[q] = F_DECB[(NCHP + b) * 4 + (e >> 13)]; } }
#pragma unroll
            for (int q = 0; q < 4; ++q) { const int t = base + q * GT; if (t < NSB * 8192) { const int b = t >> 13, e = (t & 8191) * 4;
                *(f32x4*)(osb + (size_t)b * 32768 + e) = (f32x4){d[q] * s0[q].x + bf_lo((unsigned)w[q]), d[q] * s0[q].y + bf_hi((unsigned)w[q]), d[q] * s0[q].z + bf_lo((unsigned)(w[q] >> 32)), d[q] * s0[q].w + bf_hi((unsigned)(w[q] >> 32))}; } }
        }
        for (int base = b0 * NTHR + tid_; base < NSB * 4096; base += 2 * GT) {
            f32x4 s0[2]; bf16 sp4[2][4]; float d[2];
#pragma unroll
            for (int q = 0; q < 2; ++q) { const int t = base + q * GT; if (t < NSB * 4096) { const int b = t >> 12, e2 = (t & 4095) * 4, hk = e2 >> 6, v = e2 & 63; s0[q] = *(const f32x4*)(shgrn + (size_t)b * 16384 + e2);
                const bf16* sp = F_STC + (size_t)(NCHP + b) * 16384 + (size_t)((hk >> 6) * 64 + v) * 64 + (hk & 63); sp4[q][0] = sp[0]; sp4[q][1] = sp[64]; sp4[q][2] = sp[128]; sp4[q][3] = sp[192]; d[q] = F_DECC[(size_t)(NCHP + b) * 256 + hk]; } }
#pragma unroll
            for (int q = 0; q < 2; ++q) { const int t = base + q * GT; if (t < NSB * 4096) { const int b = t >> 12, e2 = (t & 4095) * 4;
                *(f32x4*)(osc + (size_t)b * 16384 + e2) = (f32x4){d[q] * s0[q].x + bf1(sp4[q][0]), d[q] * s0[q].y + bf1(sp4[q][1]), d[q] * s0[q].z + bf1(sp4[q][2]), d[q] * s0[q].w + bf1(sp4[q][3])}; } }
        }
    }
}
constexpr int SP_XT = 0, SP_BT = 256 * 72 * 2, SP_ACS = 2 * 256 * 72 * 2, SP_DTV = SP_ACS + 1024, SP_SJ = SP_DTV + 1024, SP_END = SP_SJ + 1024;
static_assert(SP_END <= MISC_OFF, "ssd_prep LDS map");
__device__ __forceinline__ void ssd_prep_item(Frame& F, int layer, int ci) {
    ITEM_IDS();
    const Chunk c = chunk_of(ci);
    LAS bf16* XTl = (LAS bf16*)(F.lds + SP_XT); LAS bf16* BTl = (LAS bf16*)(F.lds + SP_BT);
    lf32* acs = (lf32*)(F.lds + SP_ACS); lf32* dtv = (lf32*)(F.lds + SP_DTV); lf32* sj = (lf32*)(F.lds + SP_SJ);
    const int cg = tid_ % 96, seg = tid_ / 96, col = 8 * cg;
    const bool act = seg < 4 && 16 * seg < c.nrows;
    bf16* prow = F_PROJ + (size_t)c.row0 * NPROJ + PC_X + col;
    v4u raw[19];
    if (act) {
#pragma unroll
        for (int q = 0; q < 19; ++q) { const int r = 16 * seg - 3 + q;
            if (r >= 0) raw[q] = *(const v4u*)(prow + (size_t)r * NPROJ);
            else if (c.b < 0) { if (ci > 0) raw[q] = *(const v4u*)(F_HALO + ((size_t)(ci - 1) * 3 + (3 + r)) * 768 + col); else raw[q] = (v4u){0u, 0u, 0u, 0u}; }
            else { const float* s = inp(I_SCONV) + ((size_t)(layer * NSB + c.b) * 3 + (3 + r)) * 768 + col; const f32x4 a = *(const f32x4*)s, b2 = *(const f32x4*)(s + 4);
                raw[q].x = pk2(a.x, a.y); raw[q].y = pk2(a.z, a.w); raw[q].z = pk2(b2.x, b2.y); raw[q].w = pk2(b2.z, b2.w); } }
    }
    if (wave_ == 6) { const int r = lane_; const float* dtb = inp(I_DTB) + layer * 4; const float* alg = inp(I_ALOG) + layer * 4;
        f32x4 raw4 = {0.f, 0.f, 0.f, 0.f}; if (r < c.nrows) raw4 = *(const f32x4*)(F_DT + (size_t)(c.row0 + r) * 4);
        f32x4 dt4, ac4;
#pragma unroll
        for (int h = 0; h < 4; ++h) { float dt = 0.f; if (r < c.nrows) dt = softplus_f(raw4[h] + dtb[h]); float v = -__expf(alg[h]) * dt;
#pragma unroll
            for (int o = 1; o < 64; o <<= 1) { const float t = shu(lane_, v, o); if (lane_ >= o) v += t; }
            const float last = shi(v, 63);
            dt4[h] = dt; ac4[h] = v; acs[r * 4 + h] = v; dtv[r * 4 + h] = dt; sj[h * 64 + r] = dt * __expf(last - v);
            if (r == 63) F_DECB[ci * 4 + h] = __expf(last); }
        if (r < c.nrows) { *(f32x4*)(F_DTV + (size_t)(c.row0 + r) * 4) = dt4; *(f32x4*)(F_ACS + (size_t)(c.row0 + r) * 4) = ac4; } }
    if (c.nrows < 64) { for (int i = tid_; i < 2 * 256 * 72 / 2; i += NTHR) ((LAS unsigned*)XTl)[i] = 0u; }
    asm volatile("s_waitcnt vmcnt(0)" ::: "memory");
    __syncthreads();
    if (act) {
        if (ci == NCHP - 1 && seg == 3) {
#pragma unroll
            for (int q = 0; q < 3; ++q) { float v[8]; unpack8(raw[16 + q], v); float* o = F.out + O_PCONV + (size_t)layer * 2304 + q * 768 + col;
                *(f32x4*)o = (f32x4){v[0], v[1], v[2], v[3]}; *(f32x4*)(o + 4) = (f32x4){v[4], v[5], v[6], v[7]}; } }
        if (c.b >= 0) {
#pragma unroll
            for (int q = 0; q < 3; ++q) { float v[8]; unpack8(raw[16 + q], v); float* o = F.out + O_SCONV + ((size_t)(layer * NSB + c.b) * 3 + q) * 768 + col;
                *(f32x4*)o = (f32x4){v[0], v[1], v[2], v[3]}; *(f32x4*)(o + 4) = (f32x4){v[4], v[5], v[6], v[7]}; } }
        const float* cw = inp(I_CW) + (size_t)layer * 4 * 768 + col; const float* cb = inp(I_CB) + (size_t)layer * 768 + col;
        LAS bf16* tl = (cg < 32) ? XTl + col * 72 : BTl + (col - 256) * 72;
#pragma unroll
        for (int hc = 0; hc < 2; ++hc) {
            float w0[4], w1[4], w2[4], w3[4], bb[4];
#pragma unroll
            for (int e = 0; e < 4; ++e) { bb[e] = cb[4 * hc + e]; w0[e] = cw[4 * hc + e]; w1[e] = cw[768 + 4 * hc + e]; w2[e] = cw[2 * 768 + 4 * hc + e]; w3[e] = cw[3 * 768 + 4 * hc + e]; }
#pragma unroll
            for (int i = 0; i < 16; i += 2) {
                float x[5][4];
#pragma unroll
                for (int q = 0; q < 5; ++q) { const unsigned ua = hc ? raw[i + q].z : raw[i + q].x, ub = hc ? raw[i + q].w : raw[i + q].y; x[q][0] = bf_lo(ua); x[q][1] = bf_hi(ua); x[q][2] = bf_lo(ub); x[q][3] = bf_hi(ub); }
                float ya[4], yb[4];
#pragma unroll
                for (int e = 0; e < 4; ++e) { ya[e] = silu_g(bb[e] + w0[e] * x[0][e] + w1[e] * x[1][e] + w2[e] * x[2][e] + w3[e] * x[3][e]); yb[e] = silu_g(bb[e] + w0[e] * x[1][e] + w1[e] * x[2][e] + w2[e] * x[3][e] + w3[e] * x[4][e]); }
                const int r = 16 * seg + i;
                *(unsigned long long*)(prow + (size_t)r * NPROJ + 4 * hc) = (unsigned long long)pk2(ya[0], ya[1]) | ((unsigned long long)pk2(ya[2], ya[3]) << 32);
                *(unsigned long long*)(prow + (size_t)(r + 1) * NPROJ + 4 * hc) = (unsigned long long)pk2(yb[0], yb[1]) | ((unsigned long long)pk2(yb[2], yb[3]) << 32);
                if (cg < 64) {
#pragma unroll
                    for (int e = 0; e < 4; ++e) *(LAS unsigned*)(tl + (4 * hc + e) * 72 + r) = pk2(ya[e], yb[e]); }
            }
        }
    }
    __syncthreads();
    { const int ch = tid_ >> 1, hf = tid_ & 1; bf16* dst = F_XT + ((size_t)ci * 256 + ch) * 64 + 32 * hf; const LAS bf16* src = XTl + ch * 72 + 32 * hf;
#pragma unroll
      for (int q = 0; q < 4; ++q) *(v4u*)(dst + 8 * q) = *(const LAS v4u*)(src + 8 * q); }
    const int kq = lane_ >> 4, fr = lane_ & 15, h = wave_ >> 1, g = h >> 1;
#pragma unroll
    for (int pi = 0; pi < 2; ++pi) {
        const int pb = 2 * (wave_ & 1) + pi;
        bf16x8 af[2];
#pragma unroll
        for (int ks = 0; ks < 2; ++ks) { float v[8]; unpack8(*(const LAS v4u*)(XTl + (h * 64 + pb * 16 + fr) * 72 + 32 * ks + 8 * kq), v);
#pragma unroll
            for (int e = 0; e < 8; ++e) v[e] *= sj[h * 64 + 32 * ks + 8 * kq + e];
            af[ks] = __builtin_bit_cast(bf16x8, pack8(v)); }
        bf16* dst = ci < NCHP ? F_STB + (size_t)(h * 8 + pb * 2 + (kq >> 1)) * (NCHP * 1024) + (size_t)ci * 1024 + 4 * (kq & 1) * 128 + fr
                              : F_STB + ((size_t)(ci * 4 + h) * 64 + pb * 16 + 4 * kq) * 128 + fr;
#pragma unroll
        for (int nt = 0; nt < 8; ++nt) {
            f32x4 acc = {0.f, 0.f, 0.f, 0.f};
#pragma unroll
            for (int ks = 0; ks < 2; ++ks) { const bf16x8 bfr = *(const LAS bf16x8*)(BTl + (g * 128 + nt * 16 + fr) * 72 + 32 * ks + 8 * kq); acc = __builtin_amdgcn_mfma_f32_16x16x32_bf16(af[ks], bfr, acc, 0, 0, 0); }
#pragma unroll
            for (int r = 0; r < 4; ++r) dst[r * 128 + nt * 16] = (bf16)f2bf(acc[r]);
        }
    }
    __syncthreads();
}

__device__ __forceinline__ void ssd_out_witem(Frame& F, int layer, int ci, int ib, int wave_, int lane_) {
    const Chunk c = chunk_of(ci);
    const int kq = lane_ >> 4, fr = lane_ & 15;
    constexpr int WSTRIDE = 2560 + 16384; static_assert(8 * WSTRIDE <= MISC_OFF, "per-wave LDS");
    LAS bf16* scr = (LAS bf16*)(F.lds + wave_ * WSTRIDE);
    lf32* ysc = (lf32*)(F.lds + wave_ * WSTRIDE + 2560) + lane_;
    const bf16* P = F_PROJ + (size_t)c.row0 * NPROJ;
    const float* acsg = F_ACS + (size_t)c.row0 * 4; const float* dtg = F_DTV + (size_t)c.row0 * 4;
    const int nks = (ib + 2) >> 1;
    float sq[4] = {0.f, 0.f, 0.f, 0.f};
    const float* bdp = inp(I_BD) + layer * 4;
#pragma unroll
    for (int g = 0; g < 2; ++g) {
        bf16x8 cf[4];
#pragma unroll
        for (int ks = 0; ks < 4; ++ks) cf[ks] = *(const bf16x8*)(P + (size_t)(16 * ib + fr) * NPROJ + PC_C + 128 * g + 32 * ks + 8 * kq);
        f32x4 G[4];
#pragma unroll
        for (int jb = 0; jb < 4; ++jb) { G[jb] = (f32x4){0.f, 0.f, 0.f, 0.f};
            if (jb <= ib) {
#pragma unroll
                for (int ks = 0; ks < 4; ++ks) { const bf16x8 bfr = *(const bf16x8*)(P + (size_t)(16 * jb + fr) * NPROJ + PC_B + 128 * g + 32 * ks + 8 * kq); G[jb] = __builtin_amdgcn_mfma_f32_16x16x32_bf16(cf[ks], bfr, G[jb], 0, 0, 0); } } }
#pragma unroll
        for (int hh = 0; hh < 2; ++hh) {
            const int h = 2 * g + hh;
            float ai[4], ea[4];
#pragma unroll
            for (int r = 0; r < 4; ++r) { ai[r] = acsg[(16 * ib + 4 * kq + r) * 4 + h]; ea[r] = __expf(ai[r]); }
#pragma unroll
            for (int jb = 0; jb < 4; ++jb) { const int j = 16 * jb + fr; float aj = 0.f, dj = 0.f; if (jb <= ib) { aj = acsg[j * 4 + h]; dj = dtg[j * 4 + h]; }
#pragma unroll
                for (int r = 0; r < 4; ++r) { const int i = 16 * ib + 4 * kq + r; const float v = (jb <= ib && j <= i) ? G[jb][r] * __expf(ai[r] - aj) * dj : 0.f; scr[(4 * kq + r) * 72 + j] = (bf16)f2bf(v); } }
            asm volatile("s_waitcnt lgkmcnt(0)" ::: "memory");
            bf16x8 gm[2];
#pragma unroll
            for (int ks = 0; ks < 2; ++ks) gm[ks] = *(const LAS bf16x8*)(scr + fr * 72 + 32 * ks + 8 * kq);
            asm volatile("s_waitcnt lgkmcnt(0)" ::: "memory");
            const bf16* xt = F_XT + ((size_t)ci * 256 + h * 64) * 64;
            const bf16* sin_b = F_STB + (size_t)(ci * 4 + h) * 8192; const float* sin_f = inp(I_SSSM) + (size_t)((layer * NSB + (c.b < 0 ? 0 : c.b)) * 4 + h) * 8192;
#pragma unroll 2
            for (int pt = 0; pt < 4; ++pt) {
                f32x4 a1 = {0.f, 0.f, 0.f, 0.f}, a2 = {0.f, 0.f, 0.f, 0.f};
#pragma unroll
                for (int ks = 0; ks < 2; ++ks) if (ks < nks) { const bf16x8 bfr = *(const bf16x8*)(xt + (size_t)(pt * 16 + fr) * 64 + 32 * ks + 8 * kq); a1 = __builtin_amdgcn_mfma_f32_16x16x32_bf16(gm[ks], bfr, a1, 0, 0, 0); }
#pragma unroll
                for (int ks = 0; ks < 4; ++ks) { bf16x8 bfr;
                    if (c.b < 0) bfr = *(const bf16x8*)(sin_b + (size_t)(pt * 16 + fr) * 128 + 32 * ks + 8 * kq);
                    else { const float* s = sin_f + (size_t)(pt * 16 + fr) * 128 + 32 * ks + 8 * kq; const f32x4 u0 = *(const f32x4*)s, u1 = *(const f32x4*)(s + 4); v4u w; w.x = pk2(u0.x, u0.y); w.y = pk2(u0.z, u0.w); w.z = pk2(u1.x, u1.y); w.w = pk2(u1.z, u1.w); bfr = __builtin_bit_cast(bf16x8, w); }
                    a2 = __builtin_amdgcn_mfma_f32_16x16x32_bf16(cf[ks], bfr, a2, 0, 0, 0); }
                const float dh = bdp[h];
#pragma unroll
                for (int r = 0; r < 4; ++r) { const size_t ro = (size_t)(16 * ib + 4 * kq + r) * NPROJ; const int p = h * 64 + pt * 16 + fr;
                    float y = a1[r] + ea[r] * a2[r] + dh * bf1(P[ro + PC_X + p]);
                    y *= silu_g(bf1(P[ro + PC_Z + p])); ysc[((h * 4 + pt) * 4 + r) * 64] = y; sq[r] += y * y; }
            }
        }
    }
    const float* nw = inp(I_BNRM) + (size_t)layer * 256;
#pragma unroll
    for (int r = 0; r < 4; ++r) { const float rstd = rsq_f(sum16_l(lane_, sq[r]) * (1.0f / 256.0f) + EPS); bf16* o = F_XN + (size_t)(c.row0 + 16 * ib + 4 * kq + r) * D + 256 + fr;
#pragma unroll 4
        for (int q = 0; q < 16; ++q) o[q * 16] = (bf16)f2bf(ysc[(q * 4 + r) * 64] * rstd * nw[q * 16 + fr]); }
}

constexpr int SO_SIN = 0, SO_XT = 4 * 64 * 136 * 2, SO_ACS = SO_XT + 256 * 72 * 2, SO_DTV = SO_ACS + 1024, SO_SS = SO_DTV + 1024, SO_SCR = SO_SS + 512, SO_END = SO_SCR + 8 * 2560;
static_assert(SO_END <= MISC_OFF, "ssd_out_block LDS map");
__device__ __forceinline__ void ssd_out_block(Frame& F, int layer, int ci) {
    ITEM_IDS();
    const int row0 = 64 * ci;
    LAS bf16* SIN = (LAS bf16*)(F.lds + SO_SIN); LAS bf16* XTl = (LAS bf16*)(F.lds + SO_XT);
    lf32* acs = (lf32*)(F.lds + SO_ACS); lf32* dtv = (lf32*)(F.lds + SO_DTV); lf32* ss = (lf32*)(F.lds + SO_SS);
    LAS bf16* scr = (LAS bf16*)(F.lds + SO_SCR + wave_ * 2560);
    const int kq = lane_ >> 4, fr = lane_ & 15, ib = wave_ >> 1, g = wave_ & 1;
    const bf16* P = F_PROJ + (size_t)row0 * NPROJ;
    v4u st[12];
    { const bf16* sg = F_STB + (size_t)ci * 1024; const bf16* xg = F_XT + (size_t)ci * 16384;
#pragma unroll
      for (int q = 0; q < 8; ++q) st[q] = *(const v4u*)(sg + (size_t)(4 * q + (tid_ >> 7)) * (NCHP * 1024) + (tid_ & 127) * 8);
#pragma unroll
      for (int q = 0; q < 4; ++q) st[8 + q] = *(const v4u*)(xg + (size_t)(tid_ + q * NTHR) * 8); }
    float a4 = 0.f, d4 = 0.f; if (tid_ < 256) { a4 = F_ACS[(size_t)row0 * 4 + tid_]; d4 = F_DTV[(size_t)row0 * 4 + tid_]; }
    bf16x8 cf[4], bfr[4][4];
#pragma unroll
    for (int ks = 0; ks < 4; ++ks) cf[ks] = *(const bf16x8*)(P + (size_t)(16 * ib + fr) * NPROJ + PC_C + 128 * g + 32 * ks + 8 * kq);
#pragma unroll
    for (int jb = 0; jb < 4; ++jb)
#pragma unroll
        for (int ks = 0; ks < 4; ++ks) { bfr[jb][ks] = (bf16x8){0, 0, 0, 0, 0, 0, 0, 0}; if (jb <= ib) bfr[jb][ks] = *(const bf16x8*)(P + (size_t)(16 * jb + fr) * NPROJ + PC_B + 128 * g + 32 * ks + 8 * kq); }
#pragma unroll
    for (int q = 0; q < 8; ++q) { const int it = tid_ + q * NTHR; *(LAS v4u*)(SIN + (it >> 4) * 136 + 8 * (it & 15)) = st[q]; }
#pragma unroll
    for (int q = 0; q < 4; ++q) { const int it = tid_ + q * NTHR; *(LAS v4u*)(XTl + (it >> 3) * 72 + 8 * (it & 7)) = st[8 + q]; }
    if (tid_ < 256) { acs[tid_] = a4; dtv[tid_] = d4; }
    bf16 zv[2][4][4];
#pragma unroll
    for (int hh = 0; hh < 2; ++hh)
#pragma unroll
        for (int pt = 0; pt < 4; ++pt)
#pragma unroll
            for (int r = 0; r < 4; ++r) zv[hh][pt][r] = P[(size_t)(16 * ib + 4 * kq + r) * NPROJ + PC_Z + (2 * g + hh) * 64 + pt * 16 + fr];
    __syncthreads();
    f32x4 G[4];
#pragma unroll
    for (int jb = 0; jb < 4; ++jb) { G[jb] = (f32x4){0.f, 0.f, 0.f, 0.f};
        if (jb <= ib) {
#pragma unroll
            for (int ks = 0; ks < 4; ++ks) G[jb] = __builtin_amdgcn_mfma_f32_16x16x32_bf16(cf[ks], bfr[jb][ks], G[jb], 0, 0, 0); } }
    const int nks = (ib + 2) >> 1;
    const float* bdp = inp(I_BD) + layer * 4;
    f32x4 yv[2][4]; float sq[4] = {0.f, 0.f, 0.f, 0.f};
#pragma unroll
    for (int hh = 0; hh < 2; ++hh) {
        const int h = 2 * g + hh;
        float ai[4], ea[4];
#pragma unroll
        for (int r = 0; r < 4; ++r) { ai[r] = acs[(16 * ib + 4 * kq + r) * 4 + h]; ea[r] = __expf(ai[r]); }
#pragma unroll
        for (int jb = 0; jb < 4; ++jb) { const int j = 16 * jb + fr; const float aj = acs[j * 4 + h], dj = dtv[j * 4 + h];
#pragma unroll
            for (int r = 0; r < 4; ++r) { const int i = 16 * ib + 4 * kq + r; const float v = (jb <= ib && j <= i) ? G[jb][r] * __expf(ai[r] - aj) * dj : 0.f; scr[(4 * kq + r) * 72 + j] = (bf16)f2bf(v); } }
        asm volatile("s_waitcnt lgkmcnt(0)" ::: "memory");
        bf16x8 gm[2];
#pragma unroll
        for (int ks = 0; ks < 2; ++ks) gm[ks] = *(const LAS bf16x8*)(scr + fr * 72 + 32 * ks + 8 * kq);
        asm volatile("s_waitcnt lgkmcnt(0)" ::: "memory");
        const float dh = bdp[h];
#pragma unroll
        for (int pt = 0; pt < 4; ++pt) {
            f32x4 a1 = {0.f, 0.f, 0.f, 0.f}, a2 = {0.f, 0.f, 0.f, 0.f};
            const LAS bf16* xr = XTl + (h * 64 + pt * 16 + fr) * 72; const LAS bf16* sr = SIN + (h * 64 + pt * 16 + fr) * 136;
#pragma unroll
            for (int ks = 0; ks < 2; ++ks) if (ks < nks) a1 = __builtin_amdgcn_mfma_f32_16x16x32_bf16(gm[ks], *(const LAS bf16x8*)(xr + 32 * ks + 8 * kq), a1, 0, 0, 0);
#pragma unroll
            for (int ks = 0; ks < 4; ++ks) a2 = __builtin_amdgcn_mfma_f32_16x16x32_bf16(cf[ks], *(const LAS bf16x8*)(sr + 32 * ks + 8 * kq), a2, 0, 0, 0);
            const unsigned long long xw = *(const LAS unsigned long long*)(xr + 16 * ib + 4 * kq);
            const float xx[4] = {bf_lo((unsigned)xw), bf_hi((unsigned)xw), bf_lo((unsigned)(xw >> 32)), bf_hi((unsigned)(xw >> 32))};
#pragma unroll
            for (int r = 0; r < 4; ++r) { float y = a1[r] + ea[r] * a2[r] + dh * xx[r]; y *= silu_g(bf1(zv[hh][pt][r])); yv[hh][pt][r] = y; sq[r] += y * y; }
        }
    }
#pragma unroll
    for (int r = 0; r < 4; ++r) { const float q = sum16_l(lane_, sq[r]); if (fr == 0) ss[(16 * ib + 4 * kq + r) * 2 + g] = q; }
    __syncthreads();
    const float* nw = inp(I_BNRM) + (size_t)layer * 256 + 128 * g;
#pragma unroll
    for (int r = 0; r < 4; ++r) { const int i = 16 * ib + 4 * kq + r; const float rstd = rsq_f((ss[i * 2] + ss[i * 2 + 1]) * (1.0f / 256.0f) + EPS); bf16* o = F_XN + (size_t)(row0 + i) * D + 256 + 128 * g + fr;
#pragma unroll
        for (int hh = 0; hh < 2; ++hh)
#pragma unroll
            for (int pt = 0; pt < 4; ++pt) o[hh * 64 + pt * 16] = (bf16)f2bf(yv[hh][pt][r] * rstd * nw[hh * 64 + pt * 16 + fr]); }
    __syncthreads();
}
constexpr int HP_KT = 0, HP_VT = 256 * 72 * 2, HP_HT = 2 * 256 * 72 * 2, HP_END = HP_HT + 4 * 256 * 4;
static_assert(HP_END <= MISC_OFF, "hgrn_prep LDS map");
__device__ __forceinline__ void hgrn_prep_item(Frame& F, int layer, int ci) {
    ITEM_IDS();
    const Chunk c = chunk_of(ci);
    LAS bf16* KTl = (LAS bf16*)(F.lds + HP_KT); LAS bf16* VTl = (LAS bf16*)(F.lds + HP_VT);
    lf32* ht = (lf32*)(F.lds + HP_HT);
    const int cp = tid_ & 127, qt = tid_ >> 7;
    float lb0 = 0.f, lb1 = 0.f; if (layer != 0) { const float* lbp = inp(I_LB) + 2 * cp; lb0 = rcp_f(1.0f + __expf(lbp[0] - lbp[256])); lb1 = rcp_f(1.0f + __expf(lbp[1] - lbp[257])); }
    bf16* pq = F_PROJ + (size_t)(c.row0 + 16 * qt) * NPROJ + PC_CQ + 2 * cp;
    const bool act = 16 * qt < c.nrows;
    unsigned rq[16], rf[16], rv[16];
#pragma unroll
    for (int i = 0; i < 16; ++i) { rq[i] = 0u; rf[i] = 0u; rv[i] = 0u; if (act) { const unsigned* p = (const unsigned*)(pq + (size_t)i * NPROJ); rq[i] = p[0]; rf[i] = p[128]; rv[i] = p[256]; } }
    float b0[16], b1[16], k0[16], k1[16];
    float run0 = 0.f, run1 = 0.f;
#pragma unroll
    for (int i = 0; i < 16; ++i) { float g0 = 0.f, g1 = 0.f; k0[i] = 0.f; k1[i] = 0.f;
        if (act) { const float e0 = __expf(-bf_lo(rf[i])), e1 = __expf(-bf_hi(rf[i])); const float d0 = rcp_f(1.0f + e0), d1 = rcp_f(1.0f + e1);
            g0 = __logf(lb0 + (1.0f - lb0) * d0); g1 = __logf(lb1 + (1.0f - lb1) * d1); k0[i] = (1.0f - lb0) * e0 * d0; k1[i] = (1.0f - lb1) * e1 * d1; }
        run0 += g0; run1 += g1; b0[i] = run0; b1[i] = run1; }
    *(LAS f32x2*)(ht + qt * 256 + 2 * cp) = (f32x2){run0, run1};
    __syncthreads();
    float pre0 = 0.f, pre1 = 0.f, last0 = 0.f, last1 = 0.f;
#pragma unroll
    for (int q = 0; q < 4; ++q) { const f32x2 t = *(const LAS f32x2*)(ht + q * 256 + 2 * cp); if (q < qt) { pre0 += t.x; pre1 += t.y; } last0 += t.x; last1 += t.y; }
    { float* Rg = F_RH + (size_t)ci * 1280 + 2 * cp; *(f32x2*)(Rg + qt * 256) = (f32x2){pre0, pre1};
      if (qt == 3) { *(f32x2*)(Rg + 1024) = (f32x2){last0, last1}; *(f32x2*)(F_DECC + (size_t)ci * 256 + 2 * cp) = (f32x2){__expf(last0), __expf(last1)}; } }
    const float e0 = run0, e1 = run1;
#pragma unroll
    for (int i = 0; i < 16; i += 2) {
        unsigned kt0, kt1;
#pragma unroll
        for (int q = 0; q < 2; ++q) { const int ii = i + q;
            const float qe0 = bf_lo(rq[ii]) * __expf(b0[ii]), qe1 = bf_hi(rq[ii]) * __expf(b1[ii]);
            const float ke0 = k0[ii] * __expf(e0 - b0[ii]), ke1 = k1[ii] * __expf(e1 - b1[ii]);
            const float kd0 = k0[ii] * __expf(fminf(-b0[ii], 80.f)), kd1 = k1[ii] * __expf(fminf(-b1[ii], 80.f));
            if (act && 16 * qt + ii < c.nrows) { unsigned* p = (unsigned*)(pq + (size_t)ii * NPROJ); p[0] = pk2(qe0, qe1); p[128] = pk2(ke0, ke1); p[256] = pk2(kd0, kd1); }
            const float t0 = k0[ii] * __expf(last0 - pre0 - b0[ii]), t1 = k1[ii] * __expf(last1 - pre1 - b1[ii]);
            if (q == 0) { kt0 = f2bf(t0); kt1 = f2bf(t1); } else { kt0 |= f2bf(t0) << 16; kt1 |= f2bf(t1) << 16; } }
        const int j = 16 * qt + i;
        *(LAS unsigned*)(KTl + (2 * cp) * 72 + j) = kt0; *(LAS unsigned*)(KTl + (2 * cp + 1) * 72 + j) = kt1;
        *(LAS unsigned*)(VTl + (2 * cp) * 72 + j) = (rv[i] & 0xffffu) | (rv[i + 1] << 16); *(LAS unsigned*)(VTl + (2 * cp + 1) * 72 + j) = (rv[i] >> 16) | (rv[i + 1] & 0xffff0000u);
    }
    __syncthreads();
    { const int c2 = tid_ >> 1, hf = tid_ & 1; bf16* dst = F_VT + ((size_t)ci * 256 + c2) * 64 + 32 * hf; const LAS bf16* src = VTl + c2 * 72 + 32 * hf;
#pragma unroll
      for (int q = 0; q < 4; ++q) *(v4u*)(dst + 8 * q) = *(const LAS v4u*)(src + 8 * q); }
    const int kq = lane_ >> 4, fr = lane_ & 15, h = wave_ >> 1;
#pragma unroll
    for (int vi = 0; vi < 2; ++vi) {
        const int vb = 2 * (wave_ & 1) + vi;
        bf16x8 af[2];
#pragma unroll
        for (int ks = 0; ks < 2; ++ks) af[ks] = *(const LAS bf16x8*)(VTl + (h * 64 + vb * 16 + fr) * 72 + 32 * ks + 8 * kq);
        bf16* dst = ci < NCHP ? F_STC + (size_t)(h * 4 + vb) * (NCHP * 1024) + (size_t)ci * 1024 + 4 * kq * 64 + fr
                              : F_STC + ((size_t)(ci * 4 + h) * 64 + vb * 16 + 4 * kq) * 64 + fr;
#pragma unroll
        for (int kb = 0; kb < 4; ++kb) {
            f32x4 acc = {0.f, 0.f, 0.f, 0.f};
#pragma unroll
            for (int ks = 0; ks < 2; ++ks) { const bf16x8 bfr = *(const LAS bf16x8*)(KTl + (h * 64 + kb * 16 + fr) * 72 + 32 * ks + 8 * kq); acc = __builtin_amdgcn_mfma_f32_16x16x32_bf16(af[ks], bfr, acc, 0, 0, 0); }
#pragma unroll
            for (int r = 0; r < 4; ++r) dst[r * 64 + kb * 16] = (bf16)f2bf(acc[r]);
        }
    }
    __syncthreads();
}

__device__ __forceinline__ void hgrn_out_witem(Frame& F, int layer, int ci, int h, int ib, int wave_, int lane_) {
    const Chunk c = chunk_of(ci);
    const int kq = lane_ >> 4, fr = lane_ & 15;
    LAS bf16* scr = (LAS bf16*)(F.lds + wave_ * (2560 + 16384));
    const bf16* P = F_PROJ + (size_t)c.row0 * NPROJ + h * 64;
    const float* Rg = F_RH + (size_t)ci * 1280 + h * 64;
    bf16x8 qf[2]; float qv[2][8], rI[2][8];
#pragma unroll
    for (int ks = 0; ks < 2; ++ks) { qf[ks] = *(const bf16x8*)(P + (size_t)(16 * ib + fr) * NPROJ + PC_CQ + 32 * ks + 8 * kq); unpack8(__builtin_bit_cast(v4u, qf[ks]), qv[ks]);
        const float* rp = Rg + ib * 256 + 32 * ks + 8 * kq; const f32x4 a = *(const f32x4*)rp, b2 = *(const f32x4*)(rp + 4);
        rI[ks][0] = a.x; rI[ks][1] = a.y; rI[ks][2] = a.z; rI[ks][3] = a.w; rI[ks][4] = b2.x; rI[ks][5] = b2.y; rI[ks][6] = b2.z; rI[ks][7] = b2.w; }
#pragma unroll
    for (int J = 0; J < 4; ++J) {
        f32x4 acc = {0.f, 0.f, 0.f, 0.f};
        if (J <= ib) {
#pragma unroll
            for (int ks = 0; ks < 2; ++ks) {
                bf16x8 a = qf[ks];
                if (J < ib) { const float* rp = Rg + (J + 1) * 256 + 32 * ks + 8 * kq; const f32x4 u0 = *(const f32x4*)rp, u1 = *(const f32x4*)(rp + 4); const float rj[8] = {u0.x, u0.y, u0.z, u0.w, u1.x, u1.y, u1.z, u1.w};
                    float v[8];
#pragma unroll
                    for (int e = 0; e < 8; ++e) v[e] = qv[ks][e] * __expf(rI[ks][e] - rj[e]);
                    a = __builtin_bit_cast(bf16x8, pack8(v)); }
                const bf16x8 bfr = *(const bf16x8*)(P + (size_t)(16 * J + fr) * NPROJ + (J < ib ? PC_CF : PC_CI) + 32 * ks + 8 * kq);
                acc = __builtin_amdgcn_mfma_f32_16x16x32_bf16(a, bfr, acc, 0, 0, 0);
            }
        }
#pragma unroll
        for (int r = 0; r < 4; ++r) { const int i = 4 * kq + r, j = fr; const float v = (J < ib || (J == ib && j <= i)) ? acc[r] : 0.f; scr[(4 * kq + r) * 72 + 16 * J + fr] = (bf16)f2bf(v); }
    }
    asm volatile("s_waitcnt lgkmcnt(0)" ::: "memory");
    bf16x8 ga[2];
#pragma unroll
    for (int ks = 0; ks < 2; ++ks) ga[ks] = *(const LAS bf16x8*)(scr + fr * 72 + 32 * ks + 8 * kq);
    asm volatile("s_waitcnt lgkmcnt(0)" ::: "memory");
    bf16x8 qs[2];
#pragma unroll
    for (int ks = 0; ks < 2; ++ks) { float v[8];
#pragma unroll
        for (int e = 0; e < 8; ++e) v[e] = qv[ks][e] * __expf(rI[ks][e]);
        qs[ks] = __builtin_bit_cast(bf16x8, pack8(v)); }
    const int nks = (ib + 2) >> 1;
    const bf16* vt = F_VT + ((size_t)ci * 256 + h * 64) * 64;
    const bf16* sin_b = F_STC + (size_t)(ci * 4 + h) * 4096; const float* sin_f = inp(I_SHGRN) + (size_t)((layer * NSB + (c.b < 0 ? 0 : c.b)) * 4 + h) * 4096;
    f32x4 o[4]; float sq[4] = {0.f, 0.f, 0.f, 0.f};
#pragma unroll
    for (int t = 0; t < 4; ++t) {
        o[t] = (f32x4){0.f, 0.f, 0.f, 0.f};
#pragma unroll
        for (int ks = 0; ks < 2; ++ks) if (ks < nks) { const bf16x8 bfr = *(const bf16x8*)(vt + (size_t)(t * 16 + fr) * 64 + 32 * ks + 8 * kq); o[t] = __builtin_amdgcn_mfma_f32_16x16x32_bf16(ga[ks], bfr, o[t], 0, 0, 0); }
#pragma unroll
        for (int ks = 0; ks < 2; ++ks) { bf16x8 bfr;
            if (c.b < 0) bfr = *(const bf16x8*)(sin_b + (size_t)(t * 16 + fr) * 64 + 32 * ks + 8 * kq);
            else { float v[8];
#pragma unroll
                for (int e = 0; e < 8; ++e) v[e] = sin_f[(size_t)(32 * ks + 8 * kq + e) * 64 + t * 16 + fr];
                bfr = __builtin_bit_cast(bf16x8, pack8(v)); }
            o[t] = __builtin_amdgcn_mfma_f32_16x16x32_bf16(qs[ks], bfr, o[t], 0, 0, 0); }
#pragma unroll
        for (int r = 0; r < 4; ++r) sq[r] += o[t][r] * o[t][r];
    }
    const float* nw = inp(I_CNRM) + (size_t)layer * 256 + h * 64;
#pragma unroll
    for (int r = 0; r < 4; ++r) { const float rstd = rsq_f(sum16_l(lane_, sq[r]) * (1.0f / 64.0f) + EPS); const size_t row = (size_t)(16 * ib + 4 * kq + r);
#pragma unroll
        for (int t = 0; t < 4; ++t) { const int v = t * 16 + fr; const float cg = bf1(P[row * NPROJ + PC_CG + v]);
            F_XN[(size_t)(c.row0 + row) * D + 512 + h * 64 + v] = (bf16)f2bf(o[t][r] * rstd * nw[v] * silu_g(cg)); } }
}

constexpr int HO_KE = 0, HO_VT = 64 * 264 * 2, HO_SIN = HO_VT + 256 * 72 * 2, HO_R = HO_SIN + 256 * 72 * 2, HO_SCR = HO_R + 1280 * 4, HO_END = HO_SCR + 8 * 2304;
static_assert(HO_END <= MISC_OFF, "hgrn_out_block LDS map");
__device__ __forceinline__ void hgrn_out_block(Frame& F, int layer, int ci) {
    ITEM_IDS();
    const int row0 = 64 * ci;
    LAS bf16* KEl = (LAS bf16*)(F.lds + HO_KE); LAS bf16* VTl = (LAS bf16*)(F.lds + HO_VT); LAS bf16* SIN = (LAS bf16*)(F.lds + HO_SIN); lf32* Rl = (lf32*)(F.lds + HO_R);
    LAS bf16* scr = (LAS bf16*)(F.lds + HO_SCR + wave_ * 2304);
    const int kq = lane_ >> 4, fr = lane_ & 15, h = wave_ >> 1, wp = wave_ & 1;
    const bf16* P = F_PROJ + (size_t)row0 * NPROJ;
    v4u st[13];
    { const bf16* kg = P + PC_CF; const bf16* vg = F_VT + (size_t)ci * 16384; const bf16* sg = F_STC + (size_t)ci * 1024; const float* rg = F_RH + (size_t)ci * 1280;
#pragma unroll
      for (int q = 0; q < 4; ++q) { const int it = tid_ + q * NTHR; st[q] = *(const v4u*)(kg + (size_t)(it >> 5) * NPROJ + 8 * (it & 31)); }
#pragma unroll
      for (int q = 0; q < 4; ++q) st[4 + q] = *(const v4u*)(vg + (size_t)(tid_ + q * NTHR) * 8);
#pragma unroll
      for (int q = 0; q < 4; ++q) st[8 + q] = *(const v4u*)(sg + (size_t)(4 * q + (tid_ >> 7)) * (NCHP * 1024) + (tid_ & 127) * 8);
      st[12] = (v4u){0u, 0u, 0u, 0u}; if (tid_ < 320) st[12] = *(const v4u*)(rg + 4 * tid_); }
    bf16x8 qf[2][2], kd[2][2];
#pragma unroll
    for (int bi = 0; bi < 2; ++bi)
#pragma unroll
        for (int ks = 0; ks < 2; ++ks) { const bf16* p = P + (size_t)(16 * (bi == 0 ? wp : 3 - wp) + fr) * NPROJ + h * 64 + 32 * ks + 8 * kq; qf[bi][ks] = *(const bf16x8*)(p + PC_CQ); kd[bi][ks] = *(const bf16x8*)(p + PC_CI); }
#pragma unroll
    for (int q = 0; q < 4; ++q) { const int it = tid_ + q * NTHR; *(LAS v4u*)(KEl + (it >> 5) * 264 + 8 * (it & 31)) = st[q]; }
#pragma unroll
    for (int q = 0; q < 4; ++q) { const int it = tid_ + q * NTHR; *(LAS v4u*)(VTl + (it >> 3) * 72 + 8 * (it & 7)) = st[4 + q]; *(LAS v4u*)(SIN + (it >> 3) * 72 + 8 * (it & 7)) = st[8 + q]; }
    if (tid_ < 320) *(LAS v4u*)(Rl + 4 * tid_) = st[12];
    bf16 cgv[2][4][4];
#pragma unroll
    for (int bi = 0; bi < 2; ++bi)
#pragma unroll
        for (int t = 0; t < 4; ++t)
#pragma unroll
            for (int r = 0; r < 4; ++r) cgv[bi][t][r] = P[(size_t)(16 * (bi == 0 ? wp : 3 - wp) + 4 * kq + r) * NPROJ + PC_CG + h * 64 + t * 16 + fr];
    __syncthreads();
    const float* nw = inp(I_CNRM) + (size_t)layer * 256 + h * 64;
#pragma unroll
    for (int bi = 0; bi < 2; ++bi) {
        const int ib = bi == 0 ? wp : 3 - wp;
        float qv[2][8], rI[2][8];
#pragma unroll
        for (int ks = 0; ks < 2; ++ks) { unpack8(__builtin_bit_cast(v4u, qf[bi][ks]), qv[ks]); const lf32* rp = Rl + ib * 256 + h * 64 + 32 * ks + 8 * kq;
#pragma unroll
            for (int e = 0; e < 8; ++e) rI[ks][e] = rp[e]; }
#pragma unroll
        for (int J = 0; J < 4; ++J) {
            f32x4 acc = {0.f, 0.f, 0.f, 0.f};
            if (J <= ib) {
#pragma unroll
                for (int ks = 0; ks < 2; ++ks) {
                    bf16x8 a = qf[bi][ks], bfr = kd[bi][ks];
                    if (J < ib) { const lf32* rp = Rl + (J + 1) * 256 + h * 64 + 32 * ks + 8 * kq; float v[8];
#pragma unroll
                        for (int e = 0; e < 8; ++e) v[e] = qv[ks][e] * __expf(rI[ks][e] - rp[e]);
                        a = __builtin_bit_cast(bf16x8, pack8(v)); bfr = *(const LAS bf16x8*)(KEl + (16 * J + fr) * 264 + h * 64 + 32 * ks + 8 * kq); }
                    acc = __builtin_amdgcn_mfma_f32_16x16x32_bf16(a, bfr, acc, 0, 0, 0);
                }
            }
#pragma unroll
            for (int r = 0; r < 4; ++r) { const int i = 4 * kq + r, j = fr; const float v = (J < ib || (J == ib && j <= i)) ? acc[r] : 0.f; scr[(4 * kq + r) * 72 + 16 * J + fr] = (bf16)f2bf(v); }
        }
        asm volatile("s_waitcnt lgkmcnt(0)" ::: "memory");
        bf16x8 ga[2];
#pragma unroll
        for (int ks = 0; ks < 2; ++ks) ga[ks] = *(const LAS bf16x8*)(scr + fr * 72 + 32 * ks + 8 * kq);
        asm volatile("s_waitcnt lgkmcnt(0)" ::: "memory");
        bf16x8 qs[2];
#pragma unroll
        for (int ks = 0; ks < 2; ++ks) { float v[8];
#pragma unroll
            for (int e = 0; e < 8; ++e) v[e] = qv[ks][e] * __expf(rI[ks][e]);
            qs[ks] = __builtin_bit_cast(bf16x8, pack8(v)); }
        const int nks = (ib + 2) >> 1;
        f32x4 o[4]; float sq[4] = {0.f, 0.f, 0.f, 0.f};
#pragma unroll
        for (int t = 0; t < 4; ++t) {
            o[t] = (f32x4){0.f, 0.f, 0.f, 0.f};
#pragma unroll
            for (int ks = 0; ks < 2; ++ks) if (ks < nks) o[t] = __builtin_amdgcn_mfma_f32_16x16x32_bf16(ga[ks], *(const LAS bf16x8*)(VTl + (h * 64 + t * 16 + fr) * 72 + 32 * ks + 8 * kq), o[t], 0, 0, 0);
#pragma unroll
            for (int ks = 0; ks < 2; ++ks) o[t] = __builtin_amdgcn_mfma_f32_16x16x32_bf16(qs[ks], *(const LAS bf16x8*)(SIN + (h * 64 + t * 16 + fr) * 72 + 32 * ks + 8 * kq), o[t], 0, 0, 0);
#pragma unroll
            for (int r = 0; r < 4; ++r) sq[r] += o[t][r] * o[t][r];
        }
#pragma unroll
        for (int r = 0; r < 4; ++r) { const float rstd = rsq_f(sum16_l(lane_, sq[r]) * (1.0f / 64.0f) + EPS); bf16* op = F_XN + (size_t)(row0 + 16 * ib + 4 * kq + r) * D + 512 + h * 64 + fr;
#pragma unroll
            for (int t = 0; t < 4; ++t) op[t * 16] = (bf16)f2bf(o[t][r] * rstd * nw[t * 16 + fr] * silu_g(bf1(cgv[bi][t][r]))); }
    }
    __syncthreads();
}
template <int MODE>
__device__ __forceinline__ void mini_gemm(Frame& F, const bf16* A, const bf16* Bt, int K, int ncb, bf16* O, int ldo, const float* res, float* C, const float* nw = nullptr, bf16* xo = nullptr, float* rs = nullptr) {
    ITEM_IDS();
    const int kq = lane_ >> 4, fr = lane_ & 15;
    for (int wi = ((int)blockIdx.x) * NWAVES + wave_; wi < 16 * ncb; wi += ((int)gridDim.x) * NWAVES) {
        const int rb = wi & 15, cb = wi >> 4;
        const bf16* ap = A + (size_t)(MP + 16 * rb + fr) * K + 8 * kq;
        const int c = 16 * cb + fr;
        const bf16* bp = Bt + (size_t)(MODE == 2 ? ((c >> 7) * 256 + (c & 127)) : c) * K + 8 * kq;
        f32x4 acc0 = {0.f, 0.f, 0.f, 0.f}, acc1 = {0.f, 0.f, 0.f, 0.f};
#pragma unroll 8
        for (int k0 = 0; k0 < K; k0 += 32) {
            const bf16x8 a = *(const bf16x8*)(ap + k0), b0 = *(const bf16x8*)(bp + k0);
            acc0 = __builtin_amdgcn_mfma_f32_16x16x32_bf16(a, b0, acc0, 0, 0, 0);
            if (MODE == 2) { const bf16x8 b1 = *(const bf16x8*)(bp + (size_t)128 * K + k0); acc1 = __builtin_amdgcn_mfma_f32_16x16x32_bf16(a, b1, acc1, 0, 0, 0); }
        }
#pragma unroll
        for (int r = 0; r < 4; ++r) { const size_t row = (size_t)(MP + 16 * rb + 4 * kq + r);
            if (MODE == 0) { const bf16 ob = (bf16)f2bf(acc0[r]); O[row * ldo + c] = ob; if (c >= PC_V && c < PC_V + 256) F_VTA[(size_t)(c - PC_V) * M + row] = ob; }
            if (MODE == 1) { const float x = res[row * 1024 + c] + acc0[r]; C[row * 1024 + c] = x;
                if (nw) { xo[row * 1024 + c] = (bf16)f2bf(x * nw[c]); const float q = sum16_l(lane_, x * x); if (fr == 0) atomicAdd(rs + row, q); } }
            if (MODE == 2) O[row * ldo + c] = (bf16)f2bf(silu_g(acc0[r]) * acc1[r]); }
    }
}

template <int MODE, int KS>
__device__ __forceinline__ void mini_gemm2(Frame& F, const bf16* A, const bf16* Bt, int K, int ncb32, bf16* O, int ldo, const float* res, float* C, const float* nw = nullptr, bf16* xo = nullptr, float* rs = nullptr, const bf16* rbf = nullptr, const float* rw = nullptr, bf16* Cb = nullptr) {
    ITEM_IDS();
    const int kq = lane_ >> 4, fr = lane_ & 15;
    LAS f32x4* red = (LAS f32x4*)F.lds;
    for (int it = (int)blockIdx.x; it < 8 * ncb32; it += (int)gridDim.x) {
        const int rb = it & 7, cb = it >> 3;
        const bf16* ap = A + (size_t)(MP + 32 * rb + fr) * K + wave_ * (KS * 32) + 8 * kq;
        const bf16* bp = Bt + (size_t)(32 * cb + fr) * K + wave_ * (KS * 32) + 8 * kq;
        f32x4 acc[2][2] = {{(f32x4){0.f, 0.f, 0.f, 0.f}, (f32x4){0.f, 0.f, 0.f, 0.f}}, {(f32x4){0.f, 0.f, 0.f, 0.f}, (f32x4){0.f, 0.f, 0.f, 0.f}}};
#pragma unroll (KS > 6 ? 6 : KS)
        for (int ks = 0; ks < KS; ++ks) {
            bf16x8 a[2], b[2];
#pragma unroll
            for (int i = 0; i < 2; ++i) { a[i] = *(const bf16x8*)(ap + (size_t)(16 * i) * K + 32 * ks); b[i] = *(const bf16x8*)(bp + (size_t)(16 * i) * K + 32 * ks); }
#pragma unroll
            for (int i = 0; i < 2; ++i)
#pragma unroll
                for (int j = 0; j < 2; ++j) acc[i][j] = __builtin_amdgcn_mfma_f32_16x16x32_bf16(a[i], b[j], acc[i][j], 0, 0, 0);
        }
#pragma unroll
        for (int i = 0; i < 2; ++i)
#pragma unroll
            for (int j = 0; j < 2; ++j) red[(wave_ * 4 + 2 * i + j) * 64 + lane_] = acc[i][j];
        __syncthreads();
        if (wave_ < 4) {
            const int qi = wave_ >> 1, qj = wave_ & 1;
            f32x4 s = red[wave_ * 64 + lane_];
#pragma unroll
            for (int w = 1; w < 8; ++w) s += red[(w * 4 + wave_) * 64 + lane_];
            const int c = 32 * cb + 16 * qj + fr;
#pragma unroll
            for (int r = 0; r < 4; ++r) { const size_t row = (size_t)(MP + 32 * rb + 16 * qi + 4 * kq + r);
                if (MODE == 0) { const bf16 ob = (bf16)f2bf(s[r]); O[row * ldo + c] = ob; if (c >= PC_V && c < PC_V + 256) F_VTA[(size_t)(c - PC_V) * M + row] = ob; }
                if (MODE == 1) { const float x = (rbf ? bf1(rbf[row * 1024 + c]) * (rw ? rcp_f(rw[c]) : 1.0f) : res[row * 1024 + c]) + s[r]; if (C) C[row * 1024 + c] = x; if (Cb) Cb[row * 1024 + c] = (bf16)f2bf(x);
                    if (nw) { xo[row * 1024 + c] = (bf16)f2bf(x * nw[c]); const float q = sum16_l(lane_, x * x); if (fr == 0) atomicAdd(rs + row, q); } } }
        }
        __syncthreads();
    }
}

__device__ __forceinline__ void mini_gemm_proj(Frame& F, const bf16* A, const bf16* Bt, bf16* O, const float* rs) {
    ITEM_IDS();
    const int kq = lane_ >> 4, fr = lane_ & 15;
    LAS f32x4* red = (LAS f32x4*)F.lds;
    for (int it = (int)blockIdx.x; it < 4 * (NPROJ / 64); it += (int)gridDim.x) {
        const int rb = it & 3, cb = it >> 2;
        const bf16* ap = A + (size_t)(MP + 64 * rb + fr) * D + wave_ * 128 + 8 * kq;
        const bf16* bp = Bt + (size_t)(64 * cb + fr) * D + wave_ * 128 + 8 * kq;
        f32x4 acc[4][4];
#pragma unroll
        for (int i = 0; i < 4; ++i)
#pragma unroll
            for (int j = 0; j < 4; ++j) acc[i][j] = (f32x4){0.f, 0.f, 0.f, 0.f};
        bf16x8 a[4][4], b[4][4];
#pragma unroll
        for (int ks = 0; ks < 4; ++ks)
#pragma unroll
            for (int i = 0; i < 4; ++i) { a[ks][i] = *(const bf16x8*)(ap + (size_t)(16 * i) * D + 32 * ks); b[ks][i] = *(const bf16x8*)(bp + (size_t)(16 * i) * D + 32 * ks); }
#pragma unroll
        for (int ks = 0; ks < 4; ++ks)
#pragma unroll
            for (int i = 0; i < 4; ++i)
#pragma unroll
                for (int j = 0; j < 4; ++j) acc[i][j] = __builtin_amdgcn_mfma_f32_16x16x32_bf16(a[ks][i], b[ks][j], acc[i][j], 0, 0, 0);
#pragma unroll
        for (int i = 0; i < 4; ++i)
#pragma unroll
            for (int j = 0; j < 4; ++j) red[(wave_ * 16 + 4 * i + j) * 64 + lane_] = acc[i][j];
        __syncthreads();
#pragma unroll
        for (int u = 0; u < 2; ++u) { const int q = 2 * wave_ + u, qi = q >> 2, qj = q & 3;
            f32x4 s = red[q * 64 + lane_];
#pragma unroll
            for (int w = 1; w < 8; ++w) s += red[(w * 16 + q) * 64 + lane_];
            const int c = 64 * cb + 16 * qj + fr;
#pragma unroll
            for (int r = 0; r < 4; ++r) { const size_t row = (size_t)(MP + 64 * rb + 16 * qi + 4 * kq + r); const bf16 ob = (bf16)f2bf(rs ? s[r] * rsq_f(rs[row] * (1.0f / 1024.0f) + EPS) : s[r]); O[row * NPROJ + c] = ob; if (c >= PC_V && c < PC_V + 256) F_VTA[(size_t)(c - PC_V) * M + row] = ob; } }
        __syncthreads();
    }
}

__device__ __forceinline__ void mini_dt(Frame& F, const bf16* A, const bf16* Wd, const float* rs, float* DTo) {
    ITEM_IDS();
    const int kq = lane_ >> 4, fr = lane_ & 15;
    for (int wi = (int)blockIdx.x * NWAVES + wave_; wi < M / 16; wi += (int)gridDim.x * NWAVES) {
        const bf16* ap = A + (size_t)(16 * wi + fr) * D + 8 * kq; const bf16* bp = Wd + (size_t)fr * D + 8 * kq;
        f32x4 acc = {0.f, 0.f, 0.f, 0.f};
#pragma unroll 16
        for (int k0 = 0; k0 < D; k0 += 32) acc = __builtin_amdgcn_mfma_f32_16x16x32_bf16(*(const bf16x8*)(ap + k0), *(const bf16x8*)(bp + k0), acc, 0, 0, 0);
        if (fr < 4) {
#pragma unroll
            for (int r = 0; r < 4; ++r) { const int row = 16 * wi + 4 * kq + r; DTo[(size_t)row * 4 + fr] = acc[r] * rsq_f(rs[row] * (1.0f / 1024.0f) + EPS); } }
    }
}
__device__ __forceinline__ void sample_mix_item(Frame& F, int layer, int b) {
    ssd_prep_item(F, layer, NCHP + b);
    hgrn_prep_item(F, layer, NCHP + b);
    asm volatile("s_waitcnt vmcnt(0)" ::: "memory");
    __syncthreads();
    __builtin_amdgcn_fence(__ATOMIC_ACQUIRE, "agent");
    asm volatile("s_waitcnt vmcnt(0)" ::: "memory");
    { ITEM_IDS();
      if (wave_ == 0) ssd_out_witem(F, layer, NCHP + b, 0, wave_, lane_);
      else if (wave_ <= 4) hgrn_out_witem(F, layer, NCHP + b, wave_ - 1, 0, wave_, lane_); }
    __syncthreads();
}
__device__ __forceinline__ void p2_phase(Frame& F, int layer, volatile LAS unsigned* MISC) {
    constexpr int NS = NSB, NA = NCH * 4, NB = NCHP, NC = NCHP, ND = NCH, NE = 64, NW0 = 296, NW = 432;
    const int NTOT = NS + NA + NB + NC + ND + NE + (layer == 0 ? NW0 + NW : 0);
    unsigned* head = (unsigned*)(F.ws + WS_CTL) + CW_QUEUE + 64 * layer;
    attn_bias_load(F, layer);
    unsigned nxt = 0u; if (threadIdx.x == 0) nxt = __hip_atomic_fetch_add(head, 1u, __ATOMIC_RELAXED, __HIP_MEMORY_SCOPE_AGENT);
    for (;;) {
        __syncthreads();
        if (threadIdx.x == 0) MISC[12] = nxt;
        __syncthreads();
        int it = (int)MISC[12];
        if (it >= NTOT) break;
        if (threadIdx.x == 0) nxt = __hip_atomic_fetch_add(head, 1u, __ATOMIC_RELAXED, __HIP_MEMORY_SCOPE_AGENT);
        if (it < NS) { sample_mix_item(F, layer, it); continue; } it -= NS;
        if (it < NA) { const int i2 = it - NSB * 4; const int ci = it < NSB * 4 ? NCHP + (it >> 2) : NCHP - 1 - (i2 >> 2); attn_item(F, layer, ci, it & 3); }
        else if (it < NA + NB) ssd_prep_item(F, layer, it - NA);
        else if (it < NA + NB + NC) hgrn_prep_item(F, layer, it - NA - NB);
        else if (it < NA + NB + NC + ND) pool_item(F, layer, it - NA - NB - NC);
        else if (it < NA + NB + NC + ND + NE) copy_cache(F, layer, it - NA - NB - NC - ND, NE);
        else { ITEM_IDS(); const int iw = it - NA - NB - NC - ND - NE;
            if (iw < NW0) p0_weights(F, 0, iw * NWAVES + wave_, NW0 * NWAVES, false, 1); else p0_weights(F, 1, (iw - NW0) * NWAVES + wave_, NW * NWAVES, false); }
    }
}
__device__ __forceinline__ void p4_phase(Frame& F, int layer) {
    for (int ci = ((int)blockIdx.x); ci < NCHP; ci += ((int)gridDim.x)) { ssd_out_block(F, layer, ci); hgrn_out_block(F, layer, ci); }
    state_misc(F, layer, (int)blockIdx.x, (int)gridDim.x);
}

__global__ void __launch_bounds__(NTHR, 2) fwd_kernel(Args args) {
    extern __shared__ __attribute__((aligned(16))) unsigned char lds[];
    Frame F;
    F.lds = (LAS unsigned char*)lds;
    F.out = args.out; F.ws = args.ws;
    volatile LAS unsigned* MISC = (volatile LAS unsigned*)(F.lds + MISC_OFF);
    if (threadIdx.x < 64) MISC[threadIdx.x] = 0u;
    __syncthreads();
    (void)xcd_barrier_post((unsigned*)(args.ws + WS_CTL) + CW_BAR, MISC + 8);
#define GRID_BAR() do { XcdBarrier bar_; bar_.bar = (unsigned*)((unsigned char*)inp(N_IN + 1) + WS_CTL) + CW_BAR; bar_.x = xb_xcc_id(); bar_.st = MISC + 8; xcd_barrier(bar_); \
        F.out = (float*)inp(N_IN); F.ws = (unsigned char*)inp(N_IN + 1); } while (0)
#ifdef TPROBE
    const bool stamper = (blockIdx.x == 0 && threadIdx.x == 0); int n_stamp = 0;
#define STAMP() do { if (stamper) MISC[16 + n_stamp] = (unsigned)__builtin_amdgcn_s_memrealtime(); ++n_stamp; } while (0)
#else
#define STAMP() do { } while (0)
#endif
    STAMP();

    { float* rsz = F_RS; for (int i = (int)blockIdx.x * NTHR + (int)threadIdx.x; i < 3 * M; i += (int)gridDim.x * NTHR) rsz[i] = 0.f;
      const float* w1 = inp(I_WIN) + (size_t)D * NIN; bf16* wd = F_WDT; for (int i = (int)blockIdx.x * NTHR + (int)threadIdx.x; i < 16 * D; i += (int)gridDim.x * NTHR) { const int hh = i >> 10, kk = i & 1023; wd[i] = hh < 4 ? (bf16)f2bf(w1[(size_t)kk * NIN + 1792 + hh]) : (bf16)0; } }
    {
      const int w_ = __builtin_amdgcn_readfirstlane((int)(threadIdx.x >> 6));
      { const float* wdt = inp(I_WIN); lf32* wl = (lf32*)(F.lds + 135168); for (int k2 = (int)threadIdx.x; k2 < D; k2 += NTHR) *(LAS f32x4*)(wl + 4 * k2) = *(const f32x4*)(wdt + (size_t)k2 * NIN + 1792); }
      { const float* pw = inp(I_PW); for (int i = (int)blockIdx.x * NTHR + (int)threadIdx.x; i < 2 * 4 * 64 * 64; i += (int)gridDim.x * NTHR) { const int c = i & 63, d = (i >> 6) & 63, lg = i >> 12; F_WPT[i] = (bf16)f2bf(pw[(size_t)(lg * 64 + c) * 64 + d]); } }
      __syncthreads();
      if (w_ < 2) p0_weights(F, 0, (int)blockIdx.x * 2 + w_, (int)gridDim.x * 2, false, 0);
      else norm_rows<true, false>(F, inp(I_XP), inp(I_XS) - (size_t)MP * D, inp(I_N1), inp(I_WIN), nullptr, (int)blockIdx.x * 6 + (w_ - 2), (int)gridDim.x * 6); }
    GRID_BAR(); STAMP();
#pragma unroll 1
    for (int layer = 0; layer < 2; ++layer) {
        unsigned char* wl = F.ws + WS_W + (size_t)layer * WL_STRIDE;
        const bf16* a1 = layer == 0 ? F_XN : (const bf16*)F.out; const float* rs1 = layer == 0 ? nullptr : F_RS + 2 * (size_t)M;
        if (layer == 1) mini_dt(F, a1, F_WDT, rs1, F_DT);
        mini_gemm_proj(F, a1, (const bf16*)(wl + WL_IN), F_PROJ, rs1);
        { pg8::Gemm g{a1, (const bf16*)(wl + WL_IN), MP, NPROJ, D}; pg8::StaticOrder S; S.init(MP, NPROJ, ((int)gridDim.x), ((int)blockIdx.x));
          pg8::EpiBf16 E{F_PROJ, NPROJ, F_HALO, F_VTA, M, rs1};
          pg8::gemm_phase<pg8::EpiBf16, pg8::StaticOrder, true, true>(F.lds + RING_OFF, g, S, E); }
        GRID_BAR(); STAMP();
        p2_phase(F, layer, MISC);
        GRID_BAR(); STAMP();
        scan_phase(F, layer);
        GRID_BAR(); STAMP();
        p4_phase(F, layer);
        GRID_BAR(); STAMP();
        mini_gemm2<1, 4>(F, F_XN, (const bf16*)(wl + WL_OUT), D, D / 32, nullptr, 0, inp(I_XS) - (size_t)MP * D, nullptr, inp(I_N2) + (size_t)layer * D, F_XN2, F_RS + (size_t)layer * M, layer == 0 ? nullptr : (const bf16*)F.out, layer == 0 ? nullptr : inp(I_N1) + D);
        { pg8::Gemm g{F_XN, (const bf16*)(wl + WL_OUT), MP, D, D}; pg8::StaticOrder S; S.init(MP, D, ((int)gridDim.x), ((int)blockIdx.x));
          pg8::EpiRes E{inp(I_XP), inp(I_XS) - (size_t)MP * D, nullptr, inp(I_N2) + (size_t)layer * D, F_XN2, F_RS + (size_t)layer * M, layer == 0 ? nullptr : (const bf16*)F.out, layer == 0 ? nullptr : inp(I_N1) + D, nullptr};
          pg8::gemm_phase<pg8::EpiRes, pg8::StaticOrder, true, true>(F.lds + RING_OFF, g, S, E); }
        GRID_BAR(); STAMP();
        { pg8::Gemm g{F_XN2, (const bf16*)(wl + WL_GU), M, NGU, D}; pg8::StaticOrder S; S.init(M, NGU, ((int)gridDim.x), ((int)blockIdx.x));
          pg8::EpiSwiGLU E{F_ACT, DFF, F_RS + (size_t)layer * M};
          pg8::gemm_phase<pg8::EpiSwiGLU, pg8::StaticOrder, true, true>(F.lds + RING_OFF, g, S, E); }
        GRID_BAR(); STAMP();
        mini_gemm2<1, 11>(F, F_ACT, (const bf16*)(wl + WL_DN), DFF, D / 32, nullptr, 0, nullptr, nullptr, layer == 0 ? inp(I_N1) + D : nullptr, (bf16*)F.out, F_RS + 2 * (size_t)M, F_XN2, inp(I_N2) + (size_t)layer * D, layer == 0 ? nullptr : F_XN);
        { pg8::Gemm g{F_ACT, (const bf16*)(wl + WL_DN), MP, D, DFF}; pg8::StaticOrder S; S.init(MP, D, ((int)gridDim.x), ((int)blockIdx.x));
          pg8::EpiRes E{nullptr, nullptr, nullptr, layer == 0 ? inp(I_N1) + D : nullptr, (bf16*)F.out, F_RS + 2 * (size_t)M, F_XN2, inp(I_N2) + (size_t)layer * D, layer == 0 ? nullptr : F_XN};
          pg8::gemm_phase<pg8::EpiRes, pg8::StaticOrder, true, true>(F.lds + RING_OFF, g, S, E); }
        GRID_BAR(); STAMP();
        if (layer == 1) { norm_rows<false, true>(F, nullptr, nullptr, inp(I_NF), nullptr, F_XN); STAMP(); }
    }
#ifdef TPROBE
    if (stamper) {
        unsigned v[10]; v[0] = MISC[17] - MISC[16];
        for (int j = 1; j < 9; ++j) v[j] = (MISC[17 + j] - MISC[16 + j]) + (MISC[25 + j] - MISC[24 + j]);
        v[9] = (MISC[33] - MISC[16]) / 4;
#if TPROBE >= 20
        gu32* pw = (gu32*)((unsigned*)(F.ws + WS_CTL) + CW_SCAN - 64);
#if TPROBE == 22
        const unsigned e1 = __hip_atomic_load(pw + 4, __ATOMIC_RELAXED, __HIP_MEMORY_SCOPE_AGENT), e0 = 0xFFFFFFFFu - __hip_atomic_load(pw + 5, __ATOMIC_RELAXED, __HIP_MEMORY_SCOPE_AGENT), e2 = __hip_atomic_load(pw + 6, __ATOMIC_RELAXED, __HIP_MEMORY_SCOPE_AGENT);
        const unsigned qa = (e1 - e0) / 10u, qb = (e2 - e0) / 10u;
#else
        const unsigned qa = __hip_atomic_load(pw + 2 * (TPROBE - 20), __ATOMIC_RELAXED, __HIP_MEMORY_SCOPE_AGENT) / 10u, qb = __hip_atomic_load(pw + 2 * (TPROBE - 20) + 1, __ATOMIC_RELAXED, __HIP_MEMORY_SCOPE_AGENT) / 10u;
#endif
#if TPROBE >= 23
        const unsigned e1_ = __hip_atomic_load(pw + 4, __ATOMIC_RELAXED, __HIP_MEMORY_SCOPE_AGENT), e0_ = 0xFFFFFFFFu - __hip_atomic_load(pw + 5, __ATOMIC_RELAXED, __HIP_MEMORY_SCOPE_AGENT), e2_ = __hip_atomic_load(pw + 6, __ATOMIC_RELAXED, __HIP_MEMORY_SCOPE_AGENT);
        const unsigned sv = TPROBE == 23 ? __hip_atomic_load(pw + 3, __ATOMIC_RELAXED, __HIP_MEMORY_SCOPE_AGENT) : TPROBE == 24 ? __hip_atomic_load(pw + 2, __ATOMIC_RELAXED, __HIP_MEMORY_SCOPE_AGENT) : TPROBE == 25 ? e2_ - e0_ : TPROBE == 26 ? e1_ - e0_ : TPROBE == 27 ? __hip_atomic_load(pw + 1, __ATOMIC_RELAXED, __HIP_MEMORY_SCOPE_AGENT) : __hip_atomic_load(pw, __ATOMIC_RELAXED, __HIP_MEMORY_SCOPE_AGENT);
        const unsigned dl = 800000u + 32u * sv;
        (void)qa; (void)qb;
#else
        const unsigned dl = 800000u + 50u * ((qa < 511u ? qa : 511u) + 512u * qb);
#endif
#else
        const unsigned dl = 800000u + 16u * v[TPROBE];
#endif
        const unsigned t0 = MISC[16];
        while ((unsigned)((unsigned)__builtin_amdgcn_s_memrealtime() - t0) < dl) __builtin_amdgcn_s_sleep(32);
    }
#endif
}

extern "C" void kernel_launch(void* const* d_in, const int* in_sizes, int n_in, void* d_out, int out_size, void* d_ws, size_t ws_size, hipStream_t stream) {
    static int grid = 0;
    if (grid == 0) {
        if (n_in != N_IN || (size_t)out_size != O_END || ws_size < WS_END) { fprintf(stderr, "kernel_launch: unexpected shapes (n_in %d, out %d, ws %zu)\n", n_in, out_size, ws_size); grid = -1; return; }
        int dev = 0, cus = 0, per_cu = 0;
        if (hipGetDevice(&dev) != hipSuccess || hipDeviceGetAttribute(&cus, hipDeviceAttributeMultiprocessorCount, dev) != hipSuccess) { grid = -1; return; }
        if (hipFuncSetAttribute((const void*)fwd_kernel, hipFuncAttributeMaxDynamicSharedMemorySize, LDS_BYTES) != hipSuccess) { fprintf(stderr, "kernel_launch: hipFuncSetAttribute failed\n"); grid = -1; return; }
        if (hipOccupancyMaxActiveBlocksPerMultiprocessor(&per_cu, (const void*)fwd_kernel, NTHR, LDS_BYTES) != hipSuccess || per_cu < 1) { fprintf(stderr, "kernel_launch: occupancy query says %d blocks per CU\n", per_cu); (void)hipGetLastError(); grid = -1; return; }
        grid = cus;
        if (grid < 224) { fprintf(stderr, "kernel_launch: needs at least 224 CUs (got %d)\n", cus); grid = -1; return; }
    }
    if (grid < 0) return;
    if (hipMemsetAsync((char*)d_ws + WS_CTL, 0, CTL_ZERO_BYTES, stream) != hipSuccess) { fprintf(stderr, "kernel_launch: hipMemsetAsync failed\n"); return; }
    Args a{};
    for (int i = 0; i < N_IN; ++i) a.in[i] = (const float*)d_in[i];
    a.out = (float*)d_out; a.ws = (unsigned char*)d_ws;
    void* kargs[] = {&a};
    hipError_t e = hipLaunchCooperativeKernel((const void*)fwd_kernel, dim3(grid), dim3(NTHR), kargs, LDS_BYTES, stream);
    if (e != hipSuccess) { fprintf(stderr, "kernel_launch: cooperative launch failed: %s (grid %d)\n", hipGetErrorString(e), grid); }
}
```
